# Optimizing an MI355X kernel written in HIP

```python
import math
import jax
import jax.numpy as jnp
from jax import lax
import numpy as np

D_MODEL = 1024
BATCH = 8
SEQ = 2048
DEPTH = 4

N_META = 16
LEAD = 128
HG_WIDTH = 512
HG_HEADS = 4
HG_DK = 128
HG_DV = 128
HG_CHUNK = 64
DA_WIDTH = 512
DA_HEADS = 4
DA_DQK = 64
DA_DV = 128
Q_BLOCK = 128
REL_BUCKETS = 32
REL_MAX_DIST = 128
D_FF_DENSE = 2816
N_EXPERTS = 8
TOP_K = 2
D_FF_EXPERT = 3584
MOE_BLOCK = 128
EPS = 1e-6
NEG = -1e30
LB_MAX = 0.999
MIX_WIDTH = HG_WIDTH + DA_WIDTH
W_IN_COLS = 4 * HG_WIDTH + 2 * (DA_HEADS * 2 * DA_DQK) + DA_HEADS * DA_DV
N_DENSE = (DEPTH + 1) // 2
N_MOE = DEPTH // 2

kernel_name = 'hybrid_hgrn2_diffattn_moe'


def rmsnorm(x, w):
    xf = x.astype(jnp.float32)
    y = xf * lax.rsqrt(jnp.mean(xf * xf, axis=-1, keepdims=True) + EPS)
    return (y * w.astype(jnp.float32)).astype(x.dtype)


def t5_causal_bucket(dist):
    n = jnp.maximum(dist, 0)
    max_exact = REL_BUCKETS // 2
    nf = jnp.maximum(n, max_exact).astype(jnp.float32)
    large = max_exact + (jnp.log(nf / max_exact) / math.log(REL_MAX_DIST / max_exact)
                         * (REL_BUCKETS - max_exact)).astype(jnp.int32)
    large = jnp.minimum(large, REL_BUCKETS - 1)
    return jnp.where(n < max_exact, n, large)


def attention_block_biases(rel_bias, pos, valid):
    tab = rel_bias.astype(jnp.float32)
    out = []
    for i in range(pos.shape[0] // Q_BLOCK):
        k_end = (i + 1) * Q_BLOCK
        qp = pos[i * Q_BLOCK:k_end]
        kp = pos[:k_end]
        bias = jnp.transpose(tab[t5_causal_bucket(qp[:, None] - kp[None, :])], (2, 0, 1))
        allowed = (kp[None, :] <= qp[:, None]) & valid[None, :k_end]
        out.append(jnp.where(allowed[None], bias, NEG))
    return out


def hgrn2_mixer(q, f_pre, v, g, lb, norm_w, valid):
    B, L, _ = q.shape
    n_chunks = L // HG_CHUNK

    def to_chunks(t):
        return t.reshape(B, n_chunks, HG_CHUNK, HG_HEADS, -1).transpose(1, 0, 3, 2, 4)

    qf = jax.nn.silu(q.astype(jnp.float32))
    log_f = jnp.logaddexp(jnp.log(lb), jnp.log1p(-lb) + jax.nn.log_sigmoid(f_pre.astype(jnp.float32)))
    k = -jnp.expm1(log_f)
    vmask = valid[None, :, None]
    log_f = jnp.where(vmask, log_f, 0.0)
    k = jnp.where(vmask, k, 0.0)
    qc, kc, vc, lc = (to_chunks(t) for t in (qf, k, v.astype(jnp.float32), log_f))
    bc = jnp.cumsum(lc, axis=-2)
    causal = jnp.tril(jnp.ones((HG_CHUNK, HG_CHUNK), dtype=bool))

    def step(S, inp):
        qi, ki, vi, bi = inp
        inter = jnp.einsum('bhtk,bhkv->bhtv', qi * jnp.exp(bi), S)
        rel = bi[..., :, None, :] - bi[..., None, :, :]
        decay = jnp.exp(jnp.where(causal[:, :, None], rel, -jnp.inf))
        scores = jnp.einsum('bhtk,bhsk,bhtsk->bhts', qi, ki, decay)
        intra = jnp.einsum('bhts,bhsv->bhtv', scores, vi)
        b_end = bi[..., -1:, :]
        S_new = jnp.exp(b_end[..., 0, :])[..., None] * S + jnp.einsum(
            'bhsk,bhsv->bhkv', ki * jnp.exp(b_end - bi), vi)
        return S_new, inter + intra

    S0 = jnp.zeros((B, HG_HEADS, HG_DK, HG_DV), jnp.float32)
    _, o = lax.scan(step, S0, (qc, kc, vc, bc))
    o = o.transpose(1, 0, 3, 2, 4).reshape(B, L, HG_HEADS, HG_DV)
    o = rmsnorm(o, norm_w).reshape(B, L, HG_WIDTH) * jax.nn.silu(g.astype(jnp.float32))
    return o.astype(q.dtype)


def diff_attention(q, k, v, lam, lam_init, subln_w, block_biases):
    B, L, _ = q.shape
    q = (q.reshape(B, L, DA_HEADS, 2, DA_DQK) * (DA_DQK ** -0.5)).transpose(0, 2, 3, 1, 4)
    k = k.reshape(B, L, DA_HEADS, 2, DA_DQK).transpose(0, 2, 3, 1, 4)
    vf = v.reshape(B, L, DA_HEADS, DA_DV).transpose(0, 2, 1, 3).astype(jnp.float32)
    outs = []
    for i, bias in enumerate(block_biases):
        k_end = (i + 1) * Q_BLOCK
        s = jnp.einsum('bhcqd,bhckd->bhcqk', q[:, :, :, i * Q_BLOCK:k_end], k[:, :, :, :k_end]).astype(jnp.float32)
        p = jax.nn.softmax(s + bias[None, :, None], axis=-1)
        a = p[:, :, 0] - lam * p[:, :, 1]
        outs.append(jnp.einsum('bhqk,bhkv->bhqv', a, vf[:, :, :k_end]))
    o = jnp.concatenate(outs, axis=2)
    o = rmsnorm(o, subln_w) * (1.0 - lam_init)
    return o.transpose(0, 2, 1, 3).reshape(B, L, DA_HEADS * DA_DV).astype(v.dtype)


def swiglu(h, w1, w3, w2):
    return (jax.nn.silu(h @ w1) * (h @ w3)) @ w2


def moe_swiglu(h, router, w1, w3, w2):
    N, D = h.shape
    logits = (h @ router).astype(jnp.float32)
    top_logit, top_idx = lax.top_k(logits, TOP_K)
    gate = jax.nn.softmax(top_logit, axis=-1)
    M = N * TOP_K
    flat_e = top_idx.reshape(M)
    flat_tok = jnp.repeat(jnp.arange(N, dtype=jnp.int32), TOP_K)
    flat_gate = gate.reshape(M)
    order = jnp.argsort(flat_e)
    e_sorted = flat_e[order]
    counts = jnp.bincount(flat_e, length=N_EXPERTS)
    padded = (counts + MOE_BLOCK - 1) // MOE_BLOCK * MOE_BLOCK
    pad_end = jnp.cumsum(padded)
    pad_start = pad_end - padded
    start = jnp.cumsum(counts) - counts
    dest = pad_start[e_sorted] + jnp.arange(M, dtype=jnp.int32) - start[e_sorted]
    n_blocks = -(-M // MOE_BLOCK) + N_EXPERTS
    P = n_blocks * MOE_BLOCK
    slot_tok = jnp.full((P,), N, jnp.int32).at[dest].set(flat_tok[order])
    slot_gate = jnp.zeros((P,), jnp.float32).at[dest].set(flat_gate[order])
    block_expert = jnp.minimum(
        jnp.searchsorted(pad_end, jnp.arange(n_blocks, dtype=jnp.int32) * MOE_BLOCK, side='right'),
        N_EXPERTS - 1)
    h_ext = jnp.concatenate([h, jnp.zeros((1, D), h.dtype)], axis=0)
    xb = h_ext[slot_tok].reshape(n_blocks, MOE_BLOCK, D)

    def expert_block(args):
        xblk, e = args
        return swiglu(xblk, w1[e], w3[e], w2[e])

    yb = lax.map(expert_block, (xb, block_expert)).reshape(P, D)
    y = yb.astype(jnp.float32) * slot_gate[:, None]
    out = jnp.zeros((N + 1, D), jnp.float32).at[slot_tok].add(y)[:N]
    return out.astype(h.dtype)


def setup_inputs(seed: int = 0) -> dict:
    key = jax.random.key(seed)
    ks = jax.random.split(key, 20)
    f32 = jnp.float32
    nrm = lambda k, shape, scale: jax.random.normal(k, shape, f32) * scale
    gain = lambda k, shape: 1.0 + 0.02 * jax.random.normal(k, shape, f32)
    return {
        'x': nrm(ks[0], (BATCH, SEQ, D_MODEL), 1.0),
        'meta': nrm(ks[1], (N_META, D_MODEL), 1.0),
        'rel_bias': nrm(ks[2], (REL_BUCKETS, DA_HEADS), 0.5),
        'norm_mix': gain(ks[3], (DEPTH, D_MODEL)),
        'w_in': nrm(ks[4], (DEPTH, D_MODEL, W_IN_COLS), D_MODEL ** -0.5),
        'hg_lb_logits': nrm(ks[5], (DEPTH, HG_WIDTH), 0.5),
        'hg_norm_w': gain(ks[6], (DEPTH, HG_DV)),
        'da_lambda': nrm(ks[7], (DEPTH, 4, DA_DQK), 0.1),
        'da_subln_w': gain(ks[8], (DEPTH, DA_DV)),
        'w_out': nrm(ks[9], (DEPTH, MIX_WIDTH, D_MODEL), MIX_WIDTH ** -0.5),
        'norm_ffn': gain(ks[10], (DEPTH, D_MODEL)),
        'dense_w1': nrm(ks[11], (N_DENSE, D_MODEL, D_FF_DENSE), D_MODEL ** -0.5),
        'dense_w3': nrm(ks[12], (N_DENSE, D_MODEL, D_FF_DENSE), D_MODEL ** -0.5),
        'dense_w2': nrm(ks[13], (N_DENSE, D_FF_DENSE, D_MODEL), D_FF_DENSE ** -0.5),
        'moe_router': nrm(ks[14], (N_MOE, D_MODEL, N_EXPERTS), D_MODEL ** -0.5),
        'moe_w1': nrm(ks[15], (N_MOE, N_EXPERTS, D_MODEL, D_FF_EXPERT), D_MODEL ** -0.5),
        'moe_w3': nrm(ks[16], (N_MOE, N_EXPERTS, D_MODEL, D_FF_EXPERT), D_MODEL ** -0.5),
        'moe_w2': nrm(ks[17], (N_MOE, N_EXPERTS, D_FF_EXPERT, D_MODEL), D_FF_EXPERT ** -0.5),
        'final_norm': gain(ks[18], (D_MODEL,)),
    }


def reference(x, meta, rel_bias, norm_mix, w_in, hg_lb_logits, hg_norm_w, da_lambda, da_subln_w,
              w_out, norm_ffn, dense_w1, dense_w3, dense_w2, moe_router, moe_w1, moe_w3, moe_w2,
              final_norm):
    B, S, D = x.shape
    L = LEAD + S
    h0 = jnp.concatenate([
        jnp.zeros((B, LEAD - N_META, D), x.dtype),
        jnp.broadcast_to(meta[None].astype(x.dtype), (B, N_META, D)),
        x], axis=1)
    pos = jnp.arange(L, dtype=jnp.int32) - (LEAD - N_META)
    valid = pos >= 0
    block_biases = attention_block_biases(rel_bias, pos, valid)

    lb_cum = jnp.cumsum(jax.nn.softmax(hg_lb_logits.astype(jnp.float32), axis=0), axis=0)
    lb_all = jnp.clip(lb_cum - lb_cum[0:1], 0.0, LB_MAX)

    c = np.cumsum([0, HG_WIDTH, HG_WIDTH, HG_WIDTH, HG_WIDTH,
                   DA_HEADS * 2 * DA_DQK, DA_HEADS * 2 * DA_DQK, DA_HEADS * DA_DV]).tolist()
    h = h0
    for l in range(DEPTH):
        u = rmsnorm(h, norm_mix[l])
        proj = u @ w_in[l]
        hq, hf, hv, hg, dq, dk, dv = (proj[..., c[j]:c[j + 1]] for j in range(7))
        o_hg = hgrn2_mixer(hq, hf, hv, hg, lb_all[l], hg_norm_w[l], valid)
        lam_init = 0.8 - 0.6 * math.exp(-0.3 * l)
        lv = da_lambda[l].astype(jnp.float32)
        lam = jnp.exp(jnp.sum(lv[0] * lv[1])) - jnp.exp(jnp.sum(lv[2] * lv[3])) + lam_init
        o_da = diff_attention(dq, dk, dv, lam, lam_init, da_subln_w[l], block_biases)
        h = h + (jnp.concatenate([o_hg, o_da], axis=-1) @ w_out[l]).astype(h.dtype)
        u = rmsnorm(h, norm_ffn[l])
        if l % 2 == 0:
            i = l // 2
            ff = swiglu(u, dense_w1[i], dense_w3[i], dense_w2[i])
        else:
            i = l // 2
            ff = moe_swiglu(u.reshape(B * L, D), moe_router[i], moe_w1[i], moe_w3[i], moe_w2[i]).reshape(B, L, D)
        h = h + ff.astype(h.dtype)
    out = rmsnorm(h, final_norm)
    return out[:, LEAD:]
```

```cpp
#include <hip/hip_runtime.h>
#include <cstdio>
#include <cstdint>

#ifndef MK_ONE_LAUNCH
#define MK_ONE_LAUNCH 0
#endif

namespace pg8 {
#define PG8_LAS __attribute__((address_space(3)))
typedef unsigned short bf16_t;
typedef short bf16x8 __attribute__((ext_vector_type(8)));
typedef float f32x4 __attribute__((ext_vector_type(4)));
typedef unsigned u32x4 __attribute__((ext_vector_type(4)));
typedef unsigned u32x2 __attribute__((ext_vector_type(2)));
constexpr int BM = 256, BK = 64, HALF = 128, HTB = HALF * BK * 2  , STAGE_BYTES = 8 * HTB, NXCD = 8, WGM = 8;

__host__ __device__ __forceinline__ int lds_byte(int r, int c) { const int st = (r >> 4) * 2 + (c >> 5), rr = r & 15, cc = c & 31, ob = rr * 64 + cc * 2; return st * 1024 + (ob ^ (((ob >> 9) & 1) << 5)); }
__host__ __device__ __forceinline__ void stage_rc(int b, int& R, int& C) { const int st = b / 1024, sb = b % 1024, swz = sb ^ (((sb >> 9) & 1) << 5); R = (st >> 1) * 16 + swz / 64; C = (st & 1) * 32 + (swz % 64) / 2; }
__host__ __device__ __forceinline__ int perm32(int rho) { const int n = rho >> 4, i = rho & 15; return 8 * (i >> 2) + 4 * n + (i & 3); }

struct Unit { int pm, pn, e; };
struct Gemm { const bf16_t* A; const bf16_t* Bt; int M, N, K; size_t bstride; };

struct StaticOrder {
    int nM, nN, nwg, G, c;
    __host__ __device__ void init(int M, int N, int G_, int c_) { nM = M / BM; nN = N / BM; nwg = nM * nN; G = G_; c = c_; }
    __host__ __device__ bool next(int i, Unit& u) const {
        const long L = (long)i * G + c; if (L >= nwg) return false;
        int wgid = (int)L; { const int q = nwg / NXCD, r = nwg % NXCD, xcd = wgid % NXCD, off = wgid / NXCD; wgid = (xcd < r ? xcd * (q + 1) : r * (q + 1) + (xcd - r) * q) + off; }
        const int nig = WGM * nN, gid = wgid / nig, fm = gid * WGM, gsz = (nM - fm) < WGM ? (nM - fm) : WGM;
        u.pm = fm + ((wgid % nig) % gsz); u.pn = (wgid % nig) / gsz; u.e = 0; return true;
    }
    __device__ __forceinline__ void a_ready(const Unit&) const {}
    __device__ __forceinline__ void done(const Unit&) const {}
};
struct GroupedOrder {
    int p0, p1, p2, p3, p4, p5, p6, p7, p8, nN, G, c;
    __device__ __forceinline__ bool next(int i, Unit& u) const {
        const int L = i * G + c; if (L >= p8 * nN) return false;
        int e = 0, ps = 0, pe = p1;
        if (L >= p1 * nN) { e = 1; ps = p1; pe = p2; }
        if (L >= p2 * nN) { e = 2; ps = p2; pe = p3; }
        if (L >= p3 * nN) { e = 3; ps = p3; pe = p4; }
        if (L >= p4 * nN) { e = 4; ps = p4; pe = p5; }
        if (L >= p5 * nN) { e = 5; ps = p5; pe = p6; }
        if (L >= p6 * nN) { e = 6; ps = p6; pe = p7; }
        if (L >= p7 * nN) { e = 7; ps = p7; pe = p8; }
        const int rem = L - ps * nN, R = pe - ps;
        u.e = e; u.pn = rem / R; u.pm = ps + rem % R; return true;
    }
    __device__ __forceinline__ void a_ready(const Unit&) const {}
    __device__ __forceinline__ void done(const Unit&) const {}
};

__device__ __forceinline__ unsigned cvt_pk_bf16(float lo, float hi) { unsigned r; asm volatile("v_cvt_pk_bf16_f32 %0, %1, %2" : "=v"(r) : "v"(lo), "v"(hi)); return r; }

template <class Epi, class Sched, bool ALIGN_EPI = false, bool SP2 = false>
__device__ __forceinline__ void gemm_phase(PG8_LAS unsigned char* lds, const Gemm g, const Sched& S, const Epi& E) {
    int tid_l = threadIdx.x; asm volatile("" : "+v"(tid_l));
    const int tid = tid_l, wid = __builtin_amdgcn_readfirstlane(tid >> 6), lane = tid & 63, wr = wid >> 2, wc = wid & 3, fr = lane & 15, fq = lane >> 4;
    const int K = g.K, nt = K / BK;
    unsigned voffA[2], voffB[2];
#pragma unroll
    for (int i = 0; i < 2; ++i) { int R, C; stage_rc(tid * 16 + i * 8192, R, C); const int Rb = Epi::PERM ? ((R & ~31) + perm32(R & 31)) : R;
        voffA[i] = (unsigned)(R * K + C) * 2u; voffB[i] = (unsigned)(Rb * K + C) * 2u; }
    const size_t kstep = (size_t)(BK * 2);
    const size_t hstep = (size_t)HALF * K * 2;
    const size_t tstep = 2 * hstep;
    const unsigned ldsw = (unsigned)wid * 1024u;
    const int aoff = lds_byte(wr * 64 + fr, fq * 8), boff = lds_byte(wc * 32 + fr, fq * 8);
#define PG8_SA(b, h) (((b) * 2 + (h)) * HTB)
#define PG8_SB(b, h) ((4 + (b) * 2 + (h)) * HTB)
#define PG8_STAGE(bufoff, gbase, voff) do { _Pragma("unroll") for (int _i = 0; _i < 2; ++_i) \
        __builtin_amdgcn_global_load_lds((const unsigned*)((const char*)(gbase) + (voff)[_i]), (PG8_LAS unsigned*)(lds + (bufoff) + ldsw + _i * 8192), 16, 0, 0); } while (0)
#define PG8_LDA(dst, b, h) do { _Pragma("unroll") for (int m = 0; m < 4; ++m) _Pragma("unroll") for (int k = 0; k < 2; ++k) dst[m][k] = *(const PG8_LAS bf16x8*)(lds + PG8_SA(b, h) + aoff + m * 2048 + k * 1024); } while (0)
#define PG8_LDB(dst, b, h) do { _Pragma("unroll") for (int n = 0; n < 2; ++n) _Pragma("unroll") for (int k = 0; k < 2; ++k) dst[n][k] = *(const PG8_LAS bf16x8*)(lds + PG8_SB(b, h) + boff + n * 2048 + k * 1024); } while (0)
#define PG8_MMA(ai, bj, At, Bt) do { __builtin_amdgcn_s_setprio(1); _Pragma("unroll") for (int m = 0; m < 4; ++m) _Pragma("unroll") for (int n = 0; n < 2; ++n) _Pragma("unroll") for (int k = 0; k < 2; ++k) \
        acc[ai][bj][m][n] = __builtin_amdgcn_mfma_f32_16x16x32_bf16(Bt[n][k], At[m][k], acc[ai][bj][m][n], 0, 0, 0); __builtin_amdgcn_s_setprio(0); } while (0)
#define PG8_WAIT_V(n) asm volatile("s_waitcnt vmcnt(" #n ")" ::: "memory")
#define PG8_WAIT_L(n) asm volatile("s_waitcnt lgkmcnt(" #n ")" ::: "memory")
#define PG8_BAR __builtin_amdgcn_s_barrier()
#define PG8_SCHED __builtin_amdgcn_sched_barrier(0)
    Unit cur, nxt; int ui = 0;
    if (!S.next(0, cur)) return;
    f32x4 acc[2][2][4][2];
#pragma unroll
    for (int a = 0; a < 2; ++a)
#pragma unroll
        for (int b = 0; b < 2; ++b)
#pragma unroll
            for (int m = 0; m < 4; ++m)
#pragma unroll
                for (int n = 0; n < 2; ++n) acc[a][b][m][n] = (f32x4){0.f, 0.f, 0.f, 0.f};
    bf16x8 At[4][2], B0[2][2], B1[2][2];
    const char* cA = (const char*)g.A + (size_t)cur.pm * tstep; const char* cB = (const char*)g.Bt + (size_t)cur.e * g.bstride + (size_t)cur.pn * tstep;
    S.a_ready(cur);
    if constexpr (SP2) {
        PG8_STAGE(PG8_SB(0, 0), cB, voffB); PG8_STAGE(PG8_SB(0, 1), cB + hstep, voffB); PG8_STAGE(PG8_SA(0, 0), cA, voffA); PG8_STAGE(PG8_SA(0, 1), cA + hstep, voffA);
        if (wr == 1) PG8_BAR;
        PG8_WAIT_V(2); PG8_BAR;
        PG8_STAGE(PG8_SB(1, 0), cB + kstep, voffB); PG8_STAGE(PG8_SA(1, 0), cA + kstep, voffA); PG8_STAGE(PG8_SB(1, 1), cB + hstep + kstep, voffB);
        PG8_WAIT_V(6); PG8_BAR;
    } else {
        PG8_STAGE(PG8_SB(0, 0), cB, voffB); PG8_STAGE(PG8_SA(0, 0), cA, voffA); PG8_STAGE(PG8_SB(0, 1), cB + hstep, voffB); PG8_STAGE(PG8_SA(0, 1), cA + hstep, voffA);
        if (wr == 1) PG8_BAR;
        PG8_WAIT_V(4); PG8_BAR;
        PG8_STAGE(PG8_SB(1, 0), cB + kstep, voffB); PG8_STAGE(PG8_SA(1, 0), cA + kstep, voffA); PG8_STAGE(PG8_SB(1, 1), cB + hstep + kstep, voffB);
        PG8_WAIT_V(6); PG8_BAR;
    }
    for (;;) {
        const bool has_next = S.next(ui + 1, nxt);
        const char* nA = has_next ? (const char*)g.A + (size_t)nxt.pm * tstep : cA; const char* nB = has_next ? (const char*)g.Bt + (size_t)nxt.e * g.bstride + (size_t)nxt.pn * tstep : cB;
        for (int t = 0; t < nt; t += 2) {
            const bool last = (t == nt - 2);
            const char* a1 = cA + (size_t)(t + 1) * kstep;
            const char* a2 = last ? nA : cA + (size_t)(t + 2) * kstep; const char* b2 = last ? nB : cB + (size_t)(t + 2) * kstep;
            const char* a3 = a2 + kstep; const char* b3 = b2 + kstep;
            if (last && has_next) S.a_ready(nxt);
            if constexpr (SP2) {
            PG8_LDB(B0, 0, 0); PG8_LDB(B1, 0, 1); PG8_SCHED; PG8_LDA(At, 0, 0); PG8_STAGE(PG8_SA(1, 1), a1 + hstep, voffA);
            PG8_WAIT_V(8); PG8_WAIT_L(0); PG8_BAR; PG8_MMA(0, 0, At, B0); PG8_MMA(0, 1, At, B1); PG8_BAR; PG8_SCHED;
            PG8_LDA(At, 0, 1); PG8_STAGE(PG8_SB(0, 0), b2, voffB); PG8_STAGE(PG8_SB(0, 1), b2 + hstep, voffB); PG8_STAGE(PG8_SA(0, 0), a2, voffA);
            PG8_WAIT_V(8); PG8_WAIT_L(0); PG8_BAR; PG8_MMA(1, 0, At, B0); PG8_MMA(1, 1, At, B1); PG8_BAR; PG8_SCHED;
            PG8_LDB(B0, 1, 0); PG8_LDB(B1, 1, 1); PG8_SCHED; PG8_LDA(At, 1, 0); PG8_STAGE(PG8_SA(0, 1), a2 + hstep, voffA);
            PG8_WAIT_V(8); PG8_WAIT_L(0); PG8_BAR; PG8_MMA(0, 0, At, B0); PG8_MMA(0, 1, At, B1); PG8_BAR; PG8_SCHED;
            PG8_LDA(At, 1, 1); PG8_STAGE(PG8_SB(1, 0), b3, voffB); PG8_STAGE(PG8_SB(1, 1), b3 + hstep, voffB); PG8_STAGE(PG8_SA(1, 0), a3, voffA);
            PG8_WAIT_V(8); PG8_WAIT_L(0); PG8_BAR; PG8_MMA(1, 0, At, B0); PG8_MMA(1, 1, At, B1); PG8_BAR; PG8_SCHED;
            } else {
            PG8_LDB(B0, 0, 0); PG8_SCHED; PG8_LDA(At, 0, 0); PG8_STAGE(PG8_SA(1, 1), a1 + hstep, voffA);
            PG8_WAIT_L(8); PG8_BAR; PG8_WAIT_L(0); PG8_MMA(0, 0, At, B0); PG8_BAR; PG8_SCHED;
            PG8_LDB(B1, 0, 1); PG8_STAGE(PG8_SB(0, 0), b2, voffB);
            PG8_BAR; PG8_WAIT_L(0); PG8_MMA(0, 1, At, B1); PG8_BAR;
            PG8_LDA(At, 0, 1); PG8_STAGE(PG8_SA(0, 0), a2, voffA);
            PG8_BAR; PG8_WAIT_L(0); PG8_MMA(1, 0, At, B0); PG8_BAR; PG8_SCHED;
            PG8_STAGE(PG8_SB(0, 1), b2 + hstep, voffB);
            PG8_WAIT_V(6); PG8_BAR; PG8_MMA(1, 1, At, B1); PG8_BAR;
            PG8_LDB(B0, 1, 0); PG8_SCHED; PG8_LDA(At, 1, 0); PG8_STAGE(PG8_SA(0, 1), a2 + hstep, voffA);
            PG8_WAIT_L(8); PG8_BAR; PG8_WAIT_L(0); PG8_MMA(0, 0, At, B0); PG8_BAR; PG8_SCHED;
            PG8_LDB(B1, 1, 1); PG8_STAGE(PG8_SB(1, 0), b3, voffB);
            PG8_BAR; PG8_WAIT_L(0); PG8_MMA(0, 1, At, B1); PG8_BAR;
            PG8_LDA(At, 1, 1); PG8_STAGE(PG8_SA(1, 0), a3, voffA);
            PG8_BAR; PG8_WAIT_L(0); PG8_MMA(1, 0, At, B0); PG8_BAR; PG8_SCHED;
            PG8_STAGE(PG8_SB(1, 1), b3 + hstep, voffB);
            PG8_WAIT_V(6); PG8_BAR; PG8_MMA(1, 1, At, B1); PG8_BAR;
            }
        }
        if constexpr (ALIGN_EPI) { if (wr == 0) PG8_BAR; }
        if constexpr (!Epi::AFTER_DRAIN) { E(acc, cur, wr, wc, fr, fq); S.done(cur); }
        if (!has_next) break;
#pragma unroll
        for (int a = 0; a < 2; ++a)
#pragma unroll
            for (int b = 0; b < 2; ++b)
#pragma unroll
                for (int m = 0; m < 4; ++m)
#pragma unroll
                    for (int n = 0; n < 2; ++n) acc[a][b][m][n] = (f32x4){0.f, 0.f, 0.f, 0.f};
        cur = nxt; cA = nA; cB = nB; ++ui;
        if constexpr (ALIGN_EPI) { if (wr == 1) PG8_BAR; }
    }
    PG8_WAIT_V(0);
    if constexpr (!ALIGN_EPI) { if (wr == 0) PG8_BAR; }
    PG8_BAR;
    if constexpr (Epi::AFTER_DRAIN) { E.fused(acc, cur, wr, wc, fr, fq, lds, wid, lane); S.done(cur); }
#undef PG8_SA
#undef PG8_SB
#undef PG8_STAGE
#undef PG8_LDA
#undef PG8_LDB
#undef PG8_MMA
#undef PG8_WAIT_V
#undef PG8_WAIT_L
#undef PG8_BAR
#undef PG8_SCHED
}

}

constexpr int D = 1024, NB = 8, SEQ = 2048, DEPTH = 4, LEAD = 128, FIRSTV = 112, LT = LEAD + SEQ, NTOK = NB * LT;
constexpr int WIN = 3584, FFD = 2816, FFE = 3584, NE = 8, MAXSLOT = 36864;
constexpr float EPS = 1e-6f;
constexpr int NPHASE = 1 + 8 * DEPTH;

constexpr size_t MiB = 1u << 20;
constexpr size_t WS_CTL = 0, CTL_ZERO_BYTES = MiB;
constexpr size_t WS_TAB = 1 * MiB;
constexpr size_t WS_WIN = 2 * MiB;
constexpr size_t WS_WOUT = WS_WIN + 28 * MiB;
constexpr size_t WS_WD13 = WS_WOUT + 8 * MiB;
constexpr size_t WS_WD2 = WS_WD13 + 22 * MiB;
constexpr size_t WS_WM13 = WS_WD2 + 11 * MiB;
constexpr size_t WS_WM2 = WS_WM13 + 224 * MiB;
constexpr size_t WS_H = WS_WM2 + 112 * MiB;
constexpr size_t WS_HB = WS_H + 68 * MiB;
constexpr size_t WS_SSQ = WS_HB + 34 * MiB;
constexpr size_t WS_ROUTE = WS_SSQ + 2 * MiB;
constexpr size_t WS_ACT = WS_ROUTE + 2 * MiB;
constexpr size_t WS_XG = WS_ACT + 252 * MiB;
constexpr size_t WS_END = WS_XG + 72 * MiB;
constexpr size_t ACT_PROJ = 0, ACT_LOGF = 119 * MiB, ACT_MIX = 153 * MiB;
constexpr size_t TAB_LB = 0, TAB_BIAS = 8192, TAB_LAM = 12288, TAB_SUBLN = 12544, TAB_HGNW = 14592, TAB_RF = 20480, TAB_FNORM = 20480 + 65536;
constexpr size_t ROUTE_INFO = 0, ROUTE_LIST = 640 * 1024, ROUTE_RSTD = 1280 * 1024;
constexpr int CW_TMO = 0, CW_BAR = 4096, CW_CNT = 8192;

constexpr int RING_BYTES = 131072, MISC_OFF = RING_BYTES + 320, LDS_BYTES = 147456;

#define GAS __attribute__((address_space(1)))
#define LAS __attribute__((address_space(3)))
typedef unsigned short bf16;
typedef unsigned v4u __attribute__((ext_vector_type(4)));
typedef unsigned v2u __attribute__((ext_vector_type(2)));
typedef float f32x4 __attribute__((ext_vector_type(4)));
typedef GAS unsigned gu32;
#define RLX_AGENT __ATOMIC_RELAXED, __HIP_MEMORY_SCOPE_AGENT
#define LDS_WAIT() asm volatile("s_waitcnt lgkmcnt(0)" ::: "memory")
__device__ __forceinline__ unsigned f2bf(float f) { unsigned u = __builtin_bit_cast(unsigned, f); return (u + 0x7fffu + ((u >> 16) & 1u)) >> 16; }
__device__ __forceinline__ unsigned pk2(float lo, float hi) { return f2bf(lo) | (f2bf(hi) << 16); }
__device__ __forceinline__ float bf_lo(unsigned w) { return __builtin_bit_cast(float, w << 16); }
__device__ __forceinline__ float bf_hi(unsigned w) { return __builtin_bit_cast(float, w & 0xffff0000u); }
__device__ __forceinline__ float silu_f(float x) { return x / (1.f + __expf(-x)); }
__device__ __forceinline__ float wave_sum(float v) {
#pragma unroll
    for (int o = 1; o < 64; o <<= 1) v += __shfl_xor(v, o);
    return v;
}

#define XB_TMO      128
#define XB_XCNT(j)  (256  + 64 * (j))
#define XB_XSUB(j)  (1280 + 64 * (j))
#define XB_XGEN(j)  (2304 + 64 * (j))
#define XB_TOP      3328
#define XB_TOPGEN   3392
#define XCD_BAR_WORDS 3456
#define XB_SPIN_CAP (1u << 18)

__device__ __forceinline__ unsigned xb_ld(unsigned* p)              { return __hip_atomic_load(p, __ATOMIC_RELAXED, __HIP_MEMORY_SCOPE_AGENT); }
__device__ __forceinline__ unsigned xb_add(unsigned* p, unsigned v) { return __hip_atomic_fetch_add(p, v, __ATOMIC_RELAXED, __HIP_MEMORY_SCOPE_AGENT); }
__device__ __forceinline__ unsigned xb_xcc_id() { return (unsigned)__builtin_amdgcn_s_getreg((3 << 11) | 20) & 0xFu; }
#define XB_SPIN(cond, bar) do { unsigned _sp = 0; while (cond) { __builtin_amdgcn_s_sleep(1); \
    if ((++_sp & 255u) == 0u) { if (xb_ld(&(bar)[XB_TMO])) break; if (_sp > XB_SPIN_CAP) { atomicAdd(&(bar)[XB_TMO], 1u); break; } } } } while (0)

struct XcdBarrier {
    unsigned* bar; unsigned x;
    volatile LAS unsigned* st;
};

__device__ __forceinline__ XcdBarrier xcd_barrier_post(unsigned* bar, volatile LAS unsigned* st) {
    XcdBarrier b; b.bar = bar; b.x = xb_xcc_id(); b.st = st;
    if (threadIdx.x == 0) (void)xb_add(&bar[XB_XCNT(b.x)], 1u);
    return b;
}
__device__ __forceinline__ void xcd_barrier_complete(unsigned* bar, unsigned x, unsigned& nloc, unsigned& nx) {
    const unsigned G = gridDim.x * gridDim.y * gridDim.z;
    unsigned sum, cnt, mine, sp = 0u;
    for (;;) {
        sum = 0u; cnt = 0u; mine = 0u;
#pragma unroll
        for (unsigned j = 0; j < 16; ++j) { const unsigned c = xb_ld(&bar[XB_XCNT(j)]); sum += c; cnt += (c > 0u) ? 1u : 0u; mine = (j == x) ? c : mine; }
        if (sum == G) break;
        __builtin_amdgcn_s_sleep(1);
        if ((++sp & 255u) == 0u) { if (xb_ld(&bar[XB_TMO])) break; if (sp > XB_SPIN_CAP) { atomicAdd(&bar[XB_TMO], 1u); break; } }
    }
    nloc = mine > 0u ? mine : 1u; nx = cnt > 0u ? cnt : 1u;
}

__device__ __forceinline__ void xcd_barrier(const XcdBarrier& b) {
    asm volatile("s_waitcnt vmcnt(0)" ::: "memory");
    __syncthreads();
    if (threadIdx.x == 0) {
        unsigned* bar = b.bar;
        __builtin_amdgcn_s_waitcnt(0);
        unsigned nloc = b.st[0], nx = b.st[1];
        if (nloc == 0u) { xcd_barrier_complete(bar, b.x, nloc, nx); b.st[0] = nloc; b.st[1] = nx; }
        const unsigned old = xb_add(&bar[XB_XSUB(b.x)], 1u);
        const unsigned gen = old / nloc;
        if (old + 1u == (gen + 1u) * nloc) {
            __builtin_amdgcn_fence(__ATOMIC_RELEASE, "agent");
            asm volatile("s_waitcnt vmcnt(0)" ::: "memory");
            const unsigned og = xb_add(&bar[XB_TOP], 1u);
            const unsigned tg = og / nx;
            if (og + 1u == (tg + 1u) * nx) xb_add(&bar[XB_TOPGEN], 1u);
            else XB_SPIN(xb_ld(&bar[XB_TOPGEN]) == tg, bar);
            __builtin_amdgcn_fence(__ATOMIC_ACQUIRE, "agent");
            xb_add(&bar[XB_XGEN(b.x)], 1u);
            asm volatile("s_waitcnt vmcnt(0)" ::: "memory");
        } else {
            XB_SPIN(xb_ld(&bar[XB_XGEN(b.x)]) == gen, bar);
            __builtin_amdgcn_fence(__ATOMIC_ACQUIRE, "agent");
            asm volatile("s_waitcnt vmcnt(0)" ::: "memory");
        }
    }
    __syncthreads();
}


static __device__ const unsigned char T5B[129] = {0, 1, 2, 3, 4, 5, 6, 7, 8, 9, 10, 11, 12, 13, 14, 15, 16, 16, 16, 17, 17, 18, 18, 18, 19, 19, 19, 20, 20, 20, 20, 21, 21, 21, 21, 22, 22, 22, 22, 22, 23, 23, 23, 23, 23, 23, 24, 24, 24, 24, 24, 24, 25, 25, 25, 25, 25, 25, 25, 26, 26, 26, 26, 26, 26, 26, 26, 27, 27, 27, 27, 27, 27, 27, 27, 27, 27, 28, 28, 28, 28, 28, 28, 28, 28, 28, 28, 29, 29, 29, 29, 29, 29, 29, 29, 29, 29, 29, 29, 30, 30, 30, 30, 30, 30, 30, 30, 30, 30, 30, 30, 30, 30, 31, 31, 31, 31, 31, 31, 31, 31, 31, 31, 31, 31, 31, 31, 31, 31};

struct Ctx {
    LAS unsigned char* lds;
    int tid, lane, wave, G;
    float* out;
    unsigned char* ws;
    __device__ __forceinline__ gu32* ctl() const { return (gu32*)(ws + WS_CTL); }
    __device__ __forceinline__ float* H() const { return (float*)(ws + WS_H); }
    __device__ __forceinline__ bf16* HB() const { return (bf16*)(ws + WS_HB); }
    __device__ __forceinline__ float* SSQ() const { return (float*)(ws + WS_SSQ); }
    __device__ __forceinline__ bf16* PROJ() const { return (bf16*)(ws + WS_ACT + ACT_PROJ); }
    __device__ __forceinline__ float* LOGF() const { return (float*)(ws + WS_ACT + ACT_LOGF); }
    __device__ __forceinline__ bf16* MIX() const { return (bf16*)(ws + WS_ACT + ACT_MIX); }
    __device__ __forceinline__ bf16* T() const { return (bf16*)(ws + WS_ACT); }
    __device__ __forceinline__ bf16* XG() const { return (bf16*)(ws + WS_XG); }
    __device__ __forceinline__ bf16* Y() const { return (bf16*)(ws + WS_XG); }
    __device__ __forceinline__ float* LB() const { return (float*)(ws + WS_TAB + TAB_LB); }
    __device__ __forceinline__ float* BIAST() const { return (float*)(ws + WS_TAB + TAB_BIAS); }
    __device__ __forceinline__ float* LAM() const { return (float*)(ws + WS_TAB + TAB_LAM); }
    __device__ __forceinline__ float* RF() const { return (float*)(ws + WS_TAB + TAB_RF); }
    __device__ __forceinline__ float* SUBLN() const { return (float*)(ws + WS_TAB + TAB_SUBLN); }
    __device__ __forceinline__ float* HGNW() const { return (float*)(ws + WS_TAB + TAB_HGNW); }
    __device__ __forceinline__ float* FNORM() const { return (float*)(ws + WS_TAB + TAB_FNORM); }
    __device__ __forceinline__ unsigned* TINFO() const { return (unsigned*)(ws + WS_ROUTE + ROUTE_INFO); }
    __device__ __forceinline__ int* LIST() const { return (int*)(ws + WS_ROUTE + ROUTE_LIST); }
    __device__ __forceinline__ float* RSTD() const { return (float*)(ws + WS_ROUTE + ROUTE_RSTD); }
};
struct Args { const float* in[19]; float* out; unsigned char* ws; int ph_lo, ph_hi; };
enum { IN_X = 0, IN_META, IN_RELB, IN_NMIX, IN_WIN, IN_LBL, IN_HGNW, IN_LAMBDA, IN_SUBLN, IN_WOUT, IN_NFFN, IN_DW1, IN_DW3, IN_DW2, IN_ROUTER, IN_MW1, IN_MW3, IN_MW2, IN_FNORM };

__device__ __forceinline__ float row_rstd(const float* ssq, int row) {
    const f32x4* p = (const f32x4*)(ssq + (size_t)row * 16);
    const f32x4 a = p[0], b = p[1], c = p[2], d = p[3];
    const float s = ((a[0] + a[1]) + (a[2] + a[3])) + ((b[0] + b[1]) + (b[2] + b[3])) + ((c[0] + c[1]) + (c[2] + c[3])) + ((d[0] + d[1]) + (d[2] + d[3]));
    return rsqrtf(s * (1.0f / 1024.0f) + EPS);
}
struct EpiProj {
    static constexpr bool PERM = true, AFTER_DRAIN = false;
    bf16* proj; float* logfp; const float* ssq; const float* lb;
    __device__ __forceinline__ void operator()(const pg8::f32x4 (&acc)[2][2][4][2], const pg8::Unit& u, int wr, int wc, int fr, int fq) const {
        const int grp = u.pn >> 1;
        const int row0 = u.pm * 256 + wr * 64 + fr, colb = u.pn * 256 + wc * 32 + 8 * fq;
#pragma unroll
        for (int ai = 0; ai < 2; ++ai)
#pragma unroll
            for (int m = 0; m < 4; ++m) {
                const int row = row0 + ai * 128 + m * 16;
                const float r = row_rstd(ssq, row);
                const bool valid = (row % LT) >= FIRSTV;
#pragma unroll
                for (int bj = 0; bj < 2; ++bj) {
                    const int c0 = colb + bj * 128;
                    float x[8];
#pragma unroll
                    for (int j = 0; j < 4; ++j) { x[j] = acc[ai][bj][m][0][j] * r; x[4 + j] = acc[ai][bj][m][1][j] * r; }
                    if (grp == 0 || grp == 3) {
#pragma unroll
                        for (int j = 0; j < 8; ++j) x[j] = silu_f(x[j]);
                    } else if (grp == 4) {
#pragma unroll
                        for (int j = 0; j < 8; ++j) x[j] *= 0.125f;
                    } else if (grp == 1) {
                        const int cc = c0 - 512;
                        const f32x4 l0 = *(const f32x4*)(lb + cc), l1 = *(const f32x4*)(lb + cc + 4);
                        float lf[8];
#pragma unroll
                        for (int j = 0; j < 8; ++j) {
                            const float lbv = j < 4 ? l0[j & 3] : l1[j & 3];
                            const float xx = x[j];
                            const float ls = fminf(xx, 0.f) - log1pf(expf(-fabsf(xx)));
                            const float sg = expf(ls);
                            float lgf = (lbv > 0.f) ? logf(lbv + (1.f - lbv) * sg) : ls;
                            float kk = (1.f - lbv) * expf(ls - xx);
                            if (!valid) { lgf = 0.f; kk = 0.f; }
                            lf[j] = lgf; x[j] = kk;
                        }
                        float* lp = logfp + (size_t)row * 512 + cc;
                        *(f32x4*)lp = (f32x4){lf[0], lf[1], lf[2], lf[3]}; *(f32x4*)(lp + 4) = (f32x4){lf[4], lf[5], lf[6], lf[7]};
                    }
                    v4u w; w.x = pg8::cvt_pk_bf16(x[0], x[1]); w.y = pg8::cvt_pk_bf16(x[2], x[3]); w.z = pg8::cvt_pk_bf16(x[4], x[5]); w.w = pg8::cvt_pk_bf16(x[6], x[7]);
                    *(v4u*)(proj + (size_t)row * WIN + c0) = w;
                }
            }
    }
};
struct EpiResid {
    static constexpr bool PERM = true, AFTER_DRAIN = false;
    float* H; bf16* HB; float* ssq;
    __device__ __forceinline__ void operator()(const pg8::f32x4 (&acc)[2][2][4][2], const pg8::Unit& u, int wr, int wc, int fr, int fq) const {
        const int row0 = u.pm * 256 + wr * 64 + fr, colb = u.pn * 256 + wc * 32 + 8 * fq;
#pragma unroll
        for (int ai = 0; ai < 2; ++ai)
#pragma unroll
            for (int m = 0; m < 4; ++m) {
                const int row = row0 + ai * 128 + m * 16;
                float s = 0.f;
#pragma unroll
                for (int bj = 0; bj < 2; ++bj) {
                    const int c0 = colb + bj * 128;
                    float* hp = H + (size_t)row * D + c0;
                    f32x4 h0 = *(const f32x4*)hp, h1 = *(const f32x4*)(hp + 4);
                    h0 = h0 + acc[ai][bj][m][0]; h1 = h1 + acc[ai][bj][m][1];
                    *(f32x4*)hp = h0; *(f32x4*)(hp + 4) = h1;
                    s += (h0[0] * h0[0] + h0[1] * h0[1]) + (h0[2] * h0[2] + h0[3] * h0[3]) + (h1[0] * h1[0] + h1[1] * h1[1]) + (h1[2] * h1[2] + h1[3] * h1[3]);
                    v4u w; w.x = pg8::cvt_pk_bf16(h0[0], h0[1]); w.y = pg8::cvt_pk_bf16(h0[2], h0[3]); w.z = pg8::cvt_pk_bf16(h1[0], h1[1]); w.w = pg8::cvt_pk_bf16(h1[2], h1[3]);
                    *(v4u*)(HB + (size_t)row * D + c0) = w;
                }
                s += __shfl_xor(s, 16); s += __shfl_xor(s, 32);
                if (fq == 0) ssq[(size_t)row * 16 + u.pn * 4 + wc] = s;
            }
    }
};
struct EpiGLU {
    static constexpr bool PERM = true, AFTER_DRAIN = false;
    bf16* T; int ldt; const float* ssq;
    __device__ __forceinline__ void operator()(const pg8::f32x4 (&acc)[2][2][4][2], const pg8::Unit& u, int wr, int wc, int fr, int fq) const {
        const int row0 = u.pm * 256 + wr * 64 + fr, colb = u.pn * 128 + wc * 32 + 8 * fq;
#pragma unroll
        for (int ai = 0; ai < 2; ++ai)
#pragma unroll
            for (int m = 0; m < 4; ++m) {
                const int row = row0 + ai * 128 + m * 16;
                const float r = ssq ? row_rstd(ssq, row) : 1.f;
                float x[8];
#pragma unroll
                for (int j = 0; j < 4; ++j) { x[j] = silu_f(acc[ai][0][m][0][j] * r) * (acc[ai][1][m][0][j] * r); x[4 + j] = silu_f(acc[ai][0][m][1][j] * r) * (acc[ai][1][m][1][j] * r); }
                v4u w; w.x = pg8::cvt_pk_bf16(x[0], x[1]); w.y = pg8::cvt_pk_bf16(x[2], x[3]); w.z = pg8::cvt_pk_bf16(x[4], x[5]); w.w = pg8::cvt_pk_bf16(x[6], x[7]);
                *(v4u*)(T + (size_t)row * ldt + colb) = w;
            }
    }
};
struct EpiY {
    static constexpr bool PERM = true, AFTER_DRAIN = false;
    bf16* Y;
    __device__ __forceinline__ void operator()(const pg8::f32x4 (&acc)[2][2][4][2], const pg8::Unit& u, int wr, int wc, int fr, int fq) const {
        const int row0 = u.pm * 256 + wr * 64 + fr, colb = u.pn * 256 + wc * 32 + 8 * fq;
#pragma unroll
        for (int ai = 0; ai < 2; ++ai)
#pragma unroll
            for (int m = 0; m < 4; ++m) {
                const int row = row0 + ai * 128 + m * 16;
#pragma unroll
                for (int bj = 0; bj < 2; ++bj) {
                    const pg8::f32x4 a = acc[ai][bj][m][0], b = acc[ai][bj][m][1];
                    v4u w; w.x = pg8::cvt_pk_bf16(a[0], a[1]); w.y = pg8::cvt_pk_bf16(a[2], a[3]); w.z = pg8::cvt_pk_bf16(b[0], b[1]); w.w = pg8::cvt_pk_bf16(b[2], b[3]);
                    *(v4u*)(Y + (size_t)row * D + colb + bj * 128) = w;
                }
            }
    }
};

__device__ __forceinline__ void transpose_item(const float* W, const float* fold, int K, int N, bf16* WT, int k0, int n0, int drow0, LAS float* scr, int lane) {
#pragma unroll 8
    for (int i = 0; i < 32; ++i) { const int kk = 2 * i + (lane >> 5); const float f = fold ? fold[k0 + kk] : 1.f; scr[kk * 33 + (lane & 31)] = W[(size_t)(k0 + kk) * N + n0 + (lane & 31)] * f; }
    LDS_WAIT(); asm volatile("" ::: "memory");
    const int c = lane & 7;
#pragma unroll
    for (int j = 0; j < 4; ++j) { const int n = (lane >> 3) + 8 * j; const LAS float* s = scr + (8 * c) * 33 + n;
        v4u o; o.x = pk2(s[0 * 33], s[1 * 33]); o.y = pk2(s[2 * 33], s[3 * 33]); o.z = pk2(s[4 * 33], s[5 * 33]); o.w = pk2(s[6 * 33], s[7 * 33]);
        *(GAS v4u*)(WT + (size_t)(drow0 + n) * K + k0 + 8 * c) = o; }
    LDS_WAIT(); asm volatile("" ::: "memory");
}
__device__ __forceinline__ void prologue_phase(Ctx& C, const Args& A) {
    LAS float* scr = (LAS float*)(C.lds + C.wave * 16384);
    const int gw = blockIdx.x * 8 + C.wave, NGW = C.G * 8;
    constexpr int I_IN = 16 * 112, I_OUT = 16 * 32, I_D1 = 16 * 88, I_D2 = 44 * 32, I_M1 = 16 * 112, I_M2 = 56 * 32;
    constexpr int N_IN = 4 * I_IN, N_OUT = 4 * I_OUT, N_D1 = 2 * I_D1, N_D2 = 2 * I_D2, N_M1 = 16 * I_M1, N_M2 = 16 * I_M2;
    constexpr int NITEMS = N_IN + N_OUT + 2 * N_D1 + N_D2 + 2 * N_M1 + N_M2;
    for (int it = gw; it < NITEMS; it += NGW) {
        int r = it;
        const float* W; const float* fold = nullptr; bf16* WT; int K, N, glu = -1, loc;
        if (r < N_IN) { const int l = r / I_IN; loc = r % I_IN; W = A.in[IN_WIN] + (size_t)l * D * WIN; fold = A.in[IN_NMIX] + l * D; WT = (bf16*)(C.ws + WS_WIN) + (size_t)l * WIN * D; K = D; N = WIN; }
        else if ((r -= N_IN) < N_OUT) { const int l = r / I_OUT; loc = r % I_OUT; W = A.in[IN_WOUT] + (size_t)l * D * D; WT = (bf16*)(C.ws + WS_WOUT) + (size_t)l * D * D; K = D; N = D; }
        else if ((r -= N_OUT) < N_D1) { const int i = r / I_D1; loc = r % I_D1; W = A.in[IN_DW1] + (size_t)i * D * FFD; fold = A.in[IN_NFFN] + (2 * i) * D; WT = (bf16*)(C.ws + WS_WD13) + (size_t)i * 2 * FFD * D; K = D; N = FFD; glu = 0; }
        else if ((r -= N_D1) < N_D1) { const int i = r / I_D1; loc = r % I_D1; W = A.in[IN_DW3] + (size_t)i * D * FFD; fold = A.in[IN_NFFN] + (2 * i) * D; WT = (bf16*)(C.ws + WS_WD13) + (size_t)i * 2 * FFD * D; K = D; N = FFD; glu = 1; }
        else if ((r -= N_D1) < N_D2) { const int i = r / I_D2; loc = r % I_D2; W = A.in[IN_DW2] + (size_t)i * FFD * D; WT = (bf16*)(C.ws + WS_WD2) + (size_t)i * D * FFD; K = FFD; N = D; }
        else if ((r -= N_D2) < N_M1) { const int ie = r / I_M1; loc = r % I_M1; W = A.in[IN_MW1] + (size_t)ie * D * FFE; fold = A.in[IN_NFFN] + (2 * (ie >> 3) + 1) * D; WT = (bf16*)(C.ws + WS_WM13) + (size_t)ie * 2 * FFE * D; K = D; N = FFE; glu = 0; }
        else if ((r -= N_M1) < N_M1) { const int ie = r / I_M1; loc = r % I_M1; W = A.in[IN_MW3] + (size_t)ie * D * FFE; fold = A.in[IN_NFFN] + (2 * (ie >> 3) + 1) * D; WT = (bf16*)(C.ws + WS_WM13) + (size_t)ie * 2 * FFE * D; K = D; N = FFE; glu = 1; }
        else { r -= N_M1; const int ie = r / I_M2; loc = r % I_M2; W = A.in[IN_MW2] + (size_t)ie * FFE * D; WT = (bf16*)(C.ws + WS_WM2) + (size_t)ie * D * FFE; K = FFE; N = D; }
        const int nblk = N / 32, kb = loc / nblk, nb = loc % nblk, k0 = 64 * kb, n0 = 32 * nb;
        const int drow0 = (glu < 0) ? n0 : ((n0 >> 7) * 256 + glu * 128 + (n0 & 127));
        transpose_item(W, fold, K, N, WT, k0, n0, drow0, scr, C.lane);
    }
    for (int row = gw; row < NTOK; row += NGW) {
        const int b = row / LT, t = row % LT;
        f32x4 v[4]; float s = 0.f;
#pragma unroll
        for (int j = 0; j < 4; ++j) {
            const int col = 4 * C.lane + 256 * j;
            if (t < FIRSTV) v[j] = (f32x4){0.f, 0.f, 0.f, 0.f};
            else if (t < LEAD) v[j] = *(const f32x4*)(A.in[IN_META] + (size_t)(t - FIRSTV) * D + col);
            else v[j] = *(const f32x4*)(A.in[IN_X] + ((size_t)b * SEQ + (t - LEAD)) * D + col);
            s += (v[j][0] * v[j][0] + v[j][1] * v[j][1]) + (v[j][2] * v[j][2] + v[j][3] * v[j][3]);
            *(f32x4*)(C.H() + (size_t)row * D + col) = v[j];
            v2u w; w.x = pk2(v[j][0], v[j][1]); w.y = pk2(v[j][2], v[j][3]);
            *(v2u*)(C.HB() + (size_t)row * D + col) = w;
        }
        s = wave_sum(s);
        if (C.lane < 16) C.SSQ()[(size_t)row * 16 + C.lane] = (C.lane == 0) ? s : 0.f;
    }
    if (blockIdx.x == 0) {
        const int tid = C.tid;
        {
            const float* lg = A.in[IN_LBL];
            const float a0 = lg[tid], a1 = lg[512 + tid], a2 = lg[1024 + tid], a3 = lg[1536 + tid];
            const float mx = fmaxf(fmaxf(a0, a1), fmaxf(a2, a3));
            const float e0 = expf(a0 - mx), e1 = expf(a1 - mx), e2 = expf(a2 - mx), e3 = expf(a3 - mx);
            const float inv = 1.f / (((e0 + e1) + e2) + e3);
            const float p0 = e0 * inv, p1 = e1 * inv, p2 = e2 * inv, p3 = e3 * inv;
            const float c0 = p0, c1 = c0 + p1, c2 = c1 + p2, c3 = c2 + p3;
            C.LB()[tid] = 0.f;
            C.LB()[512 + tid] = fminf(fmaxf(c1 - c0, 0.f), 0.999f);
            C.LB()[1024 + tid] = fminf(fmaxf(c2 - c0, 0.f), 0.999f);
            C.LB()[1536 + tid] = fminf(fmaxf(c3 - c0, 0.f), 0.999f);
        }
        for (int i = tid; i < 4 * 132; i += 512) { const int h = i / 132, d = i % 132; C.BIAST()[i] = (d <= 128) ? A.in[IN_RELB][T5B[d] * 4 + h] : 0.f; }
        if (tid < 4) {
            const float* lv = A.in[IN_LAMBDA] + tid * 256;
            float s01 = 0.f, s23 = 0.f;
            for (int j = 0; j < 64; ++j) { s01 += lv[j] * lv[64 + j]; s23 += lv[128 + j] * lv[192 + j]; }
            const float li = 0.8f - 0.6f * expf(-0.3f * (float)tid);
            C.LAM()[tid * 2] = expf(s01) - expf(s23) + li; C.LAM()[tid * 2 + 1] = li;
        }
        if (tid < 512) { C.SUBLN()[tid] = A.in[IN_SUBLN][tid]; C.HGNW()[tid] = A.in[IN_HGNW][tid]; C.FNORM()[tid] = A.in[IN_FNORM][tid]; C.FNORM()[512 + tid] = A.in[IN_FNORM][512 + tid]; }
        for (int i = tid; i < 2 * 8 * 1024; i += 512) { const int li = i >> 13, e = (i >> 10) & 7, k = i & 1023; C.RF()[i] = A.in[IN_NFFN][(2 * li + 1) * D + k] * A.in[IN_ROUTER][(size_t)li * D * NE + k * NE + e]; }
    }
}

__device__ __forceinline__ void attn_naive_unit(Ctx& C, int l, int b, int h, int qi) {
    LAS float* Ks = (LAS float*)C.lds;
    LAS float* Vs = Ks + 64 * 64;
    LAS float* biasl = Vs + 64 * 128;
    LAS float* red = biasl + 132;
    const int tid = C.tid, r = tid & 127, part = tid >> 7;
    const int tq = qi * 128 + r; const size_t row = (size_t)b * LT + tq;
    if (tid < 132) biasl[tid] = C.BIAST()[h * 132 + tid];
    const float lam = C.LAM()[l * 2], lam_init = C.LAM()[l * 2 + 1];
    float O0[32];
#pragma unroll
    for (int c = 0; c < 2; ++c) {
        float q[64];
        {
            const bf16* qp = C.PROJ() + row * WIN + 2048 + h * 128 + c * 64;
#pragma unroll
            for (int j = 0; j < 8; ++j) { const v4u w = *(const v4u*)(qp + 8 * j);
                q[8 * j + 0] = bf_lo(w.x); q[8 * j + 1] = bf_hi(w.x); q[8 * j + 2] = bf_lo(w.y); q[8 * j + 3] = bf_hi(w.y);
                q[8 * j + 4] = bf_lo(w.z); q[8 * j + 5] = bf_hi(w.z); q[8 * j + 6] = bf_lo(w.w); q[8 * j + 7] = bf_hi(w.w); }
        }
        float o[32];
#pragma unroll
        for (int j = 0; j < 32; ++j) o[j] = 0.f;
        float mrun = -1e30f, lsum = 0.f;
        for (int jt = 1; jt <= 2 * qi + 1; ++jt) {
            __syncthreads();
            {
                const int kk = tid >> 3, d0 = (tid & 7) * 8;
                const size_t krow = (size_t)b * LT + jt * 64 + kk;
                const v4u w = *(const v4u*)(C.PROJ() + krow * WIN + 2560 + h * 128 + c * 64 + d0);
                LAS float* kd = Ks + kk * 64 + d0;
                kd[0] = bf_lo(w.x); kd[1] = bf_hi(w.x); kd[2] = bf_lo(w.y); kd[3] = bf_hi(w.y); kd[4] = bf_lo(w.z); kd[5] = bf_hi(w.z); kd[6] = bf_lo(w.w); kd[7] = bf_hi(w.w);
                const int v0 = (tid & 7) * 16;
                const v4u wa = *(const v4u*)(C.PROJ() + krow * WIN + 3072 + h * 128 + v0), wb = *(const v4u*)(C.PROJ() + krow * WIN + 3072 + h * 128 + v0 + 8);
                LAS float* vd = Vs + kk * 128 + v0;
                vd[0] = bf_lo(wa.x); vd[1] = bf_hi(wa.x); vd[2] = bf_lo(wa.y); vd[3] = bf_hi(wa.y); vd[4] = bf_lo(wa.z); vd[5] = bf_hi(wa.z); vd[6] = bf_lo(wa.w); vd[7] = bf_hi(wa.w);
                vd[8] = bf_lo(wb.x); vd[9] = bf_hi(wb.x); vd[10] = bf_lo(wb.y); vd[11] = bf_hi(wb.y); vd[12] = bf_lo(wb.z); vd[13] = bf_hi(wb.z); vd[14] = bf_lo(wb.w); vd[15] = bf_hi(wb.w);
            }
            __syncthreads();
            for (int kk = 0; kk < 64; ++kk) {
                const int key = jt * 64 + kk;
                if (key <= tq && key >= FIRSTV) {
                    const LAS f32x4* kr = (const LAS f32x4*)(Ks + kk * 64);
                    float s = 0.f;
#pragma unroll
                    for (int j = 0; j < 16; ++j) { const f32x4 kv = kr[j]; s += q[4 * j] * kv[0] + q[4 * j + 1] * kv[1] + q[4 * j + 2] * kv[2] + q[4 * j + 3] * kv[3]; }
                    const int dist = tq - key;
                    s += biasl[dist < 128 ? dist : 128];
                    const float mn = fmaxf(mrun, s), sc = __expf(mrun - mn), p = __expf(s - mn);
                    lsum = lsum * sc + p; mrun = mn;
                    const LAS f32x4* vr = (const LAS f32x4*)(Vs + kk * 128 + 32 * part);
#pragma unroll
                    for (int j = 0; j < 8; ++j) { const f32x4 vv = vr[j]; o[4 * j] = o[4 * j] * sc + p * vv[0]; o[4 * j + 1] = o[4 * j + 1] * sc + p * vv[1]; o[4 * j + 2] = o[4 * j + 2] * sc + p * vv[2]; o[4 * j + 3] = o[4 * j + 3] * sc + p * vv[3]; }
                }
            }
        }
        const float inv = lsum > 0.f ? 1.f / lsum : 0.f;
        if (c == 0) {
#pragma unroll
            for (int j = 0; j < 32; ++j) O0[j] = o[j] * inv;
        } else {
#pragma unroll
            for (int j = 0; j < 32; ++j) O0[j] = O0[j] - lam * (o[j] * inv);
        }
    }
    float ss = 0.f;
#pragma unroll
    for (int j = 0; j < 32; ++j) ss += O0[j] * O0[j];
    __syncthreads();
    red[part * 128 + r] = ss;
    __syncthreads();
    const float tot = (red[r] + red[128 + r]) + (red[256 + r] + red[384 + r]);
    const float rs = rsqrtf(tot * (1.0f / 128.0f) + EPS) * (1.f - lam_init);
    const float* sw = C.SUBLN() + l * 128 + 32 * part;
    bf16* op = C.MIX() + row * D + 512 + h * 128 + 32 * part;
#pragma unroll
    for (int j = 0; j < 4; ++j) {
        v4u w;
        w.x = pk2(O0[8 * j + 0] * rs * sw[8 * j + 0], O0[8 * j + 1] * rs * sw[8 * j + 1]); w.y = pk2(O0[8 * j + 2] * rs * sw[8 * j + 2], O0[8 * j + 3] * rs * sw[8 * j + 3]);
        w.z = pk2(O0[8 * j + 4] * rs * sw[8 * j + 4], O0[8 * j + 5] * rs * sw[8 * j + 5]); w.w = pk2(O0[8 * j + 6] * rs * sw[8 * j + 6], O0[8 * j + 7] * rs * sw[8 * j + 7]);
        *(v4u*)(op + 8 * j) = w;
    }
    __syncthreads();
}
__device__ __forceinline__ void hgrn_naive_unit(Ctx& C, int l, int b, int h) {
    LAS float* qf = (LAS float*)C.lds;
    LAS float* kf = qf + 2048; LAS float* ff = kf + 2048; LAS float* vv = ff + 2048; LAS float* gg = vv + 2048;
    LAS float* opart = gg + 2048;
    const int tid = C.tid, dv = tid & 127, qd = tid >> 7;
    const int ltok = tid >> 5, c4 = (tid & 31) * 4;
    float S[32];
#pragma unroll
    for (int j = 0; j < 32; ++j) S[j] = 0.f;
    const float* nw = C.HGNW() + l * 128;
    for (int tb = 0; tb < LT / 16; ++tb) {
        const size_t row = (size_t)b * LT + tb * 16 + ltok;
        {
            const bf16* pp = C.PROJ() + row * WIN + h * 128 + c4;
            const v2u wq = *(const v2u*)pp, wk = *(const v2u*)(pp + 512), wv = *(const v2u*)(pp + 1024), wg = *(const v2u*)(pp + 1536);
            const f32x4 lf = *(const f32x4*)(C.LOGF() + row * 512 + h * 128 + c4);
            const int o = ltok * 128 + c4;
            qf[o] = bf_lo(wq.x); qf[o + 1] = bf_hi(wq.x); qf[o + 2] = bf_lo(wq.y); qf[o + 3] = bf_hi(wq.y);
            kf[o] = bf_lo(wk.x); kf[o + 1] = bf_hi(wk.x); kf[o + 2] = bf_lo(wk.y); kf[o + 3] = bf_hi(wk.y);
            vv[o] = bf_lo(wv.x); vv[o + 1] = bf_hi(wv.x); vv[o + 2] = bf_lo(wv.y); vv[o + 3] = bf_hi(wv.y);
            gg[o] = bf_lo(wg.x); gg[o + 1] = bf_hi(wg.x); gg[o + 2] = bf_lo(wg.y); gg[o + 3] = bf_hi(wg.y);
            ff[o] = expf(lf[0]); ff[o + 1] = expf(lf[1]); ff[o + 2] = expf(lf[2]); ff[o + 3] = expf(lf[3]);
        }
        __syncthreads();
        for (int tok = 0; tok < 16; ++tok) {
            const float v = vv[tok * 128 + dv];
            const LAS f32x4* fp = (const LAS f32x4*)(ff + tok * 128 + 32 * qd);
            const LAS f32x4* kp = (const LAS f32x4*)(kf + tok * 128 + 32 * qd);
            const LAS f32x4* qp = (const LAS f32x4*)(qf + tok * 128 + 32 * qd);
            float a = 0.f;
#pragma unroll
            for (int j = 0; j < 8; ++j) {
                const f32x4 f4 = fp[j], k4 = kp[j], q4 = qp[j];
#pragma unroll
                for (int i = 0; i < 4; ++i) { S[4 * j + i] = f4[i] * S[4 * j + i] + k4[i] * v; a += q4[i] * S[4 * j + i]; }
            }
            opart[(tok * 4 + qd) * 128 + dv] = a;
        }
        __syncthreads();
        {
            float o[4]; float ss = 0.f;
#pragma unroll
            for (int i = 0; i < 4; ++i) { o[i] = (opart[(ltok * 4 + 0) * 128 + c4 + i] + opart[(ltok * 4 + 1) * 128 + c4 + i]) + (opart[(ltok * 4 + 2) * 128 + c4 + i] + opart[(ltok * 4 + 3) * 128 + c4 + i]); ss += o[i] * o[i]; }
#pragma unroll
            for (int m = 1; m < 32; m <<= 1) ss += __shfl_xor(ss, m);
            const float rs = rsqrtf(ss * (1.0f / 128.0f) + EPS);
            const int oo = ltok * 128 + c4;
            v2u w; w.x = pk2(o[0] * rs * nw[c4] * gg[oo], o[1] * rs * nw[c4 + 1] * gg[oo + 1]); w.y = pk2(o[2] * rs * nw[c4 + 2] * gg[oo + 2], o[3] * rs * nw[c4 + 3] * gg[oo + 3]);
            *(v2u*)(C.MIX() + row * D + h * 128 + c4) = w;
        }
        __syncthreads();
    }
}
__device__ __forceinline__ void mixer_phase_naive(Ctx& C, int l) {
    for (int u = blockIdx.x; u < 17 * 32; u += C.G) { const int qi = 16 - u / 32, bh = u % 32; attn_naive_unit(C, l, bh >> 2, bh & 3, qi); }
    for (int u = C.G - 1 - (int)blockIdx.x; u < 32; u += C.G) hgrn_naive_unit(C, l, u >> 2, u & 3);
}

constexpr int RMAX = 128;
__device__ __forceinline__ void route_phase(Ctx& C, int li) {
    LAS float* rf = (LAS float*)C.lds;
    LAS int* lcnt = (LAS int*)(C.lds + 32768);
    LAS int* lbase = lcnt + 8;
    LAS int* ti = lbase + 8;
    LAS float* tf = (LAS float*)(ti + RMAX * 4);
    const int tid = C.tid, lane = C.lane;
    for (int i = tid; i < 8192; i += 512) rf[i] = C.RF()[li * 8192 + i];
    if (tid < 8) lcnt[tid] = 0;
    __syncthreads();
    const int nrows = (NTOK - (int)blockIdx.x + C.G - 1) / C.G;
    for (int k = C.wave; k < nrows; k += 8) {
        const size_t row = (size_t)blockIdx.x + (size_t)k * C.G;
        f32x4 v[4]; float ss = 0.f;
#pragma unroll
        for (int j = 0; j < 4; ++j) { v[j] = *(const f32x4*)(C.H() + row * D + 4 * lane + 256 * j); ss += (v[j][0] * v[j][0] + v[j][1] * v[j][1]) + (v[j][2] * v[j][2] + v[j][3] * v[j][3]); }
        ss = wave_sum(ss);
        const float rstd = rsqrtf(ss * (1.0f / 1024.0f) + EPS);
        float lg[8];
#pragma unroll
        for (int e = 0; e < 8; ++e) {
            float p = 0.f;
#pragma unroll
            for (int j = 0; j < 4; ++j) { const f32x4 w = *(const LAS f32x4*)(rf + e * 1024 + 4 * lane + 256 * j); p += (v[j][0] * w[0] + v[j][1] * w[1]) + (v[j][2] * w[2] + v[j][3] * w[3]); }
            lg[e] = wave_sum(p) * rstd;
        }
        int e1 = 0; float l1 = lg[0];
#pragma unroll
        for (int e = 1; e < 8; ++e) if (lg[e] > l1) { l1 = lg[e]; e1 = e; }
        int e2 = -1; float l2 = -3.0e38f;
#pragma unroll
        for (int e = 0; e < 8; ++e) if (e != e1 && lg[e] > l2) { l2 = lg[e]; e2 = e; }
        const float g1 = 1.f / (1.f + expf(l2 - l1)), g2 = 1.f - g1;
        if (lane == 0) {
            const int lr1 = __hip_atomic_fetch_add(&lcnt[e1], 1, __ATOMIC_RELAXED, __HIP_MEMORY_SCOPE_WORKGROUP), lr2 = __hip_atomic_fetch_add(&lcnt[e2], 1, __ATOMIC_RELAXED, __HIP_MEMORY_SCOPE_WORKGROUP);
            ti[k * 4 + 0] = e1; ti[k * 4 + 1] = e2; ti[k * 4 + 2] = lr1; ti[k * 4 + 3] = lr2;
            tf[k * 4 + 0] = g1; tf[k * 4 + 1] = g2; tf[k * 4 + 2] = rstd;
        }
    }
    __syncthreads();
    if (tid < 8) lbase[tid] = (int)__hip_atomic_fetch_add(C.ctl() + CW_CNT + (li * 8 + tid) * 64, (unsigned)lcnt[tid], RLX_AGENT);
    __syncthreads();
    for (int k = tid; k < nrows; k += 512) {
        const int row = (int)blockIdx.x + k * C.G;
        const int e1 = ti[k * 4], e2 = ti[k * 4 + 1], r1 = lbase[e1] + ti[k * 4 + 2], r2 = lbase[e2] + ti[k * 4 + 3];
        C.LIST()[(size_t)e1 * NTOK + r1] = row; C.LIST()[(size_t)e2 * NTOK + r2] = row;
        unsigned* inf = C.TINFO() + (size_t)row * 8;
        inf[0] = (unsigned)e1; inf[1] = (unsigned)e2; inf[2] = (unsigned)r1; inf[3] = (unsigned)r2; inf[4] = __builtin_bit_cast(unsigned, tf[k * 4]); inf[5] = __builtin_bit_cast(unsigned, tf[k * 4 + 1]);
        C.RSTD()[row] = tf[k * 4 + 2];
    }
    __syncthreads();
}
__device__ __forceinline__ void load_panels(Ctx& C, int li, LAS int* pst) {
    __syncthreads();
    if (C.tid == 0) { int acc = 0;
        for (int e = 0; e < 8; ++e) { const int c = (int)__hip_atomic_load(C.ctl() + CW_CNT + (li * 8 + e) * 64, RLX_AGENT); pst[e] = acc; pst[16 + e] = c; acc += (c + 255) >> 8; }
        pst[8] = acc; }
    __syncthreads();
}
__device__ __forceinline__ void gather_phase(Ctx& C, int li) {
    LAS int* pst = (LAS int*)C.lds;
    load_panels(C, li, pst);
    const int gw = blockIdx.x * 8 + C.wave, NGW = C.G * 8, lane = C.lane;
    const int nslot = pst[8] * 256;
    for (int s = gw; s < nslot; s += NGW) {
        const int panel = s >> 8; int e = 0;
#pragma unroll
        for (int j = 1; j < 8; ++j) if (panel >= pst[j]) e = j;
        const int rank = s - pst[e] * 256;
        bf16* xp = C.XG() + (size_t)s * D;
        if (rank < pst[16 + e]) {
            const int tok = C.LIST()[(size_t)e * NTOK + rank]; const float r = C.RSTD()[tok];
#pragma unroll
            for (int j = 0; j < 4; ++j) { const f32x4 v = *(const f32x4*)(C.H() + (size_t)tok * D + 4 * lane + 256 * j); v2u w; w.x = pk2(v[0] * r, v[1] * r); w.y = pk2(v[2] * r, v[3] * r); *(v2u*)(xp + 4 * lane + 256 * j) = w; }
        } else {
#pragma unroll
            for (int j = 0; j < 4; ++j) *(v2u*)(xp + 4 * lane + 256 * j) = (v2u){0u, 0u};
        }
    }
}
__device__ __forceinline__ void combine_phase(Ctx& C, int li, bool last) {
    LAS int* pst = (LAS int*)C.lds;
    load_panels(C, li, pst);
    const int gw = blockIdx.x * 8 + C.wave, NGW = C.G * 8, lane = C.lane;
    for (int row = gw; row < NTOK; row += NGW) {
        const unsigned* inf = C.TINFO() + (size_t)row * 8;
        const int e1 = (int)inf[0], e2 = (int)inf[1];
        const size_t s1 = (size_t)pst[e1] * 256 + inf[2], s2 = (size_t)pst[e2] * 256 + inf[3];
        const float g1 = __builtin_bit_cast(float, inf[4]), g2 = __builtin_bit_cast(float, inf[5]);
        f32x4 v[4]; float ss = 0.f;
#pragma unroll
        for (int j = 0; j < 4; ++j) {
            const int col = 4 * lane + 256 * j;
            v[j] = *(const f32x4*)(C.H() + (size_t)row * D + col);
            const v2u a = *(const v2u*)(C.Y() + s1 * D + col), b = *(const v2u*)(C.Y() + s2 * D + col);
            v[j][0] += g1 * bf_lo(a.x) + g2 * bf_lo(b.x); v[j][1] += g1 * bf_hi(a.x) + g2 * bf_hi(b.x);
            v[j][2] += g1 * bf_lo(a.y) + g2 * bf_lo(b.y); v[j][3] += g1 * bf_hi(a.y) + g2 * bf_hi(b.y);
            ss += (v[j][0] * v[j][0] + v[j][1] * v[j][1]) + (v[j][2] * v[j][2] + v[j][3] * v[j][3]);
        }
        ss = wave_sum(ss);
        if (!last) {
#pragma unroll
            for (int j = 0; j < 4; ++j) { const int col = 4 * lane + 256 * j; *(f32x4*)(C.H() + (size_t)row * D + col) = v[j]; v2u w; w.x = pk2(v[j][0], v[j][1]); w.y = pk2(v[j][2], v[j][3]); *(v2u*)(C.HB() + (size_t)row * D + col) = w; }
            if (lane < 16) C.SSQ()[(size_t)row * 16 + lane] = (lane == 0) ? ss : 0.f;
        } else {
            const int b = row / LT, t = row % LT;
            if (t >= LEAD) {
                const float rs = rsqrtf(ss * (1.0f / 1024.0f) + EPS);
#pragma unroll
                for (int j = 0; j < 4; ++j) { const int col = 4 * lane + 256 * j; const f32x4 fw = *(const f32x4*)(C.FNORM() + col);
                    *(f32x4*)(C.out + ((size_t)b * SEQ + (t - LEAD)) * D + col) = (f32x4){v[j][0] * rs * fw[0], v[j][1] * rs * fw[1], v[j][2] * rs * fw[2], v[j][3] * rs * fw[3]}; }
            }
        }
    }
}

__global__ void __launch_bounds__(512, 2) mk_fwd(Args args) {
    extern __shared__ __attribute__((aligned(16))) unsigned char lds[];
    Ctx C;
    C.lds = (LAS unsigned char*)lds;
    C.tid = threadIdx.x; C.lane = C.tid & 63; C.wave = __builtin_amdgcn_readfirstlane(C.tid >> 6); C.G = gridDim.x;
    unsigned char* ws = args.ws; C.ws = ws; C.out = args.out;
    volatile LAS unsigned* MISC = (volatile LAS unsigned*)(C.lds + MISC_OFF);
    for (int u = C.tid; u < (LDS_BYTES - RING_BYTES) / 4; u += 512) ((LAS unsigned*)(C.lds + RING_BYTES))[u] = 0u;
    __syncthreads();
    const int lo = args.ph_lo, hi = args.ph_hi;
    const bool multi = (hi - lo) > 1;
    XcdBarrier bar; bar.bar = (unsigned*)(C.ctl() + CW_BAR); bar.x = 0; bar.st = nullptr;
    if (multi) bar = xcd_barrier_post((unsigned*)(C.ctl() + CW_BAR), MISC + 8);
#define PHASE_CTX(P) Ctx P = C; { unsigned char* w_ = C.ws; asm volatile("" : "+s"(w_)); P.ws = w_; int t_ = C.tid; asm volatile("" : "+v"(t_)); P.tid = t_; P.lane = t_ & 63; P.wave = __builtin_amdgcn_readfirstlane(t_ >> 6); }
#define IN(k) (lo_l <= (k) && (k) < hi_l)
#define SEAM(k) do { if ((k) + 1 < hi_l) xcd_barrier(bar); } while (0)

    { int lo_l = lo, hi_l = hi; asm volatile("" : "+s"(lo_l), "+s"(hi_l));
      if (IN(0)) { PHASE_CTX(P); prologue_phase(P, args); SEAM(0); } }

    for (int l = 0; l < DEPTH; ++l) {
        int lo_l = lo, hi_l = hi; asm volatile("" : "+s"(lo_l), "+s"(hi_l));
        const int pb = 1 + 8 * l, li = l >> 1; const bool moe = (l & 1) != 0;
        if (IN(pb + 0)) {
            PHASE_CTX(P);
            pg8::Gemm g{P.HB(), (const bf16*)(P.ws + WS_WIN) + (size_t)l * WIN * D, NTOK, WIN, D, 0};
            pg8::StaticOrder S; S.init(NTOK, WIN, P.G, (int)blockIdx.x);
            EpiProj E{P.PROJ(), P.LOGF(), P.SSQ(), P.LB() + l * 512};
            pg8::gemm_phase<EpiProj, pg8::StaticOrder, true, true>(P.lds, g, S, E);
            SEAM(pb + 0);
        }
        if (IN(pb + 1)) { PHASE_CTX(P); mixer_phase_naive(P, l); SEAM(pb + 1); }
        if (IN(pb + 2)) {
            PHASE_CTX(P);
            pg8::Gemm g{P.MIX(), (const bf16*)(P.ws + WS_WOUT) + (size_t)l * D * D, NTOK, D, D, 0};
            pg8::StaticOrder S; S.init(NTOK, D, P.G, (int)blockIdx.x);
            EpiResid E{P.H(), P.HB(), P.SSQ()};
            pg8::gemm_phase<EpiResid, pg8::StaticOrder, true, true>(P.lds, g, S, E);
            SEAM(pb + 2);
        }
        if (!moe) {
            if (IN(pb + 5)) {
                PHASE_CTX(P);
                pg8::Gemm g{P.HB(), (const bf16*)(P.ws + WS_WD13) + (size_t)li * 2 * FFD * D, NTOK, 2 * FFD, D, 0};
                pg8::StaticOrder S; S.init(NTOK, 2 * FFD, P.G, (int)blockIdx.x);
                EpiGLU E{P.T(), FFD, P.SSQ()};
                pg8::gemm_phase<EpiGLU, pg8::StaticOrder, true, true>(P.lds, g, S, E);
                SEAM(pb + 5);
            }
            if (IN(pb + 6)) {
                PHASE_CTX(P);
                pg8::Gemm g{P.T(), (const bf16*)(P.ws + WS_WD2) + (size_t)li * D * FFD, NTOK, D, FFD, 0};
                pg8::StaticOrder S; S.init(NTOK, D, P.G, (int)blockIdx.x);
                EpiResid E{P.H(), P.HB(), P.SSQ()};
                pg8::gemm_phase<EpiResid, pg8::StaticOrder, true, true>(P.lds, g, S, E);
                SEAM(pb + 6);
            }
        } else {
            if (IN(pb + 3)) { PHASE_CTX(P); route_phase(P, li); SEAM(pb + 3); }
            if (IN(pb + 4)) { PHASE_CTX(P); gather_phase(P, li); SEAM(pb + 4); }
            if (IN(pb + 5)) {
                PHASE_CTX(P);
                LAS int* pst = (LAS int*)(P.lds + RING_BYTES + 1024);
                load_panels(P, li, pst);
#define PS(i) __builtin_amdgcn_readfirstlane(pst[i])
                pg8::GroupedOrder S{PS(0), PS(1), PS(2), PS(3), PS(4), PS(5), PS(6), PS(7), PS(8), 2 * FFE / 256, P.G, (int)blockIdx.x};
                pg8::Gemm g{P.XG(), (const bf16*)(P.ws + WS_WM13) + (size_t)li * 8 * 2 * FFE * D, 0, 2 * FFE, D, (size_t)2 * FFE * D * 2};
                EpiGLU E{P.T(), FFE, nullptr};
                pg8::gemm_phase<EpiGLU, pg8::GroupedOrder, true, true>(P.lds, g, S, E);
                SEAM(pb + 5);
            }
            if (IN(pb + 6)) {
                PHASE_CTX(P);
                LAS int* pst = (LAS int*)(P.lds + RING_BYTES + 1024);
                load_panels(P, li, pst);
                pg8::GroupedOrder S{PS(0), PS(1), PS(2), PS(3), PS(4), PS(5), PS(6), PS(7), PS(8), D / 256, P.G, (int)blockIdx.x};
                pg8::Gemm g{P.T(), (const bf16*)(P.ws + WS_WM2) + (size_t)li * 8 * D * FFE, 0, D, FFE, (size_t)D * FFE * 2};
                EpiY E{P.Y()};
                pg8::gemm_phase<EpiY, pg8::GroupedOrder, true, true>(P.lds, g, S, E);
                SEAM(pb + 6);
            }
#undef PS
            if (IN(pb + 7)) { PHASE_CTX(P); combine_phase(P, li, l == DEPTH - 1); SEAM(pb + 7); }
        }
    }
#undef IN
#undef SEAM
#undef PHASE_CTX
}

extern "C" void kernel_launch(void* const* d_in, const int* in_sizes, int n_in, void* d_out, int out_size, void* d_ws, size_t ws_size, hipStream_t stream) {
    static int grid = 0;
    if (grid == 0) {
        if (n_in != 19 || out_size != NB * SEQ * D || ws_size < WS_END) { fprintf(stderr, "kernel_launch: unexpected shapes (n_in %d, out %d, ws %zu < %zu); nothing launched\n", n_in, out_size, ws_size, (size_t)WS_END); grid = -1; return; }
        int dev = 0, cus = 0, per_cu = 0;
        if (hipGetDevice(&dev) != hipSuccess || hipDeviceGetAttribute(&cus, hipDeviceAttributeMultiprocessorCount, dev) != hipSuccess) { grid = -1; return; }
        if (hipFuncSetAttribute((const void*)mk_fwd, hipFuncAttributeMaxDynamicSharedMemorySize, LDS_BYTES) != hipSuccess) { fprintf(stderr, "kernel_launch: hipFuncSetAttribute failed\n"); grid = -1; return; }
        if (hipOccupancyMaxActiveBlocksPerMultiprocessor(&per_cu, (const void*)mk_fwd, 512, LDS_BYTES) != hipSuccess || per_cu < 1) { fprintf(stderr, "kernel_launch: occupancy query says %d blocks per CU\n", per_cu); }
        (void)hipGetLastError();
        grid = cus;
    }
    if (grid < 0) return;
    if (hipMemsetAsync((char*)d_ws + WS_CTL, 0, CTL_ZERO_BYTES, stream) != hipSuccess) return;
    Args a{};
    for (int i = 0; i < 19; ++i) a.in[i] = (const float*)d_in[i];
    a.out = (float*)d_out; a.ws = (unsigned char*)d_ws;
#if MK_ONE_LAUNCH
    a.ph_lo = 0; a.ph_hi = NPHASE;
    hipLaunchKernelGGL(mk_fwd, dim3(grid), dim3(512), LDS_BYTES, stream, a);
#else
    for (int p = 0; p < NPHASE; ++p) {
        if (p > 0) { const int l = (p - 1) / 8, k = (p - 1) % 8; const bool moe = (l & 1) != 0; if (!moe && (k == 3 || k == 4 || k == 7)) continue; }
        a.ph_lo = p; a.ph_hi = p + 1;
        hipLaunchKernelGGL(mk_fwd, dim3(grid), dim3(512), LDS_BYTES, stream, a);
    }
#endif
}
```

```cpp
#include <hip/hip_runtime.h>
#include <cstdio>
#include <cstdint>

#ifndef MK_ONE_LAUNCH
#define MK_ONE_LAUNCH 1
#endif

namespace pg8 {
#define PG8_LAS __attribute__((address_space(3)))
typedef unsigned short bf16_t;
typedef short bf16x8 __attribute__((ext_vector_type(8)));
typedef float f32x4 __attribute__((ext_vector_type(4)));
typedef unsigned u32x4 __attribute__((ext_vector_type(4)));
typedef unsigned u32x2 __attribute__((ext_vector_type(2)));
constexpr int BM = 256, BK = 64, HALF = 128, HTB = HALF * BK * 2  , STAGE_BYTES = 8 * HTB, NXCD = 8, WGM = 8;

__host__ __device__ __forceinline__ int lds_byte(int r, int c) { const int st = (r >> 4) * 2 + (c >> 5), rr = r & 15, cc = c & 31, ob = rr * 64 + cc * 2; return st * 1024 + (ob ^ (((ob >> 9) & 1) << 5)); }
__host__ __device__ __forceinline__ void stage_rc(int b, int& R, int& C) { const int st = b / 1024, sb = b % 1024, swz = sb ^ (((sb >> 9) & 1) << 5); R = (st >> 1) * 16 + swz / 64; C = (st & 1) * 32 + (swz % 64) / 2; }
__host__ __device__ __forceinline__ int perm32(int rho) { const int n = rho >> 4, i = rho & 15; return 8 * (i >> 2) + 4 * n + (i & 3); }

struct Unit { int pm, pn, e; };
struct Gemm { const bf16_t* A; const bf16_t* Bt; int M, N, K; size_t bstride; };

struct StaticOrder {
    int nM, nN, nwg, G, c;
    __host__ __device__ void init(int M, int N, int G_, int c_) { nM = M / BM; nN = N / BM; nwg = nM * nN; G = G_; c = c_; }
    __host__ __device__ bool next(int i, Unit& u) const {
        const long L = (long)i * G + c; if (L >= nwg) return false;
        int wgid = (int)L; { const int q = nwg / NXCD, r = nwg % NXCD, xcd = wgid % NXCD, off = wgid / NXCD; wgid = (xcd < r ? xcd * (q + 1) : r * (q + 1) + (xcd - r) * q) + off; }
        const int nig = WGM * nN, gid = wgid / nig, fm = gid * WGM, gsz = (nM - fm) < WGM ? (nM - fm) : WGM;
        u.pm = fm + ((wgid % nig) % gsz); u.pn = (wgid % nig) / gsz; u.e = 0; return true;
    }
    __device__ __forceinline__ void a_ready(const Unit&) const {}
    __device__ __forceinline__ void done(const Unit&) const {}
};
struct GroupedOrder {
    int p0, p1, p2, p3, p4, p5, p6, p7, p8, nN, G, c;
    __device__ __forceinline__ bool next(int i, Unit& u) const {
        const int L = i * G + c; if (L >= p8 * nN) return false;
        int e = 0, ps = 0, pe = p1;
        if (L >= p1 * nN) { e = 1; ps = p1; pe = p2; }
        if (L >= p2 * nN) { e = 2; ps = p2; pe = p3; }
        if (L >= p3 * nN) { e = 3; ps = p3; pe = p4; }
        if (L >= p4 * nN) { e = 4; ps = p4; pe = p5; }
        if (L >= p5 * nN) { e = 5; ps = p5; pe = p6; }
        if (L >= p6 * nN) { e = 6; ps = p6; pe = p7; }
        if (L >= p7 * nN) { e = 7; ps = p7; pe = p8; }
        const int rem = L - ps * nN, R = pe - ps;
        u.e = e; u.pn = rem / R; u.pm = ps + rem % R; return true;
    }
    __device__ __forceinline__ void a_ready(const Unit&) const {}
    __device__ __forceinline__ void done(const Unit&) const {}
};

__device__ __forceinline__ unsigned cvt_pk_bf16(float lo, float hi) { unsigned r; asm volatile("v_cvt_pk_bf16_f32 %0, %1, %2" : "=v"(r) : "v"(lo), "v"(hi)); return r; }

template <class Epi, class Sched, bool ALIGN_EPI = false, bool SP2 = false>
__device__ __forceinline__ void gemm_phase(PG8_LAS unsigned char* lds, const Gemm g, const Sched& S, const Epi& E) {
    int tid_l = threadIdx.x; asm volatile("" : "+v"(tid_l));
    const int tid = tid_l, wid = __builtin_amdgcn_readfirstlane(tid >> 6), lane = tid & 63, wr = wid >> 2, wc = wid & 3, fr = lane & 15, fq = lane >> 4;
    const int K = g.K, nt = K / BK;
    unsigned voffA[2], voffB[2];
#pragma unroll
    for (int i = 0; i < 2; ++i) { int R, C; stage_rc(tid * 16 + i * 8192, R, C); const int Rb = Epi::PERM ? ((R & ~31) + perm32(R & 31)) : R;
        voffA[i] = (unsigned)(R * K + C) * 2u; voffB[i] = (unsigned)(Rb * K + C) * 2u; }
    const size_t kstep = (size_t)(BK * 2);
    const size_t hstep = (size_t)HALF * K * 2;
    const size_t tstep = 2 * hstep;
    const unsigned ldsw = (unsigned)wid * 1024u;
    const int aoff = lds_byte(wr * 64 + fr, fq * 8), boff = lds_byte(wc * 32 + fr, fq * 8);
#define PG8_SA(b, h) (((b) * 2 + (h)) * HTB)
#define PG8_SB(b, h) ((4 + (b) * 2 + (h)) * HTB)
#define PG8_STAGE(bufoff, gbase, voff) do { _Pragma("unroll") for (int _i = 0; _i < 2; ++_i) \
        __builtin_amdgcn_global_load_lds((const unsigned*)((const char*)(gbase) + (voff)[_i]), (PG8_LAS unsigned*)(lds + (bufoff) + ldsw + _i * 8192), 16, 0, 0); } while (0)
#define PG8_LDA(dst, b, h) do { _Pragma("unroll") for (int m = 0; m < 4; ++m) _Pragma("unroll") for (int k = 0; k < 2; ++k) dst[m][k] = *(const PG8_LAS bf16x8*)(lds + PG8_SA(b, h) + aoff + m * 2048 + k * 1024); } while (0)
#define PG8_LDB(dst, b, h) do { _Pragma("unroll") for (int n = 0; n < 2; ++n) _Pragma("unroll") for (int k = 0; k < 2; ++k) dst[n][k] = *(const PG8_LAS bf16x8*)(lds + PG8_SB(b, h) + boff + n * 2048 + k * 1024); } while (0)
#define PG8_MMA(ai, bj, At, Bt) do { __builtin_amdgcn_s_setprio(1); _Pragma("unroll") for (int m = 0; m < 4; ++m) _Pragma("unroll") for (int n = 0; n < 2; ++n) _Pragma("unroll") for (int k = 0; k < 2; ++k) \
        acc[ai][bj][m][n] = __builtin_amdgcn_mfma_f32_16x16x32_bf16(Bt[n][k], At[m][k], acc[ai][bj][m][n], 0, 0, 0); __builtin_amdgcn_s_setprio(0); } while (0)
#define PG8_WAIT_V(n) asm volatile("s_waitcnt vmcnt(" #n ")" ::: "memory")
#define PG8_WAIT_L(n) asm volatile("s_waitcnt lgkmcnt(" #n ")" ::: "memory")
#define PG8_BAR __builtin_amdgcn_s_barrier()
#define PG8_SCHED __builtin_amdgcn_sched_barrier(0)
    Unit cur, nxt; int ui = 0;
    if (!S.next(0, cur)) return;
    f32x4 acc[2][2][4][2];
#pragma unroll
    for (int a = 0; a < 2; ++a)
#pragma unroll
        for (int b = 0; b < 2; ++b)
#pragma unroll
            for (int m = 0; m < 4; ++m)
#pragma unroll
                for (int n = 0; n < 2; ++n) acc[a][b][m][n] = (f32x4){0.f, 0.f, 0.f, 0.f};
    bf16x8 At[4][2], B0[2][2], B1[2][2];
    const char* cA = (const char*)g.A + (size_t)cur.pm * tstep; const char* cB = (const char*)g.Bt + (size_t)cur.e * g.bstride + (size_t)cur.pn * tstep;
    S.a_ready(cur);
    if constexpr (SP2) {
        PG8_STAGE(PG8_SB(0, 0), cB, voffB); PG8_STAGE(PG8_SB(0, 1), cB + hstep, voffB); PG8_STAGE(PG8_SA(0, 0), cA, voffA); PG8_STAGE(PG8_SA(0, 1), cA + hstep, voffA);
        if (wr == 1) PG8_BAR;
        PG8_WAIT_V(2); PG8_BAR;
        PG8_STAGE(PG8_SB(1, 0), cB + kstep, voffB); PG8_STAGE(PG8_SA(1, 0), cA + kstep, voffA); PG8_STAGE(PG8_SB(1, 1), cB + hstep + kstep, voffB);
        PG8_WAIT_V(6); PG8_BAR;
    } else {
        PG8_STAGE(PG8_SB(0, 0), cB, voffB); PG8_STAGE(PG8_SA(0, 0), cA, voffA); PG8_STAGE(PG8_SB(0, 1), cB + hstep, voffB); PG8_STAGE(PG8_SA(0, 1), cA + hstep, voffA);
        if (wr == 1) PG8_BAR;
        PG8_WAIT_V(4); PG8_BAR;
        PG8_STAGE(PG8_SB(1, 0), cB + kstep, voffB); PG8_STAGE(PG8_SA(1, 0), cA + kstep, voffA); PG8_STAGE(PG8_SB(1, 1), cB + hstep + kstep, voffB);
        PG8_WAIT_V(6); PG8_BAR;
    }
    for (;;) {
        const bool has_next = S.next(ui + 1, nxt);
        const char* nA = has_next ? (const char*)g.A + (size_t)nxt.pm * tstep : cA; const char* nB = has_next ? (const char*)g.Bt + (size_t)nxt.e * g.bstride + (size_t)nxt.pn * tstep : cB;
        for (int t = 0; t < nt; t += 2) {
            const bool last = (t == nt - 2);
            const char* a1 = cA + (size_t)(t + 1) * kstep;
            const char* a2 = last ? nA : cA + (size_t)(t + 2) * kstep; const char* b2 = last ? nB : cB + (size_t)(t + 2) * kstep;
            const char* a3 = a2 + kstep; const char* b3 = b2 + kstep;
            if (last && has_next) S.a_ready(nxt);
            if constexpr (SP2) {
            PG8_LDB(B0, 0, 0); PG8_LDB(B1, 0, 1); PG8_SCHED; PG8_LDA(At, 0, 0); PG8_STAGE(PG8_SA(1, 1), a1 + hstep, voffA);
            PG8_WAIT_V(8); PG8_WAIT_L(0); PG8_BAR; PG8_MMA(0, 0, At, B0); PG8_MMA(0, 1, At, B1); PG8_BAR; PG8_SCHED;
            PG8_LDA(At, 0, 1); PG8_STAGE(PG8_SB(0, 0), b2, voffB); PG8_STAGE(PG8_SB(0, 1), b2 + hstep, voffB); PG8_STAGE(PG8_SA(0, 0), a2, voffA);
            PG8_WAIT_V(8); PG8_WAIT_L(0); PG8_BAR; PG8_MMA(1, 0, At, B0); PG8_MMA(1, 1, At, B1); PG8_BAR; PG8_SCHED;
            PG8_LDB(B0, 1, 0); PG8_LDB(B1, 1, 1); PG8_SCHED; PG8_LDA(At, 1, 0); PG8_STAGE(PG8_SA(0, 1), a2 + hstep, voffA);
            PG8_WAIT_V(8); PG8_WAIT_L(0); PG8_BAR; PG8_MMA(0, 0, At, B0); PG8_MMA(0, 1, At, B1); PG8_BAR; PG8_SCHED;
            PG8_LDA(At, 1, 1); PG8_STAGE(PG8_SB(1, 0), b3, voffB); PG8_STAGE(PG8_SB(1, 1), b3 + hstep, voffB); PG8_STAGE(PG8_SA(1, 0), a3, voffA);
            PG8_WAIT_V(8); PG8_WAIT_L(0); PG8_BAR; PG8_MMA(1, 0, At, B0); PG8_MMA(1, 1, At, B1); PG8_BAR; PG8_SCHED;
            } else {
            PG8_LDB(B0, 0, 0); PG8_SCHED; PG8_LDA(At, 0, 0); PG8_STAGE(PG8_SA(1, 1), a1 + hstep, voffA);
            PG8_WAIT_L(8); PG8_BAR; PG8_WAIT_L(0); PG8_MMA(0, 0, At, B0); PG8_BAR; PG8_SCHED;
            PG8_LDB(B1, 0, 1); PG8_STAGE(PG8_SB(0, 0), b2, voffB);
            PG8_BAR; PG8_WAIT_L(0); PG8_MMA(0, 1, At, B1); PG8_BAR;
            PG8_LDA(At, 0, 1); PG8_STAGE(PG8_SA(0, 0), a2, voffA);
            PG8_BAR; PG8_WAIT_L(0); PG8_MMA(1, 0, At, B0); PG8_BAR; PG8_SCHED;
            PG8_STAGE(PG8_SB(0, 1), b2 + hstep, voffB);
            PG8_WAIT_V(6); PG8_BAR; PG8_MMA(1, 1, At, B1); PG8_BAR;
            PG8_LDB(B0, 1, 0); PG8_SCHED; PG8_LDA(At, 1, 0); PG8_STAGE(PG8_SA(0, 1), a2 + hstep, voffA);
            PG8_WAIT_L(8); PG8_BAR; PG8_WAIT_L(0); PG8_MMA(0, 0, At, B0); PG8_BAR; PG8_SCHED;
            PG8_LDB(B1, 1, 1); PG8_STAGE(PG8_SB(1, 0), b3, voffB);
            PG8_BAR; PG8_WAIT_L(0); PG8_MMA(0, 1, At, B1); PG8_BAR;
            PG8_LDA(At, 1, 1); PG8_STAGE(PG8_SA(1, 0), a3, voffA);
            PG8_BAR; PG8_WAIT_L(0); PG8_MMA(1, 0, At, B0); PG8_BAR; PG8_SCHED;
            PG8_STAGE(PG8_SB(1, 1), b3 + hstep, voffB);
            PG8_WAIT_V(6); PG8_BAR; PG8_MMA(1, 1, At, B1); PG8_BAR;
            }
        }
        if constexpr (ALIGN_EPI) { if (wr == 0) PG8_BAR; }
        if constexpr (!Epi::AFTER_DRAIN) { E(acc, cur, wr, wc, fr, fq); S.done(cur); }
        if (!has_next) break;
#pragma unroll
        for (int a = 0; a < 2; ++a)
#pragma unroll
            for (int b = 0; b < 2; ++b)
#pragma unroll
                for (int m = 0; m < 4; ++m)
#pragma unroll
                    for (int n = 0; n < 2; ++n) acc[a][b][m][n] = (f32x4){0.f, 0.f, 0.f, 0.f};
        cur = nxt; cA = nA; cB = nB; ++ui;
        if constexpr (ALIGN_EPI) { if (wr == 1) PG8_BAR; }
    }
    PG8_WAIT_V(0);
    if constexpr (!ALIGN_EPI) { if (wr == 0) PG8_BAR; }
    PG8_BAR;
    if constexpr (Epi::AFTER_DRAIN) { E.fused(acc, cur, wr, wc, fr, fq, lds, wid, lane); S.done(cur); }
#undef PG8_SA
#undef PG8_SB
#undef PG8_STAGE
#undef PG8_LDA
#undef PG8_LDB
#undef PG8_MMA
#undef PG8_WAIT_V
#undef PG8_WAIT_L
#undef PG8_BAR
#undef PG8_SCHED
}

}

constexpr int D = 1024, NB = 8, SEQ = 2048, DEPTH = 4, LEAD = 128, FIRSTV = 112, LT = LEAD + SEQ, NTOK = NB * LT;
constexpr int WIN = 3584, FFD = 2816, FFE = 3584, NE = 8, MAXSLOT = 36864;
constexpr float EPS = 1e-6f;
constexpr int NPHASE = 1 + 8 * DEPTH;

constexpr size_t MiB = 1u << 20;
constexpr size_t WS_CTL = 0, CTL_ZERO_BYTES = MiB;
constexpr size_t WS_TAB = 1 * MiB;
constexpr size_t WS_WIN = 2 * MiB;
constexpr size_t WS_WOUT = WS_WIN + 28 * MiB;
constexpr size_t WS_WD13 = WS_WOUT + 8 * MiB;
constexpr size_t WS_WD2 = WS_WD13 + 22 * MiB;
constexpr size_t WS_WM13 = WS_WD2 + 11 * MiB;
constexpr size_t WS_WM2 = WS_WM13 + 224 * MiB;
constexpr size_t WS_H = WS_WM2 + 112 * MiB;
constexpr size_t WS_HB = WS_H + 68 * MiB;
constexpr size_t WS_SSQ = WS_HB + 34 * MiB;
constexpr size_t WS_ROUTE = WS_SSQ + 2 * MiB;
constexpr size_t WS_ACT = WS_ROUTE + 2 * MiB;
constexpr size_t WS_XG = WS_ACT + 252 * MiB;
constexpr size_t WS_END = WS_XG + 72 * MiB;
constexpr size_t ACT_PROJ = 0, ACT_LOGF = 119 * MiB, ACT_MIX = 153 * MiB;
constexpr size_t TAB_LB = 0, TAB_BIAS = 8192, TAB_LAM = 12288, TAB_SUBLN = 12544, TAB_HGNW = 14592, TAB_RF = 20480, TAB_FNORM = 20480 + 65536;
constexpr size_t ROUTE_INFO = 0, ROUTE_LIST = 640 * 1024, ROUTE_RSTD = 1280 * 1024;
constexpr int CW_TMO = 0, CW_BAR = 4096, CW_CNT = 8192;

constexpr int RING_BYTES = 131072, MISC_OFF = RING_BYTES + 320, LDS_BYTES = 147456;

#define GAS __attribute__((address_space(1)))
#define LAS __attribute__((address_space(3)))
typedef unsigned short bf16;
typedef unsigned v4u __attribute__((ext_vector_type(4)));
typedef unsigned v2u __attribute__((ext_vector_type(2)));
typedef float f32x4 __attribute__((ext_vector_type(4)));
typedef GAS unsigned gu32;
#define RLX_AGENT __ATOMIC_RELAXED, __HIP_MEMORY_SCOPE_AGENT
#define LDS_WAIT() asm volatile("s_waitcnt lgkmcnt(0)" ::: "memory")
__device__ __forceinline__ unsigned f2bf(float f) { unsigned u = __builtin_bit_cast(unsigned, f); return (u + 0x7fffu + ((u >> 16) & 1u)) >> 16; }
__device__ __forceinline__ unsigned pk2(float lo, float hi) { return f2bf(lo) | (f2bf(hi) << 16); }
__device__ __forceinline__ float bf_lo(unsigned w) { return __builtin_bit_cast(float, w << 16); }
__device__ __forceinline__ float bf_hi(unsigned w) { return __builtin_bit_cast(float, w & 0xffff0000u); }
__device__ __forceinline__ float silu_f(float x) { return x / (1.f + __expf(-x)); }
__device__ __forceinline__ float wave_sum(float v) {
#pragma unroll
    for (int o = 1; o < 64; o <<= 1) v += __shfl_xor(v, o);
    return v;
}

#define XB_TMO      128
#define XB_XCNT(j)  (256  + 64 * (j))
#define XB_XSUB(j)  (1280 + 64 * (j))
#define XB_XGEN(j)  (2304 + 64 * (j))
#define XB_TOP      3328
#define XB_TOPGEN   3392
#define XCD_BAR_WORDS 3456
#define XB_SPIN_CAP (1u << 18)

__device__ __forceinline__ unsigned xb_ld(unsigned* p)              { return __hip_atomic_load(p, __ATOMIC_RELAXED, __HIP_MEMORY_SCOPE_AGENT); }
__device__ __forceinline__ unsigned xb_add(unsigned* p, unsigned v) { return __hip_atomic_fetch_add(p, v, __ATOMIC_RELAXED, __HIP_MEMORY_SCOPE_AGENT); }
__device__ __forceinline__ unsigned xb_xcc_id() { return (unsigned)__builtin_amdgcn_s_getreg((3 << 11) | 20) & 0xFu; }
#define XB_SPIN(cond, bar) do { unsigned _sp = 0; while (cond) { __builtin_amdgcn_s_sleep(1); \
    if ((++_sp & 255u) == 0u) { if (xb_ld(&(bar)[XB_TMO])) break; if (_sp > XB_SPIN_CAP) { atomicAdd(&(bar)[XB_TMO], 1u); break; } } } } while (0)

struct XcdBarrier {
    unsigned* bar; unsigned x;
    volatile LAS unsigned* st;
};

__device__ __forceinline__ XcdBarrier xcd_barrier_post(unsigned* bar, volatile LAS unsigned* st) {
    XcdBarrier b; b.bar = bar; b.x = xb_xcc_id(); b.st = st;
    if (threadIdx.x == 0) (void)xb_add(&bar[XB_XCNT(b.x)], 1u);
    return b;
}
__device__ __forceinline__ void xcd_barrier_complete(unsigned* bar, unsigned x, unsigned& nloc, unsigned& nx) {
    const unsigned G = gridDim.x * gridDim.y * gridDim.z;
    unsigned sum, cnt, mine, sp = 0u;
    for (;;) {
        sum = 0u; cnt = 0u; mine = 0u;
#pragma unroll
        for (unsigned j = 0; j < 16; ++j) { const unsigned c = xb_ld(&bar[XB_XCNT(j)]); sum += c; cnt += (c > 0u) ? 1u : 0u; mine = (j == x) ? c : mine; }
        if (sum == G) break;
        __builtin_amdgcn_s_sleep(1);
        if ((++sp & 255u) == 0u) { if (xb_ld(&bar[XB_TMO])) break; if (sp > XB_SPIN_CAP) { atomicAdd(&bar[XB_TMO], 1u); break; } }
    }
    nloc = mine > 0u ? mine : 1u; nx = cnt > 0u ? cnt : 1u;
}

__device__ __forceinline__ void xcd_barrier(const XcdBarrier& b) {
    asm volatile("s_waitcnt vmcnt(0)" ::: "memory");
    __syncthreads();
    if (threadIdx.x == 0) {
        unsigned* bar = b.bar;
        __builtin_amdgcn_s_waitcnt(0);
        unsigned nloc = b.st[0], nx = b.st[1];
        if (nloc == 0u) { xcd_barrier_complete(bar, b.x, nloc, nx); b.st[0] = nloc; b.st[1] = nx; }
        const unsigned old = xb_add(&bar[XB_XSUB(b.x)], 1u);
        const unsigned gen = old / nloc;
        if (old + 1u == (gen + 1u) * nloc) {
            __builtin_amdgcn_fence(__ATOMIC_RELEASE, "agent");
            asm volatile("s_waitcnt vmcnt(0)" ::: "memory");
            const unsigned og = xb_add(&bar[XB_TOP], 1u);
            const unsigned tg = og / nx;
            if (og + 1u == (tg + 1u) * nx) xb_add(&bar[XB_TOPGEN], 1u);
            else XB_SPIN(xb_ld(&bar[XB_TOPGEN]) == tg, bar);
            __builtin_amdgcn_fence(__ATOMIC_ACQUIRE, "agent");
            xb_add(&bar[XB_XGEN(b.x)], 1u);
            asm volatile("s_waitcnt vmcnt(0)" ::: "memory");
        } else {
            XB_SPIN(xb_ld(&bar[XB_XGEN(b.x)]) == gen, bar);
            __builtin_amdgcn_fence(__ATOMIC_ACQUIRE, "agent");
            asm volatile("s_waitcnt vmcnt(0)" ::: "memory");
        }
    }
    __syncthreads();
}


static __device__ const unsigned char T5B[129] = {0, 1, 2, 3, 4, 5, 6, 7, 8, 9, 10, 11, 12, 13, 14, 15, 16, 16, 16, 17, 17, 18, 18, 18, 19, 19, 19, 20, 20, 20, 20, 21, 21, 21, 21, 22, 22, 22, 22, 22, 23, 23, 23, 23, 23, 23, 24, 24, 24, 24, 24, 24, 25, 25, 25, 25, 25, 25, 25, 26, 26, 26, 26, 26, 26, 26, 26, 27, 27, 27, 27, 27, 27, 27, 27, 27, 27, 28, 28, 28, 28, 28, 28, 28, 28, 28, 28, 29, 29, 29, 29, 29, 29, 29, 29, 29, 29, 29, 29, 30, 30, 30, 30, 30, 30, 30, 30, 30, 30, 30, 30, 30, 30, 31, 31, 31, 31, 31, 31, 31, 31, 31, 31, 31, 31, 31, 31, 31, 31};

struct Ctx {
    LAS unsigned char* lds;
    int tid, lane, wave, G;
    float* out;
    unsigned char* ws;
    __device__ __forceinline__ gu32* ctl() const { return (gu32*)(ws + WS_CTL); }
    __device__ __forceinline__ float* H() const { return (float*)(ws + WS_H); }
    __device__ __forceinline__ bf16* HB() const { return (bf16*)(ws + WS_HB); }
    __device__ __forceinline__ float* SSQ() const { return (float*)(ws + WS_SSQ); }
    __device__ __forceinline__ bf16* PROJ() const { return (bf16*)(ws + WS_ACT + ACT_PROJ); }
    __device__ __forceinline__ float* LOGF() const { return (float*)(ws + WS_ACT + ACT_LOGF); }
    __device__ __forceinline__ bf16* MIX() const { return (bf16*)(ws + WS_ACT + ACT_MIX); }
    __device__ __forceinline__ bf16* T() const { return (bf16*)(ws + WS_ACT); }
    __device__ __forceinline__ bf16* XG() const { return (bf16*)(ws + WS_XG); }
    __device__ __forceinline__ bf16* Y() const { return (bf16*)(ws + WS_XG); }
    __device__ __forceinline__ float* LB() const { return (float*)(ws + WS_TAB + TAB_LB); }
    __device__ __forceinline__ float* BIAST() const { return (float*)(ws + WS_TAB + TAB_BIAS); }
    __device__ __forceinline__ float* LAM() const { return (float*)(ws + WS_TAB + TAB_LAM); }
    __device__ __forceinline__ float* RF() const { return (float*)(ws + WS_TAB + TAB_RF); }
    __device__ __forceinline__ float* SUBLN() const { return (float*)(ws + WS_TAB + TAB_SUBLN); }
    __device__ __forceinline__ float* HGNW() const { return (float*)(ws + WS_TAB + TAB_HGNW); }
    __device__ __forceinline__ float* FNORM() const { return (float*)(ws + WS_TAB + TAB_FNORM); }
    __device__ __forceinline__ unsigned* TINFO() const { return (unsigned*)(ws + WS_ROUTE + ROUTE_INFO); }
    __device__ __forceinline__ int* LIST() const { return (int*)(ws + WS_ROUTE + ROUTE_LIST); }
    __device__ __forceinline__ float* RSTD() const { return (float*)(ws + WS_ROUTE + ROUTE_RSTD); }
};
struct Args { const float* in[19]; float* out; unsigned char* ws; int ph_lo, ph_hi; };
enum { IN_X = 0, IN_META, IN_RELB, IN_NMIX, IN_WIN, IN_LBL, IN_HGNW, IN_LAMBDA, IN_SUBLN, IN_WOUT, IN_NFFN, IN_DW1, IN_DW3, IN_DW2, IN_ROUTER, IN_MW1, IN_MW3, IN_MW2, IN_FNORM };

__device__ __forceinline__ float row_rstd(const float* ssq, int row) {
    const f32x4* p = (const f32x4*)(ssq + (size_t)row * 16);
    const f32x4 a = p[0], b = p[1], c = p[2], d = p[3];
    const float s = ((a[0] + a[1]) + (a[2] + a[3])) + ((b[0] + b[1]) + (b[2] + b[3])) + ((c[0] + c[1]) + (c[2] + c[3])) + ((d[0] + d[1]) + (d[2] + d[3]));
    return rsqrtf(s * (1.0f / 1024.0f) + EPS);
}
struct EpiProj {
    static constexpr bool PERM = true, AFTER_DRAIN = false;
    bf16* proj; float* logfp; const float* ssq; const float* lb;
    __device__ __forceinline__ void operator()(const pg8::f32x4 (&acc)[2][2][4][2], const pg8::Unit& u, int wr, int wc, int fr, int fq) const {
        const int grp = u.pn >> 1;
        const int row0 = u.pm * 256 + wr * 64 + fr, colb = u.pn * 256 + wc * 32 + 8 * fq;
#pragma unroll
        for (int ai = 0; ai < 2; ++ai)
#pragma unroll
            for (int m = 0; m < 4; ++m) {
                const int row = row0 + ai * 128 + m * 16;
                const float r = row_rstd(ssq, row);
                const bool valid = (row % LT) >= FIRSTV;
#pragma unroll
                for (int bj = 0; bj < 2; ++bj) {
                    const int c0 = colb + bj * 128;
                    float x[8];
#pragma unroll
                    for (int j = 0; j < 4; ++j) { x[j] = acc[ai][bj][m][0][j] * r; x[4 + j] = acc[ai][bj][m][1][j] * r; }
                    if (grp == 0 || grp == 3) {
#pragma unroll
                        for (int j = 0; j < 8; ++j) x[j] = silu_f(x[j]);
                    } else if (grp == 4) {
#pragma unroll
                        for (int j = 0; j < 8; ++j) x[j] *= 0.125f;
                    } else if (grp == 1) {
                        const int cc = c0 - 512;
                        const f32x4 l0 = *(const f32x4*)(lb + cc), l1 = *(const f32x4*)(lb + cc + 4);
                        float lf[8];
#pragma unroll
                        for (int j = 0; j < 8; ++j) {
                            const float lbv = j < 4 ? l0[j & 3] : l1[j & 3];
                            const float xx = x[j];
                            const float ls = fminf(xx, 0.f) - log1pf(expf(-fabsf(xx)));
                            const float sg = expf(ls);
                            float lgf = (lbv > 0.f) ? logf(lbv + (1.f - lbv) * sg) : ls;
                            float kk = (1.f - lbv) * expf(ls - xx);
                            if (!valid) { lgf = 0.f; kk = 0.f; }
                            lf[j] = lgf; x[j] = kk;
                        }
                        float* lp = logfp + (size_t)row * 512 + cc;
                        *(f32x4*)lp = (f32x4){lf[0], lf[1], lf[2], lf[3]}; *(f32x4*)(lp + 4) = (f32x4){lf[4], lf[5], lf[6], lf[7]};
                    }
                    v4u w; w.x = pg8::cvt_pk_bf16(x[0], x[1]); w.y = pg8::cvt_pk_bf16(x[2], x[3]); w.z = pg8::cvt_pk_bf16(x[4], x[5]); w.w = pg8::cvt_pk_bf16(x[6], x[7]);
                    *(v4u*)(proj + (size_t)row * WIN + c0) = w;
                }
            }
    }
};
struct EpiResid {
    static constexpr bool PERM = true, AFTER_DRAIN = false;
    float* H; bf16* HB; float* ssq;
    __device__ __forceinline__ void operator()(const pg8::f32x4 (&acc)[2][2][4][2], const pg8::Unit& u, int wr, int wc, int fr, int fq) const {
        const int row0 = u.pm * 256 + wr * 64 + fr, colb = u.pn * 256 + wc * 32 + 8 * fq;
#pragma unroll
        for (int ai = 0; ai < 2; ++ai)
#pragma unroll
            for (int m = 0; m < 4; ++m) {
                const int row = row0 + ai * 128 + m * 16;
                float s = 0.f;
#pragma unroll
                for (int bj = 0; bj < 2; ++bj) {
                    const int c0 = colb + bj * 128;
                    float* hp = H + (size_t)row * D + c0;
                    f32x4 h0 = *(const f32x4*)hp, h1 = *(const f32x4*)(hp + 4);
                    h0 = h0 + acc[ai][bj][m][0]; h1 = h1 + acc[ai][bj][m][1];
                    *(f32x4*)hp = h0; *(f32x4*)(hp + 4) = h1;
                    s += (h0[0] * h0[0] + h0[1] * h0[1]) + (h0[2] * h0[2] + h0[3] * h0[3]) + (h1[0] * h1[0] + h1[1] * h1[1]) + (h1[2] * h1[2] + h1[3] * h1[3]);
                    v4u w; w.x = pg8::cvt_pk_bf16(h0[0], h0[1]); w.y = pg8::cvt_pk_bf16(h0[2], h0[3]); w.z = pg8::cvt_pk_bf16(h1[0], h1[1]); w.w = pg8::cvt_pk_bf16(h1[2], h1[3]);
                    *(v4u*)(HB + (size_t)row * D + c0) = w;
                }
                s += __shfl_xor(s, 16); s += __shfl_xor(s, 32);
                if (fq == 0) ssq[(size_t)row * 16 + u.pn * 4 + wc] = s;
            }
    }
};
struct EpiGLU {
    static constexpr bool PERM = true, AFTER_DRAIN = false;
    bf16* T; int ldt; const float* ssq;
    __device__ __forceinline__ void operator()(const pg8::f32x4 (&acc)[2][2][4][2], const pg8::Unit& u, int wr, int wc, int fr, int fq) const {
        const int row0 = u.pm * 256 + wr * 64 + fr, colb = u.pn * 128 + wc * 32 + 8 * fq;
#pragma unroll
        for (int ai = 0; ai < 2; ++ai)
#pragma unroll
            for (int m = 0; m < 4; ++m) {
                const int row = row0 + ai * 128 + m * 16;
                const float r = ssq ? row_rstd(ssq, row) : 1.f;
                float x[8];
#pragma unroll
                for (int j = 0; j < 4; ++j) { x[j] = silu_f(acc[ai][0][m][0][j] * r) * (acc[ai][1][m][0][j] * r); x[4 + j] = silu_f(acc[ai][0][m][1][j] * r) * (acc[ai][1][m][1][j] * r); }
                v4u w; w.x = pg8::cvt_pk_bf16(x[0], x[1]); w.y = pg8::cvt_pk_bf16(x[2], x[3]); w.z = pg8::cvt_pk_bf16(x[4], x[5]); w.w = pg8::cvt_pk_bf16(x[6], x[7]);
                *(v4u*)(T + (size_t)row * ldt + colb) = w;
            }
    }
};
struct EpiY {
    static constexpr bool PERM = true, AFTER_DRAIN = false;
    bf16* Y;
    __device__ __forceinline__ void operator()(const pg8::f32x4 (&acc)[2][2][4][2], const pg8::Unit& u, int wr, int wc, int fr, int fq) const {
        const int row0 = u.pm * 256 + wr * 64 + fr, colb = u.pn * 256 + wc * 32 + 8 * fq;
#pragma unroll
        for (int ai = 0; ai < 2; ++ai)
#pragma unroll
            for (int m = 0; m < 4; ++m) {
                const int row = row0 + ai * 128 + m * 16;
#pragma unroll
                for (int bj = 0; bj < 2; ++bj) {
                    const pg8::f32x4 a = acc[ai][bj][m][0], b = acc[ai][bj][m][1];
                    v4u w; w.x = pg8::cvt_pk_bf16(a[0], a[1]); w.y = pg8::cvt_pk_bf16(a[2], a[3]); w.z = pg8::cvt_pk_bf16(b[0], b[1]); w.w = pg8::cvt_pk_bf16(b[2], b[3]);
                    *(v4u*)(Y + (size_t)row * D + colb + bj * 128) = w;
                }
            }
    }
};

__device__ __forceinline__ void transpose_item(const float* W, const float* fold, int K, int N, bf16* WT, int k0, int n0, int drow0, LAS float* scr, int lane) {
#pragma unroll 8
    for (int i = 0; i < 32; ++i) { const int kk = 2 * i + (lane >> 5); const float f = fold ? fold[k0 + kk] : 1.f; scr[kk * 33 + (lane & 31)] = W[(size_t)(k0 + kk) * N + n0 + (lane & 31)] * f; }
    LDS_WAIT(); asm volatile("" ::: "memory");
    const int c = lane & 7;
#pragma unroll
    for (int j = 0; j < 4; ++j) { const int n = (lane >> 3) + 8 * j; const LAS float* s = scr + (8 * c) * 33 + n;
        v4u o; o.x = pk2(s[0 * 33], s[1 * 33]); o.y = pk2(s[2 * 33], s[3 * 33]); o.z = pk2(s[4 * 33], s[5 * 33]); o.w = pk2(s[6 * 33], s[7 * 33]);
        *(GAS v4u*)(WT + (size_t)(drow0 + n) * K + k0 + 8 * c) = o; }
    LDS_WAIT(); asm volatile("" ::: "memory");
}
__device__ __forceinline__ void prologue_phase(Ctx& C, const Args& A) {
    LAS float* scr = (LAS float*)(C.lds + C.wave * 16384);
    const int gw = blockIdx.x * 8 + C.wave, NGW = C.G * 8;
    constexpr int I_IN = 16 * 112, I_OUT = 16 * 32, I_D1 = 16 * 88, I_D2 = 44 * 32, I_M1 = 16 * 112, I_M2 = 56 * 32;
    constexpr int N_IN = 4 * I_IN, N_OUT = 4 * I_OUT, N_D1 = 2 * I_D1, N_D2 = 2 * I_D2, N_M1 = 16 * I_M1, N_M2 = 16 * I_M2;
    constexpr int NITEMS = N_IN + N_OUT + 2 * N_D1 + N_D2 + 2 * N_M1 + N_M2;
    for (int it = gw; it < NITEMS; it += NGW) {
        int r = it;
        const float* W; const float* fold = nullptr; bf16* WT; int K, N, glu = -1, loc;
        if (r < N_IN) { const int l = r / I_IN; loc = r % I_IN; W = A.in[IN_WIN] + (size_t)l * D * WIN; fold = A.in[IN_NMIX] + l * D; WT = (bf16*)(C.ws + WS_WIN) + (size_t)l * WIN * D; K = D; N = WIN; }
        else if ((r -= N_IN) < N_OUT) { const int l = r / I_OUT; loc = r % I_OUT; W = A.in[IN_WOUT] + (size_t)l * D * D; WT = (bf16*)(C.ws + WS_WOUT) + (size_t)l * D * D; K = D; N = D; }
        else if ((r -= N_OUT) < N_D1) { const int i = r / I_D1; loc = r % I_D1; W = A.in[IN_DW1] + (size_t)i * D * FFD; fold = A.in[IN_NFFN] + (2 * i) * D; WT = (bf16*)(C.ws + WS_WD13) + (size_t)i * 2 * FFD * D; K = D; N = FFD; glu = 0; }
        else if ((r -= N_D1) < N_D1) { const int i = r / I_D1; loc = r % I_D1; W = A.in[IN_DW3] + (size_t)i * D * FFD; fold = A.in[IN_NFFN] + (2 * i) * D; WT = (bf16*)(C.ws + WS_WD13) + (size_t)i * 2 * FFD * D; K = D; N = FFD; glu = 1; }
        else if ((r -= N_D1) < N_D2) { const int i = r / I_D2; loc = r % I_D2; W = A.in[IN_DW2] + (size_t)i * FFD * D; WT = (bf16*)(C.ws + WS_WD2) + (size_t)i * D * FFD; K = FFD; N = D; }
        else if ((r -= N_D2) < N_M1) { const int ie = r / I_M1; loc = r % I_M1; W = A.in[IN_MW1] + (size_t)ie * D * FFE; fold = A.in[IN_NFFN] + (2 * (ie >> 3) + 1) * D; WT = (bf16*)(C.ws + WS_WM13) + (size_t)ie * 2 * FFE * D; K = D; N = FFE; glu = 0; }
        else if ((r -= N_M1) < N_M1) { const int ie = r / I_M1; loc = r % I_M1; W = A.in[IN_MW3] + (size_t)ie * D * FFE; fold = A.in[IN_NFFN] + (2 * (ie >> 3) + 1) * D; WT = (bf16*)(C.ws + WS_WM13) + (size_t)ie * 2 * FFE * D; K = D; N = FFE; glu = 1; }
        else { r -= N_M1; const int ie = r / I_M2; loc = r % I_M2; W = A.in[IN_MW2] + (size_t)ie * FFE * D; WT = (bf16*)(C.ws + WS_WM2) + (size_t)ie * D * FFE; K = FFE; N = D; }
        const int nblk = N / 32, kb = loc / nblk, nb = loc % nblk, k0 = 64 * kb, n0 = 32 * nb;
        const int drow0 = (glu < 0) ? n0 : ((n0 >> 7) * 256 + glu * 128 + (n0 & 127));
        transpose_item(W, fold, K, N, WT, k0, n0, drow0, scr, C.lane);
    }
    for (int row = gw; row < NTOK; row += NGW) {
        const int b = row / LT, t = row % LT;
        f32x4 v[4]; float s = 0.f;
#pragma unroll
        for (int j = 0; j < 4; ++j) {
            const int col = 4 * C.lane + 256 * j;
            if (t < FIRSTV) v[j] = (f32x4){0.f, 0.f, 0.f, 0.f};
            else if (t < LEAD) v[j] = *(const f32x4*)(A.in[IN_META] + (size_t)(t - FIRSTV) * D + col);
            else v[j] = *(const f32x4*)(A.in[IN_X] + ((size_t)b * SEQ + (t - LEAD)) * D + col);
            s += (v[j][0] * v[j][0] + v[j][1] * v[j][1]) + (v[j][2] * v[j][2] + v[j][3] * v[j][3]);
            *(f32x4*)(C.H() + (size_t)row * D + col) = v[j];
            v2u w; w.x = pk2(v[j][0], v[j][1]); w.y = pk2(v[j][2], v[j][3]);
            *(v2u*)(C.HB() + (size_t)row * D + col) = w;
        }
        s = wave_sum(s);
        if (C.lane < 16) C.SSQ()[(size_t)row * 16 + C.lane] = (C.lane == 0) ? s : 0.f;
    }
    if (blockIdx.x == 0) {
        const int tid = C.tid;
        {
            const float* lg = A.in[IN_LBL];
            const float a0 = lg[tid], a1 = lg[512 + tid], a2 = lg[1024 + tid], a3 = lg[1536 + tid];
            const float mx = fmaxf(fmaxf(a0, a1), fmaxf(a2, a3));
            const float e0 = expf(a0 - mx), e1 = expf(a1 - mx), e2 = expf(a2 - mx), e3 = expf(a3 - mx);
            const float inv = 1.f / (((e0 + e1) + e2) + e3);
            const float p0 = e0 * inv, p1 = e1 * inv, p2 = e2 * inv, p3 = e3 * inv;
            const float c0 = p0, c1 = c0 + p1, c2 = c1 + p2, c3 = c2 + p3;
            C.LB()[tid] = 0.f;
            C.LB()[512 + tid] = fminf(fmaxf(c1 - c0, 0.f), 0.999f);
            C.LB()[1024 + tid] = fminf(fmaxf(c2 - c0, 0.f), 0.999f);
            C.LB()[1536 + tid] = fminf(fmaxf(c3 - c0, 0.f), 0.999f);
        }
        for (int i = tid; i < 4 * 132; i += 512) { const int h = i / 132, d = i % 132; C.BIAST()[i] = (d <= 128) ? A.in[IN_RELB][T5B[d] * 4 + h] : 0.f; }
        if (tid < 4) {
            const float* lv = A.in[IN_LAMBDA] + tid * 256;
            float s01 = 0.f, s23 = 0.f;
            for (int j = 0; j < 64; ++j) { s01 += lv[j] * lv[64 + j]; s23 += lv[128 + j] * lv[192 + j]; }
            const float li = 0.8f - 0.6f * expf(-0.3f * (float)tid);
            C.LAM()[tid * 2] = expf(s01) - expf(s23) + li; C.LAM()[tid * 2 + 1] = li;
        }
        if (tid < 512) { C.SUBLN()[tid] = A.in[IN_SUBLN][tid]; C.HGNW()[tid] = A.in[IN_HGNW][tid]; C.FNORM()[tid] = A.in[IN_FNORM][tid]; C.FNORM()[512 + tid] = A.in[IN_FNORM][512 + tid]; }
        for (int i = tid; i < 2 * 8 * 1024; i += 512) { const int li = i >> 13, e = (i >> 10) & 7, k = i & 1023; C.RF()[i] = A.in[IN_NFFN][(2 * li + 1) * D + k] * A.in[IN_ROUTER][(size_t)li * D * NE + k * NE + e]; }
    }
}

__device__ __forceinline__ void attn_naive_unit(Ctx& C, int l, int b, int h, int qi) {
    LAS float* Ks = (LAS float*)C.lds;
    LAS float* Vs = Ks + 64 * 64;
    LAS float* biasl = Vs + 64 * 128;
    LAS float* red = biasl + 132;
    const int tid = C.tid, r = tid & 127, part = tid >> 7;
    const int tq = qi * 128 + r; const size_t row = (size_t)b * LT + tq;
    if (tid < 132) biasl[tid] = C.BIAST()[h * 132 + tid];
    const float lam = C.LAM()[l * 2], lam_init = C.LAM()[l * 2 + 1];
    float O0[32];
#pragma unroll
    for (int c = 0; c < 2; ++c) {
        float q[64];
        {
            const bf16* qp = C.PROJ() + row * WIN + 2048 + h * 128 + c * 64;
#pragma unroll
            for (int j = 0; j < 8; ++j) { const v4u w = *(const v4u*)(qp + 8 * j);
                q[8 * j + 0] = bf_lo(w.x); q[8 * j + 1] = bf_hi(w.x); q[8 * j + 2] = bf_lo(w.y); q[8 * j + 3] = bf_hi(w.y);
                q[8 * j + 4] = bf_lo(w.z); q[8 * j + 5] = bf_hi(w.z); q[8 * j + 6] = bf_lo(w.w); q[8 * j + 7] = bf_hi(w.w); }
        }
        float o[32];
#pragma unroll
        for (int j = 0; j < 32; ++j) o[j] = 0.f;
        float mrun = -1e30f, lsum = 0.f;
        for (int jt = 1; jt <= 2 * qi + 1; ++jt) {
            __syncthreads();
            {
                const int kk = tid >> 3, d0 = (tid & 7) * 8;
                const size_t krow = (size_t)b * LT + jt * 64 + kk;
                const v4u w = *(const v4u*)(C.PROJ() + krow * WIN + 2560 + h * 128 + c * 64 + d0);
                LAS float* kd = Ks + kk * 64 + d0;
                kd[0] = bf_lo(w.x); kd[1] = bf_hi(w.x); kd[2] = bf_lo(w.y); kd[3] = bf_hi(w.y); kd[4] = bf_lo(w.z); kd[5] = bf_hi(w.z); kd[6] = bf_lo(w.w); kd[7] = bf_hi(w.w);
                const int v0 = (tid & 7) * 16;
                const v4u wa = *(const v4u*)(C.PROJ() + krow * WIN + 3072 + h * 128 + v0), wb = *(const v4u*)(C.PROJ() + krow * WIN + 3072 + h * 128 + v0 + 8);
                LAS float* vd = Vs + kk * 128 + v0;
                vd[0] = bf_lo(wa.x); vd[1] = bf_hi(wa.x); vd[2] = bf_lo(wa.y); vd[3] = bf_hi(wa.y); vd[4] = bf_lo(wa.z); vd[5] = bf_hi(wa.z); vd[6] = bf_lo(wa.w); vd[7] = bf_hi(wa.w);
                vd[8] = bf_lo(wb.x); vd[9] = bf_hi(wb.x); vd[10] = bf_lo(wb.y); vd[11] = bf_hi(wb.y); vd[12] = bf_lo(wb.z); vd[13] = bf_hi(wb.z); vd[14] = bf_lo(wb.w); vd[15] = bf_hi(wb.w);
            }
            __syncthreads();
            for (int kk = 0; kk < 64; ++kk) {
                const int key = jt * 64 + kk;
                if (key <= tq && key >= FIRSTV) {
                    const LAS f32x4* kr = (const LAS f32x4*)(Ks + kk * 64);
                    float s = 0.f;
#pragma unroll
                    for (int j = 0; j < 16; ++j) { const f32x4 kv = kr[j]; s += q[4 * j] * kv[0] + q[4 * j + 1] * kv[1] + q[4 * j + 2] * kv[2] + q[4 * j + 3] * kv[3]; }
                    const int dist = tq - key;
                    s += biasl[dist < 128 ? dist : 128];
                    const float mn = fmaxf(mrun, s), sc = __expf(mrun - mn), p = __expf(s - mn);
                    lsum = lsum * sc + p; mrun = mn;
                    const LAS f32x4* vr = (const LAS f32x4*)(Vs + kk * 128 + 32 * part);
#pragma unroll
                    for (int j = 0; j < 8; ++j) { const f32x4 vv = vr[j]; o[4 * j] = o[4 * j] * sc + p * vv[0]; o[4 * j + 1] = o[4 * j + 1] * sc + p * vv[1]; o[4 * j + 2] = o[4 * j + 2] * sc + p * vv[2]; o[4 * j + 3] = o[4 * j + 3] * sc + p * vv[3]; }
                }
            }
        }
        const float inv = lsum > 0.f ? 1.f / lsum : 0.f;
        if (c == 0) {
#pragma unroll
            for (int j = 0; j < 32; ++j) O0[j] = o[j] * inv;
        } else {
#pragma unroll
            for (int j = 0; j < 32; ++j) O0[j] = O0[j] - lam * (o[j] * inv);
        }
    }
    float ss = 0.f;
#pragma unroll
    for (int j = 0; j < 32; ++j) ss += O0[j] * O0[j];
    __syncthreads();
    red[part * 128 + r] = ss;
    __syncthreads();
    const float tot = (red[r] + red[128 + r]) + (red[256 + r] + red[384 + r]);
    const float rs = rsqrtf(tot * (1.0f / 128.0f) + EPS) * (1.f - lam_init);
    const float* sw = C.SUBLN() + l * 128 + 32 * part;
    bf16* op = C.MIX() + row * D + 512 + h * 128 + 32 * part;
#pragma unroll
    for (int j = 0; j < 4; ++j) {
        v4u w;
        w.x = pk2(O0[8 * j + 0] * rs * sw[8 * j + 0], O0[8 * j + 1] * rs * sw[8 * j + 1]); w.y = pk2(O0[8 * j + 2] * rs * sw[8 * j + 2], O0[8 * j + 3] * rs * sw[8 * j + 3]);
        w.z = pk2(O0[8 * j + 4] * rs * sw[8 * j + 4], O0[8 * j + 5] * rs * sw[8 * j + 5]); w.w = pk2(O0[8 * j + 6] * rs * sw[8 * j + 6], O0[8 * j + 7] * rs * sw[8 * j + 7]);
        *(v4u*)(op + 8 * j) = w;
    }
    __syncthreads();
}
__device__ __forceinline__ void hgrn_naive_unit(Ctx& C, int l, int b, int h) {
    LAS float* qf = (LAS float*)C.lds;
    LAS float* kf = qf + 2048; LAS float* ff = kf + 2048; LAS float* vv = ff + 2048; LAS float* gg = vv + 2048;
    LAS float* opart = gg + 2048;
    const int tid = C.tid, dv = tid & 127, qd = tid >> 7;
    const int ltok = tid >> 5, c4 = (tid & 31) * 4;
    float S[32];
#pragma unroll
    for (int j = 0; j < 32; ++j) S[j] = 0.f;
    const float* nw = C.HGNW() + l * 128;
    for (int tb = 0; tb < LT / 16; ++tb) {
        const size_t row = (size_t)b * LT + tb * 16 + ltok;
        {
            const bf16* pp = C.PROJ() + row * WIN + h * 128 + c4;
            const v2u wq = *(const v2u*)pp, wk = *(const v2u*)(pp + 512), wv = *(const v2u*)(pp + 1024), wg = *(const v2u*)(pp + 1536);
            const f32x4 lf = *(const f32x4*)(C.LOGF() + row * 512 + h * 128 + c4);
            const int o = ltok * 128 + c4;
            qf[o] = bf_lo(wq.x); qf[o + 1] = bf_hi(wq.x); qf[o + 2] = bf_lo(wq.y); qf[o + 3] = bf_hi(wq.y);
            kf[o] = bf_lo(wk.x); kf[o + 1] = bf_hi(wk.x); kf[o + 2] = bf_lo(wk.y); kf[o + 3] = bf_hi(wk.y);
            vv[o] = bf_lo(wv.x); vv[o + 1] = bf_hi(wv.x); vv[o + 2] = bf_lo(wv.y); vv[o + 3] = bf_hi(wv.y);
            gg[o] = bf_lo(wg.x); gg[o + 1] = bf_hi(wg.x); gg[o + 2] = bf_lo(wg.y); gg[o + 3] = bf_hi(wg.y);
            ff[o] = expf(lf[0]); ff[o + 1] = expf(lf[1]); ff[o + 2] = expf(lf[2]); ff[o + 3] = expf(lf[3]);
        }
        __syncthreads();
        for (int tok = 0; tok < 16; ++tok) {
            const float v = vv[tok * 128 + dv];
            const LAS f32x4* fp = (const LAS f32x4*)(ff + tok * 128 + 32 * qd);
            const LAS f32x4* kp = (const LAS f32x4*)(kf + tok * 128 + 32 * qd);
            const LAS f32x4* qp = (const LAS f32x4*)(qf + tok * 128 + 32 * qd);
            float a = 0.f;
#pragma unroll
            for (int j = 0; j < 8; ++j) {
                const f32x4 f4 = fp[j], k4 = kp[j], q4 = qp[j];
#pragma unroll
                for (int i = 0; i < 4; ++i) { S[4 * j + i] = f4[i] * S[4 * j + i] + k4[i] * v; a += q4[i] * S[4 * j + i]; }
            }
            opart[(tok * 4 + qd) * 128 + dv] = a;
        }
        __syncthreads();
        {
            float o[4]; float ss = 0.f;
#pragma unroll
            for (int i = 0; i < 4; ++i) { o[i] = (opart[(ltok * 4 + 0) * 128 + c4 + i] + opart[(ltok * 4 + 1) * 128 + c4 + i]) + (opart[(ltok * 4 + 2) * 128 + c4 + i] + opart[(ltok * 4 + 3) * 128 + c4 + i]); ss += o[i] * o[i]; }
#pragma unroll
            for (int m = 1; m < 32; m <<= 1) ss += __shfl_xor(ss, m);
            const float rs = rsqrtf(ss * (1.0f / 128.0f) + EPS);
            const int oo = ltok * 128 + c4;
            v2u w; w.x = pk2(o[0] * rs * nw[c4] * gg[oo], o[1] * rs * nw[c4 + 1] * gg[oo + 1]); w.y = pk2(o[2] * rs * nw[c4 + 2] * gg[oo + 2], o[3] * rs * nw[c4 + 3] * gg[oo + 3]);
            *(v2u*)(C.MIX() + row * D + h * 128 + c4) = w;
        }
        __syncthreads();
    }
}
__device__ __forceinline__ void mixer_phase_naive(Ctx& C, int l) {
    for (int u = blockIdx.x; u < 17 * 32; u += C.G) { const int qi = 16 - u / 32, bh = u % 32; attn_naive_unit(C, l, bh >> 2, bh & 3, qi); }
    for (int u = C.G - 1 - (int)blockIdx.x; u < 32; u += C.G) hgrn_naive_unit(C, l, u >> 2, u & 3);
}

constexpr int RMAX = 128;
__device__ __forceinline__ void route_phase(Ctx& C, int li) {
    LAS float* rf = (LAS float*)C.lds;
    LAS int* lcnt = (LAS int*)(C.lds + 32768);
    LAS int* lbase = lcnt + 8;
    LAS int* ti = lbase + 8;
    LAS float* tf = (LAS float*)(ti + RMAX * 4);
    const int tid = C.tid, lane = C.lane;
    for (int i = tid; i < 8192; i += 512) rf[i] = C.RF()[li * 8192 + i];
    if (tid < 8) lcnt[tid] = 0;
    __syncthreads();
    const int nrows = (NTOK - (int)blockIdx.x + C.G - 1) / C.G;
    for (int k = C.wave; k < nrows; k += 8) {
        const size_t row = (size_t)blockIdx.x + (size_t)k * C.G;
        f32x4 v[4]; float ss = 0.f;
#pragma unroll
        for (int j = 0; j < 4; ++j) { v[j] = *(const f32x4*)(C.H() + row * D + 4 * lane + 256 * j); ss += (v[j][0] * v[j][0] + v[j][1] * v[j][1]) + (v[j][2] * v[j][2] + v[j][3] * v[j][3]); }
        ss = wave_sum(ss);
        const float rstd = rsqrtf(ss * (1.0f / 1024.0f) + EPS);
        float lg[8];
#pragma unroll
        for (int e = 0; e < 8; ++e) {
            float p = 0.f;
#pragma unroll
            for (int j = 0; j < 4; ++j) { const f32x4 w = *(const LAS f32x4*)(rf + e * 1024 + 4 * lane + 256 * j); p += (v[j][0] * w[0] + v[j][1] * w[1]) + (v[j][2] * w[2] + v[j][3] * w[3]); }
            lg[e] = wave_sum(p) * rstd;
        }
        int e1 = 0; float l1 = lg[0];
#pragma unroll
        for (int e = 1; e < 8; ++e) if (lg[e] > l1) { l1 = lg[e]; e1 = e; }
        int e2 = -1; float l2 = -3.0e38f;
#pragma unroll
        for (int e = 0; e < 8; ++e) if (e != e1 && lg[e] > l2) { l2 = lg[e]; e2 = e; }
        const float g1 = 1.f / (1.f + expf(l2 - l1)), g2 = 1.f - g1;
        if (lane == 0) {
            const int lr1 = __hip_atomic_fetch_add(&lcnt[e1], 1, __ATOMIC_RELAXED, __HIP_MEMORY_SCOPE_WORKGROUP), lr2 = __hip_atomic_fetch_add(&lcnt[e2], 1, __ATOMIC_RELAXED, __HIP_MEMORY_SCOPE_WORKGROUP);
            ti[k * 4 + 0] = e1; ti[k * 4 + 1] = e2; ti[k * 4 + 2] = lr1; ti[k * 4 + 3] = lr2;
            tf[k * 4 + 0] = g1; tf[k * 4 + 1] = g2; tf[k * 4 + 2] = rstd;
        }
    }
    __syncthreads();
    if (tid < 8) lbase[tid] = (int)__hip_atomic_fetch_add(C.ctl() + CW_CNT + (li * 8 + tid) * 64, (unsigned)lcnt[tid], RLX_AGENT);
    __syncthreads();
    for (int k = tid; k < nrows; k += 512) {
        const int row = (int)blockIdx.x + k * C.G;
        const int e1 = ti[k * 4], e2 = ti[k * 4 + 1], r1 = lbase[e1] + ti[k * 4 + 2], r2 = lbase[e2] + ti[k * 4 + 3];
        C.LIST()[(size_t)e1 * NTOK + r1] = row; C.LIST()[(size_t)e2 * NTOK + r2] = row;
        unsigned* inf = C.TINFO() + (size_t)row * 8;
        inf[0] = (unsigned)e1; inf[1] = (unsigned)e2; inf[2] = (unsigned)r1; inf[3] = (unsigned)r2; inf[4] = __builtin_bit_cast(unsigned, tf[k * 4]); inf[5] = __builtin_bit_cast(unsigned, tf[k * 4 + 1]);
        C.RSTD()[row] = tf[k * 4 + 2];
    }
    __syncthreads();
}
__device__ __forceinline__ void load_panels(Ctx& C, int li, LAS int* pst) {
    __syncthreads();
    if (C.tid == 0) { int acc = 0;
        for (int e = 0; e < 8; ++e) { const int c = (int)__hip_atomic_load(C.ctl() + CW_CNT + (li * 8 + e) * 64, RLX_AGENT); pst[e] = acc; pst[16 + e] = c; acc += (c + 255) >> 8; }
        pst[8] = acc; }
    __syncthreads();
}
__device__ __forceinline__ void gather_phase(Ctx& C, int li) {
    LAS int* pst = (LAS int*)C.lds;
    load_panels(C, li, pst);
    const int gw = blockIdx.x * 8 + C.wave, NGW = C.G * 8, lane = C.lane;
    const int nslot = pst[8] * 256;
    for (int s = gw; s < nslot; s += NGW) {
        const int panel = s >> 8; int e = 0;
#pragma unroll
        for (int j = 1; j < 8; ++j) if (panel >= pst[j]) e = j;
        const int rank = s - pst[e] * 256;
        bf16* xp = C.XG() + (size_t)s * D;
        if (rank < pst[16 + e]) {
            const int tok = C.LIST()[(size_t)e * NTOK + rank]; const float r = C.RSTD()[tok];
#pragma unroll
            for (int j = 0; j < 4; ++j) { const f32x4 v = *(const f32x4*)(C.H() + (size_t)tok * D + 4 * lane + 256 * j); v2u w; w.x = pk2(v[0] * r, v[1] * r); w.y = pk2(v[2] * r, v[3] * r); *(v2u*)(xp + 4 * lane + 256 * j) = w; }
        } else {
#pragma unroll
            for (int j = 0; j < 4; ++j) *(v2u*)(xp + 4 * lane + 256 * j) = (v2u){0u, 0u};
        }
    }
}
__device__ __forceinline__ void combine_phase(Ctx& C, int li, bool last) {
    LAS int* pst = (LAS int*)C.lds;
    load_panels(C, li, pst);
    const int gw = blockIdx.x * 8 + C.wave, NGW = C.G * 8, lane = C.lane;
    for (int row = gw; row < NTOK; row += NGW) {
        const unsigned* inf = C.TINFO() + (size_t)row * 8;
        const int e1 = (int)inf[0], e2 = (int)inf[1];
        const size_t s1 = (size_t)pst[e1] * 256 + inf[2], s2 = (size_t)pst[e2] * 256 + inf[3];
        const float g1 = __builtin_bit_cast(float, inf[4]), g2 = __builtin_bit_cast(float, inf[5]);
        f32x4 v[4]; float ss = 0.f;
#pragma unroll
        for (int j = 0; j < 4; ++j) {
            const int col = 4 * lane + 256 * j;
            v[j] = *(const f32x4*)(C.H() + (size_t)row * D + col);
            const v2u a = *(const v2u*)(C.Y() + s1 * D + col), b = *(const v2u*)(C.Y() + s2 * D + col);
            v[j][0] += g1 * bf_lo(a.x) + g2 * bf_lo(b.x); v[j][1] += g1 * bf_hi(a.x) + g2 * bf_hi(b.x);
            v[j][2] += g1 * bf_lo(a.y) + g2 * bf_lo(b.y); v[j][3] += g1 * bf_hi(a.y) + g2 * bf_hi(b.y);
            ss += (v[j][0] * v[j][0] + v[j][1] * v[j][1]) + (v[j][2] * v[j][2] + v[j][3] * v[j][3]);
        }
        ss = wave_sum(ss);
        if (!last) {
#pragma unroll
            for (int j = 0; j < 4; ++j) { const int col = 4 * lane + 256 * j; *(f32x4*)(C.H() + (size_t)row * D + col) = v[j]; v2u w; w.x = pk2(v[j][0], v[j][1]); w.y = pk2(v[j][2], v[j][3]); *(v2u*)(C.HB() + (size_t)row * D + col) = w; }
            if (lane < 16) C.SSQ()[(size_t)row * 16 + lane] = (lane == 0) ? ss : 0.f;
        } else {
            const int b = row / LT, t = row % LT;
            if (t >= LEAD) {
                const float rs = rsqrtf(ss * (1.0f / 1024.0f) + EPS);
#pragma unroll
                for (int j = 0; j < 4; ++j) { const int col = 4 * lane + 256 * j; const f32x4 fw = *(const f32x4*)(C.FNORM() + col);
                    *(f32x4*)(C.out + ((size_t)b * SEQ + (t - LEAD)) * D + col) = (f32x4){v[j][0] * rs * fw[0], v[j][1] * rs * fw[1], v[j][2] * rs * fw[2], v[j][3] * rs * fw[3]}; }
            }
        }
    }
}

__global__ void __launch_bounds__(512, 2) mk_fwd(Args args) {
    extern __shared__ __attribute__((aligned(16))) unsigned char lds[];
    Ctx C;
    C.lds = (LAS unsigned char*)lds;
    C.tid = threadIdx.x; C.lane = C.tid & 63; C.wave = __builtin_amdgcn_readfirstlane(C.tid >> 6); C.G = gridDim.x;
    unsigned char* ws = args.ws; C.ws = ws; C.out = args.out;
    volatile LAS unsigned* MISC = (volatile LAS unsigned*)(C.lds + MISC_OFF);
    for (int u = C.tid; u < (LDS_BYTES - RING_BYTES) / 4; u += 512) ((LAS unsigned*)(C.lds + RING_BYTES))[u] = 0u;
    __syncthreads();
    const int lo = args.ph_lo, hi = args.ph_hi;
    const bool multi = (hi - lo) > 1;
    XcdBarrier bar; bar.bar = (unsigned*)(C.ctl() + CW_BAR); bar.x = 0; bar.st = nullptr;
    if (multi) bar = xcd_barrier_post((unsigned*)(C.ctl() + CW_BAR), MISC + 8);
#define PHASE_CTX(P) Ctx P = C; { unsigned char* w_ = C.ws; asm volatile("" : "+s"(w_)); P.ws = w_; int t_ = C.tid; asm volatile("" : "+v"(t_)); P.tid = t_; P.lane = t_ & 63; P.wave = __builtin_amdgcn_readfirstlane(t_ >> 6); }
#define IN(k) (lo_l <= (k) && (k) < hi_l)
#define SEAM(k) do { if ((k) + 1 < hi_l) xcd_barrier(bar); } while (0)

    { int lo_l = lo, hi_l = hi; asm volatile("" : "+s"(lo_l), "+s"(hi_l));
      if (IN(0)) { PHASE_CTX(P); prologue_phase(P, args); SEAM(0); } }

    for (int l = 0; l < DEPTH; ++l) {
        int lo_l = lo, hi_l = hi; asm volatile("" : "+s"(lo_l), "+s"(hi_l));
        const int pb = 1 + 8 * l, li = l >> 1; const bool moe = (l & 1) != 0;
        if (IN(pb + 0)) {
            PHASE_CTX(P);
            pg8::Gemm g{P.HB(), (const bf16*)(P.ws + WS_WIN) + (size_t)l * WIN * D, NTOK, WIN, D, 0};
            pg8::StaticOrder S; S.init(NTOK, WIN, P.G, (int)blockIdx.x);
            EpiProj E{P.PROJ(), P.LOGF(), P.SSQ(), P.LB() + l * 512};
            pg8::gemm_phase<EpiProj, pg8::StaticOrder, true, true>(P.lds, g, S, E);
            SEAM(pb + 0);
        }
        if (IN(pb + 1)) { PHASE_CTX(P); mixer_phase_naive(P, l); SEAM(pb + 1); }
        if (IN(pb + 2)) {
            PHASE_CTX(P);
            pg8::Gemm g{P.MIX(), (const bf16*)(P.ws + WS_WOUT) + (size_t)l * D * D, NTOK, D, D, 0};
            pg8::StaticOrder S; S.init(NTOK, D, P.G, (int)blockIdx.x);
            EpiResid E{P.H(), P.HB(), P.SSQ()};
            pg8::gemm_phase<EpiResid, pg8::StaticOrder, true, true>(P.lds, g, S, E);
            SEAM(pb + 2);
        }
        if (!moe) {
            if (IN(pb + 5)) {
                PHASE_CTX(P);
                pg8::Gemm g{P.HB(), (const bf16*)(P.ws + WS_WD13) + (size_t)li * 2 * FFD * D, NTOK, 2 * FFD, D, 0};
                pg8::StaticOrder S; S.init(NTOK, 2 * FFD, P.G, (int)blockIdx.x);
                EpiGLU E{P.T(), FFD, P.SSQ()};
                pg8::gemm_phase<EpiGLU, pg8::StaticOrder, true, true>(P.lds, g, S, E);
                SEAM(pb + 5);
            }
            if (IN(pb + 6)) {
                PHASE_CTX(P);
                pg8::Gemm g{P.T(), (const bf16*)(P.ws + WS_WD2) + (size_t)li * D * FFD, NTOK, D, FFD, 0};
                pg8::StaticOrder S; S.init(NTOK, D, P.G, (int)blockIdx.x);
                EpiResid E{P.H(), P.HB(), P.SSQ()};
                pg8::gemm_phase<EpiResid, pg8::StaticOrder, true, true>(P.lds, g, S, E);
                SEAM(pb + 6);
            }
        } else {
            if (IN(pb + 3)) { PHASE_CTX(P); route_phase(P, li); SEAM(pb + 3); }
            if (IN(pb + 4)) { PHASE_CTX(P); gather_phase(P, li); SEAM(pb + 4); }
            if (IN(pb + 5)) {
                PHASE_CTX(P);
                LAS int* pst = (LAS int*)(P.lds + RING_BYTES + 1024);
                load_panels(P, li, pst);
#define PS(i) __builtin_amdgcn_readfirstlane(pst[i])
                pg8::GroupedOrder S{PS(0), PS(1), PS(2), PS(3), PS(4), PS(5), PS(6), PS(7), PS(8), 2 * FFE / 256, P.G, (int)blockIdx.x};
                pg8::Gemm g{P.XG(), (const bf16*)(P.ws + WS_WM13) + (size_t)li * 8 * 2 * FFE * D, 0, 2 * FFE, D, (size_t)2 * FFE * D * 2};
                EpiGLU E{P.T(), FFE, nullptr};
                pg8::gemm_phase<EpiGLU, pg8::GroupedOrder, true, true>(P.lds, g, S, E);
                SEAM(pb + 5);
            }
            if (IN(pb + 6)) {
                PHASE_CTX(P);
                LAS int* pst = (LAS int*)(P.lds + RING_BYTES + 1024);
                load_panels(P, li, pst);
                pg8::GroupedOrder S{PS(0), PS(1), PS(2), PS(3), PS(4), PS(5), PS(6), PS(7), PS(8), D / 256, P.G, (int)blockIdx.x};
                pg8::Gemm g{P.T(), (const bf16*)(P.ws + WS_WM2) + (size_t)li * 8 * D * FFE, 0, D, FFE, (size_t)D * FFE * 2};
                EpiY E{P.Y()};
                pg8::gemm_phase<EpiY, pg8::GroupedOrder, true, true>(P.lds, g, S, E);
                SEAM(pb + 6);
            }
#undef PS
            if (IN(pb + 7)) { PHASE_CTX(P); combine_phase(P, li, l == DEPTH - 1); SEAM(pb + 7); }
        }
    }
#undef IN
#undef SEAM
#undef PHASE_CTX
}

extern "C" void kernel_launch(void* const* d_in, const int* in_sizes, int n_in, void* d_out, int out_size, void* d_ws, size_t ws_size, hipStream_t stream) {
    static int grid = 0;
    if (grid == 0) {
        if (n_in != 19 || out_size != NB * SEQ * D || ws_size < WS_END) { fprintf(stderr, "kernel_launch: unexpected shapes (n_in %d, out %d, ws %zu < %zu); nothing launched\n", n_in, out_size, ws_size, (size_t)WS_END); grid = -1; return; }
        int dev = 0, cus = 0, per_cu = 0;
        if (hipGetDevice(&dev) != hipSuccess || hipDeviceGetAttribute(&cus, hipDeviceAttributeMultiprocessorCount, dev) != hipSuccess) { grid = -1; return; }
        if (hipFuncSetAttribute((const void*)mk_fwd, hipFuncAttributeMaxDynamicSharedMemorySize, LDS_BYTES) != hipSuccess) { fprintf(stderr, "kernel_launch: hipFuncSetAttribute failed\n"); grid = -1; return; }
        if (hipOccupancyMaxActiveBlocksPerMultiprocessor(&per_cu, (const void*)mk_fwd, 512, LDS_BYTES) != hipSuccess || per_cu < 1) { fprintf(stderr, "kernel_launch: occupancy query says %d blocks per CU\n", per_cu); }
        (void)hipGetLastError();
        grid = cus;
    }
    if (grid < 0) return;
    if (hipMemsetAsync((char*)d_ws + WS_CTL, 0, CTL_ZERO_BYTES, stream) != hipSuccess) return;
    Args a{};
    for (int i = 0; i < 19; ++i) a.in[i] = (const float*)d_in[i];
    a.out = (float*)d_out; a.ws = (unsigned char*)d_ws;
#if MK_ONE_LAUNCH
    a.ph_lo = 0; a.ph_hi = NPHASE;
    hipLaunchKernelGGL(mk_fwd, dim3(grid), dim3(512), LDS_BYTES, stream, a);
#else
    for (int p = 0; p < NPHASE; ++p) {
        if (p > 0) { const int l = (p - 1) / 8, k = (p - 1) % 8; const bool moe = (l & 1) != 0; if (!moe && (k == 3 || k == 4 || k == 7)) continue; }
        a.ph_lo = p; a.ph_hi = p + 1;
        hipLaunchKernelGGL(mk_fwd, dim3(grid), dim3(512), LDS_BYTES, stream, a);
    }
#endif
}
```

```cpp
#include <hip/hip_runtime.h>
#include <cstdio>
#include <cstdint>

#ifndef MK_ONE_LAUNCH
#define MK_ONE_LAUNCH 1
#endif

namespace pg8 {
#define PG8_LAS __attribute__((address_space(3)))
typedef unsigned short bf16_t;
typedef short bf16x8 __attribute__((ext_vector_type(8)));
typedef float f32x4 __attribute__((ext_vector_type(4)));
typedef unsigned u32x4 __attribute__((ext_vector_type(4)));
typedef unsigned u32x2 __attribute__((ext_vector_type(2)));
constexpr int BM = 256, BK = 64, HALF = 128, HTB = HALF * BK * 2  , STAGE_BYTES = 8 * HTB, NXCD = 8, WGM = 8;

__host__ __device__ __forceinline__ int lds_byte(int r, int c) { const int st = (r >> 4) * 2 + (c >> 5), rr = r & 15, cc = c & 31, ob = rr * 64 + cc * 2; return st * 1024 + (ob ^ (((ob >> 9) & 1) << 5)); }
__host__ __device__ __forceinline__ void stage_rc(int b, int& R, int& C) { const int st = b / 1024, sb = b % 1024, swz = sb ^ (((sb >> 9) & 1) << 5); R = (st >> 1) * 16 + swz / 64; C = (st & 1) * 32 + (swz % 64) / 2; }
__host__ __device__ __forceinline__ int perm32(int rho) { const int n = rho >> 4, i = rho & 15; return 8 * (i >> 2) + 4 * n + (i & 3); }

struct Unit { int pm, pn, e; };
struct Gemm { const bf16_t* A; const bf16_t* Bt; int M, N, K; size_t bstride; };

struct StaticOrder {
    int nM, nN, nwg, G, c;
    __host__ __device__ void init(int M, int N, int G_, int c_) { nM = M / BM; nN = N / BM; nwg = nM * nN; G = G_; c = c_; }
    __host__ __device__ bool next(int i, Unit& u) const {
        const long L = (long)i * G + c; if (L >= nwg) return false;
        int wgid = (int)L; { const int q = nwg / NXCD, r = nwg % NXCD, xcd = wgid % NXCD, off = wgid / NXCD; wgid = (xcd < r ? xcd * (q + 1) : r * (q + 1) + (xcd - r) * q) + off; }
        const int nig = WGM * nN, gid = wgid / nig, fm = gid * WGM, gsz = (nM - fm) < WGM ? (nM - fm) : WGM;
        u.pm = fm + ((wgid % nig) % gsz); u.pn = (wgid % nig) / gsz; u.e = 0; return true;
    }
    __device__ __forceinline__ void a_ready(const Unit&) const {}
    __device__ __forceinline__ void done(const Unit&) const {}
};
struct GroupedOrder {
    int p0, p1, p2, p3, p4, p5, p6, p7, p8, nN, G, c;
    __device__ __forceinline__ bool next(int i, Unit& u) const {
        const int L = i * G + c; if (L >= p8 * nN) return false;
        int e = 0, ps = 0, pe = p1;
        if (L >= p1 * nN) { e = 1; ps = p1; pe = p2; }
        if (L >= p2 * nN) { e = 2; ps = p2; pe = p3; }
        if (L >= p3 * nN) { e = 3; ps = p3; pe = p4; }
        if (L >= p4 * nN) { e = 4; ps = p4; pe = p5; }
        if (L >= p5 * nN) { e = 5; ps = p5; pe = p6; }
        if (L >= p6 * nN) { e = 6; ps = p6; pe = p7; }
        if (L >= p7 * nN) { e = 7; ps = p7; pe = p8; }
        const int rem = L - ps * nN, R = pe - ps;
        u.e = e; u.pn = rem / R; u.pm = ps + rem % R; return true;
    }
    __device__ __forceinline__ void a_ready(const Unit&) const {}
    __device__ __forceinline__ void done(const Unit&) const {}
};

__device__ __forceinline__ unsigned cvt_pk_bf16(float lo, float hi) { unsigned r; asm volatile("v_cvt_pk_bf16_f32 %0, %1, %2" : "=v"(r) : "v"(lo), "v"(hi)); return r; }

template <class Epi, class Sched, bool ALIGN_EPI = false, bool SP2 = false>
__device__ __forceinline__ void gemm_phase(PG8_LAS unsigned char* lds, const Gemm g, const Sched& S, const Epi& E) {
    int tid_l = threadIdx.x; asm volatile("" : "+v"(tid_l));
    const int tid = tid_l, wid = __builtin_amdgcn_readfirstlane(tid >> 6), lane = tid & 63, wr = wid >> 2, wc = wid & 3, fr = lane & 15, fq = lane >> 4;
    const int K = g.K, nt = K / BK;
    unsigned voffA[2], voffB[2];
#pragma unroll
    for (int i = 0; i < 2; ++i) { int R, C; stage_rc(tid * 16 + i * 8192, R, C); const int Rb = Epi::PERM ? ((R & ~31) + perm32(R & 31)) : R;
        voffA[i] = (unsigned)(R * K + C) * 2u; voffB[i] = (unsigned)(Rb * K + C) * 2u; }
    const size_t kstep = (size_t)(BK * 2);
    const size_t hstep = (size_t)HALF * K * 2;
    const size_t tstep = 2 * hstep;
    const unsigned ldsw = (unsigned)wid * 1024u;
    const int aoff = lds_byte(wr * 64 + fr, fq * 8), boff = lds_byte(wc * 32 + fr, fq * 8);
#define PG8_SA(b, h) (((b) * 2 + (h)) * HTB)
#define PG8_SB(b, h) ((4 + (b) * 2 + (h)) * HTB)
#define PG8_STAGE(bufoff, gbase, voff) do { _Pragma("unroll") for (int _i = 0; _i < 2; ++_i) \
        __builtin_amdgcn_global_load_lds((const unsigned*)((const char*)(gbase) + (voff)[_i]), (PG8_LAS unsigned*)(lds + (bufoff) + ldsw + _i * 8192), 16, 0, 0); } while (0)
#define PG8_LDA(dst, b, h) do { _Pragma("unroll") for (int m = 0; m < 4; ++m) _Pragma("unroll") for (int k = 0; k < 2; ++k) dst[m][k] = *(const PG8_LAS bf16x8*)(lds + PG8_SA(b, h) + aoff + m * 2048 + k * 1024); } while (0)
#define PG8_LDB(dst, b, h) do { _Pragma("unroll") for (int n = 0; n < 2; ++n) _Pragma("unroll") for (int k = 0; k < 2; ++k) dst[n][k] = *(const PG8_LAS bf16x8*)(lds + PG8_SB(b, h) + boff + n * 2048 + k * 1024); } while (0)
#define PG8_MMA(ai, bj, At, Bt) do { __builtin_amdgcn_s_setprio(1); _Pragma("unroll") for (int m = 0; m < 4; ++m) _Pragma("unroll") for (int n = 0; n < 2; ++n) _Pragma("unroll") for (int k = 0; k < 2; ++k) \
        acc[ai][bj][m][n] = __builtin_amdgcn_mfma_f32_16x16x32_bf16(Bt[n][k], At[m][k], acc[ai][bj][m][n], 0, 0, 0); __builtin_amdgcn_s_setprio(0); } while (0)
#define PG8_WAIT_V(n) asm volatile("s_waitcnt vmcnt(" #n ")" ::: "memory")
#define PG8_WAIT_L(n) asm volatile("s_waitcnt lgkmcnt(" #n ")" ::: "memory")
#define PG8_BAR __builtin_amdgcn_s_barrier()
#define PG8_SCHED __builtin_amdgcn_sched_barrier(0)
    Unit cur, nxt; int ui = 0;
    if (!S.next(0, cur)) return;
    f32x4 acc[2][2][4][2];
#pragma unroll
    for (int a = 0; a < 2; ++a)
#pragma unroll
        for (int b = 0; b < 2; ++b)
#pragma unroll
            for (int m = 0; m < 4; ++m)
#pragma unroll
                for (int n = 0; n < 2; ++n) acc[a][b][m][n] = (f32x4){0.f, 0.f, 0.f, 0.f};
    bf16x8 At[4][2], B0[2][2], B1[2][2];
    const char* cA = (const char*)g.A + (size_t)cur.pm * tstep; const char* cB = (const char*)g.Bt + (size_t)cur.e * g.bstride + (size_t)cur.pn * tstep;
    S.a_ready(cur);
    if constexpr (SP2) {
        PG8_STAGE(PG8_SB(0, 0), cB, voffB); PG8_STAGE(PG8_SB(0, 1), cB + hstep, voffB); PG8_STAGE(PG8_SA(0, 0), cA, voffA); PG8_STAGE(PG8_SA(0, 1), cA + hstep, voffA);
        if (wr == 1) PG8_BAR;
        PG8_WAIT_V(2); PG8_BAR;
        PG8_STAGE(PG8_SB(1, 0), cB + kstep, voffB); PG8_STAGE(PG8_SA(1, 0), cA + kstep, voffA); PG8_STAGE(PG8_SB(1, 1), cB + hstep + kstep, voffB);
        PG8_WAIT_V(6); PG8_BAR;
    } else {
        PG8_STAGE(PG8_SB(0, 0), cB, voffB); PG8_STAGE(PG8_SA(0, 0), cA, voffA); PG8_STAGE(PG8_SB(0, 1), cB + hstep, voffB); PG8_STAGE(PG8_SA(0, 1), cA + hstep, voffA);
        if (wr == 1) PG8_BAR;
        PG8_WAIT_V(4); PG8_BAR;
        PG8_STAGE(PG8_SB(1, 0), cB + kstep, voffB); PG8_STAGE(PG8_SA(1, 0), cA + kstep, voffA); PG8_STAGE(PG8_SB(1, 1), cB + hstep + kstep, voffB);
        PG8_WAIT_V(6); PG8_BAR;
    }
    for (;;) {
        const bool has_next = S.next(ui + 1, nxt);
        const char* nA = has_next ? (const char*)g.A + (size_t)nxt.pm * tstep : cA; const char* nB = has_next ? (const char*)g.Bt + (size_t)nxt.e * g.bstride + (size_t)nxt.pn * tstep : cB;
        for (int t = 0; t < nt; t += 2) {
            const bool last = (t == nt - 2);
            const char* a1 = cA + (size_t)(t + 1) * kstep;
            const char* a2 = last ? nA : cA + (size_t)(t + 2) * kstep; const char* b2 = last ? nB : cB + (size_t)(t + 2) * kstep;
            const char* a3 = a2 + kstep; const char* b3 = b2 + kstep;
            if (last && has_next) S.a_ready(nxt);
            if constexpr (SP2) {
            PG8_LDB(B0, 0, 0); PG8_LDB(B1, 0, 1); PG8_SCHED; PG8_LDA(At, 0, 0); PG8_STAGE(PG8_SA(1, 1), a1 + hstep, voffA);
            PG8_WAIT_V(8); PG8_WAIT_L(0); PG8_BAR; PG8_MMA(0, 0, At, B0); PG8_MMA(0, 1, At, B1); PG8_BAR; PG8_SCHED;
            PG8_LDA(At, 0, 1); PG8_STAGE(PG8_SB(0, 0), b2, voffB); PG8_STAGE(PG8_SB(0, 1), b2 + hstep, voffB); PG8_STAGE(PG8_SA(0, 0), a2, voffA);
            PG8_WAIT_V(8); PG8_WAIT_L(0); PG8_BAR; PG8_MMA(1, 0, At, B0); PG8_MMA(1, 1, At, B1); PG8_BAR; PG8_SCHED;
            PG8_LDB(B0, 1, 0); PG8_LDB(B1, 1, 1); PG8_SCHED; PG8_LDA(At, 1, 0); PG8_STAGE(PG8_SA(0, 1), a2 + hstep, voffA);
            PG8_WAIT_V(8); PG8_WAIT_L(0); PG8_BAR; PG8_MMA(0, 0, At, B0); PG8_MMA(0, 1, At, B1); PG8_BAR; PG8_SCHED;
            PG8_LDA(At, 1, 1); PG8_STAGE(PG8_SB(1, 0), b3, voffB); PG8_STAGE(PG8_SB(1, 1), b3 + hstep, voffB); PG8_STAGE(PG8_SA(1, 0), a3, voffA);
            PG8_WAIT_V(8); PG8_WAIT_L(0); PG8_BAR; PG8_MMA(1, 0, At, B0); PG8_MMA(1, 1, At, B1); PG8_BAR; PG8_SCHED;
            } else {
            PG8_LDB(B0, 0, 0); PG8_SCHED; PG8_LDA(At, 0, 0); PG8_STAGE(PG8_SA(1, 1), a1 + hstep, voffA);
            PG8_WAIT_L(8); PG8_BAR; PG8_WAIT_L(0); PG8_MMA(0, 0, At, B0); PG8_BAR; PG8_SCHED;
            PG8_LDB(B1, 0, 1); PG8_STAGE(PG8_SB(0, 0), b2, voffB);
            PG8_BAR; PG8_WAIT_L(0); PG8_MMA(0, 1, At, B1); PG8_BAR;
            PG8_LDA(At, 0, 1); PG8_STAGE(PG8_SA(0, 0), a2, voffA);
            PG8_BAR; PG8_WAIT_L(0); PG8_MMA(1, 0, At, B0); PG8_BAR; PG8_SCHED;
            PG8_STAGE(PG8_SB(0, 1), b2 + hstep, voffB);
            PG8_WAIT_V(6); PG8_BAR; PG8_MMA(1, 1, At, B1); PG8_BAR;
            PG8_LDB(B0, 1, 0); PG8_SCHED; PG8_LDA(At, 1, 0); PG8_STAGE(PG8_SA(0, 1), a2 + hstep, voffA);
            PG8_WAIT_L(8); PG8_BAR; PG8_WAIT_L(0); PG8_MMA(0, 0, At, B0); PG8_BAR; PG8_SCHED;
            PG8_LDB(B1, 1, 1); PG8_STAGE(PG8_SB(1, 0), b3, voffB);
            PG8_BAR; PG8_WAIT_L(0); PG8_MMA(0, 1, At, B1); PG8_BAR;
            PG8_LDA(At, 1, 1); PG8_STAGE(PG8_SA(1, 0), a3, voffA);
            PG8_BAR; PG8_WAIT_L(0); PG8_MMA(1, 0, At, B0); PG8_BAR; PG8_SCHED;
            PG8_STAGE(PG8_SB(1, 1), b3 + hstep, voffB);
            PG8_WAIT_V(6); PG8_BAR; PG8_MMA(1, 1, At, B1); PG8_BAR;
            }
        }
        if constexpr (ALIGN_EPI) { if (wr == 0) PG8_BAR; }
        if constexpr (!Epi::AFTER_DRAIN) { E(acc, cur, wr, wc, fr, fq); S.done(cur); }
        if (!has_next) break;
#pragma unroll
        for (int a = 0; a < 2; ++a)
#pragma unroll
            for (int b = 0; b < 2; ++b)
#pragma unroll
                for (int m = 0; m < 4; ++m)
#pragma unroll
                    for (int n = 0; n < 2; ++n) acc[a][b][m][n] = (f32x4){0.f, 0.f, 0.f, 0.f};
        cur = nxt; cA = nA; cB = nB; ++ui;
        if constexpr (ALIGN_EPI) { if (wr == 1) PG8_BAR; }
    }
    PG8_WAIT_V(0);
    if constexpr (!ALIGN_EPI) { if (wr == 0) PG8_BAR; }
    PG8_BAR;
    if constexpr (Epi::AFTER_DRAIN) { E.fused(acc, cur, wr, wc, fr, fq, lds, wid, lane); S.done(cur); }
#undef PG8_SA
#undef PG8_SB
#undef PG8_STAGE
#undef PG8_LDA
#undef PG8_LDB
#undef PG8_MMA
#undef PG8_WAIT_V
#undef PG8_WAIT_L
#undef PG8_BAR
#undef PG8_SCHED
}

}

constexpr int D = 1024, NB = 8, SEQ = 2048, DEPTH = 4, LEAD = 128, FIRSTV = 112, LT = LEAD + SEQ, NTOK = NB * LT;
constexpr int WIN = 3584, FFD = 2816, FFE = 3584, NE = 8, MAXSLOT = 36864;
constexpr float EPS = 1e-6f;
constexpr int NPHASE = 1 + 8 * DEPTH;

constexpr size_t MiB = 1u << 20;
constexpr size_t WS_CTL = 0, CTL_ZERO_BYTES = MiB;
constexpr size_t WS_TAB = 1 * MiB;
constexpr size_t WS_WIN = 2 * MiB;
constexpr size_t WS_WOUT = WS_WIN + 28 * MiB;
constexpr size_t WS_WD13 = WS_WOUT + 8 * MiB;
constexpr size_t WS_WD2 = WS_WD13 + 22 * MiB;
constexpr size_t WS_WM13 = WS_WD2 + 11 * MiB;
constexpr size_t WS_WM2 = WS_WM13 + 224 * MiB;
constexpr size_t WS_H = WS_WM2 + 112 * MiB;
constexpr size_t WS_HB = WS_H + 68 * MiB;
constexpr size_t WS_SSQ = WS_HB + 34 * MiB;
constexpr size_t WS_ROUTE = WS_SSQ + 2 * MiB;
constexpr size_t WS_ACT = WS_ROUTE + 2 * MiB;
constexpr size_t WS_XG = WS_ACT + 252 * MiB;
constexpr size_t WS_END = WS_XG + 72 * MiB;
constexpr size_t ACT_PROJ = 0, ACT_LOGF = 119 * MiB, ACT_MIX = 153 * MiB;
constexpr size_t TAB_LB = 0, TAB_BIAS = 8192, TAB_LAM = 12288, TAB_SUBLN = 12544, TAB_HGNW = 14592, TAB_RF = 20480, TAB_FNORM = 20480 + 65536;
constexpr size_t ROUTE_INFO = 0, ROUTE_LIST = 640 * 1024, ROUTE_RSTD = 1280 * 1024;
constexpr int CW_TMO = 0, CW_BAR = 4096, CW_CNT = 8192;

constexpr int RING_BYTES = 131072, MISC_OFF = RING_BYTES + 320, LDS_BYTES = 147456;

#define GAS __attribute__((address_space(1)))
#define LAS __attribute__((address_space(3)))
typedef unsigned short bf16;
typedef unsigned v4u __attribute__((ext_vector_type(4)));
typedef unsigned v2u __attribute__((ext_vector_type(2)));
typedef float f32x4 __attribute__((ext_vector_type(4)));
typedef GAS unsigned gu32;
#define RLX_AGENT __ATOMIC_RELAXED, __HIP_MEMORY_SCOPE_AGENT
#define LDS_WAIT() asm volatile("s_waitcnt lgkmcnt(0)" ::: "memory")
__device__ __forceinline__ unsigned f2bf(float f) { unsigned u = __builtin_bit_cast(unsigned, f); return (u + 0x7fffu + ((u >> 16) & 1u)) >> 16; }
__device__ __forceinline__ unsigned pk2(float lo, float hi) { return f2bf(lo) | (f2bf(hi) << 16); }
__device__ __forceinline__ float bf_lo(unsigned w) { return __builtin_bit_cast(float, w << 16); }
__device__ __forceinline__ float bf_hi(unsigned w) { return __builtin_bit_cast(float, w & 0xffff0000u); }
__device__ __forceinline__ float silu_f(float x) { return x / (1.f + __expf(-x)); }
__device__ __forceinline__ float wave_sum(float v) {
#pragma unroll
    for (int o = 1; o < 64; o <<= 1) v += __shfl_xor(v, o);
    return v;
}

#define XB_TMO      128
#define XB_XCNT(j)  (256  + 64 * (j))
#define XB_XSUB(j)  (1280 + 64 * (j))
#define XB_XGEN(j)  (2304 + 64 * (j))
#define XB_TOP      3328
#define XB_TOPGEN   3392
#define XCD_BAR_WORDS 3456
#define XB_SPIN_CAP (1u << 18)

__device__ __forceinline__ unsigned xb_ld(unsigned* p)              { return __hip_atomic_load(p, __ATOMIC_RELAXED, __HIP_MEMORY_SCOPE_AGENT); }
__device__ __forceinline__ unsigned xb_add(unsigned* p, unsigned v) { return __hip_atomic_fetch_add(p, v, __ATOMIC_RELAXED, __HIP_MEMORY_SCOPE_AGENT); }
__device__ __forceinline__ unsigned xb_xcc_id() { return (unsigned)__builtin_amdgcn_s_getreg((3 << 11) | 20) & 0xFu; }
#define XB_SPIN(cond, bar) do { unsigned _sp = 0; while (cond) { __builtin_amdgcn_s_sleep(1); \
    if ((++_sp & 255u) == 0u) { if (xb_ld(&(bar)[XB_TMO])) break; if (_sp > XB_SPIN_CAP) { atomicAdd(&(bar)[XB_TMO], 1u); break; } } } } while (0)

struct XcdBarrier {
    unsigned* bar; unsigned x;
    volatile LAS unsigned* st;
};

__device__ __forceinline__ XcdBarrier xcd_barrier_post(unsigned* bar, volatile LAS unsigned* st) {
    XcdBarrier b; b.bar = bar; b.x = xb_xcc_id(); b.st = st;
    if (threadIdx.x == 0) (void)xb_add(&bar[XB_XCNT(b.x)], 1u);
    return b;
}
__device__ __forceinline__ void xcd_barrier_complete(unsigned* bar, unsigned x, unsigned& nloc, unsigned& nx) {
    const unsigned G = gridDim.x * gridDim.y * gridDim.z;
    unsigned sum, cnt, mine, sp = 0u;
    for (;;) {
        sum = 0u; cnt = 0u; mine = 0u;
#pragma unroll
        for (unsigned j = 0; j < 16; ++j) { const unsigned c = xb_ld(&bar[XB_XCNT(j)]); sum += c; cnt += (c > 0u) ? 1u : 0u; mine = (j == x) ? c : mine; }
        if (sum == G) break;
        __builtin_amdgcn_s_sleep(1);
        if ((++sp & 255u) == 0u) { if (xb_ld(&bar[XB_TMO])) break; if (sp > XB_SPIN_CAP) { atomicAdd(&bar[XB_TMO], 1u); break; } }
    }
    nloc = mine > 0u ? mine : 1u; nx = cnt > 0u ? cnt : 1u;
}

__device__ __forceinline__ void xcd_barrier(const XcdBarrier& b) {
    asm volatile("s_waitcnt vmcnt(0)" ::: "memory");
    __syncthreads();
    if (threadIdx.x == 0) {
        unsigned* bar = b.bar;
        __builtin_amdgcn_s_waitcnt(0);
        unsigned nloc = b.st[0], nx = b.st[1];
        if (nloc == 0u) { xcd_barrier_complete(bar, b.x, nloc, nx); b.st[0] = nloc; b.st[1] = nx; }
        const unsigned old = xb_add(&bar[XB_XSUB(b.x)], 1u);
        const unsigned gen = old / nloc;
        if (old + 1u == (gen + 1u) * nloc) {
            __builtin_amdgcn_fence(__ATOMIC_RELEASE, "agent");
            asm volatile("s_waitcnt vmcnt(0)" ::: "memory");
            const unsigned og = xb_add(&bar[XB_TOP], 1u);
            const unsigned tg = og / nx;
            if (og + 1u == (tg + 1u) * nx) xb_add(&bar[XB_TOPGEN], 1u);
            else XB_SPIN(xb_ld(&bar[XB_TOPGEN]) == tg, bar);
            __builtin_amdgcn_fence(__ATOMIC_ACQUIRE, "agent");
            xb_add(&bar[XB_XGEN(b.x)], 1u);
            asm volatile("s_waitcnt vmcnt(0)" ::: "memory");
        } else {
            XB_SPIN(xb_ld(&bar[XB_XGEN(b.x)]) == gen, bar);
            __builtin_amdgcn_fence(__ATOMIC_ACQUIRE, "agent");
            asm volatile("s_waitcnt vmcnt(0)" ::: "memory");
        }
    }
    __syncthreads();
}


static __device__ const unsigned char T5B[129] = {0, 1, 2, 3, 4, 5, 6, 7, 8, 9, 10, 11, 12, 13, 14, 15, 16, 16, 16, 17, 17, 18, 18, 18, 19, 19, 19, 20, 20, 20, 20, 21, 21, 21, 21, 22, 22, 22, 22, 22, 23, 23, 23, 23, 23, 23, 24, 24, 24, 24, 24, 24, 25, 25, 25, 25, 25, 25, 25, 26, 26, 26, 26, 26, 26, 26, 26, 27, 27, 27, 27, 27, 27, 27, 27, 27, 27, 28, 28, 28, 28, 28, 28, 28, 28, 28, 28, 29, 29, 29, 29, 29, 29, 29, 29, 29, 29, 29, 29, 30, 30, 30, 30, 30, 30, 30, 30, 30, 30, 30, 30, 30, 30, 31, 31, 31, 31, 31, 31, 31, 31, 31, 31, 31, 31, 31, 31, 31, 31};

struct Ctx {
    LAS unsigned char* lds;
    int tid, lane, wave, G;
    float* out;
    unsigned char* ws;
    __device__ __forceinline__ gu32* ctl() const { return (gu32*)(ws + WS_CTL); }
    __device__ __forceinline__ float* H() const { return (float*)(ws + WS_H); }
    __device__ __forceinline__ bf16* HB() const { return (bf16*)(ws + WS_HB); }
    __device__ __forceinline__ float* SSQ() const { return (float*)(ws + WS_SSQ); }
    __device__ __forceinline__ bf16* PROJ() const { return (bf16*)(ws + WS_ACT + ACT_PROJ); }
    __device__ __forceinline__ float* LOGF() const { return (float*)(ws + WS_ACT + ACT_LOGF); }
    __device__ __forceinline__ bf16* MIX() const { return (bf16*)(ws + WS_ACT + ACT_MIX); }
    __device__ __forceinline__ bf16* T() const { return (bf16*)(ws + WS_ACT); }
    __device__ __forceinline__ bf16* XG() const { return (bf16*)(ws + WS_XG); }
    __device__ __forceinline__ bf16* Y() const { return (bf16*)(ws + WS_XG); }
    __device__ __forceinline__ float* LB() const { return (float*)(ws + WS_TAB + TAB_LB); }
    __device__ __forceinline__ float* BIAST() const { return (float*)(ws + WS_TAB + TAB_BIAS); }
    __device__ __forceinline__ float* LAM() const { return (float*)(ws + WS_TAB + TAB_LAM); }
    __device__ __forceinline__ float* RF() const { return (float*)(ws + WS_TAB + TAB_RF); }
    __device__ __forceinline__ float* SUBLN() const { return (float*)(ws + WS_TAB + TAB_SUBLN); }
    __device__ __forceinline__ float* HGNW() const { return (float*)(ws + WS_TAB + TAB_HGNW); }
    __device__ __forceinline__ float* FNORM() const { return (float*)(ws + WS_TAB + TAB_FNORM); }
    __device__ __forceinline__ unsigned* TINFO() const { return (unsigned*)(ws + WS_ROUTE + ROUTE_INFO); }
    __device__ __forceinline__ int* LIST() const { return (int*)(ws + WS_ROUTE + ROUTE_LIST); }
    __device__ __forceinline__ float* RSTD() const { return (float*)(ws + WS_ROUTE + ROUTE_RSTD); }
};
struct Args { const float* in[19]; float* out; unsigned char* ws; int ph_lo, ph_hi; };
enum { IN_X = 0, IN_META, IN_RELB, IN_NMIX, IN_WIN, IN_LBL, IN_HGNW, IN_LAMBDA, IN_SUBLN, IN_WOUT, IN_NFFN, IN_DW1, IN_DW3, IN_DW2, IN_ROUTER, IN_MW1, IN_MW3, IN_MW2, IN_FNORM };

__device__ __forceinline__ float row_rstd(const float* ssq, int row) {
    const f32x4* p = (const f32x4*)(ssq + (size_t)row * 16);
    const f32x4 a = p[0], b = p[1], c = p[2], d = p[3];
    const float s = ((a[0] + a[1]) + (a[2] + a[3])) + ((b[0] + b[1]) + (b[2] + b[3])) + ((c[0] + c[1]) + (c[2] + c[3])) + ((d[0] + d[1]) + (d[2] + d[3]));
    return rsqrtf(s * (1.0f / 1024.0f) + EPS);
}
struct EpiProj {
    static constexpr bool PERM = true, AFTER_DRAIN = false;
    bf16* proj; float* logfp; const float* ssq; const float* lb;
    __device__ __forceinline__ void operator()(const pg8::f32x4 (&acc)[2][2][4][2], const pg8::Unit& u, int wr, int wc, int fr, int fq) const {
        const int grp = u.pn >> 1;
        const int row0 = u.pm * 256 + wr * 64 + fr, colb = u.pn * 256 + wc * 32 + 8 * fq;
#pragma unroll
        for (int ai = 0; ai < 2; ++ai)
#pragma unroll
            for (int m = 0; m < 4; ++m) {
                const int row = row0 + ai * 128 + m * 16;
                const float r = row_rstd(ssq, row);
                const bool valid = (row % LT) >= FIRSTV;
#pragma unroll
                for (int bj = 0; bj < 2; ++bj) {
                    const int c0 = colb + bj * 128;
                    float x[8];
#pragma unroll
                    for (int j = 0; j < 4; ++j) { x[j] = acc[ai][bj][m][0][j] * r; x[4 + j] = acc[ai][bj][m][1][j] * r; }
                    if (grp == 0 || grp == 3) {
#pragma unroll
                        for (int j = 0; j < 8; ++j) x[j] = silu_f(x[j]);
                    } else if (grp == 4) {
#pragma unroll
                        for (int j = 0; j < 8; ++j) x[j] *= 0.18033688011112042f;
                    } else if (grp == 1) {
                        const int cc = c0 - 512;
                        const f32x4 l0 = *(const f32x4*)(lb + cc), l1 = *(const f32x4*)(lb + cc + 4);
                        float lf[8];
#pragma unroll
                        for (int j = 0; j < 8; ++j) {
                            const float lbv = j < 4 ? l0[j & 3] : l1[j & 3];
                            const float xx = x[j];
                            const float ls = fminf(xx, 0.f) - log1pf(expf(-fabsf(xx)));
                            const float sg = expf(ls);
                            float lgf = (lbv > 0.f) ? logf(lbv + (1.f - lbv) * sg) : ls;
                            float kk = (1.f - lbv) * expf(ls - xx);
                            if (!valid) { lgf = 0.f; kk = 0.f; }
                            lf[j] = lgf; x[j] = kk;
                        }
                        float* lp = logfp + (size_t)row * 512 + cc;
                        *(f32x4*)lp = (f32x4){lf[0], lf[1], lf[2], lf[3]}; *(f32x4*)(lp + 4) = (f32x4){lf[4], lf[5], lf[6], lf[7]};
                    }
                    v4u w; w.x = pg8::cvt_pk_bf16(x[0], x[1]); w.y = pg8::cvt_pk_bf16(x[2], x[3]); w.z = pg8::cvt_pk_bf16(x[4], x[5]); w.w = pg8::cvt_pk_bf16(x[6], x[7]);
                    *(v4u*)(proj + (size_t)row * WIN + c0) = w;
                }
            }
    }
};
struct EpiResid {
    static constexpr bool PERM = true, AFTER_DRAIN = false;
    float* H; bf16* HB; float* ssq;
    __device__ __forceinline__ void operator()(const pg8::f32x4 (&acc)[2][2][4][2], const pg8::Unit& u, int wr, int wc, int fr, int fq) const {
        const int row0 = u.pm * 256 + wr * 64 + fr, colb = u.pn * 256 + wc * 32 + 8 * fq;
#pragma unroll
        for (int ai = 0; ai < 2; ++ai)
#pragma unroll
            for (int m = 0; m < 4; ++m) {
                const int row = row0 + ai * 128 + m * 16;
                float s = 0.f;
#pragma unroll
                for (int bj = 0; bj < 2; ++bj) {
                    const int c0 = colb + bj * 128;
                    float* hp = H + (size_t)row * D + c0;
                    f32x4 h0 = *(const f32x4*)hp, h1 = *(const f32x4*)(hp + 4);
                    h0 = h0 + acc[ai][bj][m][0]; h1 = h1 + acc[ai][bj][m][1];
                    *(f32x4*)hp = h0; *(f32x4*)(hp + 4) = h1;
                    s += (h0[0] * h0[0] + h0[1] * h0[1]) + (h0[2] * h0[2] + h0[3] * h0[3]) + (h1[0] * h1[0] + h1[1] * h1[1]) + (h1[2] * h1[2] + h1[3] * h1[3]);
                    v4u w; w.x = pg8::cvt_pk_bf16(h0[0], h0[1]); w.y = pg8::cvt_pk_bf16(h0[2], h0[3]); w.z = pg8::cvt_pk_bf16(h1[0], h1[1]); w.w = pg8::cvt_pk_bf16(h1[2], h1[3]);
                    *(v4u*)(HB + (size_t)row * D + c0) = w;
                }
                s += __shfl_xor(s, 16); s += __shfl_xor(s, 32);
                if (fq == 0) ssq[(size_t)row * 16 + u.pn * 4 + wc] = s;
            }
    }
};
struct EpiGLU {
    static constexpr bool PERM = true, AFTER_DRAIN = false;
    bf16* T; int ldt; const float* ssq;
    __device__ __forceinline__ void operator()(const pg8::f32x4 (&acc)[2][2][4][2], const pg8::Unit& u, int wr, int wc, int fr, int fq) const {
        const int row0 = u.pm * 256 + wr * 64 + fr, colb = u.pn * 128 + wc * 32 + 8 * fq;
#pragma unroll
        for (int ai = 0; ai < 2; ++ai)
#pragma unroll
            for (int m = 0; m < 4; ++m) {
                const int row = row0 + ai * 128 + m * 16;
                const float r = ssq ? row_rstd(ssq, row) : 1.f;
                float x[8];
#pragma unroll
                for (int j = 0; j < 4; ++j) { x[j] = silu_f(acc[ai][0][m][0][j] * r) * (acc[ai][1][m][0][j] * r); x[4 + j] = silu_f(acc[ai][0][m][1][j] * r) * (acc[ai][1][m][1][j] * r); }
                v4u w; w.x = pg8::cvt_pk_bf16(x[0], x[1]); w.y = pg8::cvt_pk_bf16(x[2], x[3]); w.z = pg8::cvt_pk_bf16(x[4], x[5]); w.w = pg8::cvt_pk_bf16(x[6], x[7]);
                *(v4u*)(T + (size_t)row * ldt + colb) = w;
            }
    }
};
struct EpiY {
    static constexpr bool PERM = true, AFTER_DRAIN = false;
    bf16* Y;
    __device__ __forceinline__ void operator()(const pg8::f32x4 (&acc)[2][2][4][2], const pg8::Unit& u, int wr, int wc, int fr, int fq) const {
        const int row0 = u.pm * 256 + wr * 64 + fr, colb = u.pn * 256 + wc * 32 + 8 * fq;
#pragma unroll
        for (int ai = 0; ai < 2; ++ai)
#pragma unroll
            for (int m = 0; m < 4; ++m) {
                const int row = row0 + ai * 128 + m * 16;
#pragma unroll
                for (int bj = 0; bj < 2; ++bj) {
                    const pg8::f32x4 a = acc[ai][bj][m][0], b = acc[ai][bj][m][1];
                    v4u w; w.x = pg8::cvt_pk_bf16(a[0], a[1]); w.y = pg8::cvt_pk_bf16(a[2], a[3]); w.z = pg8::cvt_pk_bf16(b[0], b[1]); w.w = pg8::cvt_pk_bf16(b[2], b[3]);
                    *(v4u*)(Y + (size_t)row * D + colb + bj * 128) = w;
                }
            }
    }
};

__device__ __forceinline__ void transpose_item(const float* W, const float* fold, int K, int N, bf16* WT, int k0, int n0, int drow0, LAS float* scr, int lane) {
#pragma unroll 8
    for (int i = 0; i < 32; ++i) { const int kk = 2 * i + (lane >> 5); const float f = fold ? fold[k0 + kk] : 1.f; scr[kk * 33 + (lane & 31)] = W[(size_t)(k0 + kk) * N + n0 + (lane & 31)] * f; }
    LDS_WAIT(); asm volatile("" ::: "memory");
    const int c = lane & 7;
#pragma unroll
    for (int j = 0; j < 4; ++j) { const int n = (lane >> 3) + 8 * j; const LAS float* s = scr + (8 * c) * 33 + n;
        v4u o; o.x = pk2(s[0 * 33], s[1 * 33]); o.y = pk2(s[2 * 33], s[3 * 33]); o.z = pk2(s[4 * 33], s[5 * 33]); o.w = pk2(s[6 * 33], s[7 * 33]);
        *(GAS v4u*)(WT + (size_t)(drow0 + n) * K + k0 + 8 * c) = o; }
    LDS_WAIT(); asm volatile("" ::: "memory");
}
__device__ __forceinline__ void prologue_phase(Ctx& C, const Args& A) {
    LAS float* scr = (LAS float*)(C.lds + C.wave * 16384);
    const int gw = blockIdx.x * 8 + C.wave, NGW = C.G * 8;
    constexpr int I_IN = 16 * 112, I_OUT = 16 * 32, I_D1 = 16 * 88, I_D2 = 44 * 32, I_M1 = 16 * 112, I_M2 = 56 * 32;
    constexpr int N_IN = 4 * I_IN, N_OUT = 4 * I_OUT, N_D1 = 2 * I_D1, N_D2 = 2 * I_D2, N_M1 = 16 * I_M1, N_M2 = 16 * I_M2;
    constexpr int NITEMS = N_IN + N_OUT + 2 * N_D1 + N_D2 + 2 * N_M1 + N_M2;
    for (int it = gw; it < NITEMS; it += NGW) {
        int r = it;
        const float* W; const float* fold = nullptr; bf16* WT; int K, N, glu = -1, loc;
        if (r < N_IN) { const int l = r / I_IN; loc = r % I_IN; W = A.in[IN_WIN] + (size_t)l * D * WIN; fold = A.in[IN_NMIX] + l * D; WT = (bf16*)(C.ws + WS_WIN) + (size_t)l * WIN * D; K = D; N = WIN; }
        else if ((r -= N_IN) < N_OUT) { const int l = r / I_OUT; loc = r % I_OUT; W = A.in[IN_WOUT] + (size_t)l * D * D; WT = (bf16*)(C.ws + WS_WOUT) + (size_t)l * D * D; K = D; N = D; }
        else if ((r -= N_OUT) < N_D1) { const int i = r / I_D1; loc = r % I_D1; W = A.in[IN_DW1] + (size_t)i * D * FFD; fold = A.in[IN_NFFN] + (2 * i) * D; WT = (bf16*)(C.ws + WS_WD13) + (size_t)i * 2 * FFD * D; K = D; N = FFD; glu = 0; }
        else if ((r -= N_D1) < N_D1) { const int i = r / I_D1; loc = r % I_D1; W = A.in[IN_DW3] + (size_t)i * D * FFD; fold = A.in[IN_NFFN] + (2 * i) * D; WT = (bf16*)(C.ws + WS_WD13) + (size_t)i * 2 * FFD * D; K = D; N = FFD; glu = 1; }
        else if ((r -= N_D1) < N_D2) { const int i = r / I_D2; loc = r % I_D2; W = A.in[IN_DW2] + (size_t)i * FFD * D; WT = (bf16*)(C.ws + WS_WD2) + (size_t)i * D * FFD; K = FFD; N = D; }
        else if ((r -= N_D2) < N_M1) { const int ie = r / I_M1; loc = r % I_M1; W = A.in[IN_MW1] + (size_t)ie * D * FFE; fold = A.in[IN_NFFN] + (2 * (ie >> 3) + 1) * D; WT = (bf16*)(C.ws + WS_WM13) + (size_t)ie * 2 * FFE * D; K = D; N = FFE; glu = 0; }
        else if ((r -= N_M1) < N_M1) { const int ie = r / I_M1; loc = r % I_M1; W = A.in[IN_MW3] + (size_t)ie * D * FFE; fold = A.in[IN_NFFN] + (2 * (ie >> 3) + 1) * D; WT = (bf16*)(C.ws + WS_WM13) + (size_t)ie * 2 * FFE * D; K = D; N = FFE; glu = 1; }
        else { r -= N_M1; const int ie = r / I_M2; loc = r % I_M2; W = A.in[IN_MW2] + (size_t)ie * FFE * D; WT = (bf16*)(C.ws + WS_WM2) + (size_t)ie * D * FFE; K = FFE; N = D; }
        const int nblk = N / 32, kb = loc / nblk, nb = loc % nblk, k0 = 64 * kb, n0 = 32 * nb;
        const int drow0 = (glu < 0) ? n0 : ((n0 >> 7) * 256 + glu * 128 + (n0 & 127));
        transpose_item(W, fold, K, N, WT, k0, n0, drow0, scr, C.lane);
    }
    for (int row = gw; row < NTOK; row += NGW) {
        const int b = row / LT, t = row % LT;
        f32x4 v[4]; float s = 0.f;
#pragma unroll
        for (int j = 0; j < 4; ++j) {
            const int col = 4 * C.lane + 256 * j;
            if (t < FIRSTV) v[j] = (f32x4){0.f, 0.f, 0.f, 0.f};
            else if (t < LEAD) v[j] = *(const f32x4*)(A.in[IN_META] + (size_t)(t - FIRSTV) * D + col);
            else v[j] = *(const f32x4*)(A.in[IN_X] + ((size_t)b * SEQ + (t - LEAD)) * D + col);
            s += (v[j][0] * v[j][0] + v[j][1] * v[j][1]) + (v[j][2] * v[j][2] + v[j][3] * v[j][3]);
            *(f32x4*)(C.H() + (size_t)row * D + col) = v[j];
            v2u w; w.x = pk2(v[j][0], v[j][1]); w.y = pk2(v[j][2], v[j][3]);
            *(v2u*)(C.HB() + (size_t)row * D + col) = w;
        }
        s = wave_sum(s);
        if (C.lane < 16) C.SSQ()[(size_t)row * 16 + C.lane] = (C.lane == 0) ? s : 0.f;
    }
    if (blockIdx.x == 0) {
        const int tid = C.tid;
        {
            const float* lg = A.in[IN_LBL];
            const float a0 = lg[tid], a1 = lg[512 + tid], a2 = lg[1024 + tid], a3 = lg[1536 + tid];
            const float mx = fmaxf(fmaxf(a0, a1), fmaxf(a2, a3));
            const float e0 = expf(a0 - mx), e1 = expf(a1 - mx), e2 = expf(a2 - mx), e3 = expf(a3 - mx);
            const float inv = 1.f / (((e0 + e1) + e2) + e3);
            const float p0 = e0 * inv, p1 = e1 * inv, p2 = e2 * inv, p3 = e3 * inv;
            const float c0 = p0, c1 = c0 + p1, c2 = c1 + p2, c3 = c2 + p3;
            C.LB()[tid] = 0.f;
            C.LB()[512 + tid] = fminf(fmaxf(c1 - c0, 0.f), 0.999f);
            C.LB()[1024 + tid] = fminf(fmaxf(c2 - c0, 0.f), 0.999f);
            C.LB()[1536 + tid] = fminf(fmaxf(c3 - c0, 0.f), 0.999f);
        }
        for (int i = tid; i < 4 * 132; i += 512) { const int h = i / 132, d = i % 132; C.BIAST()[i] = (d <= 128) ? A.in[IN_RELB][T5B[d] * 4 + h] : 0.f; }
        if (tid < 4) {
            const float* lv = A.in[IN_LAMBDA] + tid * 256;
            float s01 = 0.f, s23 = 0.f;
            for (int j = 0; j < 64; ++j) { s01 += lv[j] * lv[64 + j]; s23 += lv[128 + j] * lv[192 + j]; }
            const float li = 0.8f - 0.6f * expf(-0.3f * (float)tid);
            C.LAM()[tid * 2] = expf(s01) - expf(s23) + li; C.LAM()[tid * 2 + 1] = li;
        }
        if (tid < 512) { C.SUBLN()[tid] = A.in[IN_SUBLN][tid]; C.HGNW()[tid] = A.in[IN_HGNW][tid]; C.FNORM()[tid] = A.in[IN_FNORM][tid]; C.FNORM()[512 + tid] = A.in[IN_FNORM][512 + tid]; }
        for (int i = tid; i < 2 * 8 * 1024; i += 512) { const int li = i >> 13, e = (i >> 10) & 7, k = i & 1023; C.RF()[i] = A.in[IN_NFFN][(2 * li + 1) * D + k] * A.in[IN_ROUTER][(size_t)li * D * NE + k * NE + e]; }
    }
}

__device__ __forceinline__ void hgrn_naive_unit(Ctx& C, int l, int b, int h) {
    LAS float* qf = (LAS float*)C.lds;
    LAS float* kf = qf + 2048; LAS float* ff = kf + 2048; LAS float* vv = ff + 2048; LAS float* gg = vv + 2048;
    LAS float* opart = gg + 2048;
    const int tid = C.tid, dv = tid & 127, qd = tid >> 7;
    const int ltok = tid >> 5, c4 = (tid & 31) * 4;
    float S[32];
#pragma unroll
    for (int j = 0; j < 32; ++j) S[j] = 0.f;
    const float* nw = C.HGNW() + l * 128;
    for (int tb = 0; tb < LT / 16; ++tb) {
        const size_t row = (size_t)b * LT + tb * 16 + ltok;
        {
            const bf16* pp = C.PROJ() + row * WIN + h * 128 + c4;
            const v2u wq = *(const v2u*)pp, wk = *(const v2u*)(pp + 512), wv = *(const v2u*)(pp + 1024), wg = *(const v2u*)(pp + 1536);
            const f32x4 lf = *(const f32x4*)(C.LOGF() + row * 512 + h * 128 + c4);
            const int o = ltok * 128 + c4;
            qf[o] = bf_lo(wq.x); qf[o + 1] = bf_hi(wq.x); qf[o + 2] = bf_lo(wq.y); qf[o + 3] = bf_hi(wq.y);
            kf[o] = bf_lo(wk.x); kf[o + 1] = bf_hi(wk.x); kf[o + 2] = bf_lo(wk.y); kf[o + 3] = bf_hi(wk.y);
            vv[o] = bf_lo(wv.x); vv[o + 1] = bf_hi(wv.x); vv[o + 2] = bf_lo(wv.y); vv[o + 3] = bf_hi(wv.y);
            gg[o] = bf_lo(wg.x); gg[o + 1] = bf_hi(wg.x); gg[o + 2] = bf_lo(wg.y); gg[o + 3] = bf_hi(wg.y);
            ff[o] = expf(lf[0]); ff[o + 1] = expf(lf[1]); ff[o + 2] = expf(lf[2]); ff[o + 3] = expf(lf[3]);
        }
        __syncthreads();
        for (int tok = 0; tok < 16; ++tok) {
            const float v = vv[tok * 128 + dv];
            const LAS f32x4* fp = (const LAS f32x4*)(ff + tok * 128 + 32 * qd);
            const LAS f32x4* kp = (const LAS f32x4*)(kf + tok * 128 + 32 * qd);
            const LAS f32x4* qp = (const LAS f32x4*)(qf + tok * 128 + 32 * qd);
            float a = 0.f;
#pragma unroll
            for (int j = 0; j < 8; ++j) {
                const f32x4 f4 = fp[j], k4 = kp[j], q4 = qp[j];
#pragma unroll
                for (int i = 0; i < 4; ++i) { S[4 * j + i] = f4[i] * S[4 * j + i] + k4[i] * v; a += q4[i] * S[4 * j + i]; }
            }
            opart[(tok * 4 + qd) * 128 + dv] = a;
        }
        __syncthreads();
        {
            float o[4]; float ss = 0.f;
#pragma unroll
            for (int i = 0; i < 4; ++i) { o[i] = (opart[(ltok * 4 + 0) * 128 + c4 + i] + opart[(ltok * 4 + 1) * 128 + c4 + i]) + (opart[(ltok * 4 + 2) * 128 + c4 + i] + opart[(ltok * 4 + 3) * 128 + c4 + i]); ss += o[i] * o[i]; }
#pragma unroll
            for (int m = 1; m < 32; m <<= 1) ss += __shfl_xor(ss, m);
            const float rs = rsqrtf(ss * (1.0f / 128.0f) + EPS);
            const int oo = ltok * 128 + c4;
            v2u w; w.x = pk2(o[0] * rs * nw[c4] * gg[oo], o[1] * rs * nw[c4 + 1] * gg[oo + 1]); w.y = pk2(o[2] * rs * nw[c4 + 2] * gg[oo + 2], o[3] * rs * nw[c4 + 3] * gg[oo + 3]);
            *(v2u*)(C.MIX() + row * D + h * 128 + c4) = w;
        }
        __syncthreads();
    }
}
typedef float f32x16 __attribute__((ext_vector_type(16)));
typedef short bf16x8 __attribute__((ext_vector_type(8)));
typedef short s16x4 __attribute__((ext_vector_type(4)));
constexpr float LOG2E = 1.4426950408889634f;
constexpr int AT_K = 0, AT_V = 32768, AT_BIAS = 65536, AT_WSF = 66560, AT_STG = 69632, AT_XCH = 0;
__device__ __forceinline__ int crow(int r, int hi) { return (r & 3) + 8 * (r >> 2) + 4 * hi; }
__device__ __forceinline__ s16x4 vtr(const LAS unsigned char* p) { typedef short v4i16_t __attribute__((ext_vector_type(4))); return __builtin_bit_cast(s16x4, __builtin_amdgcn_ds_read_tr16_b64_v4i16((LAS v4i16_t*)p)); }
__device__ __forceinline__ bf16x8 pack8(const f32x16& p, int b0) {
    v4u w; w.x = pg8::cvt_pk_bf16(p[b0 + 0], p[b0 + 1]); w.y = pg8::cvt_pk_bf16(p[b0 + 2], p[b0 + 3]); w.z = pg8::cvt_pk_bf16(p[b0 + 4], p[b0 + 5]); w.w = pg8::cvt_pk_bf16(p[b0 + 6], p[b0 + 7]);
    return __builtin_bit_cast(bf16x8, w);
}
__device__ __forceinline__ void attn_unit(Ctx& C, int l, int b, int h, int qi) {
    LAS unsigned char* lds = C.lds;
    const int tid = C.tid, lane = C.lane, wave = C.wave, rg = wave >> 1, c = wave & 1, r32 = lane & 31, hi = lane >> 5;
    const size_t rowbase = (size_t)b * LT;
    const bf16* PJ = C.PROJ();
    LAS float* biasl = (LAS float*)(lds + AT_BIAS);
    LAS float* wsf = (LAS float*)(lds + AT_WSF) + wave * 64;
    if (tid < 132) biasl[tid] = C.BIAST()[h * 132 + tid] * LOG2E;
    const float lam = C.LAM()[l * 2], lam_init = C.LAM()[l * 2 + 1];
    const int qw0 = 128 * qi + 32 * rg, tq = qw0 + r32;
    bf16x8 qr[4];
    { const bf16* qp = PJ + (rowbase + tq) * WIN + 2048 + h * 128 + c * 64 + 8 * hi;
#pragma unroll
      for (int ks = 0; ks < 4; ++ks) qr[ks] = *(const bf16x8*)(qp + 16 * ks); }
    const int kkey = tid >> 3, kch = tid & 7;
    const bf16* ksrc = PJ + (rowbase + kkey) * WIN + 2560 + h * 128 + kch * 8;
    const int kdst = kkey * 128 + ((kch ^ ((kkey >> 1) & 7)) * 16);
    const int vkey0 = tid >> 4, vch = tid & 15;
    const bf16* vsrc = PJ + (rowbase + vkey0) * WIN + 3072 + h * 128 + vch * 8;
    const int vdst0 = ((vkey0 >> 3) * 4 + (vch >> 2)) * 512 + (vkey0 & 7) * 64 + (vch & 3) * 16;
    v4u kreg0, kreg1, vreg0, vreg1;
#define AT_LOAD(kt) do { const size_t o_ = (size_t)(kt) * 64 * WIN; kreg0 = *(const v4u*)(ksrc + o_); kreg1 = *(const v4u*)(ksrc + o_ + 64); vreg0 = *(const v4u*)(vsrc + o_); vreg1 = *(const v4u*)(vsrc + o_ + (size_t)32 * WIN); } while (0)
#define AT_STORE(buf) do { *(LAS v4u*)(lds + AT_K + (buf) * 16384 + kdst) = kreg0; *(LAS v4u*)(lds + AT_K + (buf) * 16384 + 8192 + kdst) = kreg1; \
        *(LAS v4u*)(lds + AT_V + (buf) * 16384 + vdst0) = vreg0; *(LAS v4u*)(lds + AT_V + (buf) * 16384 + 8192 + vdst0) = vreg1; } while (0)
    const int nt = 2 * qi + 1;
    AT_LOAD(1); AT_STORE(0);
    __syncthreads();
    f32x16 o[4];
#pragma unroll
    for (int d = 0; d < 4; ++d)
#pragma unroll
        for (int r = 0; r < 16; ++r) o[d][r] = 0.f;
    float mref = -1e30f, lsum = 0.f;
    const int kswz = (r32 >> 1) & 7;
    const int vb = (4 * hi + ((lane & 15) >> 2)) * 64 + ((lane >> 4) & 1) * 32 + (lane & 3) * 8;
    const float b128 = biasl[128];
    for (int it = 0; it < nt; ++it) {
        const int kt = it + 1, buf = it & 1, k0 = 64 * kt;
        if (it + 1 < nt) AT_LOAD(kt + 1);
        if (k0 <= qw0 + 31) {
            const bool near = (k0 + 63 > qw0 - 128) || (kt == 1);
            f32x16 p0, p1;
            { const float ini = near ? 0.f : b128;
#pragma unroll
              for (int r = 0; r < 16; ++r) { p0[r] = ini; p1[r] = ini; } }
            const LAS unsigned char* kb = lds + AT_K + buf * 16384 + c * 8192 + r32 * 128;
#pragma unroll
            for (int ks = 0; ks < 4; ++ks) {
                const int off = ((2 * ks + hi) ^ kswz) * 16;
                const bf16x8 k0f = *(const LAS bf16x8*)(kb + off), k1f = *(const LAS bf16x8*)(kb + 4096 + off);
                p0 = __builtin_amdgcn_mfma_f32_32x32x16_bf16(k0f, qr[ks], p0, 0, 0, 0);
                p1 = __builtin_amdgcn_mfma_f32_32x32x16_bf16(k1f, qr[ks], p1, 0, 0, 0);
            }
            if (near) {
#pragma unroll
                for (int r = 0; r < 16; ++r) {
                    const int tk = k0 + crow(r, hi), d0 = tq - tk, d1 = d0 - 32;
                    const float b0 = biasl[d0 < 0 ? 0 : (d0 > 128 ? 128 : d0)], b1 = biasl[d1 < 0 ? 0 : (d1 > 128 ? 128 : d1)];
                    p0[r] = (d0 < 0 || tk < FIRSTV) ? -INFINITY : p0[r] + b0;
                    p1[r] = (d1 < 0 || tk + 32 < FIRSTV) ? -INFINITY : p1[r] + b1;
                }
            }
            float mx = fmaxf(p0[0], p1[0]);
#pragma unroll
            for (int r = 1; r < 16; ++r) mx = fmaxf(fmaxf(mx, p0[r]), p1[r]);
            mx = fmaxf(mx, __shfl_xor(mx, 32));
            if (__any(mx > mref + 8.0f)) {
                const float mnew = fmaxf(mref, mx), f = __builtin_amdgcn_exp2f(mref - mnew);
                lsum *= f; mref = mnew;
                if (hi == 0) wsf[r32] = f;
                LDS_WAIT(); asm volatile("" ::: "memory");
#pragma unroll
                for (int g = 0; g < 4; ++g) { const f32x4 fv = *(const LAS f32x4*)(wsf + 8 * g + 4 * hi);
#pragma unroll
                    for (int d = 0; d < 4; ++d) { o[d][4 * g + 0] *= fv[0]; o[d][4 * g + 1] *= fv[1]; o[d][4 * g + 2] *= fv[2]; o[d][4 * g + 3] *= fv[3]; } }
            }
            float ps = 0.f;
#pragma unroll
            for (int r = 0; r < 16; ++r) { p0[r] = __builtin_amdgcn_exp2f(p0[r] - mref); p1[r] = __builtin_amdgcn_exp2f(p1[r] - mref); ps += p0[r] + p1[r]; }
            lsum += ps;
            const bf16x8 pa0 = pack8(p0, 0), pa1 = pack8(p0, 8), pa2 = pack8(p1, 0), pa3 = pack8(p1, 8);
            const LAS unsigned char* vp = lds + AT_V + buf * 16384 + vb;
#pragma unroll
            for (int d = 0; d < 4; ++d) {
#define AT_VF(s) ({ const s16x4 lo_ = vtr(vp + (2 * (s)) * 2048 + d * 512), hi_ = vtr(vp + (2 * (s) + 1) * 2048 + d * 512); (bf16x8){lo_[0], lo_[1], lo_[2], lo_[3], hi_[0], hi_[1], hi_[2], hi_[3]}; })
                o[d] = __builtin_amdgcn_mfma_f32_32x32x16_bf16(pa0, AT_VF(0), o[d], 0, 0, 0);
                o[d] = __builtin_amdgcn_mfma_f32_32x32x16_bf16(pa1, AT_VF(1), o[d], 0, 0, 0);
                o[d] = __builtin_amdgcn_mfma_f32_32x32x16_bf16(pa2, AT_VF(2), o[d], 0, 0, 0);
                o[d] = __builtin_amdgcn_mfma_f32_32x32x16_bf16(pa3, AT_VF(3), o[d], 0, 0, 0);
#undef AT_VF
            }
        }
        if (it + 1 < nt) AT_STORE(buf ^ 1);
        __syncthreads();
    }
#undef AT_LOAD
#undef AT_STORE
    lsum += __shfl_xor(lsum, 32);
    { const float inv = lsum > 0.f ? 1.f / lsum : 0.f;
      if (hi == 0) wsf[r32] = inv;
      LDS_WAIT(); asm volatile("" ::: "memory");
#pragma unroll
      for (int g = 0; g < 4; ++g) { const f32x4 fv = *(const LAS f32x4*)(wsf + 8 * g + 4 * hi);
#pragma unroll
          for (int d = 0; d < 4; ++d) { o[d][4 * g + 0] *= fv[0]; o[d][4 * g + 1] *= fv[1]; o[d][4 * g + 2] *= fv[2]; o[d][4 * g + 3] *= fv[3]; } } }
    LAS float* xch = (LAS float*)(lds + AT_XCH) + rg * 4096;
    if (c == 1) {
#pragma unroll
        for (int d = 0; d < 4; ++d)
#pragma unroll
            for (int r = 0; r < 16; ++r) xch[(d * 16 + r) * 64 + lane] = o[d][r];
    }
    __syncthreads();
    if (c == 0) {
        float ss[16];
#pragma unroll
        for (int r = 0; r < 16; ++r) ss[r] = 0.f;
#pragma unroll
        for (int d = 0; d < 4; ++d)
#pragma unroll
            for (int r = 0; r < 16; ++r) { const float a = o[d][r] - lam * xch[(d * 16 + r) * 64 + lane]; o[d][r] = a; ss[r] += a * a; }
#pragma unroll
        for (int r = 0; r < 16; ++r) {
            float s = ss[r];
            s += __shfl_xor(s, 1); s += __shfl_xor(s, 2); s += __shfl_xor(s, 4); s += __shfl_xor(s, 8); s += __shfl_xor(s, 16);
            ss[r] = rsqrtf(s * (1.0f / 128.0f) + EPS) * (1.f - lam_init);
        }
        LAS bf16* stg = (LAS bf16*)(lds + AT_STG) + rg * 4096;
        const float* sw = C.SUBLN() + l * 128 + r32;
#pragma unroll
        for (int d = 0; d < 4; ++d) { const float w = sw[32 * d];
#pragma unroll
            for (int r = 0; r < 16; ++r) stg[crow(r, hi) * 128 + 32 * d + r32] = (bf16)f2bf(o[d][r] * ss[r] * w); }
        LDS_WAIT(); asm volatile("" ::: "memory");
        bf16* op = C.MIX() + (rowbase + qw0) * D + 512 + h * 128;
#pragma unroll
        for (int i = 0; i < 8; ++i) { const int ch = i * 64 + lane, row = ch >> 4, cc = ch & 15; *(v4u*)(op + (size_t)row * D + cc * 8) = *(const LAS v4u*)(stg + row * 128 + cc * 8); }
    }
    __syncthreads();
}
__device__ __forceinline__ void mixer_phase(Ctx& C, int l) {
    for (int k = 0; k * C.G < 17 * 32; ++k) {
        const int u = k * C.G + ((k & 1) ? (C.G - 1 - (int)blockIdx.x) : (int)blockIdx.x);
        if (u < 17 * 32) { const int qi = 16 - u / 32, bh = u % 32; attn_unit(C, l, bh >> 2, bh & 3, qi); }
    }
    for (int u = C.G - 1 - (int)blockIdx.x; u < 32; u += C.G) hgrn_naive_unit(C, l, u >> 2, u & 3);
}

constexpr int RMAX = 128;
__device__ __forceinline__ void route_phase(Ctx& C, int li) {
    LAS float* rf = (LAS float*)C.lds;
    LAS int* lcnt = (LAS int*)(C.lds + 32768);
    LAS int* lbase = lcnt + 8;
    LAS int* ti = lbase + 8;
    LAS float* tf = (LAS float*)(ti + RMAX * 4);
    const int tid = C.tid, lane = C.lane;
    for (int i = tid; i < 8192; i += 512) rf[i] = C.RF()[li * 8192 + i];
    if (tid < 8) lcnt[tid] = 0;
    __syncthreads();
    const int nrows = (NTOK - (int)blockIdx.x + C.G - 1) / C.G;
    for (int k = C.wave; k < nrows; k += 8) {
        const size_t row = (size_t)blockIdx.x + (size_t)k * C.G;
        f32x4 v[4]; float ss = 0.f;
#pragma unroll
        for (int j = 0; j < 4; ++j) { v[j] = *(const f32x4*)(C.H() + row * D + 4 * lane + 256 * j); ss += (v[j][0] * v[j][0] + v[j][1] * v[j][1]) + (v[j][2] * v[j][2] + v[j][3] * v[j][3]); }
        ss = wave_sum(ss);
        const float rstd = rsqrtf(ss * (1.0f / 1024.0f) + EPS);
        float lg[8];
#pragma unroll
        for (int e = 0; e < 8; ++e) {
            float p = 0.f;
#pragma unroll
            for (int j = 0; j < 4; ++j) { const f32x4 w = *(const LAS f32x4*)(rf + e * 1024 + 4 * lane + 256 * j); p += (v[j][0] * w[0] + v[j][1] * w[1]) + (v[j][2] * w[2] + v[j][3] * w[3]); }
            lg[e] = wave_sum(p) * rstd;
        }
        int e1 = 0; float l1 = lg[0];
#pragma unroll
        for (int e = 1; e < 8; ++e) if (lg[e] > l1) { l1 = lg[e]; e1 = e; }
        int e2 = -1; float l2 = -3.0e38f;
#pragma unroll
        for (int e = 0; e < 8; ++e) if (e != e1 && lg[e] > l2) { l2 = lg[e]; e2 = e; }
        const float g1 = 1.f / (1.f + expf(l2 - l1)), g2 = 1.f - g1;
        if (lane == 0) {
            const int lr1 = __hip_atomic_fetch_add(&lcnt[e1], 1, __ATOMIC_RELAXED, __HIP_MEMORY_SCOPE_WORKGROUP), lr2 = __hip_atomic_fetch_add(&lcnt[e2], 1, __ATOMIC_RELAXED, __HIP_MEMORY_SCOPE_WORKGROUP);
            ti[k * 4 + 0] = e1; ti[k * 4 + 1] = e2; ti[k * 4 + 2] = lr1; ti[k * 4 + 3] = lr2;
            tf[k * 4 + 0] = g1; tf[k * 4 + 1] = g2; tf[k * 4 + 2] = rstd;
        }
    }
    __syncthreads();
    if (tid < 8) lbase[tid] = (int)__hip_atomic_fetch_add(C.ctl() + CW_CNT + (li * 8 + tid) * 64, (unsigned)lcnt[tid], RLX_AGENT);
    __syncthreads();
    for (int k = tid; k < nrows; k += 512) {
        const int row = (int)blockIdx.x + k * C.G;
        const int e1 = ti[k * 4], e2 = ti[k * 4 + 1], r1 = lbase[e1] + ti[k * 4 + 2], r2 = lbase[e2] + ti[k * 4 + 3];
        C.LIST()[(size_t)e1 * NTOK + r1] = row; C.LIST()[(size_t)e2 * NTOK + r2] = row;
        unsigned* inf = C.TINFO() + (size_t)row * 8;
        inf[0] = (unsigned)e1; inf[1] = (unsigned)e2; inf[2] = (unsigned)r1; inf[3] = (unsigned)r2; inf[4] = __builtin_bit_cast(unsigned, tf[k * 4]); inf[5] = __builtin_bit_cast(unsigned, tf[k * 4 + 1]);
        C.RSTD()[row] = tf[k * 4 + 2];
    }
    __syncthreads();
}
__device__ __forceinline__ void load_panels(Ctx& C, int li, LAS int* pst) {
    __syncthreads();
    if (C.tid == 0) { int acc = 0;
        for (int e = 0; e < 8; ++e) { const int c = (int)__hip_atomic_load(C.ctl() + CW_CNT + (li * 8 + e) * 64, RLX_AGENT); pst[e] = acc; pst[16 + e] = c; acc += (c + 255) >> 8; }
        pst[8] = acc; }
    __syncthreads();
}
__device__ __forceinline__ void gather_phase(Ctx& C, int li) {
    LAS int* pst = (LAS int*)C.lds;
    load_panels(C, li, pst);
    const int gw = blockIdx.x * 8 + C.wave, NGW = C.G * 8, lane = C.lane;
    const int nslot = pst[8] * 256;
    for (int s = gw; s < nslot; s += NGW) {
        const int panel = s >> 8; int e = 0;
#pragma unroll
        for (int j = 1; j < 8; ++j) if (panel >= pst[j]) e = j;
        const int rank = s - pst[e] * 256;
        bf16* xp = C.XG() + (size_t)s * D;
        if (rank < pst[16 + e]) {
            const int tok = C.LIST()[(size_t)e * NTOK + rank]; const float r = C.RSTD()[tok];
#pragma unroll
            for (int j = 0; j < 4; ++j) { const f32x4 v = *(const f32x4*)(C.H() + (size_t)tok * D + 4 * lane + 256 * j); v2u w; w.x = pk2(v[0] * r, v[1] * r); w.y = pk2(v[2] * r, v[3] * r); *(v2u*)(xp + 4 * lane + 256 * j) = w; }
        } else {
#pragma unroll
            for (int j = 0; j < 4; ++j) *(v2u*)(xp + 4 * lane + 256 * j) = (v2u){0u, 0u};
        }
    }
}
__device__ __forceinline__ void combine_phase(Ctx& C, int li, bool last) {
    LAS int* pst = (LAS int*)C.lds;
    load_panels(C, li, pst);
    const int gw = blockIdx.x * 8 + C.wave, NGW = C.G * 8, lane = C.lane;
    for (int row = gw; row < NTOK; row += NGW) {
        const unsigned* inf = C.TINFO() + (size_t)row * 8;
        const int e1 = (int)inf[0], e2 = (int)inf[1];
        const size_t s1 = (size_t)pst[e1] * 256 + inf[2], s2 = (size_t)pst[e2] * 256 + inf[3];
        const float g1 = __builtin_bit_cast(float, inf[4]), g2 = __builtin_bit_cast(float, inf[5]);
        f32x4 v[4]; float ss = 0.f;
#pragma unroll
        for (int j = 0; j < 4; ++j) {
            const int col = 4 * lane + 256 * j;
            v[j] = *(const f32x4*)(C.H() + (size_t)row * D + col);
            const v2u a = *(const v2u*)(C.Y() + s1 * D + col), b = *(const v2u*)(C.Y() + s2 * D + col);
            v[j][0] += g1 * bf_lo(a.x) + g2 * bf_lo(b.x); v[j][1] += g1 * bf_hi(a.x) + g2 * bf_hi(b.x);
            v[j][2] += g1 * bf_lo(a.y) + g2 * bf_lo(b.y); v[j][3] += g1 * bf_hi(a.y) + g2 * bf_hi(b.y);
            ss += (v[j][0] * v[j][0] + v[j][1] * v[j][1]) + (v[j][2] * v[j][2] + v[j][3] * v[j][3]);
        }
        ss = wave_sum(ss);
        if (!last) {
#pragma unroll
            for (int j = 0; j < 4; ++j) { const int col = 4 * lane + 256 * j; *(f32x4*)(C.H() + (size_t)row * D + col) = v[j]; v2u w; w.x = pk2(v[j][0], v[j][1]); w.y = pk2(v[j][2], v[j][3]); *(v2u*)(C.HB() + (size_t)row * D + col) = w; }
            if (lane < 16) C.SSQ()[(size_t)row * 16 + lane] = (lane == 0) ? ss : 0.f;
        } else {
            const int b = row / LT, t = row % LT;
            if (t >= LEAD) {
                const float rs = rsqrtf(ss * (1.0f / 1024.0f) + EPS);
#pragma unroll
                for (int j = 0; j < 4; ++j) { const int col = 4 * lane + 256 * j; const f32x4 fw = *(const f32x4*)(C.FNORM() + col);
                    *(f32x4*)(C.out + ((size_t)b * SEQ + (t - LEAD)) * D + col) = (f32x4){v[j][0] * rs * fw[0], v[j][1] * rs * fw[1], v[j][2] * rs * fw[2], v[j][3] * rs * fw[3]}; }
            }
        }
    }
}

__global__ void __launch_bounds__(512, 2) mk_fwd(Args args) {
    extern __shared__ __attribute__((aligned(16))) unsigned char lds[];
    Ctx C;
    C.lds = (LAS unsigned char*)lds;
    C.tid = threadIdx.x; C.lane = C.tid & 63; C.wave = __builtin_amdgcn_readfirstlane(C.tid >> 6); C.G = gridDim.x;
    unsigned char* ws = args.ws; C.ws = ws; C.out = args.out;
    volatile LAS unsigned* MISC = (volatile LAS unsigned*)(C.lds + MISC_OFF);
    for (int u = C.tid; u < (LDS_BYTES - RING_BYTES) / 4; u += 512) ((LAS unsigned*)(C.lds + RING_BYTES))[u] = 0u;
    __syncthreads();
    const int lo = args.ph_lo, hi = args.ph_hi;
    const bool multi = (hi - lo) > 1;
    XcdBarrier bar; bar.bar = (unsigned*)(C.ctl() + CW_BAR); bar.x = 0; bar.st = nullptr;
    if (multi) bar = xcd_barrier_post((unsigned*)(C.ctl() + CW_BAR), MISC + 8);
#define PHASE_CTX(P) Ctx P = C; { unsigned char* w_ = C.ws; asm volatile("" : "+s"(w_)); P.ws = w_; int t_ = C.tid; asm volatile("" : "+v"(t_)); P.tid = t_; P.lane = t_ & 63; P.wave = __builtin_amdgcn_readfirstlane(t_ >> 6); }
#define IN(k) (lo_l <= (k) && (k) < hi_l)
#define SEAM(k) do { if ((k) + 1 < hi_l) xcd_barrier(bar); } while (0)

    { int lo_l = lo, hi_l = hi; asm volatile("" : "+s"(lo_l), "+s"(hi_l));
      if (IN(0)) { PHASE_CTX(P); prologue_phase(P, args); SEAM(0); } }

    for (int l = 0; l < DEPTH; ++l) {
        int lo_l = lo, hi_l = hi; asm volatile("" : "+s"(lo_l), "+s"(hi_l));
        const int pb = 1 + 8 * l, li = l >> 1; const bool moe = (l & 1) != 0;
        if (IN(pb + 0)) {
            PHASE_CTX(P);
            pg8::Gemm g{P.HB(), (const bf16*)(P.ws + WS_WIN) + (size_t)l * WIN * D, NTOK, WIN, D, 0};
            pg8::StaticOrder S; S.init(NTOK, WIN, P.G, (int)blockIdx.x);
            EpiProj E{P.PROJ(), P.LOGF(), P.SSQ(), P.LB() + l * 512};
            pg8::gemm_phase<EpiProj, pg8::StaticOrder, true, true>(P.lds, g, S, E);
            SEAM(pb + 0);
        }
        if (IN(pb + 1)) { PHASE_CTX(P); mixer_phase(P, l); SEAM(pb + 1); }
        if (IN(pb + 2)) {
            PHASE_CTX(P);
            pg8::Gemm g{P.MIX(), (const bf16*)(P.ws + WS_WOUT) + (size_t)l * D * D, NTOK, D, D, 0};
            pg8::StaticOrder S; S.init(NTOK, D, P.G, (int)blockIdx.x);
            EpiResid E{P.H(), P.HB(), P.SSQ()};
            pg8::gemm_phase<EpiResid, pg8::StaticOrder, true, true>(P.lds, g, S, E);
            SEAM(pb + 2);
        }
        if (!moe) {
            if (IN(pb + 5)) {
                PHASE_CTX(P);
                pg8::Gemm g{P.HB(), (const bf16*)(P.ws + WS_WD13) + (size_t)li * 2 * FFD * D, NTOK, 2 * FFD, D, 0};
                pg8::StaticOrder S; S.init(NTOK, 2 * FFD, P.G, (int)blockIdx.x);
                EpiGLU E{P.T(), FFD, P.SSQ()};
                pg8::gemm_phase<EpiGLU, pg8::StaticOrder, true, true>(P.lds, g, S, E);
                SEAM(pb + 5);
            }
            if (IN(pb + 6)) {
                PHASE_CTX(P);
                pg8::Gemm g{P.T(), (const bf16*)(P.ws + WS_WD2) + (size_t)li * D * FFD, NTOK, D, FFD, 0};
                pg8::StaticOrder S; S.init(NTOK, D, P.G, (int)blockIdx.x);
                EpiResid E{P.H(), P.HB(), P.SSQ()};
                pg8::gemm_phase<EpiResid, pg8::StaticOrder, true, true>(P.lds, g, S, E);
                SEAM(pb + 6);
            }
        } else {
            if (IN(pb + 3)) { PHASE_CTX(P); route_phase(P, li); SEAM(pb + 3); }
            if (IN(pb + 4)) { PHASE_CTX(P); gather_phase(P, li); SEAM(pb + 4); }
            if (IN(pb + 5)) {
                PHASE_CTX(P);
                LAS int* pst = (LAS int*)(P.lds + RING_BYTES + 1024);
                load_panels(P, li, pst);
#define PS(i) __builtin_amdgcn_readfirstlane(pst[i])
                pg8::GroupedOrder S{PS(0), PS(1), PS(2), PS(3), PS(4), PS(5), PS(6), PS(7), PS(8), 2 * FFE / 256, P.G, (int)blockIdx.x};
                pg8::Gemm g{P.XG(), (const bf16*)(P.ws + WS_WM13) + (size_t)li * 8 * 2 * FFE * D, 0, 2 * FFE, D, (size_t)2 * FFE * D * 2};
                EpiGLU E{P.T(), FFE, nullptr};
                pg8::gemm_phase<EpiGLU, pg8::GroupedOrder, true, true>(P.lds, g, S, E);
                SEAM(pb + 5);
            }
            if (IN(pb + 6)) {
                PHASE_CTX(P);
                LAS int* pst = (LAS int*)(P.lds + RING_BYTES + 1024);
                load_panels(P, li, pst);
                pg8::GroupedOrder S{PS(0), PS(1), PS(2), PS(3), PS(4), PS(5), PS(6), PS(7), PS(8), D / 256, P.G, (int)blockIdx.x};
                pg8::Gemm g{P.T(), (const bf16*)(P.ws + WS_WM2) + (size_t)li * 8 * D * FFE, 0, D, FFE, (size_t)D * FFE * 2};
                EpiY E{P.Y()};
                pg8::gemm_phase<EpiY, pg8::GroupedOrder, true, true>(P.lds, g, S, E);
                SEAM(pb + 6);
            }
#undef PS
            if (IN(pb + 7)) { PHASE_CTX(P); combine_phase(P, li, l == DEPTH - 1); SEAM(pb + 7); }
        }
    }
#undef IN
#undef SEAM
#undef PHASE_CTX
}

extern "C" void kernel_launch(void* const* d_in, const int* in_sizes, int n_in, void* d_out, int out_size, void* d_ws, size_t ws_size, hipStream_t stream) {
    static int grid = 0;
    if (grid == 0) {
        if (n_in != 19 || out_size != NB * SEQ * D || ws_size < WS_END) { fprintf(stderr, "kernel_launch: unexpected shapes (n_in %d, out %d, ws %zu < %zu); nothing launched\n", n_in, out_size, ws_size, (size_t)WS_END); grid = -1; return; }
        int dev = 0, cus = 0, per_cu = 0;
        if (hipGetDevice(&dev) != hipSuccess || hipDeviceGetAttribute(&cus, hipDeviceAttributeMultiprocessorCount, dev) != hipSuccess) { grid = -1; return; }
        if (hipFuncSetAttribute((const void*)mk_fwd, hipFuncAttributeMaxDynamicSharedMemorySize, LDS_BYTES) != hipSuccess) { fprintf(stderr, "kernel_launch: hipFuncSetAttribute failed\n"); grid = -1; return; }
        if (hipOccupancyMaxActiveBlocksPerMultiprocessor(&per_cu, (const void*)mk_fwd, 512, LDS_BYTES) != hipSuccess || per_cu < 1) { fprintf(stderr, "kernel_launch: occupancy query says %d blocks per CU\n", per_cu); }
        (void)hipGetLastError();
        grid = cus;
    }
    if (grid < 0) return;
    if (hipMemsetAsync((char*)d_ws + WS_CTL, 0, CTL_ZERO_BYTES, stream) != hipSuccess) return;
    Args a{};
    for (int i = 0; i < 19; ++i) a.in[i] = (const float*)d_in[i];
    a.out = (float*)d_out; a.ws = (unsigned char*)d_ws;
#if MK_ONE_LAUNCH
    a.ph_lo = 0; a.ph_hi = NPHASE;
    hipLaunchKernelGGL(mk_fwd, dim3(grid), dim3(512), LDS_BYTES, stream, a);
#else
    for (int p = 0; p < NPHASE; ++p) {
        if (p > 0) { const int l = (p - 1) / 8, k = (p - 1) % 8; const bool moe = (l & 1) != 0; if (!moe && (k == 3 || k == 4 || k == 7)) continue; }
        a.ph_lo = p; a.ph_hi = p + 1;
        hipLaunchKernelGGL(mk_fwd, dim3(grid), dim3(512), LDS_BYTES, stream, a);
    }
#endif
}
```

```cpp
#include <hip/hip_runtime.h>
#include <cstdio>
#include <cstdint>

#ifndef MK_ONE_LAUNCH
#define MK_ONE_LAUNCH 1
#endif

namespace pg8 {
#define PG8_LAS __attribute__((address_space(3)))
typedef unsigned short bf16_t;
typedef short bf16x8 __attribute__((ext_vector_type(8)));
typedef float f32x4 __attribute__((ext_vector_type(4)));
typedef unsigned u32x4 __attribute__((ext_vector_type(4)));
typedef unsigned u32x2 __attribute__((ext_vector_type(2)));
constexpr int BM = 256, BK = 64, HALF = 128, HTB = HALF * BK * 2  , STAGE_BYTES = 8 * HTB, NXCD = 8, WGM = 8;

__host__ __device__ __forceinline__ int lds_byte(int r, int c) { const int st = (r >> 4) * 2 + (c >> 5), rr = r & 15, cc = c & 31, ob = rr * 64 + cc * 2; return st * 1024 + (ob ^ (((ob >> 9) & 1) << 5)); }
__host__ __device__ __forceinline__ void stage_rc(int b, int& R, int& C) { const int st = b / 1024, sb = b % 1024, swz = sb ^ (((sb >> 9) & 1) << 5); R = (st >> 1) * 16 + swz / 64; C = (st & 1) * 32 + (swz % 64) / 2; }
__host__ __device__ __forceinline__ int perm32(int rho) { const int n = rho >> 4, i = rho & 15; return 8 * (i >> 2) + 4 * n + (i & 3); }

struct Unit { int pm, pn, e; };
struct Gemm { const bf16_t* A; const bf16_t* Bt; int M, N, K; size_t bstride; };

struct StaticOrder {
    int nM, nN, nwg, G, c;
    __host__ __device__ void init(int M, int N, int G_, int c_) { nM = M / BM; nN = N / BM; nwg = nM * nN; G = G_; c = c_; }
    __host__ __device__ bool next(int i, Unit& u) const {
        const long L = (long)i * G + c; if (L >= nwg) return false;
        int wgid = (int)L; { const int q = nwg / NXCD, r = nwg % NXCD, xcd = wgid % NXCD, off = wgid / NXCD; wgid = (xcd < r ? xcd * (q + 1) : r * (q + 1) + (xcd - r) * q) + off; }
        const int nig = WGM * nN, gid = wgid / nig, fm = gid * WGM, gsz = (nM - fm) < WGM ? (nM - fm) : WGM;
        u.pm = fm + ((wgid % nig) % gsz); u.pn = (wgid % nig) / gsz; u.e = 0; return true;
    }
    __device__ __forceinline__ void a_ready(const Unit&) const {}
    __device__ __forceinline__ void done(const Unit&) const {}
};
struct GroupedOrder {
    int p0, p1, p2, p3, p4, p5, p6, p7, p8, nN, G, c;
    __device__ __forceinline__ bool next(int i, Unit& u) const {
        const int L = i * G + c; if (L >= p8 * nN) return false;
        int e = 0, ps = 0, pe = p1;
        if (L >= p1 * nN) { e = 1; ps = p1; pe = p2; }
        if (L >= p2 * nN) { e = 2; ps = p2; pe = p3; }
        if (L >= p3 * nN) { e = 3; ps = p3; pe = p4; }
        if (L >= p4 * nN) { e = 4; ps = p4; pe = p5; }
        if (L >= p5 * nN) { e = 5; ps = p5; pe = p6; }
        if (L >= p6 * nN) { e = 6; ps = p6; pe = p7; }
        if (L >= p7 * nN) { e = 7; ps = p7; pe = p8; }
        const int rem = L - ps * nN, R = pe - ps;
        u.e = e; u.pn = rem / R; u.pm = ps + rem % R; return true;
    }
    __device__ __forceinline__ void a_ready(const Unit&) const {}
    __device__ __forceinline__ void done(const Unit&) const {}
};

__device__ __forceinline__ unsigned cvt_pk_bf16(float lo, float hi) { unsigned r; asm volatile("v_cvt_pk_bf16_f32 %0, %1, %2" : "=v"(r) : "v"(lo), "v"(hi)); return r; }

template <class Epi, class Sched, bool ALIGN_EPI = false, bool SP2 = false>
__device__ __forceinline__ void gemm_phase(PG8_LAS unsigned char* lds, const Gemm g, const Sched& S, const Epi& E) {
    int tid_l = threadIdx.x; asm volatile("" : "+v"(tid_l));
    const int tid = tid_l, wid = __builtin_amdgcn_readfirstlane(tid >> 6), lane = tid & 63, wr = wid >> 2, wc = wid & 3, fr = lane & 15, fq = lane >> 4;
    const int K = g.K, nt = K / BK;
    unsigned voffA[2], voffB[2];
#pragma unroll
    for (int i = 0; i < 2; ++i) { int R, C; stage_rc(tid * 16 + i * 8192, R, C); const int Rb = Epi::PERM ? ((R & ~31) + perm32(R & 31)) : R;
        voffA[i] = (unsigned)(R * K + C) * 2u; voffB[i] = (unsigned)(Rb * K + C) * 2u; }
    const size_t kstep = (size_t)(BK * 2);
    const size_t hstep = (size_t)HALF * K * 2;
    const size_t tstep = 2 * hstep;
    const unsigned ldsw = (unsigned)wid * 1024u;
    const int aoff = lds_byte(wr * 64 + fr, fq * 8), boff = lds_byte(wc * 32 + fr, fq * 8);
#define PG8_SA(b, h) (((b) * 2 + (h)) * HTB)
#define PG8_SB(b, h) ((4 + (b) * 2 + (h)) * HTB)
#define PG8_STAGE(bufoff, gbase, voff) do { _Pragma("unroll") for (int _i = 0; _i < 2; ++_i) \
        __builtin_amdgcn_global_load_lds((const unsigned*)((const char*)(gbase) + (voff)[_i]), (PG8_LAS unsigned*)(lds + (bufoff) + ldsw + _i * 8192), 16, 0, 0); } while (0)
#define PG8_LDA(dst, b, h) do { _Pragma("unroll") for (int m = 0; m < 4; ++m) _Pragma("unroll") for (int k = 0; k < 2; ++k) dst[m][k] = *(const PG8_LAS bf16x8*)(lds + PG8_SA(b, h) + aoff + m * 2048 + k * 1024); } while (0)
#define PG8_LDB(dst, b, h) do { _Pragma("unroll") for (int n = 0; n < 2; ++n) _Pragma("unroll") for (int k = 0; k < 2; ++k) dst[n][k] = *(const PG8_LAS bf16x8*)(lds + PG8_SB(b, h) + boff + n * 2048 + k * 1024); } while (0)
#define PG8_MMA(ai, bj, At, Bt) do { __builtin_amdgcn_s_setprio(1); _Pragma("unroll") for (int m = 0; m < 4; ++m) _Pragma("unroll") for (int n = 0; n < 2; ++n) _Pragma("unroll") for (int k = 0; k < 2; ++k) \
        acc[ai][bj][m][n] = __builtin_amdgcn_mfma_f32_16x16x32_bf16(Bt[n][k], At[m][k], acc[ai][bj][m][n], 0, 0, 0); __builtin_amdgcn_s_setprio(0); } while (0)
#define PG8_WAIT_V(n) asm volatile("s_waitcnt vmcnt(" #n ")" ::: "memory")
#define PG8_WAIT_L(n) asm volatile("s_waitcnt lgkmcnt(" #n ")" ::: "memory")
#define PG8_BAR __builtin_amdgcn_s_barrier()
#define PG8_SCHED __builtin_amdgcn_sched_barrier(0)
    Unit cur, nxt; int ui = 0;
    if (!S.next(0, cur)) return;
    f32x4 acc[2][2][4][2];
#pragma unroll
    for (int a = 0; a < 2; ++a)
#pragma unroll
        for (int b = 0; b < 2; ++b)
#pragma unroll
            for (int m = 0; m < 4; ++m)
#pragma unroll
                for (int n = 0; n < 2; ++n) acc[a][b][m][n] = (f32x4){0.f, 0.f, 0.f, 0.f};
    bf16x8 At[4][2], B0[2][2], B1[2][2];
    const char* cA = (const char*)g.A + (size_t)cur.pm * tstep; const char* cB = (const char*)g.Bt + (size_t)cur.e * g.bstride + (size_t)cur.pn * tstep;
    S.a_ready(cur);
    if constexpr (SP2) {
        PG8_STAGE(PG8_SB(0, 0), cB, voffB); PG8_STAGE(PG8_SB(0, 1), cB + hstep, voffB); PG8_STAGE(PG8_SA(0, 0), cA, voffA); PG8_STAGE(PG8_SA(0, 1), cA + hstep, voffA);
        if (wr == 1) PG8_BAR;
        PG8_WAIT_V(2); PG8_BAR;
        PG8_STAGE(PG8_SB(1, 0), cB + kstep, voffB); PG8_STAGE(PG8_SA(1, 0), cA + kstep, voffA); PG8_STAGE(PG8_SB(1, 1), cB + hstep + kstep, voffB);
        PG8_WAIT_V(6); PG8_BAR;
    } else {
        PG8_STAGE(PG8_SB(0, 0), cB, voffB); PG8_STAGE(PG8_SA(0, 0), cA, voffA); PG8_STAGE(PG8_SB(0, 1), cB + hstep, voffB); PG8_STAGE(PG8_SA(0, 1), cA + hstep, voffA);
        if (wr == 1) PG8_BAR;
        PG8_WAIT_V(4); PG8_BAR;
        PG8_STAGE(PG8_SB(1, 0), cB + kstep, voffB); PG8_STAGE(PG8_SA(1, 0), cA + kstep, voffA); PG8_STAGE(PG8_SB(1, 1), cB + hstep + kstep, voffB);
        PG8_WAIT_V(6); PG8_BAR;
    }
    for (;;) {
        const bool has_next = S.next(ui + 1, nxt);
        const char* nA = has_next ? (const char*)g.A + (size_t)nxt.pm * tstep : cA; const char* nB = has_next ? (const char*)g.Bt + (size_t)nxt.e * g.bstride + (size_t)nxt.pn * tstep : cB;
        for (int t = 0; t < nt; t += 2) {
            const bool last = (t == nt - 2);
            const char* a1 = cA + (size_t)(t + 1) * kstep;
            const char* a2 = last ? nA : cA + (size_t)(t + 2) * kstep; const char* b2 = last ? nB : cB + (size_t)(t + 2) * kstep;
            const char* a3 = a2 + kstep; const char* b3 = b2 + kstep;
            if (last && has_next) S.a_ready(nxt);
            if constexpr (SP2) {
            PG8_LDB(B0, 0, 0); PG8_LDB(B1, 0, 1); PG8_SCHED; PG8_LDA(At, 0, 0); PG8_STAGE(PG8_SA(1, 1), a1 + hstep, voffA);
            PG8_WAIT_V(8); PG8_WAIT_L(0); PG8_BAR; PG8_MMA(0, 0, At, B0); PG8_MMA(0, 1, At, B1); PG8_BAR; PG8_SCHED;
            PG8_LDA(At, 0, 1); PG8_STAGE(PG8_SB(0, 0), b2, voffB); PG8_STAGE(PG8_SB(0, 1), b2 + hstep, voffB); PG8_STAGE(PG8_SA(0, 0), a2, voffA);
            PG8_WAIT_V(8); PG8_WAIT_L(0); PG8_BAR; PG8_MMA(1, 0, At, B0); PG8_MMA(1, 1, At, B1); PG8_BAR; PG8_SCHED;
            PG8_LDB(B0, 1, 0); PG8_LDB(B1, 1, 1); PG8_SCHED; PG8_LDA(At, 1, 0); PG8_STAGE(PG8_SA(0, 1), a2 + hstep, voffA);
            PG8_WAIT_V(8); PG8_WAIT_L(0); PG8_BAR; PG8_MMA(0, 0, At, B0); PG8_MMA(0, 1, At, B1); PG8_BAR; PG8_SCHED;
            PG8_LDA(At, 1, 1); PG8_STAGE(PG8_SB(1, 0), b3, voffB); PG8_STAGE(PG8_SB(1, 1), b3 + hstep, voffB); PG8_STAGE(PG8_SA(1, 0), a3, voffA);
            PG8_WAIT_V(8); PG8_WAIT_L(0); PG8_BAR; PG8_MMA(1, 0, At, B0); PG8_MMA(1, 1, At, B1); PG8_BAR; PG8_SCHED;
            } else {
            PG8_LDB(B0, 0, 0); PG8_SCHED; PG8_LDA(At, 0, 0); PG8_STAGE(PG8_SA(1, 1), a1 + hstep, voffA);
            PG8_WAIT_L(8); PG8_BAR; PG8_WAIT_L(0); PG8_MMA(0, 0, At, B0); PG8_BAR; PG8_SCHED;
            PG8_LDB(B1, 0, 1); PG8_STAGE(PG8_SB(0, 0), b2, voffB);
            PG8_BAR; PG8_WAIT_L(0); PG8_MMA(0, 1, At, B1); PG8_BAR;
            PG8_LDA(At, 0, 1); PG8_STAGE(PG8_SA(0, 0), a2, voffA);
            PG8_BAR; PG8_WAIT_L(0); PG8_MMA(1, 0, At, B0); PG8_BAR; PG8_SCHED;
            PG8_STAGE(PG8_SB(0, 1), b2 + hstep, voffB);
            PG8_WAIT_V(6); PG8_BAR; PG8_MMA(1, 1, At, B1); PG8_BAR;
            PG8_LDB(B0, 1, 0); PG8_SCHED; PG8_LDA(At, 1, 0); PG8_STAGE(PG8_SA(0, 1), a2 + hstep, voffA);
            PG8_WAIT_L(8); PG8_BAR; PG8_WAIT_L(0); PG8_MMA(0, 0, At, B0); PG8_BAR; PG8_SCHED;
            PG8_LDB(B1, 1, 1); PG8_STAGE(PG8_SB(1, 0), b3, voffB);
            PG8_BAR; PG8_WAIT_L(0); PG8_MMA(0, 1, At, B1); PG8_BAR;
            PG8_LDA(At, 1, 1); PG8_STAGE(PG8_SA(1, 0), a3, voffA);
            PG8_BAR; PG8_WAIT_L(0); PG8_MMA(1, 0, At, B0); PG8_BAR; PG8_SCHED;
            PG8_STAGE(PG8_SB(1, 1), b3 + hstep, voffB);
            PG8_WAIT_V(6); PG8_BAR; PG8_MMA(1, 1, At, B1); PG8_BAR;
            }
        }
        if constexpr (ALIGN_EPI) { if (wr == 0) PG8_BAR; }
        if constexpr (!Epi::AFTER_DRAIN) { E(acc, cur, wr, wc, fr, fq); S.done(cur); }
        if (!has_next) break;
#pragma unroll
        for (int a = 0; a < 2; ++a)
#pragma unroll
            for (int b = 0; b < 2; ++b)
#pragma unroll
                for (int m = 0; m < 4; ++m)
#pragma unroll
                    for (int n = 0; n < 2; ++n) acc[a][b][m][n] = (f32x4){0.f, 0.f, 0.f, 0.f};
        cur = nxt; cA = nA; cB = nB; ++ui;
        if constexpr (ALIGN_EPI) { if (wr == 1) PG8_BAR; }
    }
    PG8_WAIT_V(0);
    if constexpr (!ALIGN_EPI) { if (wr == 0) PG8_BAR; }
    PG8_BAR;
    if constexpr (Epi::AFTER_DRAIN) { E.fused(acc, cur, wr, wc, fr, fq, lds, wid, lane); S.done(cur); }
#undef PG8_SA
#undef PG8_SB
#undef PG8_STAGE
#undef PG8_LDA
#undef PG8_LDB
#undef PG8_MMA
#undef PG8_WAIT_V
#undef PG8_WAIT_L
#undef PG8_BAR
#undef PG8_SCHED
}

}

constexpr int D = 1024, NB = 8, SEQ = 2048, DEPTH = 4, LEAD = 128, FIRSTV = 112, LT = LEAD + SEQ, NTOK = NB * LT;
constexpr int WIN = 3584, FFD = 2816, FFE = 3584, NE = 8, MAXSLOT = 36864;
constexpr float EPS = 1e-6f;
constexpr int NPHASE = 1 + 8 * DEPTH;

constexpr size_t MiB = 1u << 20;
constexpr size_t WS_CTL = 0, CTL_ZERO_BYTES = MiB;
constexpr size_t WS_TAB = 1 * MiB;
constexpr size_t WS_WIN = 2 * MiB;
constexpr size_t WS_WOUT = WS_WIN + 28 * MiB;
constexpr size_t WS_WD13 = WS_WOUT + 8 * MiB;
constexpr size_t WS_WD2 = WS_WD13 + 22 * MiB;
constexpr size_t WS_WM13 = WS_WD2 + 11 * MiB;
constexpr size_t WS_WM2 = WS_WM13 + 224 * MiB;
constexpr size_t WS_H = WS_WM2 + 112 * MiB;
constexpr size_t WS_HB = WS_H + 68 * MiB;
constexpr size_t WS_SSQ = WS_HB + 34 * MiB;
constexpr size_t WS_ROUTE = WS_SSQ + 2 * MiB;
constexpr size_t WS_ACT = WS_ROUTE + 2 * MiB;
constexpr size_t WS_XG = WS_ACT + 252 * MiB;
constexpr size_t WS_END = WS_XG + 72 * MiB;
constexpr size_t ACT_PROJ = 0, ACT_LOGF = 119 * MiB, ACT_MIX = 153 * MiB;
constexpr size_t TAB_LB = 0, TAB_BIAS = 8192, TAB_LAM = 12288, TAB_SUBLN = 12544, TAB_HGNW = 14592, TAB_RF = 20480, TAB_FNORM = 20480 + 65536;
constexpr size_t ROUTE_INFO = 0, ROUTE_LIST = 640 * 1024, ROUTE_RSTD = 1280 * 1024;
constexpr int CW_TMO = 0, CW_BAR = 4096, CW_CNT = 8192;

constexpr int RING_BYTES = 131072, MISC_OFF = RING_BYTES + 320, LDS_BYTES = 147456;

#define GAS __attribute__((address_space(1)))
#define LAS __attribute__((address_space(3)))
typedef unsigned short bf16;
typedef unsigned v4u __attribute__((ext_vector_type(4)));
typedef unsigned v2u __attribute__((ext_vector_type(2)));
typedef float f32x4 __attribute__((ext_vector_type(4)));
typedef GAS unsigned gu32;
#define RLX_AGENT __ATOMIC_RELAXED, __HIP_MEMORY_SCOPE_AGENT
#define LDS_WAIT() asm volatile("s_waitcnt lgkmcnt(0)" ::: "memory")
__device__ __forceinline__ unsigned f2bf(float f) { unsigned u = __builtin_bit_cast(unsigned, f); return (u + 0x7fffu + ((u >> 16) & 1u)) >> 16; }
__device__ __forceinline__ unsigned pk2(float lo, float hi) { return f2bf(lo) | (f2bf(hi) << 16); }
__device__ __forceinline__ float bf_lo(unsigned w) { return __builtin_bit_cast(float, w << 16); }
__device__ __forceinline__ float bf_hi(unsigned w) { return __builtin_bit_cast(float, w & 0xffff0000u); }
__device__ __forceinline__ float silu_f(float x) { return x / (1.f + __expf(-x)); }
__device__ __forceinline__ float wave_sum(float v) {
#pragma unroll
    for (int o = 1; o < 64; o <<= 1) v += __shfl_xor(v, o);
    return v;
}

#define XB_TMO      128
#define XB_XCNT(j)  (256  + 64 * (j))
#define XB_XSUB(j)  (1280 + 64 * (j))
#define XB_XGEN(j)  (2304 + 64 * (j))
#define XB_TOP      3328
#define XB_TOPGEN   3392
#define XCD_BAR_WORDS 3456
#define XB_SPIN_CAP (1u << 18)

__device__ __forceinline__ unsigned xb_ld(unsigned* p)              { return __hip_atomic_load(p, __ATOMIC_RELAXED, __HIP_MEMORY_SCOPE_AGENT); }
__device__ __forceinline__ unsigned xb_add(unsigned* p, unsigned v) { return __hip_atomic_fetch_add(p, v, __ATOMIC_RELAXED, __HIP_MEMORY_SCOPE_AGENT); }
__device__ __forceinline__ unsigned xb_xcc_id() { return (unsigned)__builtin_amdgcn_s_getreg((3 << 11) | 20) & 0xFu; }
#define XB_SPIN(cond, bar) do { unsigned _sp = 0; while (cond) { __builtin_amdgcn_s_sleep(1); \
    if ((++_sp & 255u) == 0u) { if (xb_ld(&(bar)[XB_TMO])) break; if (_sp > XB_SPIN_CAP) { atomicAdd(&(bar)[XB_TMO], 1u); break; } } } } while (0)

struct XcdBarrier {
    unsigned* bar; unsigned x;
    volatile LAS unsigned* st;
};

__device__ __forceinline__ XcdBarrier xcd_barrier_post(unsigned* bar, volatile LAS unsigned* st) {
    XcdBarrier b; b.bar = bar; b.x = xb_xcc_id(); b.st = st;
    if (threadIdx.x == 0) (void)xb_add(&bar[XB_XCNT(b.x)], 1u);
    return b;
}
__device__ __forceinline__ void xcd_barrier_complete(unsigned* bar, unsigned x, unsigned& nloc, unsigned& nx) {
    const unsigned G = gridDim.x * gridDim.y * gridDim.z;
    unsigned sum, cnt, mine, sp = 0u;
    for (;;) {
        sum = 0u; cnt = 0u; mine = 0u;
#pragma unroll
        for (unsigned j = 0; j < 16; ++j) { const unsigned c = xb_ld(&bar[XB_XCNT(j)]); sum += c; cnt += (c > 0u) ? 1u : 0u; mine = (j == x) ? c : mine; }
        if (sum == G) break;
        __builtin_amdgcn_s_sleep(1);
        if ((++sp & 255u) == 0u) { if (xb_ld(&bar[XB_TMO])) break; if (sp > XB_SPIN_CAP) { atomicAdd(&bar[XB_TMO], 1u); break; } }
    }
    nloc = mine > 0u ? mine : 1u; nx = cnt > 0u ? cnt : 1u;
}

__device__ __forceinline__ void xcd_barrier(const XcdBarrier& b) {
    asm volatile("s_waitcnt vmcnt(0)" ::: "memory");
    __syncthreads();
    if (threadIdx.x == 0) {
        unsigned* bar = b.bar;
        __builtin_amdgcn_s_waitcnt(0);
        unsigned nloc = b.st[0], nx = b.st[1];
        if (nloc == 0u) { xcd_barrier_complete(bar, b.x, nloc, nx); b.st[0] = nloc; b.st[1] = nx; }
        const unsigned old = xb_add(&bar[XB_XSUB(b.x)], 1u);
        const unsigned gen = old / nloc;
        if (old + 1u == (gen + 1u) * nloc) {
            __builtin_amdgcn_fence(__ATOMIC_RELEASE, "agent");
            asm volatile("s_waitcnt vmcnt(0)" ::: "memory");
            const unsigned og = xb_add(&bar[XB_TOP], 1u);
            const unsigned tg = og / nx;
            if (og + 1u == (tg + 1u) * nx) xb_add(&bar[XB_TOPGEN], 1u);
            else XB_SPIN(xb_ld(&bar[XB_TOPGEN]) == tg, bar);
            __builtin_amdgcn_fence(__ATOMIC_ACQUIRE, "agent");
            xb_add(&bar[XB_XGEN(b.x)], 1u);
            asm volatile("s_waitcnt vmcnt(0)" ::: "memory");
        } else {
            XB_SPIN(xb_ld(&bar[XB_XGEN(b.x)]) == gen, bar);
            __builtin_amdgcn_fence(__ATOMIC_ACQUIRE, "agent");
            asm volatile("s_waitcnt vmcnt(0)" ::: "memory");
        }
    }
    __syncthreads();
}


static __device__ const unsigned char T5B[129] = {0, 1, 2, 3, 4, 5, 6, 7, 8, 9, 10, 11, 12, 13, 14, 15, 16, 16, 16, 17, 17, 18, 18, 18, 19, 19, 19, 20, 20, 20, 20, 21, 21, 21, 21, 22, 22, 22, 22, 22, 23, 23, 23, 23, 23, 23, 24, 24, 24, 24, 24, 24, 25, 25, 25, 25, 25, 25, 25, 26, 26, 26, 26, 26, 26, 26, 26, 27, 27, 27, 27, 27, 27, 27, 27, 27, 27, 28, 28, 28, 28, 28, 28, 28, 28, 28, 28, 29, 29, 29, 29, 29, 29, 29, 29, 29, 29, 29, 29, 30, 30, 30, 30, 30, 30, 30, 30, 30, 30, 30, 30, 30, 30, 31, 31, 31, 31, 31, 31, 31, 31, 31, 31, 31, 31, 31, 31, 31, 31};

struct Ctx {
    LAS unsigned char* lds;
    int tid, lane, wave, G, bid;
    float* out;
    unsigned char* ws;
    __device__ __forceinline__ gu32* ctl() const { return (gu32*)(ws + WS_CTL); }
    __device__ __forceinline__ float* H() const { return (float*)(ws + WS_H); }
    __device__ __forceinline__ bf16* HB() const { return (bf16*)(ws + WS_HB); }
    __device__ __forceinline__ float* SSQ() const { return (float*)(ws + WS_SSQ); }
    __device__ __forceinline__ bf16* PROJ() const { return (bf16*)(ws + WS_ACT + ACT_PROJ); }
    __device__ __forceinline__ float* LOGF() const { return (float*)(ws + WS_ACT + ACT_LOGF); }
    __device__ __forceinline__ bf16* MIX() const { return (bf16*)(ws + WS_ACT + ACT_MIX); }
    __device__ __forceinline__ bf16* T() const { return (bf16*)(ws + WS_ACT); }
    __device__ __forceinline__ bf16* XG() const { return (bf16*)(ws + WS_XG); }
    __device__ __forceinline__ bf16* Y() const { return (bf16*)(ws + WS_XG); }
    __device__ __forceinline__ float* LB() const { return (float*)(ws + WS_TAB + TAB_LB); }
    __device__ __forceinline__ float* BIAST() const { return (float*)(ws + WS_TAB + TAB_BIAS); }
    __device__ __forceinline__ float* LAM() const { return (float*)(ws + WS_TAB + TAB_LAM); }
    __device__ __forceinline__ float* RF() const { return (float*)(ws + WS_TAB + TAB_RF); }
    __device__ __forceinline__ float* SUBLN() const { return (float*)(ws + WS_TAB + TAB_SUBLN); }
    __device__ __forceinline__ float* HGNW() const { return (float*)(ws + WS_TAB + TAB_HGNW); }
    __device__ __forceinline__ float* FNORM() const { return (float*)(ws + WS_TAB + TAB_FNORM); }
    __device__ __forceinline__ unsigned* TINFO() const { return (unsigned*)(ws + WS_ROUTE + ROUTE_INFO); }
    __device__ __forceinline__ int* LIST() const { return (int*)(ws + WS_ROUTE + ROUTE_LIST); }
    __device__ __forceinline__ float* RSTD() const { return (float*)(ws + WS_ROUTE + ROUTE_RSTD); }
};
struct Args { const float* in[19]; float* out; unsigned char* ws; int ph_lo, ph_hi; };
enum { IN_X = 0, IN_META, IN_RELB, IN_NMIX, IN_WIN, IN_LBL, IN_HGNW, IN_LAMBDA, IN_SUBLN, IN_WOUT, IN_NFFN, IN_DW1, IN_DW3, IN_DW2, IN_ROUTER, IN_MW1, IN_MW3, IN_MW2, IN_FNORM };

__device__ __forceinline__ float row_rstd(const float* ssq, int row) {
    const f32x4* p = (const f32x4*)(ssq + (size_t)row * 16);
    const f32x4 a = p[0], b = p[1], c = p[2], d = p[3];
    const float s = ((a[0] + a[1]) + (a[2] + a[3])) + ((b[0] + b[1]) + (b[2] + b[3])) + ((c[0] + c[1]) + (c[2] + c[3])) + ((d[0] + d[1]) + (d[2] + d[3]));
    return rsqrtf(s * (1.0f / 1024.0f) + EPS);
}
template <int N> __device__ __forceinline__ float dpp_row_shr(float x) {
    return __builtin_bit_cast(float, __builtin_amdgcn_update_dpp(0, __builtin_bit_cast(int, x), 0x110 + N, 0xf, 0xf, true));
}
struct EpiProj {
    static constexpr bool PERM = true, AFTER_DRAIN = false;
    bf16* proj; float* logfp; const float* ssq; const float* lb;
    template <int AI, int BJ, int NN> __device__ __forceinline__ void hf_block(const pg8::f32x4 (&acc)[2][2][4][2], int row0, int colb) const {
        const int c0 = colb + BJ * 128 + 4 * NN, cc = c0 - 512;
        const f32x4 l0 = *(const f32x4*)(lb + cc);
        float lf[4][4];
#pragma unroll
        for (int m = 0; m < 4; ++m) {
            const int row = row0 + AI * 128 + m * 16;
            const float r = row_rstd(ssq, row);
            const bool valid = (row % LT) >= FIRSTV;
            float kx[4];
#pragma unroll
            for (int j = 0; j < 4; ++j) {
                const float lbv = l0[j];
                const float xx = acc[AI][BJ][m][NN][j] * r;
                const float ls = fminf(xx, 0.f) - log1pf(expf(-fabsf(xx)));
                float lgf = (lbv > 0.f) ? logf(lbv + (1.f - lbv) * expf(ls)) : ls;
                float kk = (1.f - lbv) * expf(ls - xx);
                if (!valid) { lgf = 0.f; kk = 0.f; }
                lf[m][j] = lgf; kx[j] = kk;
            }
            v2u w; w.x = pg8::cvt_pk_bf16(kx[0], kx[1]); w.y = pg8::cvt_pk_bf16(kx[2], kx[3]);
            *(v2u*)(proj + (size_t)row * WIN + c0) = w;
        }
#pragma unroll
        for (int j = 0; j < 4; ++j) {
            float carry = 0.f;
#pragma unroll
            for (int m = 0; m < 4; ++m) {
                float x = lf[m][j];
                x += dpp_row_shr<1>(x); x += dpp_row_shr<2>(x); x += dpp_row_shr<4>(x); x += dpp_row_shr<8>(x);
                x += carry;
                carry = __shfl(x, 15, 16);
                lf[m][j] = x;
            }
        }
#pragma unroll
        for (int m = 0; m < 4; ++m) *(f32x4*)(logfp + (size_t)(row0 + AI * 128 + m * 16) * 512 + cc) = (f32x4){lf[m][0], lf[m][1], lf[m][2], lf[m][3]};
    }
    __device__ __forceinline__ void operator()(const pg8::f32x4 (&acc)[2][2][4][2], const pg8::Unit& u, int wr, int wc, int fr, int fq) const {
        const int grp = u.pn >> 1;
        const int row0 = u.pm * 256 + wr * 64 + fr, colb = u.pn * 256 + wc * 32 + 8 * fq;
        if (grp == 1) {
            hf_block<0, 0, 0>(acc, row0, colb); hf_block<0, 0, 1>(acc, row0, colb); hf_block<0, 1, 0>(acc, row0, colb); hf_block<0, 1, 1>(acc, row0, colb);
            hf_block<1, 0, 0>(acc, row0, colb); hf_block<1, 0, 1>(acc, row0, colb); hf_block<1, 1, 0>(acc, row0, colb); hf_block<1, 1, 1>(acc, row0, colb);
            return;
        }
#pragma unroll
        for (int ai = 0; ai < 2; ++ai)
#pragma unroll
            for (int m = 0; m < 4; ++m) {
                const int row = row0 + ai * 128 + m * 16;
                const float r = row_rstd(ssq, row);
#pragma unroll
                for (int bj = 0; bj < 2; ++bj) {
                    const int c0 = colb + bj * 128;
                    float x[8];
#pragma unroll
                    for (int j = 0; j < 4; ++j) { x[j] = acc[ai][bj][m][0][j] * r; x[4 + j] = acc[ai][bj][m][1][j] * r; }
                    if (grp == 0 || grp == 3) {
#pragma unroll
                        for (int j = 0; j < 8; ++j) x[j] = silu_f(x[j]);
                    } else if (grp == 4) {
#pragma unroll
                        for (int j = 0; j < 8; ++j) x[j] *= 0.18033688011112042f;
                    }
                    v4u w; w.x = pg8::cvt_pk_bf16(x[0], x[1]); w.y = pg8::cvt_pk_bf16(x[2], x[3]); w.z = pg8::cvt_pk_bf16(x[4], x[5]); w.w = pg8::cvt_pk_bf16(x[6], x[7]);
                    *(v4u*)(proj + (size_t)row * WIN + c0) = w;
                }
            }
    }
};
struct EpiResid {
    static constexpr bool PERM = true, AFTER_DRAIN = false;
    float* H; bf16* HB; float* ssq;
    __device__ __forceinline__ void operator()(const pg8::f32x4 (&acc)[2][2][4][2], const pg8::Unit& u, int wr, int wc, int fr, int fq) const {
        const int row0 = u.pm * 256 + wr * 64 + fr, colb = u.pn * 256 + wc * 32 + 8 * fq;
#pragma unroll
        for (int ai = 0; ai < 2; ++ai)
#pragma unroll
            for (int m = 0; m < 4; ++m) {
                const int row = row0 + ai * 128 + m * 16;
                float s = 0.f;
#pragma unroll
                for (int bj = 0; bj < 2; ++bj) {
                    const int c0 = colb + bj * 128;
                    float* hp = H + (size_t)row * D + c0;
                    f32x4 h0 = *(const f32x4*)hp, h1 = *(const f32x4*)(hp + 4);
                    h0 = h0 + acc[ai][bj][m][0]; h1 = h1 + acc[ai][bj][m][1];
                    *(f32x4*)hp = h0; *(f32x4*)(hp + 4) = h1;
                    s += (h0[0] * h0[0] + h0[1] * h0[1]) + (h0[2] * h0[2] + h0[3] * h0[3]) + (h1[0] * h1[0] + h1[1] * h1[1]) + (h1[2] * h1[2] + h1[3] * h1[3]);
                    v4u w; w.x = pg8::cvt_pk_bf16(h0[0], h0[1]); w.y = pg8::cvt_pk_bf16(h0[2], h0[3]); w.z = pg8::cvt_pk_bf16(h1[0], h1[1]); w.w = pg8::cvt_pk_bf16(h1[2], h1[3]);
                    *(v4u*)(HB + (size_t)row * D + c0) = w;
                }
                s += __shfl_xor(s, 16); s += __shfl_xor(s, 32);
                if (fq == 0) ssq[(size_t)row * 16 + u.pn * 4 + wc] = s;
            }
    }
};
struct EpiGLU {
    static constexpr bool PERM = true, AFTER_DRAIN = false;
    bf16* T; int ldt; const float* ssq;
    __device__ __forceinline__ void operator()(const pg8::f32x4 (&acc)[2][2][4][2], const pg8::Unit& u, int wr, int wc, int fr, int fq) const {
        const int row0 = u.pm * 256 + wr * 64 + fr, colb = u.pn * 128 + wc * 32 + 8 * fq;
#pragma unroll
        for (int ai = 0; ai < 2; ++ai)
#pragma unroll
            for (int m = 0; m < 4; ++m) {
                const int row = row0 + ai * 128 + m * 16;
                const float r = ssq ? row_rstd(ssq, row) : 1.f;
                float x[8];
#pragma unroll
                for (int j = 0; j < 4; ++j) { x[j] = silu_f(acc[ai][0][m][0][j] * r) * (acc[ai][1][m][0][j] * r); x[4 + j] = silu_f(acc[ai][0][m][1][j] * r) * (acc[ai][1][m][1][j] * r); }
                v4u w; w.x = pg8::cvt_pk_bf16(x[0], x[1]); w.y = pg8::cvt_pk_bf16(x[2], x[3]); w.z = pg8::cvt_pk_bf16(x[4], x[5]); w.w = pg8::cvt_pk_bf16(x[6], x[7]);
                *(v4u*)(T + (size_t)row * ldt + colb) = w;
            }
    }
};
struct EpiY {
    static constexpr bool PERM = true, AFTER_DRAIN = false;
    bf16* Y;
    __device__ __forceinline__ void operator()(const pg8::f32x4 (&acc)[2][2][4][2], const pg8::Unit& u, int wr, int wc, int fr, int fq) const {
        const int row0 = u.pm * 256 + wr * 64 + fr, colb = u.pn * 256 + wc * 32 + 8 * fq;
#pragma unroll
        for (int ai = 0; ai < 2; ++ai)
#pragma unroll
            for (int m = 0; m < 4; ++m) {
                const int row = row0 + ai * 128 + m * 16;
#pragma unroll
                for (int bj = 0; bj < 2; ++bj) {
                    const pg8::f32x4 a = acc[ai][bj][m][0], b = acc[ai][bj][m][1];
                    v4u w; w.x = pg8::cvt_pk_bf16(a[0], a[1]); w.y = pg8::cvt_pk_bf16(a[2], a[3]); w.z = pg8::cvt_pk_bf16(b[0], b[1]); w.w = pg8::cvt_pk_bf16(b[2], b[3]);
                    *(v4u*)(Y + (size_t)row * D + colb + bj * 128) = w;
                }
            }
    }
};

__device__ __forceinline__ void transpose_item(const float* W, const float* fold, int K, int N, bf16* WT, int k0, int n0, int drow0, LAS float* scr, int lane) {
#pragma unroll 8
    for (int i = 0; i < 32; ++i) { const int kk = 2 * i + (lane >> 5); const float f = fold ? fold[k0 + kk] : 1.f; scr[kk * 33 + (lane & 31)] = W[(size_t)(k0 + kk) * N + n0 + (lane & 31)] * f; }
    LDS_WAIT(); asm volatile("" ::: "memory");
    const int c = lane & 7;
#pragma unroll
    for (int j = 0; j < 4; ++j) { const int n = (lane >> 3) + 8 * j; const LAS float* s = scr + (8 * c) * 33 + n;
        v4u o; o.x = pk2(s[0 * 33], s[1 * 33]); o.y = pk2(s[2 * 33], s[3 * 33]); o.z = pk2(s[4 * 33], s[5 * 33]); o.w = pk2(s[6 * 33], s[7 * 33]);
        *(GAS v4u*)(WT + (size_t)(drow0 + n) * K + k0 + 8 * c) = o; }
    LDS_WAIT(); asm volatile("" ::: "memory");
}
__device__ __forceinline__ void prologue_phase(Ctx& C, const Args& A) {
    LAS float* scr = (LAS float*)(C.lds + C.wave * 16384);
    const int gw = C.bid * 8 + C.wave, NGW = C.G * 8;
    constexpr int I_IN = 16 * 112, I_OUT = 16 * 32, I_D1 = 16 * 88, I_D2 = 44 * 32, I_M1 = 16 * 112, I_M2 = 56 * 32;
    constexpr int N_IN = 4 * I_IN, N_OUT = 4 * I_OUT, N_D1 = 2 * I_D1, N_D2 = 2 * I_D2, N_M1 = 16 * I_M1, N_M2 = 16 * I_M2;
    constexpr int NITEMS = N_IN + N_OUT + 2 * N_D1 + N_D2 + 2 * N_M1 + N_M2;
    for (int it = gw; it < NITEMS; it += NGW) {
        int r = it;
        const float* W; const float* fold = nullptr; bf16* WT; int K, N, glu = -1, loc;
        if (r < N_IN) { const int l = r / I_IN; loc = r % I_IN; W = A.in[IN_WIN] + (size_t)l * D * WIN; fold = A.in[IN_NMIX] + l * D; WT = (bf16*)(C.ws + WS_WIN) + (size_t)l * WIN * D; K = D; N = WIN; }
        else if ((r -= N_IN) < N_OUT) { const int l = r / I_OUT; loc = r % I_OUT; W = A.in[IN_WOUT] + (size_t)l * D * D; WT = (bf16*)(C.ws + WS_WOUT) + (size_t)l * D * D; K = D; N = D; }
        else if ((r -= N_OUT) < N_D1) { const int i = r / I_D1; loc = r % I_D1; W = A.in[IN_DW1] + (size_t)i * D * FFD; fold = A.in[IN_NFFN] + (2 * i) * D; WT = (bf16*)(C.ws + WS_WD13) + (size_t)i * 2 * FFD * D; K = D; N = FFD; glu = 0; }
        else if ((r -= N_D1) < N_D1) { const int i = r / I_D1; loc = r % I_D1; W = A.in[IN_DW3] + (size_t)i * D * FFD; fold = A.in[IN_NFFN] + (2 * i) * D; WT = (bf16*)(C.ws + WS_WD13) + (size_t)i * 2 * FFD * D; K = D; N = FFD; glu = 1; }
        else if ((r -= N_D1) < N_D2) { const int i = r / I_D2; loc = r % I_D2; W = A.in[IN_DW2] + (size_t)i * FFD * D; WT = (bf16*)(C.ws + WS_WD2) + (size_t)i * D * FFD; K = FFD; N = D; }
        else if ((r -= N_D2) < N_M1) { const int ie = r / I_M1; loc = r % I_M1; W = A.in[IN_MW1] + (size_t)ie * D * FFE; fold = A.in[IN_NFFN] + (2 * (ie >> 3) + 1) * D; WT = (bf16*)(C.ws + WS_WM13) + (size_t)ie * 2 * FFE * D; K = D; N = FFE; glu = 0; }
        else if ((r -= N_M1) < N_M1) { const int ie = r / I_M1; loc = r % I_M1; W = A.in[IN_MW3] + (size_t)ie * D * FFE; fold = A.in[IN_NFFN] + (2 * (ie >> 3) + 1) * D; WT = (bf16*)(C.ws + WS_WM13) + (size_t)ie * 2 * FFE * D; K = D; N = FFE; glu = 1; }
        else { r -= N_M1; const int ie = r / I_M2; loc = r % I_M2; W = A.in[IN_MW2] + (size_t)ie * FFE * D; WT = (bf16*)(C.ws + WS_WM2) + (size_t)ie * D * FFE; K = FFE; N = D; }
        const int nblk = N / 32, kb = loc / nblk, nb = loc % nblk, k0 = 64 * kb, n0 = 32 * nb;
        const int drow0 = (glu < 0) ? n0 : ((n0 >> 7) * 256 + glu * 128 + (n0 & 127));
        transpose_item(W, fold, K, N, WT, k0, n0, drow0, scr, C.lane);
    }
    for (int row = gw; row < NTOK; row += NGW) {
        const int b = row / LT, t = row % LT;
        f32x4 v[4]; float s = 0.f;
#pragma unroll
        for (int j = 0; j < 4; ++j) {
            const int col = 4 * C.lane + 256 * j;
            if (t < FIRSTV) v[j] = (f32x4){0.f, 0.f, 0.f, 0.f};
            else if (t < LEAD) v[j] = *(const f32x4*)(A.in[IN_META] + (size_t)(t - FIRSTV) * D + col);
            else v[j] = *(const f32x4*)(A.in[IN_X] + ((size_t)b * SEQ + (t - LEAD)) * D + col);
            s += (v[j][0] * v[j][0] + v[j][1] * v[j][1]) + (v[j][2] * v[j][2] + v[j][3] * v[j][3]);
            *(f32x4*)(C.H() + (size_t)row * D + col) = v[j];
            v2u w; w.x = pk2(v[j][0], v[j][1]); w.y = pk2(v[j][2], v[j][3]);
            *(v2u*)(C.HB() + (size_t)row * D + col) = w;
        }
        s = wave_sum(s);
        if (C.lane < 16) C.SSQ()[(size_t)row * 16 + C.lane] = (C.lane == 0) ? s : 0.f;
    }
    if (C.bid == 0) {
        const int tid = C.tid;
        {
            const float* lg = A.in[IN_LBL];
            const float a0 = lg[tid], a1 = lg[512 + tid], a2 = lg[1024 + tid], a3 = lg[1536 + tid];
            const float mx = fmaxf(fmaxf(a0, a1), fmaxf(a2, a3));
            const float e0 = expf(a0 - mx), e1 = expf(a1 - mx), e2 = expf(a2 - mx), e3 = expf(a3 - mx);
            const float inv = 1.f / (((e0 + e1) + e2) + e3);
            const float p0 = e0 * inv, p1 = e1 * inv, p2 = e2 * inv, p3 = e3 * inv;
            const float c0 = p0, c1 = c0 + p1, c2 = c1 + p2, c3 = c2 + p3;
            C.LB()[tid] = 0.f;
            C.LB()[512 + tid] = fminf(fmaxf(c1 - c0, 0.f), 0.999f);
            C.LB()[1024 + tid] = fminf(fmaxf(c2 - c0, 0.f), 0.999f);
            C.LB()[1536 + tid] = fminf(fmaxf(c3 - c0, 0.f), 0.999f);
        }
        for (int i = tid; i < 4 * 132; i += 512) { const int h = i / 132, d = i % 132; C.BIAST()[i] = (d <= 128) ? A.in[IN_RELB][T5B[d] * 4 + h] : 0.f; }
        if (tid < 4) {
            const float* lv = A.in[IN_LAMBDA] + tid * 256;
            float s01 = 0.f, s23 = 0.f;
            for (int j = 0; j < 64; ++j) { s01 += lv[j] * lv[64 + j]; s23 += lv[128 + j] * lv[192 + j]; }
            const float li = 0.8f - 0.6f * expf(-0.3f * (float)tid);
            C.LAM()[tid * 2] = expf(s01) - expf(s23) + li; C.LAM()[tid * 2 + 1] = li;
        }
        if (tid < 512) { C.SUBLN()[tid] = A.in[IN_SUBLN][tid]; C.HGNW()[tid] = A.in[IN_HGNW][tid]; C.FNORM()[tid] = A.in[IN_FNORM][tid]; C.FNORM()[512 + tid] = A.in[IN_FNORM][512 + tid]; }
        for (int i = tid; i < 2 * 8 * 1024; i += 512) { const int li = i >> 13, e = (i >> 10) & 7, k = i & 1023; C.RF()[i] = A.in[IN_NFFN][(2 * li + 1) * D + k] * A.in[IN_ROUTER][(size_t)li * D * NE + k * NE + e]; }
    }
}

__device__ __forceinline__ void hgrn_naive_unit(Ctx& C, int l, int b, int h) {
    LAS float* qf = (LAS float*)C.lds;
    LAS float* kf = qf + 2048; LAS float* ff = kf + 2048; LAS float* vv = ff + 2048; LAS float* gg = vv + 2048;
    LAS float* opart = gg + 2048;
    const int tid = C.tid, dv = tid & 127, qd = tid >> 7;
    const int ltok = tid >> 5, c4 = (tid & 31) * 4;
    float S[32];
#pragma unroll
    for (int j = 0; j < 32; ++j) S[j] = 0.f;
    const float* nw = C.HGNW() + l * 128;
    for (int tb = 0; tb < LT / 16; ++tb) {
        const size_t row = (size_t)b * LT + tb * 16 + ltok;
        {
            const bf16* pp = C.PROJ() + row * WIN + h * 128 + c4;
            const v2u wq = *(const v2u*)pp, wk = *(const v2u*)(pp + 512), wv = *(const v2u*)(pp + 1024), wg = *(const v2u*)(pp + 1536);
            const f32x4 lf = *(const f32x4*)(C.LOGF() + row * 512 + h * 128 + c4);
            const int o = ltok * 128 + c4;
            qf[o] = bf_lo(wq.x); qf[o + 1] = bf_hi(wq.x); qf[o + 2] = bf_lo(wq.y); qf[o + 3] = bf_hi(wq.y);
            kf[o] = bf_lo(wk.x); kf[o + 1] = bf_hi(wk.x); kf[o + 2] = bf_lo(wk.y); kf[o + 3] = bf_hi(wk.y);
            vv[o] = bf_lo(wv.x); vv[o + 1] = bf_hi(wv.x); vv[o + 2] = bf_lo(wv.y); vv[o + 3] = bf_hi(wv.y);
            gg[o] = bf_lo(wg.x); gg[o + 1] = bf_hi(wg.x); gg[o + 2] = bf_lo(wg.y); gg[o + 3] = bf_hi(wg.y);
            f32x4 lp = (f32x4){0.f, 0.f, 0.f, 0.f};
            if (((tb * 16 + ltok) & 63) != 0) lp = *(const f32x4*)(C.LOGF() + (row - 1) * 512 + h * 128 + c4);
            ff[o] = expf(lf[0] - lp[0]); ff[o + 1] = expf(lf[1] - lp[1]); ff[o + 2] = expf(lf[2] - lp[2]); ff[o + 3] = expf(lf[3] - lp[3]);
        }
        __syncthreads();
        for (int tok = 0; tok < 16; ++tok) {
            const float v = vv[tok * 128 + dv];
            const LAS f32x4* fp = (const LAS f32x4*)(ff + tok * 128 + 32 * qd);
            const LAS f32x4* kp = (const LAS f32x4*)(kf + tok * 128 + 32 * qd);
            const LAS f32x4* qp = (const LAS f32x4*)(qf + tok * 128 + 32 * qd);
            float a = 0.f;
#pragma unroll
            for (int j = 0; j < 8; ++j) {
                const f32x4 f4 = fp[j], k4 = kp[j], q4 = qp[j];
#pragma unroll
                for (int i = 0; i < 4; ++i) { S[4 * j + i] = f4[i] * S[4 * j + i] + k4[i] * v; a += q4[i] * S[4 * j + i]; }
            }
            opart[(tok * 4 + qd) * 128 + dv] = a;
        }
        __syncthreads();
        {
            float o[4]; float ss = 0.f;
#pragma unroll
            for (int i = 0; i < 4; ++i) { o[i] = (opart[(ltok * 4 + 0) * 128 + c4 + i] + opart[(ltok * 4 + 1) * 128 + c4 + i]) + (opart[(ltok * 4 + 2) * 128 + c4 + i] + opart[(ltok * 4 + 3) * 128 + c4 + i]); ss += o[i] * o[i]; }
#pragma unroll
            for (int m = 1; m < 32; m <<= 1) ss += __shfl_xor(ss, m);
            const float rs = rsqrtf(ss * (1.0f / 128.0f) + EPS);
            const int oo = ltok * 128 + c4;
            v2u w; w.x = pk2(o[0] * rs * nw[c4] * gg[oo], o[1] * rs * nw[c4 + 1] * gg[oo + 1]); w.y = pk2(o[2] * rs * nw[c4 + 2] * gg[oo + 2], o[3] * rs * nw[c4 + 3] * gg[oo + 3]);
            *(v2u*)(C.MIX() + row * D + h * 128 + c4) = w;
        }
        __syncthreads();
    }
}
typedef float f32x16 __attribute__((ext_vector_type(16)));
typedef short bf16x8 __attribute__((ext_vector_type(8)));
typedef short s16x4 __attribute__((ext_vector_type(4)));
constexpr float LOG2E = 1.4426950408889634f;
constexpr int AT_K = 0, AT_V = 32768, AT_BIAS = 65536, AT_WSF = 66560, AT_STG = 69632, AT_XCH = 0;
__device__ __forceinline__ int crow(int r, int hi) { return (r & 3) + 8 * (r >> 2) + 4 * hi; }
__device__ __forceinline__ s16x4 vtr(const LAS unsigned char* p) { typedef short v4i16_t __attribute__((ext_vector_type(4))); return __builtin_bit_cast(s16x4, __builtin_amdgcn_ds_read_tr16_b64_v4i16((LAS v4i16_t*)p)); }
__device__ __forceinline__ bf16x8 pack8(const f32x16& p, int b0) {
    v4u w; w.x = pg8::cvt_pk_bf16(p[b0 + 0], p[b0 + 1]); w.y = pg8::cvt_pk_bf16(p[b0 + 2], p[b0 + 3]); w.z = pg8::cvt_pk_bf16(p[b0 + 4], p[b0 + 5]); w.w = pg8::cvt_pk_bf16(p[b0 + 6], p[b0 + 7]);
    return __builtin_bit_cast(bf16x8, w);
}
__device__ __forceinline__ void attn_unit(Ctx& C, int l, int b, int h, int qi) {
    LAS unsigned char* lds = C.lds;
    const int tid = C.tid, lane = C.lane, wave = C.wave, rg = wave >> 1, c = wave & 1, r32 = lane & 31, hi = lane >> 5;
    const size_t rowbase = (size_t)b * LT;
    const bf16* PJ = C.PROJ();
    LAS float* biasl = (LAS float*)(lds + AT_BIAS);
    LAS float* wsf = (LAS float*)(lds + AT_WSF) + wave * 64;
    if (tid < 132) biasl[tid] = C.BIAST()[h * 132 + tid] * LOG2E;
    const float lam = C.LAM()[l * 2], lam_init = C.LAM()[l * 2 + 1];
    const int qw0 = 128 * qi + 32 * rg, tq = qw0 + r32;
    bf16x8 qr[4];
    { const bf16* qp = PJ + (rowbase + tq) * WIN + 2048 + h * 128 + c * 64 + 8 * hi;
#pragma unroll
      for (int ks = 0; ks < 4; ++ks) qr[ks] = *(const bf16x8*)(qp + 16 * ks); }
    const int kkey = tid >> 3, kch = tid & 7;
    const bf16* ksrc = PJ + (rowbase + kkey) * WIN + 2560 + h * 128 + kch * 8;
    const int kdst = kkey * 128 + ((kch ^ ((kkey >> 1) & 7)) * 16);
    const int vkey0 = tid >> 4, vch = tid & 15;
    const bf16* vsrc = PJ + (rowbase + vkey0) * WIN + 3072 + h * 128 + vch * 8;
    const int vdst0 = ((vkey0 >> 3) * 4 + (vch >> 2)) * 512 + (vkey0 & 7) * 64 + (vch & 3) * 16;
    v4u kreg0, kreg1, vreg0, vreg1;
#define AT_LOAD(kt) do { const size_t o_ = (size_t)(kt) * 64 * WIN; kreg0 = *(const v4u*)(ksrc + o_); kreg1 = *(const v4u*)(ksrc + o_ + 64); vreg0 = *(const v4u*)(vsrc + o_); vreg1 = *(const v4u*)(vsrc + o_ + (size_t)32 * WIN); } while (0)
#define AT_STORE(buf) do { *(LAS v4u*)(lds + AT_K + (buf) * 16384 + kdst) = kreg0; *(LAS v4u*)(lds + AT_K + (buf) * 16384 + 8192 + kdst) = kreg1; \
        *(LAS v4u*)(lds + AT_V + (buf) * 16384 + vdst0) = vreg0; *(LAS v4u*)(lds + AT_V + (buf) * 16384 + 8192 + vdst0) = vreg1; } while (0)
    const int nt = 2 * qi + 1;
    AT_LOAD(1); AT_STORE(0);
    __syncthreads();
    f32x16 o[4];
#pragma unroll
    for (int d = 0; d < 4; ++d)
#pragma unroll
        for (int r = 0; r < 16; ++r) o[d][r] = 0.f;
    float mref = -1e30f, lsum = 0.f;
    const int kswz = (r32 >> 1) & 7;
    const int vb = (4 * hi + ((lane & 15) >> 2)) * 64 + ((lane >> 4) & 1) * 32 + (lane & 3) * 8;
    const float b128 = biasl[128];
    for (int it = 0; it < nt; ++it) {
        const int kt = it + 1, buf = it & 1, k0 = 64 * kt;
        if (it + 1 < nt) AT_LOAD(kt + 1);
        if (k0 <= qw0 + 31) {
            const bool near = (k0 + 63 > qw0 - 128) || (kt == 1);
            f32x16 p0, p1;
            { const float ini = near ? 0.f : b128;
#pragma unroll
              for (int r = 0; r < 16; ++r) { p0[r] = ini; p1[r] = ini; } }
            const LAS unsigned char* kb = lds + AT_K + buf * 16384 + c * 8192 + r32 * 128;
#pragma unroll
            for (int ks = 0; ks < 4; ++ks) {
                const int off = ((2 * ks + hi) ^ kswz) * 16;
                const bf16x8 k0f = *(const LAS bf16x8*)(kb + off), k1f = *(const LAS bf16x8*)(kb + 4096 + off);
                p0 = __builtin_amdgcn_mfma_f32_32x32x16_bf16(k0f, qr[ks], p0, 0, 0, 0);
                p1 = __builtin_amdgcn_mfma_f32_32x32x16_bf16(k1f, qr[ks], p1, 0, 0, 0);
            }
            if (near) {
#pragma unroll
                for (int r = 0; r < 16; ++r) {
                    const int tk = k0 + crow(r, hi), d0 = tq - tk, d1 = d0 - 32;
                    const float b0 = biasl[d0 < 0 ? 0 : (d0 > 128 ? 128 : d0)], b1 = biasl[d1 < 0 ? 0 : (d1 > 128 ? 128 : d1)];
                    p0[r] = (d0 < 0 || tk < FIRSTV) ? -INFINITY : p0[r] + b0;
                    p1[r] = (d1 < 0 || tk + 32 < FIRSTV) ? -INFINITY : p1[r] + b1;
                }
            }
            float mx = fmaxf(p0[0], p1[0]);
#pragma unroll
            for (int r = 1; r < 16; ++r) mx = fmaxf(fmaxf(mx, p0[r]), p1[r]);
            mx = fmaxf(mx, __shfl_xor(mx, 32));
            if (__any(mx > mref + 8.0f)) {
                const float mnew = fmaxf(mref, mx), f = __builtin_amdgcn_exp2f(mref - mnew);
                lsum *= f; mref = mnew;
                if (hi == 0) wsf[r32] = f;
                LDS_WAIT(); asm volatile("" ::: "memory");
#pragma unroll
                for (int g = 0; g < 4; ++g) { const f32x4 fv = *(const LAS f32x4*)(wsf + 8 * g + 4 * hi);
#pragma unroll
                    for (int d = 0; d < 4; ++d) { o[d][4 * g + 0] *= fv[0]; o[d][4 * g + 1] *= fv[1]; o[d][4 * g + 2] *= fv[2]; o[d][4 * g + 3] *= fv[3]; } }
            }
            float ps = 0.f;
#pragma unroll
            for (int r = 0; r < 16; ++r) { p0[r] = __builtin_amdgcn_exp2f(p0[r] - mref); p1[r] = __builtin_amdgcn_exp2f(p1[r] - mref); ps += p0[r] + p1[r]; }
            lsum += ps;
            const bf16x8 pa0 = pack8(p0, 0), pa1 = pack8(p0, 8), pa2 = pack8(p1, 0), pa3 = pack8(p1, 8);
            const LAS unsigned char* vp = lds + AT_V + buf * 16384 + vb;
#pragma unroll
            for (int d = 0; d < 4; ++d) {
#define AT_VF(s) ({ const s16x4 lo_ = vtr(vp + (2 * (s)) * 2048 + d * 512), hi_ = vtr(vp + (2 * (s) + 1) * 2048 + d * 512); (bf16x8){lo_[0], lo_[1], lo_[2], lo_[3], hi_[0], hi_[1], hi_[2], hi_[3]}; })
                o[d] = __builtin_amdgcn_mfma_f32_32x32x16_bf16(pa0, AT_VF(0), o[d], 0, 0, 0);
                o[d] = __builtin_amdgcn_mfma_f32_32x32x16_bf16(pa1, AT_VF(1), o[d], 0, 0, 0);
                o[d] = __builtin_amdgcn_mfma_f32_32x32x16_bf16(pa2, AT_VF(2), o[d], 0, 0, 0);
                o[d] = __builtin_amdgcn_mfma_f32_32x32x16_bf16(pa3, AT_VF(3), o[d], 0, 0, 0);
#undef AT_VF
            }
        }
        if (it + 1 < nt) AT_STORE(buf ^ 1);
        __syncthreads();
    }
#undef AT_LOAD
#undef AT_STORE
    lsum += __shfl_xor(lsum, 32);
    { const float inv = lsum > 0.f ? 1.f / lsum : 0.f;
      if (hi == 0) wsf[r32] = inv;
      LDS_WAIT(); asm volatile("" ::: "memory");
#pragma unroll
      for (int g = 0; g < 4; ++g) { const f32x4 fv = *(const LAS f32x4*)(wsf + 8 * g + 4 * hi);
#pragma unroll
          for (int d = 0; d < 4; ++d) { o[d][4 * g + 0] *= fv[0]; o[d][4 * g + 1] *= fv[1]; o[d][4 * g + 2] *= fv[2]; o[d][4 * g + 3] *= fv[3]; } } }
    LAS float* xch = (LAS float*)(lds + AT_XCH) + rg * 4096;
    if (c == 1) {
#pragma unroll
        for (int d = 0; d < 4; ++d)
#pragma unroll
            for (int r = 0; r < 16; ++r) xch[(d * 16 + r) * 64 + lane] = o[d][r];
    }
    __syncthreads();
    if (c == 0) {
        float ss[16];
#pragma unroll
        for (int r = 0; r < 16; ++r) ss[r] = 0.f;
#pragma unroll
        for (int d = 0; d < 4; ++d)
#pragma unroll
            for (int r = 0; r < 16; ++r) { const float a = o[d][r] - lam * xch[(d * 16 + r) * 64 + lane]; o[d][r] = a; ss[r] += a * a; }
#pragma unroll
        for (int r = 0; r < 16; ++r) {
            float s = ss[r];
            s += __shfl_xor(s, 1); s += __shfl_xor(s, 2); s += __shfl_xor(s, 4); s += __shfl_xor(s, 8); s += __shfl_xor(s, 16);
            ss[r] = rsqrtf(s * (1.0f / 128.0f) + EPS) * (1.f - lam_init);
        }
        LAS bf16* stg = (LAS bf16*)(lds + AT_STG) + rg * 4096;
        const float* sw = C.SUBLN() + l * 128 + r32;
#pragma unroll
        for (int d = 0; d < 4; ++d) { const float w = sw[32 * d];
#pragma unroll
            for (int r = 0; r < 16; ++r) stg[crow(r, hi) * 128 + 32 * d + r32] = (bf16)f2bf(o[d][r] * ss[r] * w); }
        LDS_WAIT(); asm volatile("" ::: "memory");
        bf16* op = C.MIX() + (rowbase + qw0) * D + 512 + h * 128;
#pragma unroll
        for (int i = 0; i < 8; ++i) { const int ch = i * 64 + lane, row = ch >> 4, cc = ch & 15; *(v4u*)(op + (size_t)row * D + cc * 8) = *(const LAS v4u*)(stg + row * 128 + cc * 8); }
    }
    __syncthreads();
}
constexpr int HG_QM = 0, HG_KR = 16384, HG_KT = 32768, HG_V = 49152, HG_ST = 65536, HG_XT = 98304, HG_OS = 106496, HG_SQ = 122880, HG_VEC = 123904;
__device__ __forceinline__ v2u pack4(float a, float b, float c, float d) { v2u w; w.x = pg8::cvt_pk_bf16(a, b); w.y = pg8::cvt_pk_bf16(c, d); return w; }
__device__ __forceinline__ bf16x8 tr_frag(const LAS unsigned char* p) { const s16x4 lo = vtr(p), hi4 = vtr(p + 256); return (bf16x8){lo[0], lo[1], lo[2], lo[3], hi4[0], hi4[1], hi4[2], hi4[3]}; }
__device__ __forceinline__ void hgrn_unit(Ctx& C, int l, int b, int h) {
    LAS unsigned char* lds = C.lds;
    const int tid = C.tid, lane = C.lane, wave = C.wave, r32 = lane & 31, hi = lane >> 5;
    const size_t rowbase = (size_t)b * LT;
    const bf16* PJ = C.PROJ() + h * 128; const float* BL = C.LOGF() + h * 128;
    const int c4 = tid & 31, tg = tid >> 5;
    const int dkb = wave >> 1, dvb0 = 2 * (wave & 1);
    const int th = wave >> 2, dvb = wave & 3;
    const int vbq = ((lane & 15) >> 2) * 64 + ((lane >> 4) & 1) * 32 + (lane & 3) * 8;
    LAS float* vec = (LAS float*)(lds + HG_VEC);
    LAS float* sq = (LAS float*)(lds + HG_SQ);
    f32x16 st[2];
#pragma unroll
    for (int j = 0; j < 2; ++j)
#pragma unroll
        for (int r = 0; r < 16; ++r) st[j][r] = 0.f;
    v2u pq[4], pk[4], pv[4]; f32x4 pb[4], pbm;
#define HG_LOAD(ch) do { const size_t r0_ = rowbase + (size_t)(ch) * 64; \
        _Pragma("unroll") for (int i = 0; i < 4; ++i) { const size_t row_ = r0_ + 4 * tg + i; const bf16* p_ = PJ + row_ * WIN + 4 * c4; \
            pq[i] = *(const v2u*)p_; pk[i] = *(const v2u*)(p_ + 512); pv[i] = *(const v2u*)(p_ + 1024); pb[i] = *(const f32x4*)(BL + row_ * 512 + 4 * c4); } \
        pbm = *(const f32x4*)(BL + (r0_ + 31) * 512 + 4 * c4); } while (0)
    HG_LOAD(0);
    const float* nw = C.HGNW() + l * 128;
    for (int ch = 0; ch < LT / 64; ++ch) {
#pragma unroll
        for (int i = 0; i < 4; ++i) {
            const int t = 4 * tg + i;
            float qm[4], km[4];
            const float qv[4] = {bf_lo(pq[i].x), bf_hi(pq[i].x), bf_lo(pq[i].y), bf_hi(pq[i].y)};
            const float kv[4] = {bf_lo(pk[i].x), bf_hi(pk[i].x), bf_lo(pk[i].y), bf_hi(pk[i].y)};
#pragma unroll
            for (int j = 0; j < 4; ++j) { const float x = fminf(fmaxf(pb[i][j] - pbm[j], -80.f), 80.f); qm[j] = qv[j] * __expf(x); km[j] = kv[j] * __expf(-x); }
            const int rsw = (((c4 >> 1) ^ (t & 15)) * 16) + (c4 & 1) * 8;
            *(LAS v2u*)(lds + HG_QM + t * 256 + rsw) = pack4(qm[0], qm[1], qm[2], qm[3]);
            const v2u kmw = pack4(km[0], km[1], km[2], km[3]);
            *(LAS v2u*)(lds + HG_KR + t * 256 + rsw) = kmw;
            const int tso = ((t >> 3) * 4 + (c4 >> 3)) * 512 + (t & 7) * 64 + (c4 & 7) * 8;
            *(LAS v2u*)(lds + HG_KT + tso) = kmw;
            *(LAS v2u*)(lds + HG_V + tso) = pv[i];
            if (t == 31) *(LAS f32x4*)(vec + 4 * c4) = pb[i];
            if (t == 63) *(LAS f32x4*)(vec + 128 + 4 * c4) = pb[i];
        }
        __syncthreads();
        if (ch + 1 < LT / 64) HG_LOAD(ch + 1);
#pragma unroll
        for (int g = 0; g < 4; ++g) {
            const f32x4 bm = *(const LAS f32x4*)(vec + 32 * dkb + 8 * g + 4 * hi);
            const float e0 = __expf(bm[0]), e1 = __expf(bm[1]), e2 = __expf(bm[2]), e3 = __expf(bm[3]);
#pragma unroll
            for (int j = 0; j < 2; ++j) {
                st[j][4 * g + 0] *= e0; st[j][4 * g + 1] *= e1; st[j][4 * g + 2] *= e2; st[j][4 * g + 3] *= e3;
                const int dv = 32 * (dvb0 + j) + r32;
                *(LAS v2u*)(lds + HG_ST + dv * 256 + (((4 * dkb + g) ^ (dv & 15)) * 16) + hi * 8) = pack4(st[j][4 * g + 0], st[j][4 * g + 1], st[j][4 * g + 2], st[j][4 * g + 3]);
            }
        }
        if (wave < 3) {
            const int sb = (wave == 2) ? 1 : 0, tb = (wave == 0) ? 0 : 1;
            const int s = 32 * sb + r32, t = 32 * tb + r32;
            f32x16 x;
#pragma unroll
            for (int r = 0; r < 16; ++r) x[r] = 0.f;
#pragma unroll
            for (int ks = 0; ks < 8; ++ks) {
                const bf16x8 a = *(const LAS bf16x8*)(lds + HG_KR + s * 256 + (((2 * ks + hi) ^ (s & 15)) * 16));
                const bf16x8 bq = *(const LAS bf16x8*)(lds + HG_QM + t * 256 + (((2 * ks + hi) ^ (t & 15)) * 16));
                x = __builtin_amdgcn_mfma_f32_32x32x16_bf16(a, bq, x, 0, 0, 0);
            }
            if (sb == tb) {
#pragma unroll
                for (int r = 0; r < 16; ++r) x[r] = (crow(r, hi) > r32) ? 0.f : x[r];
            }
#pragma unroll
            for (int g = 0; g < 4; ++g)
                *(LAS v2u*)(lds + HG_XT + t * 128 + (((4 * sb + g) ^ ((t >> 1) & 7)) * 16) + hi * 8) = pack4(x[4 * g + 0], x[4 * g + 1], x[4 * g + 2], x[4 * g + 3]);
        }
#pragma unroll
        for (int ks = 0; ks < 4; ++ks) {
            const bf16x8 a = tr_frag(lds + HG_KT + ((2 * ks + hi) * 4 + dkb) * 512 + vbq);
#pragma unroll
            for (int j = 0; j < 2; ++j) {
                const bf16x8 bv = tr_frag(lds + HG_V + ((2 * ks + hi) * 4 + dvb0 + j) * 512 + vbq);
                st[j] = __builtin_amdgcn_mfma_f32_32x32x16_bf16(a, bv, st[j], 0, 0, 0);
            }
        }
#pragma unroll
        for (int g = 0; g < 4; ++g) {
            const f32x4 bm = *(const LAS f32x4*)(vec + 32 * dkb + 8 * g + 4 * hi), be = *(const LAS f32x4*)(vec + 128 + 32 * dkb + 8 * g + 4 * hi);
            const float e0 = __expf(be[0] - bm[0]), e1 = __expf(be[1] - bm[1]), e2 = __expf(be[2] - bm[2]), e3 = __expf(be[3] - bm[3]);
#pragma unroll
            for (int j = 0; j < 2; ++j) { st[j][4 * g + 0] *= e0; st[j][4 * g + 1] *= e1; st[j][4 * g + 2] *= e2; st[j][4 * g + 3] *= e3; }
        }
        __syncthreads();
        {
            const int dv = 32 * dvb + r32, t = 32 * th + r32;
            f32x16 o;
#pragma unroll
            for (int r = 0; r < 16; ++r) o[r] = 0.f;
#pragma unroll
            for (int ks = 0; ks < 8; ++ks) {
                const bf16x8 a = *(const LAS bf16x8*)(lds + HG_ST + dv * 256 + (((2 * ks + hi) ^ (dv & 15)) * 16));
                const bf16x8 bq = *(const LAS bf16x8*)(lds + HG_QM + t * 256 + (((2 * ks + hi) ^ (t & 15)) * 16));
                o = __builtin_amdgcn_mfma_f32_32x32x16_bf16(a, bq, o, 0, 0, 0);
            }
#pragma unroll
            for (int sb = 0; sb < 2; ++sb) {
                if (sb <= th) {
#pragma unroll
                    for (int k2 = 0; k2 < 2; ++k2) {
                        const int kg = 4 * sb + 2 * k2 + hi;
                        const bf16x8 a = tr_frag(lds + HG_V + (kg * 4 + dvb) * 512 + vbq);
                        const bf16x8 bx = *(const LAS bf16x8*)(lds + HG_XT + t * 128 + ((kg ^ ((t >> 1) & 7)) * 16));
                        o = __builtin_amdgcn_mfma_f32_32x32x16_bf16(a, bx, o, 0, 0, 0);
                    }
                }
            }
            float s2 = 0.f;
#pragma unroll
            for (int r = 0; r < 16; ++r) s2 += o[r] * o[r];
            s2 += __shfl_xor(s2, 32);
            if (hi == 0) sq[t * 4 + dvb] = s2;
#pragma unroll
            for (int g = 0; g < 4; ++g)
                *(LAS v2u*)(lds + HG_OS + t * 256 + (((4 * dvb + g) ^ (t & 15)) * 16) + hi * 8) = pack4(o[4 * g + 0], o[4 * g + 1], o[4 * g + 2], o[4 * g + 3]);
        }
        __syncthreads();
        {
            const int t = tid >> 3, seg = tid & 7;
            const size_t row = rowbase + (size_t)ch * 64 + t;
            const f32x4 sv = *(const LAS f32x4*)(sq + t * 4);
            const float rs = rsqrtf(((sv[0] + sv[1]) + (sv[2] + sv[3])) * (1.0f / 128.0f) + EPS);
            const v4u g0 = *(const v4u*)(PJ + row * WIN + 1536 + 16 * seg), g1 = *(const v4u*)(PJ + row * WIN + 1536 + 16 * seg + 8);
            const v4u o0 = *(const LAS v4u*)(lds + HG_OS + t * 256 + (((2 * seg) ^ (t & 15)) * 16)), o1 = *(const LAS v4u*)(lds + HG_OS + t * 256 + (((2 * seg + 1) ^ (t & 15)) * 16));
            const f32x4 w0 = *(const f32x4*)(nw + 16 * seg), w1 = *(const f32x4*)(nw + 16 * seg + 4), w2 = *(const f32x4*)(nw + 16 * seg + 8), w3 = *(const f32x4*)(nw + 16 * seg + 12);
            v4u r0, r1;
            r0.x = pk2(bf_lo(o0.x) * rs * w0[0] * bf_lo(g0.x), bf_hi(o0.x) * rs * w0[1] * bf_hi(g0.x)); r0.y = pk2(bf_lo(o0.y) * rs * w0[2] * bf_lo(g0.y), bf_hi(o0.y) * rs * w0[3] * bf_hi(g0.y));
            r0.z = pk2(bf_lo(o0.z) * rs * w1[0] * bf_lo(g0.z), bf_hi(o0.z) * rs * w1[1] * bf_hi(g0.z)); r0.w = pk2(bf_lo(o0.w) * rs * w1[2] * bf_lo(g0.w), bf_hi(o0.w) * rs * w1[3] * bf_hi(g0.w));
            r1.x = pk2(bf_lo(o1.x) * rs * w2[0] * bf_lo(g1.x), bf_hi(o1.x) * rs * w2[1] * bf_hi(g1.x)); r1.y = pk2(bf_lo(o1.y) * rs * w2[2] * bf_lo(g1.y), bf_hi(o1.y) * rs * w2[3] * bf_hi(g1.y));
            r1.z = pk2(bf_lo(o1.z) * rs * w3[0] * bf_lo(g1.z), bf_hi(o1.z) * rs * w3[1] * bf_hi(g1.z)); r1.w = pk2(bf_lo(o1.w) * rs * w3[2] * bf_lo(g1.w), bf_hi(o1.w) * rs * w3[3] * bf_hi(g1.w));
            bf16* op = C.MIX() + row * D + h * 128 + 16 * seg;
            *(v4u*)op = r0; *(v4u*)(op + 8) = r1;
        }
    }
#undef HG_LOAD
    __syncthreads();
}
__device__ __forceinline__ void mixer_phase(Ctx& C, int l) {
    for (int k = 0; k * C.G < 17 * 32; ++k) {
        const int u = k * C.G + ((k & 1) ? (C.G - 1 - C.bid) : C.bid);
        if (u < 17 * 32) { const int qi = 16 - u / 32, bh = u % 32; attn_unit(C, l, bh >> 2, bh & 3, qi); }
    }
    #ifdef HGRN_NAIVE
    for (int u = C.G - 1 - C.bid; u < 32; u += C.G) hgrn_naive_unit(C, l, u >> 2, u & 3);
#else
    for (int u = C.G - 1 - C.bid; u < 32; u += C.G) hgrn_unit(C, l, u >> 2, u & 3);
#endif
}

constexpr int RMAX = 128;
__device__ __forceinline__ void route_phase(Ctx& C, int li) {
    LAS float* rf = (LAS float*)C.lds;
    LAS int* lcnt = (LAS int*)(C.lds + 32768);
    LAS int* lbase = lcnt + 8;
    LAS int* ti = lbase + 8;
    LAS float* tf = (LAS float*)(ti + RMAX * 4);
    const int tid = C.tid, lane = C.lane;
    for (int i = tid; i < 8192; i += 512) rf[i] = C.RF()[li * 8192 + i];
    if (tid < 8) lcnt[tid] = 0;
    __syncthreads();
    const int nrows = (NTOK - C.bid + C.G - 1) / C.G;
    for (int k = C.wave; k < nrows; k += 8) {
        const size_t row = (size_t)C.bid + (size_t)k * C.G;
        f32x4 v[4]; float ss = 0.f;
#pragma unroll
        for (int j = 0; j < 4; ++j) { v[j] = *(const f32x4*)(C.H() + row * D + 4 * lane + 256 * j); ss += (v[j][0] * v[j][0] + v[j][1] * v[j][1]) + (v[j][2] * v[j][2] + v[j][3] * v[j][3]); }
        ss = wave_sum(ss);
        const float rstd = rsqrtf(ss * (1.0f / 1024.0f) + EPS);
        float lg[8];
#pragma unroll
        for (int e = 0; e < 8; ++e) {
            float p = 0.f;
#pragma unroll
            for (int j = 0; j < 4; ++j) { const f32x4 w = *(const LAS f32x4*)(rf + e * 1024 + 4 * lane + 256 * j); p += (v[j][0] * w[0] + v[j][1] * w[1]) + (v[j][2] * w[2] + v[j][3] * w[3]); }
            lg[e] = wave_sum(p) * rstd;
        }
        int e1 = 0; float l1 = lg[0];
#pragma unroll
        for (int e = 1; e < 8; ++e) if (lg[e] > l1) { l1 = lg[e]; e1 = e; }
        int e2 = -1; float l2 = -3.0e38f;
#pragma unroll
        for (int e = 0; e < 8; ++e) if (e != e1 && lg[e] > l2) { l2 = lg[e]; e2 = e; }
        const float g1 = 1.f / (1.f + expf(l2 - l1)), g2 = 1.f - g1;
        if (lane == 0) {
            const int lr1 = __hip_atomic_fetch_add(&lcnt[e1], 1, __ATOMIC_RELAXED, __HIP_MEMORY_SCOPE_WORKGROUP), lr2 = __hip_atomic_fetch_add(&lcnt[e2], 1, __ATOMIC_RELAXED, __HIP_MEMORY_SCOPE_WORKGROUP);
            ti[k * 4 + 0] = e1; ti[k * 4 + 1] = e2; ti[k * 4 + 2] = lr1; ti[k * 4 + 3] = lr2;
            tf[k * 4 + 0] = g1; tf[k * 4 + 1] = g2; tf[k * 4 + 2] = rstd;
        }
    }
    __syncthreads();
    if (tid < 8) lbase[tid] = (int)__hip_atomic_fetch_add(C.ctl() + CW_CNT + (li * 8 + tid) * 64, (unsigned)lcnt[tid], RLX_AGENT);
    __syncthreads();
    for (int k = tid; k < nrows; k += 512) {
        const int row = C.bid + k * C.G;
        const int e1 = ti[k * 4], e2 = ti[k * 4 + 1], r1 = lbase[e1] + ti[k * 4 + 2], r2 = lbase[e2] + ti[k * 4 + 3];
        C.LIST()[(size_t)e1 * NTOK + r1] = row; C.LIST()[(size_t)e2 * NTOK + r2] = row;
        unsigned* inf = C.TINFO() + (size_t)row * 8;
        inf[0] = (unsigned)e1; inf[1] = (unsigned)e2; inf[2] = (unsigned)r1; inf[3] = (unsigned)r2; inf[4] = __builtin_bit_cast(unsigned, tf[k * 4]); inf[5] = __builtin_bit_cast(unsigned, tf[k * 4 + 1]);
        C.RSTD()[row] = tf[k * 4 + 2];
    }
    __syncthreads();
}
__device__ __forceinline__ void load_panels(Ctx& C, int li, LAS int* pst) {
    __syncthreads();
    if (C.tid == 0) { int acc = 0;
        for (int e = 0; e < 8; ++e) { const int c = (int)__hip_atomic_load(C.ctl() + CW_CNT + (li * 8 + e) * 64, RLX_AGENT); pst[e] = acc; pst[16 + e] = c; acc += (c + 255) >> 8; }
        pst[8] = acc; }
    __syncthreads();
}
__device__ __forceinline__ void gather_phase(Ctx& C, int li) {
    LAS int* pst = (LAS int*)C.lds;
    load_panels(C, li, pst);
    const int gw = C.bid * 8 + C.wave, NGW = C.G * 8, lane = C.lane;
    const int nslot = pst[8] * 256;
    for (int s = gw; s < nslot; s += NGW) {
        const int panel = s >> 8; int e = 0;
#pragma unroll
        for (int j = 1; j < 8; ++j) if (panel >= pst[j]) e = j;
        const int rank = s - pst[e] * 256;
        bf16* xp = C.XG() + (size_t)s * D;
        if (rank < pst[16 + e]) {
            const int tok = C.LIST()[(size_t)e * NTOK + rank]; const float r = C.RSTD()[tok];
#pragma unroll
            for (int j = 0; j < 4; ++j) { const f32x4 v = *(const f32x4*)(C.H() + (size_t)tok * D + 4 * lane + 256 * j); v2u w; w.x = pk2(v[0] * r, v[1] * r); w.y = pk2(v[2] * r, v[3] * r); *(v2u*)(xp + 4 * lane + 256 * j) = w; }
        } else {
#pragma unroll
            for (int j = 0; j < 4; ++j) *(v2u*)(xp + 4 * lane + 256 * j) = (v2u){0u, 0u};
        }
    }
}
__device__ __forceinline__ void combine_phase(Ctx& C, int li, bool last) {
    LAS int* pst = (LAS int*)C.lds;
    load_panels(C, li, pst);
    const int gw = C.bid * 8 + C.wave, NGW = C.G * 8, lane = C.lane;
    for (int row = gw; row < NTOK; row += NGW) {
        const unsigned* inf = C.TINFO() + (size_t)row * 8;
        const int e1 = (int)inf[0], e2 = (int)inf[1];
        const size_t s1 = (size_t)pst[e1] * 256 + inf[2], s2 = (size_t)pst[e2] * 256 + inf[3];
        const float g1 = __builtin_bit_cast(float, inf[4]), g2 = __builtin_bit_cast(float, inf[5]);
        f32x4 v[4]; float ss = 0.f;
#pragma unroll
        for (int j = 0; j < 4; ++j) {
            const int col = 4 * lane + 256 * j;
            v[j] = *(const f32x4*)(C.H() + (size_t)row * D + col);
            const v2u a = *(const v2u*)(C.Y() + s1 * D + col), b = *(const v2u*)(C.Y() + s2 * D + col);
            v[j][0] += g1 * bf_lo(a.x) + g2 * bf_lo(b.x); v[j][1] += g1 * bf_hi(a.x) + g2 * bf_hi(b.x);
            v[j][2] += g1 * bf_lo(a.y) + g2 * bf_lo(b.y); v[j][3] += g1 * bf_hi(a.y) + g2 * bf_hi(b.y);
            ss += (v[j][0] * v[j][0] + v[j][1] * v[j][1]) + (v[j][2] * v[j][2] + v[j][3] * v[j][3]);
        }
        ss = wave_sum(ss);
        if (!last) {
#pragma unroll
            for (int j = 0; j < 4; ++j) { const int col = 4 * lane + 256 * j; *(f32x4*)(C.H() + (size_t)row * D + col) = v[j]; v2u w; w.x = pk2(v[j][0], v[j][1]); w.y = pk2(v[j][2], v[j][3]); *(v2u*)(C.HB() + (size_t)row * D + col) = w; }
            if (lane < 16) C.SSQ()[(size_t)row * 16 + lane] = (lane == 0) ? ss : 0.f;
        } else {
            const int b = row / LT, t = row % LT;
            if (t >= LEAD) {
                const float rs = rsqrtf(ss * (1.0f / 1024.0f) + EPS);
#pragma unroll
                for (int j = 0; j < 4; ++j) { const int col = 4 * lane + 256 * j; const f32x4 fw = *(const f32x4*)(C.FNORM() + col);
                    *(f32x4*)(C.out + ((size_t)b * SEQ + (t - LEAD)) * D + col) = (f32x4){v[j][0] * rs * fw[0], v[j][1] * rs * fw[1], v[j][2] * rs * fw[2], v[j][3] * rs * fw[3]}; }
            }
        }
    }
}

__global__ void __launch_bounds__(512, 2) mk_fwd(Args args) {
    extern __shared__ __attribute__((aligned(16))) unsigned char lds[];
    Ctx C;
    C.lds = (LAS unsigned char*)lds;
    C.tid = threadIdx.x; C.lane = C.tid & 63; C.wave = __builtin_amdgcn_readfirstlane(C.tid >> 6); C.G = gridDim.x; C.bid = blockIdx.x;
    unsigned char* ws = args.ws; C.ws = ws; C.out = args.out;
    volatile LAS unsigned* MISC = (volatile LAS unsigned*)(C.lds + MISC_OFF);
    for (int u = C.tid; u < (LDS_BYTES - RING_BYTES) / 4; u += 512) ((LAS unsigned*)(C.lds + RING_BYTES))[u] = 0u;
    __syncthreads();
    const int lo = args.ph_lo, hi = args.ph_hi;
    const bool multi = (hi - lo) > 1;
    XcdBarrier bar; bar.bar = (unsigned*)(C.ctl() + CW_BAR); bar.x = 0; bar.st = nullptr;
    if (multi) bar = xcd_barrier_post((unsigned*)(C.ctl() + CW_BAR), MISC + 8);
#define PHASE_CTX(P) Ctx P = C; { unsigned char* w_ = C.ws; asm volatile("" : "+s"(w_)); P.ws = w_; int t_ = C.tid; asm volatile("" : "+v"(t_)); P.tid = t_; P.lane = t_ & 63; P.wave = __builtin_amdgcn_readfirstlane(t_ >> 6); int g_ = C.G, b_ = C.bid; asm volatile("" : "+s"(g_), "+s"(b_)); P.G = g_; P.bid = b_; }
#define IN(k) (lo_l <= (k) && (k) < hi_l)
#define SEAM(k) do { if ((k) + 1 < hi_l) xcd_barrier(bar); } while (0)

    { int lo_l = lo, hi_l = hi; asm volatile("" : "+s"(lo_l), "+s"(hi_l));
      if (IN(0)) { PHASE_CTX(P); prologue_phase(P, args); SEAM(0); } }

    for (int l = 0; l < DEPTH; ++l) {
        int lo_l = lo, hi_l = hi; asm volatile("" : "+s"(lo_l), "+s"(hi_l));
        const int pb = 1 + 8 * l, li = l >> 1; const bool moe = (l & 1) != 0;
        if (IN(pb + 0)) {
            PHASE_CTX(P);
            pg8::Gemm g{P.HB(), (const bf16*)(P.ws + WS_WIN) + (size_t)l * WIN * D, NTOK, WIN, D, 0};
            pg8::StaticOrder S; S.init(NTOK, WIN, P.G, P.bid);
            EpiProj E{P.PROJ(), P.LOGF(), P.SSQ(), P.LB() + l * 512};
            pg8::gemm_phase<EpiProj, pg8::StaticOrder, true, true>(P.lds, g, S, E);
            SEAM(pb + 0);
        }
        if (IN(pb + 1)) { PHASE_CTX(P); mixer_phase(P, l); SEAM(pb + 1); }
        if (IN(pb + 2)) {
            PHASE_CTX(P);
            pg8::Gemm g{P.MIX(), (const bf16*)(P.ws + WS_WOUT) + (size_t)l * D * D, NTOK, D, D, 0};
            pg8::StaticOrder S; S.init(NTOK, D, P.G, P.bid);
            EpiResid E{P.H(), P.HB(), P.SSQ()};
            pg8::gemm_phase<EpiResid, pg8::StaticOrder, true, true>(P.lds, g, S, E);
            SEAM(pb + 2);
        }
        if (!moe) {
            if (IN(pb + 5)) {
                PHASE_CTX(P);
                pg8::Gemm g{P.HB(), (const bf16*)(P.ws + WS_WD13) + (size_t)li * 2 * FFD * D, NTOK, 2 * FFD, D, 0};
                pg8::StaticOrder S; S.init(NTOK, 2 * FFD, P.G, P.bid);
                EpiGLU E{P.T(), FFD, P.SSQ()};
                pg8::gemm_phase<EpiGLU, pg8::StaticOrder, true, true>(P.lds, g, S, E);
                SEAM(pb + 5);
            }
            if (IN(pb + 6)) {
                PHASE_CTX(P);
                pg8::Gemm g{P.T(), (const bf16*)(P.ws + WS_WD2) + (size_t)li * D * FFD, NTOK, D, FFD, 0};
                pg8::StaticOrder S; S.init(NTOK, D, P.G, P.bid);
                EpiResid E{P.H(), P.HB(), P.SSQ()};
                pg8::gemm_phase<EpiResid, pg8::StaticOrder, true, true>(P.lds, g, S, E);
                SEAM(pb + 6);
            }
        } else {
            if (IN(pb + 3)) { PHASE_CTX(P); route_phase(P, li); SEAM(pb + 3); }
            if (IN(pb + 4)) { PHASE_CTX(P); gather_phase(P, li); SEAM(pb + 4); }
            if (IN(pb + 5)) {
                PHASE_CTX(P);
                LAS int* pst = (LAS int*)(P.lds + RING_BYTES + 1024);
                load_panels(P, li, pst);
#define PS(i) __builtin_amdgcn_readfirstlane(pst[i])
                pg8::GroupedOrder S{PS(0), PS(1), PS(2), PS(3), PS(4), PS(5), PS(6), PS(7), PS(8), 2 * FFE / 256, P.G, P.bid};
                pg8::Gemm g{P.XG(), (const bf16*)(P.ws + WS_WM13) + (size_t)li * 8 * 2 * FFE * D, 0, 2 * FFE, D, (size_t)2 * FFE * D * 2};
                EpiGLU E{P.T(), FFE, nullptr};
                pg8::gemm_phase<EpiGLU, pg8::GroupedOrder, true, true>(P.lds, g, S, E);
                SEAM(pb + 5);
            }
            if (IN(pb + 6)) {
                PHASE_CTX(P);
                LAS int* pst = (LAS int*)(P.lds + RING_BYTES + 1024);
                load_panels(P, li, pst);
                pg8::GroupedOrder S{PS(0), PS(1), PS(2), PS(3), PS(4), PS(5), PS(6), PS(7), PS(8), D / 256, P.G, P.bid};
                pg8::Gemm g{P.T(), (const bf16*)(P.ws + WS_WM2) + (size_t)li * 8 * D * FFE, 0, D, FFE, (size_t)D * FFE * 2};
                EpiY E{P.Y()};
                pg8::gemm_phase<EpiY, pg8::GroupedOrder, true, true>(P.lds, g, S, E);
                SEAM(pb + 6);
            }
#undef PS
            if (IN(pb + 7)) { PHASE_CTX(P); combine_phase(P, li, l == DEPTH - 1); SEAM(pb + 7); }
        }
    }
#undef IN
#undef SEAM
#undef PHASE_CTX
}

extern "C" void kernel_launch(void* const* d_in, const int* in_sizes, int n_in, void* d_out, int out_size, void* d_ws, size_t ws_size, hipStream_t stream) {
    static int grid = 0;
    if (grid == 0) {
        if (n_in != 19 || out_size != NB * SEQ * D || ws_size < WS_END) { fprintf(stderr, "kernel_launch: unexpected shapes (n_in %d, out %d, ws %zu < %zu); nothing launched\n", n_in, out_size, ws_size, (size_t)WS_END); grid = -1; return; }
        int dev = 0, cus = 0, per_cu = 0;
        if (hipGetDevice(&dev) != hipSuccess || hipDeviceGetAttribute(&cus, hipDeviceAttributeMultiprocessorCount, dev) != hipSuccess) { grid = -1; return; }
        if (hipFuncSetAttribute((const void*)mk_fwd, hipFuncAttributeMaxDynamicSharedMemorySize, LDS_BYTES) != hipSuccess) { fprintf(stderr, "kernel_launch: hipFuncSetAttribute failed\n"); grid = -1; return; }
        if (hipOccupancyMaxActiveBlocksPerMultiprocessor(&per_cu, (const void*)mk_fwd, 512, LDS_BYTES) != hipSuccess || per_cu < 1) { fprintf(stderr, "kernel_launch: occupancy query says %d blocks per CU\n", per_cu); }
        (void)hipGetLastError();
        grid = cus;
    }
    if (grid < 0) return;
    if (hipMemsetAsync((char*)d_ws + WS_CTL, 0, CTL_ZERO_BYTES, stream) != hipSuccess) return;
    Args a{};
    for (int i = 0; i < 19; ++i) a.in[i] = (const float*)d_in[i];
    a.out = (float*)d_out; a.ws = (unsigned char*)d_ws;
#if MK_ONE_LAUNCH
    a.ph_lo = 0; a.ph_hi = NPHASE;
    hipLaunchKernelGGL(mk_fwd, dim3(grid), dim3(512), LDS_BYTES, stream, a);
#else
    for (int p = 0; p < NPHASE; ++p) {
        if (p > 0) { const int l = (p - 1) / 8, k = (p - 1) % 8; const bool moe = (l & 1) != 0; if (!moe && (k == 3 || k == 4 || k == 7)) continue; }
        a.ph_lo = p; a.ph_hi = p + 1;
        hipLaunchKernelGGL(mk_fwd, dim3(grid), dim3(512), LDS_BYTES, stream, a);
    }
#endif
}
```

```cpp
#include <hip/hip_runtime.h>
#include <cstdio>
#include <cstdint>

#ifndef REP_PRO
#define REP_PRO 1
#endif
#ifndef REP_PROJ
#define REP_PROJ 1
#endif
#ifndef REP_MIX
#define REP_MIX 1
#endif
#ifndef REP_FF1
#define REP_FF1 1
#endif
#ifndef REP_GATHER
#define REP_GATHER 1
#endif
#ifndef MK_ONE_LAUNCH
#define MK_ONE_LAUNCH 1
#endif

namespace pg8 {
#define PG8_LAS __attribute__((address_space(3)))
typedef unsigned short bf16_t;
typedef short bf16x8 __attribute__((ext_vector_type(8)));
typedef float f32x4 __attribute__((ext_vector_type(4)));
typedef unsigned u32x4 __attribute__((ext_vector_type(4)));
typedef unsigned u32x2 __attribute__((ext_vector_type(2)));
constexpr int BM = 256, BK = 64, HALF = 128, HTB = HALF * BK * 2  , STAGE_BYTES = 8 * HTB, NXCD = 8, WGM = 8;

__host__ __device__ __forceinline__ int lds_byte(int r, int c) { const int st = (r >> 4) * 2 + (c >> 5), rr = r & 15, cc = c & 31, ob = rr * 64 + cc * 2; return st * 1024 + (ob ^ (((ob >> 9) & 1) << 5)); }
__host__ __device__ __forceinline__ void stage_rc(int b, int& R, int& C) { const int st = b / 1024, sb = b % 1024, swz = sb ^ (((sb >> 9) & 1) << 5); R = (st >> 1) * 16 + swz / 64; C = (st & 1) * 32 + (swz % 64) / 2; }
__host__ __device__ __forceinline__ int perm32(int rho) { const int n = rho >> 4, i = rho & 15; return 8 * (i >> 2) + 4 * n + (i & 3); }

struct Unit { int pm, pn, e; };
struct Gemm { const bf16_t* A; const bf16_t* Bt; int M, N, K; size_t bstride; };

struct StaticOrder {
    int nM, nN, nwg, G, c;
    __host__ __device__ void init(int M, int N, int G_, int c_) { nM = M / BM; nN = N / BM; nwg = nM * nN; G = G_; c = c_; }
    __host__ __device__ bool next(int i, Unit& u) const {
        const long L = (long)i * G + c; if (L >= nwg) return false;
        int wgid = (int)L; { const int q = nwg / NXCD, r = nwg % NXCD, xcd = wgid % NXCD, off = wgid / NXCD; wgid = (xcd < r ? xcd * (q + 1) : r * (q + 1) + (xcd - r) * q) + off; }
        const int nig = WGM * nN, gid = wgid / nig, fm = gid * WGM, gsz = (nM - fm) < WGM ? (nM - fm) : WGM;
        u.pm = fm + ((wgid % nig) % gsz); u.pn = (wgid % nig) / gsz; u.e = 0; return true;
    }
    __device__ __forceinline__ void a_ready(const Unit&) const {}
    __device__ __forceinline__ void done(const Unit&) const {}
};
struct GroupedOrder {
    int p0, p1, p2, p3, p4, p5, p6, p7, p8, nN, G, c;
    __device__ __forceinline__ bool next(int i, Unit& u) const {
        const int L = i * G + c; if (L >= p8 * nN) return false;
        int e = 0, ps = 0, pe = p1;
        if (L >= p1 * nN) { e = 1; ps = p1; pe = p2; }
        if (L >= p2 * nN) { e = 2; ps = p2; pe = p3; }
        if (L >= p3 * nN) { e = 3; ps = p3; pe = p4; }
        if (L >= p4 * nN) { e = 4; ps = p4; pe = p5; }
        if (L >= p5 * nN) { e = 5; ps = p5; pe = p6; }
        if (L >= p6 * nN) { e = 6; ps = p6; pe = p7; }
        if (L >= p7 * nN) { e = 7; ps = p7; pe = p8; }
        const int rem = L - ps * nN, R = pe - ps;
        u.e = e; u.pn = rem / R; u.pm = ps + rem % R; return true;
    }
    __device__ __forceinline__ void a_ready(const Unit&) const {}
    __device__ __forceinline__ void done(const Unit&) const {}
};

__device__ __forceinline__ unsigned cvt_pk_bf16(float lo, float hi) { unsigned r; asm volatile("v_cvt_pk_bf16_f32 %0, %1, %2" : "=v"(r) : "v"(lo), "v"(hi)); return r; }

template <class Epi, class Sched, bool ALIGN_EPI = false, bool SP2 = false>
__device__ __forceinline__ void gemm_phase(PG8_LAS unsigned char* lds, const Gemm g, const Sched& S, const Epi& E) {
    int tid_l = threadIdx.x; asm volatile("" : "+v"(tid_l));
    const int tid = tid_l, wid = __builtin_amdgcn_readfirstlane(tid >> 6), lane = tid & 63, wr = wid >> 2, wc = wid & 3, fr = lane & 15, fq = lane >> 4;
    const int K = g.K, nt = K / BK;
    unsigned voffA[2], voffB[2];
#pragma unroll
    for (int i = 0; i < 2; ++i) { int R, C; stage_rc(tid * 16 + i * 8192, R, C); const int Rb = Epi::PERM ? ((R & ~31) + perm32(R & 31)) : R;
        voffA[i] = (unsigned)(R * K + C) * 2u; voffB[i] = (unsigned)(Rb * K + C) * 2u; }
    const size_t kstep = (size_t)(BK * 2);
    const size_t hstep = (size_t)HALF * K * 2;
    const size_t tstep = 2 * hstep;
    const unsigned ldsw = (unsigned)wid * 1024u;
    const int aoff = lds_byte(wr * 64 + fr, fq * 8), boff = lds_byte(wc * 32 + fr, fq * 8);
#define PG8_SA(b, h) (((b) * 2 + (h)) * HTB)
#define PG8_SB(b, h) ((4 + (b) * 2 + (h)) * HTB)
#define PG8_STAGE(bufoff, gbase, voff) do { _Pragma("unroll") for (int _i = 0; _i < 2; ++_i) \
        __builtin_amdgcn_global_load_lds((const unsigned*)((const char*)(gbase) + (voff)[_i]), (PG8_LAS unsigned*)(lds + (bufoff) + ldsw + _i * 8192), 16, 0, 0); } while (0)
#define PG8_LDA(dst, b, h) do { _Pragma("unroll") for (int m = 0; m < 4; ++m) _Pragma("unroll") for (int k = 0; k < 2; ++k) dst[m][k] = *(const PG8_LAS bf16x8*)(lds + PG8_SA(b, h) + aoff + m * 2048 + k * 1024); } while (0)
#define PG8_LDB(dst, b, h) do { _Pragma("unroll") for (int n = 0; n < 2; ++n) _Pragma("unroll") for (int k = 0; k < 2; ++k) dst[n][k] = *(const PG8_LAS bf16x8*)(lds + PG8_SB(b, h) + boff + n * 2048 + k * 1024); } while (0)
#define PG8_MMA(ai, bj, At, Bt) do { __builtin_amdgcn_s_setprio(1); _Pragma("unroll") for (int m = 0; m < 4; ++m) _Pragma("unroll") for (int n = 0; n < 2; ++n) _Pragma("unroll") for (int k = 0; k < 2; ++k) \
        acc[ai][bj][m][n] = __builtin_amdgcn_mfma_f32_16x16x32_bf16(Bt[n][k], At[m][k], acc[ai][bj][m][n], 0, 0, 0); __builtin_amdgcn_s_setprio(0); } while (0)
#define PG8_WAIT_V(n) asm volatile("s_waitcnt vmcnt(" #n ")" ::: "memory")
#define PG8_WAIT_L(n) asm volatile("s_waitcnt lgkmcnt(" #n ")" ::: "memory")
#define PG8_BAR __builtin_amdgcn_s_barrier()
#define PG8_SCHED __builtin_amdgcn_sched_barrier(0)
    Unit cur, nxt; int ui = 0;
    if (!S.next(0, cur)) return;
    f32x4 acc[2][2][4][2];
#pragma unroll
    for (int a = 0; a < 2; ++a)
#pragma unroll
        for (int b = 0; b < 2; ++b)
#pragma unroll
            for (int m = 0; m < 4; ++m)
#pragma unroll
                for (int n = 0; n < 2; ++n) acc[a][b][m][n] = (f32x4){0.f, 0.f, 0.f, 0.f};
    bf16x8 At[4][2], B0[2][2], B1[2][2];
    const char* cA = (const char*)g.A + (size_t)cur.pm * tstep; const char* cB = (const char*)g.Bt + (size_t)cur.e * g.bstride + (size_t)cur.pn * tstep;
    S.a_ready(cur);
    if constexpr (SP2) {
        PG8_STAGE(PG8_SB(0, 0), cB, voffB); PG8_STAGE(PG8_SB(0, 1), cB + hstep, voffB); PG8_STAGE(PG8_SA(0, 0), cA, voffA); PG8_STAGE(PG8_SA(0, 1), cA + hstep, voffA);
        if (wr == 1) PG8_BAR;
        PG8_WAIT_V(2); PG8_BAR;
        PG8_STAGE(PG8_SB(1, 0), cB + kstep, voffB); PG8_STAGE(PG8_SA(1, 0), cA + kstep, voffA); PG8_STAGE(PG8_SB(1, 1), cB + hstep + kstep, voffB);
        PG8_WAIT_V(6); PG8_BAR;
    } else {
        PG8_STAGE(PG8_SB(0, 0), cB, voffB); PG8_STAGE(PG8_SA(0, 0), cA, voffA); PG8_STAGE(PG8_SB(0, 1), cB + hstep, voffB); PG8_STAGE(PG8_SA(0, 1), cA + hstep, voffA);
        if (wr == 1) PG8_BAR;
        PG8_WAIT_V(4); PG8_BAR;
        PG8_STAGE(PG8_SB(1, 0), cB + kstep, voffB); PG8_STAGE(PG8_SA(1, 0), cA + kstep, voffA); PG8_STAGE(PG8_SB(1, 1), cB + hstep + kstep, voffB);
        PG8_WAIT_V(6); PG8_BAR;
    }
    for (;;) {
        const bool has_next = S.next(ui + 1, nxt);
        const char* nA = has_next ? (const char*)g.A + (size_t)nxt.pm * tstep : cA; const char* nB = has_next ? (const char*)g.Bt + (size_t)nxt.e * g.bstride + (size_t)nxt.pn * tstep : cB;
        for (int t = 0; t < nt; t += 2) {
            const bool last = (t == nt - 2);
            const char* a1 = cA + (size_t)(t + 1) * kstep;
            const char* a2 = last ? nA : cA + (size_t)(t + 2) * kstep; const char* b2 = last ? nB : cB + (size_t)(t + 2) * kstep;
            const char* a3 = a2 + kstep; const char* b3 = b2 + kstep;
            if (last && has_next) S.a_ready(nxt);
            if constexpr (SP2) {
            PG8_LDB(B0, 0, 0); PG8_LDB(B1, 0, 1); PG8_SCHED; PG8_LDA(At, 0, 0); PG8_STAGE(PG8_SA(1, 1), a1 + hstep, voffA);
            PG8_WAIT_V(8); PG8_WAIT_L(0); PG8_BAR; PG8_MMA(0, 0, At, B0); PG8_MMA(0, 1, At, B1); PG8_BAR; PG8_SCHED;
            PG8_LDA(At, 0, 1); PG8_STAGE(PG8_SB(0, 0), b2, voffB); PG8_STAGE(PG8_SB(0, 1), b2 + hstep, voffB); PG8_STAGE(PG8_SA(0, 0), a2, voffA);
            PG8_WAIT_V(8); PG8_WAIT_L(0); PG8_BAR; PG8_MMA(1, 0, At, B0); PG8_MMA(1, 1, At, B1); PG8_BAR; PG8_SCHED;
            PG8_LDB(B0, 1, 0); PG8_LDB(B1, 1, 1); PG8_SCHED; PG8_LDA(At, 1, 0); PG8_STAGE(PG8_SA(0, 1), a2 + hstep, voffA);
            PG8_WAIT_V(8); PG8_WAIT_L(0); PG8_BAR; PG8_MMA(0, 0, At, B0); PG8_MMA(0, 1, At, B1); PG8_BAR; PG8_SCHED;
            PG8_LDA(At, 1, 1); PG8_STAGE(PG8_SB(1, 0), b3, voffB); PG8_STAGE(PG8_SB(1, 1), b3 + hstep, voffB); PG8_STAGE(PG8_SA(1, 0), a3, voffA);
            PG8_WAIT_V(8); PG8_WAIT_L(0); PG8_BAR; PG8_MMA(1, 0, At, B0); PG8_MMA(1, 1, At, B1); PG8_BAR; PG8_SCHED;
            } else {
            PG8_LDB(B0, 0, 0); PG8_SCHED; PG8_LDA(At, 0, 0); PG8_STAGE(PG8_SA(1, 1), a1 + hstep, voffA);
            PG8_WAIT_L(8); PG8_BAR; PG8_WAIT_L(0); PG8_MMA(0, 0, At, B0); PG8_BAR; PG8_SCHED;
            PG8_LDB(B1, 0, 1); PG8_STAGE(PG8_SB(0, 0), b2, voffB);
            PG8_BAR; PG8_WAIT_L(0); PG8_MMA(0, 1, At, B1); PG8_BAR;
            PG8_LDA(At, 0, 1); PG8_STAGE(PG8_SA(0, 0), a2, voffA);
            PG8_BAR; PG8_WAIT_L(0); PG8_MMA(1, 0, At, B0); PG8_BAR; PG8_SCHED;
            PG8_STAGE(PG8_SB(0, 1), b2 + hstep, voffB);
            PG8_WAIT_V(6); PG8_BAR; PG8_MMA(1, 1, At, B1); PG8_BAR;
            PG8_LDB(B0, 1, 0); PG8_SCHED; PG8_LDA(At, 1, 0); PG8_STAGE(PG8_SA(0, 1), a2 + hstep, voffA);
            PG8_WAIT_L(8); PG8_BAR; PG8_WAIT_L(0); PG8_MMA(0, 0, At, B0); PG8_BAR; PG8_SCHED;
            PG8_LDB(B1, 1, 1); PG8_STAGE(PG8_SB(1, 0), b3, voffB);
            PG8_BAR; PG8_WAIT_L(0); PG8_MMA(0, 1, At, B1); PG8_BAR;
            PG8_LDA(At, 1, 1); PG8_STAGE(PG8_SA(1, 0), a3, voffA);
            PG8_BAR; PG8_WAIT_L(0); PG8_MMA(1, 0, At, B0); PG8_BAR; PG8_SCHED;
            PG8_STAGE(PG8_SB(1, 1), b3 + hstep, voffB);
            PG8_WAIT_V(6); PG8_BAR; PG8_MMA(1, 1, At, B1); PG8_BAR;
            }
        }
        if constexpr (ALIGN_EPI) { if (wr == 0) PG8_BAR; }
        if constexpr (!Epi::AFTER_DRAIN) { E(acc, cur, wr, wc, fr, fq); S.done(cur); }
        if (!has_next) break;
#pragma unroll
        for (int a = 0; a < 2; ++a)
#pragma unroll
            for (int b = 0; b < 2; ++b)
#pragma unroll
                for (int m = 0; m < 4; ++m)
#pragma unroll
                    for (int n = 0; n < 2; ++n) acc[a][b][m][n] = (f32x4){0.f, 0.f, 0.f, 0.f};
        cur = nxt; cA = nA; cB = nB; ++ui;
        if constexpr (ALIGN_EPI) { if (wr == 1) PG8_BAR; }
    }
    PG8_WAIT_V(0);
    if constexpr (!ALIGN_EPI) { if (wr == 0) PG8_BAR; }
    PG8_BAR;
    if constexpr (Epi::AFTER_DRAIN) { E.fused(acc, cur, wr, wc, fr, fq, lds, wid, lane); S.done(cur); }
#undef PG8_SA
#undef PG8_SB
#undef PG8_STAGE
#undef PG8_LDA
#undef PG8_LDB
#undef PG8_MMA
#undef PG8_WAIT_V
#undef PG8_WAIT_L
#undef PG8_BAR
#undef PG8_SCHED
}

}

constexpr int D = 1024, NB = 8, SEQ = 2048, DEPTH = 4, LEAD = 128, FIRSTV = 112, LT = LEAD + SEQ, NTOK = NB * LT;
constexpr int WIN = 3584, FFD = 2816, FFE = 3584, NE = 8, MAXSLOT = 36864;
constexpr float EPS = 1e-6f;
constexpr int NPHASE = 1 + 8 * DEPTH;

constexpr size_t MiB = 1u << 20;
constexpr size_t WS_CTL = 0, CTL_ZERO_BYTES = MiB;
constexpr size_t WS_TAB = 1 * MiB;
constexpr size_t WS_WIN = 2 * MiB;
constexpr size_t WS_WOUT = WS_WIN + 28 * MiB;
constexpr size_t WS_WD13 = WS_WOUT + 8 * MiB;
constexpr size_t WS_WD2 = WS_WD13 + 22 * MiB;
constexpr size_t WS_WM13 = WS_WD2 + 11 * MiB;
constexpr size_t WS_WM2 = WS_WM13 + 224 * MiB;
constexpr size_t WS_H = WS_WM2 + 112 * MiB;
constexpr size_t WS_HB = WS_H + 68 * MiB;
constexpr size_t WS_SSQ = WS_HB + 34 * MiB;
constexpr size_t WS_ROUTE = WS_SSQ + 2 * MiB;
constexpr size_t WS_ACT = WS_ROUTE + 2 * MiB;
constexpr size_t WS_XG = WS_ACT + 252 * MiB;
constexpr size_t WS_END = WS_XG + 72 * MiB;
constexpr size_t ACT_PROJ = 0, ACT_LOGF = 119 * MiB, ACT_MIX = 153 * MiB;
constexpr size_t TAB_LB = 0, TAB_BIAS = 8192, TAB_LAM = 12288, TAB_SUBLN = 12544, TAB_HGNW = 14592, TAB_RF = 20480, TAB_FNORM = 20480 + 65536;
constexpr size_t ROUTE_INFO = 0, ROUTE_LIST = 640 * 1024, ROUTE_RSTD = 1280 * 1024;
constexpr int CW_TMO = 0, CW_BAR = 4096, CW_CNT = 8192;

constexpr int RING_BYTES = 131072, MISC_OFF = RING_BYTES + 320, LDS_BYTES = 147456;

#define GAS __attribute__((address_space(1)))
#define LAS __attribute__((address_space(3)))
typedef unsigned short bf16;
typedef unsigned v4u __attribute__((ext_vector_type(4)));
typedef unsigned v2u __attribute__((ext_vector_type(2)));
typedef float f32x4 __attribute__((ext_vector_type(4)));
typedef GAS unsigned gu32;
#define RLX_AGENT __ATOMIC_RELAXED, __HIP_MEMORY_SCOPE_AGENT
#define LDS_WAIT() asm volatile("s_waitcnt lgkmcnt(0)" ::: "memory")
__device__ __forceinline__ unsigned f2bf(float f) { unsigned u = __builtin_bit_cast(unsigned, f); return (u + 0x7fffu + ((u >> 16) & 1u)) >> 16; }
__device__ __forceinline__ unsigned pk2(float lo, float hi) { return f2bf(lo) | (f2bf(hi) << 16); }
__device__ __forceinline__ float bf_lo(unsigned w) { return __builtin_bit_cast(float, w << 16); }
__device__ __forceinline__ float bf_hi(unsigned w) { return __builtin_bit_cast(float, w & 0xffff0000u); }
__device__ __forceinline__ float silu_f(float x) { return x * __builtin_amdgcn_rcpf(1.f + __expf(-x)); }
__device__ __forceinline__ float wave_sum(float v) {
#pragma unroll
    for (int o = 1; o < 64; o <<= 1) v += __shfl_xor(v, o);
    return v;
}

#define XB_TMO      128
#define XB_XCNT(j)  (256  + 64 * (j))
#define XB_XSUB(j)  (1280 + 64 * (j))
#define XB_XGEN(j)  (2304 + 64 * (j))
#define XB_TOP      3328
#define XB_TOPGEN   3392
#define XCD_BAR_WORDS 3456
#define XB_SPIN_CAP (1u << 18)

__device__ __forceinline__ unsigned xb_ld(unsigned* p)              { return __hip_atomic_load(p, __ATOMIC_RELAXED, __HIP_MEMORY_SCOPE_AGENT); }
__device__ __forceinline__ unsigned xb_add(unsigned* p, unsigned v) { return __hip_atomic_fetch_add(p, v, __ATOMIC_RELAXED, __HIP_MEMORY_SCOPE_AGENT); }
__device__ __forceinline__ unsigned xb_xcc_id() { return (unsigned)__builtin_amdgcn_s_getreg((3 << 11) | 20) & 0xFu; }
#define XB_SPIN(cond, bar) do { unsigned _sp = 0; while (cond) { __builtin_amdgcn_s_sleep(1); \
    if ((++_sp & 255u) == 0u) { if (xb_ld(&(bar)[XB_TMO])) break; if (_sp > XB_SPIN_CAP) { atomicAdd(&(bar)[XB_TMO], 1u); break; } } } } while (0)

struct XcdBarrier {
    unsigned* bar; unsigned x;
    volatile LAS unsigned* st;
};

__device__ __forceinline__ XcdBarrier xcd_barrier_post(unsigned* bar, volatile LAS unsigned* st) {
    XcdBarrier b; b.bar = bar; b.x = xb_xcc_id(); b.st = st;
    if (threadIdx.x == 0) (void)xb_add(&bar[XB_XCNT(b.x)], 1u);
    return b;
}
__device__ __forceinline__ void xcd_barrier_complete(unsigned* bar, unsigned x, unsigned& nloc, unsigned& nx) {
    const unsigned G = gridDim.x * gridDim.y * gridDim.z;
    unsigned sum, cnt, mine, sp = 0u;
    for (;;) {
        sum = 0u; cnt = 0u; mine = 0u;
#pragma unroll
        for (unsigned j = 0; j < 16; ++j) { const unsigned c = xb_ld(&bar[XB_XCNT(j)]); sum += c; cnt += (c > 0u) ? 1u : 0u; mine = (j == x) ? c : mine; }
        if (sum == G) break;
        __builtin_amdgcn_s_sleep(1);
        if ((++sp & 255u) == 0u) { if (xb_ld(&bar[XB_TMO])) break; if (sp > XB_SPIN_CAP) { atomicAdd(&bar[XB_TMO], 1u); break; } }
    }
    nloc = mine > 0u ? mine : 1u; nx = cnt > 0u ? cnt : 1u;
}

__device__ __forceinline__ void xcd_barrier(const XcdBarrier& b) {
    asm volatile("s_waitcnt vmcnt(0)" ::: "memory");
    __syncthreads();
    if (threadIdx.x == 0) {
        unsigned* bar = b.bar;
        __builtin_amdgcn_s_waitcnt(0);
        unsigned nloc = b.st[0], nx = b.st[1];
        if (nloc == 0u) { xcd_barrier_complete(bar, b.x, nloc, nx); b.st[0] = nloc; b.st[1] = nx; }
        const unsigned old = xb_add(&bar[XB_XSUB(b.x)], 1u);
        const unsigned gen = old / nloc;
        if (old + 1u == (gen + 1u) * nloc) {
            __builtin_amdgcn_fence(__ATOMIC_RELEASE, "agent");
            asm volatile("s_waitcnt vmcnt(0)" ::: "memory");
            const unsigned og = xb_add(&bar[XB_TOP], 1u);
            const unsigned tg = og / nx;
            if (og + 1u == (tg + 1u) * nx) xb_add(&bar[XB_TOPGEN], 1u);
            else XB_SPIN(xb_ld(&bar[XB_TOPGEN]) == tg, bar);
            __builtin_amdgcn_fence(__ATOMIC_ACQUIRE, "agent");
            xb_add(&bar[XB_XGEN(b.x)], 1u);
            asm volatile("s_waitcnt vmcnt(0)" ::: "memory");
        } else {
            XB_SPIN(xb_ld(&bar[XB_XGEN(b.x)]) == gen, bar);
            __builtin_amdgcn_fence(__ATOMIC_ACQUIRE, "agent");
            asm volatile("s_waitcnt vmcnt(0)" ::: "memory");
        }
    }
    __syncthreads();
}


static __device__ const unsigned char T5B[129] = {0, 1, 2, 3, 4, 5, 6, 7, 8, 9, 10, 11, 12, 13, 14, 15, 16, 16, 16, 17, 17, 18, 18, 18, 19, 19, 19, 20, 20, 20, 20, 21, 21, 21, 21, 22, 22, 22, 22, 22, 23, 23, 23, 23, 23, 23, 24, 24, 24, 24, 24, 24, 25, 25, 25, 25, 25, 25, 25, 26, 26, 26, 26, 26, 26, 26, 26, 27, 27, 27, 27, 27, 27, 27, 27, 27, 27, 28, 28, 28, 28, 28, 28, 28, 28, 28, 28, 29, 29, 29, 29, 29, 29, 29, 29, 29, 29, 29, 29, 30, 30, 30, 30, 30, 30, 30, 30, 30, 30, 30, 30, 30, 30, 31, 31, 31, 31, 31, 31, 31, 31, 31, 31, 31, 31, 31, 31, 31, 31};

struct Ctx {
    LAS unsigned char* lds;
    int tid, lane, wave, G, bid;
    float* out;
    unsigned char* ws;
    __device__ __forceinline__ gu32* ctl() const { return (gu32*)(ws + WS_CTL); }
    __device__ __forceinline__ float* H() const { return (float*)(ws + WS_H); }
    __device__ __forceinline__ bf16* HB() const { return (bf16*)(ws + WS_HB); }
    __device__ __forceinline__ float* SSQ() const { return (float*)(ws + WS_SSQ); }
    __device__ __forceinline__ bf16* PROJ() const { return (bf16*)(ws + WS_ACT + ACT_PROJ); }
    __device__ __forceinline__ float* LOGF() const { return (float*)(ws + WS_ACT + ACT_LOGF); }
    __device__ __forceinline__ bf16* MIX() const { return (bf16*)(ws + WS_ACT + ACT_MIX); }
    __device__ __forceinline__ bf16* T() const { return (bf16*)(ws + WS_ACT); }
    __device__ __forceinline__ bf16* XG() const { return (bf16*)(ws + WS_XG); }
    __device__ __forceinline__ bf16* Y() const { return (bf16*)(ws + WS_XG); }
    __device__ __forceinline__ float* LB() const { return (float*)(ws + WS_TAB + TAB_LB); }
    __device__ __forceinline__ float* BIAST() const { return (float*)(ws + WS_TAB + TAB_BIAS); }
    __device__ __forceinline__ float* LAM() const { return (float*)(ws + WS_TAB + TAB_LAM); }
    __device__ __forceinline__ float* RF() const { return (float*)(ws + WS_TAB + TAB_RF); }
    __device__ __forceinline__ float* SUBLN() const { return (float*)(ws + WS_TAB + TAB_SUBLN); }
    __device__ __forceinline__ float* HGNW() const { return (float*)(ws + WS_TAB + TAB_HGNW); }
    __device__ __forceinline__ float* FNORM() const { return (float*)(ws + WS_TAB + TAB_FNORM); }
    __device__ __forceinline__ unsigned* TINFO() const { return (unsigned*)(ws + WS_ROUTE + ROUTE_INFO); }
    __device__ __forceinline__ int* LIST() const { return (int*)(ws + WS_ROUTE + ROUTE_LIST); }
    __device__ __forceinline__ float* RSTD() const { return (float*)(ws + WS_ROUTE + ROUTE_RSTD); }
};
struct Args { const float* in[19]; float* out; unsigned char* ws; int ph_lo, ph_hi; };
enum { IN_X = 0, IN_META, IN_RELB, IN_NMIX, IN_WIN, IN_LBL, IN_HGNW, IN_LAMBDA, IN_SUBLN, IN_WOUT, IN_NFFN, IN_DW1, IN_DW3, IN_DW2, IN_ROUTER, IN_MW1, IN_MW3, IN_MW2, IN_FNORM };

__device__ __forceinline__ float row_rstd(const float* ssq, int row) {
    const f32x4* p = (const f32x4*)(ssq + (size_t)row * 16);
    const f32x4 a = p[0], b = p[1], c = p[2], d = p[3];
    const float s = ((a[0] + a[1]) + (a[2] + a[3])) + ((b[0] + b[1]) + (b[2] + b[3])) + ((c[0] + c[1]) + (c[2] + c[3])) + ((d[0] + d[1]) + (d[2] + d[3]));
    return rsqrtf(s * (1.0f / 1024.0f) + EPS);
}
template <int N> __device__ __forceinline__ float dpp_row_shr(float x) {
    return __builtin_bit_cast(float, __builtin_amdgcn_update_dpp(0, __builtin_bit_cast(int, x), 0x110 + N, 0xf, 0xf, true));
}
struct EpiProj {
    static constexpr bool PERM = true, AFTER_DRAIN = false;
    bf16* proj; float* logfp; const float* ssq; const float* lb;
    template <int AI, int BJ, int NN> __device__ __forceinline__ void hf_block(const pg8::f32x4 (&acc)[2][2][4][2], int row0, int colb) const {
        const int c0 = colb + BJ * 128 + 4 * NN, cc = c0 - 512;
        const f32x4 l0 = *(const f32x4*)(lb + cc);
        float lf[4][4];
#pragma unroll
        for (int m = 0; m < 4; ++m) {
            const int row = row0 + AI * 128 + m * 16;
            const float r = row_rstd(ssq, row);
            const bool valid = (row % LT) >= FIRSTV;
            float kx[4];
#pragma unroll
            for (int j = 0; j < 4; ++j) {
                const float lbv = l0[j];
                const float xx = acc[AI][BJ][m][NN][j] * r;
                const float xc = fminf(fmaxf(xx, -30.f), 30.f);
                const float te = __expf(-xc), sg = __builtin_amdgcn_rcpf(1.f + te);
                float lgf = __logf(lbv + (1.f - lbv) * sg);
                float kk = (1.f - lbv) * (te * sg);
                if (!valid) { lgf = 0.f; kk = 0.f; }
                lf[m][j] = lgf; kx[j] = kk;
            }
            v2u w; w.x = pg8::cvt_pk_bf16(kx[0], kx[1]); w.y = pg8::cvt_pk_bf16(kx[2], kx[3]);
            *(v2u*)(proj + (size_t)row * WIN + c0) = w;
        }
#pragma unroll
        for (int j = 0; j < 4; ++j) {
            float carry = 0.f;
#pragma unroll
            for (int m = 0; m < 4; ++m) {
                float x = lf[m][j];
                x += dpp_row_shr<1>(x); x += dpp_row_shr<2>(x); x += dpp_row_shr<4>(x); x += dpp_row_shr<8>(x);
                x += carry;
                carry = __shfl(x, 15, 16);
                lf[m][j] = x;
            }
        }
#pragma unroll
        for (int m = 0; m < 4; ++m) *(f32x4*)(logfp + (size_t)(row0 + AI * 128 + m * 16) * 512 + cc) = (f32x4){lf[m][0], lf[m][1], lf[m][2], lf[m][3]};
    }
    __device__ __forceinline__ void operator()(const pg8::f32x4 (&acc)[2][2][4][2], const pg8::Unit& u, int wr, int wc, int fr, int fq) const {
        const int grp = u.pn >> 1;
        const int row0 = u.pm * 256 + wr * 64 + fr, colb = u.pn * 256 + wc * 32 + 8 * fq;
        if (grp == 1) {
            hf_block<0, 0, 0>(acc, row0, colb); hf_block<0, 0, 1>(acc, row0, colb); hf_block<0, 1, 0>(acc, row0, colb); hf_block<0, 1, 1>(acc, row0, colb);
            hf_block<1, 0, 0>(acc, row0, colb); hf_block<1, 0, 1>(acc, row0, colb); hf_block<1, 1, 0>(acc, row0, colb); hf_block<1, 1, 1>(acc, row0, colb);
            return;
        }
#pragma unroll
        for (int ai = 0; ai < 2; ++ai)
#pragma unroll
            for (int m = 0; m < 4; ++m) {
                const int row = row0 + ai * 128 + m * 16;
                const float r = row_rstd(ssq, row);
#pragma unroll
                for (int bj = 0; bj < 2; ++bj) {
                    const int c0 = colb + bj * 128;
                    float x[8];
#pragma unroll
                    for (int j = 0; j < 4; ++j) { x[j] = acc[ai][bj][m][0][j] * r; x[4 + j] = acc[ai][bj][m][1][j] * r; }
                    if (grp == 0 || grp == 3) {
#pragma unroll
                        for (int j = 0; j < 8; ++j) x[j] = silu_f(x[j]);
                    } else if (grp == 4) {
#pragma unroll
                        for (int j = 0; j < 8; ++j) x[j] *= 0.18033688011112042f;
                    }
                    v4u w; w.x = pg8::cvt_pk_bf16(x[0], x[1]); w.y = pg8::cvt_pk_bf16(x[2], x[3]); w.z = pg8::cvt_pk_bf16(x[4], x[5]); w.w = pg8::cvt_pk_bf16(x[6], x[7]);
                    *(v4u*)(proj + (size_t)row * WIN + c0) = w;
                }
            }
    }
};
struct EpiResid {
    static constexpr bool PERM = true, AFTER_DRAIN = false;
    float* H; bf16* HB; float* ssq;
    __device__ __forceinline__ void operator()(const pg8::f32x4 (&acc)[2][2][4][2], const pg8::Unit& u, int wr, int wc, int fr, int fq) const {
        const int row0 = u.pm * 256 + wr * 64 + fr, colb = u.pn * 256 + wc * 32 + 8 * fq;
#pragma unroll
        for (int ai = 0; ai < 2; ++ai)
#pragma unroll
            for (int m = 0; m < 4; ++m) {
                const int row = row0 + ai * 128 + m * 16;
                float s = 0.f;
#pragma unroll
                for (int bj = 0; bj < 2; ++bj) {
                    const int c0 = colb + bj * 128;
                    float* hp = H + (size_t)row * D + c0;
                    f32x4 h0 = *(const f32x4*)hp, h1 = *(const f32x4*)(hp + 4);
                    h0 = h0 + acc[ai][bj][m][0]; h1 = h1 + acc[ai][bj][m][1];
                    *(f32x4*)hp = h0; *(f32x4*)(hp + 4) = h1;
                    s += (h0[0] * h0[0] + h0[1] * h0[1]) + (h0[2] * h0[2] + h0[3] * h0[3]) + (h1[0] * h1[0] + h1[1] * h1[1]) + (h1[2] * h1[2] + h1[3] * h1[3]);
                    v4u w; w.x = pg8::cvt_pk_bf16(h0[0], h0[1]); w.y = pg8::cvt_pk_bf16(h0[2], h0[3]); w.z = pg8::cvt_pk_bf16(h1[0], h1[1]); w.w = pg8::cvt_pk_bf16(h1[2], h1[3]);
                    *(v4u*)(HB + (size_t)row * D + c0) = w;
                }
                s += __shfl_xor(s, 16); s += __shfl_xor(s, 32);
                if (fq == 0) ssq[(size_t)row * 16 + u.pn * 4 + wc] = s;
            }
    }
};
struct EpiGLU {
    static constexpr bool PERM = true, AFTER_DRAIN = false;
    bf16* T; int ldt; const float* ssq;
    __device__ __forceinline__ void operator()(const pg8::f32x4 (&acc)[2][2][4][2], const pg8::Unit& u, int wr, int wc, int fr, int fq) const {
        const int row0 = u.pm * 256 + wr * 64 + fr, colb = u.pn * 128 + wc * 32 + 8 * fq;
#pragma unroll
        for (int ai = 0; ai < 2; ++ai)
#pragma unroll
            for (int m = 0; m < 4; ++m) {
                const int row = row0 + ai * 128 + m * 16;
                const float r = ssq ? row_rstd(ssq, row) : 1.f;
                float x[8];
#pragma unroll
                for (int j = 0; j < 4; ++j) { x[j] = silu_f(acc[ai][0][m][0][j] * r) * (acc[ai][1][m][0][j] * r); x[4 + j] = silu_f(acc[ai][0][m][1][j] * r) * (acc[ai][1][m][1][j] * r); }
                v4u w; w.x = pg8::cvt_pk_bf16(x[0], x[1]); w.y = pg8::cvt_pk_bf16(x[2], x[3]); w.z = pg8::cvt_pk_bf16(x[4], x[5]); w.w = pg8::cvt_pk_bf16(x[6], x[7]);
                *(v4u*)(T + (size_t)row * ldt + colb) = w;
            }
    }
};
struct EpiY {
    static constexpr bool PERM = true, AFTER_DRAIN = false;
    bf16* Y;
    __device__ __forceinline__ void operator()(const pg8::f32x4 (&acc)[2][2][4][2], const pg8::Unit& u, int wr, int wc, int fr, int fq) const {
        const int row0 = u.pm * 256 + wr * 64 + fr, colb = u.pn * 256 + wc * 32 + 8 * fq;
#pragma unroll
        for (int ai = 0; ai < 2; ++ai)
#pragma unroll
            for (int m = 0; m < 4; ++m) {
                const int row = row0 + ai * 128 + m * 16;
#pragma unroll
                for (int bj = 0; bj < 2; ++bj) {
                    const pg8::f32x4 a = acc[ai][bj][m][0], b = acc[ai][bj][m][1];
                    v4u w; w.x = pg8::cvt_pk_bf16(a[0], a[1]); w.y = pg8::cvt_pk_bf16(a[2], a[3]); w.z = pg8::cvt_pk_bf16(b[0], b[1]); w.w = pg8::cvt_pk_bf16(b[2], b[3]);
                    *(v4u*)(Y + (size_t)row * D + colb + bj * 128) = w;
                }
            }
    }
};

__device__ __forceinline__ void transpose_item(const float* W, const float* fold, int K, int N, bf16* WT, int k0, int n0, int drow0, LAS float* scr, int lane) {
    const int kr = lane >> 4, n4 = lane & 15;
    f32x4 v[16];
#pragma unroll
    for (int i = 0; i < 16; ++i) v[i] = *(const f32x4*)(W + (size_t)(k0 + 4 * i + kr) * N + n0 + 4 * n4);
#pragma unroll
    for (int i = 0; i < 16; ++i) { const int k = 4 * i + kr; *(LAS f32x4*)(scr + k * 64 + ((4 * n4) ^ (4 * ((k >> 3) & 7)))) = v[i]; }
    LDS_WAIT(); asm volatile("" ::: "memory");
    const int c = lane & 7, nn = lane >> 3;
    f32x4 f0 = (f32x4){1.f, 1.f, 1.f, 1.f}, f1 = f0;
    if (fold) { f0 = *(const f32x4*)(fold + k0 + 8 * c); f1 = *(const f32x4*)(fold + k0 + 8 * c + 4); }
#pragma unroll
    for (int i2 = 0; i2 < 8; ++i2) {
        const int n = 8 * i2 + nn; const LAS float* s = scr + (8 * c) * 64 + (n ^ (4 * c));
        v4u o; o.x = pk2(s[0 * 64] * f0[0], s[1 * 64] * f0[1]); o.y = pk2(s[2 * 64] * f0[2], s[3 * 64] * f0[3]); o.z = pk2(s[4 * 64] * f1[0], s[5 * 64] * f1[1]); o.w = pk2(s[6 * 64] * f1[2], s[7 * 64] * f1[3]);
        *(GAS v4u*)(WT + (size_t)(drow0 + n) * K + k0 + 8 * c) = o;
    }
    LDS_WAIT(); asm volatile("" ::: "memory");
}
__device__ __forceinline__ void prologue_phase(Ctx& C, const Args& A) {
    LAS float* scr = (LAS float*)(C.lds + C.wave * 16384);
    const int gw = C.bid * 8 + C.wave, NGW = C.G * 8;
    constexpr int I_IN = 16 * 56, I_OUT = 16 * 16, I_D1 = 16 * 44, I_D2 = 44 * 16, I_M1 = 16 * 56, I_M2 = 56 * 16;
    constexpr int N_IN = 4 * I_IN, N_OUT = 4 * I_OUT, N_D1 = 2 * I_D1, N_D2 = 2 * I_D2, N_M1 = 16 * I_M1, N_M2 = 16 * I_M2;
    constexpr int NITEMS = N_IN + N_OUT + 2 * N_D1 + N_D2 + 2 * N_M1 + N_M2;
    for (int it = gw; it < NITEMS; it += NGW) {
        int r = it;
        const float* W; const float* fold = nullptr; bf16* WT; int K, N, glu = -1, loc;
        if (r < N_IN) { const int l = r / I_IN; loc = r % I_IN; W = A.in[IN_WIN] + (size_t)l * D * WIN; fold = A.in[IN_NMIX] + l * D; WT = (bf16*)(C.ws + WS_WIN) + (size_t)l * WIN * D; K = D; N = WIN; }
        else if ((r -= N_IN) < N_OUT) { const int l = r / I_OUT; loc = r % I_OUT; W = A.in[IN_WOUT] + (size_t)l * D * D; WT = (bf16*)(C.ws + WS_WOUT) + (size_t)l * D * D; K = D; N = D; }
        else if ((r -= N_OUT) < N_D1) { const int i = r / I_D1; loc = r % I_D1; W = A.in[IN_DW1] + (size_t)i * D * FFD; fold = A.in[IN_NFFN] + (2 * i) * D; WT = (bf16*)(C.ws + WS_WD13) + (size_t)i * 2 * FFD * D; K = D; N = FFD; glu = 0; }
        else if ((r -= N_D1) < N_D1) { const int i = r / I_D1; loc = r % I_D1; W = A.in[IN_DW3] + (size_t)i * D * FFD; fold = A.in[IN_NFFN] + (2 * i) * D; WT = (bf16*)(C.ws + WS_WD13) + (size_t)i * 2 * FFD * D; K = D; N = FFD; glu = 1; }
        else if ((r -= N_D1) < N_D2) { const int i = r / I_D2; loc = r % I_D2; W = A.in[IN_DW2] + (size_t)i * FFD * D; WT = (bf16*)(C.ws + WS_WD2) + (size_t)i * D * FFD; K = FFD; N = D; }
        else if ((r -= N_D2) < N_M1) { const int ie = r / I_M1; loc = r % I_M1; W = A.in[IN_MW1] + (size_t)ie * D * FFE; fold = A.in[IN_NFFN] + (2 * (ie >> 3) + 1) * D; WT = (bf16*)(C.ws + WS_WM13) + (size_t)ie * 2 * FFE * D; K = D; N = FFE; glu = 0; }
        else if ((r -= N_M1) < N_M1) { const int ie = r / I_M1; loc = r % I_M1; W = A.in[IN_MW3] + (size_t)ie * D * FFE; fold = A.in[IN_NFFN] + (2 * (ie >> 3) + 1) * D; WT = (bf16*)(C.ws + WS_WM13) + (size_t)ie * 2 * FFE * D; K = D; N = FFE; glu = 1; }
        else { r -= N_M1; const int ie = r / I_M2; loc = r % I_M2; W = A.in[IN_MW2] + (size_t)ie * FFE * D; WT = (bf16*)(C.ws + WS_WM2) + (size_t)ie * D * FFE; K = FFE; N = D; }
        const int nblk = N / 64, kb = loc / nblk, nb = loc % nblk, k0 = 64 * kb, n0 = 64 * nb;
        const int drow0 = (glu < 0) ? n0 : ((n0 >> 7) * 256 + glu * 128 + (n0 & 127));
        transpose_item(W, fold, K, N, WT, k0, n0, drow0, scr, C.lane);
    }
    for (int row = gw; row < NTOK; row += NGW) {
        const int b = row / LT, t = row % LT;
        f32x4 v[4]; float s = 0.f;
#pragma unroll
        for (int j = 0; j < 4; ++j) {
            const int col = 4 * C.lane + 256 * j;
            if (t < FIRSTV) v[j] = (f32x4){0.f, 0.f, 0.f, 0.f};
            else if (t < LEAD) v[j] = *(const f32x4*)(A.in[IN_META] + (size_t)(t - FIRSTV) * D + col);
            else v[j] = *(const f32x4*)(A.in[IN_X] + ((size_t)b * SEQ + (t - LEAD)) * D + col);
            s += (v[j][0] * v[j][0] + v[j][1] * v[j][1]) + (v[j][2] * v[j][2] + v[j][3] * v[j][3]);
            *(f32x4*)(C.H() + (size_t)row * D + col) = v[j];
            v2u w; w.x = pk2(v[j][0], v[j][1]); w.y = pk2(v[j][2], v[j][3]);
            *(v2u*)(C.HB() + (size_t)row * D + col) = w;
        }
        s = wave_sum(s);
        if (C.lane < 16) C.SSQ()[(size_t)row * 16 + C.lane] = (C.lane == 0) ? s : 0.f;
    }
    if (C.bid == 0) {
        const int tid = C.tid;
        {
            const float* lg = A.in[IN_LBL];
            const float a0 = lg[tid], a1 = lg[512 + tid], a2 = lg[1024 + tid], a3 = lg[1536 + tid];
            const float mx = fmaxf(fmaxf(a0, a1), fmaxf(a2, a3));
            const float e0 = expf(a0 - mx), e1 = expf(a1 - mx), e2 = expf(a2 - mx), e3 = expf(a3 - mx);
            const float inv = 1.f / (((e0 + e1) + e2) + e3);
            const float p0 = e0 * inv, p1 = e1 * inv, p2 = e2 * inv, p3 = e3 * inv;
            const float c0 = p0, c1 = c0 + p1, c2 = c1 + p2, c3 = c2 + p3;
            C.LB()[tid] = 0.f;
            C.LB()[512 + tid] = fminf(fmaxf(c1 - c0, 0.f), 0.999f);
            C.LB()[1024 + tid] = fminf(fmaxf(c2 - c0, 0.f), 0.999f);
            C.LB()[1536 + tid] = fminf(fmaxf(c3 - c0, 0.f), 0.999f);
        }
        for (int i = tid; i < 4 * 132; i += 512) { const int h = i / 132, d = i % 132; C.BIAST()[i] = (d <= 128) ? A.in[IN_RELB][T5B[d] * 4 + h] : 0.f; }
        if (tid < 4) {
            const float* lv = A.in[IN_LAMBDA] + tid * 256;
            float s01 = 0.f, s23 = 0.f;
            for (int j = 0; j < 64; ++j) { s01 += lv[j] * lv[64 + j]; s23 += lv[128 + j] * lv[192 + j]; }
            const float li = 0.8f - 0.6f * expf(-0.3f * (float)tid);
            C.LAM()[tid * 2] = expf(s01) - expf(s23) + li; C.LAM()[tid * 2 + 1] = li;
        }
        if (tid < 512) { C.SUBLN()[tid] = A.in[IN_SUBLN][tid]; C.HGNW()[tid] = A.in[IN_HGNW][tid]; C.FNORM()[tid] = A.in[IN_FNORM][tid]; C.FNORM()[512 + tid] = A.in[IN_FNORM][512 + tid]; }
        for (int i = tid; i < 2 * 8 * 1024; i += 512) { const int li = i >> 13, e = (i >> 10) & 7, k = i & 1023; C.RF()[i] = A.in[IN_NFFN][(2 * li + 1) * D + k] * A.in[IN_ROUTER][(size_t)li * D * NE + k * NE + e]; }
    }
}

__device__ __forceinline__ void hgrn_naive_unit(Ctx& C, int l, int b, int h) {
    LAS float* qf = (LAS float*)C.lds;
    LAS float* kf = qf + 2048; LAS float* ff = kf + 2048; LAS float* vv = ff + 2048; LAS float* gg = vv + 2048;
    LAS float* opart = gg + 2048;
    const int tid = C.tid, dv = tid & 127, qd = tid >> 7;
    const int ltok = tid >> 5, c4 = (tid & 31) * 4;
    float S[32];
#pragma unroll
    for (int j = 0; j < 32; ++j) S[j] = 0.f;
    const float* nw = C.HGNW() + l * 128;
    for (int tb = 0; tb < LT / 16; ++tb) {
        const size_t row = (size_t)b * LT + tb * 16 + ltok;
        {
            const bf16* pp = C.PROJ() + row * WIN + h * 128 + c4;
            const v2u wq = *(const v2u*)pp, wk = *(const v2u*)(pp + 512), wv = *(const v2u*)(pp + 1024), wg = *(const v2u*)(pp + 1536);
            const f32x4 lf = *(const f32x4*)(C.LOGF() + row * 512 + h * 128 + c4);
            const int o = ltok * 128 + c4;
            qf[o] = bf_lo(wq.x); qf[o + 1] = bf_hi(wq.x); qf[o + 2] = bf_lo(wq.y); qf[o + 3] = bf_hi(wq.y);
            kf[o] = bf_lo(wk.x); kf[o + 1] = bf_hi(wk.x); kf[o + 2] = bf_lo(wk.y); kf[o + 3] = bf_hi(wk.y);
            vv[o] = bf_lo(wv.x); vv[o + 1] = bf_hi(wv.x); vv[o + 2] = bf_lo(wv.y); vv[o + 3] = bf_hi(wv.y);
            gg[o] = bf_lo(wg.x); gg[o + 1] = bf_hi(wg.x); gg[o + 2] = bf_lo(wg.y); gg[o + 3] = bf_hi(wg.y);
            f32x4 lp = (f32x4){0.f, 0.f, 0.f, 0.f};
            if (((tb * 16 + ltok) & 63) != 0) lp = *(const f32x4*)(C.LOGF() + (row - 1) * 512 + h * 128 + c4);
            ff[o] = expf(lf[0] - lp[0]); ff[o + 1] = expf(lf[1] - lp[1]); ff[o + 2] = expf(lf[2] - lp[2]); ff[o + 3] = expf(lf[3] - lp[3]);
        }
        __syncthreads();
        for (int tok = 0; tok < 16; ++tok) {
            const float v = vv[tok * 128 + dv];
            const LAS f32x4* fp = (const LAS f32x4*)(ff + tok * 128 + 32 * qd);
            const LAS f32x4* kp = (const LAS f32x4*)(kf + tok * 128 + 32 * qd);
            const LAS f32x4* qp = (const LAS f32x4*)(qf + tok * 128 + 32 * qd);
            float a = 0.f;
#pragma unroll
            for (int j = 0; j < 8; ++j) {
                const f32x4 f4 = fp[j], k4 = kp[j], q4 = qp[j];
#pragma unroll
                for (int i = 0; i < 4; ++i) { S[4 * j + i] = f4[i] * S[4 * j + i] + k4[i] * v; a += q4[i] * S[4 * j + i]; }
            }
            opart[(tok * 4 + qd) * 128 + dv] = a;
        }
        __syncthreads();
        {
            float o[4]; float ss = 0.f;
#pragma unroll
            for (int i = 0; i < 4; ++i) { o[i] = (opart[(ltok * 4 + 0) * 128 + c4 + i] + opart[(ltok * 4 + 1) * 128 + c4 + i]) + (opart[(ltok * 4 + 2) * 128 + c4 + i] + opart[(ltok * 4 + 3) * 128 + c4 + i]); ss += o[i] * o[i]; }
#pragma unroll
            for (int m = 1; m < 32; m <<= 1) ss += __shfl_xor(ss, m);
            const float rs = rsqrtf(ss * (1.0f / 128.0f) + EPS);
            const int oo = ltok * 128 + c4;
            v2u w; w.x = pk2(o[0] * rs * nw[c4] * gg[oo], o[1] * rs * nw[c4 + 1] * gg[oo + 1]); w.y = pk2(o[2] * rs * nw[c4 + 2] * gg[oo + 2], o[3] * rs * nw[c4 + 3] * gg[oo + 3]);
            *(v2u*)(C.MIX() + row * D + h * 128 + c4) = w;
        }
        __syncthreads();
    }
}
typedef float f32x16 __attribute__((ext_vector_type(16)));
typedef short bf16x8 __attribute__((ext_vector_type(8)));
typedef short s16x4 __attribute__((ext_vector_type(4)));
constexpr float LOG2E = 1.4426950408889634f;
constexpr int AT_K = 0, AT_V = 32768, AT_BIAS = 65536, AT_WSF = 66560, AT_STG = 69632, AT_XCH = 0;
__device__ __forceinline__ int crow(int r, int hi) { return (r & 3) + 8 * (r >> 2) + 4 * hi; }
__device__ __forceinline__ s16x4 vtr(const LAS unsigned char* p) { typedef short v4i16_t __attribute__((ext_vector_type(4))); return __builtin_bit_cast(s16x4, __builtin_amdgcn_ds_read_tr16_b64_v4i16((LAS v4i16_t*)p)); }
__device__ __forceinline__ bf16x8 pack8(const f32x16& p, int b0) {
    v4u w; w.x = pg8::cvt_pk_bf16(p[b0 + 0], p[b0 + 1]); w.y = pg8::cvt_pk_bf16(p[b0 + 2], p[b0 + 3]); w.z = pg8::cvt_pk_bf16(p[b0 + 4], p[b0 + 5]); w.w = pg8::cvt_pk_bf16(p[b0 + 6], p[b0 + 7]);
    return __builtin_bit_cast(bf16x8, w);
}
__device__ __forceinline__ void attn_unit(Ctx& C, int l, int b, int h, int qi) {
    LAS unsigned char* lds = C.lds;
    const int tid = C.tid, lane = C.lane, wave = C.wave, rg = wave >> 1, c = wave & 1, r32 = lane & 31, hi = lane >> 5;
    const size_t rowbase = (size_t)b * LT;
    const bf16* PJ = C.PROJ();
    LAS float* biasl = (LAS float*)(lds + AT_BIAS);
    LAS float* wsf = (LAS float*)(lds + AT_WSF) + wave * 64;
    if (tid < 132) biasl[tid] = C.BIAST()[h * 132 + tid] * LOG2E;
    const float lam = C.LAM()[l * 2], lam_init = C.LAM()[l * 2 + 1];
    const int qw0 = 128 * qi + 32 * rg, tq = qw0 + r32;
    bf16x8 qr[4];
    { const bf16* qp = PJ + (rowbase + tq) * WIN + 2048 + h * 128 + c * 64 + 8 * hi;
#pragma unroll
      for (int ks = 0; ks < 4; ++ks) qr[ks] = *(const bf16x8*)(qp + 16 * ks); }
    const int kkey = tid >> 3, kch = tid & 7;
    const bf16* ksrc = PJ + (rowbase + kkey) * WIN + 2560 + h * 128 + kch * 8;
    const int kdst = kkey * 128 + ((kch ^ ((kkey >> 1) & 7)) * 16);
    const int vkey0 = tid >> 4, vch = tid & 15;
    const bf16* vsrc = PJ + (rowbase + vkey0) * WIN + 3072 + h * 128 + vch * 8;
    const int vdst0 = ((vkey0 >> 3) * 4 + (vch >> 2)) * 512 + (vkey0 & 7) * 64 + (vch & 3) * 16;
    v4u kreg0, kreg1, vreg0, vreg1;
#define AT_LOAD(kt) do { const size_t o_ = (size_t)(kt) * 64 * WIN; kreg0 = *(const v4u*)(ksrc + o_); kreg1 = *(const v4u*)(ksrc + o_ + 64); vreg0 = *(const v4u*)(vsrc + o_); vreg1 = *(const v4u*)(vsrc + o_ + (size_t)32 * WIN); } while (0)
#define AT_STORE(buf) do { *(LAS v4u*)(lds + AT_K + (buf) * 16384 + kdst) = kreg0; *(LAS v4u*)(lds + AT_K + (buf) * 16384 + 8192 + kdst) = kreg1; \
        *(LAS v4u*)(lds + AT_V + (buf) * 16384 + vdst0) = vreg0; *(LAS v4u*)(lds + AT_V + (buf) * 16384 + 8192 + vdst0) = vreg1; } while (0)
    const int nt = 2 * qi + 1;
    AT_LOAD(1); AT_STORE(0);
    __syncthreads();
    f32x16 o[4];
#pragma unroll
    for (int d = 0; d < 4; ++d)
#pragma unroll
        for (int r = 0; r < 16; ++r) o[d][r] = 0.f;
    float mref = -1e30f, lsum = 0.f;
    const int kswz = (r32 >> 1) & 7;
    const int vb = (4 * hi + ((lane & 15) >> 2)) * 64 + ((lane >> 4) & 1) * 32 + (lane & 3) * 8;
    const float b128 = biasl[128];
    for (int it = 0; it < nt; ++it) {
        const int kt = it + 1, buf = it & 1, k0 = 64 * kt;
        if (it + 1 < nt) AT_LOAD(kt + 1);
        if (k0 <= qw0 + 31) {
            const bool near = (k0 + 63 > qw0 - 128) || (kt == 1);
            f32x16 p0, p1;
            { const float ini = near ? 0.f : b128;
#pragma unroll
              for (int r = 0; r < 16; ++r) { p0[r] = ini; p1[r] = ini; } }
            const LAS unsigned char* kb = lds + AT_K + buf * 16384 + c * 8192 + r32 * 128;
#pragma unroll
            for (int ks = 0; ks < 4; ++ks) {
                const int off = ((2 * ks + hi) ^ kswz) * 16;
                const bf16x8 k0f = *(const LAS bf16x8*)(kb + off), k1f = *(const LAS bf16x8*)(kb + 4096 + off);
                p0 = __builtin_amdgcn_mfma_f32_32x32x16_bf16(k0f, qr[ks], p0, 0, 0, 0);
                p1 = __builtin_amdgcn_mfma_f32_32x32x16_bf16(k1f, qr[ks], p1, 0, 0, 0);
            }
            if (near) {
#pragma unroll
                for (int r = 0; r < 16; ++r) {
                    const int tk = k0 + crow(r, hi), d0 = tq - tk, d1 = d0 - 32;
                    const float b0 = biasl[d0 < 0 ? 0 : (d0 > 128 ? 128 : d0)], b1 = biasl[d1 < 0 ? 0 : (d1 > 128 ? 128 : d1)];
                    p0[r] = (d0 < 0 || tk < FIRSTV) ? -INFINITY : p0[r] + b0;
                    p1[r] = (d1 < 0 || tk + 32 < FIRSTV) ? -INFINITY : p1[r] + b1;
                }
            }
            float mx = fmaxf(p0[0], p1[0]);
#pragma unroll
            for (int r = 1; r < 16; ++r) mx = fmaxf(fmaxf(mx, p0[r]), p1[r]);
            mx = fmaxf(mx, __shfl_xor(mx, 32));
            if (__any(mx > mref + 8.0f)) {
                const float mnew = fmaxf(mref, mx), f = __builtin_amdgcn_exp2f(mref - mnew);
                lsum *= f; mref = mnew;
                if (hi == 0) wsf[r32] = f;
                LDS_WAIT(); asm volatile("" ::: "memory");
#pragma unroll
                for (int g = 0; g < 4; ++g) { const f32x4 fv = *(const LAS f32x4*)(wsf + 8 * g + 4 * hi);
#pragma unroll
                    for (int d = 0; d < 4; ++d) { o[d][4 * g + 0] *= fv[0]; o[d][4 * g + 1] *= fv[1]; o[d][4 * g + 2] *= fv[2]; o[d][4 * g + 3] *= fv[3]; } }
            }
            float ps = 0.f;
#pragma unroll
            for (int r = 0; r < 16; ++r) { p0[r] = __builtin_amdgcn_exp2f(p0[r] - mref); p1[r] = __builtin_amdgcn_exp2f(p1[r] - mref); ps += p0[r] + p1[r]; }
            lsum += ps;
            const bf16x8 pa0 = pack8(p0, 0), pa1 = pack8(p0, 8), pa2 = pack8(p1, 0), pa3 = pack8(p1, 8);
            const LAS unsigned char* vp = lds + AT_V + buf * 16384 + vb;
#pragma unroll
            for (int d = 0; d < 4; ++d) {
#define AT_VF(s) ({ const s16x4 lo_ = vtr(vp + (2 * (s)) * 2048 + d * 512), hi_ = vtr(vp + (2 * (s) + 1) * 2048 + d * 512); (bf16x8){lo_[0], lo_[1], lo_[2], lo_[3], hi_[0], hi_[1], hi_[2], hi_[3]}; })
                o[d] = __builtin_amdgcn_mfma_f32_32x32x16_bf16(pa0, AT_VF(0), o[d], 0, 0, 0);
                o[d] = __builtin_amdgcn_mfma_f32_32x32x16_bf16(pa1, AT_VF(1), o[d], 0, 0, 0);
                o[d] = __builtin_amdgcn_mfma_f32_32x32x16_bf16(pa2, AT_VF(2), o[d], 0, 0, 0);
                o[d] = __builtin_amdgcn_mfma_f32_32x32x16_bf16(pa3, AT_VF(3), o[d], 0, 0, 0);
#undef AT_VF
            }
        }
        if (it + 1 < nt) AT_STORE(buf ^ 1);
        __syncthreads();
    }
#undef AT_LOAD
#undef AT_STORE
    lsum += __shfl_xor(lsum, 32);
    { const float inv = lsum > 0.f ? 1.f / lsum : 0.f;
      if (hi == 0) wsf[r32] = inv;
      LDS_WAIT(); asm volatile("" ::: "memory");
#pragma unroll
      for (int g = 0; g < 4; ++g) { const f32x4 fv = *(const LAS f32x4*)(wsf + 8 * g + 4 * hi);
#pragma unroll
          for (int d = 0; d < 4; ++d) { o[d][4 * g + 0] *= fv[0]; o[d][4 * g + 1] *= fv[1]; o[d][4 * g + 2] *= fv[2]; o[d][4 * g + 3] *= fv[3]; } } }
    LAS float* xch = (LAS float*)(lds + AT_XCH) + rg * 4096;
    if (c == 1) {
#pragma unroll
        for (int d = 0; d < 4; ++d)
#pragma unroll
            for (int r = 0; r < 16; ++r) xch[(d * 16 + r) * 64 + lane] = o[d][r];
    }
    __syncthreads();
    if (c == 0) {
        float ss[16];
#pragma unroll
        for (int r = 0; r < 16; ++r) ss[r] = 0.f;
#pragma unroll
        for (int d = 0; d < 4; ++d)
#pragma unroll
            for (int r = 0; r < 16; ++r) { const float a = o[d][r] - lam * xch[(d * 16 + r) * 64 + lane]; o[d][r] = a; ss[r] += a * a; }
#pragma unroll
        for (int r = 0; r < 16; ++r) {
            float s = ss[r];
            s += __shfl_xor(s, 1); s += __shfl_xor(s, 2); s += __shfl_xor(s, 4); s += __shfl_xor(s, 8); s += __shfl_xor(s, 16);
            ss[r] = rsqrtf(s * (1.0f / 128.0f) + EPS) * (1.f - lam_init);
        }
        LAS bf16* stg = (LAS bf16*)(lds + AT_STG) + rg * 4096;
        const float* sw = C.SUBLN() + l * 128 + r32;
#pragma unroll
        for (int d = 0; d < 4; ++d) { const float w = sw[32 * d];
#pragma unroll
            for (int r = 0; r < 16; ++r) stg[crow(r, hi) * 128 + 32 * d + r32] = (bf16)f2bf(o[d][r] * ss[r] * w); }
        LDS_WAIT(); asm volatile("" ::: "memory");
        bf16* op = C.MIX() + (rowbase + qw0) * D + 512 + h * 128;
#pragma unroll
        for (int i = 0; i < 8; ++i) { const int ch = i * 64 + lane, row = ch >> 4, cc = ch & 15; *(v4u*)(op + (size_t)row * D + cc * 8) = *(const LAS v4u*)(stg + row * 128 + cc * 8); }
    }
    __syncthreads();
}
constexpr int HG_QM = 0, HG_KR = 16384, HG_KT = 32768, HG_V = 49152, HG_ST = 65536, HG_XT = 98304, HG_OS = 106496, HG_SQ = 122880, HG_VEC = 123904;
__device__ __forceinline__ v2u pack4(float a, float b, float c, float d) { v2u w; w.x = pg8::cvt_pk_bf16(a, b); w.y = pg8::cvt_pk_bf16(c, d); return w; }
__device__ __forceinline__ bf16x8 tr_frag(const LAS unsigned char* p) { const s16x4 lo = vtr(p), hi4 = vtr(p + 256); return (bf16x8){lo[0], lo[1], lo[2], lo[3], hi4[0], hi4[1], hi4[2], hi4[3]}; }
__device__ __forceinline__ void hgrn_unit(Ctx& C, int l, int b, int h) {
    LAS unsigned char* lds = C.lds;
    const int tid = C.tid, lane = C.lane, wave = C.wave, r32 = lane & 31, hi = lane >> 5;
    const size_t rowbase = (size_t)b * LT;
    const bf16* PJ = C.PROJ() + h * 128; const float* BL = C.LOGF() + h * 128;
    const int c4 = tid & 31, tg = tid >> 5;
    const int dkb = wave >> 1, dvb0 = 2 * (wave & 1);
    const int th = wave >> 2, dvb = wave & 3;
    const int vbq = ((lane & 15) >> 2) * 64 + ((lane >> 4) & 1) * 32 + (lane & 3) * 8;
    LAS float* vec = (LAS float*)(lds + HG_VEC);
    LAS float* sq = (LAS float*)(lds + HG_SQ);
    f32x16 st[2];
#pragma unroll
    for (int j = 0; j < 2; ++j)
#pragma unroll
        for (int r = 0; r < 16; ++r) st[j][r] = 0.f;
    v2u pq[4], pk[4], pv[4]; f32x4 pb[4], pbm;
#define HG_LOAD(ch) do { const size_t r0_ = rowbase + (size_t)(ch) * 64; \
        _Pragma("unroll") for (int i = 0; i < 4; ++i) { const size_t row_ = r0_ + 4 * tg + i; const bf16* p_ = PJ + row_ * WIN + 4 * c4; \
            pq[i] = *(const v2u*)p_; pk[i] = *(const v2u*)(p_ + 512); pv[i] = *(const v2u*)(p_ + 1024); pb[i] = *(const f32x4*)(BL + row_ * 512 + 4 * c4); } \
        pbm = *(const f32x4*)(BL + (r0_ + 31) * 512 + 4 * c4); } while (0)
    HG_LOAD(0);
    const float* nw = C.HGNW() + l * 128;
    for (int ch = 0; ch < LT / 64; ++ch) {
#pragma unroll
        for (int i = 0; i < 4; ++i) {
            const int t = 4 * tg + i;
            float qm[4], km[4];
            const float qv[4] = {bf_lo(pq[i].x), bf_hi(pq[i].x), bf_lo(pq[i].y), bf_hi(pq[i].y)};
            const float kv[4] = {bf_lo(pk[i].x), bf_hi(pk[i].x), bf_lo(pk[i].y), bf_hi(pk[i].y)};
#pragma unroll
            for (int j = 0; j < 4; ++j) { const float x = fminf(fmaxf(pb[i][j] - pbm[j], -80.f), 80.f); qm[j] = qv[j] * __expf(x); km[j] = kv[j] * __expf(-x); }
            const int rsw = (((c4 >> 1) ^ (t & 15)) * 16) + (c4 & 1) * 8;
            *(LAS v2u*)(lds + HG_QM + t * 256 + rsw) = pack4(qm[0], qm[1], qm[2], qm[3]);
            const v2u kmw = pack4(km[0], km[1], km[2], km[3]);
            *(LAS v2u*)(lds + HG_KR + t * 256 + rsw) = kmw;
            const int tso = ((t >> 3) * 4 + (c4 >> 3)) * 512 + (t & 7) * 64 + (c4 & 7) * 8;
            *(LAS v2u*)(lds + HG_KT + tso) = kmw;
            *(LAS v2u*)(lds + HG_V + tso) = pv[i];
            if (t == 31) *(LAS f32x4*)(vec + 4 * c4) = pb[i];
            if (t == 63) *(LAS f32x4*)(vec + 128 + 4 * c4) = pb[i];
        }
        __syncthreads();
        if (ch + 1 < LT / 64) HG_LOAD(ch + 1);
#pragma unroll
        for (int g = 0; g < 4; ++g) {
            const f32x4 bm = *(const LAS f32x4*)(vec + 32 * dkb + 8 * g + 4 * hi);
            const float e0 = __expf(bm[0]), e1 = __expf(bm[1]), e2 = __expf(bm[2]), e3 = __expf(bm[3]);
#pragma unroll
            for (int j = 0; j < 2; ++j) {
                st[j][4 * g + 0] *= e0; st[j][4 * g + 1] *= e1; st[j][4 * g + 2] *= e2; st[j][4 * g + 3] *= e3;
                const int dv = 32 * (dvb0 + j) + r32;
                *(LAS v2u*)(lds + HG_ST + dv * 256 + (((4 * dkb + g) ^ (dv & 15)) * 16) + hi * 8) = pack4(st[j][4 * g + 0], st[j][4 * g + 1], st[j][4 * g + 2], st[j][4 * g + 3]);
            }
        }
        if (wave < 3) {
            const int sb = (wave == 2) ? 1 : 0, tb = (wave == 0) ? 0 : 1;
            const int s = 32 * sb + r32, t = 32 * tb + r32;
            f32x16 x;
#pragma unroll
            for (int r = 0; r < 16; ++r) x[r] = 0.f;
#pragma unroll
            for (int ks = 0; ks < 8; ++ks) {
                const bf16x8 a = *(const LAS bf16x8*)(lds + HG_KR + s * 256 + (((2 * ks + hi) ^ (s & 15)) * 16));
                const bf16x8 bq = *(const LAS bf16x8*)(lds + HG_QM + t * 256 + (((2 * ks + hi) ^ (t & 15)) * 16));
                x = __builtin_amdgcn_mfma_f32_32x32x16_bf16(a, bq, x, 0, 0, 0);
            }
            if (sb == tb) {
#pragma unroll
                for (int r = 0; r < 16; ++r) x[r] = (crow(r, hi) > r32) ? 0.f : x[r];
            }
#pragma unroll
            for (int g = 0; g < 4; ++g)
                *(LAS v2u*)(lds + HG_XT + t * 128 + (((4 * sb + g) ^ ((t >> 1) & 7)) * 16) + hi * 8) = pack4(x[4 * g + 0], x[4 * g + 1], x[4 * g + 2], x[4 * g + 3]);
        }
#pragma unroll
        for (int ks = 0; ks < 4; ++ks) {
            const bf16x8 a = tr_frag(lds + HG_KT + ((2 * ks + hi) * 4 + dkb) * 512 + vbq);
#pragma unroll
            for (int j = 0; j < 2; ++j) {
                const bf16x8 bv = tr_frag(lds + HG_V + ((2 * ks + hi) * 4 + dvb0 + j) * 512 + vbq);
                st[j] = __builtin_amdgcn_mfma_f32_32x32x16_bf16(a, bv, st[j], 0, 0, 0);
            }
        }
#pragma unroll
        for (int g = 0; g < 4; ++g) {
            const f32x4 bm = *(const LAS f32x4*)(vec + 32 * dkb + 8 * g + 4 * hi), be = *(const LAS f32x4*)(vec + 128 + 32 * dkb + 8 * g + 4 * hi);
            const float e0 = __expf(be[0] - bm[0]), e1 = __expf(be[1] - bm[1]), e2 = __expf(be[2] - bm[2]), e3 = __expf(be[3] - bm[3]);
#pragma unroll
            for (int j = 0; j < 2; ++j) { st[j][4 * g + 0] *= e0; st[j][4 * g + 1] *= e1; st[j][4 * g + 2] *= e2; st[j][4 * g + 3] *= e3; }
        }
        __syncthreads();
        {
            const int dv = 32 * dvb + r32, t = 32 * th + r32;
            f32x16 o;
#pragma unroll
            for (int r = 0; r < 16; ++r) o[r] = 0.f;
#pragma unroll
            for (int ks = 0; ks < 8; ++ks) {
                const bf16x8 a = *(const LAS bf16x8*)(lds + HG_ST + dv * 256 + (((2 * ks + hi) ^ (dv & 15)) * 16));
                const bf16x8 bq = *(const LAS bf16x8*)(lds + HG_QM + t * 256 + (((2 * ks + hi) ^ (t & 15)) * 16));
                o = __builtin_amdgcn_mfma_f32_32x32x16_bf16(a, bq, o, 0, 0, 0);
            }
#pragma unroll
            for (int sb = 0; sb < 2; ++sb) {
                if (sb <= th) {
#pragma unroll
                    for (int k2 = 0; k2 < 2; ++k2) {
                        const int kg = 4 * sb + 2 * k2 + hi;
                        const bf16x8 a = tr_frag(lds + HG_V + (kg * 4 + dvb) * 512 + vbq);
                        const bf16x8 bx = *(const LAS bf16x8*)(lds + HG_XT + t * 128 + ((kg ^ ((t >> 1) & 7)) * 16));
                        o = __builtin_amdgcn_mfma_f32_32x32x16_bf16(a, bx, o, 0, 0, 0);
                    }
                }
            }
            float s2 = 0.f;
#pragma unroll
            for (int r = 0; r < 16; ++r) s2 += o[r] * o[r];
            s2 += __shfl_xor(s2, 32);
            if (hi == 0) sq[t * 4 + dvb] = s2;
#pragma unroll
            for (int g = 0; g < 4; ++g)
                *(LAS v2u*)(lds + HG_OS + t * 256 + (((4 * dvb + g) ^ (t & 15)) * 16) + hi * 8) = pack4(o[4 * g + 0], o[4 * g + 1], o[4 * g + 2], o[4 * g + 3]);
        }
        __syncthreads();
        {
            const int t = tid >> 3, seg = tid & 7;
            const size_t row = rowbase + (size_t)ch * 64 + t;
            const f32x4 sv = *(const LAS f32x4*)(sq + t * 4);
            const float rs = rsqrtf(((sv[0] + sv[1]) + (sv[2] + sv[3])) * (1.0f / 128.0f) + EPS);
            const v4u g0 = *(const v4u*)(PJ + row * WIN + 1536 + 16 * seg), g1 = *(const v4u*)(PJ + row * WIN + 1536 + 16 * seg + 8);
            const v4u o0 = *(const LAS v4u*)(lds + HG_OS + t * 256 + (((2 * seg) ^ (t & 15)) * 16)), o1 = *(const LAS v4u*)(lds + HG_OS + t * 256 + (((2 * seg + 1) ^ (t & 15)) * 16));
            const f32x4 w0 = *(const f32x4*)(nw + 16 * seg), w1 = *(const f32x4*)(nw + 16 * seg + 4), w2 = *(const f32x4*)(nw + 16 * seg + 8), w3 = *(const f32x4*)(nw + 16 * seg + 12);
            v4u r0, r1;
            r0.x = pk2(bf_lo(o0.x) * rs * w0[0] * bf_lo(g0.x), bf_hi(o0.x) * rs * w0[1] * bf_hi(g0.x)); r0.y = pk2(bf_lo(o0.y) * rs * w0[2] * bf_lo(g0.y), bf_hi(o0.y) * rs * w0[3] * bf_hi(g0.y));
            r0.z = pk2(bf_lo(o0.z) * rs * w1[0] * bf_lo(g0.z), bf_hi(o0.z) * rs * w1[1] * bf_hi(g0.z)); r0.w = pk2(bf_lo(o0.w) * rs * w1[2] * bf_lo(g0.w), bf_hi(o0.w) * rs * w1[3] * bf_hi(g0.w));
            r1.x = pk2(bf_lo(o1.x) * rs * w2[0] * bf_lo(g1.x), bf_hi(o1.x) * rs * w2[1] * bf_hi(g1.x)); r1.y = pk2(bf_lo(o1.y) * rs * w2[2] * bf_lo(g1.y), bf_hi(o1.y) * rs * w2[3] * bf_hi(g1.y));
            r1.z = pk2(bf_lo(o1.z) * rs * w3[0] * bf_lo(g1.z), bf_hi(o1.z) * rs * w3[1] * bf_hi(g1.z)); r1.w = pk2(bf_lo(o1.w) * rs * w3[2] * bf_lo(g1.w), bf_hi(o1.w) * rs * w3[3] * bf_hi(g1.w));
            bf16* op = C.MIX() + row * D + h * 128 + 16 * seg;
            *(v4u*)op = r0; *(v4u*)(op + 8) = r1;
        }
    }
#undef HG_LOAD
    __syncthreads();
}
__device__ __forceinline__ void mixer_phase(Ctx& C, int l) {
    for (int k = 0; k * C.G < 17 * 32; ++k) {
        const int u = k * C.G + ((k & 1) ? (C.G - 1 - C.bid) : C.bid);
        if (u < 17 * 32) { const int qi = 16 - u / 32, bh = u % 32; attn_unit(C, l, bh >> 2, bh & 3, qi); }
    }
    #ifdef HGRN_NAIVE
    for (int u = C.G - 1 - C.bid; u < 32; u += C.G) hgrn_naive_unit(C, l, u >> 2, u & 3);
#else
    for (int u = C.G - 1 - C.bid; u < 32; u += C.G) hgrn_unit(C, l, u >> 2, u & 3);
#endif
}

constexpr int RMAX = 128;
__device__ __forceinline__ void route_phase(Ctx& C, int li) {
    LAS float* rf = (LAS float*)C.lds;
    LAS int* lcnt = (LAS int*)(C.lds + 32768);
    LAS int* lbase = lcnt + 8;
    LAS int* ti = lbase + 8;
    LAS float* tf = (LAS float*)(ti + RMAX * 4);
    const int tid = C.tid, lane = C.lane;
    for (int i = tid; i < 8192; i += 512) rf[i] = C.RF()[li * 8192 + i];
    if (tid < 8) lcnt[tid] = 0;
    __syncthreads();
    const int nrows = (NTOK - C.bid + C.G - 1) / C.G;
    for (int k = C.wave; k < nrows; k += 8) {
        const size_t row = (size_t)C.bid + (size_t)k * C.G;
        f32x4 v[4]; float ss = 0.f;
#pragma unroll
        for (int j = 0; j < 4; ++j) { v[j] = *(const f32x4*)(C.H() + row * D + 4 * lane + 256 * j); ss += (v[j][0] * v[j][0] + v[j][1] * v[j][1]) + (v[j][2] * v[j][2] + v[j][3] * v[j][3]); }
        ss = wave_sum(ss);
        const float rstd = rsqrtf(ss * (1.0f / 1024.0f) + EPS);
        float lg[8];
#pragma unroll
        for (int e = 0; e < 8; ++e) {
            float p = 0.f;
#pragma unroll
            for (int j = 0; j < 4; ++j) { const f32x4 w = *(const LAS f32x4*)(rf + e * 1024 + 4 * lane + 256 * j); p += (v[j][0] * w[0] + v[j][1] * w[1]) + (v[j][2] * w[2] + v[j][3] * w[3]); }
            lg[e] = wave_sum(p) * rstd;
        }
        int e1 = 0; float l1 = lg[0];
#pragma unroll
        for (int e = 1; e < 8; ++e) if (lg[e] > l1) { l1 = lg[e]; e1 = e; }
        int e2 = -1; float l2 = -3.0e38f;
#pragma unroll
        for (int e = 0; e < 8; ++e) if (e != e1 && lg[e] > l2) { l2 = lg[e]; e2 = e; }
        const float g1 = 1.f / (1.f + expf(l2 - l1)), g2 = 1.f - g1;
        if (lane == 0) {
            const int lr1 = __hip_atomic_fetch_add(&lcnt[e1], 1, __ATOMIC_RELAXED, __HIP_MEMORY_SCOPE_WORKGROUP), lr2 = __hip_atomic_fetch_add(&lcnt[e2], 1, __ATOMIC_RELAXED, __HIP_MEMORY_SCOPE_WORKGROUP);
            ti[k * 4 + 0] = e1; ti[k * 4 + 1] = e2; ti[k * 4 + 2] = lr1; ti[k * 4 + 3] = lr2;
            tf[k * 4 + 0] = g1; tf[k * 4 + 1] = g2; tf[k * 4 + 2] = rstd;
        }
    }
    __syncthreads();
    if (tid < 8) lbase[tid] = (int)__hip_atomic_fetch_add(C.ctl() + CW_CNT + (li * 8 + tid) * 64, (unsigned)lcnt[tid], RLX_AGENT);
    __syncthreads();
    for (int k = tid; k < nrows; k += 512) {
        const int row = C.bid + k * C.G;
        const int e1 = ti[k * 4], e2 = ti[k * 4 + 1], r1 = lbase[e1] + ti[k * 4 + 2], r2 = lbase[e2] + ti[k * 4 + 3];
        C.LIST()[(size_t)e1 * NTOK + r1] = row; C.LIST()[(size_t)e2 * NTOK + r2] = row;
        unsigned* inf = C.TINFO() + (size_t)row * 8;
        inf[0] = (unsigned)e1; inf[1] = (unsigned)e2; inf[2] = (unsigned)r1; inf[3] = (unsigned)r2; inf[4] = __builtin_bit_cast(unsigned, tf[k * 4]); inf[5] = __builtin_bit_cast(unsigned, tf[k * 4 + 1]);
        C.RSTD()[row] = tf[k * 4 + 2];
    }
    __syncthreads();
}
__device__ __forceinline__ void load_panels(Ctx& C, int li, LAS int* pst) {
    __syncthreads();
    if (C.tid == 0) { int acc = 0;
        for (int e = 0; e < 8; ++e) { const int c = (int)__hip_atomic_load(C.ctl() + CW_CNT + (li * 8 + e) * 64, RLX_AGENT); pst[e] = acc; pst[16 + e] = c; acc += (c + 255) >> 8; }
        pst[8] = acc; }
    __syncthreads();
}
__device__ __forceinline__ void gather_phase(Ctx& C, int li) {
    LAS int* pst = (LAS int*)C.lds;
    load_panels(C, li, pst);
    const int gw = C.bid * 8 + C.wave, NGW = C.G * 8, lane = C.lane;
    const int nslot = pst[8] * 256;
    for (int s = gw; s < nslot; s += NGW) {
        const int panel = s >> 8; int e = 0;
#pragma unroll
        for (int j = 1; j < 8; ++j) if (panel >= pst[j]) e = j;
        const int rank = s - pst[e] * 256;
        bf16* xp = C.XG() + (size_t)s * D;
        if (rank < pst[16 + e]) {
            const int tok = C.LIST()[(size_t)e * NTOK + rank]; const float r = C.RSTD()[tok];
#pragma unroll
            for (int j = 0; j < 4; ++j) { const f32x4 v = *(const f32x4*)(C.H() + (size_t)tok * D + 4 * lane + 256 * j); v2u w; w.x = pk2(v[0] * r, v[1] * r); w.y = pk2(v[2] * r, v[3] * r); *(v2u*)(xp + 4 * lane + 256 * j) = w; }
        } else {
#pragma unroll
            for (int j = 0; j < 4; ++j) *(v2u*)(xp + 4 * lane + 256 * j) = (v2u){0u, 0u};
        }
    }
}
__device__ __forceinline__ void combine_phase(Ctx& C, int li, bool last) {
    LAS int* pst = (LAS int*)C.lds;
    load_panels(C, li, pst);
    const int gw = C.bid * 8 + C.wave, NGW = C.G * 8, lane = C.lane;
    for (int row = gw; row < NTOK; row += NGW) {
        const unsigned* inf = C.TINFO() + (size_t)row * 8;
        const int e1 = (int)inf[0], e2 = (int)inf[1];
        const size_t s1 = (size_t)pst[e1] * 256 + inf[2], s2 = (size_t)pst[e2] * 256 + inf[3];
        const float g1 = __builtin_bit_cast(float, inf[4]), g2 = __builtin_bit_cast(float, inf[5]);
        f32x4 v[4]; float ss = 0.f;
#pragma unroll
        for (int j = 0; j < 4; ++j) {
            const int col = 4 * lane + 256 * j;
            v[j] = *(const f32x4*)(C.H() + (size_t)row * D + col);
            const v2u a = *(const v2u*)(C.Y() + s1 * D + col), b = *(const v2u*)(C.Y() + s2 * D + col);
            v[j][0] += g1 * bf_lo(a.x) + g2 * bf_lo(b.x); v[j][1] += g1 * bf_hi(a.x) + g2 * bf_hi(b.x);
            v[j][2] += g1 * bf_lo(a.y) + g2 * bf_lo(b.y); v[j][3] += g1 * bf_hi(a.y) + g2 * bf_hi(b.y);
            ss += (v[j][0] * v[j][0] + v[j][1] * v[j][1]) + (v[j][2] * v[j][2] + v[j][3] * v[j][3]);
        }
        ss = wave_sum(ss);
        if (!last) {
#pragma unroll
            for (int j = 0; j < 4; ++j) { const int col = 4 * lane + 256 * j; *(f32x4*)(C.H() + (size_t)row * D + col) = v[j]; v2u w; w.x = pk2(v[j][0], v[j][1]); w.y = pk2(v[j][2], v[j][3]); *(v2u*)(C.HB() + (size_t)row * D + col) = w; }
            if (lane < 16) C.SSQ()[(size_t)row * 16 + lane] = (lane == 0) ? ss : 0.f;
        } else {
            const int b = row / LT, t = row % LT;
            if (t >= LEAD) {
                const float rs = rsqrtf(ss * (1.0f / 1024.0f) + EPS);
#pragma unroll
                for (int j = 0; j < 4; ++j) { const int col = 4 * lane + 256 * j; const f32x4 fw = *(const f32x4*)(C.FNORM() + col);
                    *(f32x4*)(C.out + ((size_t)b * SEQ + (t - LEAD)) * D + col) = (f32x4){v[j][0] * rs * fw[0], v[j][1] * rs * fw[1], v[j][2] * rs * fw[2], v[j][3] * rs * fw[3]}; }
            }
        }
    }
}

__global__ void __launch_bounds__(512, 2) mk_fwd(Args args) {
    extern __shared__ __attribute__((aligned(16))) unsigned char lds[];
    Ctx C;
    C.lds = (LAS unsigned char*)lds;
    C.tid = threadIdx.x; C.lane = C.tid & 63; C.wave = __builtin_amdgcn_readfirstlane(C.tid >> 6); C.G = gridDim.x; C.bid = blockIdx.x;
    unsigned char* ws = args.ws; C.ws = ws; C.out = args.out;
    volatile LAS unsigned* MISC = (volatile LAS unsigned*)(C.lds + MISC_OFF);
    for (int u = C.tid; u < (LDS_BYTES - RING_BYTES) / 4; u += 512) ((LAS unsigned*)(C.lds + RING_BYTES))[u] = 0u;
    __syncthreads();
    const int lo = args.ph_lo, hi = args.ph_hi;
    const bool multi = (hi - lo) > 1;
    XcdBarrier bar; bar.bar = (unsigned*)(C.ctl() + CW_BAR); bar.x = 0; bar.st = nullptr;
    if (multi) bar = xcd_barrier_post((unsigned*)(C.ctl() + CW_BAR), MISC + 8);
#define PHASE_CTX(P) Ctx P = C; { unsigned char* w_ = C.ws; asm volatile("" : "+s"(w_)); P.ws = w_; int t_ = C.tid; asm volatile("" : "+v"(t_)); P.tid = t_; P.lane = t_ & 63; P.wave = __builtin_amdgcn_readfirstlane(t_ >> 6); int g_ = C.G, b_ = C.bid; asm volatile("" : "+s"(g_), "+s"(b_)); P.G = g_; P.bid = b_; }
#define IN(k) (lo_l <= (k) && (k) < hi_l)
#define SEAM(k) do { if ((k) + 1 < hi_l) xcd_barrier(bar); } while (0)

    { int lo_l = lo, hi_l = hi; asm volatile("" : "+s"(lo_l), "+s"(hi_l));
      if (IN(0)) { for (int rep = 0; rep < REP_PRO; ++rep) { PHASE_CTX(P); prologue_phase(P, args); SEAM(0); } } }

    for (int l = 0; l < DEPTH; ++l) {
        int lo_l = lo, hi_l = hi; asm volatile("" : "+s"(lo_l), "+s"(hi_l));
        const int pb = 1 + 8 * l, li = l >> 1; const bool moe = (l & 1) != 0;
        if (IN(pb + 0)) for (int rep = 0; rep < REP_PROJ; ++rep) {
            PHASE_CTX(P);
            pg8::Gemm g{P.HB(), (const bf16*)(P.ws + WS_WIN) + (size_t)l * WIN * D, NTOK, WIN, D, 0};
            pg8::StaticOrder S; S.init(NTOK, WIN, P.G, P.bid);
            EpiProj E{P.PROJ(), P.LOGF(), P.SSQ(), P.LB() + l * 512};
            pg8::gemm_phase<EpiProj, pg8::StaticOrder, true, true>(P.lds, g, S, E);
            SEAM(pb + 0);
        }
        if (IN(pb + 1)) for (int rep = 0; rep < REP_MIX; ++rep) { PHASE_CTX(P); mixer_phase(P, l); SEAM(pb + 1); }
        if (IN(pb + 2)) {
            PHASE_CTX(P);
            pg8::Gemm g{P.MIX(), (const bf16*)(P.ws + WS_WOUT) + (size_t)l * D * D, NTOK, D, D, 0};
            pg8::StaticOrder S; S.init(NTOK, D, P.G, P.bid);
            EpiResid E{P.H(), P.HB(), P.SSQ()};
            pg8::gemm_phase<EpiResid, pg8::StaticOrder, true, true>(P.lds, g, S, E);
            SEAM(pb + 2);
        }
        if (!moe) {
            if (IN(pb + 5)) for (int rep = 0; rep < REP_FF1; ++rep) {
                PHASE_CTX(P);
                pg8::Gemm g{P.HB(), (const bf16*)(P.ws + WS_WD13) + (size_t)li * 2 * FFD * D, NTOK, 2 * FFD, D, 0};
                pg8::StaticOrder S; S.init(NTOK, 2 * FFD, P.G, P.bid);
                EpiGLU E{P.T(), FFD, P.SSQ()};
                pg8::gemm_phase<EpiGLU, pg8::StaticOrder, true, true>(P.lds, g, S, E);
                SEAM(pb + 5);
            }
            if (IN(pb + 6)) {
                PHASE_CTX(P);
                pg8::Gemm g{P.T(), (const bf16*)(P.ws + WS_WD2) + (size_t)li * D * FFD, NTOK, D, FFD, 0};
                pg8::StaticOrder S; S.init(NTOK, D, P.G, P.bid);
                EpiResid E{P.H(), P.HB(), P.SSQ()};
                pg8::gemm_phase<EpiResid, pg8::StaticOrder, true, true>(P.lds, g, S, E);
                SEAM(pb + 6);
            }
        } else {
            if (IN(pb + 3)) { PHASE_CTX(P); route_phase(P, li); SEAM(pb + 3); }
            if (IN(pb + 4)) for (int rep = 0; rep < REP_GATHER; ++rep) { PHASE_CTX(P); gather_phase(P, li); SEAM(pb + 4); }
            if (IN(pb + 5)) for (int rep = 0; rep < REP_FF1; ++rep) {
                PHASE_CTX(P);
                LAS int* pst = (LAS int*)(P.lds + RING_BYTES + 1024);
                load_panels(P, li, pst);
#define PS(i) __builtin_amdgcn_readfirstlane(pst[i])
                pg8::GroupedOrder S{PS(0), PS(1), PS(2), PS(3), PS(4), PS(5), PS(6), PS(7), PS(8), 2 * FFE / 256, P.G, P.bid};
                pg8::Gemm g{P.XG(), (const bf16*)(P.ws + WS_WM13) + (size_t)li * 8 * 2 * FFE * D, 0, 2 * FFE, D, (size_t)2 * FFE * D * 2};
                EpiGLU E{P.T(), FFE, nullptr};
                pg8::gemm_phase<EpiGLU, pg8::GroupedOrder, true, true>(P.lds, g, S, E);
                SEAM(pb + 5);
            }
            if (IN(pb + 6)) {
                PHASE_CTX(P);
                LAS int* pst = (LAS int*)(P.lds + RING_BYTES + 1024);
                load_panels(P, li, pst);
                pg8::GroupedOrder S{PS(0), PS(1), PS(2), PS(3), PS(4), PS(5), PS(6), PS(7), PS(8), D / 256, P.G, P.bid};
                pg8::Gemm g{P.T(), (const bf16*)(P.ws + WS_WM2) + (size_t)li * 8 * D * FFE, 0, D, FFE, (size_t)D * FFE * 2};
                EpiY E{P.Y()};
                pg8::gemm_phase<EpiY, pg8::GroupedOrder, true, true>(P.lds, g, S, E);
                SEAM(pb + 6);
            }
#undef PS
            if (IN(pb + 7)) { PHASE_CTX(P); combine_phase(P, li, l == DEPTH - 1); SEAM(pb + 7); }
        }
    }
#undef IN
#undef SEAM
#undef PHASE_CTX
}

extern "C" void kernel_launch(void* const* d_in, const int* in_sizes, int n_in, void* d_out, int out_size, void* d_ws, size_t ws_size, hipStream_t stream) {
    static int grid = 0;
    if (grid == 0) {
        if (n_in != 19 || out_size != NB * SEQ * D || ws_size < WS_END) { fprintf(stderr, "kernel_launch: unexpected shapes (n_in %d, out %d, ws %zu < %zu); nothing launched\n", n_in, out_size, ws_size, (size_t)WS_END); grid = -1; return; }
        int dev = 0, cus = 0, per_cu = 0;
        if (hipGetDevice(&dev) != hipSuccess || hipDeviceGetAttribute(&cus, hipDeviceAttributeMultiprocessorCount, dev) != hipSuccess) { grid = -1; return; }
        if (hipFuncSetAttribute((const void*)mk_fwd, hipFuncAttributeMaxDynamicSharedMemorySize, LDS_BYTES) != hipSuccess) { fprintf(stderr, "kernel_launch: hipFuncSetAttribute failed\n"); grid = -1; return; }
        if (hipOccupancyMaxActiveBlocksPerMultiprocessor(&per_cu, (const void*)mk_fwd, 512, LDS_BYTES) != hipSuccess || per_cu < 1) { fprintf(stderr, "kernel_launch: occupancy query says %d blocks per CU\n", per_cu); }
        (void)hipGetLastError();
        grid = cus;
    }
    if (grid < 0) return;
    if (hipMemsetAsync((char*)d_ws + WS_CTL, 0, CTL_ZERO_BYTES, stream) != hipSuccess) return;
    Args a{};
    for (int i = 0; i < 19; ++i) a.in[i] = (const float*)d_in[i];
    a.out = (float*)d_out; a.ws = (unsigned char*)d_ws;
#if MK_ONE_LAUNCH
    a.ph_lo = 0; a.ph_hi = NPHASE;
    hipLaunchKernelGGL(mk_fwd, dim3(grid), dim3(512), LDS_BYTES, stream, a);
#else
    for (int p = 0; p < NPHASE; ++p) {
        if (p > 0) { const int l = (p - 1) / 8, k = (p - 1) % 8; const bool moe = (l & 1) != 0; if (!moe && (k == 3 || k == 4 || k == 7)) continue; }
        a.ph_lo = p; a.ph_hi = p + 1;
        hipLaunchKernelGGL(mk_fwd, dim3(grid), dim3(512), LDS_BYTES, stream, a);
    }
#endif
}
```

```cpp
#include <hip/hip_runtime.h>
#include <cstdio>
#include <cstdint>

#ifndef REP_ATT
#define REP_ATT 1
#endif
#ifndef REP_HG
#define REP_HG 1
#endif
#ifndef REP_PRO
#define REP_PRO 1
#endif
#ifndef REP_PROJ
#define REP_PROJ 1
#endif
#ifndef REP_MIX
#define REP_MIX 1
#endif
#ifndef REP_FF1
#define REP_FF1 1
#endif
#ifndef REP_GATHER
#define REP_GATHER 1
#endif
#ifndef MK_ONE_LAUNCH
#define MK_ONE_LAUNCH 1
#endif

namespace pg8 {
#define PG8_LAS __attribute__((address_space(3)))
typedef unsigned short bf16_t;
typedef short bf16x8 __attribute__((ext_vector_type(8)));
typedef float f32x4 __attribute__((ext_vector_type(4)));
typedef unsigned u32x4 __attribute__((ext_vector_type(4)));
typedef unsigned u32x2 __attribute__((ext_vector_type(2)));
constexpr int BM = 256, BK = 64, HALF = 128, HTB = HALF * BK * 2  , STAGE_BYTES = 8 * HTB, NXCD = 8, WGM = 8;

__host__ __device__ __forceinline__ int lds_byte(int r, int c) { const int st = (r >> 4) * 2 + (c >> 5), rr = r & 15, cc = c & 31, ob = rr * 64 + cc * 2; return st * 1024 + (ob ^ (((ob >> 9) & 1) << 5)); }
__host__ __device__ __forceinline__ void stage_rc(int b, int& R, int& C) { const int st = b / 1024, sb = b % 1024, swz = sb ^ (((sb >> 9) & 1) << 5); R = (st >> 1) * 16 + swz / 64; C = (st & 1) * 32 + (swz % 64) / 2; }
__host__ __device__ __forceinline__ int perm32(int rho) { const int n = rho >> 4, i = rho & 15; return 8 * (i >> 2) + 4 * n + (i & 3); }

struct Unit { int pm, pn, e; };
struct Gemm { const bf16_t* A; const bf16_t* Bt; int M, N, K; size_t bstride; };

struct StaticOrder {
    int nM, nN, nwg, G, c;
    __host__ __device__ void init(int M, int N, int G_, int c_) { nM = M / BM; nN = N / BM; nwg = nM * nN; G = G_; c = c_; }
    __host__ __device__ bool next(int i, Unit& u) const {
        const long L = (long)i * G + c; if (L >= nwg) return false;
        int wgid = (int)L; { const int q = nwg / NXCD, r = nwg % NXCD, xcd = wgid % NXCD, off = wgid / NXCD; wgid = (xcd < r ? xcd * (q + 1) : r * (q + 1) + (xcd - r) * q) + off; }
        const int nig = WGM * nN, gid = wgid / nig, fm = gid * WGM, gsz = (nM - fm) < WGM ? (nM - fm) : WGM;
        u.pm = fm + ((wgid % nig) % gsz); u.pn = (wgid % nig) / gsz; u.e = 0; return true;
    }
    __device__ __forceinline__ void a_ready(const Unit&) const {}
    __device__ __forceinline__ void done(const Unit&) const {}
};
struct GroupedOrder {
    int p0, p1, p2, p3, p4, p5, p6, p7, p8, nN, G, c;
    __device__ __forceinline__ bool next(int i, Unit& u) const {
        const int L = i * G + c; if (L >= p8 * nN) return false;
        int e = 0, ps = 0, pe = p1;
        if (L >= p1 * nN) { e = 1; ps = p1; pe = p2; }
        if (L >= p2 * nN) { e = 2; ps = p2; pe = p3; }
        if (L >= p3 * nN) { e = 3; ps = p3; pe = p4; }
        if (L >= p4 * nN) { e = 4; ps = p4; pe = p5; }
        if (L >= p5 * nN) { e = 5; ps = p5; pe = p6; }
        if (L >= p6 * nN) { e = 6; ps = p6; pe = p7; }
        if (L >= p7 * nN) { e = 7; ps = p7; pe = p8; }
        const int rem = L - ps * nN, R = pe - ps;
        u.e = e; u.pn = rem / R; u.pm = ps + rem % R; return true;
    }
    __device__ __forceinline__ void a_ready(const Unit&) const {}
    __device__ __forceinline__ void done(const Unit&) const {}
};

__device__ __forceinline__ unsigned cvt_pk_bf16(float lo, float hi) { unsigned r; asm volatile("v_cvt_pk_bf16_f32 %0, %1, %2" : "=v"(r) : "v"(lo), "v"(hi)); return r; }

template <class Epi, class Sched, bool ALIGN_EPI = false, bool SP2 = false>
__device__ __forceinline__ void gemm_phase(PG8_LAS unsigned char* lds, const Gemm g, const Sched& S, const Epi& E) {
    int tid_l = threadIdx.x; asm volatile("" : "+v"(tid_l));
    const int tid = tid_l, wid = __builtin_amdgcn_readfirstlane(tid >> 6), lane = tid & 63, wr = wid >> 2, wc = wid & 3, fr = lane & 15, fq = lane >> 4;
    const int K = g.K, nt = K / BK;
    unsigned voffA[2], voffB[2];
#pragma unroll
    for (int i = 0; i < 2; ++i) { int R, C; stage_rc(tid * 16 + i * 8192, R, C); const int Rb = Epi::PERM ? ((R & ~31) + perm32(R & 31)) : R;
        voffA[i] = (unsigned)(R * K + C) * 2u; voffB[i] = (unsigned)(Rb * K + C) * 2u; }
    const size_t kstep = (size_t)(BK * 2);
    const size_t hstep = (size_t)HALF * K * 2;
    const size_t tstep = 2 * hstep;
    const unsigned ldsw = (unsigned)wid * 1024u;
    const int aoff = lds_byte(wr * 64 + fr, fq * 8), boff = lds_byte(wc * 32 + fr, fq * 8);
#define PG8_SA(b, h) (((b) * 2 + (h)) * HTB)
#define PG8_SB(b, h) ((4 + (b) * 2 + (h)) * HTB)
#define PG8_STAGE(bufoff, gbase, voff) do { _Pragma("unroll") for (int _i = 0; _i < 2; ++_i) \
        __builtin_amdgcn_global_load_lds((const unsigned*)((const char*)(gbase) + (voff)[_i]), (PG8_LAS unsigned*)(lds + (bufoff) + ldsw + _i * 8192), 16, 0, 0); } while (0)
#define PG8_LDA(dst, b, h) do { _Pragma("unroll") for (int m = 0; m < 4; ++m) _Pragma("unroll") for (int k = 0; k < 2; ++k) dst[m][k] = *(const PG8_LAS bf16x8*)(lds + PG8_SA(b, h) + aoff + m * 2048 + k * 1024); } while (0)
#define PG8_LDB(dst, b, h) do { _Pragma("unroll") for (int n = 0; n < 2; ++n) _Pragma("unroll") for (int k = 0; k < 2; ++k) dst[n][k] = *(const PG8_LAS bf16x8*)(lds + PG8_SB(b, h) + boff + n * 2048 + k * 1024); } while (0)
#define PG8_MMA(ai, bj, At, Bt) do { __builtin_amdgcn_s_setprio(1); _Pragma("unroll") for (int m = 0; m < 4; ++m) _Pragma("unroll") for (int n = 0; n < 2; ++n) _Pragma("unroll") for (int k = 0; k < 2; ++k) \
        acc[ai][bj][m][n] = __builtin_amdgcn_mfma_f32_16x16x32_bf16(Bt[n][k], At[m][k], acc[ai][bj][m][n], 0, 0, 0); __builtin_amdgcn_s_setprio(0); } while (0)
#define PG8_WAIT_V(n) asm volatile("s_waitcnt vmcnt(" #n ")" ::: "memory")
#define PG8_WAIT_L(n) asm volatile("s_waitcnt lgkmcnt(" #n ")" ::: "memory")
#define PG8_BAR __builtin_amdgcn_s_barrier()
#define PG8_SCHED __builtin_amdgcn_sched_barrier(0)
    Unit cur, nxt; int ui = 0;
    if (!S.next(0, cur)) return;
    f32x4 acc[2][2][4][2];
#pragma unroll
    for (int a = 0; a < 2; ++a)
#pragma unroll
        for (int b = 0; b < 2; ++b)
#pragma unroll
            for (int m = 0; m < 4; ++m)
#pragma unroll
                for (int n = 0; n < 2; ++n) acc[a][b][m][n] = (f32x4){0.f, 0.f, 0.f, 0.f};
    bf16x8 At[4][2], B0[2][2], B1[2][2];
    const char* cA = (const char*)g.A + (size_t)cur.pm * tstep; const char* cB = (const char*)g.Bt + (size_t)cur.e * g.bstride + (size_t)cur.pn * tstep;
    S.a_ready(cur);
    if constexpr (SP2) {
        PG8_STAGE(PG8_SB(0, 0), cB, voffB); PG8_STAGE(PG8_SB(0, 1), cB + hstep, voffB); PG8_STAGE(PG8_SA(0, 0), cA, voffA); PG8_STAGE(PG8_SA(0, 1), cA + hstep, voffA);
        if (wr == 1) PG8_BAR;
        PG8_WAIT_V(2); PG8_BAR;
        PG8_STAGE(PG8_SB(1, 0), cB + kstep, voffB); PG8_STAGE(PG8_SA(1, 0), cA + kstep, voffA); PG8_STAGE(PG8_SB(1, 1), cB + hstep + kstep, voffB);
        PG8_WAIT_V(6); PG8_BAR;
    } else {
        PG8_STAGE(PG8_SB(0, 0), cB, voffB); PG8_STAGE(PG8_SA(0, 0), cA, voffA); PG8_STAGE(PG8_SB(0, 1), cB + hstep, voffB); PG8_STAGE(PG8_SA(0, 1), cA + hstep, voffA);
        if (wr == 1) PG8_BAR;
        PG8_WAIT_V(4); PG8_BAR;
        PG8_STAGE(PG8_SB(1, 0), cB + kstep, voffB); PG8_STAGE(PG8_SA(1, 0), cA + kstep, voffA); PG8_STAGE(PG8_SB(1, 1), cB + hstep + kstep, voffB);
        PG8_WAIT_V(6); PG8_BAR;
    }
    for (;;) {
        const bool has_next = S.next(ui + 1, nxt);
        const char* nA = has_next ? (const char*)g.A + (size_t)nxt.pm * tstep : cA; const char* nB = has_next ? (const char*)g.Bt + (size_t)nxt.e * g.bstride + (size_t)nxt.pn * tstep : cB;
        for (int t = 0; t < nt; t += 2) {
            const bool last = (t == nt - 2);
            const char* a1 = cA + (size_t)(t + 1) * kstep;
            const char* a2 = last ? nA : cA + (size_t)(t + 2) * kstep; const char* b2 = last ? nB : cB + (size_t)(t + 2) * kstep;
            const char* a3 = a2 + kstep; const char* b3 = b2 + kstep;
            if (last && has_next) S.a_ready(nxt);
            if constexpr (SP2) {
            PG8_LDB(B0, 0, 0); PG8_LDB(B1, 0, 1); PG8_SCHED; PG8_LDA(At, 0, 0); PG8_STAGE(PG8_SA(1, 1), a1 + hstep, voffA);
            PG8_WAIT_V(8); PG8_WAIT_L(0); PG8_BAR; PG8_MMA(0, 0, At, B0); PG8_MMA(0, 1, At, B1); PG8_BAR; PG8_SCHED;
            PG8_LDA(At, 0, 1); PG8_STAGE(PG8_SB(0, 0), b2, voffB); PG8_STAGE(PG8_SB(0, 1), b2 + hstep, voffB); PG8_STAGE(PG8_SA(0, 0), a2, voffA);
            PG8_WAIT_V(8); PG8_WAIT_L(0); PG8_BAR; PG8_MMA(1, 0, At, B0); PG8_MMA(1, 1, At, B1); PG8_BAR; PG8_SCHED;
            PG8_LDB(B0, 1, 0); PG8_LDB(B1, 1, 1); PG8_SCHED; PG8_LDA(At, 1, 0); PG8_STAGE(PG8_SA(0, 1), a2 + hstep, voffA);
            PG8_WAIT_V(8); PG8_WAIT_L(0); PG8_BAR; PG8_MMA(0, 0, At, B0); PG8_MMA(0, 1, At, B1); PG8_BAR; PG8_SCHED;
            PG8_LDA(At, 1, 1); PG8_STAGE(PG8_SB(1, 0), b3, voffB); PG8_STAGE(PG8_SB(1, 1), b3 + hstep, voffB); PG8_STAGE(PG8_SA(1, 0), a3, voffA);
            PG8_WAIT_V(8); PG8_WAIT_L(0); PG8_BAR; PG8_MMA(1, 0, At, B0); PG8_MMA(1, 1, At, B1); PG8_BAR; PG8_SCHED;
            } else {
            PG8_LDB(B0, 0, 0); PG8_SCHED; PG8_LDA(At, 0, 0); PG8_STAGE(PG8_SA(1, 1), a1 + hstep, voffA);
            PG8_WAIT_L(8); PG8_BAR; PG8_WAIT_L(0); PG8_MMA(0, 0, At, B0); PG8_BAR; PG8_SCHED;
            PG8_LDB(B1, 0, 1); PG8_STAGE(PG8_SB(0, 0), b2, voffB);
            PG8_BAR; PG8_WAIT_L(0); PG8_MMA(0, 1, At, B1); PG8_BAR;
            PG8_LDA(At, 0, 1); PG8_STAGE(PG8_SA(0, 0), a2, voffA);
            PG8_BAR; PG8_WAIT_L(0); PG8_MMA(1, 0, At, B0); PG8_BAR; PG8_SCHED;
            PG8_STAGE(PG8_SB(0, 1), b2 + hstep, voffB);
            PG8_WAIT_V(6); PG8_BAR; PG8_MMA(1, 1, At, B1); PG8_BAR;
            PG8_LDB(B0, 1, 0); PG8_SCHED; PG8_LDA(At, 1, 0); PG8_STAGE(PG8_SA(0, 1), a2 + hstep, voffA);
            PG8_WAIT_L(8); PG8_BAR; PG8_WAIT_L(0); PG8_MMA(0, 0, At, B0); PG8_BAR; PG8_SCHED;
            PG8_LDB(B1, 1, 1); PG8_STAGE(PG8_SB(1, 0), b3, voffB);
            PG8_BAR; PG8_WAIT_L(0); PG8_MMA(0, 1, At, B1); PG8_BAR;
            PG8_LDA(At, 1, 1); PG8_STAGE(PG8_SA(1, 0), a3, voffA);
            PG8_BAR; PG8_WAIT_L(0); PG8_MMA(1, 0, At, B0); PG8_BAR; PG8_SCHED;
            PG8_STAGE(PG8_SB(1, 1), b3 + hstep, voffB);
            PG8_WAIT_V(6); PG8_BAR; PG8_MMA(1, 1, At, B1); PG8_BAR;
            }
        }
        if constexpr (ALIGN_EPI) { if (wr == 0) PG8_BAR; }
        if constexpr (!Epi::AFTER_DRAIN) { E(acc, cur, wr, wc, fr, fq); S.done(cur); }
        if (!has_next) break;
#pragma unroll
        for (int a = 0; a < 2; ++a)
#pragma unroll
            for (int b = 0; b < 2; ++b)
#pragma unroll
                for (int m = 0; m < 4; ++m)
#pragma unroll
                    for (int n = 0; n < 2; ++n) acc[a][b][m][n] = (f32x4){0.f, 0.f, 0.f, 0.f};
        cur = nxt; cA = nA; cB = nB; ++ui;
        if constexpr (ALIGN_EPI) { if (wr == 1) PG8_BAR; }
    }
    PG8_WAIT_V(0);
    if constexpr (!ALIGN_EPI) { if (wr == 0) PG8_BAR; }
    PG8_BAR;
    if constexpr (Epi::AFTER_DRAIN) { E.fused(acc, cur, wr, wc, fr, fq, lds, wid, lane); S.done(cur); }
#undef PG8_SA
#undef PG8_SB
#undef PG8_STAGE
#undef PG8_LDA
#undef PG8_LDB
#undef PG8_MMA
#undef PG8_WAIT_V
#undef PG8_WAIT_L
#undef PG8_BAR
#undef PG8_SCHED
}

}

constexpr int D = 1024, NB = 8, SEQ = 2048, DEPTH = 4, LEAD = 128, FIRSTV = 112, LT = LEAD + SEQ, NTOK = NB * LT;
constexpr int WIN = 3584, FFD = 2816, FFE = 3584, NE = 8, MAXSLOT = 36864;
constexpr float EPS = 1e-6f;
constexpr int NPHASE = 1 + 8 * DEPTH;

constexpr size_t MiB = 1u << 20;
constexpr size_t WS_CTL = 0, CTL_ZERO_BYTES = MiB;
constexpr size_t WS_TAB = 1 * MiB;
constexpr size_t WS_WIN = 2 * MiB;
constexpr size_t WS_WOUT = WS_WIN + 28 * MiB;
constexpr size_t WS_WD13 = WS_WOUT + 8 * MiB;
constexpr size_t WS_WD2 = WS_WD13 + 22 * MiB;
constexpr size_t WS_WM13 = WS_WD2 + 11 * MiB;
constexpr size_t WS_WM2 = WS_WM13 + 224 * MiB;
constexpr size_t WS_H = WS_WM2 + 112 * MiB;
constexpr size_t WS_HB = WS_H + 68 * MiB;
constexpr size_t WS_SSQ = WS_HB + 34 * MiB;
constexpr size_t WS_ROUTE = WS_SSQ + 2 * MiB;
constexpr size_t WS_ACT = WS_ROUTE + 2 * MiB;
constexpr size_t WS_XG = WS_ACT + 252 * MiB;
constexpr size_t WS_END = WS_XG + 72 * MiB;
constexpr size_t ACT_PROJ = 0, ACT_LOGF = 119 * MiB, ACT_MIX = 153 * MiB;
constexpr size_t TAB_LB = 0, TAB_BIAS = 8192, TAB_LAM = 12288, TAB_SUBLN = 12544, TAB_HGNW = 14592, TAB_RF = 20480, TAB_FNORM = 20480 + 65536;
constexpr size_t ROUTE_INFO = 0, ROUTE_LIST = 640 * 1024, ROUTE_RSTD = 1280 * 1024;
constexpr int CW_TMO = 0, CW_BAR = 4096, CW_CNT = 8192;

constexpr int RING_BYTES = 131072, MISC_OFF = RING_BYTES + 320, LDS_BYTES = 147456;

#define GAS __attribute__((address_space(1)))
#define LAS __attribute__((address_space(3)))
typedef unsigned short bf16;
typedef unsigned v4u __attribute__((ext_vector_type(4)));
typedef unsigned v2u __attribute__((ext_vector_type(2)));
typedef float f32x4 __attribute__((ext_vector_type(4)));
typedef GAS unsigned gu32;
#define RLX_AGENT __ATOMIC_RELAXED, __HIP_MEMORY_SCOPE_AGENT
#define LDS_WAIT() asm volatile("s_waitcnt lgkmcnt(0)" ::: "memory")
__device__ __forceinline__ unsigned f2bf(float f) { unsigned u = __builtin_bit_cast(unsigned, f); return (u + 0x7fffu + ((u >> 16) & 1u)) >> 16; }
__device__ __forceinline__ unsigned pk2(float lo, float hi) { return f2bf(lo) | (f2bf(hi) << 16); }
__device__ __forceinline__ float bf_lo(unsigned w) { return __builtin_bit_cast(float, w << 16); }
__device__ __forceinline__ float bf_hi(unsigned w) { return __builtin_bit_cast(float, w & 0xffff0000u); }
__device__ __forceinline__ float silu_f(float x) { return x * __builtin_amdgcn_rcpf(1.f + __expf(-x)); }
__device__ __forceinline__ float wave_sum(float v) {
#pragma unroll
    for (int o = 1; o < 64; o <<= 1) v += __shfl_xor(v, o);
    return v;
}

#define XB_TMO      128
#define XB_XCNT(j)  (256  + 64 * (j))
#define XB_XSUB(j)  (1280 + 64 * (j))
#define XB_XGEN(j)  (2304 + 64 * (j))
#define XB_TOP      3328
#define XB_TOPGEN   3392
#define XCD_BAR_WORDS 3456
#define XB_SPIN_CAP (1u << 18)

__device__ __forceinline__ unsigned xb_ld(unsigned* p)              { return __hip_atomic_load(p, __ATOMIC_RELAXED, __HIP_MEMORY_SCOPE_AGENT); }
__device__ __forceinline__ unsigned xb_add(unsigned* p, unsigned v) { return __hip_atomic_fetch_add(p, v, __ATOMIC_RELAXED, __HIP_MEMORY_SCOPE_AGENT); }
__device__ __forceinline__ unsigned xb_xcc_id() { return (unsigned)__builtin_amdgcn_s_getreg((3 << 11) | 20) & 0xFu; }
#define XB_SPIN(cond, bar) do { unsigned _sp = 0; while (cond) { __builtin_amdgcn_s_sleep(1); \
    if ((++_sp & 255u) == 0u) { if (xb_ld(&(bar)[XB_TMO])) break; if (_sp > XB_SPIN_CAP) { atomicAdd(&(bar)[XB_TMO], 1u); break; } } } } while (0)

struct XcdBarrier {
    unsigned* bar; unsigned x;
    volatile LAS unsigned* st;
};

__device__ __forceinline__ XcdBarrier xcd_barrier_post(unsigned* bar, volatile LAS unsigned* st) {
    XcdBarrier b; b.bar = bar; b.x = xb_xcc_id(); b.st = st;
    if (threadIdx.x == 0) (void)xb_add(&bar[XB_XCNT(b.x)], 1u);
    return b;
}
__device__ __forceinline__ void xcd_barrier_complete(unsigned* bar, unsigned x, unsigned& nloc, unsigned& nx) {
    const unsigned G = gridDim.x * gridDim.y * gridDim.z;
    unsigned sum, cnt, mine, sp = 0u;
    for (;;) {
        sum = 0u; cnt = 0u; mine = 0u;
#pragma unroll
        for (unsigned j = 0; j < 16; ++j) { const unsigned c = xb_ld(&bar[XB_XCNT(j)]); sum += c; cnt += (c > 0u) ? 1u : 0u; mine = (j == x) ? c : mine; }
        if (sum == G) break;
        __builtin_amdgcn_s_sleep(1);
        if ((++sp & 255u) == 0u) { if (xb_ld(&bar[XB_TMO])) break; if (sp > XB_SPIN_CAP) { atomicAdd(&bar[XB_TMO], 1u); break; } }
    }
    nloc = mine > 0u ? mine : 1u; nx = cnt > 0u ? cnt : 1u;
}

__device__ __forceinline__ void xcd_barrier(const XcdBarrier& b) {
    asm volatile("s_waitcnt vmcnt(0)" ::: "memory");
    __syncthreads();
    if (threadIdx.x == 0) {
        unsigned* bar = b.bar;
        __builtin_amdgcn_s_waitcnt(0);
        unsigned nloc = b.st[0], nx = b.st[1];
        if (nloc == 0u) { xcd_barrier_complete(bar, b.x, nloc, nx); b.st[0] = nloc; b.st[1] = nx; }
        const unsigned old = xb_add(&bar[XB_XSUB(b.x)], 1u);
        const unsigned gen = old / nloc;
        if (old + 1u == (gen + 1u) * nloc) {
            __builtin_amdgcn_fence(__ATOMIC_RELEASE, "agent");
            asm volatile("s_waitcnt vmcnt(0)" ::: "memory");
            const unsigned og = xb_add(&bar[XB_TOP], 1u);
            const unsigned tg = og / nx;
            if (og + 1u == (tg + 1u) * nx) xb_add(&bar[XB_TOPGEN], 1u);
            else XB_SPIN(xb_ld(&bar[XB_TOPGEN]) == tg, bar);
            __builtin_amdgcn_fence(__ATOMIC_ACQUIRE, "agent");
            xb_add(&bar[XB_XGEN(b.x)], 1u);
            asm volatile("s_waitcnt vmcnt(0)" ::: "memory");
        } else {
            XB_SPIN(xb_ld(&bar[XB_XGEN(b.x)]) == gen, bar);
            __builtin_amdgcn_fence(__ATOMIC_ACQUIRE, "agent");
            asm volatile("s_waitcnt vmcnt(0)" ::: "memory");
        }
    }
    __syncthreads();
}


static __device__ const unsigned char T5B[129] = {0, 1, 2, 3, 4, 5, 6, 7, 8, 9, 10, 11, 12, 13, 14, 15, 16, 16, 16, 17, 17, 18, 18, 18, 19, 19, 19, 20, 20, 20, 20, 21, 21, 21, 21, 22, 22, 22, 22, 22, 23, 23, 23, 23, 23, 23, 24, 24, 24, 24, 24, 24, 25, 25, 25, 25, 25, 25, 25, 26, 26, 26, 26, 26, 26, 26, 26, 27, 27, 27, 27, 27, 27, 27, 27, 27, 27, 28, 28, 28, 28, 28, 28, 28, 28, 28, 28, 29, 29, 29, 29, 29, 29, 29, 29, 29, 29, 29, 29, 30, 30, 30, 30, 30, 30, 30, 30, 30, 30, 30, 30, 30, 30, 31, 31, 31, 31, 31, 31, 31, 31, 31, 31, 31, 31, 31, 31, 31, 31};

struct Ctx {
    LAS unsigned char* lds;
    int tid, lane, wave, G, bid;
    float* out;
    unsigned char* ws;
    __device__ __forceinline__ gu32* ctl() const { return (gu32*)(ws + WS_CTL); }
    __device__ __forceinline__ float* H() const { return (float*)(ws + WS_H); }
    __device__ __forceinline__ bf16* HB() const { return (bf16*)(ws + WS_HB); }
    __device__ __forceinline__ float* SSQ() const { return (float*)(ws + WS_SSQ); }
    __device__ __forceinline__ bf16* PROJ() const { return (bf16*)(ws + WS_ACT + ACT_PROJ); }
    __device__ __forceinline__ float* LOGF() const { return (float*)(ws + WS_ACT + ACT_LOGF); }
    __device__ __forceinline__ bf16* MIX() const { return (bf16*)(ws + WS_ACT + ACT_MIX); }
    __device__ __forceinline__ bf16* T() const { return (bf16*)(ws + WS_ACT); }
    __device__ __forceinline__ bf16* XG() const { return (bf16*)(ws + WS_XG); }
    __device__ __forceinline__ bf16* Y() const { return (bf16*)(ws + WS_XG); }
    __device__ __forceinline__ float* LB() const { return (float*)(ws + WS_TAB + TAB_LB); }
    __device__ __forceinline__ float* BIAST() const { return (float*)(ws + WS_TAB + TAB_BIAS); }
    __device__ __forceinline__ float* LAM() const { return (float*)(ws + WS_TAB + TAB_LAM); }
    __device__ __forceinline__ float* RF() const { return (float*)(ws + WS_TAB + TAB_RF); }
    __device__ __forceinline__ float* SUBLN() const { return (float*)(ws + WS_TAB + TAB_SUBLN); }
    __device__ __forceinline__ float* HGNW() const { return (float*)(ws + WS_TAB + TAB_HGNW); }
    __device__ __forceinline__ float* FNORM() const { return (float*)(ws + WS_TAB + TAB_FNORM); }
    __device__ __forceinline__ unsigned* TINFO() const { return (unsigned*)(ws + WS_ROUTE + ROUTE_INFO); }
    __device__ __forceinline__ int* LIST() const { return (int*)(ws + WS_ROUTE + ROUTE_LIST); }
    __device__ __forceinline__ float* RSTD() const { return (float*)(ws + WS_ROUTE + ROUTE_RSTD); }
};
struct Args { const float* in[19]; float* out; unsigned char* ws; int ph_lo, ph_hi; };
enum { IN_X = 0, IN_META, IN_RELB, IN_NMIX, IN_WIN, IN_LBL, IN_HGNW, IN_LAMBDA, IN_SUBLN, IN_WOUT, IN_NFFN, IN_DW1, IN_DW3, IN_DW2, IN_ROUTER, IN_MW1, IN_MW3, IN_MW2, IN_FNORM };

__device__ __forceinline__ float row_rstd(const float* ssq, int row) {
    const f32x4* p = (const f32x4*)(ssq + (size_t)row * 16);
    const f32x4 a = p[0], b = p[1], c = p[2], d = p[3];
    const float s = ((a[0] + a[1]) + (a[2] + a[3])) + ((b[0] + b[1]) + (b[2] + b[3])) + ((c[0] + c[1]) + (c[2] + c[3])) + ((d[0] + d[1]) + (d[2] + d[3]));
    return rsqrtf(s * (1.0f / 1024.0f) + EPS);
}
template <int N> __device__ __forceinline__ float dpp_row_shr(float x) {
    return __builtin_bit_cast(float, __builtin_amdgcn_update_dpp(0, __builtin_bit_cast(int, x), 0x110 + N, 0xf, 0xf, true));
}
struct EpiProj {
    static constexpr bool PERM = true, AFTER_DRAIN = false;
    bf16* proj; float* logfp; const float* ssq; const float* lb;
    template <int AI, int BJ, int NN> __device__ __forceinline__ void hf_block(const pg8::f32x4 (&acc)[2][2][4][2], int row0, int colb) const {
        const int c0 = colb + BJ * 128 + 4 * NN, cc = c0 - 512;
        const f32x4 l0 = *(const f32x4*)(lb + cc);
        float lf[4][4];
#pragma unroll
        for (int m = 0; m < 4; ++m) {
            const int row = row0 + AI * 128 + m * 16;
            const float r = row_rstd(ssq, row);
            const bool valid = (row % LT) >= FIRSTV;
            float kx[4];
#pragma unroll
            for (int j = 0; j < 4; ++j) {
                const float lbv = l0[j];
                const float xx = acc[AI][BJ][m][NN][j] * r;
                const float xc = fminf(fmaxf(xx, -30.f), 30.f);
                const float te = __expf(-xc), sg = __builtin_amdgcn_rcpf(1.f + te);
                float lgf = __logf(lbv + (1.f - lbv) * sg);
                float kk = (1.f - lbv) * (te * sg);
                if (!valid) { lgf = 0.f; kk = 0.f; }
                lf[m][j] = lgf; kx[j] = kk;
            }
            v2u w; w.x = pg8::cvt_pk_bf16(kx[0], kx[1]); w.y = pg8::cvt_pk_bf16(kx[2], kx[3]);
            *(v2u*)(proj + (size_t)row * WIN + c0) = w;
        }
#pragma unroll
        for (int j = 0; j < 4; ++j) {
            float carry = 0.f;
#pragma unroll
            for (int m = 0; m < 4; ++m) {
                float x = lf[m][j];
                x += dpp_row_shr<1>(x); x += dpp_row_shr<2>(x); x += dpp_row_shr<4>(x); x += dpp_row_shr<8>(x);
                x += carry;
                carry = __shfl(x, 15, 16);
                lf[m][j] = x;
            }
        }
#pragma unroll
        for (int m = 0; m < 4; ++m) *(f32x4*)(logfp + (size_t)(row0 + AI * 128 + m * 16) * 512 + cc) = (f32x4){lf[m][0], lf[m][1], lf[m][2], lf[m][3]};
    }
    __device__ __forceinline__ void operator()(const pg8::f32x4 (&acc)[2][2][4][2], const pg8::Unit& u, int wr, int wc, int fr, int fq) const {
        const int grp = u.pn >> 1;
        const int row0 = u.pm * 256 + wr * 64 + fr, colb = u.pn * 256 + wc * 32 + 8 * fq;
        if (grp == 1) {
            hf_block<0, 0, 0>(acc, row0, colb); hf_block<0, 0, 1>(acc, row0, colb); hf_block<0, 1, 0>(acc, row0, colb); hf_block<0, 1, 1>(acc, row0, colb);
            hf_block<1, 0, 0>(acc, row0, colb); hf_block<1, 0, 1>(acc, row0, colb); hf_block<1, 1, 0>(acc, row0, colb); hf_block<1, 1, 1>(acc, row0, colb);
            return;
        }
#pragma unroll
        for (int ai = 0; ai < 2; ++ai)
#pragma unroll
            for (int m = 0; m < 4; ++m) {
                const int row = row0 + ai * 128 + m * 16;
                const float r = row_rstd(ssq, row);
#pragma unroll
                for (int bj = 0; bj < 2; ++bj) {
                    const int c0 = colb + bj * 128;
                    float x[8];
#pragma unroll
                    for (int j = 0; j < 4; ++j) { x[j] = acc[ai][bj][m][0][j] * r; x[4 + j] = acc[ai][bj][m][1][j] * r; }
                    if (grp == 0 || grp == 3) {
#pragma unroll
                        for (int j = 0; j < 8; ++j) x[j] = silu_f(x[j]);
                    } else if (grp == 4) {
#pragma unroll
                        for (int j = 0; j < 8; ++j) x[j] *= 0.18033688011112042f;
                    }
                    v4u w; w.x = pg8::cvt_pk_bf16(x[0], x[1]); w.y = pg8::cvt_pk_bf16(x[2], x[3]); w.z = pg8::cvt_pk_bf16(x[4], x[5]); w.w = pg8::cvt_pk_bf16(x[6], x[7]);
                    *(v4u*)(proj + (size_t)row * WIN + c0) = w;
                }
            }
    }
};
struct EpiResid {
    static constexpr bool PERM = true, AFTER_DRAIN = false;
    float* H; bf16* HB; float* ssq;
    __device__ __forceinline__ void operator()(const pg8::f32x4 (&acc)[2][2][4][2], const pg8::Unit& u, int wr, int wc, int fr, int fq) const {
        const int row0 = u.pm * 256 + wr * 64 + fr, colb = u.pn * 256 + wc * 32 + 8 * fq;
#pragma unroll
        for (int ai = 0; ai < 2; ++ai)
#pragma unroll
            for (int m = 0; m < 4; ++m) {
                const int row = row0 + ai * 128 + m * 16;
                float s = 0.f;
#pragma unroll
                for (int bj = 0; bj < 2; ++bj) {
                    const int c0 = colb + bj * 128;
                    float* hp = H + (size_t)row * D + c0;
                    f32x4 h0 = *(const f32x4*)hp, h1 = *(const f32x4*)(hp + 4);
                    h0 = h0 + acc[ai][bj][m][0]; h1 = h1 + acc[ai][bj][m][1];
                    *(f32x4*)hp = h0; *(f32x4*)(hp + 4) = h1;
                    s += (h0[0] * h0[0] + h0[1] * h0[1]) + (h0[2] * h0[2] + h0[3] * h0[3]) + (h1[0] * h1[0] + h1[1] * h1[1]) + (h1[2] * h1[2] + h1[3] * h1[3]);
                    v4u w; w.x = pg8::cvt_pk_bf16(h0[0], h0[1]); w.y = pg8::cvt_pk_bf16(h0[2], h0[3]); w.z = pg8::cvt_pk_bf16(h1[0], h1[1]); w.w = pg8::cvt_pk_bf16(h1[2], h1[3]);
                    *(v4u*)(HB + (size_t)row * D + c0) = w;
                }
                s += __shfl_xor(s, 16); s += __shfl_xor(s, 32);
                if (fq == 0) ssq[(size_t)row * 16 + u.pn * 4 + wc] = s;
            }
    }
};
struct EpiGLU {
    static constexpr bool PERM = true, AFTER_DRAIN = false;
    bf16* T; int ldt; const float* ssq;
    __device__ __forceinline__ void operator()(const pg8::f32x4 (&acc)[2][2][4][2], const pg8::Unit& u, int wr, int wc, int fr, int fq) const {
        const int row0 = u.pm * 256 + wr * 64 + fr, colb = u.pn * 128 + wc * 32 + 8 * fq;
#pragma unroll
        for (int ai = 0; ai < 2; ++ai)
#pragma unroll
            for (int m = 0; m < 4; ++m) {
                const int row = row0 + ai * 128 + m * 16;
                const float r = ssq ? row_rstd(ssq, row) : 1.f;
                float x[8];
#pragma unroll
                for (int j = 0; j < 4; ++j) { x[j] = silu_f(acc[ai][0][m][0][j] * r) * (acc[ai][1][m][0][j] * r); x[4 + j] = silu_f(acc[ai][0][m][1][j] * r) * (acc[ai][1][m][1][j] * r); }
                v4u w; w.x = pg8::cvt_pk_bf16(x[0], x[1]); w.y = pg8::cvt_pk_bf16(x[2], x[3]); w.z = pg8::cvt_pk_bf16(x[4], x[5]); w.w = pg8::cvt_pk_bf16(x[6], x[7]);
                *(v4u*)(T + (size_t)row * ldt + colb) = w;
            }
    }
};
struct EpiY {
    static constexpr bool PERM = true, AFTER_DRAIN = false;
    bf16* Y;
    __device__ __forceinline__ void operator()(const pg8::f32x4 (&acc)[2][2][4][2], const pg8::Unit& u, int wr, int wc, int fr, int fq) const {
        const int row0 = u.pm * 256 + wr * 64 + fr, colb = u.pn * 256 + wc * 32 + 8 * fq;
#pragma unroll
        for (int ai = 0; ai < 2; ++ai)
#pragma unroll
            for (int m = 0; m < 4; ++m) {
                const int row = row0 + ai * 128 + m * 16;
#pragma unroll
                for (int bj = 0; bj < 2; ++bj) {
                    const pg8::f32x4 a = acc[ai][bj][m][0], b = acc[ai][bj][m][1];
                    v4u w; w.x = pg8::cvt_pk_bf16(a[0], a[1]); w.y = pg8::cvt_pk_bf16(a[2], a[3]); w.z = pg8::cvt_pk_bf16(b[0], b[1]); w.w = pg8::cvt_pk_bf16(b[2], b[3]);
                    *(v4u*)(Y + (size_t)row * D + colb + bj * 128) = w;
                }
            }
    }
};

__device__ __forceinline__ void transpose_item(const float* W, const float* fold, int K, int N, bf16* WT, int k0, int n0, int drow0, LAS float* scr, int lane) {
    const int kr = lane >> 4, n4 = lane & 15;
    f32x4 v[16];
#pragma unroll
    for (int i = 0; i < 16; ++i) v[i] = *(const f32x4*)(W + (size_t)(k0 + 4 * i + kr) * N + n0 + 4 * n4);
#pragma unroll
    for (int i = 0; i < 16; ++i) { const int k = 4 * i + kr; *(LAS f32x4*)(scr + k * 64 + ((4 * n4) ^ (4 * ((k >> 3) & 7)))) = v[i]; }
    LDS_WAIT(); asm volatile("" ::: "memory");
    const int c = lane & 7, nn = lane >> 3;
    f32x4 f0 = (f32x4){1.f, 1.f, 1.f, 1.f}, f1 = f0;
    if (fold) { f0 = *(const f32x4*)(fold + k0 + 8 * c); f1 = *(const f32x4*)(fold + k0 + 8 * c + 4); }
#pragma unroll
    for (int i2 = 0; i2 < 8; ++i2) {
        const int n = 8 * i2 + nn; const LAS float* s = scr + (8 * c) * 64 + (n ^ (4 * c));
        v4u o; o.x = pk2(s[0 * 64] * f0[0], s[1 * 64] * f0[1]); o.y = pk2(s[2 * 64] * f0[2], s[3 * 64] * f0[3]); o.z = pk2(s[4 * 64] * f1[0], s[5 * 64] * f1[1]); o.w = pk2(s[6 * 64] * f1[2], s[7 * 64] * f1[3]);
        *(GAS v4u*)(WT + (size_t)(drow0 + n) * K + k0 + 8 * c) = o;
    }
    LDS_WAIT(); asm volatile("" ::: "memory");
}
__device__ __forceinline__ void prologue_phase(Ctx& C, const Args& A) {
    LAS float* scr = (LAS float*)(C.lds + C.wave * 16384);
    const int gw = C.bid * 8 + C.wave, NGW = C.G * 8;
    constexpr int I_IN = 16 * 56, I_OUT = 16 * 16, I_D1 = 16 * 44, I_D2 = 44 * 16, I_M1 = 16 * 56, I_M2 = 56 * 16;
    constexpr int N_IN = 4 * I_IN, N_OUT = 4 * I_OUT, N_D1 = 2 * I_D1, N_D2 = 2 * I_D2, N_M1 = 16 * I_M1, N_M2 = 16 * I_M2;
    constexpr int NITEMS = N_IN + N_OUT + 2 * N_D1 + N_D2 + 2 * N_M1 + N_M2;
    for (int it = gw; it < NITEMS; it += NGW) {
        int r = it;
        const float* W; const float* fold = nullptr; bf16* WT; int K, N, glu = -1, loc;
        if (r < N_IN) { const int l = r / I_IN; loc = r % I_IN; W = A.in[IN_WIN] + (size_t)l * D * WIN; fold = A.in[IN_NMIX] + l * D; WT = (bf16*)(C.ws + WS_WIN) + (size_t)l * WIN * D; K = D; N = WIN; }
        else if ((r -= N_IN) < N_OUT) { const int l = r / I_OUT; loc = r % I_OUT; W = A.in[IN_WOUT] + (size_t)l * D * D; WT = (bf16*)(C.ws + WS_WOUT) + (size_t)l * D * D; K = D; N = D; }
        else if ((r -= N_OUT) < N_D1) { const int i = r / I_D1; loc = r % I_D1; W = A.in[IN_DW1] + (size_t)i * D * FFD; fold = A.in[IN_NFFN] + (2 * i) * D; WT = (bf16*)(C.ws + WS_WD13) + (size_t)i * 2 * FFD * D; K = D; N = FFD; glu = 0; }
        else if ((r -= N_D1) < N_D1) { const int i = r / I_D1; loc = r % I_D1; W = A.in[IN_DW3] + (size_t)i * D * FFD; fold = A.in[IN_NFFN] + (2 * i) * D; WT = (bf16*)(C.ws + WS_WD13) + (size_t)i * 2 * FFD * D; K = D; N = FFD; glu = 1; }
        else if ((r -= N_D1) < N_D2) { const int i = r / I_D2; loc = r % I_D2; W = A.in[IN_DW2] + (size_t)i * FFD * D; WT = (bf16*)(C.ws + WS_WD2) + (size_t)i * D * FFD; K = FFD; N = D; }
        else if ((r -= N_D2) < N_M1) { const int ie = r / I_M1; loc = r % I_M1; W = A.in[IN_MW1] + (size_t)ie * D * FFE; fold = A.in[IN_NFFN] + (2 * (ie >> 3) + 1) * D; WT = (bf16*)(C.ws + WS_WM13) + (size_t)ie * 2 * FFE * D; K = D; N = FFE; glu = 0; }
        else if ((r -= N_M1) < N_M1) { const int ie = r / I_M1; loc = r % I_M1; W = A.in[IN_MW3] + (size_t)ie * D * FFE; fold = A.in[IN_NFFN] + (2 * (ie >> 3) + 1) * D; WT = (bf16*)(C.ws + WS_WM13) + (size_t)ie * 2 * FFE * D; K = D; N = FFE; glu = 1; }
        else { r -= N_M1; const int ie = r / I_M2; loc = r % I_M2; W = A.in[IN_MW2] + (size_t)ie * FFE * D; WT = (bf16*)(C.ws + WS_WM2) + (size_t)ie * D * FFE; K = FFE; N = D; }
        const int nblk = N / 64, kb = loc / nblk, nb = loc % nblk, k0 = 64 * kb, n0 = 64 * nb;
        const int drow0 = (glu < 0) ? n0 : ((n0 >> 7) * 256 + glu * 128 + (n0 & 127));
        transpose_item(W, fold, K, N, WT, k0, n0, drow0, scr, C.lane);
    }
    for (int row = gw; row < NTOK; row += NGW) {
        const int b = row / LT, t = row % LT;
        f32x4 v[4]; float s = 0.f;
#pragma unroll
        for (int j = 0; j < 4; ++j) {
            const int col = 4 * C.lane + 256 * j;
            if (t < FIRSTV) v[j] = (f32x4){0.f, 0.f, 0.f, 0.f};
            else if (t < LEAD) v[j] = *(const f32x4*)(A.in[IN_META] + (size_t)(t - FIRSTV) * D + col);
            else v[j] = *(const f32x4*)(A.in[IN_X] + ((size_t)b * SEQ + (t - LEAD)) * D + col);
            s += (v[j][0] * v[j][0] + v[j][1] * v[j][1]) + (v[j][2] * v[j][2] + v[j][3] * v[j][3]);
            *(f32x4*)(C.H() + (size_t)row * D + col) = v[j];
            v2u w; w.x = pk2(v[j][0], v[j][1]); w.y = pk2(v[j][2], v[j][3]);
            *(v2u*)(C.HB() + (size_t)row * D + col) = w;
        }
        s = wave_sum(s);
        if (C.lane < 16) C.SSQ()[(size_t)row * 16 + C.lane] = (C.lane == 0) ? s : 0.f;
    }
    if (C.bid == 0) {
        const int tid = C.tid;
        {
            const float* lg = A.in[IN_LBL];
            const float a0 = lg[tid], a1 = lg[512 + tid], a2 = lg[1024 + tid], a3 = lg[1536 + tid];
            const float mx = fmaxf(fmaxf(a0, a1), fmaxf(a2, a3));
            const float e0 = expf(a0 - mx), e1 = expf(a1 - mx), e2 = expf(a2 - mx), e3 = expf(a3 - mx);
            const float inv = 1.f / (((e0 + e1) + e2) + e3);
            const float p0 = e0 * inv, p1 = e1 * inv, p2 = e2 * inv, p3 = e3 * inv;
            const float c0 = p0, c1 = c0 + p1, c2 = c1 + p2, c3 = c2 + p3;
            C.LB()[tid] = 0.f;
            C.LB()[512 + tid] = fminf(fmaxf(c1 - c0, 0.f), 0.999f);
            C.LB()[1024 + tid] = fminf(fmaxf(c2 - c0, 0.f), 0.999f);
            C.LB()[1536 + tid] = fminf(fmaxf(c3 - c0, 0.f), 0.999f);
        }
        for (int i = tid; i < 4 * 132; i += 512) { const int h = i / 132, d = i % 132; C.BIAST()[i] = (d <= 128) ? A.in[IN_RELB][T5B[d] * 4 + h] : 0.f; }
        if (tid < 4) {
            const float* lv = A.in[IN_LAMBDA] + tid * 256;
            float s01 = 0.f, s23 = 0.f;
            for (int j = 0; j < 64; ++j) { s01 += lv[j] * lv[64 + j]; s23 += lv[128 + j] * lv[192 + j]; }
            const float li = 0.8f - 0.6f * expf(-0.3f * (float)tid);
            C.LAM()[tid * 2] = expf(s01) - expf(s23) + li; C.LAM()[tid * 2 + 1] = li;
        }
        if (tid < 512) { C.SUBLN()[tid] = A.in[IN_SUBLN][tid]; C.HGNW()[tid] = A.in[IN_HGNW][tid]; C.FNORM()[tid] = A.in[IN_FNORM][tid]; C.FNORM()[512 + tid] = A.in[IN_FNORM][512 + tid]; }
        for (int i = tid; i < 2 * 8 * 1024; i += 512) { const int li = i >> 13, e = (i >> 10) & 7, k = i & 1023; C.RF()[i] = A.in[IN_NFFN][(2 * li + 1) * D + k] * A.in[IN_ROUTER][(size_t)li * D * NE + k * NE + e]; }
    }
}

__device__ __forceinline__ void hgrn_naive_unit(Ctx& C, int l, int b, int h) {
    LAS float* qf = (LAS float*)C.lds;
    LAS float* kf = qf + 2048; LAS float* ff = kf + 2048; LAS float* vv = ff + 2048; LAS float* gg = vv + 2048;
    LAS float* opart = gg + 2048;
    const int tid = C.tid, dv = tid & 127, qd = tid >> 7;
    const int ltok = tid >> 5, c4 = (tid & 31) * 4;
    float S[32];
#pragma unroll
    for (int j = 0; j < 32; ++j) S[j] = 0.f;
    const float* nw = C.HGNW() + l * 128;
    for (int tb = 0; tb < LT / 16; ++tb) {
        const size_t row = (size_t)b * LT + tb * 16 + ltok;
        {
            const bf16* pp = C.PROJ() + row * WIN + h * 128 + c4;
            const v2u wq = *(const v2u*)pp, wk = *(const v2u*)(pp + 512), wv = *(const v2u*)(pp + 1024), wg = *(const v2u*)(pp + 1536);
            const f32x4 lf = *(const f32x4*)(C.LOGF() + row * 512 + h * 128 + c4);
            const int o = ltok * 128 + c4;
            qf[o] = bf_lo(wq.x); qf[o + 1] = bf_hi(wq.x); qf[o + 2] = bf_lo(wq.y); qf[o + 3] = bf_hi(wq.y);
            kf[o] = bf_lo(wk.x); kf[o + 1] = bf_hi(wk.x); kf[o + 2] = bf_lo(wk.y); kf[o + 3] = bf_hi(wk.y);
            vv[o] = bf_lo(wv.x); vv[o + 1] = bf_hi(wv.x); vv[o + 2] = bf_lo(wv.y); vv[o + 3] = bf_hi(wv.y);
            gg[o] = bf_lo(wg.x); gg[o + 1] = bf_hi(wg.x); gg[o + 2] = bf_lo(wg.y); gg[o + 3] = bf_hi(wg.y);
            f32x4 lp = (f32x4){0.f, 0.f, 0.f, 0.f};
            if (((tb * 16 + ltok) & 63) != 0) lp = *(const f32x4*)(C.LOGF() + (row - 1) * 512 + h * 128 + c4);
            ff[o] = expf(lf[0] - lp[0]); ff[o + 1] = expf(lf[1] - lp[1]); ff[o + 2] = expf(lf[2] - lp[2]); ff[o + 3] = expf(lf[3] - lp[3]);
        }
        __syncthreads();
        for (int tok = 0; tok < 16; ++tok) {
            const float v = vv[tok * 128 + dv];
            const LAS f32x4* fp = (const LAS f32x4*)(ff + tok * 128 + 32 * qd);
            const LAS f32x4* kp = (const LAS f32x4*)(kf + tok * 128 + 32 * qd);
            const LAS f32x4* qp = (const LAS f32x4*)(qf + tok * 128 + 32 * qd);
            float a = 0.f;
#pragma unroll
            for (int j = 0; j < 8; ++j) {
                const f32x4 f4 = fp[j], k4 = kp[j], q4 = qp[j];
#pragma unroll
                for (int i = 0; i < 4; ++i) { S[4 * j + i] = f4[i] * S[4 * j + i] + k4[i] * v; a += q4[i] * S[4 * j + i]; }
            }
            opart[(tok * 4 + qd) * 128 + dv] = a;
        }
        __syncthreads();
        {
            float o[4]; float ss = 0.f;
#pragma unroll
            for (int i = 0; i < 4; ++i) { o[i] = (opart[(ltok * 4 + 0) * 128 + c4 + i] + opart[(ltok * 4 + 1) * 128 + c4 + i]) + (opart[(ltok * 4 + 2) * 128 + c4 + i] + opart[(ltok * 4 + 3) * 128 + c4 + i]); ss += o[i] * o[i]; }
#pragma unroll
            for (int m = 1; m < 32; m <<= 1) ss += __shfl_xor(ss, m);
            const float rs = rsqrtf(ss * (1.0f / 128.0f) + EPS);
            const int oo = ltok * 128 + c4;
            v2u w; w.x = pk2(o[0] * rs * nw[c4] * gg[oo], o[1] * rs * nw[c4 + 1] * gg[oo + 1]); w.y = pk2(o[2] * rs * nw[c4 + 2] * gg[oo + 2], o[3] * rs * nw[c4 + 3] * gg[oo + 3]);
            *(v2u*)(C.MIX() + row * D + h * 128 + c4) = w;
        }
        __syncthreads();
    }
}
typedef float f32x16 __attribute__((ext_vector_type(16)));
typedef short bf16x8 __attribute__((ext_vector_type(8)));
typedef short s16x4 __attribute__((ext_vector_type(4)));
constexpr float LOG2E = 1.4426950408889634f;
constexpr int AT_K = 0, AT_V = 32768, AT_BIAS = 65536, AT_WSF = 66560, AT_STG = 69632, AT_XCH = 0;
__device__ __forceinline__ int crow(int r, int hi) { return (r & 3) + 8 * (r >> 2) + 4 * hi; }
__device__ __forceinline__ s16x4 vtr(const LAS unsigned char* p) { typedef short v4i16_t __attribute__((ext_vector_type(4))); return __builtin_bit_cast(s16x4, __builtin_amdgcn_ds_read_tr16_b64_v4i16((LAS v4i16_t*)p)); }
__device__ __forceinline__ bf16x8 pack8(const f32x16& p, int b0) {
    v4u w; w.x = pg8::cvt_pk_bf16(p[b0 + 0], p[b0 + 1]); w.y = pg8::cvt_pk_bf16(p[b0 + 2], p[b0 + 3]); w.z = pg8::cvt_pk_bf16(p[b0 + 4], p[b0 + 5]); w.w = pg8::cvt_pk_bf16(p[b0 + 6], p[b0 + 7]);
    return __builtin_bit_cast(bf16x8, w);
}
__device__ __forceinline__ void attn_unit(Ctx& C, int l, int b, int h, int qi) {
    LAS unsigned char* lds = C.lds;
    const int tid = C.tid, lane = C.lane, wave = C.wave, rg = wave >> 1, c = wave & 1, r32 = lane & 31, hi = lane >> 5;
    const size_t rowbase = (size_t)b * LT;
    const bf16* PJ = C.PROJ();
    LAS float* biasl = (LAS float*)(lds + AT_BIAS);
    LAS float* wsf = (LAS float*)(lds + AT_WSF) + wave * 64;
    if (tid < 132) biasl[tid] = C.BIAST()[h * 132 + tid] * LOG2E;
    const float lam = C.LAM()[l * 2], lam_init = C.LAM()[l * 2 + 1];
    const int qw0 = 128 * qi + 32 * rg, tq = qw0 + r32;
    bf16x8 qr[4];
    { const bf16* qp = PJ + (rowbase + tq) * WIN + 2048 + h * 128 + c * 64 + 8 * hi;
#pragma unroll
      for (int ks = 0; ks < 4; ++ks) qr[ks] = *(const bf16x8*)(qp + 16 * ks); }
    const int kkey = tid >> 3, kch = tid & 7;
    const bf16* ksrc = PJ + (rowbase + kkey) * WIN + 2560 + h * 128 + kch * 8;
    const int kdst = kkey * 128 + ((kch ^ ((kkey >> 1) & 7)) * 16);
    const int vkey0 = tid >> 4, vch = tid & 15;
    const bf16* vsrc = PJ + (rowbase + vkey0) * WIN + 3072 + h * 128 + vch * 8;
    const int vdst0 = ((vkey0 >> 3) * 4 + (vch >> 2)) * 512 + (vkey0 & 7) * 64 + (vch & 3) * 16;
    v4u kreg0, kreg1, vreg0, vreg1;
#define AT_LOAD(kt) do { const size_t o_ = (size_t)(kt) * 64 * WIN; kreg0 = *(const v4u*)(ksrc + o_); kreg1 = *(const v4u*)(ksrc + o_ + 64); vreg0 = *(const v4u*)(vsrc + o_); vreg1 = *(const v4u*)(vsrc + o_ + (size_t)32 * WIN); } while (0)
#define AT_STORE(buf) do { *(LAS v4u*)(lds + AT_K + (buf) * 16384 + kdst) = kreg0; *(LAS v4u*)(lds + AT_K + (buf) * 16384 + 8192 + kdst) = kreg1; \
        *(LAS v4u*)(lds + AT_V + (buf) * 16384 + vdst0) = vreg0; *(LAS v4u*)(lds + AT_V + (buf) * 16384 + 8192 + vdst0) = vreg1; } while (0)
    const int nt = 2 * qi + 1;
    AT_LOAD(1); AT_STORE(0);
    __syncthreads();
    f32x16 o[4];
#pragma unroll
    for (int d = 0; d < 4; ++d)
#pragma unroll
        for (int r = 0; r < 16; ++r) o[d][r] = 0.f;
    float mref = -1e30f, lsum = 0.f;
    const int kswz = (r32 >> 1) & 7;
    const int vb = (4 * hi + ((lane & 15) >> 2)) * 64 + ((lane >> 4) & 1) * 32 + (lane & 3) * 8;
    const float b128 = biasl[128];
    for (int it = 0; it < nt; ++it) {
        const int kt = it + 1, buf = it & 1, k0 = 64 * kt;
        if (it + 1 < nt) AT_LOAD(kt + 1);
        if (k0 <= qw0 + 31) {
            const bool near = (k0 + 63 > qw0 - 128) || (kt == 1);
            f32x16 p0, p1;
            { const float ini = near ? 0.f : b128;
#pragma unroll
              for (int r = 0; r < 16; ++r) { p0[r] = ini; p1[r] = ini; } }
            const LAS unsigned char* kb = lds + AT_K + buf * 16384 + c * 8192 + r32 * 128;
#pragma unroll
            for (int ks = 0; ks < 4; ++ks) {
                const int off = ((2 * ks + hi) ^ kswz) * 16;
                const bf16x8 k0f = *(const LAS bf16x8*)(kb + off), k1f = *(const LAS bf16x8*)(kb + 4096 + off);
                p0 = __builtin_amdgcn_mfma_f32_32x32x16_bf16(k0f, qr[ks], p0, 0, 0, 0);
                p1 = __builtin_amdgcn_mfma_f32_32x32x16_bf16(k1f, qr[ks], p1, 0, 0, 0);
            }
            if (near) {
#pragma unroll
                for (int r = 0; r < 16; ++r) {
                    const int tk = k0 + crow(r, hi), d0 = tq - tk, d1 = d0 - 32;
                    const float b0 = biasl[d0 < 0 ? 0 : (d0 > 128 ? 128 : d0)], b1 = biasl[d1 < 0 ? 0 : (d1 > 128 ? 128 : d1)];
                    p0[r] = (d0 < 0 || tk < FIRSTV) ? -INFINITY : p0[r] + b0;
                    p1[r] = (d1 < 0 || tk + 32 < FIRSTV) ? -INFINITY : p1[r] + b1;
                }
            }
            float mx = fmaxf(p0[0], p1[0]);
#pragma unroll
            for (int r = 1; r < 16; ++r) mx = fmaxf(fmaxf(mx, p0[r]), p1[r]);
            mx = fmaxf(mx, __shfl_xor(mx, 32));
            if (__any(mx > mref + 8.0f)) {
                const float mnew = fmaxf(mref, mx), f = __builtin_amdgcn_exp2f(mref - mnew);
                lsum *= f; mref = mnew;
                if (hi == 0) wsf[r32] = f;
                LDS_WAIT(); asm volatile("" ::: "memory");
#pragma unroll
                for (int g = 0; g < 4; ++g) { const f32x4 fv = *(const LAS f32x4*)(wsf + 8 * g + 4 * hi);
#pragma unroll
                    for (int d = 0; d < 4; ++d) { o[d][4 * g + 0] *= fv[0]; o[d][4 * g + 1] *= fv[1]; o[d][4 * g + 2] *= fv[2]; o[d][4 * g + 3] *= fv[3]; } }
            }
            float ps = 0.f;
#pragma unroll
            for (int r = 0; r < 16; ++r) { p0[r] = __builtin_amdgcn_exp2f(p0[r] - mref); p1[r] = __builtin_amdgcn_exp2f(p1[r] - mref); ps += p0[r] + p1[r]; }
            lsum += ps;
            const bf16x8 pa0 = pack8(p0, 0), pa1 = pack8(p0, 8), pa2 = pack8(p1, 0), pa3 = pack8(p1, 8);
            const LAS unsigned char* vp = lds + AT_V + buf * 16384 + vb;
#pragma unroll
            for (int d = 0; d < 4; ++d) {
#define AT_VF(s) ({ const s16x4 lo_ = vtr(vp + (2 * (s)) * 2048 + d * 512), hi_ = vtr(vp + (2 * (s) + 1) * 2048 + d * 512); (bf16x8){lo_[0], lo_[1], lo_[2], lo_[3], hi_[0], hi_[1], hi_[2], hi_[3]}; })
                o[d] = __builtin_amdgcn_mfma_f32_32x32x16_bf16(pa0, AT_VF(0), o[d], 0, 0, 0);
                o[d] = __builtin_amdgcn_mfma_f32_32x32x16_bf16(pa1, AT_VF(1), o[d], 0, 0, 0);
                o[d] = __builtin_amdgcn_mfma_f32_32x32x16_bf16(pa2, AT_VF(2), o[d], 0, 0, 0);
                o[d] = __builtin_amdgcn_mfma_f32_32x32x16_bf16(pa3, AT_VF(3), o[d], 0, 0, 0);
#undef AT_VF
            }
        }
        if (it + 1 < nt) AT_STORE(buf ^ 1);
        __syncthreads();
    }
#undef AT_LOAD
#undef AT_STORE
    lsum += __shfl_xor(lsum, 32);
    { const float inv = lsum > 0.f ? 1.f / lsum : 0.f;
      if (hi == 0) wsf[r32] = inv;
      LDS_WAIT(); asm volatile("" ::: "memory");
#pragma unroll
      for (int g = 0; g < 4; ++g) { const f32x4 fv = *(const LAS f32x4*)(wsf + 8 * g + 4 * hi);
#pragma unroll
          for (int d = 0; d < 4; ++d) { o[d][4 * g + 0] *= fv[0]; o[d][4 * g + 1] *= fv[1]; o[d][4 * g + 2] *= fv[2]; o[d][4 * g + 3] *= fv[3]; } } }
    LAS float* xch = (LAS float*)(lds + AT_XCH) + rg * 4096;
    if (c == 1) {
#pragma unroll
        for (int d = 0; d < 4; ++d)
#pragma unroll
            for (int r = 0; r < 16; ++r) xch[(d * 16 + r) * 64 + lane] = o[d][r];
    }
    __syncthreads();
    if (c == 0) {
        float ss[16];
#pragma unroll
        for (int r = 0; r < 16; ++r) ss[r] = 0.f;
#pragma unroll
        for (int d = 0; d < 4; ++d)
#pragma unroll
            for (int r = 0; r < 16; ++r) { const float a = o[d][r] - lam * xch[(d * 16 + r) * 64 + lane]; o[d][r] = a; ss[r] += a * a; }
#pragma unroll
        for (int r = 0; r < 16; ++r) {
            float s = ss[r];
            s += __shfl_xor(s, 1); s += __shfl_xor(s, 2); s += __shfl_xor(s, 4); s += __shfl_xor(s, 8); s += __shfl_xor(s, 16);
            ss[r] = rsqrtf(s * (1.0f / 128.0f) + EPS) * (1.f - lam_init);
        }
        LAS bf16* stg = (LAS bf16*)(lds + AT_STG) + rg * 4096;
        const float* sw = C.SUBLN() + l * 128 + r32;
#pragma unroll
        for (int d = 0; d < 4; ++d) { const float w = sw[32 * d];
#pragma unroll
            for (int r = 0; r < 16; ++r) stg[crow(r, hi) * 128 + 32 * d + r32] = (bf16)f2bf(o[d][r] * ss[r] * w); }
        LDS_WAIT(); asm volatile("" ::: "memory");
        bf16* op = C.MIX() + (rowbase + qw0) * D + 512 + h * 128;
#pragma unroll
        for (int i = 0; i < 8; ++i) { const int ch = i * 64 + lane, row = ch >> 4, cc = ch & 15; *(v4u*)(op + (size_t)row * D + cc * 8) = *(const LAS v4u*)(stg + row * 128 + cc * 8); }
    }
    __syncthreads();
}
constexpr int HG_QM = 0, HG_KR = 16384, HG_KT = 32768, HG_V = 49152, HG_ST = 65536, HG_XT = 98304, HG_OS = 106496, HG_SQ = 122880, HG_VEC = 123904;
__device__ __forceinline__ v2u pack4(float a, float b, float c, float d) { v2u w; w.x = pg8::cvt_pk_bf16(a, b); w.y = pg8::cvt_pk_bf16(c, d); return w; }
__device__ __forceinline__ bf16x8 tr_frag(const LAS unsigned char* p) { const s16x4 lo = vtr(p), hi4 = vtr(p + 256); return (bf16x8){lo[0], lo[1], lo[2], lo[3], hi4[0], hi4[1], hi4[2], hi4[3]}; }
__device__ __forceinline__ void hgrn_unit(Ctx& C, int l, int b, int h) {
    LAS unsigned char* lds = C.lds;
    const int tid = C.tid, lane = C.lane, wave = C.wave, r32 = lane & 31, hi = lane >> 5;
    const size_t rowbase = (size_t)b * LT;
    const bf16* PJ = C.PROJ() + h * 128; const float* BL = C.LOGF() + h * 128;
    const int c4 = tid & 31, tg = tid >> 5;
    const int dkb = wave >> 1, dvb0 = 2 * (wave & 1);
    const int th = wave >> 2, dvb = wave & 3;
    const int vbq = ((lane & 15) >> 2) * 64 + ((lane >> 4) & 1) * 32 + (lane & 3) * 8;
    LAS float* vec = (LAS float*)(lds + HG_VEC);
    LAS float* sq = (LAS float*)(lds + HG_SQ);
    f32x16 st[2];
#pragma unroll
    for (int j = 0; j < 2; ++j)
#pragma unroll
        for (int r = 0; r < 16; ++r) st[j][r] = 0.f;
    v2u pq[4], pk[4], pv[4]; f32x4 pb[4], pbm;
#define HG_LOAD(ch) do { const size_t r0_ = rowbase + (size_t)(ch) * 64; \
        _Pragma("unroll") for (int i = 0; i < 4; ++i) { const size_t row_ = r0_ + 4 * tg + i; const bf16* p_ = PJ + row_ * WIN + 4 * c4; \
            pq[i] = *(const v2u*)p_; pk[i] = *(const v2u*)(p_ + 512); pv[i] = *(const v2u*)(p_ + 1024); pb[i] = *(const f32x4*)(BL + row_ * 512 + 4 * c4); } \
        pbm = *(const f32x4*)(BL + (r0_ + 31) * 512 + 4 * c4); } while (0)
    HG_LOAD(0);
    const float* nw = C.HGNW() + l * 128;
    for (int ch = 0; ch < LT / 64; ++ch) {
#pragma unroll
        for (int i = 0; i < 4; ++i) {
            const int t = 4 * tg + i;
            float qm[4], km[4];
            const float qv[4] = {bf_lo(pq[i].x), bf_hi(pq[i].x), bf_lo(pq[i].y), bf_hi(pq[i].y)};
            const float kv[4] = {bf_lo(pk[i].x), bf_hi(pk[i].x), bf_lo(pk[i].y), bf_hi(pk[i].y)};
#pragma unroll
            for (int j = 0; j < 4; ++j) { const float x = fminf(fmaxf(pb[i][j] - pbm[j], -80.f), 80.f); qm[j] = qv[j] * __expf(x); km[j] = kv[j] * __expf(-x); }
            const int rsw = (((c4 >> 1) ^ (t & 15)) * 16) + (c4 & 1) * 8;
            *(LAS v2u*)(lds + HG_QM + t * 256 + rsw) = pack4(qm[0], qm[1], qm[2], qm[3]);
            const v2u kmw = pack4(km[0], km[1], km[2], km[3]);
            *(LAS v2u*)(lds + HG_KR + t * 256 + rsw) = kmw;
            const int tso = ((t >> 3) * 4 + (c4 >> 3)) * 512 + (t & 7) * 64 + (c4 & 7) * 8;
            *(LAS v2u*)(lds + HG_KT + tso) = kmw;
            *(LAS v2u*)(lds + HG_V + tso) = pv[i];
            if (t == 31) *(LAS f32x4*)(vec + 4 * c4) = pb[i];
            if (t == 63) *(LAS f32x4*)(vec + 128 + 4 * c4) = pb[i];
        }
        __syncthreads();
        if (ch + 1 < LT / 64) HG_LOAD(ch + 1);
        const v4u g0 = *(const v4u*)(PJ + (rowbase + (size_t)ch * 64 + (tid >> 3)) * WIN + 1536 + 16 * (tid & 7)), g1 = *(const v4u*)(PJ + (rowbase + (size_t)ch * 64 + (tid >> 3)) * WIN + 1536 + 16 * (tid & 7) + 8);
#pragma unroll
        for (int g = 0; g < 4; ++g) {
            const f32x4 bm = *(const LAS f32x4*)(vec + 32 * dkb + 8 * g + 4 * hi);
            const float e0 = __expf(bm[0]), e1 = __expf(bm[1]), e2 = __expf(bm[2]), e3 = __expf(bm[3]);
#pragma unroll
            for (int j = 0; j < 2; ++j) {
                st[j][4 * g + 0] *= e0; st[j][4 * g + 1] *= e1; st[j][4 * g + 2] *= e2; st[j][4 * g + 3] *= e3;
                const int dv = 32 * (dvb0 + j) + r32;
                *(LAS v2u*)(lds + HG_ST + dv * 256 + (((4 * dkb + g) ^ (dv & 15)) * 16) + hi * 8) = pack4(st[j][4 * g + 0], st[j][4 * g + 1], st[j][4 * g + 2], st[j][4 * g + 3]);
            }
        }
        if (wave < 3) {
            const int sb = (wave == 2) ? 1 : 0, tb = (wave == 0) ? 0 : 1;
            const int s = 32 * sb + r32, t = 32 * tb + r32;
            f32x16 x;
#pragma unroll
            for (int r = 0; r < 16; ++r) x[r] = 0.f;
#pragma unroll
            for (int ks = 0; ks < 8; ++ks) {
                const bf16x8 a = *(const LAS bf16x8*)(lds + HG_KR + s * 256 + (((2 * ks + hi) ^ (s & 15)) * 16));
                const bf16x8 bq = *(const LAS bf16x8*)(lds + HG_QM + t * 256 + (((2 * ks + hi) ^ (t & 15)) * 16));
                x = __builtin_amdgcn_mfma_f32_32x32x16_bf16(a, bq, x, 0, 0, 0);
            }
            if (sb == tb) {
#pragma unroll
                for (int r = 0; r < 16; ++r) x[r] = (crow(r, hi) > r32) ? 0.f : x[r];
            }
#pragma unroll
            for (int g = 0; g < 4; ++g)
                *(LAS v2u*)(lds + HG_XT + t * 128 + (((4 * sb + g) ^ ((t >> 1) & 7)) * 16) + hi * 8) = pack4(x[4 * g + 0], x[4 * g + 1], x[4 * g + 2], x[4 * g + 3]);
        }
#pragma unroll
        for (int ks = 0; ks < 4; ++ks) {
            const bf16x8 a = tr_frag(lds + HG_KT + ((2 * ks + hi) * 4 + dkb) * 512 + vbq);
#pragma unroll
            for (int j = 0; j < 2; ++j) {
                const bf16x8 bv = tr_frag(lds + HG_V + ((2 * ks + hi) * 4 + dvb0 + j) * 512 + vbq);
                st[j] = __builtin_amdgcn_mfma_f32_32x32x16_bf16(a, bv, st[j], 0, 0, 0);
            }
        }
#pragma unroll
        for (int g = 0; g < 4; ++g) {
            const f32x4 bm = *(const LAS f32x4*)(vec + 32 * dkb + 8 * g + 4 * hi), be = *(const LAS f32x4*)(vec + 128 + 32 * dkb + 8 * g + 4 * hi);
            const float e0 = __expf(be[0] - bm[0]), e1 = __expf(be[1] - bm[1]), e2 = __expf(be[2] - bm[2]), e3 = __expf(be[3] - bm[3]);
#pragma unroll
            for (int j = 0; j < 2; ++j) { st[j][4 * g + 0] *= e0; st[j][4 * g + 1] *= e1; st[j][4 * g + 2] *= e2; st[j][4 * g + 3] *= e3; }
        }
        __syncthreads();
        {
            const int dv = 32 * dvb + r32, t = 32 * th + r32;
            f32x16 o;
#pragma unroll
            for (int r = 0; r < 16; ++r) o[r] = 0.f;
#pragma unroll
            for (int ks = 0; ks < 8; ++ks) {
                const bf16x8 a = *(const LAS bf16x8*)(lds + HG_ST + dv * 256 + (((2 * ks + hi) ^ (dv & 15)) * 16));
                const bf16x8 bq = *(const LAS bf16x8*)(lds + HG_QM + t * 256 + (((2 * ks + hi) ^ (t & 15)) * 16));
                o = __builtin_amdgcn_mfma_f32_32x32x16_bf16(a, bq, o, 0, 0, 0);
            }
#pragma unroll
            for (int sb = 0; sb < 2; ++sb) {
                if (sb <= th) {
#pragma unroll
                    for (int k2 = 0; k2 < 2; ++k2) {
                        const int kg = 4 * sb + 2 * k2 + hi;
                        const bf16x8 a = tr_frag(lds + HG_V + (kg * 4 + dvb) * 512 + vbq);
                        const bf16x8 bx = *(const LAS bf16x8*)(lds + HG_XT + t * 128 + ((kg ^ ((t >> 1) & 7)) * 16));
                        o = __builtin_amdgcn_mfma_f32_32x32x16_bf16(a, bx, o, 0, 0, 0);
                    }
                }
            }
            float s2 = 0.f;
#pragma unroll
            for (int r = 0; r < 16; ++r) s2 += o[r] * o[r];
            s2 += __shfl_xor(s2, 32);
            if (hi == 0) sq[t * 4 + dvb] = s2;
#pragma unroll
            for (int g = 0; g < 4; ++g)
                *(LAS v2u*)(lds + HG_OS + t * 256 + (((4 * dvb + g) ^ (t & 15)) * 16) + hi * 8) = pack4(o[4 * g + 0], o[4 * g + 1], o[4 * g + 2], o[4 * g + 3]);
        }
        __syncthreads();
        {
            const int t = tid >> 3, seg = tid & 7;
            const size_t row = rowbase + (size_t)ch * 64 + t;
            const f32x4 sv = *(const LAS f32x4*)(sq + t * 4);
            const float rs = rsqrtf(((sv[0] + sv[1]) + (sv[2] + sv[3])) * (1.0f / 128.0f) + EPS);
            const v4u o0 = *(const LAS v4u*)(lds + HG_OS + t * 256 + (((2 * seg) ^ (t & 15)) * 16)), o1 = *(const LAS v4u*)(lds + HG_OS + t * 256 + (((2 * seg + 1) ^ (t & 15)) * 16));
            const f32x4 w0 = *(const f32x4*)(nw + 16 * seg), w1 = *(const f32x4*)(nw + 16 * seg + 4), w2 = *(const f32x4*)(nw + 16 * seg + 8), w3 = *(const f32x4*)(nw + 16 * seg + 12);
            v4u r0, r1;
            r0.x = pk2(bf_lo(o0.x) * rs * w0[0] * bf_lo(g0.x), bf_hi(o0.x) * rs * w0[1] * bf_hi(g0.x)); r0.y = pk2(bf_lo(o0.y) * rs * w0[2] * bf_lo(g0.y), bf_hi(o0.y) * rs * w0[3] * bf_hi(g0.y));
            r0.z = pk2(bf_lo(o0.z) * rs * w1[0] * bf_lo(g0.z), bf_hi(o0.z) * rs * w1[1] * bf_hi(g0.z)); r0.w = pk2(bf_lo(o0.w) * rs * w1[2] * bf_lo(g0.w), bf_hi(o0.w) * rs * w1[3] * bf_hi(g0.w));
            r1.x = pk2(bf_lo(o1.x) * rs * w2[0] * bf_lo(g1.x), bf_hi(o1.x) * rs * w2[1] * bf_hi(g1.x)); r1.y = pk2(bf_lo(o1.y) * rs * w2[2] * bf_lo(g1.y), bf_hi(o1.y) * rs * w2[3] * bf_hi(g1.y));
            r1.z = pk2(bf_lo(o1.z) * rs * w3[0] * bf_lo(g1.z), bf_hi(o1.z) * rs * w3[1] * bf_hi(g1.z)); r1.w = pk2(bf_lo(o1.w) * rs * w3[2] * bf_lo(g1.w), bf_hi(o1.w) * rs * w3[3] * bf_hi(g1.w));
            bf16* op = C.MIX() + row * D + h * 128 + 16 * seg;
            *(v4u*)op = r0; *(v4u*)(op + 8) = r1;
        }
    }
#undef HG_LOAD
    __syncthreads();
}
__device__ __forceinline__ void mixer_phase(Ctx& C, int l) {
    const int NA = C.G - 32;
    if (C.bid < NA) {
        for (int rep = 0; rep < REP_ATT; ++rep)
        for (int k = 0; k * NA < 17 * 32; ++k) {
            const int u = k * NA + ((k & 1) ? (NA - 1 - C.bid) : C.bid);
            if (u < 17 * 32) { const int qi = 16 - u / 32, bh = u % 32; attn_unit(C, l, bh >> 2, bh & 3, qi); }
        }
    } else {
        for (int rep = 0; rep < REP_HG; ++rep) { const int u = C.bid - NA; hgrn_unit(C, l, u >> 2, u & 3); }
    }
}

constexpr int RMAX = 128;
__device__ __forceinline__ void route_phase(Ctx& C, int li) {
    LAS float* rf = (LAS float*)C.lds;
    LAS int* lcnt = (LAS int*)(C.lds + 32768);
    LAS int* lbase = lcnt + 8;
    LAS int* ti = lbase + 8;
    LAS float* tf = (LAS float*)(ti + RMAX * 4);
    const int tid = C.tid, lane = C.lane;
    for (int i = tid; i < 8192; i += 512) rf[i] = C.RF()[li * 8192 + i];
    if (tid < 8) lcnt[tid] = 0;
    __syncthreads();
    const int nrows = (NTOK - C.bid + C.G - 1) / C.G;
    for (int k = C.wave; k < nrows; k += 8) {
        const size_t row = (size_t)C.bid + (size_t)k * C.G;
        f32x4 v[4]; float ss = 0.f;
#pragma unroll
        for (int j = 0; j < 4; ++j) { v[j] = *(const f32x4*)(C.H() + row * D + 4 * lane + 256 * j); ss += (v[j][0] * v[j][0] + v[j][1] * v[j][1]) + (v[j][2] * v[j][2] + v[j][3] * v[j][3]); }
        ss = wave_sum(ss);
        const float rstd = rsqrtf(ss * (1.0f / 1024.0f) + EPS);
        float lg[8];
#pragma unroll
        for (int e = 0; e < 8; ++e) {
            float p = 0.f;
#pragma unroll
            for (int j = 0; j < 4; ++j) { const f32x4 w = *(const LAS f32x4*)(rf + e * 1024 + 4 * lane + 256 * j); p += (v[j][0] * w[0] + v[j][1] * w[1]) + (v[j][2] * w[2] + v[j][3] * w[3]); }
            lg[e] = wave_sum(p) * rstd;
        }
        int e1 = 0; float l1 = lg[0];
#pragma unroll
        for (int e = 1; e < 8; ++e) if (lg[e] > l1) { l1 = lg[e]; e1 = e; }
        int e2 = -1; float l2 = -3.0e38f;
#pragma unroll
        for (int e = 0; e < 8; ++e) if (e != e1 && lg[e] > l2) { l2 = lg[e]; e2 = e; }
        const float g1 = 1.f / (1.f + expf(l2 - l1)), g2 = 1.f - g1;
        if (lane == 0) {
            const int lr1 = __hip_atomic_fetch_add(&lcnt[e1], 1, __ATOMIC_RELAXED, __HIP_MEMORY_SCOPE_WORKGROUP), lr2 = __hip_atomic_fetch_add(&lcnt[e2], 1, __ATOMIC_RELAXED, __HIP_MEMORY_SCOPE_WORKGROUP);
            ti[k * 4 + 0] = e1; ti[k * 4 + 1] = e2; ti[k * 4 + 2] = lr1; ti[k * 4 + 3] = lr2;
            tf[k * 4 + 0] = g1; tf[k * 4 + 1] = g2; tf[k * 4 + 2] = rstd;
        }
    }
    __syncthreads();
    if (tid < 8) lbase[tid] = (int)__hip_atomic_fetch_add(C.ctl() + CW_CNT + (li * 8 + tid) * 64, (unsigned)lcnt[tid], RLX_AGENT);
    __syncthreads();
    for (int k = tid; k < nrows; k += 512) {
        const int row = C.bid + k * C.G;
        const int e1 = ti[k * 4], e2 = ti[k * 4 + 1], r1 = lbase[e1] + ti[k * 4 + 2], r2 = lbase[e2] + ti[k * 4 + 3];
        C.LIST()[(size_t)e1 * NTOK + r1] = row; C.LIST()[(size_t)e2 * NTOK + r2] = row;
        unsigned* inf = C.TINFO() + (size_t)row * 8;
        inf[0] = (unsigned)e1; inf[1] = (unsigned)e2; inf[2] = (unsigned)r1; inf[3] = (unsigned)r2; inf[4] = __builtin_bit_cast(unsigned, tf[k * 4]); inf[5] = __builtin_bit_cast(unsigned, tf[k * 4 + 1]);
        C.RSTD()[row] = tf[k * 4 + 2];
    }
    __syncthreads();
}
__device__ __forceinline__ void load_panels(Ctx& C, int li, LAS int* pst) {
    __syncthreads();
    if (C.tid == 0) { int acc = 0;
        for (int e = 0; e < 8; ++e) { const int c = (int)__hip_atomic_load(C.ctl() + CW_CNT + (li * 8 + e) * 64, RLX_AGENT); pst[e] = acc; pst[16 + e] = c; acc += (c + 255) >> 8; }
        pst[8] = acc; }
    __syncthreads();
}
__device__ __forceinline__ void gather_phase(Ctx& C, int li) {
    LAS int* pst = (LAS int*)C.lds;
    load_panels(C, li, pst);
    const int gw = C.bid * 8 + C.wave, NGW = C.G * 8, lane = C.lane;
    const int nslot = pst[8] * 256;
    for (int s = gw; s < nslot; s += NGW) {
        const int panel = s >> 8; int e = 0;
#pragma unroll
        for (int j = 1; j < 8; ++j) if (panel >= pst[j]) e = j;
        const int rank = s - pst[e] * 256;
        bf16* xp = C.XG() + (size_t)s * D;
        if (rank < pst[16 + e]) {
            const int tok = C.LIST()[(size_t)e * NTOK + rank]; const float r = C.RSTD()[tok];
#pragma unroll
            for (int j = 0; j < 4; ++j) { const f32x4 v = *(const f32x4*)(C.H() + (size_t)tok * D + 4 * lane + 256 * j); v2u w; w.x = pk2(v[0] * r, v[1] * r); w.y = pk2(v[2] * r, v[3] * r); *(v2u*)(xp + 4 * lane + 256 * j) = w; }
        } else {
#pragma unroll
            for (int j = 0; j < 4; ++j) *(v2u*)(xp + 4 * lane + 256 * j) = (v2u){0u, 0u};
        }
    }
}
__device__ __forceinline__ void combine_phase(Ctx& C, int li, bool last) {
    LAS int* pst = (LAS int*)C.lds;
    load_panels(C, li, pst);
    const int gw = C.bid * 8 + C.wave, NGW = C.G * 8, lane = C.lane;
    for (int row = gw; row < NTOK; row += NGW) {
        const unsigned* inf = C.TINFO() + (size_t)row * 8;
        const int e1 = (int)inf[0], e2 = (int)inf[1];
        const size_t s1 = (size_t)pst[e1] * 256 + inf[2], s2 = (size_t)pst[e2] * 256 + inf[3];
        const float g1 = __builtin_bit_cast(float, inf[4]), g2 = __builtin_bit_cast(float, inf[5]);
        f32x4 v[4]; float ss = 0.f;
#pragma unroll
        for (int j = 0; j < 4; ++j) {
            const int col = 4 * lane + 256 * j;
            v[j] = *(const f32x4*)(C.H() + (size_t)row * D + col);
            const v2u a = *(const v2u*)(C.Y() + s1 * D + col), b = *(const v2u*)(C.Y() + s2 * D + col);
            v[j][0] += g1 * bf_lo(a.x) + g2 * bf_lo(b.x); v[j][1] += g1 * bf_hi(a.x) + g2 * bf_hi(b.x);
            v[j][2] += g1 * bf_lo(a.y) + g2 * bf_lo(b.y); v[j][3] += g1 * bf_hi(a.y) + g2 * bf_hi(b.y);
            ss += (v[j][0] * v[j][0] + v[j][1] * v[j][1]) + (v[j][2] * v[j][2] + v[j][3] * v[j][3]);
        }
        ss = wave_sum(ss);
        if (!last) {
#pragma unroll
            for (int j = 0; j < 4; ++j) { const int col = 4 * lane + 256 * j; *(f32x4*)(C.H() + (size_t)row * D + col) = v[j]; v2u w; w.x = pk2(v[j][0], v[j][1]); w.y = pk2(v[j][2], v[j][3]); *(v2u*)(C.HB() + (size_t)row * D + col) = w; }
            if (lane < 16) C.SSQ()[(size_t)row * 16 + lane] = (lane == 0) ? ss : 0.f;
        } else {
            const int b = row / LT, t = row % LT;
            if (t >= LEAD) {
                const float rs = rsqrtf(ss * (1.0f / 1024.0f) + EPS);
#pragma unroll
                for (int j = 0; j < 4; ++j) { const int col = 4 * lane + 256 * j; const f32x4 fw = *(const f32x4*)(C.FNORM() + col);
                    *(f32x4*)(C.out + ((size_t)b * SEQ + (t - LEAD)) * D + col) = (f32x4){v[j][0] * rs * fw[0], v[j][1] * rs * fw[1], v[j][2] * rs * fw[2], v[j][3] * rs * fw[3]}; }
            }
        }
    }
}

__global__ void __launch_bounds__(512, 2) mk_fwd(Args args) {
    extern __shared__ __attribute__((aligned(16))) unsigned char lds[];
    Ctx C;
    C.lds = (LAS unsigned char*)lds;
    C.tid = threadIdx.x; C.lane = C.tid & 63; C.wave = __builtin_amdgcn_readfirstlane(C.tid >> 6); C.G = gridDim.x; C.bid = blockIdx.x;
    unsigned char* ws = args.ws; C.ws = ws; C.out = args.out;
    volatile LAS unsigned* MISC = (volatile LAS unsigned*)(C.lds + MISC_OFF);
    for (int u = C.tid; u < (LDS_BYTES - RING_BYTES) / 4; u += 512) ((LAS unsigned*)(C.lds + RING_BYTES))[u] = 0u;
    __syncthreads();
    const int lo = args.ph_lo, hi = args.ph_hi;
    const bool multi = (hi - lo) > 1;
    XcdBarrier bar; bar.bar = (unsigned*)(C.ctl() + CW_BAR); bar.x = 0; bar.st = nullptr;
    if (multi) bar = xcd_barrier_post((unsigned*)(C.ctl() + CW_BAR), MISC + 8);
#define PHASE_CTX(P) Ctx P = C; { unsigned char* w_ = C.ws; asm volatile("" : "+s"(w_)); P.ws = w_; int t_ = C.tid; asm volatile("" : "+v"(t_)); P.tid = t_; P.lane = t_ & 63; P.wave = __builtin_amdgcn_readfirstlane(t_ >> 6); int g_ = C.G, b_ = C.bid; asm volatile("" : "+s"(g_), "+s"(b_)); P.G = g_; P.bid = b_; }
#define IN(k) (lo_l <= (k) && (k) < hi_l)
#define SEAM(k) do { if ((k) + 1 < hi_l) xcd_barrier(bar); } while (0)

    { int lo_l = lo, hi_l = hi; asm volatile("" : "+s"(lo_l), "+s"(hi_l));
      if (IN(0)) { for (int rep = 0; rep < REP_PRO; ++rep) { PHASE_CTX(P); prologue_phase(P, args); SEAM(0); } } }

    for (int l = 0; l < DEPTH; ++l) {
        int lo_l = lo, hi_l = hi; asm volatile("" : "+s"(lo_l), "+s"(hi_l));
        const int pb = 1 + 8 * l, li = l >> 1; const bool moe = (l & 1) != 0;
        if (IN(pb + 0)) for (int rep = 0; rep < REP_PROJ; ++rep) {
            PHASE_CTX(P);
            pg8::Gemm g{P.HB(), (const bf16*)(P.ws + WS_WIN) + (size_t)l * WIN * D, NTOK, WIN, D, 0};
            pg8::StaticOrder S; S.init(NTOK, WIN, P.G, P.bid);
            EpiProj E{P.PROJ(), P.LOGF(), P.SSQ(), P.LB() + l * 512};
            pg8::gemm_phase<EpiProj, pg8::StaticOrder, true, true>(P.lds, g, S, E);
            SEAM(pb + 0);
        }
        if (IN(pb + 1)) for (int rep = 0; rep < REP_MIX; ++rep) { PHASE_CTX(P); mixer_phase(P, l); SEAM(pb + 1); }
        if (IN(pb + 2)) {
            PHASE_CTX(P);
            pg8::Gemm g{P.MIX(), (const bf16*)(P.ws + WS_WOUT) + (size_t)l * D * D, NTOK, D, D, 0};
            pg8::StaticOrder S; S.init(NTOK, D, P.G, P.bid);
            EpiResid E{P.H(), P.HB(), P.SSQ()};
            pg8::gemm_phase<EpiResid, pg8::StaticOrder, true, true>(P.lds, g, S, E);
            SEAM(pb + 2);
        }
        if (!moe) {
            if (IN(pb + 5)) for (int rep = 0; rep < REP_FF1; ++rep) {
                PHASE_CTX(P);
                pg8::Gemm g{P.HB(), (const bf16*)(P.ws + WS_WD13) + (size_t)li * 2 * FFD * D, NTOK, 2 * FFD, D, 0};
                pg8::StaticOrder S; S.init(NTOK, 2 * FFD, P.G, P.bid);
                EpiGLU E{P.T(), FFD, P.SSQ()};
                pg8::gemm_phase<EpiGLU, pg8::StaticOrder, true, true>(P.lds, g, S, E);
                SEAM(pb + 5);
            }
            if (IN(pb + 6)) {
                PHASE_CTX(P);
                pg8::Gemm g{P.T(), (const bf16*)(P.ws + WS_WD2) + (size_t)li * D * FFD, NTOK, D, FFD, 0};
                pg8::StaticOrder S; S.init(NTOK, D, P.G, P.bid);
                EpiResid E{P.H(), P.HB(), P.SSQ()};
                pg8::gemm_phase<EpiResid, pg8::StaticOrder, true, true>(P.lds, g, S, E);
                SEAM(pb + 6);
            }
        } else {
            if (IN(pb + 3)) { PHASE_CTX(P); route_phase(P, li); SEAM(pb + 3); }
            if (IN(pb + 4)) for (int rep = 0; rep < REP_GATHER; ++rep) { PHASE_CTX(P); gather_phase(P, li); SEAM(pb + 4); }
            if (IN(pb + 5)) for (int rep = 0; rep < REP_FF1; ++rep) {
                PHASE_CTX(P);
                LAS int* pst = (LAS int*)(P.lds + RING_BYTES + 1024);
                load_panels(P, li, pst);
#define PS(i) __builtin_amdgcn_readfirstlane(pst[i])
                pg8::GroupedOrder S{PS(0), PS(1), PS(2), PS(3), PS(4), PS(5), PS(6), PS(7), PS(8), 2 * FFE / 256, P.G, P.bid};
                pg8::Gemm g{P.XG(), (const bf16*)(P.ws + WS_WM13) + (size_t)li * 8 * 2 * FFE * D, 0, 2 * FFE, D, (size_t)2 * FFE * D * 2};
                EpiGLU E{P.T(), FFE, nullptr};
                pg8::gemm_phase<EpiGLU, pg8::GroupedOrder, true, true>(P.lds, g, S, E);
                SEAM(pb + 5);
            }
            if (IN(pb + 6)) {
                PHASE_CTX(P);
                LAS int* pst = (LAS int*)(P.lds + RING_BYTES + 1024);
                load_panels(P, li, pst);
                pg8::GroupedOrder S{PS(0), PS(1), PS(2), PS(3), PS(4), PS(5), PS(6), PS(7), PS(8), D / 256, P.G, P.bid};
                pg8::Gemm g{P.T(), (const bf16*)(P.ws + WS_WM2) + (size_t)li * 8 * D * FFE, 0, D, FFE, (size_t)D * FFE * 2};
                EpiY E{P.Y()};
                pg8::gemm_phase<EpiY, pg8::GroupedOrder, true, true>(P.lds, g, S, E);
                SEAM(pb + 6);
            }
#undef PS
            if (IN(pb + 7)) { PHASE_CTX(P); combine_phase(P, li, l == DEPTH - 1); SEAM(pb + 7); }
        }
    }
#undef IN
#undef SEAM
#undef PHASE_CTX
}

extern "C" void kernel_launch(void* const* d_in, const int* in_sizes, int n_in, void* d_out, int out_size, void* d_ws, size_t ws_size, hipStream_t stream) {
    static int grid = 0;
    if (grid == 0) {
        if (n_in != 19 || out_size != NB * SEQ * D || ws_size < WS_END) { fprintf(stderr, "kernel_launch: unexpected shapes (n_in %d, out %d, ws %zu < %zu); nothing launched\n", n_in, out_size, ws_size, (size_t)WS_END); grid = -1; return; }
        int dev = 0, cus = 0, per_cu = 0;
        if (hipGetDevice(&dev) != hipSuccess || hipDeviceGetAttribute(&cus, hipDeviceAttributeMultiprocessorCount, dev) != hipSuccess) { grid = -1; return; }
        if (hipFuncSetAttribute((const void*)mk_fwd, hipFuncAttributeMaxDynamicSharedMemorySize, LDS_BYTES) != hipSuccess) { fprintf(stderr, "kernel_launch: hipFuncSetAttribute failed\n"); grid = -1; return; }
        if (hipOccupancyMaxActiveBlocksPerMultiprocessor(&per_cu, (const void*)mk_fwd, 512, LDS_BYTES) != hipSuccess || per_cu < 1) { fprintf(stderr, "kernel_launch: occupancy query says %d blocks per CU\n", per_cu); }
        (void)hipGetLastError();
        grid = cus;
    }
    if (grid < 0) return;
    if (hipMemsetAsync((char*)d_ws + WS_CTL, 0, CTL_ZERO_BYTES, stream) != hipSuccess) return;
    Args a{};
    for (int i = 0; i < 19; ++i) a.in[i] = (const float*)d_in[i];
    a.out = (float*)d_out; a.ws = (unsigned char*)d_ws;
#if MK_ONE_LAUNCH
    a.ph_lo = 0; a.ph_hi = NPHASE;
    hipLaunchKernelGGL(mk_fwd, dim3(grid), dim3(512), LDS_BYTES, stream, a);
#else
    for (int p = 0; p < NPHASE; ++p) {
        if (p > 0) { const int l = (p - 1) / 8, k = (p - 1) % 8; const bool moe = (l & 1) != 0; if (!moe && (k == 3 || k == 4 || k == 7)) continue; }
        a.ph_lo = p; a.ph_hi = p + 1;
        hipLaunchKernelGGL(mk_fwd, dim3(grid), dim3(512), LDS_BYTES, stream, a);
    }
#endif
}
```

```cpp
#include <hip/hip_runtime.h>
#include <cstdio>
#include <cstdint>

#ifndef REP_ATT
#define REP_ATT 1
#endif
#ifndef REP_HG
#define REP_HG 1
#endif
#ifndef PROBE_PROJ_NOEPI
#define PROBE_PROJ_NOEPI 0
#endif
#ifndef PROBE_WOUT_NOEPI
#define PROBE_WOUT_NOEPI 0
#endif
#ifndef PROBE_FF2_NOEPI
#define PROBE_FF2_NOEPI 0
#endif
#ifndef REP_PRO
#define REP_PRO 1
#endif
#ifndef REP_PROJ
#define REP_PROJ 1
#endif
#ifndef REP_MIX
#define REP_MIX 1
#endif
#ifndef REP_FF1
#define REP_FF1 1
#endif
#ifndef REP_GATHER
#define REP_GATHER 1
#endif
#ifndef MK_ONE_LAUNCH
#define MK_ONE_LAUNCH 1
#endif

namespace pg8 {
#define PG8_LAS __attribute__((address_space(3)))
typedef unsigned short bf16_t;
typedef short bf16x8 __attribute__((ext_vector_type(8)));
typedef float f32x4 __attribute__((ext_vector_type(4)));
typedef unsigned u32x4 __attribute__((ext_vector_type(4)));
typedef unsigned u32x2 __attribute__((ext_vector_type(2)));
constexpr int BM = 256, BK = 64, HALF = 128, HTB = HALF * BK * 2  , STAGE_BYTES = 8 * HTB, NXCD = 8, WGM = 8;

__host__ __device__ __forceinline__ int lds_byte(int r, int c) { const int st = (r >> 4) * 2 + (c >> 5), rr = r & 15, cc = c & 31, ob = rr * 64 + cc * 2; return st * 1024 + (ob ^ (((ob >> 9) & 1) << 5)); }
__host__ __device__ __forceinline__ void stage_rc(int b, int& R, int& C) { const int st = b / 1024, sb = b % 1024, swz = sb ^ (((sb >> 9) & 1) << 5); R = (st >> 1) * 16 + swz / 64; C = (st & 1) * 32 + (swz % 64) / 2; }
__host__ __device__ __forceinline__ int perm32(int rho) { const int n = rho >> 4, i = rho & 15; return 8 * (i >> 2) + 4 * n + (i & 3); }

struct Unit { int pm, pn, e; };
struct Gemm { const bf16_t* A; const bf16_t* Bt; int M, N, K; size_t bstride; };

struct StaticOrder {
    int nM, nN, nwg, G, c;
    __host__ __device__ void init(int M, int N, int G_, int c_) { nM = M / BM; nN = N / BM; nwg = nM * nN; G = G_; c = c_; }
    __host__ __device__ bool next(int i, Unit& u) const {
        const long L = (long)i * G + c; if (L >= nwg) return false;
        int wgid = (int)L; { const int q = nwg / NXCD, r = nwg % NXCD, xcd = wgid % NXCD, off = wgid / NXCD; wgid = (xcd < r ? xcd * (q + 1) : r * (q + 1) + (xcd - r) * q) + off; }
        const int nig = WGM * nN, gid = wgid / nig, fm = gid * WGM, gsz = (nM - fm) < WGM ? (nM - fm) : WGM;
        u.pm = fm + ((wgid % nig) % gsz); u.pn = (wgid % nig) / gsz; u.e = 0; return true;
    }
    __device__ __forceinline__ void a_ready(const Unit&) const {}
    __device__ __forceinline__ void done(const Unit&) const {}
};
struct GroupedPanelOrder {
    int p1, p2, p3, p4, p5, p6, p7, plim, nN, G, c;
    __device__ __forceinline__ bool next(int i, Unit& u) const {
        const int L = i * G + c; if (L >= plim * nN) return false;
        const int pm = L / nN; u.pm = pm; u.pn = L - pm * nN;
        u.e = (pm >= p1) + (pm >= p2) + (pm >= p3) + (pm >= p4) + (pm >= p5) + (pm >= p6) + (pm >= p7); return true;
    }
    __device__ __forceinline__ void a_ready(const Unit&) const {}
    __device__ __forceinline__ void done(const Unit&) const {}
};
struct GroupedOrder {
    int p0, p1, p2, p3, p4, p5, p6, p7, p8, nN, G, c;
    __device__ __forceinline__ bool next(int i, Unit& u) const {
        const int L = i * G + c; if (L >= p8 * nN) return false;
        int e = 0, ps = 0, pe = p1;
        if (L >= p1 * nN) { e = 1; ps = p1; pe = p2; }
        if (L >= p2 * nN) { e = 2; ps = p2; pe = p3; }
        if (L >= p3 * nN) { e = 3; ps = p3; pe = p4; }
        if (L >= p4 * nN) { e = 4; ps = p4; pe = p5; }
        if (L >= p5 * nN) { e = 5; ps = p5; pe = p6; }
        if (L >= p6 * nN) { e = 6; ps = p6; pe = p7; }
        if (L >= p7 * nN) { e = 7; ps = p7; pe = p8; }
        const int rem = L - ps * nN, R = pe - ps;
        u.e = e; u.pn = rem / R; u.pm = ps + rem % R; return true;
    }
    __device__ __forceinline__ void a_ready(const Unit&) const {}
    __device__ __forceinline__ void done(const Unit&) const {}
};

__device__ __forceinline__ unsigned cvt_pk_bf16(float lo, float hi) { unsigned r; asm volatile("v_cvt_pk_bf16_f32 %0, %1, %2" : "=v"(r) : "v"(lo), "v"(hi)); return r; }

template <class Epi, class Sched, bool ALIGN_EPI = false, bool SP2 = false>
__device__ __forceinline__ void gemm_phase(PG8_LAS unsigned char* lds, const Gemm g, const Sched& S, const Epi& E) {
    int tid_l = threadIdx.x; asm volatile("" : "+v"(tid_l));
    const int tid = tid_l, wid = __builtin_amdgcn_readfirstlane(tid >> 6), lane = tid & 63, wr = wid >> 2, wc = wid & 3, fr = lane & 15, fq = lane >> 4;
    const int K = g.K, nt = K / BK;
    unsigned voffA[2], voffB[2];
#pragma unroll
    for (int i = 0; i < 2; ++i) { int R, C; stage_rc(tid * 16 + i * 8192, R, C); const int Rb = Epi::PERM ? ((R & ~31) + perm32(R & 31)) : R;
        voffA[i] = (unsigned)(R * K + C) * 2u; voffB[i] = (unsigned)(Rb * K + C) * 2u; }
    const size_t kstep = (size_t)(BK * 2);
    const size_t hstep = (size_t)HALF * K * 2;
    const size_t tstep = 2 * hstep;
    const unsigned ldsw = (unsigned)wid * 1024u;
    const int aoff = lds_byte(wr * 64 + fr, fq * 8), boff = lds_byte(wc * 32 + fr, fq * 8);
#define PG8_SA(b, h) (((b) * 2 + (h)) * HTB)
#define PG8_SB(b, h) ((4 + (b) * 2 + (h)) * HTB)
#define PG8_STAGE(bufoff, gbase, voff) do { _Pragma("unroll") for (int _i = 0; _i < 2; ++_i) \
        __builtin_amdgcn_global_load_lds((const unsigned*)((const char*)(gbase) + (voff)[_i]), (PG8_LAS unsigned*)(lds + (bufoff) + ldsw + _i * 8192), 16, 0, 0); } while (0)
#define PG8_LDA(dst, b, h) do { _Pragma("unroll") for (int m = 0; m < 4; ++m) _Pragma("unroll") for (int k = 0; k < 2; ++k) dst[m][k] = *(const PG8_LAS bf16x8*)(lds + PG8_SA(b, h) + aoff + m * 2048 + k * 1024); } while (0)
#define PG8_LDB(dst, b, h) do { _Pragma("unroll") for (int n = 0; n < 2; ++n) _Pragma("unroll") for (int k = 0; k < 2; ++k) dst[n][k] = *(const PG8_LAS bf16x8*)(lds + PG8_SB(b, h) + boff + n * 2048 + k * 1024); } while (0)
#define PG8_MMA(ai, bj, At, Bt) do { __builtin_amdgcn_s_setprio(1); _Pragma("unroll") for (int m = 0; m < 4; ++m) _Pragma("unroll") for (int n = 0; n < 2; ++n) _Pragma("unroll") for (int k = 0; k < 2; ++k) \
        acc[ai][bj][m][n] = __builtin_amdgcn_mfma_f32_16x16x32_bf16(Bt[n][k], At[m][k], acc[ai][bj][m][n], 0, 0, 0); __builtin_amdgcn_s_setprio(0); } while (0)
#define PG8_WAIT_V(n) asm volatile("s_waitcnt vmcnt(" #n ")" ::: "memory")
#define PG8_WAIT_L(n) asm volatile("s_waitcnt lgkmcnt(" #n ")" ::: "memory")
#define PG8_BAR __builtin_amdgcn_s_barrier()
#define PG8_SCHED __builtin_amdgcn_sched_barrier(0)
    Unit cur, nxt; int ui = 0;
    if (!S.next(0, cur)) return;
    f32x4 acc[2][2][4][2];
#pragma unroll
    for (int a = 0; a < 2; ++a)
#pragma unroll
        for (int b = 0; b < 2; ++b)
#pragma unroll
            for (int m = 0; m < 4; ++m)
#pragma unroll
                for (int n = 0; n < 2; ++n) acc[a][b][m][n] = (f32x4){0.f, 0.f, 0.f, 0.f};
    bf16x8 At[4][2], B0[2][2], B1[2][2];
    const char* cA = (const char*)g.A + (size_t)cur.pm * tstep; const char* cB = (const char*)g.Bt + (size_t)cur.e * g.bstride + (size_t)cur.pn * tstep;
    S.a_ready(cur);
    if constexpr (SP2) {
        PG8_STAGE(PG8_SB(0, 0), cB, voffB); PG8_STAGE(PG8_SB(0, 1), cB + hstep, voffB); PG8_STAGE(PG8_SA(0, 0), cA, voffA); PG8_STAGE(PG8_SA(0, 1), cA + hstep, voffA);
        if (wr == 1) PG8_BAR;
        PG8_WAIT_V(2); PG8_BAR;
        PG8_STAGE(PG8_SB(1, 0), cB + kstep, voffB); PG8_STAGE(PG8_SA(1, 0), cA + kstep, voffA); PG8_STAGE(PG8_SB(1, 1), cB + hstep + kstep, voffB);
        PG8_WAIT_V(6); PG8_BAR;
    } else {
        PG8_STAGE(PG8_SB(0, 0), cB, voffB); PG8_STAGE(PG8_SA(0, 0), cA, voffA); PG8_STAGE(PG8_SB(0, 1), cB + hstep, voffB); PG8_STAGE(PG8_SA(0, 1), cA + hstep, voffA);
        if (wr == 1) PG8_BAR;
        PG8_WAIT_V(4); PG8_BAR;
        PG8_STAGE(PG8_SB(1, 0), cB + kstep, voffB); PG8_STAGE(PG8_SA(1, 0), cA + kstep, voffA); PG8_STAGE(PG8_SB(1, 1), cB + hstep + kstep, voffB);
        PG8_WAIT_V(6); PG8_BAR;
    }
    for (;;) {
        const bool has_next = S.next(ui + 1, nxt);
        const char* nA = has_next ? (const char*)g.A + (size_t)nxt.pm * tstep : cA; const char* nB = has_next ? (const char*)g.Bt + (size_t)nxt.e * g.bstride + (size_t)nxt.pn * tstep : cB;
        for (int t = 0; t < nt; t += 2) {
            const bool last = (t == nt - 2);
            const char* a1 = cA + (size_t)(t + 1) * kstep;
            const char* a2 = last ? nA : cA + (size_t)(t + 2) * kstep; const char* b2 = last ? nB : cB + (size_t)(t + 2) * kstep;
            const char* a3 = a2 + kstep; const char* b3 = b2 + kstep;
            if (last && has_next) S.a_ready(nxt);
            if constexpr (SP2) {
            PG8_LDB(B0, 0, 0); PG8_LDB(B1, 0, 1); PG8_SCHED; PG8_LDA(At, 0, 0); PG8_STAGE(PG8_SA(1, 1), a1 + hstep, voffA);
            PG8_WAIT_V(8); PG8_WAIT_L(0); PG8_BAR; PG8_MMA(0, 0, At, B0); PG8_MMA(0, 1, At, B1); PG8_BAR; PG8_SCHED;
            PG8_LDA(At, 0, 1); PG8_STAGE(PG8_SB(0, 0), b2, voffB); PG8_STAGE(PG8_SB(0, 1), b2 + hstep, voffB); PG8_STAGE(PG8_SA(0, 0), a2, voffA);
            PG8_WAIT_V(8); PG8_WAIT_L(0); PG8_BAR; PG8_MMA(1, 0, At, B0); PG8_MMA(1, 1, At, B1); PG8_BAR; PG8_SCHED;
            PG8_LDB(B0, 1, 0); PG8_LDB(B1, 1, 1); PG8_SCHED; PG8_LDA(At, 1, 0); PG8_STAGE(PG8_SA(0, 1), a2 + hstep, voffA);
            PG8_WAIT_V(8); PG8_WAIT_L(0); PG8_BAR; PG8_MMA(0, 0, At, B0); PG8_MMA(0, 1, At, B1); PG8_BAR; PG8_SCHED;
            PG8_LDA(At, 1, 1); PG8_STAGE(PG8_SB(1, 0), b3, voffB); PG8_STAGE(PG8_SB(1, 1), b3 + hstep, voffB); PG8_STAGE(PG8_SA(1, 0), a3, voffA);
            PG8_WAIT_V(8); PG8_WAIT_L(0); PG8_BAR; PG8_MMA(1, 0, At, B0); PG8_MMA(1, 1, At, B1); PG8_BAR; PG8_SCHED;
            } else {
            PG8_LDB(B0, 0, 0); PG8_SCHED; PG8_LDA(At, 0, 0); PG8_STAGE(PG8_SA(1, 1), a1 + hstep, voffA);
            PG8_WAIT_L(8); PG8_BAR; PG8_WAIT_L(0); PG8_MMA(0, 0, At, B0); PG8_BAR; PG8_SCHED;
            PG8_LDB(B1, 0, 1); PG8_STAGE(PG8_SB(0, 0), b2, voffB);
            PG8_BAR; PG8_WAIT_L(0); PG8_MMA(0, 1, At, B1); PG8_BAR;
            PG8_LDA(At, 0, 1); PG8_STAGE(PG8_SA(0, 0), a2, voffA);
            PG8_BAR; PG8_WAIT_L(0); PG8_MMA(1, 0, At, B0); PG8_BAR; PG8_SCHED;
            PG8_STAGE(PG8_SB(0, 1), b2 + hstep, voffB);
            PG8_WAIT_V(6); PG8_BAR; PG8_MMA(1, 1, At, B1); PG8_BAR;
            PG8_LDB(B0, 1, 0); PG8_SCHED; PG8_LDA(At, 1, 0); PG8_STAGE(PG8_SA(0, 1), a2 + hstep, voffA);
            PG8_WAIT_L(8); PG8_BAR; PG8_WAIT_L(0); PG8_MMA(0, 0, At, B0); PG8_BAR; PG8_SCHED;
            PG8_LDB(B1, 1, 1); PG8_STAGE(PG8_SB(1, 0), b3, voffB);
            PG8_BAR; PG8_WAIT_L(0); PG8_MMA(0, 1, At, B1); PG8_BAR;
            PG8_LDA(At, 1, 1); PG8_STAGE(PG8_SA(1, 0), a3, voffA);
            PG8_BAR; PG8_WAIT_L(0); PG8_MMA(1, 0, At, B0); PG8_BAR; PG8_SCHED;
            PG8_STAGE(PG8_SB(1, 1), b3 + hstep, voffB);
            PG8_WAIT_V(6); PG8_BAR; PG8_MMA(1, 1, At, B1); PG8_BAR;
            }
        }
        if constexpr (ALIGN_EPI) { if (wr == 0) PG8_BAR; }
        if constexpr (!Epi::AFTER_DRAIN) { E(acc, cur, wr, wc, fr, fq); S.done(cur); }
        if (!has_next) break;
#pragma unroll
        for (int a = 0; a < 2; ++a)
#pragma unroll
            for (int b = 0; b < 2; ++b)
#pragma unroll
                for (int m = 0; m < 4; ++m)
#pragma unroll
                    for (int n = 0; n < 2; ++n) acc[a][b][m][n] = (f32x4){0.f, 0.f, 0.f, 0.f};
        cur = nxt; cA = nA; cB = nB; ++ui;
        if constexpr (ALIGN_EPI) { if (wr == 1) PG8_BAR; }
    }
    PG8_WAIT_V(0);
    if constexpr (!ALIGN_EPI) { if (wr == 0) PG8_BAR; }
    PG8_BAR;
    if constexpr (Epi::AFTER_DRAIN) { E.fused(acc, cur, wr, wc, fr, fq, lds, wid, lane); S.done(cur); }
#undef PG8_SA
#undef PG8_SB
#undef PG8_STAGE
#undef PG8_LDA
#undef PG8_LDB
#undef PG8_MMA
#undef PG8_WAIT_V
#undef PG8_WAIT_L
#undef PG8_BAR
#undef PG8_SCHED
}

}

constexpr int D = 1024, NB = 8, SEQ = 2048, DEPTH = 4, LEAD = 128, FIRSTV = 112, LT = LEAD + SEQ, NTOK = NB * LT;
constexpr int WIN = 3584, FFD = 2816, FFE = 3584, NE = 8, MAXSLOT = 36864;
constexpr float EPS = 1e-6f;
constexpr int NPHASE = 1 + 8 * DEPTH;
constexpr int MAINROWS = (NTOK / (64 * 256)) * (64 * 256);

constexpr size_t MiB = 1u << 20;
constexpr size_t WS_CTL = 0, CTL_ZERO_BYTES = MiB;
constexpr size_t WS_TAB = 1 * MiB;
constexpr size_t WS_WIN = 2 * MiB;
constexpr size_t WS_WOUT = WS_WIN + 28 * MiB;
constexpr size_t WS_WD13 = WS_WOUT + 8 * MiB;
constexpr size_t WS_WD2 = WS_WD13 + 22 * MiB;
constexpr size_t WS_WM13 = WS_WD2 + 11 * MiB;
constexpr size_t WS_WM2 = WS_WM13 + 224 * MiB;
constexpr size_t WS_H = WS_WM2 + 112 * MiB;
constexpr size_t WS_HB = WS_H + 68 * MiB;
constexpr size_t WS_SSQ = WS_HB + 34 * MiB;
constexpr size_t WS_ROUTE = WS_SSQ + 2 * MiB;
constexpr size_t WS_ACT = WS_ROUTE + 2 * MiB;
constexpr size_t WS_XG = WS_ACT + 252 * MiB;
constexpr size_t WS_END = WS_XG + 72 * MiB;
constexpr size_t ACT_PROJ = 0, ACT_LOGF = 119 * MiB, ACT_MIX = 153 * MiB;
constexpr size_t TAB_LB = 0, TAB_BIAS = 8192, TAB_LAM = 12288, TAB_SUBLN = 12544, TAB_HGNW = 14592, TAB_RF = 20480, TAB_FNORM = 20480 + 65536;
constexpr size_t ROUTE_INFO = 0, ROUTE_LIST = 640 * 1024, ROUTE_RSTD = 1280 * 1024;
constexpr int CW_TMO = 0, CW_BAR = 4096, CW_CNT = 8192;

constexpr int RING_BYTES = 131072, MISC_OFF = RING_BYTES + 320, LDS_BYTES = 147456;

#define GAS __attribute__((address_space(1)))
#define LAS __attribute__((address_space(3)))
typedef unsigned short bf16;
typedef unsigned v4u __attribute__((ext_vector_type(4)));
typedef unsigned v2u __attribute__((ext_vector_type(2)));
typedef float f32x4 __attribute__((ext_vector_type(4)));
typedef GAS unsigned gu32;
#define RLX_AGENT __ATOMIC_RELAXED, __HIP_MEMORY_SCOPE_AGENT
#define LDS_WAIT() asm volatile("s_waitcnt lgkmcnt(0)" ::: "memory")
__device__ __forceinline__ unsigned f2bf(float f) { unsigned u = __builtin_bit_cast(unsigned, f); return (u + 0x7fffu + ((u >> 16) & 1u)) >> 16; }
__device__ __forceinline__ unsigned pk2(float lo, float hi) { return f2bf(lo) | (f2bf(hi) << 16); }
__device__ __forceinline__ float bf_lo(unsigned w) { return __builtin_bit_cast(float, w << 16); }
__device__ __forceinline__ float bf_hi(unsigned w) { return __builtin_bit_cast(float, w & 0xffff0000u); }
__device__ __forceinline__ float silu_f(float x) { return x * __builtin_amdgcn_rcpf(1.f + __expf(-x)); }
__device__ __forceinline__ float wave_sum(float v) {
#pragma unroll
    for (int o = 1; o < 64; o <<= 1) v += __shfl_xor(v, o);
    return v;
}

#define XB_TMO      128
#define XB_XCNT(j)  (256  + 64 * (j))
#define XB_XSUB(j)  (1280 + 64 * (j))
#define XB_XGEN(j)  (2304 + 64 * (j))
#define XB_TOP      3328
#define XB_TOPGEN   3392
#define XCD_BAR_WORDS 3456
#define XB_SPIN_CAP (1u << 18)

__device__ __forceinline__ unsigned xb_ld(unsigned* p)              { return __hip_atomic_load(p, __ATOMIC_RELAXED, __HIP_MEMORY_SCOPE_AGENT); }
__device__ __forceinline__ unsigned xb_add(unsigned* p, unsigned v) { return __hip_atomic_fetch_add(p, v, __ATOMIC_RELAXED, __HIP_MEMORY_SCOPE_AGENT); }
__device__ __forceinline__ unsigned xb_xcc_id() { return (unsigned)__builtin_amdgcn_s_getreg((3 << 11) | 20) & 0xFu; }
#define XB_SPIN(cond, bar) do { unsigned _sp = 0; while (cond) { __builtin_amdgcn_s_sleep(1); \
    if ((++_sp & 255u) == 0u) { if (xb_ld(&(bar)[XB_TMO])) break; if (_sp > XB_SPIN_CAP) { atomicAdd(&(bar)[XB_TMO], 1u); break; } } } } while (0)

struct XcdBarrier {
    unsigned* bar; unsigned x;
    volatile LAS unsigned* st;
};

__device__ __forceinline__ XcdBarrier xcd_barrier_post(unsigned* bar, volatile LAS unsigned* st) {
    XcdBarrier b; b.bar = bar; b.x = xb_xcc_id(); b.st = st;
    if (threadIdx.x == 0) (void)xb_add(&bar[XB_XCNT(b.x)], 1u);
    return b;
}
__device__ __forceinline__ void xcd_barrier_complete(unsigned* bar, unsigned x, unsigned& nloc, unsigned& nx) {
    const unsigned G = gridDim.x * gridDim.y * gridDim.z;
    unsigned sum, cnt, mine, sp = 0u;
    for (;;) {
        sum = 0u; cnt = 0u; mine = 0u;
#pragma unroll
        for (unsigned j = 0; j < 16; ++j) { const unsigned c = xb_ld(&bar[XB_XCNT(j)]); sum += c; cnt += (c > 0u) ? 1u : 0u; mine = (j == x) ? c : mine; }
        if (sum == G) break;
        __builtin_amdgcn_s_sleep(1);
        if ((++sp & 255u) == 0u) { if (xb_ld(&bar[XB_TMO])) break; if (sp > XB_SPIN_CAP) { atomicAdd(&bar[XB_TMO], 1u); break; } }
    }
    nloc = mine > 0u ? mine : 1u; nx = cnt > 0u ? cnt : 1u;
}

__device__ __forceinline__ void xcd_barrier(const XcdBarrier& b) {
    asm volatile("s_waitcnt vmcnt(0)" ::: "memory");
    __syncthreads();
    if (threadIdx.x == 0) {
        unsigned* bar = b.bar;
        __builtin_amdgcn_s_waitcnt(0);
        unsigned nloc = b.st[0], nx = b.st[1];
        if (nloc == 0u) { xcd_barrier_complete(bar, b.x, nloc, nx); b.st[0] = nloc; b.st[1] = nx; }
        const unsigned old = xb_add(&bar[XB_XSUB(b.x)], 1u);
        const unsigned gen = old / nloc;
        if (old + 1u == (gen + 1u) * nloc) {
            __builtin_amdgcn_fence(__ATOMIC_RELEASE, "agent");
            asm volatile("s_waitcnt vmcnt(0)" ::: "memory");
            const unsigned og = xb_add(&bar[XB_TOP], 1u);
            const unsigned tg = og / nx;
            if (og + 1u == (tg + 1u) * nx) xb_add(&bar[XB_TOPGEN], 1u);
            else XB_SPIN(xb_ld(&bar[XB_TOPGEN]) == tg, bar);
            __builtin_amdgcn_fence(__ATOMIC_ACQUIRE, "agent");
            xb_add(&bar[XB_XGEN(b.x)], 1u);
            asm volatile("s_waitcnt vmcnt(0)" ::: "memory");
        } else {
            XB_SPIN(xb_ld(&bar[XB_XGEN(b.x)]) == gen, bar);
            __builtin_amdgcn_fence(__ATOMIC_ACQUIRE, "agent");
            asm volatile("s_waitcnt vmcnt(0)" ::: "memory");
        }
    }
    __syncthreads();
}


static __device__ const unsigned char T5B[129] = {0, 1, 2, 3, 4, 5, 6, 7, 8, 9, 10, 11, 12, 13, 14, 15, 16, 16, 16, 17, 17, 18, 18, 18, 19, 19, 19, 20, 20, 20, 20, 21, 21, 21, 21, 22, 22, 22, 22, 22, 23, 23, 23, 23, 23, 23, 24, 24, 24, 24, 24, 24, 25, 25, 25, 25, 25, 25, 25, 26, 26, 26, 26, 26, 26, 26, 26, 27, 27, 27, 27, 27, 27, 27, 27, 27, 27, 28, 28, 28, 28, 28, 28, 28, 28, 28, 28, 29, 29, 29, 29, 29, 29, 29, 29, 29, 29, 29, 29, 30, 30, 30, 30, 30, 30, 30, 30, 30, 30, 30, 30, 30, 30, 31, 31, 31, 31, 31, 31, 31, 31, 31, 31, 31, 31, 31, 31, 31, 31};

struct Ctx {
    LAS unsigned char* lds;
    int tid, lane, wave, G, bid;
    float* out;
    unsigned char* ws;
    __device__ __forceinline__ gu32* ctl() const { return (gu32*)(ws + WS_CTL); }
    __device__ __forceinline__ float* H() const { return (float*)(ws + WS_H); }
    __device__ __forceinline__ bf16* HB() const { return (bf16*)(ws + WS_HB); }
    __device__ __forceinline__ float* SSQ() const { return (float*)(ws + WS_SSQ); }
    __device__ __forceinline__ bf16* PROJ() const { return (bf16*)(ws + WS_ACT + ACT_PROJ); }
    __device__ __forceinline__ float* LOGF() const { return (float*)(ws + WS_ACT + ACT_LOGF); }
    __device__ __forceinline__ bf16* MIX() const { return (bf16*)(ws + WS_ACT + ACT_MIX); }
    __device__ __forceinline__ bf16* T() const { return (bf16*)(ws + WS_ACT); }
    __device__ __forceinline__ bf16* XG() const { return (bf16*)(ws + WS_XG); }
    __device__ __forceinline__ bf16* Y() const { return (bf16*)(ws + WS_XG); }
    __device__ __forceinline__ float* LB() const { return (float*)(ws + WS_TAB + TAB_LB); }
    __device__ __forceinline__ float* BIAST() const { return (float*)(ws + WS_TAB + TAB_BIAS); }
    __device__ __forceinline__ float* LAM() const { return (float*)(ws + WS_TAB + TAB_LAM); }
    __device__ __forceinline__ float* RF() const { return (float*)(ws + WS_TAB + TAB_RF); }
    __device__ __forceinline__ float* SUBLN() const { return (float*)(ws + WS_TAB + TAB_SUBLN); }
    __device__ __forceinline__ float* HGNW() const { return (float*)(ws + WS_TAB + TAB_HGNW); }
    __device__ __forceinline__ float* FNORM() const { return (float*)(ws + WS_TAB + TAB_FNORM); }
    __device__ __forceinline__ unsigned* TINFO() const { return (unsigned*)(ws + WS_ROUTE + ROUTE_INFO); }
    __device__ __forceinline__ int* LIST() const { return (int*)(ws + WS_ROUTE + ROUTE_LIST); }
    __device__ __forceinline__ float* RSTD() const { return (float*)(ws + WS_ROUTE + ROUTE_RSTD); }
};
struct Args { const float* in[19]; float* out; unsigned char* ws; int ph_lo, ph_hi; };
enum { IN_X = 0, IN_META, IN_RELB, IN_NMIX, IN_WIN, IN_LBL, IN_HGNW, IN_LAMBDA, IN_SUBLN, IN_WOUT, IN_NFFN, IN_DW1, IN_DW3, IN_DW2, IN_ROUTER, IN_MW1, IN_MW3, IN_MW2, IN_FNORM };

__device__ __forceinline__ v2u pack4(float a, float b, float c, float d) { v2u w; w.x = pg8::cvt_pk_bf16(a, b); w.y = pg8::cvt_pk_bf16(c, d); return w; }
__device__ __forceinline__ float row_rstd(const float* ssq, int row) {
    const f32x4* p = (const f32x4*)(ssq + (size_t)row * 16);
    const f32x4 a = p[0], b = p[1], c = p[2], d = p[3];
    const float s = ((a[0] + a[1]) + (a[2] + a[3])) + ((b[0] + b[1]) + (b[2] + b[3])) + ((c[0] + c[1]) + (c[2] + c[3])) + ((d[0] + d[1]) + (d[2] + d[3]));
    return rsqrtf(s * (1.0f / 1024.0f) + EPS);
}
template <int N> __device__ __forceinline__ float dpp_row_shr(float x) {
    return __builtin_bit_cast(float, __builtin_amdgcn_update_dpp(0, __builtin_bit_cast(int, x), 0x110 + N, 0xf, 0xf, true));
}
struct EpiProj {
    static constexpr bool PERM = true, AFTER_DRAIN = false;
    bf16* proj; float* logfp; const float* ssq; const float* lb;
    template <int AI, int BJ, int NN> __device__ __forceinline__ void hf_block(const pg8::f32x4 (&acc)[2][2][4][2], int row0, int colb) const {
        const int c0 = colb + BJ * 128 + 4 * NN, cc = c0 - 512;
        const f32x4 l0 = *(const f32x4*)(lb + cc);
        float lf[4][4];
#pragma unroll
        for (int m = 0; m < 4; ++m) {
            const int row = row0 + AI * 128 + m * 16;
            const float r = row_rstd(ssq, row);
            const bool valid = (row % LT) >= FIRSTV;
            float kx[4];
#pragma unroll
            for (int j = 0; j < 4; ++j) {
                const float lbv = l0[j];
                const float xx = acc[AI][BJ][m][NN][j] * r;
                const float xc = fminf(fmaxf(xx, -30.f), 30.f);
                const float te = __expf(-xc), sg = __builtin_amdgcn_rcpf(1.f + te);
                float lgf = __logf(lbv + (1.f - lbv) * sg);
                float kk = (1.f - lbv) * (te * sg);
                if (!valid) { lgf = 0.f; kk = 0.f; }
                lf[m][j] = lgf; kx[j] = kk;
            }
            v2u w; w.x = pg8::cvt_pk_bf16(kx[0], kx[1]); w.y = pg8::cvt_pk_bf16(kx[2], kx[3]);
            *(v2u*)(proj + (size_t)row * WIN + c0) = w;
        }
#pragma unroll
        for (int j = 0; j < 4; ++j) {
            float carry = 0.f;
#pragma unroll
            for (int m = 0; m < 4; ++m) {
                float x = lf[m][j];
                x += dpp_row_shr<1>(x); x += dpp_row_shr<2>(x); x += dpp_row_shr<4>(x); x += dpp_row_shr<8>(x);
                x += carry;
                carry = __shfl(x, 15, 16);
                lf[m][j] = x;
            }
        }
#pragma unroll
        for (int m = 0; m < 4; ++m) *(f32x4*)(logfp + (size_t)(row0 + AI * 128 + m * 16) * 512 + cc) = (f32x4){lf[m][0], lf[m][1], lf[m][2], lf[m][3]};
    }
    __device__ __forceinline__ void operator()(const pg8::f32x4 (&acc)[2][2][4][2], const pg8::Unit& u, int wr, int wc, int fr, int fq) const {
        const int grp = u.pn >> 1;
        const int row0 = u.pm * 256 + wr * 64 + fr, colb = u.pn * 256 + wc * 32 + 8 * fq;
        if (grp == 1) {
            hf_block<0, 0, 0>(acc, row0, colb); hf_block<0, 0, 1>(acc, row0, colb); hf_block<0, 1, 0>(acc, row0, colb); hf_block<0, 1, 1>(acc, row0, colb);
            hf_block<1, 0, 0>(acc, row0, colb); hf_block<1, 0, 1>(acc, row0, colb); hf_block<1, 1, 0>(acc, row0, colb); hf_block<1, 1, 1>(acc, row0, colb);
            return;
        }
#pragma unroll
        for (int ai = 0; ai < 2; ++ai)
#pragma unroll
            for (int m = 0; m < 4; ++m) {
                const int row = row0 + ai * 128 + m * 16;
                const float r = row_rstd(ssq, row);
#pragma unroll
                for (int bj = 0; bj < 2; ++bj) {
                    const int c0 = colb + bj * 128;
                    float x[8];
#pragma unroll
                    for (int j = 0; j < 4; ++j) { x[j] = acc[ai][bj][m][0][j] * r; x[4 + j] = acc[ai][bj][m][1][j] * r; }
                    if (grp == 0 || grp == 3) {
#pragma unroll
                        for (int j = 0; j < 8; ++j) x[j] = silu_f(x[j]);
                    } else if (grp == 4) {
#pragma unroll
                        for (int j = 0; j < 8; ++j) x[j] *= 0.18033688011112042f;
                    }
                    v4u w; w.x = pg8::cvt_pk_bf16(x[0], x[1]); w.y = pg8::cvt_pk_bf16(x[2], x[3]); w.z = pg8::cvt_pk_bf16(x[4], x[5]); w.w = pg8::cvt_pk_bf16(x[6], x[7]);
                    *(v4u*)(proj + (size_t)row * WIN + c0) = w;
                }
            }
    }
};
struct EpiResid {
    static constexpr bool PERM = true, AFTER_DRAIN = false;
    float* H; bf16* HB; float* ssq;
    __device__ __forceinline__ void operator()(const pg8::f32x4 (&acc)[2][2][4][2], const pg8::Unit& u, int wr, int wc, int fr, int fq) const {
        const int row0 = u.pm * 256 + wr * 64 + fr, colb = u.pn * 256 + wc * 32 + 8 * fq;
#pragma unroll
        for (int ai = 0; ai < 2; ++ai)
#pragma unroll
            for (int m = 0; m < 4; ++m) {
                const int row = row0 + ai * 128 + m * 16;
                float s = 0.f;
#pragma unroll
                for (int bj = 0; bj < 2; ++bj) {
                    const int c0 = colb + bj * 128;
                    float* hp = H + (size_t)row * D + c0;
                    f32x4 h0 = *(const f32x4*)hp, h1 = *(const f32x4*)(hp + 4);
                    h0 = h0 + acc[ai][bj][m][0]; h1 = h1 + acc[ai][bj][m][1];
                    *(f32x4*)hp = h0; *(f32x4*)(hp + 4) = h1;
                    s += (h0[0] * h0[0] + h0[1] * h0[1]) + (h0[2] * h0[2] + h0[3] * h0[3]) + (h1[0] * h1[0] + h1[1] * h1[1]) + (h1[2] * h1[2] + h1[3] * h1[3]);
                    v4u w; w.x = pg8::cvt_pk_bf16(h0[0], h0[1]); w.y = pg8::cvt_pk_bf16(h0[2], h0[3]); w.z = pg8::cvt_pk_bf16(h1[0], h1[1]); w.w = pg8::cvt_pk_bf16(h1[2], h1[3]);
                    *(v4u*)(HB + (size_t)row * D + c0) = w;
                }
                s += __shfl_xor(s, 16); s += __shfl_xor(s, 32);
                if (fq == 0) ssq[(size_t)row * 16 + u.pn * 4 + wc] = s;
            }
    }
};
struct EpiGLU {
    static constexpr bool PERM = true, AFTER_DRAIN = false;
    bf16* T; int ldt; const float* ssq;
    __device__ __forceinline__ void operator()(const pg8::f32x4 (&acc)[2][2][4][2], const pg8::Unit& u, int wr, int wc, int fr, int fq) const {
        const int row0 = u.pm * 256 + wr * 64 + fr, colb = u.pn * 128 + wc * 32 + 8 * fq;
#pragma unroll
        for (int ai = 0; ai < 2; ++ai)
#pragma unroll
            for (int m = 0; m < 4; ++m) {
                const int row = row0 + ai * 128 + m * 16;
                const float r = ssq ? row_rstd(ssq, row) : 1.f;
                float x[8];
#pragma unroll
                for (int j = 0; j < 4; ++j) { x[j] = silu_f(acc[ai][0][m][0][j] * r) * (acc[ai][1][m][0][j] * r); x[4 + j] = silu_f(acc[ai][0][m][1][j] * r) * (acc[ai][1][m][1][j] * r); }
                v4u w; w.x = pg8::cvt_pk_bf16(x[0], x[1]); w.y = pg8::cvt_pk_bf16(x[2], x[3]); w.z = pg8::cvt_pk_bf16(x[4], x[5]); w.w = pg8::cvt_pk_bf16(x[6], x[7]);
                *(v4u*)(T + (size_t)row * ldt + colb) = w;
            }
    }
};
struct EpiNone { static constexpr bool PERM = true, AFTER_DRAIN = false; unsigned* sink;
    __device__ __forceinline__ void operator()(const pg8::f32x4 (&acc)[2][2][4][2], const pg8::Unit& u, int wr, int wc, int fr, int fq) const { pg8::f32x4 s = acc[0][0][0][0];
#pragma unroll
        for (int a = 0; a < 2; ++a)
#pragma unroll
            for (int b = 0; b < 2; ++b)
#pragma unroll
                for (int m = 0; m < 4; ++m)
#pragma unroll
                    for (int n = 0; n < 2; ++n) s = s + acc[a][b][m][n];
        if (s[0] + s[1] + s[2] + s[3] == 1.2345e38f) sink[0] = 1u; } };
struct EpiY {
    static constexpr bool PERM = true, AFTER_DRAIN = false;
    bf16* Y;
    __device__ __forceinline__ void operator()(const pg8::f32x4 (&acc)[2][2][4][2], const pg8::Unit& u, int wr, int wc, int fr, int fq) const {
        const int row0 = u.pm * 256 + wr * 64 + fr, colb = u.pn * 256 + wc * 32 + 8 * fq;
#pragma unroll
        for (int ai = 0; ai < 2; ++ai)
#pragma unroll
            for (int m = 0; m < 4; ++m) {
                const int row = row0 + ai * 128 + m * 16;
#pragma unroll
                for (int bj = 0; bj < 2; ++bj) {
                    const pg8::f32x4 a = acc[ai][bj][m][0], b = acc[ai][bj][m][1];
                    v4u w; w.x = pg8::cvt_pk_bf16(a[0], a[1]); w.y = pg8::cvt_pk_bf16(a[2], a[3]); w.z = pg8::cvt_pk_bf16(b[0], b[1]); w.w = pg8::cvt_pk_bf16(b[2], b[3]);
                    *(v4u*)(Y + (size_t)row * D + colb + bj * 128) = w;
                }
            }
    }
};

__device__ __forceinline__ void transpose_item(const float* W, const float* fold, int K, int N, bf16* WT, int k0, int n0, int drow0, LAS float* scr, int lane) {
    const int kr = lane >> 4, n4 = lane & 15;
    f32x4 v[16];
#pragma unroll
    for (int i = 0; i < 16; ++i) v[i] = *(const f32x4*)(W + (size_t)(k0 + 4 * i + kr) * N + n0 + 4 * n4);
#pragma unroll
    for (int i = 0; i < 16; ++i) { const int k = 4 * i + kr; *(LAS f32x4*)(scr + k * 64 + ((4 * n4) ^ (4 * ((k >> 3) & 7)))) = v[i]; }
    LDS_WAIT(); asm volatile("" ::: "memory");
    const int c = lane & 7, nn = lane >> 3;
    f32x4 f0 = (f32x4){1.f, 1.f, 1.f, 1.f}, f1 = f0;
    if (fold) { f0 = *(const f32x4*)(fold + k0 + 8 * c); f1 = *(const f32x4*)(fold + k0 + 8 * c + 4); }
#pragma unroll
    for (int i2 = 0; i2 < 8; ++i2) {
        const int n = 8 * i2 + nn; const LAS float* s = scr + (8 * c) * 64 + (n ^ (4 * c));
        v4u o; o.x = pk2(s[0 * 64] * f0[0], s[1 * 64] * f0[1]); o.y = pk2(s[2 * 64] * f0[2], s[3 * 64] * f0[3]); o.z = pk2(s[4 * 64] * f1[0], s[5 * 64] * f1[1]); o.w = pk2(s[6 * 64] * f1[2], s[7 * 64] * f1[3]);
        *(GAS v4u*)(WT + (size_t)(drow0 + n) * K + k0 + 8 * c) = o;
    }
    LDS_WAIT(); asm volatile("" ::: "memory");
}
__device__ __forceinline__ void prologue_phase(Ctx& C, const Args& A) {
    LAS float* scr = (LAS float*)(C.lds + C.wave * 16384);
    const int gw = C.bid * 8 + C.wave, NGW = C.G * 8;
    constexpr int I_IN = 16 * 56, I_OUT = 16 * 16, I_D1 = 16 * 44, I_D2 = 44 * 16, I_M1 = 16 * 56, I_M2 = 56 * 16;
    constexpr int N_IN = 4 * I_IN, N_OUT = 4 * I_OUT, N_D1 = 2 * I_D1, N_D2 = 2 * I_D2, N_M1 = 16 * I_M1, N_M2 = 16 * I_M2;
    constexpr int NITEMS = N_IN + N_OUT + 2 * N_D1 + N_D2 + 2 * N_M1 + N_M2;
    for (int it = gw; it < NITEMS; it += NGW) {
        int r = it;
        const float* W; const float* fold = nullptr; bf16* WT; int K, N, glu = -1, loc;
        if (r < N_IN) { const int l = r / I_IN; loc = r % I_IN; W = A.in[IN_WIN] + (size_t)l * D * WIN; fold = A.in[IN_NMIX] + l * D; WT = (bf16*)(C.ws + WS_WIN) + (size_t)l * WIN * D; K = D; N = WIN; }
        else if ((r -= N_IN) < N_OUT) { const int l = r / I_OUT; loc = r % I_OUT; W = A.in[IN_WOUT] + (size_t)l * D * D; WT = (bf16*)(C.ws + WS_WOUT) + (size_t)l * D * D; K = D; N = D; }
        else if ((r -= N_OUT) < N_D1) { const int i = r / I_D1; loc = r % I_D1; W = A.in[IN_DW1] + (size_t)i * D * FFD; fold = A.in[IN_NFFN] + (2 * i) * D; WT = (bf16*)(C.ws + WS_WD13) + (size_t)i * 2 * FFD * D; K = D; N = FFD; glu = 0; }
        else if ((r -= N_D1) < N_D1) { const int i = r / I_D1; loc = r % I_D1; W = A.in[IN_DW3] + (size_t)i * D * FFD; fold = A.in[IN_NFFN] + (2 * i) * D; WT = (bf16*)(C.ws + WS_WD13) + (size_t)i * 2 * FFD * D; K = D; N = FFD; glu = 1; }
        else if ((r -= N_D1) < N_D2) { const int i = r / I_D2; loc = r % I_D2; W = A.in[IN_DW2] + (size_t)i * FFD * D; WT = (bf16*)(C.ws + WS_WD2) + (size_t)i * D * FFD; K = FFD; N = D; }
        else if ((r -= N_D2) < N_M1) { const int ie = r / I_M1; loc = r % I_M1; W = A.in[IN_MW1] + (size_t)ie * D * FFE; fold = A.in[IN_NFFN] + (2 * (ie >> 3) + 1) * D; WT = (bf16*)(C.ws + WS_WM13) + (size_t)ie * 2 * FFE * D; K = D; N = FFE; glu = 0; }
        else if ((r -= N_M1) < N_M1) { const int ie = r / I_M1; loc = r % I_M1; W = A.in[IN_MW3] + (size_t)ie * D * FFE; fold = A.in[IN_NFFN] + (2 * (ie >> 3) + 1) * D; WT = (bf16*)(C.ws + WS_WM13) + (size_t)ie * 2 * FFE * D; K = D; N = FFE; glu = 1; }
        else { r -= N_M1; const int ie = r / I_M2; loc = r % I_M2; W = A.in[IN_MW2] + (size_t)ie * FFE * D; WT = (bf16*)(C.ws + WS_WM2) + (size_t)ie * D * FFE; K = FFE; N = D; }
        const int nblk = N / 64, kb = loc / nblk, nb = loc % nblk, k0 = 64 * kb, n0 = 64 * nb;
        const int drow0 = (glu < 0) ? n0 : ((n0 >> 7) * 256 + glu * 128 + (n0 & 127));
        transpose_item(W, fold, K, N, WT, k0, n0, drow0, scr, C.lane);
    }
    for (int row = gw; row < NTOK; row += NGW) {
        const int b = row / LT, t = row % LT;
        f32x4 v[4]; float s = 0.f;
#pragma unroll
        for (int j = 0; j < 4; ++j) {
            const int col = 4 * C.lane + 256 * j;
            if (t < FIRSTV) v[j] = (f32x4){0.f, 0.f, 0.f, 0.f};
            else if (t < LEAD) v[j] = *(const f32x4*)(A.in[IN_META] + (size_t)(t - FIRSTV) * D + col);
            else v[j] = *(const f32x4*)(A.in[IN_X] + ((size_t)b * SEQ + (t - LEAD)) * D + col);
            s += (v[j][0] * v[j][0] + v[j][1] * v[j][1]) + (v[j][2] * v[j][2] + v[j][3] * v[j][3]);
            *(f32x4*)(C.H() + (size_t)row * D + col) = v[j];
            v2u w; w.x = pk2(v[j][0], v[j][1]); w.y = pk2(v[j][2], v[j][3]);
            *(v2u*)(C.HB() + (size_t)row * D + col) = w;
        }
        s = wave_sum(s);
        if (C.lane < 16) C.SSQ()[(size_t)row * 16 + C.lane] = (C.lane == 0) ? s : 0.f;
    }
    if (C.bid == 0) {
        const int tid = C.tid;
        {
            const float* lg = A.in[IN_LBL];
            const float a0 = lg[tid], a1 = lg[512 + tid], a2 = lg[1024 + tid], a3 = lg[1536 + tid];
            const float mx = fmaxf(fmaxf(a0, a1), fmaxf(a2, a3));
            const float e0 = expf(a0 - mx), e1 = expf(a1 - mx), e2 = expf(a2 - mx), e3 = expf(a3 - mx);
            const float inv = 1.f / (((e0 + e1) + e2) + e3);
            const float p0 = e0 * inv, p1 = e1 * inv, p2 = e2 * inv, p3 = e3 * inv;
            const float c0 = p0, c1 = c0 + p1, c2 = c1 + p2, c3 = c2 + p3;
            C.LB()[tid] = 0.f;
            C.LB()[512 + tid] = fminf(fmaxf(c1 - c0, 0.f), 0.999f);
            C.LB()[1024 + tid] = fminf(fmaxf(c2 - c0, 0.f), 0.999f);
            C.LB()[1536 + tid] = fminf(fmaxf(c3 - c0, 0.f), 0.999f);
        }
        for (int i = tid; i < 4 * 132; i += 512) { const int h = i / 132, d = i % 132; C.BIAST()[i] = (d <= 128) ? A.in[IN_RELB][T5B[d] * 4 + h] : 0.f; }
        if (tid < 4) {
            const float* lv = A.in[IN_LAMBDA] + tid * 256;
            float s01 = 0.f, s23 = 0.f;
            for (int j = 0; j < 64; ++j) { s01 += lv[j] * lv[64 + j]; s23 += lv[128 + j] * lv[192 + j]; }
            const float li = 0.8f - 0.6f * expf(-0.3f * (float)tid);
            C.LAM()[tid * 2] = expf(s01) - expf(s23) + li; C.LAM()[tid * 2 + 1] = li;
        }
        if (tid < 512) { C.SUBLN()[tid] = A.in[IN_SUBLN][tid]; C.HGNW()[tid] = A.in[IN_HGNW][tid]; C.FNORM()[tid] = A.in[IN_FNORM][tid]; C.FNORM()[512 + tid] = A.in[IN_FNORM][512 + tid]; }
        for (int i = tid; i < 2 * 8 * 1024; i += 512) { const int li = i >> 13, e = (i >> 10) & 7, k = i & 1023; C.RF()[i] = A.in[IN_NFFN][(2 * li + 1) * D + k] * A.in[IN_ROUTER][(size_t)li * D * NE + k * NE + e]; }
    }
}

__device__ __forceinline__ void hgrn_naive_unit(Ctx& C, int l, int b, int h) {
    LAS float* qf = (LAS float*)C.lds;
    LAS float* kf = qf + 2048; LAS float* ff = kf + 2048; LAS float* vv = ff + 2048; LAS float* gg = vv + 2048;
    LAS float* opart = gg + 2048;
    const int tid = C.tid, dv = tid & 127, qd = tid >> 7;
    const int ltok = tid >> 5, c4 = (tid & 31) * 4;
    float S[32];
#pragma unroll
    for (int j = 0; j < 32; ++j) S[j] = 0.f;
    const float* nw = C.HGNW() + l * 128;
    for (int tb = 0; tb < LT / 16; ++tb) {
        const size_t row = (size_t)b * LT + tb * 16 + ltok;
        {
            const bf16* pp = C.PROJ() + row * WIN + h * 128 + c4;
            const v2u wq = *(const v2u*)pp, wk = *(const v2u*)(pp + 512), wv = *(const v2u*)(pp + 1024), wg = *(const v2u*)(pp + 1536);
            const f32x4 lf = *(const f32x4*)(C.LOGF() + row * 512 + h * 128 + c4);
            const int o = ltok * 128 + c4;
            qf[o] = bf_lo(wq.x); qf[o + 1] = bf_hi(wq.x); qf[o + 2] = bf_lo(wq.y); qf[o + 3] = bf_hi(wq.y);
            kf[o] = bf_lo(wk.x); kf[o + 1] = bf_hi(wk.x); kf[o + 2] = bf_lo(wk.y); kf[o + 3] = bf_hi(wk.y);
            vv[o] = bf_lo(wv.x); vv[o + 1] = bf_hi(wv.x); vv[o + 2] = bf_lo(wv.y); vv[o + 3] = bf_hi(wv.y);
            gg[o] = bf_lo(wg.x); gg[o + 1] = bf_hi(wg.x); gg[o + 2] = bf_lo(wg.y); gg[o + 3] = bf_hi(wg.y);
            f32x4 lp = (f32x4){0.f, 0.f, 0.f, 0.f};
            if (((tb * 16 + ltok) & 63) != 0) lp = *(const f32x4*)(C.LOGF() + (row - 1) * 512 + h * 128 + c4);
            ff[o] = expf(lf[0] - lp[0]); ff[o + 1] = expf(lf[1] - lp[1]); ff[o + 2] = expf(lf[2] - lp[2]); ff[o + 3] = expf(lf[3] - lp[3]);
        }
        __syncthreads();
        for (int tok = 0; tok < 16; ++tok) {
            const float v = vv[tok * 128 + dv];
            const LAS f32x4* fp = (const LAS f32x4*)(ff + tok * 128 + 32 * qd);
            const LAS f32x4* kp = (const LAS f32x4*)(kf + tok * 128 + 32 * qd);
            const LAS f32x4* qp = (const LAS f32x4*)(qf + tok * 128 + 32 * qd);
            float a = 0.f;
#pragma unroll
            for (int j = 0; j < 8; ++j) {
                const f32x4 f4 = fp[j], k4 = kp[j], q4 = qp[j];
#pragma unroll
                for (int i = 0; i < 4; ++i) { S[4 * j + i] = f4[i] * S[4 * j + i] + k4[i] * v; a += q4[i] * S[4 * j + i]; }
            }
            opart[(tok * 4 + qd) * 128 + dv] = a;
        }
        __syncthreads();
        {
            float o[4]; float ss = 0.f;
#pragma unroll
            for (int i = 0; i < 4; ++i) { o[i] = (opart[(ltok * 4 + 0) * 128 + c4 + i] + opart[(ltok * 4 + 1) * 128 + c4 + i]) + (opart[(ltok * 4 + 2) * 128 + c4 + i] + opart[(ltok * 4 + 3) * 128 + c4 + i]); ss += o[i] * o[i]; }
#pragma unroll
            for (int m = 1; m < 32; m <<= 1) ss += __shfl_xor(ss, m);
            const float rs = rsqrtf(ss * (1.0f / 128.0f) + EPS);
            const int oo = ltok * 128 + c4;
            v2u w; w.x = pk2(o[0] * rs * nw[c4] * gg[oo], o[1] * rs * nw[c4 + 1] * gg[oo + 1]); w.y = pk2(o[2] * rs * nw[c4 + 2] * gg[oo + 2], o[3] * rs * nw[c4 + 3] * gg[oo + 3]);
            *(v2u*)(C.MIX() + row * D + h * 128 + c4) = w;
        }
        __syncthreads();
    }
}
typedef float f32x16 __attribute__((ext_vector_type(16)));
typedef short bf16x8 __attribute__((ext_vector_type(8)));
typedef short s16x4 __attribute__((ext_vector_type(4)));
constexpr float LOG2E = 1.4426950408889634f;
constexpr int AT_K = 0, AT_V = 32768, AT_BIAS = 65536, AT_WSF = 66560, AT_STG = 69632, AT_XCH = 0;
__device__ __forceinline__ int crow(int r, int hi) { return (r & 3) + 8 * (r >> 2) + 4 * hi; }
__device__ __forceinline__ s16x4 vtr(const LAS unsigned char* p) { typedef short v4i16_t __attribute__((ext_vector_type(4))); return __builtin_bit_cast(s16x4, __builtin_amdgcn_ds_read_tr16_b64_v4i16((LAS v4i16_t*)p)); }
__device__ __forceinline__ bf16x8 pack8(const f32x16& p, int b0) {
    v4u w; w.x = pg8::cvt_pk_bf16(p[b0 + 0], p[b0 + 1]); w.y = pg8::cvt_pk_bf16(p[b0 + 2], p[b0 + 3]); w.z = pg8::cvt_pk_bf16(p[b0 + 4], p[b0 + 5]); w.w = pg8::cvt_pk_bf16(p[b0 + 6], p[b0 + 7]);
    return __builtin_bit_cast(bf16x8, w);
}
__device__ __forceinline__ void attn_unit(Ctx& C, int l, int b, int h, int qi) {
    LAS unsigned char* lds = C.lds;
    const int tid = C.tid, lane = C.lane, wave = C.wave, rg = wave >> 1, c = wave & 1, r32 = lane & 31, hi = lane >> 5;
    const size_t rowbase = (size_t)b * LT;
    const bf16* PJ = C.PROJ();
    LAS float* biasl = (LAS float*)(lds + AT_BIAS);
    LAS float* wsf = (LAS float*)(lds + AT_WSF) + wave * 64;
    if (tid < 132) biasl[tid] = C.BIAST()[h * 132 + tid] * LOG2E;
    const float lam = C.LAM()[l * 2], lam_init = C.LAM()[l * 2 + 1];
    const int qw0 = 128 * qi + 32 * rg, tq = qw0 + r32;
    bf16x8 qr[4];
    { const bf16* qp = PJ + (rowbase + tq) * WIN + 2048 + h * 128 + c * 64 + 8 * hi;
#pragma unroll
      for (int ks = 0; ks < 4; ++ks) qr[ks] = *(const bf16x8*)(qp + 16 * ks); }
    const int kkey = tid >> 3, kch = tid & 7;
    const bf16* ksrc = PJ + (rowbase + kkey) * WIN + 2560 + h * 128 + kch * 8;
    const int kdst = kkey * 128 + ((kch ^ ((kkey >> 1) & 7)) * 16);
    const int vkey0 = tid >> 4, vch = tid & 15;
    const bf16* vsrc = PJ + (rowbase + vkey0) * WIN + 3072 + h * 128 + vch * 8;
    const int vdst0 = ((vkey0 >> 3) * 4 + (vch >> 2)) * 512 + (vkey0 & 7) * 64 + (vch & 3) * 16;
    v4u kreg0, kreg1, vreg0, vreg1;
#define AT_LOAD(kt) do { const size_t o_ = (size_t)(kt) * 64 * WIN; kreg0 = *(const v4u*)(ksrc + o_); kreg1 = *(const v4u*)(ksrc + o_ + 64); vreg0 = *(const v4u*)(vsrc + o_); vreg1 = *(const v4u*)(vsrc + o_ + (size_t)32 * WIN); } while (0)
#define AT_STORE(buf) do { *(LAS v4u*)(lds + AT_K + (buf) * 16384 + kdst) = kreg0; *(LAS v4u*)(lds + AT_K + (buf) * 16384 + 8192 + kdst) = kreg1; \
        *(LAS v4u*)(lds + AT_V + (buf) * 16384 + vdst0) = vreg0; *(LAS v4u*)(lds + AT_V + (buf) * 16384 + 8192 + vdst0) = vreg1; } while (0)
    const int nt = 2 * qi + 1;
    AT_LOAD(1); AT_STORE(0);
    __syncthreads();
    f32x16 o[4];
#pragma unroll
    for (int d = 0; d < 4; ++d)
#pragma unroll
        for (int r = 0; r < 16; ++r) o[d][r] = 0.f;
    float mref = -1e30f, lsum = 0.f;
    const int kswz = (r32 >> 1) & 7;
    const int vb = (4 * hi + ((lane & 15) >> 2)) * 64 + ((lane >> 4) & 1) * 32 + (lane & 3) * 8;
    const float b128 = biasl[128];
    for (int it = 0; it < nt; ++it) {
        const int kt = it + 1, buf = it & 1, k0 = 64 * kt;
        if (it + 1 < nt) AT_LOAD(kt + 1);
        if (k0 <= qw0 + 31) {
            const bool near = (k0 + 63 > qw0 - 128) || (kt == 1);
            f32x16 p0, p1;
            { const float ini = near ? 0.f : b128;
#pragma unroll
              for (int r = 0; r < 16; ++r) { p0[r] = ini; p1[r] = ini; } }
            const LAS unsigned char* kb = lds + AT_K + buf * 16384 + c * 8192 + r32 * 128;
#pragma unroll
            for (int ks = 0; ks < 4; ++ks) {
                const int off = ((2 * ks + hi) ^ kswz) * 16;
                const bf16x8 k0f = *(const LAS bf16x8*)(kb + off), k1f = *(const LAS bf16x8*)(kb + 4096 + off);
                p0 = __builtin_amdgcn_mfma_f32_32x32x16_bf16(k0f, qr[ks], p0, 0, 0, 0);
                p1 = __builtin_amdgcn_mfma_f32_32x32x16_bf16(k1f, qr[ks], p1, 0, 0, 0);
            }
            if (near) {
#pragma unroll
                for (int r = 0; r < 16; ++r) {
                    const int tk = k0 + crow(r, hi), d0 = tq - tk, d1 = d0 - 32;
                    const float b0 = biasl[d0 < 0 ? 0 : (d0 > 128 ? 128 : d0)], b1 = biasl[d1 < 0 ? 0 : (d1 > 128 ? 128 : d1)];
                    p0[r] = (d0 < 0 || tk < FIRSTV) ? -INFINITY : p0[r] + b0;
                    p1[r] = (d1 < 0 || tk + 32 < FIRSTV) ? -INFINITY : p1[r] + b1;
                }
            }
            float mx = fmaxf(p0[0], p1[0]);
#pragma unroll
            for (int r = 1; r < 16; ++r) mx = fmaxf(fmaxf(mx, p0[r]), p1[r]);
            mx = fmaxf(mx, __shfl_xor(mx, 32));
            if (__any(mx > mref + 8.0f)) {
                const float mnew = fmaxf(mref, mx), f = __builtin_amdgcn_exp2f(mref - mnew);
                lsum *= f; mref = mnew;
                if (hi == 0) wsf[r32] = f;
                LDS_WAIT(); asm volatile("" ::: "memory");
#pragma unroll
                for (int g = 0; g < 4; ++g) { const f32x4 fv = *(const LAS f32x4*)(wsf + 8 * g + 4 * hi);
#pragma unroll
                    for (int d = 0; d < 4; ++d) { o[d][4 * g + 0] *= fv[0]; o[d][4 * g + 1] *= fv[1]; o[d][4 * g + 2] *= fv[2]; o[d][4 * g + 3] *= fv[3]; } }
            }
            float ps = 0.f;
#pragma unroll
            for (int r = 0; r < 16; ++r) { p0[r] = __builtin_amdgcn_exp2f(p0[r] - mref); p1[r] = __builtin_amdgcn_exp2f(p1[r] - mref); ps += p0[r] + p1[r]; }
            lsum += ps;
            const bf16x8 pa0 = pack8(p0, 0), pa1 = pack8(p0, 8), pa2 = pack8(p1, 0), pa3 = pack8(p1, 8);
            const LAS unsigned char* vp = lds + AT_V + buf * 16384 + vb;
#pragma unroll
            for (int d = 0; d < 4; ++d) {
#define AT_VF(s) ({ const s16x4 lo_ = vtr(vp + (2 * (s)) * 2048 + d * 512), hi_ = vtr(vp + (2 * (s) + 1) * 2048 + d * 512); (bf16x8){lo_[0], lo_[1], lo_[2], lo_[3], hi_[0], hi_[1], hi_[2], hi_[3]}; })
                o[d] = __builtin_amdgcn_mfma_f32_32x32x16_bf16(pa0, AT_VF(0), o[d], 0, 0, 0);
                o[d] = __builtin_amdgcn_mfma_f32_32x32x16_bf16(pa1, AT_VF(1), o[d], 0, 0, 0);
                o[d] = __builtin_amdgcn_mfma_f32_32x32x16_bf16(pa2, AT_VF(2), o[d], 0, 0, 0);
                o[d] = __builtin_amdgcn_mfma_f32_32x32x16_bf16(pa3, AT_VF(3), o[d], 0, 0, 0);
#undef AT_VF
            }
        }
        if (it + 1 < nt) AT_STORE(buf ^ 1);
        __syncthreads();
    }
#undef AT_LOAD
#undef AT_STORE
    lsum += __shfl_xor(lsum, 32);
    { const float inv = lsum > 0.f ? 1.f / lsum : 0.f;
      if (hi == 0) wsf[r32] = inv;
      LDS_WAIT(); asm volatile("" ::: "memory");
#pragma unroll
      for (int g = 0; g < 4; ++g) { const f32x4 fv = *(const LAS f32x4*)(wsf + 8 * g + 4 * hi);
#pragma unroll
          for (int d = 0; d < 4; ++d) { o[d][4 * g + 0] *= fv[0]; o[d][4 * g + 1] *= fv[1]; o[d][4 * g + 2] *= fv[2]; o[d][4 * g + 3] *= fv[3]; } } }
    LAS float* xch = (LAS float*)(lds + AT_XCH) + rg * 4096;
    if (c == 1) {
#pragma unroll
        for (int d = 0; d < 4; ++d)
#pragma unroll
            for (int r = 0; r < 16; ++r) xch[(d * 16 + r) * 64 + lane] = o[d][r];
    }
    __syncthreads();
    if (c == 0) {
        float ss[16];
#pragma unroll
        for (int r = 0; r < 16; ++r) ss[r] = 0.f;
#pragma unroll
        for (int d = 0; d < 4; ++d)
#pragma unroll
            for (int r = 0; r < 16; ++r) { const float a = o[d][r] - lam * xch[(d * 16 + r) * 64 + lane]; o[d][r] = a; ss[r] += a * a; }
#pragma unroll
        for (int r = 0; r < 16; ++r) {
            float s = ss[r];
            s += __shfl_xor(s, 1); s += __shfl_xor(s, 2); s += __shfl_xor(s, 4); s += __shfl_xor(s, 8); s += __shfl_xor(s, 16);
            ss[r] = rsqrtf(s * (1.0f / 128.0f) + EPS) * (1.f - lam_init);
        }
        LAS bf16* stg = (LAS bf16*)(lds + AT_STG) + rg * 4096;
        const float* sw = C.SUBLN() + l * 128 + r32;
#pragma unroll
        for (int d = 0; d < 4; ++d) { const float w = sw[32 * d];
#pragma unroll
            for (int r = 0; r < 16; ++r) stg[crow(r, hi) * 128 + 32 * d + r32] = (bf16)f2bf(o[d][r] * ss[r] * w); }
        LDS_WAIT(); asm volatile("" ::: "memory");
        bf16* op = C.MIX() + (rowbase + qw0) * D + 512 + h * 128;
#pragma unroll
        for (int i = 0; i < 8; ++i) { const int ch = i * 64 + lane, row = ch >> 4, cc = ch & 15; *(v4u*)(op + (size_t)row * D + cc * 8) = *(const LAS v4u*)(stg + row * 128 + cc * 8); }
    }
    __syncthreads();
}
constexpr int HG_QM = 0, HG_KR = 16384, HG_KT = 32768, HG_V = 49152, HG_ST = 65536, HG_XT = 98304, HG_OS = 106496, HG_SQ = 122880, HG_VEC = 123904;
__device__ __forceinline__ bf16x8 tr_frag(const LAS unsigned char* p) { const s16x4 lo = vtr(p), hi4 = vtr(p + 256); return (bf16x8){lo[0], lo[1], lo[2], lo[3], hi4[0], hi4[1], hi4[2], hi4[3]}; }
__device__ __forceinline__ void hgrn_unit(Ctx& C, int l, int b, int h) {
    LAS unsigned char* lds = C.lds;
    const int tid = C.tid, lane = C.lane, wave = C.wave, r32 = lane & 31, hi = lane >> 5;
    const size_t rowbase = (size_t)b * LT;
    const bf16* PJ = C.PROJ() + h * 128; const float* BL = C.LOGF() + h * 128;
    const int c4 = tid & 31, tg = tid >> 5;
    const int dkb = wave >> 1, dvb0 = 2 * (wave & 1);
    const int th = wave >> 2, dvb = wave & 3;
    const int vbq = ((lane & 15) >> 2) * 64 + ((lane >> 4) & 1) * 32 + (lane & 3) * 8;
    LAS float* vec = (LAS float*)(lds + HG_VEC);
    LAS float* sq = (LAS float*)(lds + HG_SQ);
    f32x16 st[2];
#pragma unroll
    for (int j = 0; j < 2; ++j)
#pragma unroll
        for (int r = 0; r < 16; ++r) st[j][r] = 0.f;
    v2u pq[4], pk[4], pv[4]; f32x4 pb[4], pbm;
#define HG_LOAD(ch) do { const size_t r0_ = rowbase + (size_t)(ch) * 64; \
        _Pragma("unroll") for (int i = 0; i < 4; ++i) { const size_t row_ = r0_ + 4 * tg + i; const bf16* p_ = PJ + row_ * WIN + 4 * c4; \
            pq[i] = *(const v2u*)p_; pk[i] = *(const v2u*)(p_ + 512); pv[i] = *(const v2u*)(p_ + 1024); pb[i] = *(const f32x4*)(BL + row_ * 512 + 4 * c4); } \
        pbm = *(const f32x4*)(BL + (r0_ + 31) * 512 + 4 * c4); } while (0)
    HG_LOAD(0);
    const float* nw = C.HGNW() + l * 128;
    for (int ch = 0; ch < LT / 64; ++ch) {
#pragma unroll
        for (int i = 0; i < 4; ++i) {
            const int t = 4 * tg + i;
            float qm[4], km[4];
            const float qv[4] = {bf_lo(pq[i].x), bf_hi(pq[i].x), bf_lo(pq[i].y), bf_hi(pq[i].y)};
            const float kv[4] = {bf_lo(pk[i].x), bf_hi(pk[i].x), bf_lo(pk[i].y), bf_hi(pk[i].y)};
#pragma unroll
            for (int j = 0; j < 4; ++j) { const float x = fminf(fmaxf(pb[i][j] - pbm[j], -80.f), 80.f); qm[j] = qv[j] * __expf(x); km[j] = kv[j] * __expf(-x); }
            const int rsw = (((c4 >> 1) ^ (t & 15)) * 16) + (c4 & 1) * 8;
            *(LAS v2u*)(lds + HG_QM + t * 256 + rsw) = pack4(qm[0], qm[1], qm[2], qm[3]);
            const v2u kmw = pack4(km[0], km[1], km[2], km[3]);
            *(LAS v2u*)(lds + HG_KR + t * 256 + rsw) = kmw;
            const int tso = ((t >> 3) * 4 + (c4 >> 3)) * 512 + (t & 7) * 64 + (c4 & 7) * 8;
            *(LAS v2u*)(lds + HG_KT + tso) = kmw;
            *(LAS v2u*)(lds + HG_V + tso) = pv[i];
            if (t == 31) *(LAS f32x4*)(vec + 4 * c4) = pb[i];
            if (t == 63) *(LAS f32x4*)(vec + 128 + 4 * c4) = pb[i];
        }
        __syncthreads();
        if (ch + 1 < LT / 64) HG_LOAD(ch + 1);
        const v4u g0 = *(const v4u*)(PJ + (rowbase + (size_t)ch * 64 + (tid >> 3)) * WIN + 1536 + 16 * (tid & 7)), g1 = *(const v4u*)(PJ + (rowbase + (size_t)ch * 64 + (tid >> 3)) * WIN + 1536 + 16 * (tid & 7) + 8);
#pragma unroll
        for (int g = 0; g < 4; ++g) {
            const f32x4 bm = *(const LAS f32x4*)(vec + 32 * dkb + 8 * g + 4 * hi);
            const float e0 = __expf(bm[0]), e1 = __expf(bm[1]), e2 = __expf(bm[2]), e3 = __expf(bm[3]);
#pragma unroll
            for (int j = 0; j < 2; ++j) {
                st[j][4 * g + 0] *= e0; st[j][4 * g + 1] *= e1; st[j][4 * g + 2] *= e2; st[j][4 * g + 3] *= e3;
                const int dv = 32 * (dvb0 + j) + r32;
                *(LAS v2u*)(lds + HG_ST + dv * 256 + (((4 * dkb + g) ^ (dv & 15)) * 16) + hi * 8) = pack4(st[j][4 * g + 0], st[j][4 * g + 1], st[j][4 * g + 2], st[j][4 * g + 3]);
            }
        }
        if (wave < 3) {
            const int sb = (wave == 2) ? 1 : 0, tb = (wave == 0) ? 0 : 1;
            const int s = 32 * sb + r32, t = 32 * tb + r32;
            f32x16 x;
#pragma unroll
            for (int r = 0; r < 16; ++r) x[r] = 0.f;
#pragma unroll
            for (int ks = 0; ks < 8; ++ks) {
                const bf16x8 a = *(const LAS bf16x8*)(lds + HG_KR + s * 256 + (((2 * ks + hi) ^ (s & 15)) * 16));
                const bf16x8 bq = *(const LAS bf16x8*)(lds + HG_QM + t * 256 + (((2 * ks + hi) ^ (t & 15)) * 16));
                x = __builtin_amdgcn_mfma_f32_32x32x16_bf16(a, bq, x, 0, 0, 0);
            }
            if (sb == tb) {
#pragma unroll
                for (int r = 0; r < 16; ++r) x[r] = (crow(r, hi) > r32) ? 0.f : x[r];
            }
#pragma unroll
            for (int g = 0; g < 4; ++g)
                *(LAS v2u*)(lds + HG_XT + t * 128 + (((4 * sb + g) ^ ((t >> 1) & 7)) * 16) + hi * 8) = pack4(x[4 * g + 0], x[4 * g + 1], x[4 * g + 2], x[4 * g + 3]);
        }
#pragma unroll
        for (int ks = 0; ks < 4; ++ks) {
            const bf16x8 a = tr_frag(lds + HG_KT + ((2 * ks + hi) * 4 + dkb) * 512 + vbq);
#pragma unroll
            for (int j = 0; j < 2; ++j) {
                const bf16x8 bv = tr_frag(lds + HG_V + ((2 * ks + hi) * 4 + dvb0 + j) * 512 + vbq);
                st[j] = __builtin_amdgcn_mfma_f32_32x32x16_bf16(a, bv, st[j], 0, 0, 0);
            }
        }
#pragma unroll
        for (int g = 0; g < 4; ++g) {
            const f32x4 bm = *(const LAS f32x4*)(vec + 32 * dkb + 8 * g + 4 * hi), be = *(const LAS f32x4*)(vec + 128 + 32 * dkb + 8 * g + 4 * hi);
            const float e0 = __expf(be[0] - bm[0]), e1 = __expf(be[1] - bm[1]), e2 = __expf(be[2] - bm[2]), e3 = __expf(be[3] - bm[3]);
#pragma unroll
            for (int j = 0; j < 2; ++j) { st[j][4 * g + 0] *= e0; st[j][4 * g + 1] *= e1; st[j][4 * g + 2] *= e2; st[j][4 * g + 3] *= e3; }
        }
        __syncthreads();
        {
            const int dv = 32 * dvb + r32, t = 32 * th + r32;
            f32x16 o;
#pragma unroll
            for (int r = 0; r < 16; ++r) o[r] = 0.f;
#pragma unroll
            for (int ks = 0; ks < 8; ++ks) {
                const bf16x8 a = *(const LAS bf16x8*)(lds + HG_ST + dv * 256 + (((2 * ks + hi) ^ (dv & 15)) * 16));
                const bf16x8 bq = *(const LAS bf16x8*)(lds + HG_QM + t * 256 + (((2 * ks + hi) ^ (t & 15)) * 16));
                o = __builtin_amdgcn_mfma_f32_32x32x16_bf16(a, bq, o, 0, 0, 0);
            }
#pragma unroll
            for (int sb = 0; sb < 2; ++sb) {
                if (sb <= th) {
#pragma unroll
                    for (int k2 = 0; k2 < 2; ++k2) {
                        const int kg = 4 * sb + 2 * k2 + hi;
                        const bf16x8 a = tr_frag(lds + HG_V + (kg * 4 + dvb) * 512 + vbq);
                        const bf16x8 bx = *(const LAS bf16x8*)(lds + HG_XT + t * 128 + ((kg ^ ((t >> 1) & 7)) * 16));
                        o = __builtin_amdgcn_mfma_f32_32x32x16_bf16(a, bx, o, 0, 0, 0);
                    }
                }
            }
            float s2 = 0.f;
#pragma unroll
            for (int r = 0; r < 16; ++r) s2 += o[r] * o[r];
            s2 += __shfl_xor(s2, 32);
            if (hi == 0) sq[t * 4 + dvb] = s2;
#pragma unroll
            for (int g = 0; g < 4; ++g)
                *(LAS v2u*)(lds + HG_OS + t * 256 + (((4 * dvb + g) ^ (t & 15)) * 16) + hi * 8) = pack4(o[4 * g + 0], o[4 * g + 1], o[4 * g + 2], o[4 * g + 3]);
        }
        __syncthreads();
        {
            const int t = tid >> 3, seg = tid & 7;
            const size_t row = rowbase + (size_t)ch * 64 + t;
            const f32x4 sv = *(const LAS f32x4*)(sq + t * 4);
            const float rs = rsqrtf(((sv[0] + sv[1]) + (sv[2] + sv[3])) * (1.0f / 128.0f) + EPS);
            const v4u o0 = *(const LAS v4u*)(lds + HG_OS + t * 256 + (((2 * seg) ^ (t & 15)) * 16)), o1 = *(const LAS v4u*)(lds + HG_OS + t * 256 + (((2 * seg + 1) ^ (t & 15)) * 16));
            const f32x4 w0 = *(const f32x4*)(nw + 16 * seg), w1 = *(const f32x4*)(nw + 16 * seg + 4), w2 = *(const f32x4*)(nw + 16 * seg + 8), w3 = *(const f32x4*)(nw + 16 * seg + 12);
            v4u r0, r1;
            r0.x = pk2(bf_lo(o0.x) * rs * w0[0] * bf_lo(g0.x), bf_hi(o0.x) * rs * w0[1] * bf_hi(g0.x)); r0.y = pk2(bf_lo(o0.y) * rs * w0[2] * bf_lo(g0.y), bf_hi(o0.y) * rs * w0[3] * bf_hi(g0.y));
            r0.z = pk2(bf_lo(o0.z) * rs * w1[0] * bf_lo(g0.z), bf_hi(o0.z) * rs * w1[1] * bf_hi(g0.z)); r0.w = pk2(bf_lo(o0.w) * rs * w1[2] * bf_lo(g0.w), bf_hi(o0.w) * rs * w1[3] * bf_hi(g0.w));
            r1.x = pk2(bf_lo(o1.x) * rs * w2[0] * bf_lo(g1.x), bf_hi(o1.x) * rs * w2[1] * bf_hi(g1.x)); r1.y = pk2(bf_lo(o1.y) * rs * w2[2] * bf_lo(g1.y), bf_hi(o1.y) * rs * w2[3] * bf_hi(g1.y));
            r1.z = pk2(bf_lo(o1.z) * rs * w3[0] * bf_lo(g1.z), bf_hi(o1.z) * rs * w3[1] * bf_hi(g1.z)); r1.w = pk2(bf_lo(o1.w) * rs * w3[2] * bf_lo(g1.w), bf_hi(o1.w) * rs * w3[3] * bf_hi(g1.w));
            bf16* op = C.MIX() + row * D + h * 128 + 16 * seg;
            *(v4u*)op = r0; *(v4u*)(op + 8) = r1;
        }
    }
#undef HG_LOAD
    __syncthreads();
}
__device__ __forceinline__ void mixer_phase(Ctx& C, int l) {
    const int NA = C.G - 32;
    if (C.bid < NA) {
        for (int rep = 0; rep < REP_ATT; ++rep)
        for (int k = 0; k * NA < 17 * 32; ++k) {
            const int u = k * NA + ((k & 1) ? (NA - 1 - C.bid) : C.bid);
            if (u < 17 * 32) { const int qi = 16 - u / 32, bh = u % 32; attn_unit(C, l, bh >> 2, bh & 3, qi); }
        }
    } else {
        for (int rep = 0; rep < REP_HG; ++rep) { const int u = C.bid - NA; hgrn_unit(C, l, u >> 2, u & 3); }
    }
}


template <class F> __device__ __forceinline__ void mini_tile(LAS unsigned char* lds, const bf16* A, const bf16* Bt, int K, int r0, int c0, int lane, int wave, const F& epi) {
    const int fr = lane & 15, fq = lane >> 4;
    const int srow = 8 * wave + (lane >> 3), lch = (lane & 7) ^ ((srow >> 1) & 7);
    const bf16* asrc = A + (size_t)(r0 + srow) * K + 8 * lch;
    const bf16* bsrc = Bt + (size_t)(c0 + srow) * K + 8 * lch;
    const int nk = K / 64;
    LAS unsigned char* wbase = lds + wave * 1024;
#define RT_ISSUE(s) do { const int sl_ = ((s) & 7) * 16384; __builtin_amdgcn_global_load_lds((const unsigned*)(asrc + (size_t)(s) * 64), (LAS unsigned*)(wbase + sl_), 16, 0, 0); \
        __builtin_amdgcn_global_load_lds((const unsigned*)(bsrc + (size_t)(s) * 64), (LAS unsigned*)(wbase + sl_ + 8192), 16, 0, 0); } while (0)
#pragma unroll
    for (int s = 0; s < 7; ++s) RT_ISSUE(s);
    f32x4 acc0 = (f32x4){0.f, 0.f, 0.f, 0.f}, acc1 = acc0;
    const int arow = 32 * (wave >> 2) + fr, brow = 16 * (wave & 3) + fr;
    const int asw = (arow >> 1) & 7, bsw = (brow >> 1) & 7;
    for (int s = 0; s < nk; ++s) {
        if (s + 6 < nk) asm volatile("s_waitcnt vmcnt(12)" ::: "memory"); else asm volatile("s_waitcnt vmcnt(0)" ::: "memory");
        __builtin_amdgcn_s_barrier(); asm volatile("" ::: "memory");
        if (s + 7 < nk) RT_ISSUE(s + 7);
        const LAS unsigned char* sa = lds + (s & 7) * 16384; const LAS unsigned char* sb = sa + 8192;
#pragma unroll
        for (int j = 0; j < 2; ++j) {
            const bf16x8 a0 = *(const LAS bf16x8*)(sa + arow * 128 + (((4 * j + fq) ^ asw) * 16)), a1 = *(const LAS bf16x8*)(sa + (arow + 16) * 128 + (((4 * j + fq) ^ asw) * 16));
            const bf16x8 b = *(const LAS bf16x8*)(sb + brow * 128 + (((4 * j + fq) ^ bsw) * 16));
            acc0 = __builtin_amdgcn_mfma_f32_16x16x32_bf16(b, a0, acc0, 0, 0, 0); acc1 = __builtin_amdgcn_mfma_f32_16x16x32_bf16(b, a1, acc1, 0, 0, 0);
        }
    }
#undef RT_ISSUE
    const int row = r0 + 32 * (wave >> 2) + fr, col = c0 + 16 * (wave & 3) + 4 * fq;
    epi(acc0, acc1, row, col);
    asm volatile("s_waitcnt lgkmcnt(0)" ::: "memory"); __builtin_amdgcn_s_barrier(); asm volatile("" ::: "memory");
}
__device__ __forceinline__ void mini_resid_phase(Ctx& C, const bf16* A, const bf16* Bt, int K, int row_lo) {
    LAS float* red = (LAS float*)(C.lds + RING_BYTES + 2048);
    const int nrb = (NTOK - row_lo) / 64, ntile = nrb * 16;
    float* H = C.H(); bf16* HB = C.HB(); float* SSQ = C.SSQ();
    for (int mt = C.bid; mt < ntile; mt += C.G) {
        const int rb = mt >> 4, cb = mt & 15, r0 = row_lo + 64 * rb, c0 = 64 * cb;
        const int lane = C.lane, wave = C.wave;
        mini_tile(C.lds, A, Bt, K, r0, c0, lane, wave, [&](const f32x4& x0, const f32x4& x1, int row, int col) {
            float* hp = H + (size_t)row * D + col;
            f32x4 h0 = *(const f32x4*)hp + x0, h1 = *(const f32x4*)(hp + (size_t)16 * D) + x1;
            *(f32x4*)hp = h0; *(f32x4*)(hp + (size_t)16 * D) = h1;
            *(v2u*)(HB + (size_t)row * D + col) = pack4(h0[0], h0[1], h0[2], h0[3]); *(v2u*)(HB + (size_t)(row + 16) * D + col) = pack4(h1[0], h1[1], h1[2], h1[3]);
            float s0 = (h0[0] * h0[0] + h0[1] * h0[1]) + (h0[2] * h0[2] + h0[3] * h0[3]), s1 = (h1[0] * h1[0] + h1[1] * h1[1]) + (h1[2] * h1[2] + h1[3] * h1[3]);
            s0 += __shfl_xor(s0, 16); s0 += __shfl_xor(s0, 32); s1 += __shfl_xor(s1, 16); s1 += __shfl_xor(s1, 32);
            if ((lane >> 4) == 0) { red[(row - r0) * 4 + (wave & 3)] = s0; red[(row - r0 + 16) * 4 + (wave & 3)] = s1; }
        });
        __syncthreads();
        if (C.tid < 64) { const f32x4 p = *(const LAS f32x4*)(red + C.tid * 4); SSQ[(size_t)(r0 + C.tid) * 16 + cb] = (p[0] + p[1]) + (p[2] + p[3]); }
        __syncthreads();
    }
}
__device__ __forceinline__ void mini_y_phase(Ctx& C, const bf16* A, const bf16* Bt, size_t bstride_el, int K, int plim, int pend, int p1, int p2, int p3, int p4, int p5, int p6, int p7) {
    const int ntile = (pend - plim) * 4 * 16;
    bf16* Y = C.Y();
    for (int mt = C.bid; mt < ntile; mt += C.G) {
        const int rb = mt >> 4, cb = mt & 15, pm = plim + (rb >> 2), r0 = plim * 256 + 64 * rb, c0 = 64 * cb;
        const int e = (pm >= p1) + (pm >= p2) + (pm >= p3) + (pm >= p4) + (pm >= p5) + (pm >= p6) + (pm >= p7);
        mini_tile(C.lds, A, Bt + (size_t)e * bstride_el, K, r0, c0, C.lane, C.wave, [&](const f32x4& x0, const f32x4& x1, int row, int col) {
            *(v2u*)(Y + (size_t)row * D + col) = pack4(x0[0], x0[1], x0[2], x0[3]); *(v2u*)(Y + (size_t)(row + 16) * D + col) = pack4(x1[0], x1[1], x1[2], x1[3]);
        });
    }
}

constexpr int RMAX = 128;
__device__ __forceinline__ void route_phase(Ctx& C, int li) {
    LAS float* rf = (LAS float*)C.lds;
    LAS int* lcnt = (LAS int*)(C.lds + 32768);
    LAS int* lbase = lcnt + 8;
    LAS int* ti = lbase + 8;
    LAS float* tf = (LAS float*)(ti + RMAX * 4);
    const int tid = C.tid, lane = C.lane;
    for (int i = tid; i < 8192; i += 512) rf[i] = C.RF()[li * 8192 + i];
    if (tid < 8) lcnt[tid] = 0;
    __syncthreads();
    const int nrows = (NTOK - C.bid + C.G - 1) / C.G;
    for (int k = C.wave; k < nrows; k += 8) {
        const size_t row = (size_t)C.bid + (size_t)k * C.G;
        if ((int)(row % LT) < FIRSTV) { if (lane == 0) ti[k * 4] = -1; continue; }
        f32x4 v[4]; float ss = 0.f;
#pragma unroll
        for (int j = 0; j < 4; ++j) { v[j] = *(const f32x4*)(C.H() + row * D + 4 * lane + 256 * j); ss += (v[j][0] * v[j][0] + v[j][1] * v[j][1]) + (v[j][2] * v[j][2] + v[j][3] * v[j][3]); }
        ss = wave_sum(ss);
        const float rstd = rsqrtf(ss * (1.0f / 1024.0f) + EPS);
        float lg[8];
#pragma unroll
        for (int e = 0; e < 8; ++e) {
            float p = 0.f;
#pragma unroll
            for (int j = 0; j < 4; ++j) { const f32x4 w = *(const LAS f32x4*)(rf + e * 1024 + 4 * lane + 256 * j); p += (v[j][0] * w[0] + v[j][1] * w[1]) + (v[j][2] * w[2] + v[j][3] * w[3]); }
            lg[e] = wave_sum(p) * rstd;
        }
        int e1 = 0; float l1 = lg[0];
#pragma unroll
        for (int e = 1; e < 8; ++e) if (lg[e] > l1) { l1 = lg[e]; e1 = e; }
        int e2 = -1; float l2 = -3.0e38f;
#pragma unroll
        for (int e = 0; e < 8; ++e) if (e != e1 && lg[e] > l2) { l2 = lg[e]; e2 = e; }
        const float g1 = 1.f / (1.f + expf(l2 - l1)), g2 = 1.f - g1;
        if (lane == 0) {
            const int lr1 = __hip_atomic_fetch_add(&lcnt[e1], 1, __ATOMIC_RELAXED, __HIP_MEMORY_SCOPE_WORKGROUP), lr2 = __hip_atomic_fetch_add(&lcnt[e2], 1, __ATOMIC_RELAXED, __HIP_MEMORY_SCOPE_WORKGROUP);
            ti[k * 4 + 0] = e1; ti[k * 4 + 1] = e2; ti[k * 4 + 2] = lr1; ti[k * 4 + 3] = lr2;
            tf[k * 4 + 0] = g1; tf[k * 4 + 1] = g2; tf[k * 4 + 2] = rstd;
        }
    }
    __syncthreads();
    if (tid < 8) lbase[tid] = (int)__hip_atomic_fetch_add(C.ctl() + CW_CNT + (li * 8 + tid) * 64, (unsigned)lcnt[tid], RLX_AGENT);
    __syncthreads();
    for (int k = tid; k < nrows; k += 512) {
        const int row = C.bid + k * C.G;
        if (ti[k * 4] < 0) continue;
        const int e1 = ti[k * 4], e2 = ti[k * 4 + 1], r1 = lbase[e1] + ti[k * 4 + 2], r2 = lbase[e2] + ti[k * 4 + 3];
        C.LIST()[(size_t)e1 * NTOK + r1] = row; C.LIST()[(size_t)e2 * NTOK + r2] = row;
        unsigned* inf = C.TINFO() + (size_t)row * 8;
        inf[0] = (unsigned)e1; inf[1] = (unsigned)e2; inf[2] = (unsigned)r1; inf[3] = (unsigned)r2; inf[4] = __builtin_bit_cast(unsigned, tf[k * 4]); inf[5] = __builtin_bit_cast(unsigned, tf[k * 4 + 1]);
        C.RSTD()[row] = tf[k * 4 + 2];
    }
    __syncthreads();
}
__device__ __forceinline__ void load_panels(Ctx& C, int li, LAS int* pst) {
    __syncthreads();
    if (C.tid == 0) { int acc = 0;
        for (int e = 0; e < 8; ++e) { const int c = (int)__hip_atomic_load(C.ctl() + CW_CNT + (li * 8 + e) * 64, RLX_AGENT); pst[e] = acc; pst[16 + e] = c; acc += (c + 255) >> 8; }
        pst[8] = acc; }
    __syncthreads();
}
__device__ __forceinline__ void gather_phase(Ctx& C, int li) {
    LAS int* pst = (LAS int*)C.lds;
    load_panels(C, li, pst);
    const int gw = C.bid * 8 + C.wave, NGW = C.G * 8, lane = C.lane;
    const int nslot = pst[8] * 256;
    for (int s = gw; s < nslot; s += NGW) {
        const int panel = s >> 8; int e = 0;
#pragma unroll
        for (int j = 1; j < 8; ++j) if (panel >= pst[j]) e = j;
        const int rank = s - pst[e] * 256;
        bf16* xp = C.XG() + (size_t)s * D;
        if (rank < pst[16 + e]) {
            const int tok = C.LIST()[(size_t)e * NTOK + rank]; const float r = C.RSTD()[tok];
#pragma unroll
            for (int j = 0; j < 4; ++j) { const f32x4 v = *(const f32x4*)(C.H() + (size_t)tok * D + 4 * lane + 256 * j); v2u w; w.x = pk2(v[0] * r, v[1] * r); w.y = pk2(v[2] * r, v[3] * r); *(v2u*)(xp + 4 * lane + 256 * j) = w; }
        } else {
#pragma unroll
            for (int j = 0; j < 4; ++j) *(v2u*)(xp + 4 * lane + 256 * j) = (v2u){0u, 0u};
        }
    }
}
__device__ __forceinline__ void combine_phase(Ctx& C, int li, bool last) {
    LAS int* pst = (LAS int*)C.lds;
    load_panels(C, li, pst);
    const int gw = C.bid * 8 + C.wave, NGW = C.G * 8, lane = C.lane;
    for (int row = gw; row < NTOK; row += NGW) {
        if ((row % LT) < FIRSTV) continue;
        const unsigned* inf = C.TINFO() + (size_t)row * 8;
        const int e1 = (int)inf[0], e2 = (int)inf[1];
        const size_t s1 = (size_t)pst[e1] * 256 + inf[2], s2 = (size_t)pst[e2] * 256 + inf[3];
        const float g1 = __builtin_bit_cast(float, inf[4]), g2 = __builtin_bit_cast(float, inf[5]);
        f32x4 v[4]; float ss = 0.f;
#pragma unroll
        for (int j = 0; j < 4; ++j) {
            const int col = 4 * lane + 256 * j;
            v[j] = *(const f32x4*)(C.H() + (size_t)row * D + col);
            const v2u a = *(const v2u*)(C.Y() + s1 * D + col), b = *(const v2u*)(C.Y() + s2 * D + col);
            v[j][0] += g1 * bf_lo(a.x) + g2 * bf_lo(b.x); v[j][1] += g1 * bf_hi(a.x) + g2 * bf_hi(b.x);
            v[j][2] += g1 * bf_lo(a.y) + g2 * bf_lo(b.y); v[j][3] += g1 * bf_hi(a.y) + g2 * bf_hi(b.y);
            ss += (v[j][0] * v[j][0] + v[j][1] * v[j][1]) + (v[j][2] * v[j][2] + v[j][3] * v[j][3]);
        }
        ss = wave_sum(ss);
        if (!last) {
#pragma unroll
            for (int j = 0; j < 4; ++j) { const int col = 4 * lane + 256 * j; *(f32x4*)(C.H() + (size_t)row * D + col) = v[j]; v2u w; w.x = pk2(v[j][0], v[j][1]); w.y = pk2(v[j][2], v[j][3]); *(v2u*)(C.HB() + (size_t)row * D + col) = w; }
            if (lane < 16) C.SSQ()[(size_t)row * 16 + lane] = (lane == 0) ? ss : 0.f;
        } else {
            const int b = row / LT, t = row % LT;
            if (t >= LEAD) {
                const float rs = rsqrtf(ss * (1.0f / 1024.0f) + EPS);
#pragma unroll
                for (int j = 0; j < 4; ++j) { const int col = 4 * lane + 256 * j; const f32x4 fw = *(const f32x4*)(C.FNORM() + col);
                    *(f32x4*)(C.out + ((size_t)b * SEQ + (t - LEAD)) * D + col) = (f32x4){v[j][0] * rs * fw[0], v[j][1] * rs * fw[1], v[j][2] * rs * fw[2], v[j][3] * rs * fw[3]}; }
            }
        }
    }
}

__global__ void __launch_bounds__(512, 2) mk_fwd(Args args) {
    extern __shared__ __attribute__((aligned(16))) unsigned char lds[];
    Ctx C;
    C.lds = (LAS unsigned char*)lds;
    C.tid = threadIdx.x; C.lane = C.tid & 63; C.wave = __builtin_amdgcn_readfirstlane(C.tid >> 6); C.G = gridDim.x; C.bid = blockIdx.x;
    unsigned char* ws = args.ws; C.ws = ws; C.out = args.out;
    volatile LAS unsigned* MISC = (volatile LAS unsigned*)(C.lds + MISC_OFF);
    for (int u = C.tid; u < (LDS_BYTES - RING_BYTES) / 4; u += 512) ((LAS unsigned*)(C.lds + RING_BYTES))[u] = 0u;
    __syncthreads();
    const int lo = args.ph_lo, hi = args.ph_hi;
    const bool multi = (hi - lo) > 1;
    XcdBarrier bar; bar.bar = (unsigned*)(C.ctl() + CW_BAR); bar.x = 0; bar.st = nullptr;
    if (multi) bar = xcd_barrier_post((unsigned*)(C.ctl() + CW_BAR), MISC + 8);
#define PHASE_CTX(P) Ctx P = C; { unsigned char* w_ = C.ws; asm volatile("" : "+s"(w_)); P.ws = w_; int t_ = C.tid; asm volatile("" : "+v"(t_)); P.tid = t_; P.lane = t_ & 63; P.wave = __builtin_amdgcn_readfirstlane(t_ >> 6); int g_ = C.G, b_ = C.bid; asm volatile("" : "+s"(g_), "+s"(b_)); P.G = g_; P.bid = b_; }
#define IN(k) (lo_l <= (k) && (k) < hi_l)
#define SEAM(k) do { if ((k) + 1 < hi_l) xcd_barrier(bar); } while (0)

    { int lo_l = lo, hi_l = hi; asm volatile("" : "+s"(lo_l), "+s"(hi_l));
      if (IN(0)) { for (int rep = 0; rep < REP_PRO; ++rep) { PHASE_CTX(P); prologue_phase(P, args); SEAM(0); } } }

    for (int l = 0; l < DEPTH; ++l) {
        int lo_l = lo, hi_l = hi; asm volatile("" : "+s"(lo_l), "+s"(hi_l));
        const int pb = 1 + 8 * l, li = l >> 1; const bool moe = (l & 1) != 0;
        if (PROBE_PROJ_NOEPI && IN(pb + 0)) {
            PHASE_CTX(P);
            pg8::Gemm g{P.HB(), (const bf16*)(P.ws + WS_WIN) + (size_t)l * WIN * D, NTOK, WIN, D, 0};
            pg8::StaticOrder S; S.init(NTOK, WIN, P.G, P.bid);
            EpiNone E{(unsigned*)(P.ws + WS_CTL) + 64};
            pg8::gemm_phase<EpiNone, pg8::StaticOrder, true, true>(P.lds, g, S, E);
            SEAM(pb + 0);
        }
        if (PROBE_WOUT_NOEPI && IN(pb + 2)) {
            PHASE_CTX(P);
            pg8::Gemm g{P.HB(), (const bf16*)(P.ws + WS_WOUT) + (size_t)l * D * D, NTOK, D, D, 0};
            pg8::StaticOrder S; S.init(NTOK, D, P.G, P.bid);
            EpiNone E{(unsigned*)(P.ws + WS_CTL) + 64};
            pg8::gemm_phase<EpiNone, pg8::StaticOrder, true, true>(P.lds, g, S, E);
            SEAM(pb + 0);
        }
        if (PROBE_FF2_NOEPI && IN(pb + 2)) {
            PHASE_CTX(P);
            pg8::Gemm g{(const bf16*)(P.ws + WS_WD13), (const bf16*)(P.ws + WS_WD2) + (size_t)li * D * FFD, NTOK, D, FFD, 0};
            pg8::StaticOrder S; S.init(NTOK, D, P.G, P.bid);
            EpiNone E{(unsigned*)(P.ws + WS_CTL) + 64};
            pg8::gemm_phase<EpiNone, pg8::StaticOrder, true, true>(P.lds, g, S, E);
            SEAM(pb + 0);
        }
        if (IN(pb + 0)) for (int rep = 0; rep < REP_PROJ; ++rep) {
            PHASE_CTX(P);
            pg8::Gemm g{P.HB(), (const bf16*)(P.ws + WS_WIN) + (size_t)l * WIN * D, NTOK, WIN, D, 0};
            pg8::StaticOrder S; S.init(NTOK, WIN, P.G, P.bid);
            EpiProj E{P.PROJ(), P.LOGF(), P.SSQ(), P.LB() + l * 512};
            pg8::gemm_phase<EpiProj, pg8::StaticOrder, true, true>(P.lds, g, S, E);
            SEAM(pb + 0);
        }
        if (IN(pb + 1)) for (int rep = 0; rep < REP_MIX; ++rep) { PHASE_CTX(P); mixer_phase(P, l); SEAM(pb + 1); }
        if (IN(pb + 2)) {
            PHASE_CTX(P);
            pg8::Gemm g{P.MIX(), (const bf16*)(P.ws + WS_WOUT) + (size_t)l * D * D, NTOK, D, D, 0};
            pg8::StaticOrder S; S.init(MAINROWS, D, P.G, P.bid);
            EpiResid E{P.H(), P.HB(), P.SSQ()};
            pg8::gemm_phase<EpiResid, pg8::StaticOrder, true, true>(P.lds, g, S, E);
            mini_resid_phase(P, g.A, g.Bt, D, MAINROWS);
            SEAM(pb + 2);
        }
        if (!moe) {
            if (IN(pb + 5)) for (int rep = 0; rep < REP_FF1; ++rep) {
                PHASE_CTX(P);
                pg8::Gemm g{P.HB(), (const bf16*)(P.ws + WS_WD13) + (size_t)li * 2 * FFD * D, NTOK, 2 * FFD, D, 0};
                pg8::StaticOrder S; S.init(NTOK, 2 * FFD, P.G, P.bid);
                EpiGLU E{P.T(), FFD, P.SSQ()};
                pg8::gemm_phase<EpiGLU, pg8::StaticOrder, true, true>(P.lds, g, S, E);
                SEAM(pb + 5);
            }
            if (IN(pb + 6)) {
                PHASE_CTX(P);
                pg8::Gemm g{P.T(), (const bf16*)(P.ws + WS_WD2) + (size_t)li * D * FFD, NTOK, D, FFD, 0};
                pg8::StaticOrder S; S.init(MAINROWS, D, P.G, P.bid);
                EpiResid E{P.H(), P.HB(), P.SSQ()};
                pg8::gemm_phase<EpiResid, pg8::StaticOrder, true, true>(P.lds, g, S, E);
                mini_resid_phase(P, g.A, g.Bt, FFD, MAINROWS);
                SEAM(pb + 6);
            }
        } else {
            if (IN(pb + 3)) { PHASE_CTX(P); route_phase(P, li); SEAM(pb + 3); }
            if (IN(pb + 4)) for (int rep = 0; rep < REP_GATHER; ++rep) { PHASE_CTX(P); gather_phase(P, li); SEAM(pb + 4); }
            if (IN(pb + 5)) for (int rep = 0; rep < REP_FF1; ++rep) {
                PHASE_CTX(P);
                LAS int* pst = (LAS int*)(P.lds + RING_BYTES + 1024);
                load_panels(P, li, pst);
#define PS(i) __builtin_amdgcn_readfirstlane(pst[i])
                pg8::GroupedOrder S{PS(0), PS(1), PS(2), PS(3), PS(4), PS(5), PS(6), PS(7), PS(8), 2 * FFE / 256, P.G, P.bid};
                pg8::Gemm g{P.XG(), (const bf16*)(P.ws + WS_WM13) + (size_t)li * 8 * 2 * FFE * D, 0, 2 * FFE, D, (size_t)2 * FFE * D * 2};
                EpiGLU E{P.T(), FFE, nullptr};
                pg8::gemm_phase<EpiGLU, pg8::GroupedOrder, true, true>(P.lds, g, S, E);
                SEAM(pb + 5);
            }
            if (IN(pb + 6)) {
                PHASE_CTX(P);
                LAS int* pst = (LAS int*)(P.lds + RING_BYTES + 1024);
                load_panels(P, li, pst);
                const int ptot = PS(8), pfull = (ptot / 64) * 64, plim = (ptot - pfull <= 32) ? pfull : ptot;
                pg8::GroupedPanelOrder S{PS(1), PS(2), PS(3), PS(4), PS(5), PS(6), PS(7), plim, D / 256, P.G, P.bid};
                pg8::Gemm g{P.T(), (const bf16*)(P.ws + WS_WM2) + (size_t)li * 8 * D * FFE, 0, D, FFE, (size_t)D * FFE * 2};
                EpiY E{P.Y()};
                pg8::gemm_phase<EpiY, pg8::GroupedPanelOrder, true, true>(P.lds, g, S, E);
                mini_y_phase(P, g.A, g.Bt, (size_t)D * FFE, FFE, plim, ptot, PS(1), PS(2), PS(3), PS(4), PS(5), PS(6), PS(7));
                SEAM(pb + 6);
            }
#undef PS
            if (IN(pb + 7)) { PHASE_CTX(P); combine_phase(P, li, l == DEPTH - 1); SEAM(pb + 7); }
        }
    }
#undef IN
#undef SEAM
#undef PHASE_CTX
}

extern "C" void kernel_launch(void* const* d_in, const int* in_sizes, int n_in, void* d_out, int out_size, void* d_ws, size_t ws_size, hipStream_t stream) {
    static int grid = 0;
    if (grid == 0) {
        if (n_in != 19 || out_size != NB * SEQ * D || ws_size < WS_END) { fprintf(stderr, "kernel_launch: unexpected shapes (n_in %d, out %d, ws %zu < %zu); nothing launched\n", n_in, out_size, ws_size, (size_t)WS_END); grid = -1; return; }
        int dev = 0, cus = 0, per_cu = 0;
        if (hipGetDevice(&dev) != hipSuccess || hipDeviceGetAttribute(&cus, hipDeviceAttributeMultiprocessorCount, dev) != hipSuccess) { grid = -1; return; }
        if (hipFuncSetAttribute((const void*)mk_fwd, hipFuncAttributeMaxDynamicSharedMemorySize, LDS_BYTES) != hipSuccess) { fprintf(stderr, "kernel_launch: hipFuncSetAttribute failed\n"); grid = -1; return; }
        if (hipOccupancyMaxActiveBlocksPerMultiprocessor(&per_cu, (const void*)mk_fwd, 512, LDS_BYTES) != hipSuccess || per_cu < 1) { fprintf(stderr, "kernel_launch: occupancy query says %d blocks per CU\n", per_cu); }
        (void)hipGetLastError();
        grid = cus;
    }
    if (grid < 0) return;
    if (hipMemsetAsync((char*)d_ws + WS_CTL, 0, CTL_ZERO_BYTES, stream) != hipSuccess) return;
    Args a{};
    for (int i = 0; i < 19; ++i) a.in[i] = (const float*)d_in[i];
    a.out = (float*)d_out; a.ws = (unsigned char*)d_ws;
#if MK_ONE_LAUNCH
    a.ph_lo = 0; a.ph_hi = NPHASE;
    hipLaunchKernelGGL(mk_fwd, dim3(grid), dim3(512), LDS_BYTES, stream, a);
#else
    for (int p = 0; p < NPHASE; ++p) {
        if (p > 0) { const int l = (p - 1) / 8, k = (p - 1) % 8; const bool moe = (l & 1) != 0; if (!moe && (k == 3 || k == 4 || k == 7)) continue; }
        a.ph_lo = p; a.ph_hi = p + 1;
        hipLaunchKernelGGL(mk_fwd, dim3(grid), dim3(512), LDS_BYTES, stream, a);
    }
#endif
}
```

```cpp
#include <hip/hip_runtime.h>
#include <cstdio>
#include <cstdint>

#ifndef REP_ATT
#define REP_ATT 1
#endif
#ifndef REP_HG
#define REP_HG 1
#endif
#ifndef PROBE_PROJ_NOEPI
#define PROBE_PROJ_NOEPI 0
#endif
#ifndef PROBE_WOUT_NOEPI
#define PROBE_WOUT_NOEPI 0
#endif
#ifndef PROBE_FF2_NOEPI
#define PROBE_FF2_NOEPI 0
#endif
#ifndef REP_PRO
#define REP_PRO 1
#endif
#ifndef REP_PROJ
#define REP_PROJ 1
#endif
#ifndef REP_MIX
#define REP_MIX 1
#endif
#ifndef REP_FF1
#define REP_FF1 1
#endif
#ifndef REP_GATHER
#define REP_GATHER 1
#endif
#ifndef MK_ONE_LAUNCH
#define MK_ONE_LAUNCH 1
#endif

namespace pg8 {
#define PG8_LAS __attribute__((address_space(3)))
typedef unsigned short bf16_t;
typedef short bf16x8 __attribute__((ext_vector_type(8)));
typedef float f32x4 __attribute__((ext_vector_type(4)));
typedef unsigned u32x4 __attribute__((ext_vector_type(4)));
typedef unsigned u32x2 __attribute__((ext_vector_type(2)));
constexpr int BM = 256, BK = 64, HALF = 128, HTB = HALF * BK * 2  , STAGE_BYTES = 8 * HTB, NXCD = 8, WGM = 8;

__host__ __device__ __forceinline__ int lds_byte(int r, int c) { const int st = (r >> 4) * 2 + (c >> 5), rr = r & 15, cc = c & 31, ob = rr * 64 + cc * 2; return st * 1024 + (ob ^ (((ob >> 9) & 1) << 5)); }
__host__ __device__ __forceinline__ void stage_rc(int b, int& R, int& C) { const int st = b / 1024, sb = b % 1024, swz = sb ^ (((sb >> 9) & 1) << 5); R = (st >> 1) * 16 + swz / 64; C = (st & 1) * 32 + (swz % 64) / 2; }
__host__ __device__ __forceinline__ int perm32(int rho) { const int n = rho >> 4, i = rho & 15; return 8 * (i >> 2) + 4 * n + (i & 3); }

struct Unit { int pm, pn, e, idx; };
struct Gemm { const bf16_t* A; const bf16_t* Bt; int M, N, K; size_t bstride; };

struct StaticOrder {
    int nM, nN, nwg, G, c;
    __host__ __device__ void init(int M, int N, int G_, int c_) { nM = M / BM; nN = N / BM; nwg = nM * nN; G = G_; c = c_; }
    __host__ __device__ bool next(int i, Unit& u) const {
        const long L = (long)i * G + c; if (L >= nwg) return false;
        int wgid = (int)L; { const int q = nwg / NXCD, r = nwg % NXCD, xcd = wgid % NXCD, off = wgid / NXCD; wgid = (xcd < r ? xcd * (q + 1) : r * (q + 1) + (xcd - r) * q) + off; }
        const int nig = WGM * nN, gid = wgid / nig, fm = gid * WGM, gsz = (nM - fm) < WGM ? (nM - fm) : WGM;
        u.pm = fm + ((wgid % nig) % gsz); u.pn = (wgid % nig) / gsz; u.e = 0; u.idx = i; return true;
    }
    __device__ __forceinline__ void a_ready(const Unit&) const {}
    __device__ __forceinline__ void done(const Unit&) const {}
};
struct GroupedPanelOrder {
    int p1, p2, p3, p4, p5, p6, p7, plim, nN, G, c;
    __device__ __forceinline__ bool next(int i, Unit& u) const {
        const int L = i * G + c; if (L >= plim * nN) return false;
        const int pm = L / nN; u.pm = pm; u.pn = L - pm * nN;
        u.e = (pm >= p1) + (pm >= p2) + (pm >= p3) + (pm >= p4) + (pm >= p5) + (pm >= p6) + (pm >= p7); u.idx = i; return true;
    }
    __device__ __forceinline__ void a_ready(const Unit&) const {}
    __device__ __forceinline__ void done(const Unit&) const {}
};
struct GroupedOrder {
    int p0, p1, p2, p3, p4, p5, p6, p7, p8, nN, G, c;
    __device__ __forceinline__ bool next(int i, Unit& u) const {
        const int L = i * G + c; if (L >= p8 * nN) return false;
        int e = 0, ps = 0, pe = p1;
        if (L >= p1 * nN) { e = 1; ps = p1; pe = p2; }
        if (L >= p2 * nN) { e = 2; ps = p2; pe = p3; }
        if (L >= p3 * nN) { e = 3; ps = p3; pe = p4; }
        if (L >= p4 * nN) { e = 4; ps = p4; pe = p5; }
        if (L >= p5 * nN) { e = 5; ps = p5; pe = p6; }
        if (L >= p6 * nN) { e = 6; ps = p6; pe = p7; }
        if (L >= p7 * nN) { e = 7; ps = p7; pe = p8; }
        const int rem = L - ps * nN, R = pe - ps;
        u.e = e; u.pn = rem / R; u.pm = ps + rem % R; u.idx = i; return true;
    }
    __device__ __forceinline__ void a_ready(const Unit&) const {}
    __device__ __forceinline__ void done(const Unit&) const {}
};

__device__ __forceinline__ unsigned cvt_pk_bf16(float lo, float hi) { unsigned r; asm volatile("v_cvt_pk_bf16_f32 %0, %1, %2" : "=v"(r) : "v"(lo), "v"(hi)); return r; }

template <class Epi, class Sched, bool ALIGN_EPI = false, bool SP2 = false>
__device__ __forceinline__ void gemm_phase(PG8_LAS unsigned char* lds, const Gemm g, const Sched& S, const Epi& E) {
    int tid_l = threadIdx.x; asm volatile("" : "+v"(tid_l));
    const int tid = tid_l, wid = __builtin_amdgcn_readfirstlane(tid >> 6), lane = tid & 63, wr = wid >> 2, wc = wid & 3, fr = lane & 15, fq = lane >> 4;
    const int K = g.K, nt = K / BK;
    unsigned voffA[2], voffB[2];
#pragma unroll
    for (int i = 0; i < 2; ++i) { int R, C; stage_rc(tid * 16 + i * 8192, R, C); const int Rb = Epi::PERM ? ((R & ~31) + perm32(R & 31)) : R;
        voffA[i] = (unsigned)(R * K + C) * 2u; voffB[i] = (unsigned)(Rb * K + C) * 2u; }
    const size_t kstep = (size_t)(BK * 2);
    const size_t hstep = (size_t)HALF * K * 2;
    const size_t tstep = 2 * hstep;
    const unsigned ldsw = (unsigned)wid * 1024u;
    const int aoff = lds_byte(wr * 64 + fr, fq * 8), boff = lds_byte(wc * 32 + fr, fq * 8);
#define PG8_SA(b, h) (((b) * 2 + (h)) * HTB)
#define PG8_SB(b, h) ((4 + (b) * 2 + (h)) * HTB)
#define PG8_STAGE(bufoff, gbase, voff) do { _Pragma("unroll") for (int _i = 0; _i < 2; ++_i) \
        __builtin_amdgcn_global_load_lds((const unsigned*)((const char*)(gbase) + (voff)[_i]), (PG8_LAS unsigned*)(lds + (bufoff) + ldsw + _i * 8192), 16, 0, 0); } while (0)
#define PG8_LDA(dst, b, h) do { _Pragma("unroll") for (int m = 0; m < 4; ++m) _Pragma("unroll") for (int k = 0; k < 2; ++k) dst[m][k] = *(const PG8_LAS bf16x8*)(lds + PG8_SA(b, h) + aoff + m * 2048 + k * 1024); } while (0)
#define PG8_LDB(dst, b, h) do { _Pragma("unroll") for (int n = 0; n < 2; ++n) _Pragma("unroll") for (int k = 0; k < 2; ++k) dst[n][k] = *(const PG8_LAS bf16x8*)(lds + PG8_SB(b, h) + boff + n * 2048 + k * 1024); } while (0)
#define PG8_MMA(ai, bj, At, Bt) do { __builtin_amdgcn_s_setprio(1); _Pragma("unroll") for (int m = 0; m < 4; ++m) _Pragma("unroll") for (int n = 0; n < 2; ++n) _Pragma("unroll") for (int k = 0; k < 2; ++k) \
        acc[ai][bj][m][n] = __builtin_amdgcn_mfma_f32_16x16x32_bf16(Bt[n][k], At[m][k], acc[ai][bj][m][n], 0, 0, 0); __builtin_amdgcn_s_setprio(0); } while (0)
#define PG8_WAIT_V(n) asm volatile("s_waitcnt vmcnt(" #n ")" ::: "memory")
#define PG8_WAIT_L(n) asm volatile("s_waitcnt lgkmcnt(" #n ")" ::: "memory")
#define PG8_BAR __builtin_amdgcn_s_barrier()
#define PG8_SCHED __builtin_amdgcn_sched_barrier(0)
    Unit cur, nxt; int ui = 0;
    if (!S.next(0, cur)) return;
    f32x4 acc[2][2][4][2];
#pragma unroll
    for (int a = 0; a < 2; ++a)
#pragma unroll
        for (int b = 0; b < 2; ++b)
#pragma unroll
            for (int m = 0; m < 4; ++m)
#pragma unroll
                for (int n = 0; n < 2; ++n) acc[a][b][m][n] = (f32x4){0.f, 0.f, 0.f, 0.f};
    bf16x8 At[4][2], B0[2][2], B1[2][2];
    const char* cA = (const char*)g.A + (size_t)cur.pm * tstep; const char* cB = (const char*)g.Bt + (size_t)cur.e * g.bstride + (size_t)cur.pn * tstep;
    S.a_ready(cur);
    if constexpr (SP2) {
        PG8_STAGE(PG8_SB(0, 0), cB, voffB); PG8_STAGE(PG8_SB(0, 1), cB + hstep, voffB); PG8_STAGE(PG8_SA(0, 0), cA, voffA); PG8_STAGE(PG8_SA(0, 1), cA + hstep, voffA);
        if (wr == 1) PG8_BAR;
        PG8_WAIT_V(2); PG8_BAR;
        PG8_STAGE(PG8_SB(1, 0), cB + kstep, voffB); PG8_STAGE(PG8_SA(1, 0), cA + kstep, voffA); PG8_STAGE(PG8_SB(1, 1), cB + hstep + kstep, voffB);
        PG8_WAIT_V(6); PG8_BAR;
    } else {
        PG8_STAGE(PG8_SB(0, 0), cB, voffB); PG8_STAGE(PG8_SA(0, 0), cA, voffA); PG8_STAGE(PG8_SB(0, 1), cB + hstep, voffB); PG8_STAGE(PG8_SA(0, 1), cA + hstep, voffA);
        if (wr == 1) PG8_BAR;
        PG8_WAIT_V(4); PG8_BAR;
        PG8_STAGE(PG8_SB(1, 0), cB + kstep, voffB); PG8_STAGE(PG8_SA(1, 0), cA + kstep, voffA); PG8_STAGE(PG8_SB(1, 1), cB + hstep + kstep, voffB);
        PG8_WAIT_V(6); PG8_BAR;
    }
    for (;;) {
        const bool has_next = S.next(ui + 1, nxt);
        const char* nA = has_next ? (const char*)g.A + (size_t)nxt.pm * tstep : cA; const char* nB = has_next ? (const char*)g.Bt + (size_t)nxt.e * g.bstride + (size_t)nxt.pn * tstep : cB;
        for (int t = 0; t < nt; t += 2) {
            const bool last = (t == nt - 2);
            const char* a1 = cA + (size_t)(t + 1) * kstep;
            const char* a2 = last ? nA : cA + (size_t)(t + 2) * kstep; const char* b2 = last ? nB : cB + (size_t)(t + 2) * kstep;
            const char* a3 = a2 + kstep; const char* b3 = b2 + kstep;
            if (last && has_next) S.a_ready(nxt);
            if constexpr (SP2) {
            PG8_LDB(B0, 0, 0); PG8_LDB(B1, 0, 1); PG8_SCHED; PG8_LDA(At, 0, 0); PG8_STAGE(PG8_SA(1, 1), a1 + hstep, voffA);
            PG8_WAIT_V(8); PG8_WAIT_L(0); PG8_BAR; PG8_MMA(0, 0, At, B0); PG8_MMA(0, 1, At, B1); PG8_BAR; PG8_SCHED;
            PG8_LDA(At, 0, 1); PG8_STAGE(PG8_SB(0, 0), b2, voffB); PG8_STAGE(PG8_SB(0, 1), b2 + hstep, voffB); PG8_STAGE(PG8_SA(0, 0), a2, voffA);
            PG8_WAIT_V(8); PG8_WAIT_L(0); PG8_BAR; PG8_MMA(1, 0, At, B0); PG8_MMA(1, 1, At, B1); PG8_BAR; PG8_SCHED;
            PG8_LDB(B0, 1, 0); PG8_LDB(B1, 1, 1); PG8_SCHED; PG8_LDA(At, 1, 0); PG8_STAGE(PG8_SA(0, 1), a2 + hstep, voffA);
            PG8_WAIT_V(8); PG8_WAIT_L(0); PG8_BAR; PG8_MMA(0, 0, At, B0); PG8_MMA(0, 1, At, B1); PG8_BAR; PG8_SCHED;
            PG8_LDA(At, 1, 1); PG8_STAGE(PG8_SB(1, 0), b3, voffB); PG8_STAGE(PG8_SB(1, 1), b3 + hstep, voffB); PG8_STAGE(PG8_SA(1, 0), a3, voffA);
            PG8_WAIT_V(8); PG8_WAIT_L(0); PG8_BAR; PG8_MMA(1, 0, At, B0); PG8_MMA(1, 1, At, B1); PG8_BAR; PG8_SCHED;
            } else {
            PG8_LDB(B0, 0, 0); PG8_SCHED; PG8_LDA(At, 0, 0); PG8_STAGE(PG8_SA(1, 1), a1 + hstep, voffA);
            PG8_WAIT_L(8); PG8_BAR; PG8_WAIT_L(0); PG8_MMA(0, 0, At, B0); PG8_BAR; PG8_SCHED;
            PG8_LDB(B1, 0, 1); PG8_STAGE(PG8_SB(0, 0), b2, voffB);
            PG8_BAR; PG8_WAIT_L(0); PG8_MMA(0, 1, At, B1); PG8_BAR;
            PG8_LDA(At, 0, 1); PG8_STAGE(PG8_SA(0, 0), a2, voffA);
            PG8_BAR; PG8_WAIT_L(0); PG8_MMA(1, 0, At, B0); PG8_BAR; PG8_SCHED;
            PG8_STAGE(PG8_SB(0, 1), b2 + hstep, voffB);
            PG8_WAIT_V(6); PG8_BAR; PG8_MMA(1, 1, At, B1); PG8_BAR;
            PG8_LDB(B0, 1, 0); PG8_SCHED; PG8_LDA(At, 1, 0); PG8_STAGE(PG8_SA(0, 1), a2 + hstep, voffA);
            PG8_WAIT_L(8); PG8_BAR; PG8_WAIT_L(0); PG8_MMA(0, 0, At, B0); PG8_BAR; PG8_SCHED;
            PG8_LDB(B1, 1, 1); PG8_STAGE(PG8_SB(1, 0), b3, voffB);
            PG8_BAR; PG8_WAIT_L(0); PG8_MMA(0, 1, At, B1); PG8_BAR;
            PG8_LDA(At, 1, 1); PG8_STAGE(PG8_SA(1, 0), a3, voffA);
            PG8_BAR; PG8_WAIT_L(0); PG8_MMA(1, 0, At, B0); PG8_BAR; PG8_SCHED;
            PG8_STAGE(PG8_SB(1, 1), b3 + hstep, voffB);
            PG8_WAIT_V(6); PG8_BAR; PG8_MMA(1, 1, At, B1); PG8_BAR;
            }
        }
        if constexpr (ALIGN_EPI) { if (wr == 0) PG8_BAR; }
        if constexpr (!Epi::AFTER_DRAIN) { E(acc, cur, wr, wc, fr, fq); S.done(cur); }
        if (!has_next) break;
#pragma unroll
        for (int a = 0; a < 2; ++a)
#pragma unroll
            for (int b = 0; b < 2; ++b)
#pragma unroll
                for (int m = 0; m < 4; ++m)
#pragma unroll
                    for (int n = 0; n < 2; ++n) acc[a][b][m][n] = (f32x4){0.f, 0.f, 0.f, 0.f};
        cur = nxt; cA = nA; cB = nB; ++ui;
        if constexpr (ALIGN_EPI) { if (wr == 1) PG8_BAR; }
    }
    PG8_WAIT_V(0);
    if constexpr (!ALIGN_EPI) { if (wr == 0) PG8_BAR; }
    PG8_BAR;
    if constexpr (Epi::AFTER_DRAIN) { E.fused(acc, cur, wr, wc, fr, fq, lds, wid, lane); S.done(cur); }
#undef PG8_SA
#undef PG8_SB
#undef PG8_STAGE
#undef PG8_LDA
#undef PG8_LDB
#undef PG8_MMA
#undef PG8_WAIT_V
#undef PG8_WAIT_L
#undef PG8_BAR
#undef PG8_SCHED
}

}

constexpr int D = 1024, NB = 8, SEQ = 2048, DEPTH = 4, LEAD = 128, FIRSTV = 112, LT = LEAD + SEQ, NTOK = NB * LT;
constexpr int WIN = 3584, FFD = 2816, FFE = 3584, NE = 8, MAXSLOT = 36864;
constexpr float EPS = 1e-6f;
constexpr int NPHASE = 1 + 8 * DEPTH;
constexpr int MAINROWS = (NTOK / (64 * 256)) * (64 * 256);

constexpr size_t MiB = 1u << 20;
constexpr size_t WS_CTL = 0, CTL_ZERO_BYTES = MiB;
constexpr size_t WS_TAB = 1 * MiB;
constexpr size_t WS_WIN = 2 * MiB;
constexpr size_t WS_WOUT = WS_WIN + 28 * MiB;
constexpr size_t WS_WD13 = WS_WOUT + 8 * MiB;
constexpr size_t WS_WD2 = WS_WD13 + 22 * MiB;
constexpr size_t WS_WM13 = WS_WD2 + 11 * MiB;
constexpr size_t WS_WM2 = WS_WM13 + 224 * MiB;
constexpr size_t WS_H = WS_WM2 + 112 * MiB;
constexpr size_t WS_HB = WS_H + 68 * MiB;
constexpr size_t WS_SSQ = WS_HB + 34 * MiB;
constexpr size_t WS_ROUTE = WS_SSQ + 2 * MiB;
constexpr size_t WS_ACT = WS_ROUTE + 2 * MiB;
constexpr size_t WS_XG = WS_ACT + 252 * MiB;
constexpr size_t WS_END = WS_XG + 72 * MiB;
constexpr size_t ACT_PROJ = 0, ACT_LOGF = 119 * MiB, ACT_MIX = 153 * MiB;
constexpr size_t TAB_LB = 0, TAB_BIAS = 8192, TAB_LAM = 12288, TAB_SUBLN = 12544, TAB_HGNW = 14592, TAB_RF = 20480, TAB_FNORM = 20480 + 65536;
constexpr size_t ROUTE_INFO = 0, ROUTE_LIST = 640 * 1024, ROUTE_RSTD = 1280 * 1024;
constexpr int CW_TMO = 0, CW_BAR = 4096, CW_CNT = 8192;

constexpr int RING_BYTES = 131072, MISC_OFF = RING_BYTES + 320, LDS_BYTES = 147456;

#define GAS __attribute__((address_space(1)))
#define LAS __attribute__((address_space(3)))
typedef unsigned short bf16;
typedef unsigned v4u __attribute__((ext_vector_type(4)));
typedef unsigned v2u __attribute__((ext_vector_type(2)));
typedef float f32x4 __attribute__((ext_vector_type(4)));
typedef GAS unsigned gu32;
#define RLX_AGENT __ATOMIC_RELAXED, __HIP_MEMORY_SCOPE_AGENT
#define LDS_WAIT() asm volatile("s_waitcnt lgkmcnt(0)" ::: "memory")
__device__ __forceinline__ unsigned f2bf(float f) { unsigned u = __builtin_bit_cast(unsigned, f); return (u + 0x7fffu + ((u >> 16) & 1u)) >> 16; }
__device__ __forceinline__ unsigned pk2(float lo, float hi) { return f2bf(lo) | (f2bf(hi) << 16); }
__device__ __forceinline__ float bf_lo(unsigned w) { return __builtin_bit_cast(float, w << 16); }
__device__ __forceinline__ float bf_hi(unsigned w) { return __builtin_bit_cast(float, w & 0xffff0000u); }
__device__ __forceinline__ float silu_f(float x) { return x * __builtin_amdgcn_rcpf(1.f + __expf(-x)); }
__device__ __forceinline__ float wave_sum(float v) {
#pragma unroll
    for (int o = 1; o < 64; o <<= 1) v += __shfl_xor(v, o);
    return v;
}

#define XB_TMO      128
#define XB_XCNT(j)  (256  + 64 * (j))
#define XB_XSUB(j)  (1280 + 64 * (j))
#define XB_XGEN(j)  (2304 + 64 * (j))
#define XB_TOP      3328
#define XB_TOPGEN   3392
#define XCD_BAR_WORDS 3456
#define XB_SPIN_CAP (1u << 18)

__device__ __forceinline__ unsigned xb_ld(unsigned* p)              { return __hip_atomic_load(p, __ATOMIC_RELAXED, __HIP_MEMORY_SCOPE_AGENT); }
__device__ __forceinline__ unsigned xb_add(unsigned* p, unsigned v) { return __hip_atomic_fetch_add(p, v, __ATOMIC_RELAXED, __HIP_MEMORY_SCOPE_AGENT); }
__device__ __forceinline__ unsigned xb_xcc_id() { return (unsigned)__builtin_amdgcn_s_getreg((3 << 11) | 20) & 0xFu; }
#define XB_SPIN(cond, bar) do { unsigned _sp = 0; while (cond) { __builtin_amdgcn_s_sleep(1); \
    if ((++_sp & 255u) == 0u) { if (xb_ld(&(bar)[XB_TMO])) break; if (_sp > XB_SPIN_CAP) { atomicAdd(&(bar)[XB_TMO], 1u); break; } } } } while (0)

struct XcdBarrier {
    unsigned* bar; unsigned x;
    volatile LAS unsigned* st;
};

__device__ __forceinline__ XcdBarrier xcd_barrier_post(unsigned* bar, volatile LAS unsigned* st) {
    XcdBarrier b; b.bar = bar; b.x = xb_xcc_id(); b.st = st;
    if (threadIdx.x == 0) (void)xb_add(&bar[XB_XCNT(b.x)], 1u);
    return b;
}
__device__ __forceinline__ void xcd_barrier_complete(unsigned* bar, unsigned x, unsigned& nloc, unsigned& nx) {
    const unsigned G = gridDim.x * gridDim.y * gridDim.z;
    unsigned sum, cnt, mine, sp = 0u;
    for (;;) {
        sum = 0u; cnt = 0u; mine = 0u;
#pragma unroll
        for (unsigned j = 0; j < 16; ++j) { const unsigned c = xb_ld(&bar[XB_XCNT(j)]); sum += c; cnt += (c > 0u) ? 1u : 0u; mine = (j == x) ? c : mine; }
        if (sum == G) break;
        __builtin_amdgcn_s_sleep(1);
        if ((++sp & 255u) == 0u) { if (xb_ld(&bar[XB_TMO])) break; if (sp > XB_SPIN_CAP) { atomicAdd(&bar[XB_TMO], 1u); break; } }
    }
    nloc = mine > 0u ? mine : 1u; nx = cnt > 0u ? cnt : 1u;
}

__device__ __forceinline__ void xcd_barrier(const XcdBarrier& b) {
    asm volatile("s_waitcnt vmcnt(0)" ::: "memory");
    __syncthreads();
    if (threadIdx.x == 0) {
        unsigned* bar = b.bar;
        __builtin_amdgcn_s_waitcnt(0);
        unsigned nloc = b.st[0], nx = b.st[1];
        if (nloc == 0u) { xcd_barrier_complete(bar, b.x, nloc, nx); b.st[0] = nloc; b.st[1] = nx; }
        const unsigned old = xb_add(&bar[XB_XSUB(b.x)], 1u);
        const unsigned gen = old / nloc;
        if (old + 1u == (gen + 1u) * nloc) {
            __builtin_amdgcn_fence(__ATOMIC_RELEASE, "agent");
            asm volatile("s_waitcnt vmcnt(0)" ::: "memory");
            const unsigned og = xb_add(&bar[XB_TOP], 1u);
            const unsigned tg = og / nx;
            if (og + 1u == (tg + 1u) * nx) xb_add(&bar[XB_TOPGEN], 1u);
            else XB_SPIN(xb_ld(&bar[XB_TOPGEN]) == tg, bar);
            __builtin_amdgcn_fence(__ATOMIC_ACQUIRE, "agent");
            xb_add(&bar[XB_XGEN(b.x)], 1u);
            asm volatile("s_waitcnt vmcnt(0)" ::: "memory");
        } else {
            XB_SPIN(xb_ld(&bar[XB_XGEN(b.x)]) == gen, bar);
            __builtin_amdgcn_fence(__ATOMIC_ACQUIRE, "agent");
            asm volatile("s_waitcnt vmcnt(0)" ::: "memory");
        }
    }
    __syncthreads();
}


static __device__ const unsigned char T5B[129] = {0, 1, 2, 3, 4, 5, 6, 7, 8, 9, 10, 11, 12, 13, 14, 15, 16, 16, 16, 17, 17, 18, 18, 18, 19, 19, 19, 20, 20, 20, 20, 21, 21, 21, 21, 22, 22, 22, 22, 22, 23, 23, 23, 23, 23, 23, 24, 24, 24, 24, 24, 24, 25, 25, 25, 25, 25, 25, 25, 26, 26, 26, 26, 26, 26, 26, 26, 27, 27, 27, 27, 27, 27, 27, 27, 27, 27, 28, 28, 28, 28, 28, 28, 28, 28, 28, 28, 29, 29, 29, 29, 29, 29, 29, 29, 29, 29, 29, 29, 30, 30, 30, 30, 30, 30, 30, 30, 30, 30, 30, 30, 30, 30, 31, 31, 31, 31, 31, 31, 31, 31, 31, 31, 31, 31, 31, 31, 31, 31};

struct Ctx {
    LAS unsigned char* lds;
    int tid, lane, wave, G, bid;
    float* out;
    unsigned char* ws;
    __device__ __forceinline__ gu32* ctl() const { return (gu32*)(ws + WS_CTL); }
    __device__ __forceinline__ float* H() const { return (float*)(ws + WS_H); }
    __device__ __forceinline__ bf16* HB() const { return (bf16*)(ws + WS_HB); }
    __device__ __forceinline__ float* SSQ() const { return (float*)(ws + WS_SSQ); }
    __device__ __forceinline__ bf16* PROJ() const { return (bf16*)(ws + WS_ACT + ACT_PROJ); }
    __device__ __forceinline__ float* LOGF() const { return (float*)(ws + WS_ACT + ACT_LOGF); }
    __device__ __forceinline__ bf16* MIX() const { return (bf16*)(ws + WS_ACT + ACT_MIX); }
    __device__ __forceinline__ bf16* T() const { return (bf16*)(ws + WS_ACT); }
    __device__ __forceinline__ bf16* XG() const { return (bf16*)(ws + WS_XG); }
    __device__ __forceinline__ bf16* Y() const { return (bf16*)(ws + WS_XG); }
    __device__ __forceinline__ float* LB() const { return (float*)(ws + WS_TAB + TAB_LB); }
    __device__ __forceinline__ float* BIAST() const { return (float*)(ws + WS_TAB + TAB_BIAS); }
    __device__ __forceinline__ float* LAM() const { return (float*)(ws + WS_TAB + TAB_LAM); }
    __device__ __forceinline__ float* RF() const { return (float*)(ws + WS_TAB + TAB_RF); }
    __device__ __forceinline__ float* SUBLN() const { return (float*)(ws + WS_TAB + TAB_SUBLN); }
    __device__ __forceinline__ float* HGNW() const { return (float*)(ws + WS_TAB + TAB_HGNW); }
    __device__ __forceinline__ float* FNORM() const { return (float*)(ws + WS_TAB + TAB_FNORM); }
    __device__ __forceinline__ unsigned* TINFO() const { return (unsigned*)(ws + WS_ROUTE + ROUTE_INFO); }
    __device__ __forceinline__ int* LIST() const { return (int*)(ws + WS_ROUTE + ROUTE_LIST); }
    __device__ __forceinline__ float* RSTD() const { return (float*)(ws + WS_ROUTE + ROUTE_RSTD); }
};
struct Args { const float* in[19]; float* out; unsigned char* ws; int ph_lo, ph_hi; };
enum { IN_X = 0, IN_META, IN_RELB, IN_NMIX, IN_WIN, IN_LBL, IN_HGNW, IN_LAMBDA, IN_SUBLN, IN_WOUT, IN_NFFN, IN_DW1, IN_DW3, IN_DW2, IN_ROUTER, IN_MW1, IN_MW3, IN_MW2, IN_FNORM };

__device__ __forceinline__ v2u pack4(float a, float b, float c, float d) { v2u w; w.x = pg8::cvt_pk_bf16(a, b); w.y = pg8::cvt_pk_bf16(c, d); return w; }
__device__ __forceinline__ float row_rstd(const float* ssq, int row) {
    const f32x4* p = (const f32x4*)(ssq + (size_t)row * 16);
    const f32x4 a = p[0], b = p[1], c = p[2], d = p[3];
    const float s = ((a[0] + a[1]) + (a[2] + a[3])) + ((b[0] + b[1]) + (b[2] + b[3])) + ((c[0] + c[1]) + (c[2] + c[3])) + ((d[0] + d[1]) + (d[2] + d[3]));
    return rsqrtf(s * (1.0f / 1024.0f) + EPS);
}
template <int N> __device__ __forceinline__ float dpp_row_shr(float x) {
    return __builtin_bit_cast(float, __builtin_amdgcn_update_dpp(0, __builtin_bit_cast(int, x), 0x110 + N, 0xf, 0xf, true));
}
constexpr int RS_OFF = RING_BYTES + 4096, RS_MAXU = 12;
template <class Sched> __device__ __forceinline__ void rstd_table(LAS unsigned char* lds, const float* ssq, const Sched& S, int tid) {
    LAS float* rs = (LAS float*)(lds + RS_OFF);
    pg8::Unit u;
    for (int i0 = 0; i0 < RS_MAXU; i0 += 2) {
        const int i = i0 + (tid >> 8);
        if (S.next(i, u)) rs[i * 256 + (tid & 255)] = row_rstd(ssq, u.pm * 256 + (tid & 255));
    }
    __syncthreads();
}
struct EpiProj {
    static constexpr bool PERM = true, AFTER_DRAIN = false;
    bf16* proj; float* logfp; const LAS float* rs; const float* lb;
    template <int AI, int BJ, int NN> __device__ __forceinline__ void hf_block(const pg8::f32x4 (&acc)[2][2][4][2], int row0, int colb, const LAS float* rsu) const {
        const int c0 = colb + BJ * 128 + 4 * NN, cc = c0 - 512;
        const f32x4 l0 = *(const f32x4*)(lb + cc);
        float lf[4][4];
#pragma unroll
        for (int m = 0; m < 4; ++m) {
            const int row = row0 + AI * 128 + m * 16;
            const float r = rsu[AI * 128 + m * 16];
            const bool valid = (row % LT) >= FIRSTV;
            float kx[4];
#pragma unroll
            for (int j = 0; j < 4; ++j) {
                const float lbv = l0[j];
                const float xx = acc[AI][BJ][m][NN][j] * r;
                const float xc = fminf(fmaxf(xx, -30.f), 30.f);
                const float te = __expf(-xc), sg = __builtin_amdgcn_rcpf(1.f + te);
                float lgf = __logf(lbv + (1.f - lbv) * sg);
                float kk = (1.f - lbv) * (te * sg);
                if (!valid) { lgf = 0.f; kk = 0.f; }
                lf[m][j] = lgf; kx[j] = kk;
            }
            v2u w; w.x = pg8::cvt_pk_bf16(kx[0], kx[1]); w.y = pg8::cvt_pk_bf16(kx[2], kx[3]);
            *(v2u*)(proj + (size_t)row * WIN + c0) = w;
        }
#pragma unroll
        for (int j = 0; j < 4; ++j) {
            float carry = 0.f;
#pragma unroll
            for (int m = 0; m < 4; ++m) {
                float x = lf[m][j];
                x += dpp_row_shr<1>(x); x += dpp_row_shr<2>(x); x += dpp_row_shr<4>(x); x += dpp_row_shr<8>(x);
                x += carry;
                carry = __shfl(x, 15, 16);
                lf[m][j] = x;
            }
        }
#pragma unroll
        for (int m = 0; m < 4; ++m) *(f32x4*)(logfp + (size_t)(row0 + AI * 128 + m * 16) * 512 + cc) = (f32x4){lf[m][0], lf[m][1], lf[m][2], lf[m][3]};
    }
    __device__ __forceinline__ void operator()(const pg8::f32x4 (&acc)[2][2][4][2], const pg8::Unit& u, int wr, int wc, int fr, int fq) const {
        const int grp = u.pn >> 1;
        const int row0 = u.pm * 256 + wr * 64 + fr, colb = u.pn * 256 + wc * 32 + 8 * fq;
        const LAS float* rsu = rs + u.idx * 256 + wr * 64 + fr;
        if (grp == 1) {
            hf_block<0, 0, 0>(acc, row0, colb, rsu); hf_block<0, 0, 1>(acc, row0, colb, rsu); hf_block<0, 1, 0>(acc, row0, colb, rsu); hf_block<0, 1, 1>(acc, row0, colb, rsu);
            hf_block<1, 0, 0>(acc, row0, colb, rsu); hf_block<1, 0, 1>(acc, row0, colb, rsu); hf_block<1, 1, 0>(acc, row0, colb, rsu); hf_block<1, 1, 1>(acc, row0, colb, rsu);
            return;
        }
#pragma unroll
        for (int ai = 0; ai < 2; ++ai)
#pragma unroll
            for (int m = 0; m < 4; ++m) {
                const int row = row0 + ai * 128 + m * 16;
                const float r = rsu[ai * 128 + m * 16];
#pragma unroll
                for (int bj = 0; bj < 2; ++bj) {
                    const int c0 = colb + bj * 128;
                    float x[8];
#pragma unroll
                    for (int j = 0; j < 4; ++j) { x[j] = acc[ai][bj][m][0][j] * r; x[4 + j] = acc[ai][bj][m][1][j] * r; }
                    if (grp == 0 || grp == 3) {
#pragma unroll
                        for (int j = 0; j < 8; ++j) x[j] = silu_f(x[j]);
                    } else if (grp == 4) {
#pragma unroll
                        for (int j = 0; j < 8; ++j) x[j] *= 0.18033688011112042f;
                    }
                    v4u w; w.x = pg8::cvt_pk_bf16(x[0], x[1]); w.y = pg8::cvt_pk_bf16(x[2], x[3]); w.z = pg8::cvt_pk_bf16(x[4], x[5]); w.w = pg8::cvt_pk_bf16(x[6], x[7]);
                    *(v4u*)(proj + (size_t)row * WIN + c0) = w;
                }
            }
    }
};
struct EpiResid {
    static constexpr bool PERM = true, AFTER_DRAIN = false;
    float* H; bf16* HB; float* ssq;
    __device__ __forceinline__ void operator()(const pg8::f32x4 (&acc)[2][2][4][2], const pg8::Unit& u, int wr, int wc, int fr, int fq) const {
        const int row0 = u.pm * 256 + wr * 64 + fr, colb = u.pn * 256 + wc * 32 + 8 * fq;
#pragma unroll
        for (int ai = 0; ai < 2; ++ai) {
            f32x4 h[4][2][2];
#pragma unroll
            for (int m = 0; m < 4; ++m)
#pragma unroll
                for (int bj = 0; bj < 2; ++bj) { const float* hp = H + (size_t)(row0 + ai * 128 + m * 16) * D + colb + bj * 128; h[m][bj][0] = *(const f32x4*)hp; h[m][bj][1] = *(const f32x4*)(hp + 4); }
#pragma unroll
            for (int m = 0; m < 4; ++m) {
                const int row = row0 + ai * 128 + m * 16;
                float s = 0.f;
#pragma unroll
                for (int bj = 0; bj < 2; ++bj) {
                    const int c0 = colb + bj * 128;
                    float* hp = H + (size_t)row * D + c0;
                    const f32x4 h0 = h[m][bj][0] + acc[ai][bj][m][0], h1 = h[m][bj][1] + acc[ai][bj][m][1];
                    *(f32x4*)hp = h0; *(f32x4*)(hp + 4) = h1;
                    s += (h0[0] * h0[0] + h0[1] * h0[1]) + (h0[2] * h0[2] + h0[3] * h0[3]) + (h1[0] * h1[0] + h1[1] * h1[1]) + (h1[2] * h1[2] + h1[3] * h1[3]);
                    v4u w; w.x = pg8::cvt_pk_bf16(h0[0], h0[1]); w.y = pg8::cvt_pk_bf16(h0[2], h0[3]); w.z = pg8::cvt_pk_bf16(h1[0], h1[1]); w.w = pg8::cvt_pk_bf16(h1[2], h1[3]);
                    *(v4u*)(HB + (size_t)row * D + c0) = w;
                }
                s += __shfl_xor(s, 16); s += __shfl_xor(s, 32);
                if (fq == 0) ssq[(size_t)row * 16 + u.pn * 4 + wc] = s;
            }
        }
    }
};
struct EpiGLU {
    static constexpr bool PERM = true, AFTER_DRAIN = false;
    bf16* T; int ldt; const LAS float* rs;
    __device__ __forceinline__ void operator()(const pg8::f32x4 (&acc)[2][2][4][2], const pg8::Unit& u, int wr, int wc, int fr, int fq) const {
        const int row0 = u.pm * 256 + wr * 64 + fr, colb = u.pn * 128 + wc * 32 + 8 * fq;
#pragma unroll
        for (int ai = 0; ai < 2; ++ai)
#pragma unroll
            for (int m = 0; m < 4; ++m) {
                const int row = row0 + ai * 128 + m * 16;
                const float r = rs ? rs[u.idx * 256 + wr * 64 + fr + ai * 128 + m * 16] : 1.f;
                float x[8];
#pragma unroll
                for (int j = 0; j < 4; ++j) { x[j] = silu_f(acc[ai][0][m][0][j] * r) * (acc[ai][1][m][0][j] * r); x[4 + j] = silu_f(acc[ai][0][m][1][j] * r) * (acc[ai][1][m][1][j] * r); }
                v4u w; w.x = pg8::cvt_pk_bf16(x[0], x[1]); w.y = pg8::cvt_pk_bf16(x[2], x[3]); w.z = pg8::cvt_pk_bf16(x[4], x[5]); w.w = pg8::cvt_pk_bf16(x[6], x[7]);
                *(v4u*)(T + (size_t)row * ldt + colb) = w;
            }
    }
};
struct EpiNone { static constexpr bool PERM = true, AFTER_DRAIN = false; unsigned* sink;
    __device__ __forceinline__ void operator()(const pg8::f32x4 (&acc)[2][2][4][2], const pg8::Unit& u, int wr, int wc, int fr, int fq) const { pg8::f32x4 s = acc[0][0][0][0];
#pragma unroll
        for (int a = 0; a < 2; ++a)
#pragma unroll
            for (int b = 0; b < 2; ++b)
#pragma unroll
                for (int m = 0; m < 4; ++m)
#pragma unroll
                    for (int n = 0; n < 2; ++n) s = s + acc[a][b][m][n];
        if (s[0] + s[1] + s[2] + s[3] == 1.2345e38f) sink[0] = 1u; } };
struct EpiY {
    static constexpr bool PERM = true, AFTER_DRAIN = false;
    bf16* Y;
    __device__ __forceinline__ void operator()(const pg8::f32x4 (&acc)[2][2][4][2], const pg8::Unit& u, int wr, int wc, int fr, int fq) const {
        const int row0 = u.pm * 256 + wr * 64 + fr, colb = u.pn * 256 + wc * 32 + 8 * fq;
#pragma unroll
        for (int ai = 0; ai < 2; ++ai)
#pragma unroll
            for (int m = 0; m < 4; ++m) {
                const int row = row0 + ai * 128 + m * 16;
#pragma unroll
                for (int bj = 0; bj < 2; ++bj) {
                    const pg8::f32x4 a = acc[ai][bj][m][0], b = acc[ai][bj][m][1];
                    v4u w; w.x = pg8::cvt_pk_bf16(a[0], a[1]); w.y = pg8::cvt_pk_bf16(a[2], a[3]); w.z = pg8::cvt_pk_bf16(b[0], b[1]); w.w = pg8::cvt_pk_bf16(b[2], b[3]);
                    *(v4u*)(Y + (size_t)row * D + colb + bj * 128) = w;
                }
            }
    }
};

__device__ __forceinline__ void transpose_item(const float* W, const float* fold, int K, int N, bf16* WT, int k0, int n0, int drow0, LAS float* scr, int lane) {
    const int kr = lane >> 4, n4 = lane & 15;
    f32x4 v[16];
#pragma unroll
    for (int i = 0; i < 16; ++i) v[i] = *(const f32x4*)(W + (size_t)(k0 + 4 * i + kr) * N + n0 + 4 * n4);
#pragma unroll
    for (int i = 0; i < 16; ++i) { const int k = 4 * i + kr; *(LAS f32x4*)(scr + k * 64 + ((4 * n4) ^ (4 * ((k >> 3) & 7)))) = v[i]; }
    LDS_WAIT(); asm volatile("" ::: "memory");
    const int c = lane & 7, nn = lane >> 3;
    f32x4 f0 = (f32x4){1.f, 1.f, 1.f, 1.f}, f1 = f0;
    if (fold) { f0 = *(const f32x4*)(fold + k0 + 8 * c); f1 = *(const f32x4*)(fold + k0 + 8 * c + 4); }
#pragma unroll
    for (int i2 = 0; i2 < 8; ++i2) {
        const int n = 8 * i2 + nn; const LAS float* s = scr + (8 * c) * 64 + (n ^ (4 * c));
        v4u o; o.x = pk2(s[0 * 64] * f0[0], s[1 * 64] * f0[1]); o.y = pk2(s[2 * 64] * f0[2], s[3 * 64] * f0[3]); o.z = pk2(s[4 * 64] * f1[0], s[5 * 64] * f1[1]); o.w = pk2(s[6 * 64] * f1[2], s[7 * 64] * f1[3]);
        *(GAS v4u*)(WT + (size_t)(drow0 + n) * K + k0 + 8 * c) = o;
    }
    LDS_WAIT(); asm volatile("" ::: "memory");
}
__device__ __forceinline__ void prologue_phase(Ctx& C, const Args& A) {
    LAS float* scr = (LAS float*)(C.lds + C.wave * 16384);
    const int gw = C.bid * 8 + C.wave, NGW = C.G * 8;
    constexpr int I_IN = 16 * 56, I_OUT = 16 * 16, I_D1 = 16 * 44, I_D2 = 44 * 16, I_M1 = 16 * 56, I_M2 = 56 * 16;
    constexpr int N_IN = 4 * I_IN, N_OUT = 4 * I_OUT, N_D1 = 2 * I_D1, N_D2 = 2 * I_D2, N_M1 = 16 * I_M1, N_M2 = 16 * I_M2;
    constexpr int NITEMS = N_IN + N_OUT + 2 * N_D1 + N_D2 + 2 * N_M1 + N_M2;
    for (int it = gw; it < NITEMS; it += NGW) {
        int r = it;
        const float* W; const float* fold = nullptr; bf16* WT; int K, N, glu = -1, loc;
        if (r < N_IN) { const int l = r / I_IN; loc = r % I_IN; W = A.in[IN_WIN] + (size_t)l * D * WIN; fold = A.in[IN_NMIX] + l * D; WT = (bf16*)(C.ws + WS_WIN) + (size_t)l * WIN * D; K = D; N = WIN; }
        else if ((r -= N_IN) < N_OUT) { const int l = r / I_OUT; loc = r % I_OUT; W = A.in[IN_WOUT] + (size_t)l * D * D; WT = (bf16*)(C.ws + WS_WOUT) + (size_t)l * D * D; K = D; N = D; }
        else if ((r -= N_OUT) < N_D1) { const int i = r / I_D1; loc = r % I_D1; W = A.in[IN_DW1] + (size_t)i * D * FFD; fold = A.in[IN_NFFN] + (2 * i) * D; WT = (bf16*)(C.ws + WS_WD13) + (size_t)i * 2 * FFD * D; K = D; N = FFD; glu = 0; }
        else if ((r -= N_D1) < N_D1) { const int i = r / I_D1; loc = r % I_D1; W = A.in[IN_DW3] + (size_t)i * D * FFD; fold = A.in[IN_NFFN] + (2 * i) * D; WT = (bf16*)(C.ws + WS_WD13) + (size_t)i * 2 * FFD * D; K = D; N = FFD; glu = 1; }
        else if ((r -= N_D1) < N_D2) { const int i = r / I_D2; loc = r % I_D2; W = A.in[IN_DW2] + (size_t)i * FFD * D; WT = (bf16*)(C.ws + WS_WD2) + (size_t)i * D * FFD; K = FFD; N = D; }
        else if ((r -= N_D2) < N_M1) { const int ie = r / I_M1; loc = r % I_M1; W = A.in[IN_MW1] + (size_t)ie * D * FFE; fold = A.in[IN_NFFN] + (2 * (ie >> 3) + 1) * D; WT = (bf16*)(C.ws + WS_WM13) + (size_t)ie * 2 * FFE * D; K = D; N = FFE; glu = 0; }
        else if ((r -= N_M1) < N_M1) { const int ie = r / I_M1; loc = r % I_M1; W = A.in[IN_MW3] + (size_t)ie * D * FFE; fold = A.in[IN_NFFN] + (2 * (ie >> 3) + 1) * D; WT = (bf16*)(C.ws + WS_WM13) + (size_t)ie * 2 * FFE * D; K = D; N = FFE; glu = 1; }
        else { r -= N_M1; const int ie = r / I_M2; loc = r % I_M2; W = A.in[IN_MW2] + (size_t)ie * FFE * D; WT = (bf16*)(C.ws + WS_WM2) + (size_t)ie * D * FFE; K = FFE; N = D; }
        const int nblk = N / 64, kb = loc / nblk, nb = loc % nblk, k0 = 64 * kb, n0 = 64 * nb;
        const int drow0 = (glu < 0) ? n0 : ((n0 >> 7) * 256 + glu * 128 + (n0 & 127));
        transpose_item(W, fold, K, N, WT, k0, n0, drow0, scr, C.lane);
    }
    for (int row = gw; row < NTOK; row += NGW) {
        const int b = row / LT, t = row % LT;
        f32x4 v[4]; float s = 0.f;
#pragma unroll
        for (int j = 0; j < 4; ++j) {
            const int col = 4 * C.lane + 256 * j;
            if (t < FIRSTV) v[j] = (f32x4){0.f, 0.f, 0.f, 0.f};
            else if (t < LEAD) v[j] = *(const f32x4*)(A.in[IN_META] + (size_t)(t - FIRSTV) * D + col);
            else v[j] = *(const f32x4*)(A.in[IN_X] + ((size_t)b * SEQ + (t - LEAD)) * D + col);
            s += (v[j][0] * v[j][0] + v[j][1] * v[j][1]) + (v[j][2] * v[j][2] + v[j][3] * v[j][3]);
            *(f32x4*)(C.H() + (size_t)row * D + col) = v[j];
            v2u w; w.x = pk2(v[j][0], v[j][1]); w.y = pk2(v[j][2], v[j][3]);
            *(v2u*)(C.HB() + (size_t)row * D + col) = w;
        }
        s = wave_sum(s);
        if (C.lane < 16) C.SSQ()[(size_t)row * 16 + C.lane] = (C.lane == 0) ? s : 0.f;
    }
    if (C.bid == 0) {
        const int tid = C.tid;
        {
            const float* lg = A.in[IN_LBL];
            const float a0 = lg[tid], a1 = lg[512 + tid], a2 = lg[1024 + tid], a3 = lg[1536 + tid];
            const float mx = fmaxf(fmaxf(a0, a1), fmaxf(a2, a3));
            const float e0 = expf(a0 - mx), e1 = expf(a1 - mx), e2 = expf(a2 - mx), e3 = expf(a3 - mx);
            const float inv = 1.f / (((e0 + e1) + e2) + e3);
            const float p0 = e0 * inv, p1 = e1 * inv, p2 = e2 * inv, p3 = e3 * inv;
            const float c0 = p0, c1 = c0 + p1, c2 = c1 + p2, c3 = c2 + p3;
            C.LB()[tid] = 0.f;
            C.LB()[512 + tid] = fminf(fmaxf(c1 - c0, 0.f), 0.999f);
            C.LB()[1024 + tid] = fminf(fmaxf(c2 - c0, 0.f), 0.999f);
            C.LB()[1536 + tid] = fminf(fmaxf(c3 - c0, 0.f), 0.999f);
        }
        for (int i = tid; i < 4 * 132; i += 512) { const int h = i / 132, d = i % 132; C.BIAST()[i] = (d <= 128) ? A.in[IN_RELB][T5B[d] * 4 + h] : 0.f; }
        if (tid < 4) {
            const float* lv = A.in[IN_LAMBDA] + tid * 256;
            float s01 = 0.f, s23 = 0.f;
            for (int j = 0; j < 64; ++j) { s01 += lv[j] * lv[64 + j]; s23 += lv[128 + j] * lv[192 + j]; }
            const float li = 0.8f - 0.6f * expf(-0.3f * (float)tid);
            C.LAM()[tid * 2] = expf(s01) - expf(s23) + li; C.LAM()[tid * 2 + 1] = li;
        }
        if (tid < 512) { C.SUBLN()[tid] = A.in[IN_SUBLN][tid]; C.HGNW()[tid] = A.in[IN_HGNW][tid]; C.FNORM()[tid] = A.in[IN_FNORM][tid]; C.FNORM()[512 + tid] = A.in[IN_FNORM][512 + tid]; }
        for (int i = tid; i < 2 * 8 * 1024; i += 512) { const int li = i >> 13, e = (i >> 10) & 7, k = i & 1023; C.RF()[i] = A.in[IN_NFFN][(2 * li + 1) * D + k] * A.in[IN_ROUTER][(size_t)li * D * NE + k * NE + e]; }
    }
}

__device__ __forceinline__ void hgrn_naive_unit(Ctx& C, int l, int b, int h) {
    LAS float* qf = (LAS float*)C.lds;
    LAS float* kf = qf + 2048; LAS float* ff = kf + 2048; LAS float* vv = ff + 2048; LAS float* gg = vv + 2048;
    LAS float* opart = gg + 2048;
    const int tid = C.tid, dv = tid & 127, qd = tid >> 7;
    const int ltok = tid >> 5, c4 = (tid & 31) * 4;
    float S[32];
#pragma unroll
    for (int j = 0; j < 32; ++j) S[j] = 0.f;
    const float* nw = C.HGNW() + l * 128;
    for (int tb = 0; tb < LT / 16; ++tb) {
        const size_t row = (size_t)b * LT + tb * 16 + ltok;
        {
            const bf16* pp = C.PROJ() + row * WIN + h * 128 + c4;
            const v2u wq = *(const v2u*)pp, wk = *(const v2u*)(pp + 512), wv = *(const v2u*)(pp + 1024), wg = *(const v2u*)(pp + 1536);
            const f32x4 lf = *(const f32x4*)(C.LOGF() + row * 512 + h * 128 + c4);
            const int o = ltok * 128 + c4;
            qf[o] = bf_lo(wq.x); qf[o + 1] = bf_hi(wq.x); qf[o + 2] = bf_lo(wq.y); qf[o + 3] = bf_hi(wq.y);
            kf[o] = bf_lo(wk.x); kf[o + 1] = bf_hi(wk.x); kf[o + 2] = bf_lo(wk.y); kf[o + 3] = bf_hi(wk.y);
            vv[o] = bf_lo(wv.x); vv[o + 1] = bf_hi(wv.x); vv[o + 2] = bf_lo(wv.y); vv[o + 3] = bf_hi(wv.y);
            gg[o] = bf_lo(wg.x); gg[o + 1] = bf_hi(wg.x); gg[o + 2] = bf_lo(wg.y); gg[o + 3] = bf_hi(wg.y);
            f32x4 lp = (f32x4){0.f, 0.f, 0.f, 0.f};
            if (((tb * 16 + ltok) & 63) != 0) lp = *(const f32x4*)(C.LOGF() + (row - 1) * 512 + h * 128 + c4);
            ff[o] = expf(lf[0] - lp[0]); ff[o + 1] = expf(lf[1] - lp[1]); ff[o + 2] = expf(lf[2] - lp[2]); ff[o + 3] = expf(lf[3] - lp[3]);
        }
        __syncthreads();
        for (int tok = 0; tok < 16; ++tok) {
            const float v = vv[tok * 128 + dv];
            const LAS f32x4* fp = (const LAS f32x4*)(ff + tok * 128 + 32 * qd);
            const LAS f32x4* kp = (const LAS f32x4*)(kf + tok * 128 + 32 * qd);
            const LAS f32x4* qp = (const LAS f32x4*)(qf + tok * 128 + 32 * qd);
            float a = 0.f;
#pragma unroll
            for (int j = 0; j < 8; ++j) {
                const f32x4 f4 = fp[j], k4 = kp[j], q4 = qp[j];
#pragma unroll
                for (int i = 0; i < 4; ++i) { S[4 * j + i] = f4[i] * S[4 * j + i] + k4[i] * v; a += q4[i] * S[4 * j + i]; }
            }
            opart[(tok * 4 + qd) * 128 + dv] = a;
        }
        __syncthreads();
        {
            float o[4]; float ss = 0.f;
#pragma unroll
            for (int i = 0; i < 4; ++i) { o[i] = (opart[(ltok * 4 + 0) * 128 + c4 + i] + opart[(ltok * 4 + 1) * 128 + c4 + i]) + (opart[(ltok * 4 + 2) * 128 + c4 + i] + opart[(ltok * 4 + 3) * 128 + c4 + i]); ss += o[i] * o[i]; }
#pragma unroll
            for (int m = 1; m < 32; m <<= 1) ss += __shfl_xor(ss, m);
            const float rs = rsqrtf(ss * (1.0f / 128.0f) + EPS);
            const int oo = ltok * 128 + c4;
            v2u w; w.x = pk2(o[0] * rs * nw[c4] * gg[oo], o[1] * rs * nw[c4 + 1] * gg[oo + 1]); w.y = pk2(o[2] * rs * nw[c4 + 2] * gg[oo + 2], o[3] * rs * nw[c4 + 3] * gg[oo + 3]);
            *(v2u*)(C.MIX() + row * D + h * 128 + c4) = w;
        }
        __syncthreads();
    }
}
typedef float f32x16 __attribute__((ext_vector_type(16)));
typedef short bf16x8 __attribute__((ext_vector_type(8)));
typedef short s16x4 __attribute__((ext_vector_type(4)));
constexpr float LOG2E = 1.4426950408889634f;
constexpr int AT_K = 0, AT_V = 32768, AT_BIAS = 65536, AT_WSF = 66560, AT_STG = 69632, AT_XCH = 0;
__device__ __forceinline__ int crow(int r, int hi) { return (r & 3) + 8 * (r >> 2) + 4 * hi; }
__device__ __forceinline__ s16x4 vtr(const LAS unsigned char* p) { typedef short v4i16_t __attribute__((ext_vector_type(4))); return __builtin_bit_cast(s16x4, __builtin_amdgcn_ds_read_tr16_b64_v4i16((LAS v4i16_t*)p)); }
__device__ __forceinline__ bf16x8 pack8(const f32x16& p, int b0) {
    v4u w; w.x = pg8::cvt_pk_bf16(p[b0 + 0], p[b0 + 1]); w.y = pg8::cvt_pk_bf16(p[b0 + 2], p[b0 + 3]); w.z = pg8::cvt_pk_bf16(p[b0 + 4], p[b0 + 5]); w.w = pg8::cvt_pk_bf16(p[b0 + 6], p[b0 + 7]);
    return __builtin_bit_cast(bf16x8, w);
}
__device__ __forceinline__ void attn_unit(Ctx& C, int l, int b, int h, int qi) {
    LAS unsigned char* lds = C.lds;
    const int tid = C.tid, lane = C.lane, wave = C.wave, rg = wave >> 1, c = wave & 1, r32 = lane & 31, hi = lane >> 5;
    const size_t rowbase = (size_t)b * LT;
    const bf16* PJ = C.PROJ();
    LAS float* biasl = (LAS float*)(lds + AT_BIAS);
    LAS float* wsf = (LAS float*)(lds + AT_WSF) + wave * 64;
    if (tid < 132) biasl[tid] = C.BIAST()[h * 132 + tid] * LOG2E;
    const float lam = C.LAM()[l * 2], lam_init = C.LAM()[l * 2 + 1];
    const int qw0 = 128 * qi + 32 * rg, tq = qw0 + r32;
    bf16x8 qr[4];
    { const bf16* qp = PJ + (rowbase + tq) * WIN + 2048 + h * 128 + c * 64 + 8 * hi;
#pragma unroll
      for (int ks = 0; ks < 4; ++ks) qr[ks] = *(const bf16x8*)(qp + 16 * ks); }
    const int kkey = tid >> 3, kch = tid & 7;
    const bf16* ksrc = PJ + (rowbase + kkey) * WIN + 2560 + h * 128 + kch * 8;
    const int kdst = kkey * 128 + ((kch ^ ((kkey >> 1) & 7)) * 16);
    const int vkey0 = tid >> 4, vch = tid & 15;
    const bf16* vsrc = PJ + (rowbase + vkey0) * WIN + 3072 + h * 128 + vch * 8;
    const int vdst0 = ((vkey0 >> 3) * 4 + (vch >> 2)) * 512 + (vkey0 & 7) * 64 + (vch & 3) * 16;
    v4u kreg0, kreg1, vreg0, vreg1;
#define AT_LOAD(kt) do { const size_t o_ = (size_t)(kt) * 64 * WIN; kreg0 = *(const v4u*)(ksrc + o_); kreg1 = *(const v4u*)(ksrc + o_ + 64); vreg0 = *(const v4u*)(vsrc + o_); vreg1 = *(const v4u*)(vsrc + o_ + (size_t)32 * WIN); } while (0)
#define AT_STORE(buf) do { *(LAS v4u*)(lds + AT_K + (buf) * 16384 + kdst) = kreg0; *(LAS v4u*)(lds + AT_K + (buf) * 16384 + 8192 + kdst) = kreg1; \
        *(LAS v4u*)(lds + AT_V + (buf) * 16384 + vdst0) = vreg0; *(LAS v4u*)(lds + AT_V + (buf) * 16384 + 8192 + vdst0) = vreg1; } while (0)
    const int nt = 2 * qi + 1;
    AT_LOAD(1); AT_STORE(0);
    __syncthreads();
    f32x16 o[4];
#pragma unroll
    for (int d = 0; d < 4; ++d)
#pragma unroll
        for (int r = 0; r < 16; ++r) o[d][r] = 0.f;
    float mref = -1e30f, lsum = 0.f;
    const int kswz = (r32 >> 1) & 7;
    const int vb = (4 * hi + ((lane & 15) >> 2)) * 64 + ((lane >> 4) & 1) * 32 + (lane & 3) * 8;
    const float b128 = biasl[128];
    for (int it = 0; it < nt; ++it) {
        const int kt = it + 1, buf = it & 1, k0 = 64 * kt;
        if (it + 1 < nt) AT_LOAD(kt + 1);
        if (k0 <= qw0 + 31) {
            const bool near = (k0 + 63 > qw0 - 128) || (kt == 1);
            f32x16 p0, p1;
            { const float ini = near ? 0.f : b128;
#pragma unroll
              for (int r = 0; r < 16; ++r) { p0[r] = ini; p1[r] = ini; } }
            const LAS unsigned char* kb = lds + AT_K + buf * 16384 + c * 8192 + r32 * 128;
#pragma unroll
            for (int ks = 0; ks < 4; ++ks) {
                const int off = ((2 * ks + hi) ^ kswz) * 16;
                const bf16x8 k0f = *(const LAS bf16x8*)(kb + off), k1f = *(const LAS bf16x8*)(kb + 4096 + off);
                p0 = __builtin_amdgcn_mfma_f32_32x32x16_bf16(k0f, qr[ks], p0, 0, 0, 0);
                p1 = __builtin_amdgcn_mfma_f32_32x32x16_bf16(k1f, qr[ks], p1, 0, 0, 0);
            }
            if (near) {
#pragma unroll
                for (int r = 0; r < 16; ++r) {
                    const int tk = k0 + crow(r, hi), d0 = tq - tk, d1 = d0 - 32;
                    const float b0 = biasl[d0 < 0 ? 0 : (d0 > 128 ? 128 : d0)], b1 = biasl[d1 < 0 ? 0 : (d1 > 128 ? 128 : d1)];
                    p0[r] = (d0 < 0 || tk < FIRSTV) ? -INFINITY : p0[r] + b0;
                    p1[r] = (d1 < 0 || tk + 32 < FIRSTV) ? -INFINITY : p1[r] + b1;
                }
            }
            float mx = fmaxf(p0[0], p1[0]);
#pragma unroll
            for (int r = 1; r < 16; ++r) mx = fmaxf(fmaxf(mx, p0[r]), p1[r]);
            mx = fmaxf(mx, __shfl_xor(mx, 32));
            if (__any(mx > mref + 8.0f)) {
                const float mnew = fmaxf(mref, mx), f = __builtin_amdgcn_exp2f(mref - mnew);
                lsum *= f; mref = mnew;
                if (hi == 0) wsf[r32] = f;
                LDS_WAIT(); asm volatile("" ::: "memory");
#pragma unroll
                for (int g = 0; g < 4; ++g) { const f32x4 fv = *(const LAS f32x4*)(wsf + 8 * g + 4 * hi);
#pragma unroll
                    for (int d = 0; d < 4; ++d) { o[d][4 * g + 0] *= fv[0]; o[d][4 * g + 1] *= fv[1]; o[d][4 * g + 2] *= fv[2]; o[d][4 * g + 3] *= fv[3]; } }
            }
            float ps = 0.f;
#pragma unroll
            for (int r = 0; r < 16; ++r) { p0[r] = __builtin_amdgcn_exp2f(p0[r] - mref); p1[r] = __builtin_amdgcn_exp2f(p1[r] - mref); ps += p0[r] + p1[r]; }
            lsum += ps;
            const bf16x8 pa0 = pack8(p0, 0), pa1 = pack8(p0, 8), pa2 = pack8(p1, 0), pa3 = pack8(p1, 8);
            const LAS unsigned char* vp = lds + AT_V + buf * 16384 + vb;
#pragma unroll
            for (int d = 0; d < 4; ++d) {
#define AT_VF(s) ({ const s16x4 lo_ = vtr(vp + (2 * (s)) * 2048 + d * 512), hi_ = vtr(vp + (2 * (s) + 1) * 2048 + d * 512); (bf16x8){lo_[0], lo_[1], lo_[2], lo_[3], hi_[0], hi_[1], hi_[2], hi_[3]}; })
                o[d] = __builtin_amdgcn_mfma_f32_32x32x16_bf16(pa0, AT_VF(0), o[d], 0, 0, 0);
                o[d] = __builtin_amdgcn_mfma_f32_32x32x16_bf16(pa1, AT_VF(1), o[d], 0, 0, 0);
                o[d] = __builtin_amdgcn_mfma_f32_32x32x16_bf16(pa2, AT_VF(2), o[d], 0, 0, 0);
                o[d] = __builtin_amdgcn_mfma_f32_32x32x16_bf16(pa3, AT_VF(3), o[d], 0, 0, 0);
#undef AT_VF
            }
        }
        if (it + 1 < nt) AT_STORE(buf ^ 1);
        __syncthreads();
    }
#undef AT_LOAD
#undef AT_STORE
    lsum += __shfl_xor(lsum, 32);
    { const float inv = lsum > 0.f ? 1.f / lsum : 0.f;
      if (hi == 0) wsf[r32] = inv;
      LDS_WAIT(); asm volatile("" ::: "memory");
#pragma unroll
      for (int g = 0; g < 4; ++g) { const f32x4 fv = *(const LAS f32x4*)(wsf + 8 * g + 4 * hi);
#pragma unroll
          for (int d = 0; d < 4; ++d) { o[d][4 * g + 0] *= fv[0]; o[d][4 * g + 1] *= fv[1]; o[d][4 * g + 2] *= fv[2]; o[d][4 * g + 3] *= fv[3]; } } }
    LAS float* xch = (LAS float*)(lds + AT_XCH) + rg * 4096;
    if (c == 1) {
#pragma unroll
        for (int d = 0; d < 4; ++d)
#pragma unroll
            for (int r = 0; r < 16; ++r) xch[(d * 16 + r) * 64 + lane] = o[d][r];
    }
    __syncthreads();
    if (c == 0) {
        float ss[16];
#pragma unroll
        for (int r = 0; r < 16; ++r) ss[r] = 0.f;
#pragma unroll
        for (int d = 0; d < 4; ++d)
#pragma unroll
            for (int r = 0; r < 16; ++r) { const float a = o[d][r] - lam * xch[(d * 16 + r) * 64 + lane]; o[d][r] = a; ss[r] += a * a; }
#pragma unroll
        for (int r = 0; r < 16; ++r) {
            float s = ss[r];
            s += __shfl_xor(s, 1); s += __shfl_xor(s, 2); s += __shfl_xor(s, 4); s += __shfl_xor(s, 8); s += __shfl_xor(s, 16);
            ss[r] = rsqrtf(s * (1.0f / 128.0f) + EPS) * (1.f - lam_init);
        }
        LAS bf16* stg = (LAS bf16*)(lds + AT_STG) + rg * 4096;
        const float* sw = C.SUBLN() + l * 128 + r32;
#pragma unroll
        for (int d = 0; d < 4; ++d) { const float w = sw[32 * d];
#pragma unroll
            for (int r = 0; r < 16; ++r) stg[crow(r, hi) * 128 + 32 * d + r32] = (bf16)f2bf(o[d][r] * ss[r] * w); }
        LDS_WAIT(); asm volatile("" ::: "memory");
        bf16* op = C.MIX() + (rowbase + qw0) * D + 512 + h * 128;
#pragma unroll
        for (int i = 0; i < 8; ++i) { const int ch = i * 64 + lane, row = ch >> 4, cc = ch & 15; *(v4u*)(op + (size_t)row * D + cc * 8) = *(const LAS v4u*)(stg + row * 128 + cc * 8); }
    }
    __syncthreads();
}
constexpr int HG_QM = 0, HG_KR = 16384, HG_KT = 32768, HG_V = 49152, HG_ST = 65536, HG_XT = 98304, HG_OS = 106496, HG_SQ = 122880, HG_VEC = 123904;
__device__ __forceinline__ bf16x8 tr_frag(const LAS unsigned char* p) { const s16x4 lo = vtr(p), hi4 = vtr(p + 256); return (bf16x8){lo[0], lo[1], lo[2], lo[3], hi4[0], hi4[1], hi4[2], hi4[3]}; }
__device__ __forceinline__ void hgrn_unit(Ctx& C, int l, int b, int h) {
    LAS unsigned char* lds = C.lds;
    const int tid = C.tid, lane = C.lane, wave = C.wave, r32 = lane & 31, hi = lane >> 5;
    const size_t rowbase = (size_t)b * LT;
    const bf16* PJ = C.PROJ() + h * 128; const float* BL = C.LOGF() + h * 128;
    const int c4 = tid & 31, tg = tid >> 5;
    const int dkb = wave >> 1, dvb0 = 2 * (wave & 1);
    const int th = wave >> 2, dvb = wave & 3;
    const int vbq = ((lane & 15) >> 2) * 64 + ((lane >> 4) & 1) * 32 + (lane & 3) * 8;
    LAS float* vec = (LAS float*)(lds + HG_VEC);
    LAS float* sq = (LAS float*)(lds + HG_SQ);
    f32x16 st[2];
#pragma unroll
    for (int j = 0; j < 2; ++j)
#pragma unroll
        for (int r = 0; r < 16; ++r) st[j][r] = 0.f;
    v2u pq[4], pk[4], pv[4]; f32x4 pb[4], pbm;
#define HG_LOAD(ch) do { const size_t r0_ = rowbase + (size_t)(ch) * 64; \
        _Pragma("unroll") for (int i = 0; i < 4; ++i) { const size_t row_ = r0_ + 4 * tg + i; const bf16* p_ = PJ + row_ * WIN + 4 * c4; \
            pq[i] = *(const v2u*)p_; pk[i] = *(const v2u*)(p_ + 512); pv[i] = *(const v2u*)(p_ + 1024); pb[i] = *(const f32x4*)(BL + row_ * 512 + 4 * c4); } \
        pbm = *(const f32x4*)(BL + (r0_ + 31) * 512 + 4 * c4); } while (0)
    HG_LOAD(0);
    const float* nw = C.HGNW() + l * 128;
    for (int ch = 0; ch < LT / 64; ++ch) {
#pragma unroll
        for (int i = 0; i < 4; ++i) {
            const int t = 4 * tg + i;
            float qm[4], km[4];
            const float qv[4] = {bf_lo(pq[i].x), bf_hi(pq[i].x), bf_lo(pq[i].y), bf_hi(pq[i].y)};
            const float kv[4] = {bf_lo(pk[i].x), bf_hi(pk[i].x), bf_lo(pk[i].y), bf_hi(pk[i].y)};
#pragma unroll
            for (int j = 0; j < 4; ++j) { const float x = fminf(fmaxf(pb[i][j] - pbm[j], -80.f), 80.f); qm[j] = qv[j] * __expf(x); km[j] = kv[j] * __expf(-x); }
            const int rsw = (((c4 >> 1) ^ (t & 15)) * 16) + (c4 & 1) * 8;
            *(LAS v2u*)(lds + HG_QM + t * 256 + rsw) = pack4(qm[0], qm[1], qm[2], qm[3]);
            const v2u kmw = pack4(km[0], km[1], km[2], km[3]);
            *(LAS v2u*)(lds + HG_KR + t * 256 + rsw) = kmw;
            const int tso = ((t >> 3) * 4 + (c4 >> 3)) * 512 + (t & 7) * 64 + (c4 & 7) * 8;
            *(LAS v2u*)(lds + HG_KT + tso) = kmw;
            *(LAS v2u*)(lds + HG_V + tso) = pv[i];
            if (t == 31) *(LAS f32x4*)(vec + 4 * c4) = pb[i];
            if (t == 63) *(LAS f32x4*)(vec + 128 + 4 * c4) = pb[i];
        }
        __syncthreads();
        if (ch + 1 < LT / 64) HG_LOAD(ch + 1);
        const v4u g0 = *(const v4u*)(PJ + (rowbase + (size_t)ch * 64 + (tid >> 3)) * WIN + 1536 + 16 * (tid & 7)), g1 = *(const v4u*)(PJ + (rowbase + (size_t)ch * 64 + (tid >> 3)) * WIN + 1536 + 16 * (tid & 7) + 8);
#pragma unroll
        for (int g = 0; g < 4; ++g) {
            const f32x4 bm = *(const LAS f32x4*)(vec + 32 * dkb + 8 * g + 4 * hi);
            const float e0 = __expf(bm[0]), e1 = __expf(bm[1]), e2 = __expf(bm[2]), e3 = __expf(bm[3]);
#pragma unroll
            for (int j = 0; j < 2; ++j) {
                st[j][4 * g + 0] *= e0; st[j][4 * g + 1] *= e1; st[j][4 * g + 2] *= e2; st[j][4 * g + 3] *= e3;
                const int dv = 32 * (dvb0 + j) + r32;
                *(LAS v2u*)(lds + HG_ST + dv * 256 + (((4 * dkb + g) ^ (dv & 15)) * 16) + hi * 8) = pack4(st[j][4 * g + 0], st[j][4 * g + 1], st[j][4 * g + 2], st[j][4 * g + 3]);
            }
        }
        if (wave < 3) {
            const int sb = (wave == 2) ? 1 : 0, tb = (wave == 0) ? 0 : 1;
            const int s = 32 * sb + r32, t = 32 * tb + r32;
            f32x16 x;
#pragma unroll
            for (int r = 0; r < 16; ++r) x[r] = 0.f;
#pragma unroll
            for (int ks = 0; ks < 8; ++ks) {
                const bf16x8 a = *(const LAS bf16x8*)(lds + HG_KR + s * 256 + (((2 * ks + hi) ^ (s & 15)) * 16));
                const bf16x8 bq = *(const LAS bf16x8*)(lds + HG_QM + t * 256 + (((2 * ks + hi) ^ (t & 15)) * 16));
                x = __builtin_amdgcn_mfma_f32_32x32x16_bf16(a, bq, x, 0, 0, 0);
            }
            if (sb == tb) {
#pragma unroll
                for (int r = 0; r < 16; ++r) x[r] = (crow(r, hi) > r32) ? 0.f : x[r];
            }
#pragma unroll
            for (int g = 0; g < 4; ++g)
                *(LAS v2u*)(lds + HG_XT + t * 128 + (((4 * sb + g) ^ ((t >> 1) & 7)) * 16) + hi * 8) = pack4(x[4 * g + 0], x[4 * g + 1], x[4 * g + 2], x[4 * g + 3]);
        }
#pragma unroll
        for (int ks = 0; ks < 4; ++ks) {
            const bf16x8 a = tr_frag(lds + HG_KT + ((2 * ks + hi) * 4 + dkb) * 512 + vbq);
#pragma unroll
            for (int j = 0; j < 2; ++j) {
                const bf16x8 bv = tr_frag(lds + HG_V + ((2 * ks + hi) * 4 + dvb0 + j) * 512 + vbq);
                st[j] = __builtin_amdgcn_mfma_f32_32x32x16_bf16(a, bv, st[j], 0, 0, 0);
            }
        }
#pragma unroll
        for (int g = 0; g < 4; ++g) {
            const f32x4 bm = *(const LAS f32x4*)(vec + 32 * dkb + 8 * g + 4 * hi), be = *(const LAS f32x4*)(vec + 128 + 32 * dkb + 8 * g + 4 * hi);
            const float e0 = __expf(be[0] - bm[0]), e1 = __expf(be[1] - bm[1]), e2 = __expf(be[2] - bm[2]), e3 = __expf(be[3] - bm[3]);
#pragma unroll
            for (int j = 0; j < 2; ++j) { st[j][4 * g + 0] *= e0; st[j][4 * g + 1] *= e1; st[j][4 * g + 2] *= e2; st[j][4 * g + 3] *= e3; }
        }
        __syncthreads();
        {
            const int dv = 32 * dvb + r32, t = 32 * th + r32;
            f32x16 o;
#pragma unroll
            for (int r = 0; r < 16; ++r) o[r] = 0.f;
#pragma unroll
            for (int ks = 0; ks < 8; ++ks) {
                const bf16x8 a = *(const LAS bf16x8*)(lds + HG_ST + dv * 256 + (((2 * ks + hi) ^ (dv & 15)) * 16));
                const bf16x8 bq = *(const LAS bf16x8*)(lds + HG_QM + t * 256 + (((2 * ks + hi) ^ (t & 15)) * 16));
                o = __builtin_amdgcn_mfma_f32_32x32x16_bf16(a, bq, o, 0, 0, 0);
            }
#pragma unroll
            for (int sb = 0; sb < 2; ++sb) {
                if (sb <= th) {
#pragma unroll
                    for (int k2 = 0; k2 < 2; ++k2) {
                        const int kg = 4 * sb + 2 * k2 + hi;
                        const bf16x8 a = tr_frag(lds + HG_V + (kg * 4 + dvb) * 512 + vbq);
                        const bf16x8 bx = *(const LAS bf16x8*)(lds + HG_XT + t * 128 + ((kg ^ ((t >> 1) & 7)) * 16));
                        o = __builtin_amdgcn_mfma_f32_32x32x16_bf16(a, bx, o, 0, 0, 0);
                    }
                }
            }
            float s2 = 0.f;
#pragma unroll
            for (int r = 0; r < 16; ++r) s2 += o[r] * o[r];
            s2 += __shfl_xor(s2, 32);
            if (hi == 0) sq[t * 4 + dvb] = s2;
#pragma unroll
            for (int g = 0; g < 4; ++g)
                *(LAS v2u*)(lds + HG_OS + t * 256 + (((4 * dvb + g) ^ (t & 15)) * 16) + hi * 8) = pack4(o[4 * g + 0], o[4 * g + 1], o[4 * g + 2], o[4 * g + 3]);
        }
        __syncthreads();
        {
            const int t = tid >> 3, seg = tid & 7;
            const size_t row = rowbase + (size_t)ch * 64 + t;
            const f32x4 sv = *(const LAS f32x4*)(sq + t * 4);
            const float rs = rsqrtf(((sv[0] + sv[1]) + (sv[2] + sv[3])) * (1.0f / 128.0f) + EPS);
            const v4u o0 = *(const LAS v4u*)(lds + HG_OS + t * 256 + (((2 * seg) ^ (t & 15)) * 16)), o1 = *(const LAS v4u*)(lds + HG_OS + t * 256 + (((2 * seg + 1) ^ (t & 15)) * 16));
            const f32x4 w0 = *(const f32x4*)(nw + 16 * seg), w1 = *(const f32x4*)(nw + 16 * seg + 4), w2 = *(const f32x4*)(nw + 16 * seg + 8), w3 = *(const f32x4*)(nw + 16 * seg + 12);
            v4u r0, r1;
            r0.x = pk2(bf_lo(o0.x) * rs * w0[0] * bf_lo(g0.x), bf_hi(o0.x) * rs * w0[1] * bf_hi(g0.x)); r0.y = pk2(bf_lo(o0.y) * rs * w0[2] * bf_lo(g0.y), bf_hi(o0.y) * rs * w0[3] * bf_hi(g0.y));
            r0.z = pk2(bf_lo(o0.z) * rs * w1[0] * bf_lo(g0.z), bf_hi(o0.z) * rs * w1[1] * bf_hi(g0.z)); r0.w = pk2(bf_lo(o0.w) * rs * w1[2] * bf_lo(g0.w), bf_hi(o0.w) * rs * w1[3] * bf_hi(g0.w));
            r1.x = pk2(bf_lo(o1.x) * rs * w2[0] * bf_lo(g1.x), bf_hi(o1.x) * rs * w2[1] * bf_hi(g1.x)); r1.y = pk2(bf_lo(o1.y) * rs * w2[2] * bf_lo(g1.y), bf_hi(o1.y) * rs * w2[3] * bf_hi(g1.y));
            r1.z = pk2(bf_lo(o1.z) * rs * w3[0] * bf_lo(g1.z), bf_hi(o1.z) * rs * w3[1] * bf_hi(g1.z)); r1.w = pk2(bf_lo(o1.w) * rs * w3[2] * bf_lo(g1.w), bf_hi(o1.w) * rs * w3[3] * bf_hi(g1.w));
            bf16* op = C.MIX() + row * D + h * 128 + 16 * seg;
            *(v4u*)op = r0; *(v4u*)(op + 8) = r1;
        }
    }
#undef HG_LOAD
    __syncthreads();
}
__device__ __forceinline__ void mixer_phase(Ctx& C, int l) {
    const int NA = C.G - 32;
    if (C.bid < NA) {
        for (int rep = 0; rep < REP_ATT; ++rep)
        for (int k = 0; k * NA < 17 * 32; ++k) {
            const int u = k * NA + ((k & 1) ? (NA - 1 - C.bid) : C.bid);
            if (u < 17 * 32) { const int qi = 16 - u / 32, bh = u % 32; attn_unit(C, l, bh >> 2, bh & 3, qi); }
        }
    } else {
        for (int rep = 0; rep < REP_HG; ++rep) { const int u = C.bid - NA; hgrn_unit(C, l, u >> 2, u & 3); }
    }
}


template <class F> __device__ __forceinline__ void mini_tile(LAS unsigned char* lds, const bf16* A, const bf16* Bt, int K, int r0, int c0, int lane, int wave, const F& epi) {
    const int fr = lane & 15, fq = lane >> 4;
    const int srow = 8 * wave + (lane >> 3), lch = (lane & 7) ^ ((srow >> 1) & 7);
    const bf16* asrc = A + (size_t)(r0 + srow) * K + 8 * lch;
    const bf16* bsrc = Bt + (size_t)(c0 + srow) * K + 8 * lch;
    const int nk = K / 64;
    LAS unsigned char* wbase = lds + wave * 1024;
#define RT_ISSUE(s) do { const int sl_ = ((s) & 7) * 16384; __builtin_amdgcn_global_load_lds((const unsigned*)(asrc + (size_t)(s) * 64), (LAS unsigned*)(wbase + sl_), 16, 0, 0); \
        __builtin_amdgcn_global_load_lds((const unsigned*)(bsrc + (size_t)(s) * 64), (LAS unsigned*)(wbase + sl_ + 8192), 16, 0, 0); } while (0)
#pragma unroll
    for (int s = 0; s < 7; ++s) RT_ISSUE(s);
    f32x4 acc0 = (f32x4){0.f, 0.f, 0.f, 0.f}, acc1 = acc0;
    const int arow = 32 * (wave >> 2) + fr, brow = 16 * (wave & 3) + fr;
    const int asw = (arow >> 1) & 7, bsw = (brow >> 1) & 7;
    for (int s = 0; s < nk; ++s) {
        if (s + 6 < nk) asm volatile("s_waitcnt vmcnt(12)" ::: "memory"); else asm volatile("s_waitcnt vmcnt(0)" ::: "memory");
        __builtin_amdgcn_s_barrier(); asm volatile("" ::: "memory");
        if (s + 7 < nk) RT_ISSUE(s + 7);
        const LAS unsigned char* sa = lds + (s & 7) * 16384; const LAS unsigned char* sb = sa + 8192;
#pragma unroll
        for (int j = 0; j < 2; ++j) {
            const bf16x8 a0 = *(const LAS bf16x8*)(sa + arow * 128 + (((4 * j + fq) ^ asw) * 16)), a1 = *(const LAS bf16x8*)(sa + (arow + 16) * 128 + (((4 * j + fq) ^ asw) * 16));
            const bf16x8 b = *(const LAS bf16x8*)(sb + brow * 128 + (((4 * j + fq) ^ bsw) * 16));
            acc0 = __builtin_amdgcn_mfma_f32_16x16x32_bf16(b, a0, acc0, 0, 0, 0); acc1 = __builtin_amdgcn_mfma_f32_16x16x32_bf16(b, a1, acc1, 0, 0, 0);
        }
    }
#undef RT_ISSUE
    const int row = r0 + 32 * (wave >> 2) + fr, col = c0 + 16 * (wave & 3) + 4 * fq;
    epi(acc0, acc1, row, col);
    asm volatile("s_waitcnt lgkmcnt(0)" ::: "memory"); __builtin_amdgcn_s_barrier(); asm volatile("" ::: "memory");
}
__device__ __forceinline__ void mini_resid_phase(Ctx& C, const bf16* A, const bf16* Bt, int K, int row_lo) {
    LAS float* red = (LAS float*)(C.lds + RING_BYTES + 2048);
    const int nrb = (NTOK - row_lo) / 64, ntile = nrb * 16;
    float* H = C.H(); bf16* HB = C.HB(); float* SSQ = C.SSQ();
    for (int mt = C.bid; mt < ntile; mt += C.G) {
        const int rb = mt >> 4, cb = mt & 15, r0 = row_lo + 64 * rb, c0 = 64 * cb;
        const int lane = C.lane, wave = C.wave;
        mini_tile(C.lds, A, Bt, K, r0, c0, lane, wave, [&](const f32x4& x0, const f32x4& x1, int row, int col) {
            float* hp = H + (size_t)row * D + col;
            f32x4 h0 = *(const f32x4*)hp + x0, h1 = *(const f32x4*)(hp + (size_t)16 * D) + x1;
            *(f32x4*)hp = h0; *(f32x4*)(hp + (size_t)16 * D) = h1;
            *(v2u*)(HB + (size_t)row * D + col) = pack4(h0[0], h0[1], h0[2], h0[3]); *(v2u*)(HB + (size_t)(row + 16) * D + col) = pack4(h1[0], h1[1], h1[2], h1[3]);
            float s0 = (h0[0] * h0[0] + h0[1] * h0[1]) + (h0[2] * h0[2] + h0[3] * h0[3]), s1 = (h1[0] * h1[0] + h1[1] * h1[1]) + (h1[2] * h1[2] + h1[3] * h1[3]);
            s0 += __shfl_xor(s0, 16); s0 += __shfl_xor(s0, 32); s1 += __shfl_xor(s1, 16); s1 += __shfl_xor(s1, 32);
            if ((lane >> 4) == 0) { red[(row - r0) * 4 + (wave & 3)] = s0; red[(row - r0 + 16) * 4 + (wave & 3)] = s1; }
        });
        __syncthreads();
        if (C.tid < 64) { const f32x4 p = *(const LAS f32x4*)(red + C.tid * 4); SSQ[(size_t)(r0 + C.tid) * 16 + cb] = (p[0] + p[1]) + (p[2] + p[3]); }
        __syncthreads();
    }
}
__device__ __forceinline__ void mini_y_phase(Ctx& C, const bf16* A, const bf16* Bt, size_t bstride_el, int K, int plim, int pend, int p1, int p2, int p3, int p4, int p5, int p6, int p7) {
    const int ntile = (pend - plim) * 4 * 16;
    bf16* Y = C.Y();
    for (int mt = C.bid; mt < ntile; mt += C.G) {
        const int rb = mt >> 4, cb = mt & 15, pm = plim + (rb >> 2), r0 = plim * 256 + 64 * rb, c0 = 64 * cb;
        const int e = (pm >= p1) + (pm >= p2) + (pm >= p3) + (pm >= p4) + (pm >= p5) + (pm >= p6) + (pm >= p7);
        mini_tile(C.lds, A, Bt + (size_t)e * bstride_el, K, r0, c0, C.lane, C.wave, [&](const f32x4& x0, const f32x4& x1, int row, int col) {
            *(v2u*)(Y + (size_t)row * D + col) = pack4(x0[0], x0[1], x0[2], x0[3]); *(v2u*)(Y + (size_t)(row + 16) * D + col) = pack4(x1[0], x1[1], x1[2], x1[3]);
        });
    }
}

constexpr int RMAX = 128;
__device__ __forceinline__ void route_phase(Ctx& C, int li) {
    LAS float* rf = (LAS float*)C.lds;
    LAS int* lcnt = (LAS int*)(C.lds + 32768);
    LAS int* lbase = lcnt + 8;
    LAS int* ti = lbase + 8;
    LAS float* tf = (LAS float*)(ti + RMAX * 4);
    const int tid = C.tid, lane = C.lane;
    for (int i = tid; i < 8192; i += 512) rf[i] = C.RF()[li * 8192 + i];
    if (tid < 8) lcnt[tid] = 0;
    __syncthreads();
    const int nrows = (NTOK - C.bid + C.G - 1) / C.G;
    for (int k = C.wave; k < nrows; k += 8) {
        const size_t row = (size_t)C.bid + (size_t)k * C.G;
        if ((int)(row % LT) < FIRSTV) { if (lane == 0) ti[k * 4] = -1; continue; }
        f32x4 v[4]; float ss = 0.f;
#pragma unroll
        for (int j = 0; j < 4; ++j) { v[j] = *(const f32x4*)(C.H() + row * D + 4 * lane + 256 * j); ss += (v[j][0] * v[j][0] + v[j][1] * v[j][1]) + (v[j][2] * v[j][2] + v[j][3] * v[j][3]); }
        ss = wave_sum(ss);
        const float rstd = rsqrtf(ss * (1.0f / 1024.0f) + EPS);
        float lg[8];
#pragma unroll
        for (int e = 0; e < 8; ++e) {
            float p = 0.f;
#pragma unroll
            for (int j = 0; j < 4; ++j) { const f32x4 w = *(const LAS f32x4*)(rf + e * 1024 + 4 * lane + 256 * j); p += (v[j][0] * w[0] + v[j][1] * w[1]) + (v[j][2] * w[2] + v[j][3] * w[3]); }
            lg[e] = wave_sum(p) * rstd;
        }
        int e1 = 0; float l1 = lg[0];
#pragma unroll
        for (int e = 1; e < 8; ++e) if (lg[e] > l1) { l1 = lg[e]; e1 = e; }
        int e2 = -1; float l2 = -3.0e38f;
#pragma unroll
        for (int e = 0; e < 8; ++e) if (e != e1 && lg[e] > l2) { l2 = lg[e]; e2 = e; }
        const float g1 = 1.f / (1.f + expf(l2 - l1)), g2 = 1.f - g1;
        if (lane == 0) {
            const int lr1 = __hip_atomic_fetch_add(&lcnt[e1], 1, __ATOMIC_RELAXED, __HIP_MEMORY_SCOPE_WORKGROUP), lr2 = __hip_atomic_fetch_add(&lcnt[e2], 1, __ATOMIC_RELAXED, __HIP_MEMORY_SCOPE_WORKGROUP);
            ti[k * 4 + 0] = e1; ti[k * 4 + 1] = e2; ti[k * 4 + 2] = lr1; ti[k * 4 + 3] = lr2;
            tf[k * 4 + 0] = g1; tf[k * 4 + 1] = g2; tf[k * 4 + 2] = rstd;
        }
    }
    __syncthreads();
    if (tid < 8) lbase[tid] = (int)__hip_atomic_fetch_add(C.ctl() + CW_CNT + (li * 8 + tid) * 64, (unsigned)lcnt[tid], RLX_AGENT);
    __syncthreads();
    for (int k = tid; k < nrows; k += 512) {
        const int row = C.bid + k * C.G;
        if (ti[k * 4] < 0) continue;
        const int e1 = ti[k * 4], e2 = ti[k * 4 + 1], r1 = lbase[e1] + ti[k * 4 + 2], r2 = lbase[e2] + ti[k * 4 + 3];
        C.LIST()[(size_t)e1 * NTOK + r1] = row; C.LIST()[(size_t)e2 * NTOK + r2] = row;
        unsigned* inf = C.TINFO() + (size_t)row * 8;
        inf[0] = (unsigned)e1; inf[1] = (unsigned)e2; inf[2] = (unsigned)r1; inf[3] = (unsigned)r2; inf[4] = __builtin_bit_cast(unsigned, tf[k * 4]); inf[5] = __builtin_bit_cast(unsigned, tf[k * 4 + 1]);
        C.RSTD()[row] = tf[k * 4 + 2];
    }
    __syncthreads();
}
__device__ __forceinline__ void load_panels(Ctx& C, int li, LAS int* pst) {
    __syncthreads();
    if (C.tid == 0) { int acc = 0;
        for (int e = 0; e < 8; ++e) { const int c = (int)__hip_atomic_load(C.ctl() + CW_CNT + (li * 8 + e) * 64, RLX_AGENT); pst[e] = acc; pst[16 + e] = c; acc += (c + 255) >> 8; }
        pst[8] = acc; }
    __syncthreads();
}
__device__ __forceinline__ void gather_phase(Ctx& C, int li) {
    LAS int* pst = (LAS int*)C.lds;
    load_panels(C, li, pst);
    const int gw = C.bid * 8 + C.wave, NGW = C.G * 8, lane = C.lane;
    const int nslot = pst[8] * 256;
    for (int s = gw; s < nslot; s += NGW) {
        const int panel = s >> 8; int e = 0;
#pragma unroll
        for (int j = 1; j < 8; ++j) if (panel >= pst[j]) e = j;
        const int rank = s - pst[e] * 256;
        bf16* xp = C.XG() + (size_t)s * D;
        if (rank < pst[16 + e]) {
            const int tok = C.LIST()[(size_t)e * NTOK + rank]; const float r = C.RSTD()[tok];
#pragma unroll
            for (int j = 0; j < 4; ++j) { const f32x4 v = *(const f32x4*)(C.H() + (size_t)tok * D + 4 * lane + 256 * j); v2u w; w.x = pk2(v[0] * r, v[1] * r); w.y = pk2(v[2] * r, v[3] * r); *(v2u*)(xp + 4 * lane + 256 * j) = w; }
        } else {
#pragma unroll
            for (int j = 0; j < 4; ++j) *(v2u*)(xp + 4 * lane + 256 * j) = (v2u){0u, 0u};
        }
    }
}
__device__ __forceinline__ void combine_phase(Ctx& C, int li, bool last) {
    LAS int* pst = (LAS int*)C.lds;
    load_panels(C, li, pst);
    const int gw = C.bid * 8 + C.wave, NGW = C.G * 8, lane = C.lane;
    for (int row = gw; row < NTOK; row += NGW) {
        if ((row % LT) < FIRSTV) continue;
        const unsigned* inf = C.TINFO() + (size_t)row * 8;
        const int e1 = (int)inf[0], e2 = (int)inf[1];
        const size_t s1 = (size_t)pst[e1] * 256 + inf[2], s2 = (size_t)pst[e2] * 256 + inf[3];
        const float g1 = __builtin_bit_cast(float, inf[4]), g2 = __builtin_bit_cast(float, inf[5]);
        f32x4 v[4]; float ss = 0.f;
#pragma unroll
        for (int j = 0; j < 4; ++j) {
            const int col = 4 * lane + 256 * j;
            v[j] = *(const f32x4*)(C.H() + (size_t)row * D + col);
            const v2u a = *(const v2u*)(C.Y() + s1 * D + col), b = *(const v2u*)(C.Y() + s2 * D + col);
            v[j][0] += g1 * bf_lo(a.x) + g2 * bf_lo(b.x); v[j][1] += g1 * bf_hi(a.x) + g2 * bf_hi(b.x);
            v[j][2] += g1 * bf_lo(a.y) + g2 * bf_lo(b.y); v[j][3] += g1 * bf_hi(a.y) + g2 * bf_hi(b.y);
            ss += (v[j][0] * v[j][0] + v[j][1] * v[j][1]) + (v[j][2] * v[j][2] + v[j][3] * v[j][3]);
        }
        ss = wave_sum(ss);
        if (!last) {
#pragma unroll
            for (int j = 0; j < 4; ++j) { const int col = 4 * lane + 256 * j; *(f32x4*)(C.H() + (size_t)row * D + col) = v[j]; v2u w; w.x = pk2(v[j][0], v[j][1]); w.y = pk2(v[j][2], v[j][3]); *(v2u*)(C.HB() + (size_t)row * D + col) = w; }
            if (lane < 16) C.SSQ()[(size_t)row * 16 + lane] = (lane == 0) ? ss : 0.f;
        } else {
            const int b = row / LT, t = row % LT;
            if (t >= LEAD) {
                const float rs = rsqrtf(ss * (1.0f / 1024.0f) + EPS);
#pragma unroll
                for (int j = 0; j < 4; ++j) { const int col = 4 * lane + 256 * j; const f32x4 fw = *(const f32x4*)(C.FNORM() + col);
                    *(f32x4*)(C.out + ((size_t)b * SEQ + (t - LEAD)) * D + col) = (f32x4){v[j][0] * rs * fw[0], v[j][1] * rs * fw[1], v[j][2] * rs * fw[2], v[j][3] * rs * fw[3]}; }
            }
        }
    }
}

__global__ void __launch_bounds__(512, 2) mk_fwd(Args args) {
    extern __shared__ __attribute__((aligned(16))) unsigned char lds[];
    Ctx C;
    C.lds = (LAS unsigned char*)lds;
    C.tid = threadIdx.x; C.lane = C.tid & 63; C.wave = __builtin_amdgcn_readfirstlane(C.tid >> 6); C.G = gridDim.x; C.bid = blockIdx.x;
    unsigned char* ws = args.ws; C.ws = ws; C.out = args.out;
    volatile LAS unsigned* MISC = (volatile LAS unsigned*)(C.lds + MISC_OFF);
    for (int u = C.tid; u < (LDS_BYTES - RING_BYTES) / 4; u += 512) ((LAS unsigned*)(C.lds + RING_BYTES))[u] = 0u;
    __syncthreads();
    const int lo = args.ph_lo, hi = args.ph_hi;
    const bool multi = (hi - lo) > 1;
    XcdBarrier bar; bar.bar = (unsigned*)(C.ctl() + CW_BAR); bar.x = 0; bar.st = nullptr;
    if (multi) bar = xcd_barrier_post((unsigned*)(C.ctl() + CW_BAR), MISC + 8);
#define PHASE_CTX(P) Ctx P = C; { unsigned char* w_ = C.ws; asm volatile("" : "+s"(w_)); P.ws = w_; int t_ = C.tid; asm volatile("" : "+v"(t_)); P.tid = t_; P.lane = t_ & 63; P.wave = __builtin_amdgcn_readfirstlane(t_ >> 6); int g_ = C.G, b_ = C.bid; asm volatile("" : "+s"(g_), "+s"(b_)); P.G = g_; P.bid = b_; }
#define IN(k) (lo_l <= (k) && (k) < hi_l)
#define SEAM(k) do { if ((k) + 1 < hi_l) xcd_barrier(bar); } while (0)

    { int lo_l = lo, hi_l = hi; asm volatile("" : "+s"(lo_l), "+s"(hi_l));
      if (IN(0)) { for (int rep = 0; rep < REP_PRO; ++rep) { PHASE_CTX(P); prologue_phase(P, args); SEAM(0); } } }

    for (int l = 0; l < DEPTH; ++l) {
        int lo_l = lo, hi_l = hi; asm volatile("" : "+s"(lo_l), "+s"(hi_l));
        const int pb = 1 + 8 * l, li = l >> 1; const bool moe = (l & 1) != 0;
        if (PROBE_PROJ_NOEPI && IN(pb + 0)) {
            PHASE_CTX(P);
            pg8::Gemm g{P.HB(), (const bf16*)(P.ws + WS_WIN) + (size_t)l * WIN * D, NTOK, WIN, D, 0};
            pg8::StaticOrder S; S.init(NTOK, WIN, P.G, P.bid);
            EpiNone E{(unsigned*)(P.ws + WS_CTL) + 64};
            pg8::gemm_phase<EpiNone, pg8::StaticOrder, true, true>(P.lds, g, S, E);
            SEAM(pb + 0);
        }
        if (PROBE_WOUT_NOEPI && IN(pb + 2)) {
            PHASE_CTX(P);
            pg8::Gemm g{P.HB(), (const bf16*)(P.ws + WS_WOUT) + (size_t)l * D * D, NTOK, D, D, 0};
            pg8::StaticOrder S; S.init(NTOK, D, P.G, P.bid);
            EpiNone E{(unsigned*)(P.ws + WS_CTL) + 64};
            pg8::gemm_phase<EpiNone, pg8::StaticOrder, true, true>(P.lds, g, S, E);
            SEAM(pb + 0);
        }
        if (PROBE_FF2_NOEPI && IN(pb + 2)) {
            PHASE_CTX(P);
            pg8::Gemm g{(const bf16*)(P.ws + WS_WD13), (const bf16*)(P.ws + WS_WD2) + (size_t)li * D * FFD, NTOK, D, FFD, 0};
            pg8::StaticOrder S; S.init(NTOK, D, P.G, P.bid);
            EpiNone E{(unsigned*)(P.ws + WS_CTL) + 64};
            pg8::gemm_phase<EpiNone, pg8::StaticOrder, true, true>(P.lds, g, S, E);
            SEAM(pb + 0);
        }
        if (IN(pb + 0)) for (int rep = 0; rep < REP_PROJ; ++rep) {
            PHASE_CTX(P);
            pg8::Gemm g{P.HB(), (const bf16*)(P.ws + WS_WIN) + (size_t)l * WIN * D, NTOK, WIN, D, 0};
            pg8::StaticOrder S; S.init(NTOK, WIN, P.G, P.bid);
            rstd_table(P.lds, P.SSQ(), S, P.tid);
            EpiProj E{P.PROJ(), P.LOGF(), (const LAS float*)(P.lds + RS_OFF), P.LB() + l * 512};
            pg8::gemm_phase<EpiProj, pg8::StaticOrder, true, true>(P.lds, g, S, E);
            SEAM(pb + 0);
        }
        if (IN(pb + 1)) for (int rep = 0; rep < REP_MIX; ++rep) { PHASE_CTX(P); mixer_phase(P, l); SEAM(pb + 1); }
        if (IN(pb + 2)) {
            PHASE_CTX(P);
            pg8::Gemm g{P.MIX(), (const bf16*)(P.ws + WS_WOUT) + (size_t)l * D * D, NTOK, D, D, 0};
            pg8::StaticOrder S; S.init(MAINROWS, D, P.G, P.bid);
            EpiResid E{P.H(), P.HB(), P.SSQ()};
            pg8::gemm_phase<EpiResid, pg8::StaticOrder, true, true>(P.lds, g, S, E);
            mini_resid_phase(P, g.A, g.Bt, D, MAINROWS);
            SEAM(pb + 2);
        }
        if (!moe) {
            if (IN(pb + 5)) for (int rep = 0; rep < REP_FF1; ++rep) {
                PHASE_CTX(P);
                pg8::Gemm g{P.HB(), (const bf16*)(P.ws + WS_WD13) + (size_t)li * 2 * FFD * D, NTOK, 2 * FFD, D, 0};
                pg8::StaticOrder S; S.init(NTOK, 2 * FFD, P.G, P.bid);
                rstd_table(P.lds, P.SSQ(), S, P.tid);
                EpiGLU E{P.T(), FFD, (const LAS float*)(P.lds + RS_OFF)};
                pg8::gemm_phase<EpiGLU, pg8::StaticOrder, true, true>(P.lds, g, S, E);
                SEAM(pb + 5);
            }
            if (IN(pb + 6)) {
                PHASE_CTX(P);
                pg8::Gemm g{P.T(), (const bf16*)(P.ws + WS_WD2) + (size_t)li * D * FFD, NTOK, D, FFD, 0};
                pg8::StaticOrder S; S.init(MAINROWS, D, P.G, P.bid);
                EpiResid E{P.H(), P.HB(), P.SSQ()};
                pg8::gemm_phase<EpiResid, pg8::StaticOrder, true, true>(P.lds, g, S, E);
                mini_resid_phase(P, g.A, g.Bt, FFD, MAINROWS);
                SEAM(pb + 6);
            }
        } else {
            if (IN(pb + 3)) { PHASE_CTX(P); route_phase(P, li); SEAM(pb + 3); }
            if (IN(pb + 4)) for (int rep = 0; rep < REP_GATHER; ++rep) { PHASE_CTX(P); gather_phase(P, li); SEAM(pb + 4); }
            if (IN(pb + 5)) for (int rep = 0; rep < REP_FF1; ++rep) {
                PHASE_CTX(P);
                LAS int* pst = (LAS int*)(P.lds + RING_BYTES + 1024);
                load_panels(P, li, pst);
#define PS(i) __builtin_amdgcn_readfirstlane(pst[i])
                pg8::GroupedOrder S{PS(0), PS(1), PS(2), PS(3), PS(4), PS(5), PS(6), PS(7), PS(8), 2 * FFE / 256, P.G, P.bid};
                pg8::Gemm g{P.XG(), (const bf16*)(P.ws + WS_WM13) + (size_t)li * 8 * 2 * FFE * D, 0, 2 * FFE, D, (size_t)2 * FFE * D * 2};
                EpiGLU E{P.T(), FFE, nullptr};
                pg8::gemm_phase<EpiGLU, pg8::GroupedOrder, true, true>(P.lds, g, S, E);
                SEAM(pb + 5);
            }
            if (IN(pb + 6)) {
                PHASE_CTX(P);
                LAS int* pst = (LAS int*)(P.lds + RING_BYTES + 1024);
                load_panels(P, li, pst);
                const int ptot = PS(8), pfull = (ptot / 64) * 64, plim = (ptot - pfull <= 32) ? pfull : ptot;
                pg8::GroupedPanelOrder S{PS(1), PS(2), PS(3), PS(4), PS(5), PS(6), PS(7), plim, D / 256, P.G, P.bid};
                pg8::Gemm g{P.T(), (const bf16*)(P.ws + WS_WM2) + (size_t)li * 8 * D * FFE, 0, D, FFE, (size_t)D * FFE * 2};
                EpiY E{P.Y()};
                pg8::gemm_phase<EpiY, pg8::GroupedPanelOrder, true, true>(P.lds, g, S, E);
                mini_y_phase(P, g.A, g.Bt, (size_t)D * FFE, FFE, plim, ptot, PS(1), PS(2), PS(3), PS(4), PS(5), PS(6), PS(7));
                SEAM(pb + 6);
            }
#undef PS
            if (IN(pb + 7)) { PHASE_CTX(P); combine_phase(P, li, l == DEPTH - 1); SEAM(pb + 7); }
        }
    }
#undef IN
#undef SEAM
#undef PHASE_CTX
}

extern "C" void kernel_launch(void* const* d_in, const int* in_sizes, int n_in, void* d_out, int out_size, void* d_ws, size_t ws_size, hipStream_t stream) {
    static int grid = 0;
    if (grid == 0) {
        if (n_in != 19 || out_size != NB * SEQ * D || ws_size < WS_END) { fprintf(stderr, "kernel_launch: unexpected shapes (n_in %d, out %d, ws %zu < %zu); nothing launched\n", n_in, out_size, ws_size, (size_t)WS_END); grid = -1; return; }
        int dev = 0, cus = 0, per_cu = 0;
        if (hipGetDevice(&dev) != hipSuccess || hipDeviceGetAttribute(&cus, hipDeviceAttributeMultiprocessorCount, dev) != hipSuccess) { grid = -1; return; }
        if (hipFuncSetAttribute((const void*)mk_fwd, hipFuncAttributeMaxDynamicSharedMemorySize, LDS_BYTES) != hipSuccess) { fprintf(stderr, "kernel_launch: hipFuncSetAttribute failed\n"); grid = -1; return; }
        if (hipOccupancyMaxActiveBlocksPerMultiprocessor(&per_cu, (const void*)mk_fwd, 512, LDS_BYTES) != hipSuccess || per_cu < 1) { fprintf(stderr, "kernel_launch: occupancy query says %d blocks per CU\n", per_cu); }
        (void)hipGetLastError();
        grid = cus;
    }
    if (grid < 0) return;
    if (hipMemsetAsync((char*)d_ws + WS_CTL, 0, CTL_ZERO_BYTES, stream) != hipSuccess) return;
    Args a{};
    for (int i = 0; i < 19; ++i) a.in[i] = (const float*)d_in[i];
    a.out = (float*)d_out; a.ws = (unsigned char*)d_ws;
#if MK_ONE_LAUNCH
    a.ph_lo = 0; a.ph_hi = NPHASE;
    hipLaunchKernelGGL(mk_fwd, dim3(grid), dim3(512), LDS_BYTES, stream, a);
#else
    for (int p = 0; p < NPHASE; ++p) {
        if (p > 0) { const int l = (p - 1) / 8, k = (p - 1) % 8; const bool moe = (l & 1) != 0; if (!moe && (k == 3 || k == 4 || k == 7)) continue; }
        a.ph_lo = p; a.ph_hi = p + 1;
        hipLaunchKernelGGL(mk_fwd, dim3(grid), dim3(512), LDS_BYTES, stream, a);
    }
#endif
}
```

```cpp
#include <hip/hip_runtime.h>
#include <cstdio>
#include <cstdint>

#ifndef REP_ATT
#define REP_ATT 1
#endif
#ifndef REP_HG
#define REP_HG 1
#endif
#ifndef PROBE_PROJ_NOEPI
#define PROBE_PROJ_NOEPI 0
#endif
#ifndef PROBE_WOUT_NOEPI
#define PROBE_WOUT_NOEPI 0
#endif
#ifndef PROBE_FF2_NOEPI
#define PROBE_FF2_NOEPI 0
#endif
#ifndef REP_PRO
#define REP_PRO 1
#endif
#ifndef REP_PROJ
#define REP_PROJ 1
#endif
#ifndef REP_MIX
#define REP_MIX 1
#endif
#ifndef REP_FF1
#define REP_FF1 1
#endif
#ifndef REP_GATHER
#define REP_GATHER 1
#endif
#ifndef MK_ONE_LAUNCH
#define MK_ONE_LAUNCH 1
#endif

namespace pg8 {
#define PG8_LAS __attribute__((address_space(3)))
typedef unsigned short bf16_t;
typedef short bf16x8 __attribute__((ext_vector_type(8)));
typedef float f32x4 __attribute__((ext_vector_type(4)));
typedef unsigned u32x4 __attribute__((ext_vector_type(4)));
typedef unsigned u32x2 __attribute__((ext_vector_type(2)));
constexpr int BM = 256, BK = 64, HALF = 128, HTB = HALF * BK * 2  , STAGE_BYTES = 8 * HTB, NXCD = 8, WGM = 8;

__host__ __device__ __forceinline__ int lds_byte(int r, int c) { const int st = (r >> 4) * 2 + (c >> 5), rr = r & 15, cc = c & 31, ob = rr * 64 + cc * 2; return st * 1024 + (ob ^ (((ob >> 9) & 1) << 5)); }
__host__ __device__ __forceinline__ void stage_rc(int b, int& R, int& C) { const int st = b / 1024, sb = b % 1024, swz = sb ^ (((sb >> 9) & 1) << 5); R = (st >> 1) * 16 + swz / 64; C = (st & 1) * 32 + (swz % 64) / 2; }
__host__ __device__ __forceinline__ int perm32(int rho) { const int n = rho >> 4, i = rho & 15; return 8 * (i >> 2) + 4 * n + (i & 3); }

struct Unit { int pm, pn, e, idx; };
struct Gemm { const bf16_t* A; const bf16_t* Bt; int M, N, K; size_t bstride; };

struct StaticOrder {
    int nM, nN, nwg, G, c;
    __host__ __device__ void init(int M, int N, int G_, int c_) { nM = M / BM; nN = N / BM; nwg = nM * nN; G = G_; c = c_; }
    __host__ __device__ bool next(int i, Unit& u) const {
        const long L = (long)i * G + c; if (L >= nwg) return false;
        int wgid = (int)L; { const int q = nwg / NXCD, r = nwg % NXCD, xcd = wgid % NXCD, off = wgid / NXCD; wgid = (xcd < r ? xcd * (q + 1) : r * (q + 1) + (xcd - r) * q) + off; }
        const int nig = WGM * nN, gid = wgid / nig, fm = gid * WGM, gsz = (nM - fm) < WGM ? (nM - fm) : WGM;
        u.pm = fm + ((wgid % nig) % gsz); u.pn = (wgid % nig) / gsz; u.e = 0; u.idx = i; return true;
    }
    __device__ __forceinline__ void a_ready(const Unit&) const {}
    __device__ __forceinline__ void done(const Unit&) const {}
};
struct GroupedPanelOrder {
    int p1, p2, p3, p4, p5, p6, p7, plim, nN, G, c;
    __device__ __forceinline__ bool next(int i, Unit& u) const {
        const int L = i * G + c; if (L >= plim * nN) return false;
        const int pm = L / nN; u.pm = pm; u.pn = L - pm * nN;
        u.e = (pm >= p1) + (pm >= p2) + (pm >= p3) + (pm >= p4) + (pm >= p5) + (pm >= p6) + (pm >= p7); u.idx = i; return true;
    }
    __device__ __forceinline__ void a_ready(const Unit&) const {}
    __device__ __forceinline__ void done(const Unit&) const {}
};
struct GroupedOrder {
    int p0, p1, p2, p3, p4, p5, p6, p7, p8, nN, G, c;
    __device__ __forceinline__ bool next(int i, Unit& u) const {
        const int L = i * G + c; if (L >= p8 * nN) return false;
        int e = 0, ps = 0, pe = p1;
        if (L >= p1 * nN) { e = 1; ps = p1; pe = p2; }
        if (L >= p2 * nN) { e = 2; ps = p2; pe = p3; }
        if (L >= p3 * nN) { e = 3; ps = p3; pe = p4; }
        if (L >= p4 * nN) { e = 4; ps = p4; pe = p5; }
        if (L >= p5 * nN) { e = 5; ps = p5; pe = p6; }
        if (L >= p6 * nN) { e = 6; ps = p6; pe = p7; }
        if (L >= p7 * nN) { e = 7; ps = p7; pe = p8; }
        const int rem = L - ps * nN, R = pe - ps;
        u.e = e; u.pn = rem / R; u.pm = ps + rem % R; u.idx = i; return true;
    }
    __device__ __forceinline__ void a_ready(const Unit&) const {}
    __device__ __forceinline__ void done(const Unit&) const {}
};

__device__ __forceinline__ unsigned cvt_pk_bf16(float lo, float hi) { unsigned r; asm volatile("v_cvt_pk_bf16_f32 %0, %1, %2" : "=v"(r) : "v"(lo), "v"(hi)); return r; }

template <class Epi, class Sched, bool ALIGN_EPI = false, bool SP2 = false>
__device__ __forceinline__ void gemm_phase(PG8_LAS unsigned char* lds, const Gemm g, const Sched& S, const Epi& E) {
    int tid_l = threadIdx.x; asm volatile("" : "+v"(tid_l));
    const int tid = tid_l, wid = __builtin_amdgcn_readfirstlane(tid >> 6), lane = tid & 63, wr = wid >> 2, wc = wid & 3, fr = lane & 15, fq = lane >> 4;
    const int K = g.K, nt = K / BK;
    unsigned voffA[2], voffB[2];
#pragma unroll
    for (int i = 0; i < 2; ++i) { int R, C; stage_rc(tid * 16 + i * 8192, R, C); const int Rb = Epi::PERM ? ((R & ~31) + perm32(R & 31)) : R;
        voffA[i] = (unsigned)(R * K + C) * 2u; voffB[i] = (unsigned)(Rb * K + C) * 2u; }
    const size_t kstep = (size_t)(BK * 2);
    const size_t hstep = (size_t)HALF * K * 2;
    const size_t tstep = 2 * hstep;
    const unsigned ldsw = (unsigned)wid * 1024u;
    const int aoff = lds_byte(wr * 64 + fr, fq * 8), boff = lds_byte(wc * 32 + fr, fq * 8);
#define PG8_SA(b, h) (((b) * 2 + (h)) * HTB)
#define PG8_SB(b, h) ((4 + (b) * 2 + (h)) * HTB)
#define PG8_STAGE(bufoff, gbase, voff) do { _Pragma("unroll") for (int _i = 0; _i < 2; ++_i) \
        __builtin_amdgcn_global_load_lds((const unsigned*)((const char*)(gbase) + (voff)[_i]), (PG8_LAS unsigned*)(lds + (bufoff) + ldsw + _i * 8192), 16, 0, 0); } while (0)
#define PG8_LDA(dst, b, h) do { _Pragma("unroll") for (int m = 0; m < 4; ++m) _Pragma("unroll") for (int k = 0; k < 2; ++k) dst[m][k] = *(const PG8_LAS bf16x8*)(lds + PG8_SA(b, h) + aoff + m * 2048 + k * 1024); } while (0)
#define PG8_LDB(dst, b, h) do { _Pragma("unroll") for (int n = 0; n < 2; ++n) _Pragma("unroll") for (int k = 0; k < 2; ++k) dst[n][k] = *(const PG8_LAS bf16x8*)(lds + PG8_SB(b, h) + boff + n * 2048 + k * 1024); } while (0)
#define PG8_MMA(ai, bj, At, Bt) do { __builtin_amdgcn_s_setprio(1); _Pragma("unroll") for (int m = 0; m < 4; ++m) _Pragma("unroll") for (int n = 0; n < 2; ++n) _Pragma("unroll") for (int k = 0; k < 2; ++k) \
        acc[ai][bj][m][n] = __builtin_amdgcn_mfma_f32_16x16x32_bf16(Bt[n][k], At[m][k], acc[ai][bj][m][n], 0, 0, 0); __builtin_amdgcn_s_setprio(0); } while (0)
#define PG8_WAIT_V(n) asm volatile("s_waitcnt vmcnt(" #n ")" ::: "memory")
#define PG8_WAIT_L(n) asm volatile("s_waitcnt lgkmcnt(" #n ")" ::: "memory")
#define PG8_BAR __builtin_amdgcn_s_barrier()
#define PG8_SCHED __builtin_amdgcn_sched_barrier(0)
    Unit cur, nxt; int ui = 0;
    if (!S.next(0, cur)) return;
    f32x4 acc[2][2][4][2];
#pragma unroll
    for (int a = 0; a < 2; ++a)
#pragma unroll
        for (int b = 0; b < 2; ++b)
#pragma unroll
            for (int m = 0; m < 4; ++m)
#pragma unroll
                for (int n = 0; n < 2; ++n) acc[a][b][m][n] = (f32x4){0.f, 0.f, 0.f, 0.f};
    bf16x8 At[4][2], B0[2][2], B1[2][2];
    const char* cA = (const char*)g.A + (size_t)cur.pm * tstep; const char* cB = (const char*)g.Bt + (size_t)cur.e * g.bstride + (size_t)cur.pn * tstep;
    S.a_ready(cur);
    if constexpr (SP2) {
        PG8_STAGE(PG8_SB(0, 0), cB, voffB); PG8_STAGE(PG8_SB(0, 1), cB + hstep, voffB); PG8_STAGE(PG8_SA(0, 0), cA, voffA); PG8_STAGE(PG8_SA(0, 1), cA + hstep, voffA);
        if (wr == 1) PG8_BAR;
        PG8_WAIT_V(2); PG8_BAR;
        PG8_STAGE(PG8_SB(1, 0), cB + kstep, voffB); PG8_STAGE(PG8_SA(1, 0), cA + kstep, voffA); PG8_STAGE(PG8_SB(1, 1), cB + hstep + kstep, voffB);
        PG8_WAIT_V(6); PG8_BAR;
    } else {
        PG8_STAGE(PG8_SB(0, 0), cB, voffB); PG8_STAGE(PG8_SA(0, 0), cA, voffA); PG8_STAGE(PG8_SB(0, 1), cB + hstep, voffB); PG8_STAGE(PG8_SA(0, 1), cA + hstep, voffA);
        if (wr == 1) PG8_BAR;
        PG8_WAIT_V(4); PG8_BAR;
        PG8_STAGE(PG8_SB(1, 0), cB + kstep, voffB); PG8_STAGE(PG8_SA(1, 0), cA + kstep, voffA); PG8_STAGE(PG8_SB(1, 1), cB + hstep + kstep, voffB);
        PG8_WAIT_V(6); PG8_BAR;
    }
    for (;;) {
        const bool has_next = S.next(ui + 1, nxt);
        const char* nA = has_next ? (const char*)g.A + (size_t)nxt.pm * tstep : cA; const char* nB = has_next ? (const char*)g.Bt + (size_t)nxt.e * g.bstride + (size_t)nxt.pn * tstep : cB;
        for (int t = 0; t < nt; t += 2) {
            const bool last = (t == nt - 2);
            const char* a1 = cA + (size_t)(t + 1) * kstep;
            const char* a2 = last ? nA : cA + (size_t)(t + 2) * kstep; const char* b2 = last ? nB : cB + (size_t)(t + 2) * kstep;
            const char* a3 = a2 + kstep; const char* b3 = b2 + kstep;
            if (last && has_next) S.a_ready(nxt);
            if constexpr (SP2) {
            PG8_LDB(B0, 0, 0); PG8_LDB(B1, 0, 1); PG8_SCHED; PG8_LDA(At, 0, 0); PG8_STAGE(PG8_SA(1, 1), a1 + hstep, voffA);
            PG8_WAIT_V(8); PG8_WAIT_L(0); PG8_BAR; PG8_MMA(0, 0, At, B0); PG8_MMA(0, 1, At, B1); PG8_BAR; PG8_SCHED;
            PG8_LDA(At, 0, 1); PG8_STAGE(PG8_SB(0, 0), b2, voffB); PG8_STAGE(PG8_SB(0, 1), b2 + hstep, voffB); PG8_STAGE(PG8_SA(0, 0), a2, voffA);
            PG8_WAIT_V(8); PG8_WAIT_L(0); PG8_BAR; PG8_MMA(1, 0, At, B0); PG8_MMA(1, 1, At, B1); PG8_BAR; PG8_SCHED;
            PG8_LDB(B0, 1, 0); PG8_LDB(B1, 1, 1); PG8_SCHED; PG8_LDA(At, 1, 0); PG8_STAGE(PG8_SA(0, 1), a2 + hstep, voffA);
            PG8_WAIT_V(8); PG8_WAIT_L(0); PG8_BAR; PG8_MMA(0, 0, At, B0); PG8_MMA(0, 1, At, B1); PG8_BAR; PG8_SCHED;
            PG8_LDA(At, 1, 1); PG8_STAGE(PG8_SB(1, 0), b3, voffB); PG8_STAGE(PG8_SB(1, 1), b3 + hstep, voffB); PG8_STAGE(PG8_SA(1, 0), a3, voffA);
            PG8_WAIT_V(8); PG8_WAIT_L(0); PG8_BAR; PG8_MMA(1, 0, At, B0); PG8_MMA(1, 1, At, B1); PG8_BAR; PG8_SCHED;
            } else {
            PG8_LDB(B0, 0, 0); PG8_SCHED; PG8_LDA(At, 0, 0); PG8_STAGE(PG8_SA(1, 1), a1 + hstep, voffA);
            PG8_WAIT_L(8); PG8_BAR; PG8_WAIT_L(0); PG8_MMA(0, 0, At, B0); PG8_BAR; PG8_SCHED;
            PG8_LDB(B1, 0, 1); PG8_STAGE(PG8_SB(0, 0), b2, voffB);
            PG8_BAR; PG8_WAIT_L(0); PG8_MMA(0, 1, At, B1); PG8_BAR;
            PG8_LDA(At, 0, 1); PG8_STAGE(PG8_SA(0, 0), a2, voffA);
            PG8_BAR; PG8_WAIT_L(0); PG8_MMA(1, 0, At, B0); PG8_BAR; PG8_SCHED;
            PG8_STAGE(PG8_SB(0, 1), b2 + hstep, voffB);
            PG8_WAIT_V(6); PG8_BAR; PG8_MMA(1, 1, At, B1); PG8_BAR;
            PG8_LDB(B0, 1, 0); PG8_SCHED; PG8_LDA(At, 1, 0); PG8_STAGE(PG8_SA(0, 1), a2 + hstep, voffA);
            PG8_WAIT_L(8); PG8_BAR; PG8_WAIT_L(0); PG8_MMA(0, 0, At, B0); PG8_BAR; PG8_SCHED;
            PG8_LDB(B1, 1, 1); PG8_STAGE(PG8_SB(1, 0), b3, voffB);
            PG8_BAR; PG8_WAIT_L(0); PG8_MMA(0, 1, At, B1); PG8_BAR;
            PG8_LDA(At, 1, 1); PG8_STAGE(PG8_SA(1, 0), a3, voffA);
            PG8_BAR; PG8_WAIT_L(0); PG8_MMA(1, 0, At, B0); PG8_BAR; PG8_SCHED;
            PG8_STAGE(PG8_SB(1, 1), b3 + hstep, voffB);
            PG8_WAIT_V(6); PG8_BAR; PG8_MMA(1, 1, At, B1); PG8_BAR;
            }
        }
        if constexpr (ALIGN_EPI) { if (wr == 0) PG8_BAR; }
        if constexpr (!Epi::AFTER_DRAIN) { E(acc, cur, wr, wc, fr, fq); S.done(cur); }
        if (!has_next) break;
#pragma unroll
        for (int a = 0; a < 2; ++a)
#pragma unroll
            for (int b = 0; b < 2; ++b)
#pragma unroll
                for (int m = 0; m < 4; ++m)
#pragma unroll
                    for (int n = 0; n < 2; ++n) acc[a][b][m][n] = (f32x4){0.f, 0.f, 0.f, 0.f};
        cur = nxt; cA = nA; cB = nB; ++ui;
        if constexpr (ALIGN_EPI) { if (wr == 1) PG8_BAR; }
    }
    PG8_WAIT_V(0);
    if constexpr (!ALIGN_EPI) { if (wr == 0) PG8_BAR; }
    PG8_BAR;
    if constexpr (Epi::AFTER_DRAIN) { E.fused(acc, cur, wr, wc, fr, fq, lds, wid, lane); S.done(cur); }
#undef PG8_SA
#undef PG8_SB
#undef PG8_STAGE
#undef PG8_LDA
#undef PG8_LDB
#undef PG8_MMA
#undef PG8_WAIT_V
#undef PG8_WAIT_L
#undef PG8_BAR
#undef PG8_SCHED
}

}

constexpr int D = 1024, NB = 8, SEQ = 2048, DEPTH = 4, LEAD = 128, FIRSTV = 112, LT = LEAD + SEQ, NTOK = NB * LT;
constexpr int WIN = 3584, FFD = 2816, FFE = 3584, NE = 8, MAXSLOT = 36864;
constexpr float EPS = 1e-6f;
constexpr int NPHASE = 1 + 8 * DEPTH;
constexpr int MAINROWS = (NTOK / (64 * 256)) * (64 * 256);

constexpr size_t MiB = 1u << 20;
constexpr size_t WS_CTL = 0, CTL_ZERO_BYTES = MiB;
constexpr size_t WS_TAB = 1 * MiB;
constexpr size_t WS_WIN = 2 * MiB;
constexpr size_t WS_WOUT = WS_WIN + 28 * MiB;
constexpr size_t WS_WD13 = WS_WOUT + 8 * MiB;
constexpr size_t WS_WD2 = WS_WD13 + 22 * MiB;
constexpr size_t WS_WM13 = WS_WD2 + 11 * MiB;
constexpr size_t WS_WM2 = WS_WM13 + 224 * MiB;
constexpr size_t WS_H = WS_WM2 + 112 * MiB;
constexpr size_t WS_HB = WS_H + 68 * MiB;
constexpr size_t WS_SSQ = WS_HB + 34 * MiB;
constexpr size_t WS_ROUTE = WS_SSQ + 2 * MiB;
constexpr size_t WS_ACT = WS_ROUTE + 2 * MiB;
constexpr size_t WS_XG = WS_ACT + 252 * MiB;
constexpr size_t WS_END = WS_XG + 72 * MiB;
constexpr size_t ACT_PROJ = 0, ACT_LOGF = 119 * MiB, ACT_MIX = 153 * MiB;
constexpr size_t TAB_LB = 0, TAB_BIAS = 8192, TAB_LAM = 12288, TAB_SUBLN = 12544, TAB_HGNW = 14592, TAB_RF = 20480, TAB_FNORM = 20480 + 65536;
constexpr size_t ROUTE_INFO = 0, ROUTE_LIST = 640 * 1024, ROUTE_RSTD = 1280 * 1024;
constexpr int CW_TMO = 0, CW_BAR = 4096, CW_CNT = 8192;

constexpr int RING_BYTES = 131072, MISC_OFF = RING_BYTES + 320, LDS_BYTES = 147456;

#define GAS __attribute__((address_space(1)))
#define LAS __attribute__((address_space(3)))
typedef unsigned short bf16;
typedef unsigned v4u __attribute__((ext_vector_type(4)));
typedef unsigned v2u __attribute__((ext_vector_type(2)));
typedef float f32x4 __attribute__((ext_vector_type(4)));
typedef GAS unsigned gu32;
#define RLX_AGENT __ATOMIC_RELAXED, __HIP_MEMORY_SCOPE_AGENT
#define LDS_WAIT() asm volatile("s_waitcnt lgkmcnt(0)" ::: "memory")
__device__ __forceinline__ unsigned f2bf(float f) { unsigned u = __builtin_bit_cast(unsigned, f); return (u + 0x7fffu + ((u >> 16) & 1u)) >> 16; }
__device__ __forceinline__ unsigned pk2(float lo, float hi) { return f2bf(lo) | (f2bf(hi) << 16); }
__device__ __forceinline__ float bf_lo(unsigned w) { return __builtin_bit_cast(float, w << 16); }
__device__ __forceinline__ float bf_hi(unsigned w) { return __builtin_bit_cast(float, w & 0xffff0000u); }
__device__ __forceinline__ f32x4 bf4(v2u w) { return (f32x4){bf_lo(w.x), bf_hi(w.x), bf_lo(w.y), bf_hi(w.y)}; }
__device__ __forceinline__ float silu_f(float x) { return x * __builtin_amdgcn_rcpf(1.f + __expf(-x)); }
__device__ __forceinline__ float wave_sum(float v) {
#pragma unroll
    for (int o = 1; o < 64; o <<= 1) v += __shfl_xor(v, o);
    return v;
}

#define XB_TMO      128
#define XB_XCNT(j)  (256  + 64 * (j))
#define XB_XSUB(j)  (1280 + 64 * (j))
#define XB_XGEN(j)  (2304 + 64 * (j))
#define XB_TOP      3328
#define XB_TOPGEN   3392
#define XCD_BAR_WORDS 3456
#define XB_SPIN_CAP (1u << 18)

__device__ __forceinline__ unsigned xb_ld(unsigned* p)              { return __hip_atomic_load(p, __ATOMIC_RELAXED, __HIP_MEMORY_SCOPE_AGENT); }
__device__ __forceinline__ unsigned xb_add(unsigned* p, unsigned v) { return __hip_atomic_fetch_add(p, v, __ATOMIC_RELAXED, __HIP_MEMORY_SCOPE_AGENT); }
__device__ __forceinline__ unsigned xb_xcc_id() { return (unsigned)__builtin_amdgcn_s_getreg((3 << 11) | 20) & 0xFu; }
#define XB_SPIN(cond, bar) do { unsigned _sp = 0; while (cond) { __builtin_amdgcn_s_sleep(1); \
    if ((++_sp & 255u) == 0u) { if (xb_ld(&(bar)[XB_TMO])) break; if (_sp > XB_SPIN_CAP) { atomicAdd(&(bar)[XB_TMO], 1u); break; } } } } while (0)

struct XcdBarrier {
    unsigned* bar; unsigned x;
    volatile LAS unsigned* st;
};

__device__ __forceinline__ XcdBarrier xcd_barrier_post(unsigned* bar, volatile LAS unsigned* st) {
    XcdBarrier b; b.bar = bar; b.x = xb_xcc_id(); b.st = st;
    if (threadIdx.x == 0) (void)xb_add(&bar[XB_XCNT(b.x)], 1u);
    return b;
}
__device__ __forceinline__ void xcd_barrier_complete(unsigned* bar, unsigned x, unsigned& nloc, unsigned& nx) {
    const unsigned G = gridDim.x * gridDim.y * gridDim.z;
    unsigned sum, cnt, mine, sp = 0u;
    for (;;) {
        sum = 0u; cnt = 0u; mine = 0u;
#pragma unroll
        for (unsigned j = 0; j < 16; ++j) { const unsigned c = xb_ld(&bar[XB_XCNT(j)]); sum += c; cnt += (c > 0u) ? 1u : 0u; mine = (j == x) ? c : mine; }
        if (sum == G) break;
        __builtin_amdgcn_s_sleep(1);
        if ((++sp & 255u) == 0u) { if (xb_ld(&bar[XB_TMO])) break; if (sp > XB_SPIN_CAP) { atomicAdd(&bar[XB_TMO], 1u); break; } }
    }
    nloc = mine > 0u ? mine : 1u; nx = cnt > 0u ? cnt : 1u;
}

__device__ __forceinline__ void xcd_barrier(const XcdBarrier& b) {
    asm volatile("s_waitcnt vmcnt(0)" ::: "memory");
    __syncthreads();
    if (threadIdx.x == 0) {
        unsigned* bar = b.bar;
        __builtin_amdgcn_s_waitcnt(0);
        unsigned nloc = b.st[0], nx = b.st[1];
        if (nloc == 0u) { xcd_barrier_complete(bar, b.x, nloc, nx); b.st[0] = nloc; b.st[1] = nx; }
        const unsigned old = xb_add(&bar[XB_XSUB(b.x)], 1u);
        const unsigned gen = old / nloc;
        if (old + 1u == (gen + 1u) * nloc) {
            __builtin_amdgcn_fence(__ATOMIC_RELEASE, "agent");
            asm volatile("s_waitcnt vmcnt(0)" ::: "memory");
            const unsigned og = xb_add(&bar[XB_TOP], 1u);
            const unsigned tg = og / nx;
            if (og + 1u == (tg + 1u) * nx) xb_add(&bar[XB_TOPGEN], 1u);
            else XB_SPIN(xb_ld(&bar[XB_TOPGEN]) == tg, bar);
            __builtin_amdgcn_fence(__ATOMIC_ACQUIRE, "agent");
            xb_add(&bar[XB_XGEN(b.x)], 1u);
            asm volatile("s_waitcnt vmcnt(0)" ::: "memory");
        } else {
            XB_SPIN(xb_ld(&bar[XB_XGEN(b.x)]) == gen, bar);
            __builtin_amdgcn_fence(__ATOMIC_ACQUIRE, "agent");
            asm volatile("s_waitcnt vmcnt(0)" ::: "memory");
        }
    }
    __syncthreads();
}


static __device__ const unsigned char T5B[129] = {0, 1, 2, 3, 4, 5, 6, 7, 8, 9, 10, 11, 12, 13, 14, 15, 16, 16, 16, 17, 17, 18, 18, 18, 19, 19, 19, 20, 20, 20, 20, 21, 21, 21, 21, 22, 22, 22, 22, 22, 23, 23, 23, 23, 23, 23, 24, 24, 24, 24, 24, 24, 25, 25, 25, 25, 25, 25, 25, 26, 26, 26, 26, 26, 26, 26, 26, 27, 27, 27, 27, 27, 27, 27, 27, 27, 27, 28, 28, 28, 28, 28, 28, 28, 28, 28, 28, 29, 29, 29, 29, 29, 29, 29, 29, 29, 29, 29, 29, 30, 30, 30, 30, 30, 30, 30, 30, 30, 30, 30, 30, 30, 30, 31, 31, 31, 31, 31, 31, 31, 31, 31, 31, 31, 31, 31, 31, 31, 31};

struct Ctx {
    LAS unsigned char* lds;
    int tid, lane, wave, G, bid;
    float* out;
    unsigned char* ws;
    __device__ __forceinline__ gu32* ctl() const { return (gu32*)(ws + WS_CTL); }
    __device__ __forceinline__ bf16* HB() const { return (bf16*)(ws + WS_HB); }
    __device__ __forceinline__ float* SSQ() const { return (float*)(ws + WS_SSQ); }
    __device__ __forceinline__ bf16* PROJ() const { return (bf16*)(ws + WS_ACT + ACT_PROJ); }
    __device__ __forceinline__ float* LOGF() const { return (float*)(ws + WS_ACT + ACT_LOGF); }
    __device__ __forceinline__ bf16* MIX() const { return (bf16*)(ws + WS_ACT + ACT_MIX); }
    __device__ __forceinline__ bf16* T() const { return (bf16*)(ws + WS_ACT); }
    __device__ __forceinline__ bf16* XG() const { return (bf16*)(ws + WS_XG); }
    __device__ __forceinline__ bf16* Y() const { return (bf16*)(ws + WS_XG); }
    __device__ __forceinline__ float* LB() const { return (float*)(ws + WS_TAB + TAB_LB); }
    __device__ __forceinline__ float* BIAST() const { return (float*)(ws + WS_TAB + TAB_BIAS); }
    __device__ __forceinline__ float* LAM() const { return (float*)(ws + WS_TAB + TAB_LAM); }
    __device__ __forceinline__ float* RF() const { return (float*)(ws + WS_TAB + TAB_RF); }
    __device__ __forceinline__ float* SUBLN() const { return (float*)(ws + WS_TAB + TAB_SUBLN); }
    __device__ __forceinline__ float* HGNW() const { return (float*)(ws + WS_TAB + TAB_HGNW); }
    __device__ __forceinline__ float* FNORM() const { return (float*)(ws + WS_TAB + TAB_FNORM); }
    __device__ __forceinline__ unsigned* TINFO() const { return (unsigned*)(ws + WS_ROUTE + ROUTE_INFO); }
    __device__ __forceinline__ int* LIST() const { return (int*)(ws + WS_ROUTE + ROUTE_LIST); }
    __device__ __forceinline__ float* RSTD() const { return (float*)(ws + WS_ROUTE + ROUTE_RSTD); }
};
struct Args { const float* in[19]; float* out; unsigned char* ws; int ph_lo, ph_hi; };
enum { IN_X = 0, IN_META, IN_RELB, IN_NMIX, IN_WIN, IN_LBL, IN_HGNW, IN_LAMBDA, IN_SUBLN, IN_WOUT, IN_NFFN, IN_DW1, IN_DW3, IN_DW2, IN_ROUTER, IN_MW1, IN_MW3, IN_MW2, IN_FNORM };

__device__ __forceinline__ v2u pack4(float a, float b, float c, float d) { v2u w; w.x = pg8::cvt_pk_bf16(a, b); w.y = pg8::cvt_pk_bf16(c, d); return w; }
__device__ __forceinline__ float row_rstd(const float* ssq, int row) {
    const f32x4* p = (const f32x4*)(ssq + (size_t)row * 16);
    const f32x4 a = p[0], b = p[1], c = p[2], d = p[3];
    const float s = ((a[0] + a[1]) + (a[2] + a[3])) + ((b[0] + b[1]) + (b[2] + b[3])) + ((c[0] + c[1]) + (c[2] + c[3])) + ((d[0] + d[1]) + (d[2] + d[3]));
    return rsqrtf(s * (1.0f / 1024.0f) + EPS);
}
template <int N> __device__ __forceinline__ float dpp_row_shr(float x) {
    return __builtin_bit_cast(float, __builtin_amdgcn_update_dpp(0, __builtin_bit_cast(int, x), 0x110 + N, 0xf, 0xf, true));
}
constexpr int RS_OFF = RING_BYTES + 4096, RS_MAXU = 12;
template <class Sched> __device__ __forceinline__ void rstd_table(LAS unsigned char* lds, const float* ssq, const Sched& S, int tid) {
    LAS float* rs = (LAS float*)(lds + RS_OFF);
    pg8::Unit u;
    for (int i0 = 0; i0 < RS_MAXU; i0 += 2) {
        const int i = i0 + (tid >> 8);
        if (S.next(i, u)) rs[i * 256 + (tid & 255)] = row_rstd(ssq, u.pm * 256 + (tid & 255));
    }
    __syncthreads();
}
struct EpiProj {
    static constexpr bool PERM = true, AFTER_DRAIN = false;
    bf16* proj; float* logfp; const LAS float* rs; const float* lb;
    template <int AI, int BJ, int NN> __device__ __forceinline__ void hf_block(const pg8::f32x4 (&acc)[2][2][4][2], int row0, int colb, const LAS float* rsu) const {
        const int c0 = colb + BJ * 128 + 4 * NN, cc = c0 - 512;
        const f32x4 l0 = *(const f32x4*)(lb + cc);
        float lf[4][4];
#pragma unroll
        for (int m = 0; m < 4; ++m) {
            const int row = row0 + AI * 128 + m * 16;
            const float r = rsu[AI * 128 + m * 16];
            const bool valid = (row % LT) >= FIRSTV;
            float kx[4];
#pragma unroll
            for (int j = 0; j < 4; ++j) {
                const float lbv = l0[j];
                const float xx = acc[AI][BJ][m][NN][j] * r;
                const float xc = fminf(fmaxf(xx, -30.f), 30.f);
                const float te = __expf(-xc), sg = __builtin_amdgcn_rcpf(1.f + te);
                float lgf = __logf(lbv + (1.f - lbv) * sg);
                float kk = (1.f - lbv) * (te * sg);
                if (!valid) { lgf = 0.f; kk = 0.f; }
                lf[m][j] = lgf; kx[j] = kk;
            }
            v2u w; w.x = pg8::cvt_pk_bf16(kx[0], kx[1]); w.y = pg8::cvt_pk_bf16(kx[2], kx[3]);
            *(v2u*)(proj + (size_t)row * WIN + c0) = w;
        }
#pragma unroll
        for (int j = 0; j < 4; ++j) {
            float carry = 0.f;
#pragma unroll
            for (int m = 0; m < 4; ++m) {
                float x = lf[m][j];
                x += dpp_row_shr<1>(x); x += dpp_row_shr<2>(x); x += dpp_row_shr<4>(x); x += dpp_row_shr<8>(x);
                x += carry;
                carry = __shfl(x, 15, 16);
                lf[m][j] = x;
            }
        }
#pragma unroll
        for (int m = 0; m < 4; ++m) *(f32x4*)(logfp + (size_t)(row0 + AI * 128 + m * 16) * 512 + cc) = (f32x4){lf[m][0], lf[m][1], lf[m][2], lf[m][3]};
    }
    __device__ __forceinline__ void operator()(const pg8::f32x4 (&acc)[2][2][4][2], const pg8::Unit& u, int wr, int wc, int fr, int fq) const {
        const int grp = u.pn >> 1;
        const int row0 = u.pm * 256 + wr * 64 + fr, colb = u.pn * 256 + wc * 32 + 8 * fq;
        const LAS float* rsu = rs + u.idx * 256 + wr * 64 + fr;
        if (grp == 1) {
            hf_block<0, 0, 0>(acc, row0, colb, rsu); hf_block<0, 0, 1>(acc, row0, colb, rsu); hf_block<0, 1, 0>(acc, row0, colb, rsu); hf_block<0, 1, 1>(acc, row0, colb, rsu);
            hf_block<1, 0, 0>(acc, row0, colb, rsu); hf_block<1, 0, 1>(acc, row0, colb, rsu); hf_block<1, 1, 0>(acc, row0, colb, rsu); hf_block<1, 1, 1>(acc, row0, colb, rsu);
            return;
        }
#pragma unroll
        for (int ai = 0; ai < 2; ++ai)
#pragma unroll
            for (int m = 0; m < 4; ++m) {
                const int row = row0 + ai * 128 + m * 16;
                const float r = rsu[ai * 128 + m * 16];
#pragma unroll
                for (int bj = 0; bj < 2; ++bj) {
                    const int c0 = colb + bj * 128;
                    float x[8];
#pragma unroll
                    for (int j = 0; j < 4; ++j) { x[j] = acc[ai][bj][m][0][j] * r; x[4 + j] = acc[ai][bj][m][1][j] * r; }
                    if (grp == 0 || grp == 3) {
#pragma unroll
                        for (int j = 0; j < 8; ++j) x[j] = silu_f(x[j]);
                    } else if (grp == 4) {
#pragma unroll
                        for (int j = 0; j < 8; ++j) x[j] *= 0.18033688011112042f;
                    }
                    v4u w; w.x = pg8::cvt_pk_bf16(x[0], x[1]); w.y = pg8::cvt_pk_bf16(x[2], x[3]); w.z = pg8::cvt_pk_bf16(x[4], x[5]); w.w = pg8::cvt_pk_bf16(x[6], x[7]);
                    *(v4u*)(proj + (size_t)row * WIN + c0) = w;
                }
            }
    }
};
struct EpiResid {
    static constexpr bool PERM = true, AFTER_DRAIN = false;
    bf16* HB; float* ssq;
    __device__ __forceinline__ void operator()(const pg8::f32x4 (&acc)[2][2][4][2], const pg8::Unit& u, int wr, int wc, int fr, int fq) const {
        const int row0 = u.pm * 256 + wr * 64 + fr, colb = u.pn * 256 + wc * 32 + 8 * fq;
#pragma unroll
        for (int ai = 0; ai < 2; ++ai) {
            v4u h[4][2];
#pragma unroll
            for (int m = 0; m < 4; ++m)
#pragma unroll
                for (int bj = 0; bj < 2; ++bj) h[m][bj] = *(const v4u*)(HB + (size_t)(row0 + ai * 128 + m * 16) * D + colb + bj * 128);
#pragma unroll
            for (int m = 0; m < 4; ++m) {
                const int row = row0 + ai * 128 + m * 16;
                float s = 0.f;
#pragma unroll
                for (int bj = 0; bj < 2; ++bj) {
                    const v4u hw = h[m][bj];
                    const f32x4 h0 = (f32x4){bf_lo(hw.x), bf_hi(hw.x), bf_lo(hw.y), bf_hi(hw.y)} + acc[ai][bj][m][0], h1 = (f32x4){bf_lo(hw.z), bf_hi(hw.z), bf_lo(hw.w), bf_hi(hw.w)} + acc[ai][bj][m][1];
                    s += (h0[0] * h0[0] + h0[1] * h0[1]) + (h0[2] * h0[2] + h0[3] * h0[3]) + (h1[0] * h1[0] + h1[1] * h1[1]) + (h1[2] * h1[2] + h1[3] * h1[3]);
                    v4u w; w.x = pg8::cvt_pk_bf16(h0[0], h0[1]); w.y = pg8::cvt_pk_bf16(h0[2], h0[3]); w.z = pg8::cvt_pk_bf16(h1[0], h1[1]); w.w = pg8::cvt_pk_bf16(h1[2], h1[3]);
                    *(v4u*)(HB + (size_t)row * D + colb + bj * 128) = w;
                }
                s += __shfl_xor(s, 16); s += __shfl_xor(s, 32);
                if (fq == 0) ssq[(size_t)row * 16 + u.pn * 4 + wc] = s;
            }
        }
    }
};
struct EpiGLU {
    static constexpr bool PERM = true, AFTER_DRAIN = false;
    bf16* T; int ldt; const LAS float* rs;
    __device__ __forceinline__ void operator()(const pg8::f32x4 (&acc)[2][2][4][2], const pg8::Unit& u, int wr, int wc, int fr, int fq) const {
        const int row0 = u.pm * 256 + wr * 64 + fr, colb = u.pn * 128 + wc * 32 + 8 * fq;
#pragma unroll
        for (int ai = 0; ai < 2; ++ai)
#pragma unroll
            for (int m = 0; m < 4; ++m) {
                const int row = row0 + ai * 128 + m * 16;
                const float r = rs ? rs[u.idx * 256 + wr * 64 + fr + ai * 128 + m * 16] : 1.f;
                float x[8];
#pragma unroll
                for (int j = 0; j < 4; ++j) { x[j] = silu_f(acc[ai][0][m][0][j] * r) * (acc[ai][1][m][0][j] * r); x[4 + j] = silu_f(acc[ai][0][m][1][j] * r) * (acc[ai][1][m][1][j] * r); }
                v4u w; w.x = pg8::cvt_pk_bf16(x[0], x[1]); w.y = pg8::cvt_pk_bf16(x[2], x[3]); w.z = pg8::cvt_pk_bf16(x[4], x[5]); w.w = pg8::cvt_pk_bf16(x[6], x[7]);
                *(v4u*)(T + (size_t)row * ldt + colb) = w;
            }
    }
};
struct EpiNone { static constexpr bool PERM = true, AFTER_DRAIN = false; unsigned* sink;
    __device__ __forceinline__ void operator()(const pg8::f32x4 (&acc)[2][2][4][2], const pg8::Unit& u, int wr, int wc, int fr, int fq) const { pg8::f32x4 s = acc[0][0][0][0];
#pragma unroll
        for (int a = 0; a < 2; ++a)
#pragma unroll
            for (int b = 0; b < 2; ++b)
#pragma unroll
                for (int m = 0; m < 4; ++m)
#pragma unroll
                    for (int n = 0; n < 2; ++n) s = s + acc[a][b][m][n];
        if (s[0] + s[1] + s[2] + s[3] == 1.2345e38f) sink[0] = 1u; } };
struct EpiY {
    static constexpr bool PERM = true, AFTER_DRAIN = false;
    bf16* Y;
    __device__ __forceinline__ void operator()(const pg8::f32x4 (&acc)[2][2][4][2], const pg8::Unit& u, int wr, int wc, int fr, int fq) const {
        const int row0 = u.pm * 256 + wr * 64 + fr, colb = u.pn * 256 + wc * 32 + 8 * fq;
#pragma unroll
        for (int ai = 0; ai < 2; ++ai)
#pragma unroll
            for (int m = 0; m < 4; ++m) {
                const int row = row0 + ai * 128 + m * 16;
#pragma unroll
                for (int bj = 0; bj < 2; ++bj) {
                    const pg8::f32x4 a = acc[ai][bj][m][0], b = acc[ai][bj][m][1];
                    v4u w; w.x = pg8::cvt_pk_bf16(a[0], a[1]); w.y = pg8::cvt_pk_bf16(a[2], a[3]); w.z = pg8::cvt_pk_bf16(b[0], b[1]); w.w = pg8::cvt_pk_bf16(b[2], b[3]);
                    *(v4u*)(Y + (size_t)row * D + colb + bj * 128) = w;
                }
            }
    }
};

__device__ __forceinline__ void transpose_item(const float* W, const float* fold, int K, int N, bf16* WT, int k0, int n0, int drow0, LAS float* scr, int lane) {
    const int kr = lane >> 4, n4 = lane & 15;
    f32x4 v[16];
#pragma unroll
    for (int i = 0; i < 16; ++i) v[i] = *(const f32x4*)(W + (size_t)(k0 + 4 * i + kr) * N + n0 + 4 * n4);
#pragma unroll
    for (int i = 0; i < 16; ++i) { const int k = 4 * i + kr; *(LAS f32x4*)(scr + k * 64 + ((4 * n4) ^ (4 * ((k >> 3) & 7)))) = v[i]; }
    LDS_WAIT(); asm volatile("" ::: "memory");
    const int c = lane & 7, nn = lane >> 3;
    f32x4 f0 = (f32x4){1.f, 1.f, 1.f, 1.f}, f1 = f0;
    if (fold) { f0 = *(const f32x4*)(fold + k0 + 8 * c); f1 = *(const f32x4*)(fold + k0 + 8 * c + 4); }
#pragma unroll
    for (int i2 = 0; i2 < 8; ++i2) {
        const int n = 8 * i2 + nn; const LAS float* s = scr + (8 * c) * 64 + (n ^ (4 * c));
        v4u o; o.x = pk2(s[0 * 64] * f0[0], s[1 * 64] * f0[1]); o.y = pk2(s[2 * 64] * f0[2], s[3 * 64] * f0[3]); o.z = pk2(s[4 * 64] * f1[0], s[5 * 64] * f1[1]); o.w = pk2(s[6 * 64] * f1[2], s[7 * 64] * f1[3]);
        *(GAS v4u*)(WT + (size_t)(drow0 + n) * K + k0 + 8 * c) = o;
    }
    LDS_WAIT(); asm volatile("" ::: "memory");
}
__device__ __forceinline__ void prologue_phase(Ctx& C, const Args& A) {
    LAS float* scr = (LAS float*)(C.lds + C.wave * 16384);
    const int gw = C.bid * 8 + C.wave, NGW = C.G * 8;
    constexpr int I_IN = 16 * 56, I_OUT = 16 * 16, I_D1 = 16 * 44, I_D2 = 44 * 16, I_M1 = 16 * 56, I_M2 = 56 * 16;
    constexpr int N_IN = 4 * I_IN, N_OUT = 4 * I_OUT, N_D1 = 2 * I_D1, N_D2 = 2 * I_D2, N_M1 = 16 * I_M1, N_M2 = 16 * I_M2;
    constexpr int NITEMS = N_IN + N_OUT + 2 * N_D1 + N_D2 + 2 * N_M1 + N_M2;
    for (int it = gw; it < NITEMS; it += NGW) {
        int r = it;
        const float* W; const float* fold = nullptr; bf16* WT; int K, N, glu = -1, loc;
        if (r < N_IN) { const int l = r / I_IN; loc = r % I_IN; W = A.in[IN_WIN] + (size_t)l * D * WIN; fold = A.in[IN_NMIX] + l * D; WT = (bf16*)(C.ws + WS_WIN) + (size_t)l * WIN * D; K = D; N = WIN; }
        else if ((r -= N_IN) < N_OUT) { const int l = r / I_OUT; loc = r % I_OUT; W = A.in[IN_WOUT] + (size_t)l * D * D; WT = (bf16*)(C.ws + WS_WOUT) + (size_t)l * D * D; K = D; N = D; }
        else if ((r -= N_OUT) < N_D1) { const int i = r / I_D1; loc = r % I_D1; W = A.in[IN_DW1] + (size_t)i * D * FFD; fold = A.in[IN_NFFN] + (2 * i) * D; WT = (bf16*)(C.ws + WS_WD13) + (size_t)i * 2 * FFD * D; K = D; N = FFD; glu = 0; }
        else if ((r -= N_D1) < N_D1) { const int i = r / I_D1; loc = r % I_D1; W = A.in[IN_DW3] + (size_t)i * D * FFD; fold = A.in[IN_NFFN] + (2 * i) * D; WT = (bf16*)(C.ws + WS_WD13) + (size_t)i * 2 * FFD * D; K = D; N = FFD; glu = 1; }
        else if ((r -= N_D1) < N_D2) { const int i = r / I_D2; loc = r % I_D2; W = A.in[IN_DW2] + (size_t)i * FFD * D; WT = (bf16*)(C.ws + WS_WD2) + (size_t)i * D * FFD; K = FFD; N = D; }
        else if ((r -= N_D2) < N_M1) { const int ie = r / I_M1; loc = r % I_M1; W = A.in[IN_MW1] + (size_t)ie * D * FFE; fold = A.in[IN_NFFN] + (2 * (ie >> 3) + 1) * D; WT = (bf16*)(C.ws + WS_WM13) + (size_t)ie * 2 * FFE * D; K = D; N = FFE; glu = 0; }
        else if ((r -= N_M1) < N_M1) { const int ie = r / I_M1; loc = r % I_M1; W = A.in[IN_MW3] + (size_t)ie * D * FFE; fold = A.in[IN_NFFN] + (2 * (ie >> 3) + 1) * D; WT = (bf16*)(C.ws + WS_WM13) + (size_t)ie * 2 * FFE * D; K = D; N = FFE; glu = 1; }
        else { r -= N_M1; const int ie = r / I_M2; loc = r % I_M2; W = A.in[IN_MW2] + (size_t)ie * FFE * D; WT = (bf16*)(C.ws + WS_WM2) + (size_t)ie * D * FFE; K = FFE; N = D; }
        const int nblk = N / 64, kb = loc / nblk, nb = loc % nblk, k0 = 64 * kb, n0 = 64 * nb;
        const int drow0 = (glu < 0) ? n0 : ((n0 >> 7) * 256 + glu * 128 + (n0 & 127));
        transpose_item(W, fold, K, N, WT, k0, n0, drow0, scr, C.lane);
    }
    for (int row = gw; row < NTOK; row += NGW) {
        const int b = row / LT, t = row % LT;
        f32x4 v[4]; float s = 0.f;
#pragma unroll
        for (int j = 0; j < 4; ++j) {
            const int col = 4 * C.lane + 256 * j;
            if (t < FIRSTV) v[j] = (f32x4){0.f, 0.f, 0.f, 0.f};
            else if (t < LEAD) v[j] = *(const f32x4*)(A.in[IN_META] + (size_t)(t - FIRSTV) * D + col);
            else v[j] = *(const f32x4*)(A.in[IN_X] + ((size_t)b * SEQ + (t - LEAD)) * D + col);
            s += (v[j][0] * v[j][0] + v[j][1] * v[j][1]) + (v[j][2] * v[j][2] + v[j][3] * v[j][3]);
            v2u w; w.x = pk2(v[j][0], v[j][1]); w.y = pk2(v[j][2], v[j][3]);
            *(v2u*)(C.HB() + (size_t)row * D + col) = w;
        }
        s = wave_sum(s);
        if (C.lane < 16) C.SSQ()[(size_t)row * 16 + C.lane] = (C.lane == 0) ? s : 0.f;
    }
    if (C.bid == 0) {
        const int tid = C.tid;
        {
            const float* lg = A.in[IN_LBL];
            const float a0 = lg[tid], a1 = lg[512 + tid], a2 = lg[1024 + tid], a3 = lg[1536 + tid];
            const float mx = fmaxf(fmaxf(a0, a1), fmaxf(a2, a3));
            const float e0 = expf(a0 - mx), e1 = expf(a1 - mx), e2 = expf(a2 - mx), e3 = expf(a3 - mx);
            const float inv = 1.f / (((e0 + e1) + e2) + e3);
            const float p0 = e0 * inv, p1 = e1 * inv, p2 = e2 * inv, p3 = e3 * inv;
            const float c0 = p0, c1 = c0 + p1, c2 = c1 + p2, c3 = c2 + p3;
            C.LB()[tid] = 0.f;
            C.LB()[512 + tid] = fminf(fmaxf(c1 - c0, 0.f), 0.999f);
            C.LB()[1024 + tid] = fminf(fmaxf(c2 - c0, 0.f), 0.999f);
            C.LB()[1536 + tid] = fminf(fmaxf(c3 - c0, 0.f), 0.999f);
        }
        for (int i = tid; i < 4 * 132; i += 512) { const int h = i / 132, d = i % 132; C.BIAST()[i] = (d <= 128) ? A.in[IN_RELB][T5B[d] * 4 + h] : 0.f; }
        if (tid < 4) {
            const float* lv = A.in[IN_LAMBDA] + tid * 256;
            float s01 = 0.f, s23 = 0.f;
            for (int j = 0; j < 64; ++j) { s01 += lv[j] * lv[64 + j]; s23 += lv[128 + j] * lv[192 + j]; }
            const float li = 0.8f - 0.6f * expf(-0.3f * (float)tid);
            C.LAM()[tid * 2] = expf(s01) - expf(s23) + li; C.LAM()[tid * 2 + 1] = li;
        }
        if (tid < 512) { C.SUBLN()[tid] = A.in[IN_SUBLN][tid]; C.HGNW()[tid] = A.in[IN_HGNW][tid]; C.FNORM()[tid] = A.in[IN_FNORM][tid]; C.FNORM()[512 + tid] = A.in[IN_FNORM][512 + tid]; }
        for (int i = tid; i < 2 * 8 * 1024; i += 512) { const int li = i >> 13, e = (i >> 10) & 7, k = i & 1023; C.RF()[i] = A.in[IN_NFFN][(2 * li + 1) * D + k] * A.in[IN_ROUTER][(size_t)li * D * NE + k * NE + e]; }
    }
}

__device__ __forceinline__ void hgrn_naive_unit(Ctx& C, int l, int b, int h) {
    LAS float* qf = (LAS float*)C.lds;
    LAS float* kf = qf + 2048; LAS float* ff = kf + 2048; LAS float* vv = ff + 2048; LAS float* gg = vv + 2048;
    LAS float* opart = gg + 2048;
    const int tid = C.tid, dv = tid & 127, qd = tid >> 7;
    const int ltok = tid >> 5, c4 = (tid & 31) * 4;
    float S[32];
#pragma unroll
    for (int j = 0; j < 32; ++j) S[j] = 0.f;
    const float* nw = C.HGNW() + l * 128;
    for (int tb = 0; tb < LT / 16; ++tb) {
        const size_t row = (size_t)b * LT + tb * 16 + ltok;
        {
            const bf16* pp = C.PROJ() + row * WIN + h * 128 + c4;
            const v2u wq = *(const v2u*)pp, wk = *(const v2u*)(pp + 512), wv = *(const v2u*)(pp + 1024), wg = *(const v2u*)(pp + 1536);
            const f32x4 lf = *(const f32x4*)(C.LOGF() + row * 512 + h * 128 + c4);
            const int o = ltok * 128 + c4;
            qf[o] = bf_lo(wq.x); qf[o + 1] = bf_hi(wq.x); qf[o + 2] = bf_lo(wq.y); qf[o + 3] = bf_hi(wq.y);
            kf[o] = bf_lo(wk.x); kf[o + 1] = bf_hi(wk.x); kf[o + 2] = bf_lo(wk.y); kf[o + 3] = bf_hi(wk.y);
            vv[o] = bf_lo(wv.x); vv[o + 1] = bf_hi(wv.x); vv[o + 2] = bf_lo(wv.y); vv[o + 3] = bf_hi(wv.y);
            gg[o] = bf_lo(wg.x); gg[o + 1] = bf_hi(wg.x); gg[o + 2] = bf_lo(wg.y); gg[o + 3] = bf_hi(wg.y);
            f32x4 lp = (f32x4){0.f, 0.f, 0.f, 0.f};
            if (((tb * 16 + ltok) & 63) != 0) lp = *(const f32x4*)(C.LOGF() + (row - 1) * 512 + h * 128 + c4);
            ff[o] = expf(lf[0] - lp[0]); ff[o + 1] = expf(lf[1] - lp[1]); ff[o + 2] = expf(lf[2] - lp[2]); ff[o + 3] = expf(lf[3] - lp[3]);
        }
        __syncthreads();
        for (int tok = 0; tok < 16; ++tok) {
            const float v = vv[tok * 128 + dv];
            const LAS f32x4* fp = (const LAS f32x4*)(ff + tok * 128 + 32 * qd);
            const LAS f32x4* kp = (const LAS f32x4*)(kf + tok * 128 + 32 * qd);
            const LAS f32x4* qp = (const LAS f32x4*)(qf + tok * 128 + 32 * qd);
            float a = 0.f;
#pragma unroll
            for (int j = 0; j < 8; ++j) {
                const f32x4 f4 = fp[j], k4 = kp[j], q4 = qp[j];
#pragma unroll
                for (int i = 0; i < 4; ++i) { S[4 * j + i] = f4[i] * S[4 * j + i] + k4[i] * v; a += q4[i] * S[4 * j + i]; }
            }
            opart[(tok * 4 + qd) * 128 + dv] = a;
        }
        __syncthreads();
        {
            float o[4]; float ss = 0.f;
#pragma unroll
            for (int i = 0; i < 4; ++i) { o[i] = (opart[(ltok * 4 + 0) * 128 + c4 + i] + opart[(ltok * 4 + 1) * 128 + c4 + i]) + (opart[(ltok * 4 + 2) * 128 + c4 + i] + opart[(ltok * 4 + 3) * 128 + c4 + i]); ss += o[i] * o[i]; }
#pragma unroll
            for (int m = 1; m < 32; m <<= 1) ss += __shfl_xor(ss, m);
            const float rs = rsqrtf(ss * (1.0f / 128.0f) + EPS);
            const int oo = ltok * 128 + c4;
            v2u w; w.x = pk2(o[0] * rs * nw[c4] * gg[oo], o[1] * rs * nw[c4 + 1] * gg[oo + 1]); w.y = pk2(o[2] * rs * nw[c4 + 2] * gg[oo + 2], o[3] * rs * nw[c4 + 3] * gg[oo + 3]);
            *(v2u*)(C.MIX() + row * D + h * 128 + c4) = w;
        }
        __syncthreads();
    }
}
typedef float f32x16 __attribute__((ext_vector_type(16)));
typedef short bf16x8 __attribute__((ext_vector_type(8)));
typedef short s16x4 __attribute__((ext_vector_type(4)));
constexpr float LOG2E = 1.4426950408889634f;
constexpr int AT_K = 0, AT_V = 32768, AT_BIAS = 65536, AT_WSF = 66560, AT_STG = 69632, AT_XCH = 0;
__device__ __forceinline__ int crow(int r, int hi) { return (r & 3) + 8 * (r >> 2) + 4 * hi; }
__device__ __forceinline__ s16x4 vtr(const LAS unsigned char* p) { typedef short v4i16_t __attribute__((ext_vector_type(4))); return __builtin_bit_cast(s16x4, __builtin_amdgcn_ds_read_tr16_b64_v4i16((LAS v4i16_t*)p)); }
__device__ __forceinline__ bf16x8 pack8(const f32x16& p, int b0) {
    v4u w; w.x = pg8::cvt_pk_bf16(p[b0 + 0], p[b0 + 1]); w.y = pg8::cvt_pk_bf16(p[b0 + 2], p[b0 + 3]); w.z = pg8::cvt_pk_bf16(p[b0 + 4], p[b0 + 5]); w.w = pg8::cvt_pk_bf16(p[b0 + 6], p[b0 + 7]);
    return __builtin_bit_cast(bf16x8, w);
}
__device__ __forceinline__ void attn_unit(Ctx& C, int l, int b, int h, int qi) {
    LAS unsigned char* lds = C.lds;
    const int tid = C.tid, lane = C.lane, wave = C.wave, rg = wave >> 1, c = wave & 1, r32 = lane & 31, hi = lane >> 5;
    const size_t rowbase = (size_t)b * LT;
    const bf16* PJ = C.PROJ();
    LAS float* biasl = (LAS float*)(lds + AT_BIAS);
    LAS float* wsf = (LAS float*)(lds + AT_WSF) + wave * 64;
    if (tid < 132) biasl[tid] = C.BIAST()[h * 132 + tid] * LOG2E;
    const float lam = C.LAM()[l * 2], lam_init = C.LAM()[l * 2 + 1];
    const int qw0 = 128 * qi + 32 * rg, tq = qw0 + r32;
    bf16x8 qr[4];
    { const bf16* qp = PJ + (rowbase + tq) * WIN + 2048 + h * 128 + c * 64 + 8 * hi;
#pragma unroll
      for (int ks = 0; ks < 4; ++ks) qr[ks] = *(const bf16x8*)(qp + 16 * ks); }
    const int kkey = tid >> 3, kch = tid & 7;
    const bf16* ksrc = PJ + (rowbase + kkey) * WIN + 2560 + h * 128 + kch * 8;
    const int kdst = kkey * 128 + ((kch ^ ((kkey >> 1) & 7)) * 16);
    const int vkey0 = tid >> 4, vch = tid & 15;
    const bf16* vsrc = PJ + (rowbase + vkey0) * WIN + 3072 + h * 128 + vch * 8;
    const int vdst0 = ((vkey0 >> 3) * 4 + (vch >> 2)) * 512 + (vkey0 & 7) * 64 + (vch & 3) * 16;
    v4u kreg0, kreg1, vreg0, vreg1;
#define AT_LOAD(kt) do { const size_t o_ = (size_t)(kt) * 64 * WIN; kreg0 = *(const v4u*)(ksrc + o_); kreg1 = *(const v4u*)(ksrc + o_ + 64); vreg0 = *(const v4u*)(vsrc + o_); vreg1 = *(const v4u*)(vsrc + o_ + (size_t)32 * WIN); } while (0)
#define AT_STORE(buf) do { *(LAS v4u*)(lds + AT_K + (buf) * 16384 + kdst) = kreg0; *(LAS v4u*)(lds + AT_K + (buf) * 16384 + 8192 + kdst) = kreg1; \
        *(LAS v4u*)(lds + AT_V + (buf) * 16384 + vdst0) = vreg0; *(LAS v4u*)(lds + AT_V + (buf) * 16384 + 8192 + vdst0) = vreg1; } while (0)
    const int nt = 2 * qi + 1;
    AT_LOAD(1); AT_STORE(0);
    __syncthreads();
    f32x16 o[4];
#pragma unroll
    for (int d = 0; d < 4; ++d)
#pragma unroll
        for (int r = 0; r < 16; ++r) o[d][r] = 0.f;
    float mref = -1e30f, lsum = 0.f;
    const int kswz = (r32 >> 1) & 7;
    const int vb = (4 * hi + ((lane & 15) >> 2)) * 64 + ((lane >> 4) & 1) * 32 + (lane & 3) * 8;
    const float b128 = biasl[128];
    for (int it = 0; it < nt; ++it) {
        const int kt = it + 1, buf = it & 1, k0 = 64 * kt;
        if (it + 1 < nt) AT_LOAD(kt + 1);
        if (k0 <= qw0 + 31) {
            const bool near = (k0 + 63 > qw0 - 128) || (kt == 1);
            f32x16 p0, p1;
            { const float ini = near ? 0.f : b128;
#pragma unroll
              for (int r = 0; r < 16; ++r) { p0[r] = ini; p1[r] = ini; } }
            const LAS unsigned char* kb = lds + AT_K + buf * 16384 + c * 8192 + r32 * 128;
#pragma unroll
            for (int ks = 0; ks < 4; ++ks) {
                const int off = ((2 * ks + hi) ^ kswz) * 16;
                const bf16x8 k0f = *(const LAS bf16x8*)(kb + off), k1f = *(const LAS bf16x8*)(kb + 4096 + off);
                p0 = __builtin_amdgcn_mfma_f32_32x32x16_bf16(k0f, qr[ks], p0, 0, 0, 0);
                p1 = __builtin_amdgcn_mfma_f32_32x32x16_bf16(k1f, qr[ks], p1, 0, 0, 0);
            }
            if (near) {
#pragma unroll
                for (int r = 0; r < 16; ++r) {
                    const int tk = k0 + crow(r, hi), d0 = tq - tk, d1 = d0 - 32;
                    const float b0 = biasl[d0 < 0 ? 0 : (d0 > 128 ? 128 : d0)], b1 = biasl[d1 < 0 ? 0 : (d1 > 128 ? 128 : d1)];
                    p0[r] = (d0 < 0 || tk < FIRSTV) ? -INFINITY : p0[r] + b0;
                    p1[r] = (d1 < 0 || tk + 32 < FIRSTV) ? -INFINITY : p1[r] + b1;
                }
            }
            float mx = fmaxf(p0[0], p1[0]);
#pragma unroll
            for (int r = 1; r < 16; ++r) mx = fmaxf(fmaxf(mx, p0[r]), p1[r]);
            mx = fmaxf(mx, __shfl_xor(mx, 32));
            if (__any(mx > mref + 8.0f)) {
                const float mnew = fmaxf(mref, mx), f = __builtin_amdgcn_exp2f(mref - mnew);
                lsum *= f; mref = mnew;
                if (hi == 0) wsf[r32] = f;
                LDS_WAIT(); asm volatile("" ::: "memory");
#pragma unroll
                for (int g = 0; g < 4; ++g) { const f32x4 fv = *(const LAS f32x4*)(wsf + 8 * g + 4 * hi);
#pragma unroll
                    for (int d = 0; d < 4; ++d) { o[d][4 * g + 0] *= fv[0]; o[d][4 * g + 1] *= fv[1]; o[d][4 * g + 2] *= fv[2]; o[d][4 * g + 3] *= fv[3]; } }
            }
            float ps = 0.f;
#pragma unroll
            for (int r = 0; r < 16; ++r) { p0[r] = __builtin_amdgcn_exp2f(p0[r] - mref); p1[r] = __builtin_amdgcn_exp2f(p1[r] - mref); ps += p0[r] + p1[r]; }
            lsum += ps;
            const bf16x8 pa0 = pack8(p0, 0), pa1 = pack8(p0, 8), pa2 = pack8(p1, 0), pa3 = pack8(p1, 8);
            const LAS unsigned char* vp = lds + AT_V + buf * 16384 + vb;
#pragma unroll
            for (int d = 0; d < 4; ++d) {
#define AT_VF(s) ({ const s16x4 lo_ = vtr(vp + (2 * (s)) * 2048 + d * 512), hi_ = vtr(vp + (2 * (s) + 1) * 2048 + d * 512); (bf16x8){lo_[0], lo_[1], lo_[2], lo_[3], hi_[0], hi_[1], hi_[2], hi_[3]}; })
                o[d] = __builtin_amdgcn_mfma_f32_32x32x16_bf16(pa0, AT_VF(0), o[d], 0, 0, 0);
                o[d] = __builtin_amdgcn_mfma_f32_32x32x16_bf16(pa1, AT_VF(1), o[d], 0, 0, 0);
                o[d] = __builtin_amdgcn_mfma_f32_32x32x16_bf16(pa2, AT_VF(2), o[d], 0, 0, 0);
                o[d] = __builtin_amdgcn_mfma_f32_32x32x16_bf16(pa3, AT_VF(3), o[d], 0, 0, 0);
#undef AT_VF
            }
        }
        if (it + 1 < nt) AT_STORE(buf ^ 1);
        __syncthreads();
    }
#undef AT_LOAD
#undef AT_STORE
    lsum += __shfl_xor(lsum, 32);
    { const float inv = lsum > 0.f ? 1.f / lsum : 0.f;
      if (hi == 0) wsf[r32] = inv;
      LDS_WAIT(); asm volatile("" ::: "memory");
#pragma unroll
      for (int g = 0; g < 4; ++g) { const f32x4 fv = *(const LAS f32x4*)(wsf + 8 * g + 4 * hi);
#pragma unroll
          for (int d = 0; d < 4; ++d) { o[d][4 * g + 0] *= fv[0]; o[d][4 * g + 1] *= fv[1]; o[d][4 * g + 2] *= fv[2]; o[d][4 * g + 3] *= fv[3]; } } }
    LAS float* xch = (LAS float*)(lds + AT_XCH) + rg * 4096;
    if (c == 1) {
#pragma unroll
        for (int d = 0; d < 4; ++d)
#pragma unroll
            for (int r = 0; r < 16; ++r) xch[(d * 16 + r) * 64 + lane] = o[d][r];
    }
    __syncthreads();
    if (c == 0) {
        float ss[16];
#pragma unroll
        for (int r = 0; r < 16; ++r) ss[r] = 0.f;
#pragma unroll
        for (int d = 0; d < 4; ++d)
#pragma unroll
            for (int r = 0; r < 16; ++r) { const float a = o[d][r] - lam * xch[(d * 16 + r) * 64 + lane]; o[d][r] = a; ss[r] += a * a; }
#pragma unroll
        for (int r = 0; r < 16; ++r) {
            float s = ss[r];
            s += __shfl_xor(s, 1); s += __shfl_xor(s, 2); s += __shfl_xor(s, 4); s += __shfl_xor(s, 8); s += __shfl_xor(s, 16);
            ss[r] = rsqrtf(s * (1.0f / 128.0f) + EPS) * (1.f - lam_init);
        }
        LAS bf16* stg = (LAS bf16*)(lds + AT_STG) + rg * 4096;
        const float* sw = C.SUBLN() + l * 128 + r32;
#pragma unroll
        for (int d = 0; d < 4; ++d) { const float w = sw[32 * d];
#pragma unroll
            for (int r = 0; r < 16; ++r) stg[crow(r, hi) * 128 + 32 * d + r32] = (bf16)f2bf(o[d][r] * ss[r] * w); }
        LDS_WAIT(); asm volatile("" ::: "memory");
        bf16* op = C.MIX() + (rowbase + qw0) * D + 512 + h * 128;
#pragma unroll
        for (int i = 0; i < 8; ++i) { const int ch = i * 64 + lane, row = ch >> 4, cc = ch & 15; *(v4u*)(op + (size_t)row * D + cc * 8) = *(const LAS v4u*)(stg + row * 128 + cc * 8); }
    }
    __syncthreads();
}
constexpr int HG_QM = 0, HG_KR = 16384, HG_KT = 32768, HG_V = 49152, HG_ST = 65536, HG_XT = 98304, HG_OS = 106496, HG_SQ = 122880, HG_VEC = 123904;
__device__ __forceinline__ bf16x8 tr_frag(const LAS unsigned char* p) { const s16x4 lo = vtr(p), hi4 = vtr(p + 256); return (bf16x8){lo[0], lo[1], lo[2], lo[3], hi4[0], hi4[1], hi4[2], hi4[3]}; }
__device__ __forceinline__ void hgrn_unit(Ctx& C, int l, int b, int h) {
    LAS unsigned char* lds = C.lds;
    const int tid = C.tid, lane = C.lane, wave = C.wave, r32 = lane & 31, hi = lane >> 5;
    const size_t rowbase = (size_t)b * LT;
    const bf16* PJ = C.PROJ() + h * 128; const float* BL = C.LOGF() + h * 128;
    const int c4 = tid & 31, tg = tid >> 5;
    const int dkb = wave >> 1, dvb0 = 2 * (wave & 1);
    const int th = wave >> 2, dvb = wave & 3;
    const int vbq = ((lane & 15) >> 2) * 64 + ((lane >> 4) & 1) * 32 + (lane & 3) * 8;
    LAS float* vec = (LAS float*)(lds + HG_VEC);
    LAS float* sq = (LAS float*)(lds + HG_SQ);
    f32x16 st[2];
#pragma unroll
    for (int j = 0; j < 2; ++j)
#pragma unroll
        for (int r = 0; r < 16; ++r) st[j][r] = 0.f;
    v2u pq[4], pk[4], pv[4]; f32x4 pb[4], pbm;
#define HG_LOAD(ch) do { const size_t r0_ = rowbase + (size_t)(ch) * 64; \
        _Pragma("unroll") for (int i = 0; i < 4; ++i) { const size_t row_ = r0_ + 4 * tg + i; const bf16* p_ = PJ + row_ * WIN + 4 * c4; \
            pq[i] = *(const v2u*)p_; pk[i] = *(const v2u*)(p_ + 512); pv[i] = *(const v2u*)(p_ + 1024); pb[i] = *(const f32x4*)(BL + row_ * 512 + 4 * c4); } \
        pbm = *(const f32x4*)(BL + (r0_ + 31) * 512 + 4 * c4); } while (0)
    HG_LOAD(0);
    const float* nw = C.HGNW() + l * 128;
    for (int ch = 0; ch < LT / 64; ++ch) {
#pragma unroll
        for (int i = 0; i < 4; ++i) {
            const int t = 4 * tg + i;
            float qm[4], km[4];
            const float qv[4] = {bf_lo(pq[i].x), bf_hi(pq[i].x), bf_lo(pq[i].y), bf_hi(pq[i].y)};
            const float kv[4] = {bf_lo(pk[i].x), bf_hi(pk[i].x), bf_lo(pk[i].y), bf_hi(pk[i].y)};
#pragma unroll
            for (int j = 0; j < 4; ++j) { const float x = fminf(fmaxf(pb[i][j] - pbm[j], -80.f), 80.f); qm[j] = qv[j] * __expf(x); km[j] = kv[j] * __expf(-x); }
            const int rsw = (((c4 >> 1) ^ (t & 15)) * 16) + (c4 & 1) * 8;
            *(LAS v2u*)(lds + HG_QM + t * 256 + rsw) = pack4(qm[0], qm[1], qm[2], qm[3]);
            const v2u kmw = pack4(km[0], km[1], km[2], km[3]);
            *(LAS v2u*)(lds + HG_KR + t * 256 + rsw) = kmw;
            const int tso = ((t >> 3) * 4 + (c4 >> 3)) * 512 + (t & 7) * 64 + (c4 & 7) * 8;
            *(LAS v2u*)(lds + HG_KT + tso) = kmw;
            *(LAS v2u*)(lds + HG_V + tso) = pv[i];
            if (t == 31) *(LAS f32x4*)(vec + 4 * c4) = pb[i];
            if (t == 63) *(LAS f32x4*)(vec + 128 + 4 * c4) = pb[i];
        }
        __syncthreads();
        if (ch + 1 < LT / 64) HG_LOAD(ch + 1);
        const v4u g0 = *(const v4u*)(PJ + (rowbase + (size_t)ch * 64 + (tid >> 3)) * WIN + 1536 + 16 * (tid & 7)), g1 = *(const v4u*)(PJ + (rowbase + (size_t)ch * 64 + (tid >> 3)) * WIN + 1536 + 16 * (tid & 7) + 8);
#pragma unroll
        for (int g = 0; g < 4; ++g) {
            const f32x4 bm = *(const LAS f32x4*)(vec + 32 * dkb + 8 * g + 4 * hi);
            const float e0 = __expf(bm[0]), e1 = __expf(bm[1]), e2 = __expf(bm[2]), e3 = __expf(bm[3]);
#pragma unroll
            for (int j = 0; j < 2; ++j) {
                st[j][4 * g + 0] *= e0; st[j][4 * g + 1] *= e1; st[j][4 * g + 2] *= e2; st[j][4 * g + 3] *= e3;
                const int dv = 32 * (dvb0 + j) + r32;
                *(LAS v2u*)(lds + HG_ST + dv * 256 + (((4 * dkb + g) ^ (dv & 15)) * 16) + hi * 8) = pack4(st[j][4 * g + 0], st[j][4 * g + 1], st[j][4 * g + 2], st[j][4 * g + 3]);
            }
        }
        if (wave < 3) {
            const int sb = (wave == 2) ? 1 : 0, tb = (wave == 0) ? 0 : 1;
            const int s = 32 * sb + r32, t = 32 * tb + r32;
            f32x16 x;
#pragma unroll
            for (int r = 0; r < 16; ++r) x[r] = 0.f;
#pragma unroll
            for (int ks = 0; ks < 8; ++ks) {
                const bf16x8 a = *(const LAS bf16x8*)(lds + HG_KR + s * 256 + (((2 * ks + hi) ^ (s & 15)) * 16));
                const bf16x8 bq = *(const LAS bf16x8*)(lds + HG_QM + t * 256 + (((2 * ks + hi) ^ (t & 15)) * 16));
                x = __builtin_amdgcn_mfma_f32_32x32x16_bf16(a, bq, x, 0, 0, 0);
            }
            if (sb == tb) {
#pragma unroll
                for (int r = 0; r < 16; ++r) x[r] = (crow(r, hi) > r32) ? 0.f : x[r];
            }
#pragma unroll
            for (int g = 0; g < 4; ++g)
                *(LAS v2u*)(lds + HG_XT + t * 128 + (((4 * sb + g) ^ ((t >> 1) & 7)) * 16) + hi * 8) = pack4(x[4 * g + 0], x[4 * g + 1], x[4 * g + 2], x[4 * g + 3]);
        }
#pragma unroll
        for (int ks = 0; ks < 4; ++ks) {
            const bf16x8 a = tr_frag(lds + HG_KT + ((2 * ks + hi) * 4 + dkb) * 512 + vbq);
#pragma unroll
            for (int j = 0; j < 2; ++j) {
                const bf16x8 bv = tr_frag(lds + HG_V + ((2 * ks + hi) * 4 + dvb0 + j) * 512 + vbq);
                st[j] = __builtin_amdgcn_mfma_f32_32x32x16_bf16(a, bv, st[j], 0, 0, 0);
            }
        }
#pragma unroll
        for (int g = 0; g < 4; ++g) {
            const f32x4 bm = *(const LAS f32x4*)(vec + 32 * dkb + 8 * g + 4 * hi), be = *(const LAS f32x4*)(vec + 128 + 32 * dkb + 8 * g + 4 * hi);
            const float e0 = __expf(be[0] - bm[0]), e1 = __expf(be[1] - bm[1]), e2 = __expf(be[2] - bm[2]), e3 = __expf(be[3] - bm[3]);
#pragma unroll
            for (int j = 0; j < 2; ++j) { st[j][4 * g + 0] *= e0; st[j][4 * g + 1] *= e1; st[j][4 * g + 2] *= e2; st[j][4 * g + 3] *= e3; }
        }
        __syncthreads();
        {
            const int dv = 32 * dvb + r32, t = 32 * th + r32;
            f32x16 o;
#pragma unroll
            for (int r = 0; r < 16; ++r) o[r] = 0.f;
#pragma unroll
            for (int ks = 0; ks < 8; ++ks) {
                const bf16x8 a = *(const LAS bf16x8*)(lds + HG_ST + dv * 256 + (((2 * ks + hi) ^ (dv & 15)) * 16));
                const bf16x8 bq = *(const LAS bf16x8*)(lds + HG_QM + t * 256 + (((2 * ks + hi) ^ (t & 15)) * 16));
                o = __builtin_amdgcn_mfma_f32_32x32x16_bf16(a, bq, o, 0, 0, 0);
            }
#pragma unroll
            for (int sb = 0; sb < 2; ++sb) {
                if (sb <= th) {
#pragma unroll
                    for (int k2 = 0; k2 < 2; ++k2) {
                        const int kg = 4 * sb + 2 * k2 + hi;
                        const bf16x8 a = tr_frag(lds + HG_V + (kg * 4 + dvb) * 512 + vbq);
                        const bf16x8 bx = *(const LAS bf16x8*)(lds + HG_XT + t * 128 + ((kg ^ ((t >> 1) & 7)) * 16));
                        o = __builtin_amdgcn_mfma_f32_32x32x16_bf16(a, bx, o, 0, 0, 0);
                    }
                }
            }
            float s2 = 0.f;
#pragma unroll
            for (int r = 0; r < 16; ++r) s2 += o[r] * o[r];
            s2 += __shfl_xor(s2, 32);
            if (hi == 0) sq[t * 4 + dvb] = s2;
#pragma unroll
            for (int g = 0; g < 4; ++g)
                *(LAS v2u*)(lds + HG_OS + t * 256 + (((4 * dvb + g) ^ (t & 15)) * 16) + hi * 8) = pack4(o[4 * g + 0], o[4 * g + 1], o[4 * g + 2], o[4 * g + 3]);
        }
        __syncthreads();
        {
            const int t = tid >> 3, seg = tid & 7;
            const size_t row = rowbase + (size_t)ch * 64 + t;
            const f32x4 sv = *(const LAS f32x4*)(sq + t * 4);
            const float rs = rsqrtf(((sv[0] + sv[1]) + (sv[2] + sv[3])) * (1.0f / 128.0f) + EPS);
            const v4u o0 = *(const LAS v4u*)(lds + HG_OS + t * 256 + (((2 * seg) ^ (t & 15)) * 16)), o1 = *(const LAS v4u*)(lds + HG_OS + t * 256 + (((2 * seg + 1) ^ (t & 15)) * 16));
            const f32x4 w0 = *(const f32x4*)(nw + 16 * seg), w1 = *(const f32x4*)(nw + 16 * seg + 4), w2 = *(const f32x4*)(nw + 16 * seg + 8), w3 = *(const f32x4*)(nw + 16 * seg + 12);
            v4u r0, r1;
            r0.x = pk2(bf_lo(o0.x) * rs * w0[0] * bf_lo(g0.x), bf_hi(o0.x) * rs * w0[1] * bf_hi(g0.x)); r0.y = pk2(bf_lo(o0.y) * rs * w0[2] * bf_lo(g0.y), bf_hi(o0.y) * rs * w0[3] * bf_hi(g0.y));
            r0.z = pk2(bf_lo(o0.z) * rs * w1[0] * bf_lo(g0.z), bf_hi(o0.z) * rs * w1[1] * bf_hi(g0.z)); r0.w = pk2(bf_lo(o0.w) * rs * w1[2] * bf_lo(g0.w), bf_hi(o0.w) * rs * w1[3] * bf_hi(g0.w));
            r1.x = pk2(bf_lo(o1.x) * rs * w2[0] * bf_lo(g1.x), bf_hi(o1.x) * rs * w2[1] * bf_hi(g1.x)); r1.y = pk2(bf_lo(o1.y) * rs * w2[2] * bf_lo(g1.y), bf_hi(o1.y) * rs * w2[3] * bf_hi(g1.y));
            r1.z = pk2(bf_lo(o1.z) * rs * w3[0] * bf_lo(g1.z), bf_hi(o1.z) * rs * w3[1] * bf_hi(g1.z)); r1.w = pk2(bf_lo(o1.w) * rs * w3[2] * bf_lo(g1.w), bf_hi(o1.w) * rs * w3[3] * bf_hi(g1.w));
            bf16* op = C.MIX() + row * D + h * 128 + 16 * seg;
            *(v4u*)op = r0; *(v4u*)(op + 8) = r1;
        }
    }
#undef HG_LOAD
    __syncthreads();
}
__device__ __forceinline__ void mixer_phase(Ctx& C, int l) {
    const int NA = C.G - 32;
    if (C.bid < NA) {
        for (int rep = 0; rep < REP_ATT; ++rep)
        for (int k = 0; k * NA < 17 * 32; ++k) {
            const int u = k * NA + ((k & 1) ? (NA - 1 - C.bid) : C.bid);
            if (u < 17 * 32) { const int qi = 16 - u / 32, bh = u % 32; attn_unit(C, l, bh >> 2, bh & 3, qi); }
        }
    } else {
        for (int rep = 0; rep < REP_HG; ++rep) { const int u = C.bid - NA; hgrn_unit(C, l, u >> 2, u & 3); }
    }
}


template <class F> __device__ __forceinline__ void mini_tile(LAS unsigned char* lds, const bf16* A, const bf16* Bt, int K, int r0, int c0, int lane, int wave, const F& epi) {
    const int fr = lane & 15, fq = lane >> 4;
    const int srow = 8 * wave + (lane >> 3), lch = (lane & 7) ^ ((srow >> 1) & 7);
    const bf16* asrc = A + (size_t)(r0 + srow) * K + 8 * lch;
    const bf16* bsrc = Bt + (size_t)(c0 + srow) * K + 8 * lch;
    const int nk = K / 64;
    LAS unsigned char* wbase = lds + wave * 1024;
#define RT_ISSUE(s) do { const int sl_ = ((s) & 7) * 16384; __builtin_amdgcn_global_load_lds((const unsigned*)(asrc + (size_t)(s) * 64), (LAS unsigned*)(wbase + sl_), 16, 0, 0); \
        __builtin_amdgcn_global_load_lds((const unsigned*)(bsrc + (size_t)(s) * 64), (LAS unsigned*)(wbase + sl_ + 8192), 16, 0, 0); } while (0)
#pragma unroll
    for (int s = 0; s < 7; ++s) RT_ISSUE(s);
    f32x4 acc0 = (f32x4){0.f, 0.f, 0.f, 0.f}, acc1 = acc0;
    const int arow = 32 * (wave >> 2) + fr, brow = 16 * (wave & 3) + fr;
    const int asw = (arow >> 1) & 7, bsw = (brow >> 1) & 7;
    for (int s = 0; s < nk; ++s) {
        if (s + 6 < nk) asm volatile("s_waitcnt vmcnt(12)" ::: "memory"); else asm volatile("s_waitcnt vmcnt(0)" ::: "memory");
        __builtin_amdgcn_s_barrier(); asm volatile("" ::: "memory");
        if (s + 7 < nk) RT_ISSUE(s + 7);
        const LAS unsigned char* sa = lds + (s & 7) * 16384; const LAS unsigned char* sb = sa + 8192;
#pragma unroll
        for (int j = 0; j < 2; ++j) {
            const bf16x8 a0 = *(const LAS bf16x8*)(sa + arow * 128 + (((4 * j + fq) ^ asw) * 16)), a1 = *(const LAS bf16x8*)(sa + (arow + 16) * 128 + (((4 * j + fq) ^ asw) * 16));
            const bf16x8 b = *(const LAS bf16x8*)(sb + brow * 128 + (((4 * j + fq) ^ bsw) * 16));
            acc0 = __builtin_amdgcn_mfma_f32_16x16x32_bf16(b, a0, acc0, 0, 0, 0); acc1 = __builtin_amdgcn_mfma_f32_16x16x32_bf16(b, a1, acc1, 0, 0, 0);
        }
    }
#undef RT_ISSUE
    const int row = r0 + 32 * (wave >> 2) + fr, col = c0 + 16 * (wave & 3) + 4 * fq;
    epi(acc0, acc1, row, col);
    asm volatile("s_waitcnt lgkmcnt(0)" ::: "memory"); __builtin_amdgcn_s_barrier(); asm volatile("" ::: "memory");
}
__device__ __forceinline__ void mini_resid_phase(Ctx& C, const bf16* A, const bf16* Bt, int K, int row_lo) {
    LAS float* red = (LAS float*)(C.lds + RING_BYTES + 2048);
    const int nrb = (NTOK - row_lo) / 64, ntile = nrb * 16;
    bf16* HB = C.HB(); float* SSQ = C.SSQ();
    for (int mt = C.bid; mt < ntile; mt += C.G) {
        const int rb = mt >> 4, cb = mt & 15, r0 = row_lo + 64 * rb, c0 = 64 * cb;
        const int lane = C.lane, wave = C.wave;
        mini_tile(C.lds, A, Bt, K, r0, c0, lane, wave, [&](const f32x4& x0, const f32x4& x1, int row, int col) {
            bf16* hp = HB + (size_t)row * D + col;
            const f32x4 h0 = bf4(*(const v2u*)hp) + x0, h1 = bf4(*(const v2u*)(hp + (size_t)16 * D)) + x1;
            *(v2u*)hp = pack4(h0[0], h0[1], h0[2], h0[3]); *(v2u*)(hp + (size_t)16 * D) = pack4(h1[0], h1[1], h1[2], h1[3]);
            float s0 = (h0[0] * h0[0] + h0[1] * h0[1]) + (h0[2] * h0[2] + h0[3] * h0[3]), s1 = (h1[0] * h1[0] + h1[1] * h1[1]) + (h1[2] * h1[2] + h1[3] * h1[3]);
            s0 += __shfl_xor(s0, 16); s0 += __shfl_xor(s0, 32); s1 += __shfl_xor(s1, 16); s1 += __shfl_xor(s1, 32);
            if ((lane >> 4) == 0) { red[(row - r0) * 4 + (wave & 3)] = s0; red[(row - r0 + 16) * 4 + (wave & 3)] = s1; }
        });
        __syncthreads();
        if (C.tid < 64) { const f32x4 p = *(const LAS f32x4*)(red + C.tid * 4); SSQ[(size_t)(r0 + C.tid) * 16 + cb] = (p[0] + p[1]) + (p[2] + p[3]); }
        __syncthreads();
    }
}
__device__ __forceinline__ void mini_y_phase(Ctx& C, const bf16* A, const bf16* Bt, size_t bstride_el, int K, int plim, int pend, int p1, int p2, int p3, int p4, int p5, int p6, int p7) {
    const int ntile = (pend - plim) * 4 * 16;
    bf16* Y = C.Y();
    for (int mt = C.bid; mt < ntile; mt += C.G) {
        const int rb = mt >> 4, cb = mt & 15, pm = plim + (rb >> 2), r0 = plim * 256 + 64 * rb, c0 = 64 * cb;
        const int e = (pm >= p1) + (pm >= p2) + (pm >= p3) + (pm >= p4) + (pm >= p5) + (pm >= p6) + (pm >= p7);
        mini_tile(C.lds, A, Bt + (size_t)e * bstride_el, K, r0, c0, C.lane, C.wave, [&](const f32x4& x0, const f32x4& x1, int row, int col) {
            *(v2u*)(Y + (size_t)row * D + col) = pack4(x0[0], x0[1], x0[2], x0[3]); *(v2u*)(Y + (size_t)(row + 16) * D + col) = pack4(x1[0], x1[1], x1[2], x1[3]);
        });
    }
}

constexpr int RMAX = 128;
__device__ __forceinline__ void route_phase(Ctx& C, int li) {
    LAS float* rf = (LAS float*)C.lds;
    LAS int* lcnt = (LAS int*)(C.lds + 32768);
    LAS int* lbase = lcnt + 8;
    LAS int* ti = lbase + 8;
    LAS float* tf = (LAS float*)(ti + RMAX * 4);
    const int tid = C.tid, lane = C.lane;
    for (int i = tid; i < 8192; i += 512) rf[i] = C.RF()[li * 8192 + i];
    if (tid < 8) lcnt[tid] = 0;
    __syncthreads();
    const int nrows = (NTOK - C.bid + C.G - 1) / C.G;
    for (int k = C.wave; k < nrows; k += 8) {
        const size_t row = (size_t)C.bid + (size_t)k * C.G;
        if ((int)(row % LT) < FIRSTV) { if (lane == 0) ti[k * 4] = -1; continue; }
        f32x4 v[4]; float ss = 0.f;
#pragma unroll
        for (int j = 0; j < 4; ++j) { v[j] = bf4(*(const v2u*)(C.HB() + row * D + 4 * lane + 256 * j)); ss += (v[j][0] * v[j][0] + v[j][1] * v[j][1]) + (v[j][2] * v[j][2] + v[j][3] * v[j][3]); }
        ss = wave_sum(ss);
        const float rstd = rsqrtf(ss * (1.0f / 1024.0f) + EPS);
        float lg[8];
#pragma unroll
        for (int e = 0; e < 8; ++e) {
            float p = 0.f;
#pragma unroll
            for (int j = 0; j < 4; ++j) { const f32x4 w = *(const LAS f32x4*)(rf + e * 1024 + 4 * lane + 256 * j); p += (v[j][0] * w[0] + v[j][1] * w[1]) + (v[j][2] * w[2] + v[j][3] * w[3]); }
            lg[e] = wave_sum(p) * rstd;
        }
        int e1 = 0; float l1 = lg[0];
#pragma unroll
        for (int e = 1; e < 8; ++e) if (lg[e] > l1) { l1 = lg[e]; e1 = e; }
        int e2 = -1; float l2 = -3.0e38f;
#pragma unroll
        for (int e = 0; e < 8; ++e) if (e != e1 && lg[e] > l2) { l2 = lg[e]; e2 = e; }
        const float g1 = 1.f / (1.f + expf(l2 - l1)), g2 = 1.f - g1;
        if (lane == 0) {
            const int lr1 = __hip_atomic_fetch_add(&lcnt[e1], 1, __ATOMIC_RELAXED, __HIP_MEMORY_SCOPE_WORKGROUP), lr2 = __hip_atomic_fetch_add(&lcnt[e2], 1, __ATOMIC_RELAXED, __HIP_MEMORY_SCOPE_WORKGROUP);
            ti[k * 4 + 0] = e1; ti[k * 4 + 1] = e2; ti[k * 4 + 2] = lr1; ti[k * 4 + 3] = lr2;
            tf[k * 4 + 0] = g1; tf[k * 4 + 1] = g2; tf[k * 4 + 2] = rstd;
        }
    }
    __syncthreads();
    if (tid < 8) lbase[tid] = (int)__hip_atomic_fetch_add(C.ctl() + CW_CNT + (li * 8 + tid) * 64, (unsigned)lcnt[tid], RLX_AGENT);
    __syncthreads();
    for (int k = tid; k < nrows; k += 512) {
        const int row = C.bid + k * C.G;
        if (ti[k * 4] < 0) continue;
        const int e1 = ti[k * 4], e2 = ti[k * 4 + 1], r1 = lbase[e1] + ti[k * 4 + 2], r2 = lbase[e2] + ti[k * 4 + 3];
        C.LIST()[(size_t)e1 * NTOK + r1] = row; C.LIST()[(size_t)e2 * NTOK + r2] = row;
        unsigned* inf = C.TINFO() + (size_t)row * 8;
        inf[0] = (unsigned)e1; inf[1] = (unsigned)e2; inf[2] = (unsigned)r1; inf[3] = (unsigned)r2; inf[4] = __builtin_bit_cast(unsigned, tf[k * 4]); inf[5] = __builtin_bit_cast(unsigned, tf[k * 4 + 1]);
        C.RSTD()[row] = tf[k * 4 + 2];
    }
    __syncthreads();
}
__device__ __forceinline__ void load_panels(Ctx& C, int li, LAS int* pst) {
    __syncthreads();
    if (C.tid == 0) { int acc = 0;
        for (int e = 0; e < 8; ++e) { const int c = (int)__hip_atomic_load(C.ctl() + CW_CNT + (li * 8 + e) * 64, RLX_AGENT); pst[e] = acc; pst[16 + e] = c; acc += (c + 255) >> 8; }
        pst[8] = acc; }
    __syncthreads();
}
__device__ __forceinline__ void gather_phase(Ctx& C, int li) {
    LAS int* pst = (LAS int*)C.lds;
    load_panels(C, li, pst);
    const int gw = C.bid * 8 + C.wave, NGW = C.G * 8, lane = C.lane;
    const int nslot = pst[8] * 256;
    for (int s = gw; s < nslot; s += NGW) {
        const int panel = s >> 8; int e = 0;
#pragma unroll
        for (int j = 1; j < 8; ++j) if (panel >= pst[j]) e = j;
        const int rank = s - pst[e] * 256;
        bf16* xp = C.XG() + (size_t)s * D;
        if (rank < pst[16 + e]) {
            const int tok = C.LIST()[(size_t)e * NTOK + rank]; const float r = C.RSTD()[tok];
#pragma unroll
            for (int j = 0; j < 4; ++j) { const f32x4 v = bf4(*(const v2u*)(C.HB() + (size_t)tok * D + 4 * lane + 256 * j)); v2u w; w.x = pk2(v[0] * r, v[1] * r); w.y = pk2(v[2] * r, v[3] * r); *(v2u*)(xp + 4 * lane + 256 * j) = w; }
        } else {
#pragma unroll
            for (int j = 0; j < 4; ++j) *(v2u*)(xp + 4 * lane + 256 * j) = (v2u){0u, 0u};
        }
    }
}
__device__ __forceinline__ void combine_phase(Ctx& C, int li, bool last) {
    LAS int* pst = (LAS int*)C.lds;
    load_panels(C, li, pst);
    const int gw = C.bid * 8 + C.wave, NGW = C.G * 8, lane = C.lane;
    for (int row = gw; row < NTOK; row += NGW) {
        if ((row % LT) < FIRSTV) continue;
        const unsigned* inf = C.TINFO() + (size_t)row * 8;
        const int e1 = (int)inf[0], e2 = (int)inf[1];
        const size_t s1 = (size_t)pst[e1] * 256 + inf[2], s2 = (size_t)pst[e2] * 256 + inf[3];
        const float g1 = __builtin_bit_cast(float, inf[4]), g2 = __builtin_bit_cast(float, inf[5]);
        f32x4 v[4]; float ss = 0.f;
#pragma unroll
        for (int j = 0; j < 4; ++j) {
            const int col = 4 * lane + 256 * j;
            v[j] = bf4(*(const v2u*)(C.HB() + (size_t)row * D + col));
            const v2u a = *(const v2u*)(C.Y() + s1 * D + col), b = *(const v2u*)(C.Y() + s2 * D + col);
            v[j][0] += g1 * bf_lo(a.x) + g2 * bf_lo(b.x); v[j][1] += g1 * bf_hi(a.x) + g2 * bf_hi(b.x);
            v[j][2] += g1 * bf_lo(a.y) + g2 * bf_lo(b.y); v[j][3] += g1 * bf_hi(a.y) + g2 * bf_hi(b.y);
            ss += (v[j][0] * v[j][0] + v[j][1] * v[j][1]) + (v[j][2] * v[j][2] + v[j][3] * v[j][3]);
        }
        ss = wave_sum(ss);
        if (!last) {
#pragma unroll
            for (int j = 0; j < 4; ++j) { const int col = 4 * lane + 256 * j; v2u w; w.x = pk2(v[j][0], v[j][1]); w.y = pk2(v[j][2], v[j][3]); *(v2u*)(C.HB() + (size_t)row * D + col) = w; }
            if (lane < 16) C.SSQ()[(size_t)row * 16 + lane] = (lane == 0) ? ss : 0.f;
        } else {
            const int b = row / LT, t = row % LT;
            if (t >= LEAD) {
                const float rs = rsqrtf(ss * (1.0f / 1024.0f) + EPS);
#pragma unroll
                for (int j = 0; j < 4; ++j) { const int col = 4 * lane + 256 * j; const f32x4 fw = *(const f32x4*)(C.FNORM() + col);
                    *(f32x4*)(C.out + ((size_t)b * SEQ + (t - LEAD)) * D + col) = (f32x4){v[j][0] * rs * fw[0], v[j][1] * rs * fw[1], v[j][2] * rs * fw[2], v[j][3] * rs * fw[3]}; }
            }
        }
    }
}

__global__ void __launch_bounds__(512, 2) mk_fwd(Args args) {
    extern __shared__ __attribute__((aligned(16))) unsigned char lds[];
    Ctx C;
    C.lds = (LAS unsigned char*)lds;
    C.tid = threadIdx.x; C.lane = C.tid & 63; C.wave = __builtin_amdgcn_readfirstlane(C.tid >> 6); C.G = gridDim.x; C.bid = blockIdx.x;
    unsigned char* ws = args.ws; C.ws = ws; C.out = args.out;
    volatile LAS unsigned* MISC = (volatile LAS unsigned*)(C.lds + MISC_OFF);
    for (int u = C.tid; u < (LDS_BYTES - RING_BYTES) / 4; u += 512) ((LAS unsigned*)(C.lds + RING_BYTES))[u] = 0u;
    __syncthreads();
    const int lo = args.ph_lo, hi = args.ph_hi;
    const bool multi = (hi - lo) > 1;
    XcdBarrier bar; bar.bar = (unsigned*)(C.ctl() + CW_BAR); bar.x = 0; bar.st = nullptr;
    if (multi) bar = xcd_barrier_post((unsigned*)(C.ctl() + CW_BAR), MISC + 8);
#define PHASE_CTX(P) Ctx P = C; { unsigned char* w_ = C.ws; asm volatile("" : "+s"(w_)); P.ws = w_; int t_ = C.tid; asm volatile("" : "+v"(t_)); P.tid = t_; P.lane = t_ & 63; P.wave = __builtin_amdgcn_readfirstlane(t_ >> 6); int g_ = C.G, b_ = C.bid; asm volatile("" : "+s"(g_), "+s"(b_)); P.G = g_; P.bid = b_; }
#define IN(k) (lo_l <= (k) && (k) < hi_l)
#define SEAM(k) do { if ((k) + 1 < hi_l) xcd_barrier(bar); } while (0)

    { int lo_l = lo, hi_l = hi; asm volatile("" : "+s"(lo_l), "+s"(hi_l));
      if (IN(0)) { for (int rep = 0; rep < REP_PRO; ++rep) { PHASE_CTX(P); prologue_phase(P, args); SEAM(0); } } }

    for (int l = 0; l < DEPTH; ++l) {
        int lo_l = lo, hi_l = hi; asm volatile("" : "+s"(lo_l), "+s"(hi_l));
        const int pb = 1 + 8 * l, li = l >> 1; const bool moe = (l & 1) != 0;
        if (PROBE_PROJ_NOEPI && IN(pb + 0)) {
            PHASE_CTX(P);
            pg8::Gemm g{P.HB(), (const bf16*)(P.ws + WS_WIN) + (size_t)l * WIN * D, NTOK, WIN, D, 0};
            pg8::StaticOrder S; S.init(NTOK, WIN, P.G, P.bid);
            EpiNone E{(unsigned*)(P.ws + WS_CTL) + 64};
            pg8::gemm_phase<EpiNone, pg8::StaticOrder, true, true>(P.lds, g, S, E);
            SEAM(pb + 0);
        }
        if (PROBE_WOUT_NOEPI && IN(pb + 2)) {
            PHASE_CTX(P);
            pg8::Gemm g{P.HB(), (const bf16*)(P.ws + WS_WOUT) + (size_t)l * D * D, NTOK, D, D, 0};
            pg8::StaticOrder S; S.init(NTOK, D, P.G, P.bid);
            EpiNone E{(unsigned*)(P.ws + WS_CTL) + 64};
            pg8::gemm_phase<EpiNone, pg8::StaticOrder, true, true>(P.lds, g, S, E);
            SEAM(pb + 0);
        }
        if (PROBE_FF2_NOEPI && IN(pb + 2)) {
            PHASE_CTX(P);
            pg8::Gemm g{(const bf16*)(P.ws + WS_WD13), (const bf16*)(P.ws + WS_WD2) + (size_t)li * D * FFD, NTOK, D, FFD, 0};
            pg8::StaticOrder S; S.init(NTOK, D, P.G, P.bid);
            EpiNone E{(unsigned*)(P.ws + WS_CTL) + 64};
            pg8::gemm_phase<EpiNone, pg8::StaticOrder, true, true>(P.lds, g, S, E);
            SEAM(pb + 0);
        }
        if (IN(pb + 0)) for (int rep = 0; rep < REP_PROJ; ++rep) {
            PHASE_CTX(P);
            pg8::Gemm g{P.HB(), (const bf16*)(P.ws + WS_WIN) + (size_t)l * WIN * D, NTOK, WIN, D, 0};
            pg8::StaticOrder S; S.init(NTOK, WIN, P.G, P.bid);
            rstd_table(P.lds, P.SSQ(), S, P.tid);
            EpiProj E{P.PROJ(), P.LOGF(), (const LAS float*)(P.lds + RS_OFF), P.LB() + l * 512};
            pg8::gemm_phase<EpiProj, pg8::StaticOrder, true, true>(P.lds, g, S, E);
            SEAM(pb + 0);
        }
        if (IN(pb + 1)) for (int rep = 0; rep < REP_MIX; ++rep) { PHASE_CTX(P); mixer_phase(P, l); SEAM(pb + 1); }
        if (IN(pb + 2)) {
            PHASE_CTX(P);
            pg8::Gemm g{P.MIX(), (const bf16*)(P.ws + WS_WOUT) + (size_t)l * D * D, NTOK, D, D, 0};
            pg8::StaticOrder S; S.init(MAINROWS, D, P.G, P.bid);
            EpiResid E{P.HB(), P.SSQ()};
            pg8::gemm_phase<EpiResid, pg8::StaticOrder, true, true>(P.lds, g, S, E);
            mini_resid_phase(P, g.A, g.Bt, D, MAINROWS);
            SEAM(pb + 2);
        }
        if (!moe) {
            if (IN(pb + 5)) for (int rep = 0; rep < REP_FF1; ++rep) {
                PHASE_CTX(P);
                pg8::Gemm g{P.HB(), (const bf16*)(P.ws + WS_WD13) + (size_t)li * 2 * FFD * D, NTOK, 2 * FFD, D, 0};
                pg8::StaticOrder S; S.init(NTOK, 2 * FFD, P.G, P.bid);
                rstd_table(P.lds, P.SSQ(), S, P.tid);
                EpiGLU E{P.T(), FFD, (const LAS float*)(P.lds + RS_OFF)};
                pg8::gemm_phase<EpiGLU, pg8::StaticOrder, true, true>(P.lds, g, S, E);
                SEAM(pb + 5);
            }
            if (IN(pb + 6)) {
                PHASE_CTX(P);
                pg8::Gemm g{P.T(), (const bf16*)(P.ws + WS_WD2) + (size_t)li * D * FFD, NTOK, D, FFD, 0};
                pg8::StaticOrder S; S.init(MAINROWS, D, P.G, P.bid);
                EpiResid E{P.HB(), P.SSQ()};
                pg8::gemm_phase<EpiResid, pg8::StaticOrder, true, true>(P.lds, g, S, E);
                mini_resid_phase(P, g.A, g.Bt, FFD, MAINROWS);
                SEAM(pb + 6);
            }
        } else {
            if (IN(pb + 3)) { PHASE_CTX(P); route_phase(P, li); SEAM(pb + 3); }
            if (IN(pb + 4)) for (int rep = 0; rep < REP_GATHER; ++rep) { PHASE_CTX(P); gather_phase(P, li); SEAM(pb + 4); }
            if (IN(pb + 5)) for (int rep = 0; rep < REP_FF1; ++rep) {
                PHASE_CTX(P);
                LAS int* pst = (LAS int*)(P.lds + RING_BYTES + 1024);
                load_panels(P, li, pst);
#define PS(i) __builtin_amdgcn_readfirstlane(pst[i])
                pg8::GroupedOrder S{PS(0), PS(1), PS(2), PS(3), PS(4), PS(5), PS(6), PS(7), PS(8), 2 * FFE / 256, P.G, P.bid};
                pg8::Gemm g{P.XG(), (const bf16*)(P.ws + WS_WM13) + (size_t)li * 8 * 2 * FFE * D, 0, 2 * FFE, D, (size_t)2 * FFE * D * 2};
                EpiGLU E{P.T(), FFE, nullptr};
                pg8::gemm_phase<EpiGLU, pg8::GroupedOrder, true, true>(P.lds, g, S, E);
                SEAM(pb + 5);
            }
            if (IN(pb + 6)) {
                PHASE_CTX(P);
                LAS int* pst = (LAS int*)(P.lds + RING_BYTES + 1024);
                load_panels(P, li, pst);
                const int ptot = PS(8), pfull = (ptot / 64) * 64, plim = (ptot - pfull <= 32) ? pfull : ptot;
                pg8::GroupedPanelOrder S{PS(1), PS(2), PS(3), PS(4), PS(5), PS(6), PS(7), plim, D / 256, P.G, P.bid};
                pg8::Gemm g{P.T(), (const bf16*)(P.ws + WS_WM2) + (size_t)li * 8 * D * FFE, 0, D, FFE, (size_t)D * FFE * 2};
                EpiY E{P.Y()};
                pg8::gemm_phase<EpiY, pg8::GroupedPanelOrder, true, true>(P.lds, g, S, E);
                mini_y_phase(P, g.A, g.Bt, (size_t)D * FFE, FFE, plim, ptot, PS(1), PS(2), PS(3), PS(4), PS(5), PS(6), PS(7));
                SEAM(pb + 6);
            }
#undef PS
            if (IN(pb + 7)) { PHASE_CTX(P); combine_phase(P, li, l == DEPTH - 1); SEAM(pb + 7); }
        }
    }
#undef IN
#undef SEAM
#undef PHASE_CTX
}

extern "C" void kernel_launch(void* const* d_in, const int* in_sizes, int n_in, void* d_out, int out_size, void* d_ws, size_t ws_size, hipStream_t stream) {
    static int grid = 0;
    if (grid == 0) {
        if (n_in != 19 || out_size != NB * SEQ * D || ws_size < WS_END) { fprintf(stderr, "kernel_launch: unexpected shapes (n_in %d, out %d, ws %zu < %zu); nothing launched\n", n_in, out_size, ws_size, (size_t)WS_END); grid = -1; return; }
        int dev = 0, cus = 0, per_cu = 0;
        if (hipGetDevice(&dev) != hipSuccess || hipDeviceGetAttribute(&cus, hipDeviceAttributeMultiprocessorCount, dev) != hipSuccess) { grid = -1; return; }
        if (hipFuncSetAttribute((const void*)mk_fwd, hipFuncAttributeMaxDynamicSharedMemorySize, LDS_BYTES) != hipSuccess) { fprintf(stderr, "kernel_launch: hipFuncSetAttribute failed\n"); grid = -1; return; }
        if (hipOccupancyMaxActiveBlocksPerMultiprocessor(&per_cu, (const void*)mk_fwd, 512, LDS_BYTES) != hipSuccess || per_cu < 1) { fprintf(stderr, "kernel_launch: occupancy query says %d blocks per CU\n", per_cu); }
        (void)hipGetLastError();
        grid = cus;
    }
    if (grid < 0) return;
    if (hipMemsetAsync((char*)d_ws + WS_CTL, 0, CTL_ZERO_BYTES, stream) != hipSuccess) return;
    Args a{};
    for (int i = 0; i < 19; ++i) a.in[i] = (const float*)d_in[i];
    a.out = (float*)d_out; a.ws = (unsigned char*)d_ws;
#if MK_ONE_LAUNCH
    a.ph_lo = 0; a.ph_hi = NPHASE;
    hipLaunchKernelGGL(mk_fwd, dim3(grid), dim3(512), LDS_BYTES, stream, a);
#else
    for (int p = 0; p < NPHASE; ++p) {
        if (p > 0) { const int l = (p - 1) / 8, k = (p - 1) % 8; const bool moe = (l & 1) != 0; if (!moe && (k == 3 || k == 4 || k == 7)) continue; }
        a.ph_lo = p; a.ph_hi = p + 1;
        hipLaunchKernelGGL(mk_fwd, dim3(grid), dim3(512), LDS_BYTES, stream, a);
    }
#endif
}
```

```cpp
#define NT_STORES 0
#include <hip/hip_runtime.h>
#include <cstdio>
#include <cstdint>

#ifndef REP_ATT
#define REP_ATT 1
#endif
#ifndef REP_HG
#define REP_HG 1
#endif
#ifndef PROBE_PROJ_NOEPI
#define PROBE_PROJ_NOEPI 0
#endif
#ifndef PROBE_WOUT_NOEPI
#define PROBE_WOUT_NOEPI 0
#endif
#ifndef PROBE_FF2_NOEPI
#define PROBE_FF2_NOEPI 0
#endif
#ifndef PROBE_XBAR
#define PROBE_XBAR 0
#endif
#ifndef NT_STORES
#define NT_STORES 1
#endif
#ifndef REP_PRO
#define REP_PRO 1
#endif
#ifndef REP_PROJ
#define REP_PROJ 1
#endif
#ifndef REP_MIX
#define REP_MIX 1
#endif
#ifndef REP_FF1
#define REP_FF1 1
#endif
#ifndef REP_GATHER
#define REP_GATHER 1
#endif
#ifndef MK_ONE_LAUNCH
#define MK_ONE_LAUNCH 1
#endif

namespace pg8 {
#define PG8_LAS __attribute__((address_space(3)))
typedef unsigned short bf16_t;
typedef short bf16x8 __attribute__((ext_vector_type(8)));
typedef float f32x4 __attribute__((ext_vector_type(4)));
typedef unsigned u32x4 __attribute__((ext_vector_type(4)));
typedef unsigned u32x2 __attribute__((ext_vector_type(2)));
constexpr int BM = 256, BK = 64, HALF = 128, HTB = HALF * BK * 2  , STAGE_BYTES = 8 * HTB, NXCD = 8, WGM = 8;

__host__ __device__ __forceinline__ int lds_byte(int r, int c) { const int st = (r >> 4) * 2 + (c >> 5), rr = r & 15, cc = c & 31, ob = rr * 64 + cc * 2; return st * 1024 + (ob ^ (((ob >> 9) & 1) << 5)); }
__host__ __device__ __forceinline__ void stage_rc(int b, int& R, int& C) { const int st = b / 1024, sb = b % 1024, swz = sb ^ (((sb >> 9) & 1) << 5); R = (st >> 1) * 16 + swz / 64; C = (st & 1) * 32 + (swz % 64) / 2; }
__host__ __device__ __forceinline__ int perm32(int rho) { const int n = rho >> 4, i = rho & 15; return 8 * (i >> 2) + 4 * n + (i & 3); }

struct Unit { int pm, pn, e, idx; };
struct Gemm { const bf16_t* A; const bf16_t* Bt; int M, N, K; size_t bstride; };

struct StaticOrder {
    int nM, nN, nwg, G, c;
    __host__ __device__ void init(int M, int N, int G_, int c_) { nM = M / BM; nN = N / BM; nwg = nM * nN; G = G_; c = c_; }
    __host__ __device__ bool next(int i, Unit& u) const {
        const long L = (long)i * G + c; if (L >= nwg) return false;
        int wgid = (int)L; { const int q = nwg / NXCD, r = nwg % NXCD, xcd = wgid % NXCD, off = wgid / NXCD; wgid = (xcd < r ? xcd * (q + 1) : r * (q + 1) + (xcd - r) * q) + off; }
        const int nig = WGM * nN, gid = wgid / nig, fm = gid * WGM, gsz = (nM - fm) < WGM ? (nM - fm) : WGM;
        u.pm = fm + ((wgid % nig) % gsz); u.pn = (wgid % nig) / gsz; u.e = 0; u.idx = i; return true;
    }
    __device__ __forceinline__ void a_ready(const Unit&) const {}
    __device__ __forceinline__ void done(const Unit&) const {}
};
struct GroupedPanelOrder {
    int p1, p2, p3, p4, p5, p6, p7, plim, nN, G, c;
    __device__ __forceinline__ bool next(int i, Unit& u) const {
        const int L = i * G + c; if (L >= plim * nN) return false;
        const int pm = L / nN; u.pm = pm; u.pn = L - pm * nN;
        u.e = (pm >= p1) + (pm >= p2) + (pm >= p3) + (pm >= p4) + (pm >= p5) + (pm >= p6) + (pm >= p7); u.idx = i; return true;
    }
    __device__ __forceinline__ void a_ready(const Unit&) const {}
    __device__ __forceinline__ void done(const Unit&) const {}
};
struct GroupedOrder {
    int p0, p1, p2, p3, p4, p5, p6, p7, p8, nN, G, c;
    __device__ __forceinline__ bool next(int i, Unit& u) const {
        const int L = i * G + c; if (L >= p8 * nN) return false;
        int e = 0, ps = 0, pe = p1;
        if (L >= p1 * nN) { e = 1; ps = p1; pe = p2; }
        if (L >= p2 * nN) { e = 2; ps = p2; pe = p3; }
        if (L >= p3 * nN) { e = 3; ps = p3; pe = p4; }
        if (L >= p4 * nN) { e = 4; ps = p4; pe = p5; }
        if (L >= p5 * nN) { e = 5; ps = p5; pe = p6; }
        if (L >= p6 * nN) { e = 6; ps = p6; pe = p7; }
        if (L >= p7 * nN) { e = 7; ps = p7; pe = p8; }
        const int rem = L - ps * nN, R = pe - ps;
        u.e = e; u.pn = rem / R; u.pm = ps + rem % R; u.idx = i; return true;
    }
    __device__ __forceinline__ void a_ready(const Unit&) const {}
    __device__ __forceinline__ void done(const Unit&) const {}
};

__device__ __forceinline__ unsigned cvt_pk_bf16(float lo, float hi) { unsigned r; asm volatile("v_cvt_pk_bf16_f32 %0, %1, %2" : "=v"(r) : "v"(lo), "v"(hi)); return r; }

template <class Epi, class Sched, bool ALIGN_EPI = false, bool SP2 = false>
__device__ __forceinline__ void gemm_phase(PG8_LAS unsigned char* lds, const Gemm g, const Sched& S, const Epi& E) {
    int tid_l = threadIdx.x; asm volatile("" : "+v"(tid_l));
    const int tid = tid_l, wid = __builtin_amdgcn_readfirstlane(tid >> 6), lane = tid & 63, wr = wid >> 2, wc = wid & 3, fr = lane & 15, fq = lane >> 4;
    const int K = g.K, nt = K / BK;
    unsigned voffA[2], voffB[2];
#pragma unroll
    for (int i = 0; i < 2; ++i) { int R, C; stage_rc(tid * 16 + i * 8192, R, C); const int Rb = Epi::PERM ? ((R & ~31) + perm32(R & 31)) : R;
        voffA[i] = (unsigned)(R * K + C) * 2u; voffB[i] = (unsigned)(Rb * K + C) * 2u; }
    const size_t kstep = (size_t)(BK * 2);
    const size_t hstep = (size_t)HALF * K * 2;
    const size_t tstep = 2 * hstep;
    const unsigned ldsw = (unsigned)wid * 1024u;
    const int aoff = lds_byte(wr * 64 + fr, fq * 8), boff = lds_byte(wc * 32 + fr, fq * 8);
#define PG8_SA(b, h) (((b) * 2 + (h)) * HTB)
#define PG8_SB(b, h) ((4 + (b) * 2 + (h)) * HTB)
#define PG8_STAGE(bufoff, gbase, voff) do { _Pragma("unroll") for (int _i = 0; _i < 2; ++_i) \
        __builtin_amdgcn_global_load_lds((const unsigned*)((const char*)(gbase) + (voff)[_i]), (PG8_LAS unsigned*)(lds + (bufoff) + ldsw + _i * 8192), 16, 0, 0); } while (0)
#define PG8_LDA(dst, b, h) do { _Pragma("unroll") for (int m = 0; m < 4; ++m) _Pragma("unroll") for (int k = 0; k < 2; ++k) dst[m][k] = *(const PG8_LAS bf16x8*)(lds + PG8_SA(b, h) + aoff + m * 2048 + k * 1024); } while (0)
#define PG8_LDB(dst, b, h) do { _Pragma("unroll") for (int n = 0; n < 2; ++n) _Pragma("unroll") for (int k = 0; k < 2; ++k) dst[n][k] = *(const PG8_LAS bf16x8*)(lds + PG8_SB(b, h) + boff + n * 2048 + k * 1024); } while (0)
#define PG8_MMA(ai, bj, At, Bt) do { __builtin_amdgcn_s_setprio(1); _Pragma("unroll") for (int m = 0; m < 4; ++m) _Pragma("unroll") for (int n = 0; n < 2; ++n) _Pragma("unroll") for (int k = 0; k < 2; ++k) \
        acc[ai][bj][m][n] = __builtin_amdgcn_mfma_f32_16x16x32_bf16(Bt[n][k], At[m][k], acc[ai][bj][m][n], 0, 0, 0); __builtin_amdgcn_s_setprio(0); } while (0)
#define PG8_WAIT_V(n) asm volatile("s_waitcnt vmcnt(" #n ")" ::: "memory")
#define PG8_WAIT_L(n) asm volatile("s_waitcnt lgkmcnt(" #n ")" ::: "memory")
#define PG8_BAR __builtin_amdgcn_s_barrier()
#define PG8_SCHED __builtin_amdgcn_sched_barrier(0)
    Unit cur, nxt; int ui = 0;
    if (!S.next(0, cur)) return;
    f32x4 acc[2][2][4][2];
#pragma unroll
    for (int a = 0; a < 2; ++a)
#pragma unroll
        for (int b = 0; b < 2; ++b)
#pragma unroll
            for (int m = 0; m < 4; ++m)
#pragma unroll
                for (int n = 0; n < 2; ++n) acc[a][b][m][n] = (f32x4){0.f, 0.f, 0.f, 0.f};
    bf16x8 At[4][2], B0[2][2], B1[2][2];
    const char* cA = (const char*)g.A + (size_t)cur.pm * tstep; const char* cB = (const char*)g.Bt + (size_t)cur.e * g.bstride + (size_t)cur.pn * tstep;
    S.a_ready(cur);
    if constexpr (SP2) {
        PG8_STAGE(PG8_SB(0, 0), cB, voffB); PG8_STAGE(PG8_SB(0, 1), cB + hstep, voffB); PG8_STAGE(PG8_SA(0, 0), cA, voffA); PG8_STAGE(PG8_SA(0, 1), cA + hstep, voffA);
        if (wr == 1) PG8_BAR;
        PG8_WAIT_V(2); PG8_BAR;
        PG8_STAGE(PG8_SB(1, 0), cB + kstep, voffB); PG8_STAGE(PG8_SA(1, 0), cA + kstep, voffA); PG8_STAGE(PG8_SB(1, 1), cB + hstep + kstep, voffB);
        PG8_WAIT_V(6); PG8_BAR;
    } else {
        PG8_STAGE(PG8_SB(0, 0), cB, voffB); PG8_STAGE(PG8_SA(0, 0), cA, voffA); PG8_STAGE(PG8_SB(0, 1), cB + hstep, voffB); PG8_STAGE(PG8_SA(0, 1), cA + hstep, voffA);
        if (wr == 1) PG8_BAR;
        PG8_WAIT_V(4); PG8_BAR;
        PG8_STAGE(PG8_SB(1, 0), cB + kstep, voffB); PG8_STAGE(PG8_SA(1, 0), cA + kstep, voffA); PG8_STAGE(PG8_SB(1, 1), cB + hstep + kstep, voffB);
        PG8_WAIT_V(6); PG8_BAR;
    }
    for (;;) {
        const bool has_next = S.next(ui + 1, nxt);
        const char* nA = has_next ? (const char*)g.A + (size_t)nxt.pm * tstep : cA; const char* nB = has_next ? (const char*)g.Bt + (size_t)nxt.e * g.bstride + (size_t)nxt.pn * tstep : cB;
        for (int t = 0; t < nt; t += 2) {
            const bool last = (t == nt - 2);
            const char* a1 = cA + (size_t)(t + 1) * kstep;
            const char* a2 = last ? nA : cA + (size_t)(t + 2) * kstep; const char* b2 = last ? nB : cB + (size_t)(t + 2) * kstep;
            const char* a3 = a2 + kstep; const char* b3 = b2 + kstep;
            if (last && has_next) S.a_ready(nxt);
            if constexpr (SP2) {
            PG8_LDB(B0, 0, 0); PG8_LDB(B1, 0, 1); PG8_SCHED; PG8_LDA(At, 0, 0); PG8_STAGE(PG8_SA(1, 1), a1 + hstep, voffA);
            PG8_WAIT_V(8); PG8_WAIT_L(0); PG8_BAR; PG8_MMA(0, 0, At, B0); PG8_MMA(0, 1, At, B1); PG8_BAR; PG8_SCHED;
            PG8_LDA(At, 0, 1); PG8_STAGE(PG8_SB(0, 0), b2, voffB); PG8_STAGE(PG8_SB(0, 1), b2 + hstep, voffB); PG8_STAGE(PG8_SA(0, 0), a2, voffA);
            PG8_WAIT_V(8); PG8_WAIT_L(0); PG8_BAR; PG8_MMA(1, 0, At, B0); PG8_MMA(1, 1, At, B1); PG8_BAR; PG8_SCHED;
            PG8_LDB(B0, 1, 0); PG8_LDB(B1, 1, 1); PG8_SCHED; PG8_LDA(At, 1, 0); PG8_STAGE(PG8_SA(0, 1), a2 + hstep, voffA);
            PG8_WAIT_V(8); PG8_WAIT_L(0); PG8_BAR; PG8_MMA(0, 0, At, B0); PG8_MMA(0, 1, At, B1); PG8_BAR; PG8_SCHED;
            PG8_LDA(At, 1, 1); PG8_STAGE(PG8_SB(1, 0), b3, voffB); PG8_STAGE(PG8_SB(1, 1), b3 + hstep, voffB); PG8_STAGE(PG8_SA(1, 0), a3, voffA);
            PG8_WAIT_V(8); PG8_WAIT_L(0); PG8_BAR; PG8_MMA(1, 0, At, B0); PG8_MMA(1, 1, At, B1); PG8_BAR; PG8_SCHED;
            } else {
            PG8_LDB(B0, 0, 0); PG8_SCHED; PG8_LDA(At, 0, 0); PG8_STAGE(PG8_SA(1, 1), a1 + hstep, voffA);
            PG8_WAIT_L(8); PG8_BAR; PG8_WAIT_L(0); PG8_MMA(0, 0, At, B0); PG8_BAR; PG8_SCHED;
            PG8_LDB(B1, 0, 1); PG8_STAGE(PG8_SB(0, 0), b2, voffB);
            PG8_BAR; PG8_WAIT_L(0); PG8_MMA(0, 1, At, B1); PG8_BAR;
            PG8_LDA(At, 0, 1); PG8_STAGE(PG8_SA(0, 0), a2, voffA);
            PG8_BAR; PG8_WAIT_L(0); PG8_MMA(1, 0, At, B0); PG8_BAR; PG8_SCHED;
            PG8_STAGE(PG8_SB(0, 1), b2 + hstep, voffB);
            PG8_WAIT_V(6); PG8_BAR; PG8_MMA(1, 1, At, B1); PG8_BAR;
            PG8_LDB(B0, 1, 0); PG8_SCHED; PG8_LDA(At, 1, 0); PG8_STAGE(PG8_SA(0, 1), a2 + hstep, voffA);
            PG8_WAIT_L(8); PG8_BAR; PG8_WAIT_L(0); PG8_MMA(0, 0, At, B0); PG8_BAR; PG8_SCHED;
            PG8_LDB(B1, 1, 1); PG8_STAGE(PG8_SB(1, 0), b3, voffB);
            PG8_BAR; PG8_WAIT_L(0); PG8_MMA(0, 1, At, B1); PG8_BAR;
            PG8_LDA(At, 1, 1); PG8_STAGE(PG8_SA(1, 0), a3, voffA);
            PG8_BAR; PG8_WAIT_L(0); PG8_MMA(1, 0, At, B0); PG8_BAR; PG8_SCHED;
            PG8_STAGE(PG8_SB(1, 1), b3 + hstep, voffB);
            PG8_WAIT_V(6); PG8_BAR; PG8_MMA(1, 1, At, B1); PG8_BAR;
            }
        }
        if constexpr (ALIGN_EPI) { if (wr == 0) PG8_BAR; }
        if constexpr (!Epi::AFTER_DRAIN) { E(acc, cur, wr, wc, fr, fq); S.done(cur); }
        if (!has_next) break;
#pragma unroll
        for (int a = 0; a < 2; ++a)
#pragma unroll
            for (int b = 0; b < 2; ++b)
#pragma unroll
                for (int m = 0; m < 4; ++m)
#pragma unroll
                    for (int n = 0; n < 2; ++n) acc[a][b][m][n] = (f32x4){0.f, 0.f, 0.f, 0.f};
        cur = nxt; cA = nA; cB = nB; ++ui;
        if constexpr (ALIGN_EPI) { if (wr == 1) PG8_BAR; }
    }
    PG8_WAIT_V(0);
    if constexpr (!ALIGN_EPI) { if (wr == 0) PG8_BAR; }
    PG8_BAR;
    if constexpr (Epi::AFTER_DRAIN) { E.fused(acc, cur, wr, wc, fr, fq, lds, wid, lane); S.done(cur); }
#undef PG8_SA
#undef PG8_SB
#undef PG8_STAGE
#undef PG8_LDA
#undef PG8_LDB
#undef PG8_MMA
#undef PG8_WAIT_V
#undef PG8_WAIT_L
#undef PG8_BAR
#undef PG8_SCHED
}

}

constexpr int D = 1024, NB = 8, SEQ = 2048, DEPTH = 4, LEAD = 128, FIRSTV = 112, LT = LEAD + SEQ, NTOK = NB * LT;
constexpr int WIN = 3584, FFD = 2816, FFE = 3584, NE = 8, MAXSLOT = 36864;
constexpr float EPS = 1e-6f;
constexpr int NPHASE = 1 + 8 * DEPTH;
constexpr int MAINROWS = (NTOK / (64 * 256)) * (64 * 256);

constexpr size_t MiB = 1u << 20;
constexpr size_t WS_CTL = 0, CTL_ZERO_BYTES = MiB;
constexpr size_t WS_TAB = 1 * MiB;
constexpr size_t WS_WIN = 2 * MiB;
constexpr size_t WS_WOUT = WS_WIN + 28 * MiB;
constexpr size_t WS_WD13 = WS_WOUT + 8 * MiB;
constexpr size_t WS_WD2 = WS_WD13 + 22 * MiB;
constexpr size_t WS_WM13 = WS_WD2 + 11 * MiB;
constexpr size_t WS_WM2 = WS_WM13 + 224 * MiB;
constexpr size_t WS_H = WS_WM2 + 112 * MiB;
constexpr size_t WS_HB = WS_H + 68 * MiB;
constexpr size_t WS_SSQ = WS_HB + 34 * MiB;
constexpr size_t WS_ROUTE = WS_SSQ + 2 * MiB;
constexpr size_t WS_ACT = WS_ROUTE + 2 * MiB;
constexpr size_t WS_XG = WS_ACT + 252 * MiB;
constexpr size_t WS_END = WS_XG + 72 * MiB;
constexpr size_t ACT_PROJ = 0, ACT_LOGF = 119 * MiB, ACT_MIX = 153 * MiB;
constexpr size_t TAB_LB = 0, TAB_BIAS = 8192, TAB_LAM = 12288, TAB_SUBLN = 12544, TAB_HGNW = 14592, TAB_RF = 20480, TAB_FNORM = 20480 + 65536;
constexpr size_t ROUTE_INFO = 0, ROUTE_LIST = 640 * 1024, ROUTE_RSTD = 1280 * 1024;
constexpr int CW_TMO = 0, CW_BAR = 4096, CW_CNT = 8192;

constexpr int RING_BYTES = 131072, MISC_OFF = RING_BYTES + 320, LDS_BYTES = 147456;

#define GAS __attribute__((address_space(1)))
#define LAS __attribute__((address_space(3)))
typedef unsigned short bf16;
typedef unsigned v4u __attribute__((ext_vector_type(4)));
typedef unsigned v2u __attribute__((ext_vector_type(2)));
typedef float f32x4 __attribute__((ext_vector_type(4)));
typedef GAS unsigned gu32;
#define RLX_AGENT __ATOMIC_RELAXED, __HIP_MEMORY_SCOPE_AGENT
#define LDS_WAIT() asm volatile("s_waitcnt lgkmcnt(0)" ::: "memory")
__device__ __forceinline__ unsigned f2bf(float f) { unsigned u = __builtin_bit_cast(unsigned, f); return (u + 0x7fffu + ((u >> 16) & 1u)) >> 16; }
__device__ __forceinline__ unsigned pk2(float lo, float hi) { return f2bf(lo) | (f2bf(hi) << 16); }
__device__ __forceinline__ float bf_lo(unsigned w) { return __builtin_bit_cast(float, w << 16); }
__device__ __forceinline__ float bf_hi(unsigned w) { return __builtin_bit_cast(float, w & 0xffff0000u); }
__device__ __forceinline__ f32x4 bf4(v2u w) { return (f32x4){bf_lo(w.x), bf_hi(w.x), bf_lo(w.y), bf_hi(w.y)}; }
template <class V> __device__ __forceinline__ void st_out(V* p, V v) { if (NT_STORES) __builtin_nontemporal_store(v, p); else *p = v; }
__device__ __forceinline__ float silu_f(float x) { return x * __builtin_amdgcn_rcpf(1.f + __expf(-x)); }
__device__ __forceinline__ float wave_sum(float v) {
#pragma unroll
    for (int o = 1; o < 64; o <<= 1) v += __shfl_xor(v, o);
    return v;
}

#define XB_TMO      128
#define XB_XCNT(j)  (256  + 64 * (j))
#define XB_XSUB(j)  (1280 + 64 * (j))
#define XB_XGEN(j)  (2304 + 64 * (j))
#define XB_TOP      3328
#define XB_TOPGEN   3392
#define XCD_BAR_WORDS 3456
#define XB_SPIN_CAP (1u << 18)

__device__ __forceinline__ unsigned xb_ld(unsigned* p)              { return __hip_atomic_load(p, __ATOMIC_RELAXED, __HIP_MEMORY_SCOPE_AGENT); }
__device__ __forceinline__ unsigned xb_add(unsigned* p, unsigned v) { return __hip_atomic_fetch_add(p, v, __ATOMIC_RELAXED, __HIP_MEMORY_SCOPE_AGENT); }
__device__ __forceinline__ unsigned xb_xcc_id() { return (unsigned)__builtin_amdgcn_s_getreg((3 << 11) | 20) & 0xFu; }
#define XB_SPIN(cond, bar) do { unsigned _sp = 0; while (cond) { __builtin_amdgcn_s_sleep(1); \
    if ((++_sp & 255u) == 0u) { if (xb_ld(&(bar)[XB_TMO])) break; if (_sp > XB_SPIN_CAP) { atomicAdd(&(bar)[XB_TMO], 1u); break; } } } } while (0)

struct XcdBarrier {
    unsigned* bar; unsigned x;
    volatile LAS unsigned* st;
};

__device__ __forceinline__ XcdBarrier xcd_barrier_post(unsigned* bar, volatile LAS unsigned* st) {
    XcdBarrier b; b.bar = bar; b.x = xb_xcc_id(); b.st = st;
    if (threadIdx.x == 0) (void)xb_add(&bar[XB_XCNT(b.x)], 1u);
    return b;
}
__device__ __forceinline__ void xcd_barrier_complete(unsigned* bar, unsigned x, unsigned& nloc, unsigned& nx) {
    const unsigned G = gridDim.x * gridDim.y * gridDim.z;
    unsigned sum, cnt, mine, sp = 0u;
    for (;;) {
        sum = 0u; cnt = 0u; mine = 0u;
#pragma unroll
        for (unsigned j = 0; j < 16; ++j) { const unsigned c = xb_ld(&bar[XB_XCNT(j)]); sum += c; cnt += (c > 0u) ? 1u : 0u; mine = (j == x) ? c : mine; }
        if (sum == G) break;
        __builtin_amdgcn_s_sleep(1);
        if ((++sp & 255u) == 0u) { if (xb_ld(&bar[XB_TMO])) break; if (sp > XB_SPIN_CAP) { atomicAdd(&bar[XB_TMO], 1u); break; } }
    }
    nloc = mine > 0u ? mine : 1u; nx = cnt > 0u ? cnt : 1u;
}

__device__ __forceinline__ void xcd_barrier(const XcdBarrier& b) {
    asm volatile("s_waitcnt vmcnt(0)" ::: "memory");
    __syncthreads();
    if (threadIdx.x == 0) {
        unsigned* bar = b.bar;
        __builtin_amdgcn_s_waitcnt(0);
        unsigned nloc = b.st[0], nx = b.st[1];
        if (nloc == 0u) { xcd_barrier_complete(bar, b.x, nloc, nx); b.st[0] = nloc; b.st[1] = nx; }
        const unsigned old = xb_add(&bar[XB_XSUB(b.x)], 1u);
        const unsigned gen = old / nloc;
        if (old + 1u == (gen + 1u) * nloc) {
            __builtin_amdgcn_fence(__ATOMIC_RELEASE, "agent");
            asm volatile("s_waitcnt vmcnt(0)" ::: "memory");
            const unsigned og = xb_add(&bar[XB_TOP], 1u);
            const unsigned tg = og / nx;
            if (og + 1u == (tg + 1u) * nx) xb_add(&bar[XB_TOPGEN], 1u);
            else XB_SPIN(xb_ld(&bar[XB_TOPGEN]) == tg, bar);
            __builtin_amdgcn_fence(__ATOMIC_ACQUIRE, "agent");
            xb_add(&bar[XB_XGEN(b.x)], 1u);
            asm volatile("s_waitcnt vmcnt(0)" ::: "memory");
        } else {
            XB_SPIN(xb_ld(&bar[XB_XGEN(b.x)]) == gen, bar);
            __builtin_amdgcn_fence(__ATOMIC_ACQUIRE, "agent");
            asm volatile("s_waitcnt vmcnt(0)" ::: "memory");
        }
    }
    __syncthreads();
}


static __device__ const unsigned char T5B[129] = {0, 1, 2, 3, 4, 5, 6, 7, 8, 9, 10, 11, 12, 13, 14, 15, 16, 16, 16, 17, 17, 18, 18, 18, 19, 19, 19, 20, 20, 20, 20, 21, 21, 21, 21, 22, 22, 22, 22, 22, 23, 23, 23, 23, 23, 23, 24, 24, 24, 24, 24, 24, 25, 25, 25, 25, 25, 25, 25, 26, 26, 26, 26, 26, 26, 26, 26, 27, 27, 27, 27, 27, 27, 27, 27, 27, 27, 28, 28, 28, 28, 28, 28, 28, 28, 28, 28, 29, 29, 29, 29, 29, 29, 29, 29, 29, 29, 29, 29, 30, 30, 30, 30, 30, 30, 30, 30, 30, 30, 30, 30, 30, 30, 31, 31, 31, 31, 31, 31, 31, 31, 31, 31, 31, 31, 31, 31, 31, 31};

struct Ctx {
    LAS unsigned char* lds;
    int tid, lane, wave, G, bid;
    float* out;
    unsigned char* ws;
    __device__ __forceinline__ gu32* ctl() const { return (gu32*)(ws + WS_CTL); }
    __device__ __forceinline__ bf16* HB() const { return (bf16*)(ws + WS_HB); }
    __device__ __forceinline__ float* SSQ() const { return (float*)(ws + WS_SSQ); }
    __device__ __forceinline__ bf16* PROJ() const { return (bf16*)(ws + WS_ACT + ACT_PROJ); }
    __device__ __forceinline__ float* LOGF() const { return (float*)(ws + WS_ACT + ACT_LOGF); }
    __device__ __forceinline__ bf16* MIX() const { return (bf16*)(ws + WS_ACT + ACT_MIX); }
    __device__ __forceinline__ bf16* T() const { return (bf16*)(ws + WS_ACT); }
    __device__ __forceinline__ bf16* XG() const { return (bf16*)(ws + WS_XG); }
    __device__ __forceinline__ bf16* Y() const { return (bf16*)(ws + WS_XG); }
    __device__ __forceinline__ float* LB() const { return (float*)(ws + WS_TAB + TAB_LB); }
    __device__ __forceinline__ float* BIAST() const { return (float*)(ws + WS_TAB + TAB_BIAS); }
    __device__ __forceinline__ float* LAM() const { return (float*)(ws + WS_TAB + TAB_LAM); }
    __device__ __forceinline__ float* RF() const { return (float*)(ws + WS_TAB + TAB_RF); }
    __device__ __forceinline__ float* SUBLN() const { return (float*)(ws + WS_TAB + TAB_SUBLN); }
    __device__ __forceinline__ float* HGNW() const { return (float*)(ws + WS_TAB + TAB_HGNW); }
    __device__ __forceinline__ float* FNORM() const { return (float*)(ws + WS_TAB + TAB_FNORM); }
    __device__ __forceinline__ unsigned* TINFO() const { return (unsigned*)(ws + WS_ROUTE + ROUTE_INFO); }
    __device__ __forceinline__ int* LIST() const { return (int*)(ws + WS_ROUTE + ROUTE_LIST); }
    __device__ __forceinline__ float* RSTD() const { return (float*)(ws + WS_ROUTE + ROUTE_RSTD); }
};
struct Args { const float* in[19]; float* out; unsigned char* ws; int ph_lo, ph_hi; };
enum { IN_X = 0, IN_META, IN_RELB, IN_NMIX, IN_WIN, IN_LBL, IN_HGNW, IN_LAMBDA, IN_SUBLN, IN_WOUT, IN_NFFN, IN_DW1, IN_DW3, IN_DW2, IN_ROUTER, IN_MW1, IN_MW3, IN_MW2, IN_FNORM };

__device__ __forceinline__ v2u pack4(float a, float b, float c, float d) { v2u w; w.x = pg8::cvt_pk_bf16(a, b); w.y = pg8::cvt_pk_bf16(c, d); return w; }
__device__ __forceinline__ float row_rstd(const float* ssq, int row) {
    const f32x4* p = (const f32x4*)(ssq + (size_t)row * 16);
    const f32x4 a = p[0], b = p[1], c = p[2], d = p[3];
    const float s = ((a[0] + a[1]) + (a[2] + a[3])) + ((b[0] + b[1]) + (b[2] + b[3])) + ((c[0] + c[1]) + (c[2] + c[3])) + ((d[0] + d[1]) + (d[2] + d[3]));
    return rsqrtf(s * (1.0f / 1024.0f) + EPS);
}
template <int N> __device__ __forceinline__ float dpp_row_shr(float x) {
    return __builtin_bit_cast(float, __builtin_amdgcn_update_dpp(0, __builtin_bit_cast(int, x), 0x110 + N, 0xf, 0xf, true));
}
constexpr int RS_OFF = RING_BYTES + 4096, RS_MAXU = 12;
template <class Sched> __device__ __forceinline__ void rstd_table(LAS unsigned char* lds, const float* ssq, const Sched& S, int tid) {
    LAS float* rs = (LAS float*)(lds + RS_OFF);
    pg8::Unit u;
    for (int i0 = 0; i0 < RS_MAXU; i0 += 2) {
        const int i = i0 + (tid >> 8);
        if (S.next(i, u)) rs[i * 256 + (tid & 255)] = row_rstd(ssq, u.pm * 256 + (tid & 255));
    }
    __syncthreads();
}
struct EpiProj {
    static constexpr bool PERM = true, AFTER_DRAIN = false;
    bf16* proj; float* logfp; const LAS float* rs; const float* lb;
    template <int AI, int BJ, int NN> __device__ __forceinline__ void hf_block(const pg8::f32x4 (&acc)[2][2][4][2], int row0, int colb, const LAS float* rsu) const {
        const int c0 = colb + BJ * 128 + 4 * NN, cc = c0 - 512;
        const f32x4 l0 = *(const f32x4*)(lb + cc);
        float lf[4][4];
#pragma unroll
        for (int m = 0; m < 4; ++m) {
            const int row = row0 + AI * 128 + m * 16;
            const float r = rsu[AI * 128 + m * 16];
            const bool valid = (row % LT) >= FIRSTV;
            float kx[4];
#pragma unroll
            for (int j = 0; j < 4; ++j) {
                const float lbv = l0[j];
                const float xx = acc[AI][BJ][m][NN][j] * r;
                const float xc = fminf(fmaxf(xx, -30.f), 30.f);
                const float te = __expf(-xc), sg = __builtin_amdgcn_rcpf(1.f + te);
                float lgf = __logf(lbv + (1.f - lbv) * sg);
                float kk = (1.f - lbv) * (te * sg);
                if (!valid) { lgf = 0.f; kk = 0.f; }
                lf[m][j] = lgf; kx[j] = kk;
            }
            v2u w; w.x = pg8::cvt_pk_bf16(kx[0], kx[1]); w.y = pg8::cvt_pk_bf16(kx[2], kx[3]);
            *(v2u*)(proj + (size_t)row * WIN + c0) = w;
        }
#pragma unroll
        for (int j = 0; j < 4; ++j) {
            float carry = 0.f;
#pragma unroll
            for (int m = 0; m < 4; ++m) {
                float x = lf[m][j];
                x += dpp_row_shr<1>(x); x += dpp_row_shr<2>(x); x += dpp_row_shr<4>(x); x += dpp_row_shr<8>(x);
                x += carry;
                carry = __shfl(x, 15, 16);
                lf[m][j] = x;
            }
        }
#pragma unroll
        for (int m = 0; m < 4; ++m) *(f32x4*)(logfp + (size_t)(row0 + AI * 128 + m * 16) * 512 + cc) = (f32x4){lf[m][0], lf[m][1], lf[m][2], lf[m][3]};
    }
    __device__ __forceinline__ void operator()(const pg8::f32x4 (&acc)[2][2][4][2], const pg8::Unit& u, int wr, int wc, int fr, int fq) const {
        const int grp = u.pn >> 1;
        const int row0 = u.pm * 256 + wr * 64 + fr, colb = u.pn * 256 + wc * 32 + 8 * fq;
        const LAS float* rsu = rs + u.idx * 256 + wr * 64 + fr;
        if (grp == 1) {
            hf_block<0, 0, 0>(acc, row0, colb, rsu); hf_block<0, 0, 1>(acc, row0, colb, rsu); hf_block<0, 1, 0>(acc, row0, colb, rsu); hf_block<0, 1, 1>(acc, row0, colb, rsu);
            hf_block<1, 0, 0>(acc, row0, colb, rsu); hf_block<1, 0, 1>(acc, row0, colb, rsu); hf_block<1, 1, 0>(acc, row0, colb, rsu); hf_block<1, 1, 1>(acc, row0, colb, rsu);
            return;
        }
#pragma unroll
        for (int ai = 0; ai < 2; ++ai)
#pragma unroll
            for (int m = 0; m < 4; ++m) {
                const int row = row0 + ai * 128 + m * 16;
                const float r = rsu[ai * 128 + m * 16];
#pragma unroll
                for (int bj = 0; bj < 2; ++bj) {
                    const int c0 = colb + bj * 128;
                    float x[8];
#pragma unroll
                    for (int j = 0; j < 4; ++j) { x[j] = acc[ai][bj][m][0][j] * r; x[4 + j] = acc[ai][bj][m][1][j] * r; }
                    if (grp == 0 || grp == 3) {
#pragma unroll
                        for (int j = 0; j < 8; ++j) x[j] = silu_f(x[j]);
                    } else if (grp == 4) {
#pragma unroll
                        for (int j = 0; j < 8; ++j) x[j] *= 0.18033688011112042f;
                    }
                    v4u w; w.x = pg8::cvt_pk_bf16(x[0], x[1]); w.y = pg8::cvt_pk_bf16(x[2], x[3]); w.z = pg8::cvt_pk_bf16(x[4], x[5]); w.w = pg8::cvt_pk_bf16(x[6], x[7]);
                    st_out((v4u*)(proj + (size_t)row * WIN + c0), w);
                }
            }
    }
};
struct EpiResid {
    static constexpr bool PERM = true, AFTER_DRAIN = false;
    bf16* HB; float* ssq;
    __device__ __forceinline__ void operator()(const pg8::f32x4 (&acc)[2][2][4][2], const pg8::Unit& u, int wr, int wc, int fr, int fq) const {
        const int row0 = u.pm * 256 + wr * 64 + fr, colb = u.pn * 256 + wc * 32 + 8 * fq;
#pragma unroll
        for (int ai = 0; ai < 2; ++ai) {
            v4u h[4][2];
#pragma unroll
            for (int m = 0; m < 4; ++m)
#pragma unroll
                for (int bj = 0; bj < 2; ++bj) h[m][bj] = *(const v4u*)(HB + (size_t)(row0 + ai * 128 + m * 16) * D + colb + bj * 128);
#pragma unroll
            for (int m = 0; m < 4; ++m) {
                const int row = row0 + ai * 128 + m * 16;
                float s = 0.f;
#pragma unroll
                for (int bj = 0; bj < 2; ++bj) {
                    const v4u hw = h[m][bj];
                    const f32x4 h0 = (f32x4){bf_lo(hw.x), bf_hi(hw.x), bf_lo(hw.y), bf_hi(hw.y)} + acc[ai][bj][m][0], h1 = (f32x4){bf_lo(hw.z), bf_hi(hw.z), bf_lo(hw.w), bf_hi(hw.w)} + acc[ai][bj][m][1];
                    s += (h0[0] * h0[0] + h0[1] * h0[1]) + (h0[2] * h0[2] + h0[3] * h0[3]) + (h1[0] * h1[0] + h1[1] * h1[1]) + (h1[2] * h1[2] + h1[3] * h1[3]);
                    v4u w; w.x = pg8::cvt_pk_bf16(h0[0], h0[1]); w.y = pg8::cvt_pk_bf16(h0[2], h0[3]); w.z = pg8::cvt_pk_bf16(h1[0], h1[1]); w.w = pg8::cvt_pk_bf16(h1[2], h1[3]);
                    *(v4u*)(HB + (size_t)row * D + colb + bj * 128) = w;
                }
                s += __shfl_xor(s, 16); s += __shfl_xor(s, 32);
                if (fq == 0) ssq[(size_t)row * 16 + u.pn * 4 + wc] = s;
            }
        }
    }
};
struct EpiGLU {
    static constexpr bool PERM = true, AFTER_DRAIN = false;
    bf16* T; int ldt; const LAS float* rs;
    __device__ __forceinline__ void operator()(const pg8::f32x4 (&acc)[2][2][4][2], const pg8::Unit& u, int wr, int wc, int fr, int fq) const {
        const int row0 = u.pm * 256 + wr * 64 + fr, colb = u.pn * 128 + wc * 32 + 8 * fq;
#pragma unroll
        for (int ai = 0; ai < 2; ++ai)
#pragma unroll
            for (int m = 0; m < 4; ++m) {
                const int row = row0 + ai * 128 + m * 16;
                const float r = rs ? rs[u.idx * 256 + wr * 64 + fr + ai * 128 + m * 16] : 1.f;
                float x[8];
#pragma unroll
                for (int j = 0; j < 4; ++j) { x[j] = silu_f(acc[ai][0][m][0][j] * r) * (acc[ai][1][m][0][j] * r); x[4 + j] = silu_f(acc[ai][0][m][1][j] * r) * (acc[ai][1][m][1][j] * r); }
                v4u w; w.x = pg8::cvt_pk_bf16(x[0], x[1]); w.y = pg8::cvt_pk_bf16(x[2], x[3]); w.z = pg8::cvt_pk_bf16(x[4], x[5]); w.w = pg8::cvt_pk_bf16(x[6], x[7]);
                st_out((v4u*)(T + (size_t)row * ldt + colb), w);
            }
    }
};
struct EpiNone { static constexpr bool PERM = true, AFTER_DRAIN = false; unsigned* sink;
    __device__ __forceinline__ void operator()(const pg8::f32x4 (&acc)[2][2][4][2], const pg8::Unit& u, int wr, int wc, int fr, int fq) const { pg8::f32x4 s = acc[0][0][0][0];
#pragma unroll
        for (int a = 0; a < 2; ++a)
#pragma unroll
            for (int b = 0; b < 2; ++b)
#pragma unroll
                for (int m = 0; m < 4; ++m)
#pragma unroll
                    for (int n = 0; n < 2; ++n) s = s + acc[a][b][m][n];
        if (s[0] + s[1] + s[2] + s[3] == 1.2345e38f) sink[0] = 1u; } };
struct EpiY {
    static constexpr bool PERM = true, AFTER_DRAIN = false;
    bf16* Y;
    __device__ __forceinline__ void operator()(const pg8::f32x4 (&acc)[2][2][4][2], const pg8::Unit& u, int wr, int wc, int fr, int fq) const {
        const int row0 = u.pm * 256 + wr * 64 + fr, colb = u.pn * 256 + wc * 32 + 8 * fq;
#pragma unroll
        for (int ai = 0; ai < 2; ++ai)
#pragma unroll
            for (int m = 0; m < 4; ++m) {
                const int row = row0 + ai * 128 + m * 16;
#pragma unroll
                for (int bj = 0; bj < 2; ++bj) {
                    const pg8::f32x4 a = acc[ai][bj][m][0], b = acc[ai][bj][m][1];
                    v4u w; w.x = pg8::cvt_pk_bf16(a[0], a[1]); w.y = pg8::cvt_pk_bf16(a[2], a[3]); w.z = pg8::cvt_pk_bf16(b[0], b[1]); w.w = pg8::cvt_pk_bf16(b[2], b[3]);
                    *(v4u*)(Y + (size_t)row * D + colb + bj * 128) = w;
                }
            }
    }
};

__device__ __forceinline__ void transpose_item(const float* W, const float* fold, int K, int N, bf16* WT, int k0, int n0, int drow0, LAS float* scr, int lane) {
    const int kr = lane >> 4, n4 = lane & 15;
    f32x4 v[16];
#pragma unroll
    for (int i = 0; i < 16; ++i) v[i] = *(const f32x4*)(W + (size_t)(k0 + 4 * i + kr) * N + n0 + 4 * n4);
#pragma unroll
    for (int i = 0; i < 16; ++i) { const int k = 4 * i + kr; *(LAS f32x4*)(scr + k * 64 + ((4 * n4) ^ (4 * ((k >> 3) & 7)))) = v[i]; }
    LDS_WAIT(); asm volatile("" ::: "memory");
    const int c = lane & 7, nn = lane >> 3;
    f32x4 f0 = (f32x4){1.f, 1.f, 1.f, 1.f}, f1 = f0;
    if (fold) { f0 = *(const f32x4*)(fold + k0 + 8 * c); f1 = *(const f32x4*)(fold + k0 + 8 * c + 4); }
#pragma unroll
    for (int i2 = 0; i2 < 8; ++i2) {
        const int n = 8 * i2 + nn; const LAS float* s = scr + (8 * c) * 64 + (n ^ (4 * c));
        v4u o; o.x = pk2(s[0 * 64] * f0[0], s[1 * 64] * f0[1]); o.y = pk2(s[2 * 64] * f0[2], s[3 * 64] * f0[3]); o.z = pk2(s[4 * 64] * f1[0], s[5 * 64] * f1[1]); o.w = pk2(s[6 * 64] * f1[2], s[7 * 64] * f1[3]);
        *(GAS v4u*)(WT + (size_t)(drow0 + n) * K + k0 + 8 * c) = o;
    }
    LDS_WAIT(); asm volatile("" ::: "memory");
}
__device__ __forceinline__ void prologue_phase(Ctx& C, const Args& A) {
    LAS float* scr = (LAS float*)(C.lds + C.wave * 16384);
    const int gw = C.bid * 8 + C.wave, NGW = C.G * 8;
    constexpr int I_IN = 16 * 56, I_OUT = 16 * 16, I_D1 = 16 * 44, I_D2 = 44 * 16, I_M1 = 16 * 56, I_M2 = 56 * 16;
    constexpr int N_IN = 4 * I_IN, N_OUT = 4 * I_OUT, N_D1 = 2 * I_D1, N_D2 = 2 * I_D2, N_M1 = 16 * I_M1, N_M2 = 16 * I_M2;
    constexpr int NITEMS = N_IN + N_OUT + 2 * N_D1 + N_D2 + 2 * N_M1 + N_M2;
    for (int it = gw; it < NITEMS; it += NGW) {
        int r = it;
        const float* W; const float* fold = nullptr; bf16* WT; int K, N, glu = -1, loc;
        if (r < N_IN) { const int l = r / I_IN; loc = r % I_IN; W = A.in[IN_WIN] + (size_t)l * D * WIN; fold = A.in[IN_NMIX] + l * D; WT = (bf16*)(C.ws + WS_WIN) + (size_t)l * WIN * D; K = D; N = WIN; }
        else if ((r -= N_IN) < N_OUT) { const int l = r / I_OUT; loc = r % I_OUT; W = A.in[IN_WOUT] + (size_t)l * D * D; WT = (bf16*)(C.ws + WS_WOUT) + (size_t)l * D * D; K = D; N = D; }
        else if ((r -= N_OUT) < N_D1) { const int i = r / I_D1; loc = r % I_D1; W = A.in[IN_DW1] + (size_t)i * D * FFD; fold = A.in[IN_NFFN] + (2 * i) * D; WT = (bf16*)(C.ws + WS_WD13) + (size_t)i * 2 * FFD * D; K = D; N = FFD; glu = 0; }
        else if ((r -= N_D1) < N_D1) { const int i = r / I_D1; loc = r % I_D1; W = A.in[IN_DW3] + (size_t)i * D * FFD; fold = A.in[IN_NFFN] + (2 * i) * D; WT = (bf16*)(C.ws + WS_WD13) + (size_t)i * 2 * FFD * D; K = D; N = FFD; glu = 1; }
        else if ((r -= N_D1) < N_D2) { const int i = r / I_D2; loc = r % I_D2; W = A.in[IN_DW2] + (size_t)i * FFD * D; WT = (bf16*)(C.ws + WS_WD2) + (size_t)i * D * FFD; K = FFD; N = D; }
        else if ((r -= N_D2) < N_M1) { const int ie = r / I_M1; loc = r % I_M1; W = A.in[IN_MW1] + (size_t)ie * D * FFE; fold = A.in[IN_NFFN] + (2 * (ie >> 3) + 1) * D; WT = (bf16*)(C.ws + WS_WM13) + (size_t)ie * 2 * FFE * D; K = D; N = FFE; glu = 0; }
        else if ((r -= N_M1) < N_M1) { const int ie = r / I_M1; loc = r % I_M1; W = A.in[IN_MW3] + (size_t)ie * D * FFE; fold = A.in[IN_NFFN] + (2 * (ie >> 3) + 1) * D; WT = (bf16*)(C.ws + WS_WM13) + (size_t)ie * 2 * FFE * D; K = D; N = FFE; glu = 1; }
        else { r -= N_M1; const int ie = r / I_M2; loc = r % I_M2; W = A.in[IN_MW2] + (size_t)ie * FFE * D; WT = (bf16*)(C.ws + WS_WM2) + (size_t)ie * D * FFE; K = FFE; N = D; }
        const int nblk = N / 64, kb = loc / nblk, nb = loc % nblk, k0 = 64 * kb, n0 = 64 * nb;
        const int drow0 = (glu < 0) ? n0 : ((n0 >> 7) * 256 + glu * 128 + (n0 & 127));
        transpose_item(W, fold, K, N, WT, k0, n0, drow0, scr, C.lane);
    }
    for (int row = gw; row < NTOK; row += NGW) {
        const int b = row / LT, t = row % LT;
        f32x4 v[4]; float s = 0.f;
#pragma unroll
        for (int j = 0; j < 4; ++j) {
            const int col = 4 * C.lane + 256 * j;
            if (t < FIRSTV) v[j] = (f32x4){0.f, 0.f, 0.f, 0.f};
            else if (t < LEAD) v[j] = *(const f32x4*)(A.in[IN_META] + (size_t)(t - FIRSTV) * D + col);
            else v[j] = *(const f32x4*)(A.in[IN_X] + ((size_t)b * SEQ + (t - LEAD)) * D + col);
            s += (v[j][0] * v[j][0] + v[j][1] * v[j][1]) + (v[j][2] * v[j][2] + v[j][3] * v[j][3]);
            v2u w; w.x = pk2(v[j][0], v[j][1]); w.y = pk2(v[j][2], v[j][3]);
            *(v2u*)(C.HB() + (size_t)row * D + col) = w;
        }
        s = wave_sum(s);
        if (C.lane < 16) C.SSQ()[(size_t)row * 16 + C.lane] = (C.lane == 0) ? s : 0.f;
    }
    if (C.bid == 0) {
        const int tid = C.tid;
        {
            const float* lg = A.in[IN_LBL];
            const float a0 = lg[tid], a1 = lg[512 + tid], a2 = lg[1024 + tid], a3 = lg[1536 + tid];
            const float mx = fmaxf(fmaxf(a0, a1), fmaxf(a2, a3));
            const float e0 = expf(a0 - mx), e1 = expf(a1 - mx), e2 = expf(a2 - mx), e3 = expf(a3 - mx);
            const float inv = 1.f / (((e0 + e1) + e2) + e3);
            const float p0 = e0 * inv, p1 = e1 * inv, p2 = e2 * inv, p3 = e3 * inv;
            const float c0 = p0, c1 = c0 + p1, c2 = c1 + p2, c3 = c2 + p3;
            C.LB()[tid] = 0.f;
            C.LB()[512 + tid] = fminf(fmaxf(c1 - c0, 0.f), 0.999f);
            C.LB()[1024 + tid] = fminf(fmaxf(c2 - c0, 0.f), 0.999f);
            C.LB()[1536 + tid] = fminf(fmaxf(c3 - c0, 0.f), 0.999f);
        }
        for (int i = tid; i < 4 * 132; i += 512) { const int h = i / 132, d = i % 132; C.BIAST()[i] = (d <= 128) ? A.in[IN_RELB][T5B[d] * 4 + h] : 0.f; }
        if (tid < 4) {
            const float* lv = A.in[IN_LAMBDA] + tid * 256;
            float s01 = 0.f, s23 = 0.f;
            for (int j = 0; j < 64; ++j) { s01 += lv[j] * lv[64 + j]; s23 += lv[128 + j] * lv[192 + j]; }
            const float li = 0.8f - 0.6f * expf(-0.3f * (float)tid);
            C.LAM()[tid * 2] = expf(s01) - expf(s23) + li; C.LAM()[tid * 2 + 1] = li;
        }
        if (tid < 512) { C.SUBLN()[tid] = A.in[IN_SUBLN][tid]; C.HGNW()[tid] = A.in[IN_HGNW][tid]; C.FNORM()[tid] = A.in[IN_FNORM][tid]; C.FNORM()[512 + tid] = A.in[IN_FNORM][512 + tid]; }
        for (int i = tid; i < 2 * 8 * 1024; i += 512) { const int li = i >> 13, e = (i >> 10) & 7, k = i & 1023; C.RF()[i] = A.in[IN_NFFN][(2 * li + 1) * D + k] * A.in[IN_ROUTER][(size_t)li * D * NE + k * NE + e]; }
    }
}

__device__ __forceinline__ void hgrn_naive_unit(Ctx& C, int l, int b, int h) {
    LAS float* qf = (LAS float*)C.lds;
    LAS float* kf = qf + 2048; LAS float* ff = kf + 2048; LAS float* vv = ff + 2048; LAS float* gg = vv + 2048;
    LAS float* opart = gg + 2048;
    const int tid = C.tid, dv = tid & 127, qd = tid >> 7;
    const int ltok = tid >> 5, c4 = (tid & 31) * 4;
    float S[32];
#pragma unroll
    for (int j = 0; j < 32; ++j) S[j] = 0.f;
    const float* nw = C.HGNW() + l * 128;
    for (int tb = 0; tb < LT / 16; ++tb) {
        const size_t row = (size_t)b * LT + tb * 16 + ltok;
        {
            const bf16* pp = C.PROJ() + row * WIN + h * 128 + c4;
            const v2u wq = *(const v2u*)pp, wk = *(const v2u*)(pp + 512), wv = *(const v2u*)(pp + 1024), wg = *(const v2u*)(pp + 1536);
            const f32x4 lf = *(const f32x4*)(C.LOGF() + row * 512 + h * 128 + c4);
            const int o = ltok * 128 + c4;
            qf[o] = bf_lo(wq.x); qf[o + 1] = bf_hi(wq.x); qf[o + 2] = bf_lo(wq.y); qf[o + 3] = bf_hi(wq.y);
            kf[o] = bf_lo(wk.x); kf[o + 1] = bf_hi(wk.x); kf[o + 2] = bf_lo(wk.y); kf[o + 3] = bf_hi(wk.y);
            vv[o] = bf_lo(wv.x); vv[o + 1] = bf_hi(wv.x); vv[o + 2] = bf_lo(wv.y); vv[o + 3] = bf_hi(wv.y);
            gg[o] = bf_lo(wg.x); gg[o + 1] = bf_hi(wg.x); gg[o + 2] = bf_lo(wg.y); gg[o + 3] = bf_hi(wg.y);
            f32x4 lp = (f32x4){0.f, 0.f, 0.f, 0.f};
            if (((tb * 16 + ltok) & 63) != 0) lp = *(const f32x4*)(C.LOGF() + (row - 1) * 512 + h * 128 + c4);
            ff[o] = expf(lf[0] - lp[0]); ff[o + 1] = expf(lf[1] - lp[1]); ff[o + 2] = expf(lf[2] - lp[2]); ff[o + 3] = expf(lf[3] - lp[3]);
        }
        __syncthreads();
        for (int tok = 0; tok < 16; ++tok) {
            const float v = vv[tok * 128 + dv];
            const LAS f32x4* fp = (const LAS f32x4*)(ff + tok * 128 + 32 * qd);
            const LAS f32x4* kp = (const LAS f32x4*)(kf + tok * 128 + 32 * qd);
            const LAS f32x4* qp = (const LAS f32x4*)(qf + tok * 128 + 32 * qd);
            float a = 0.f;
#pragma unroll
            for (int j = 0; j < 8; ++j) {
                const f32x4 f4 = fp[j], k4 = kp[j], q4 = qp[j];
#pragma unroll
                for (int i = 0; i < 4; ++i) { S[4 * j + i] = f4[i] * S[4 * j + i] + k4[i] * v; a += q4[i] * S[4 * j + i]; }
            }
            opart[(tok * 4 + qd) * 128 + dv] = a;
        }
        __syncthreads();
        {
            float o[4]; float ss = 0.f;
#pragma unroll
            for (int i = 0; i < 4; ++i) { o[i] = (opart[(ltok * 4 + 0) * 128 + c4 + i] + opart[(ltok * 4 + 1) * 128 + c4 + i]) + (opart[(ltok * 4 + 2) * 128 + c4 + i] + opart[(ltok * 4 + 3) * 128 + c4 + i]); ss += o[i] * o[i]; }
#pragma unroll
            for (int m = 1; m < 32; m <<= 1) ss += __shfl_xor(ss, m);
            const float rs = rsqrtf(ss * (1.0f / 128.0f) + EPS);
            const int oo = ltok * 128 + c4;
            v2u w; w.x = pk2(o[0] * rs * nw[c4] * gg[oo], o[1] * rs * nw[c4 + 1] * gg[oo + 1]); w.y = pk2(o[2] * rs * nw[c4 + 2] * gg[oo + 2], o[3] * rs * nw[c4 + 3] * gg[oo + 3]);
            *(v2u*)(C.MIX() + row * D + h * 128 + c4) = w;
        }
        __syncthreads();
    }
}
typedef float f32x16 __attribute__((ext_vector_type(16)));
typedef short bf16x8 __attribute__((ext_vector_type(8)));
typedef short s16x4 __attribute__((ext_vector_type(4)));
constexpr float LOG2E = 1.4426950408889634f;
constexpr int AT_K = 0, AT_V = 32768, AT_BIAS = 65536, AT_WSF = 66560, AT_STG = 69632, AT_XCH = 0;
__device__ __forceinline__ int crow(int r, int hi) { return (r & 3) + 8 * (r >> 2) + 4 * hi; }
__device__ __forceinline__ s16x4 vtr(const LAS unsigned char* p) { typedef short v4i16_t __attribute__((ext_vector_type(4))); return __builtin_bit_cast(s16x4, __builtin_amdgcn_ds_read_tr16_b64_v4i16((LAS v4i16_t*)p)); }
__device__ __forceinline__ bf16x8 pack8(const f32x16& p, int b0) {
    v4u w; w.x = pg8::cvt_pk_bf16(p[b0 + 0], p[b0 + 1]); w.y = pg8::cvt_pk_bf16(p[b0 + 2], p[b0 + 3]); w.z = pg8::cvt_pk_bf16(p[b0 + 4], p[b0 + 5]); w.w = pg8::cvt_pk_bf16(p[b0 + 6], p[b0 + 7]);
    return __builtin_bit_cast(bf16x8, w);
}
__device__ __forceinline__ void attn_unit(Ctx& C, int l, int b, int h, int qi) {
    LAS unsigned char* lds = C.lds;
    const int tid = C.tid, lane = C.lane, wave = C.wave, rg = wave >> 1, c = wave & 1, r32 = lane & 31, hi = lane >> 5;
    const size_t rowbase = (size_t)b * LT;
    const bf16* PJ = C.PROJ();
    LAS float* biasl = (LAS float*)(lds + AT_BIAS);
    LAS float* wsf = (LAS float*)(lds + AT_WSF) + wave * 64;
    if (tid < 132) biasl[tid] = C.BIAST()[h * 132 + tid] * LOG2E;
    const float lam = C.LAM()[l * 2], lam_init = C.LAM()[l * 2 + 1];
    const int qw0 = 128 * qi + 32 * rg, tq = qw0 + r32;
    bf16x8 qr[4];
    { const bf16* qp = PJ + (rowbase + tq) * WIN + 2048 + h * 128 + c * 64 + 8 * hi;
#pragma unroll
      for (int ks = 0; ks < 4; ++ks) qr[ks] = *(const bf16x8*)(qp + 16 * ks); }
    const int kkey = tid >> 3, kch = tid & 7;
    const bf16* ksrc = PJ + (rowbase + kkey) * WIN + 2560 + h * 128 + kch * 8;
    const int kdst = kkey * 128 + ((kch ^ ((kkey >> 1) & 7)) * 16);
    const int vkey0 = tid >> 4, vch = tid & 15;
    const bf16* vsrc = PJ + (rowbase + vkey0) * WIN + 3072 + h * 128 + vch * 8;
    const int vdst0 = ((vkey0 >> 3) * 4 + (vch >> 2)) * 512 + (vkey0 & 7) * 64 + (vch & 3) * 16;
    v4u kreg0, kreg1, vreg0, vreg1;
#define AT_LOAD(kt) do { const size_t o_ = (size_t)(kt) * 64 * WIN; kreg0 = *(const v4u*)(ksrc + o_); kreg1 = *(const v4u*)(ksrc + o_ + 64); vreg0 = *(const v4u*)(vsrc + o_); vreg1 = *(const v4u*)(vsrc + o_ + (size_t)32 * WIN); } while (0)
#define AT_STORE(buf) do { *(LAS v4u*)(lds + AT_K + (buf) * 16384 + kdst) = kreg0; *(LAS v4u*)(lds + AT_K + (buf) * 16384 + 8192 + kdst) = kreg1; \
        *(LAS v4u*)(lds + AT_V + (buf) * 16384 + vdst0) = vreg0; *(LAS v4u*)(lds + AT_V + (buf) * 16384 + 8192 + vdst0) = vreg1; } while (0)
    const int nt = 2 * qi + 1;
    AT_LOAD(1); AT_STORE(0);
    __syncthreads();
    f32x16 o[4];
#pragma unroll
    for (int d = 0; d < 4; ++d)
#pragma unroll
        for (int r = 0; r < 16; ++r) o[d][r] = 0.f;
    float mref = -1e30f, lsum = 0.f;
    const int kswz = (r32 >> 1) & 7;
    const int vb = (4 * hi + ((lane & 15) >> 2)) * 64 + ((lane >> 4) & 1) * 32 + (lane & 3) * 8;
    const float b128 = biasl[128];
    for (int it = 0; it < nt; ++it) {
        const int kt = it + 1, buf = it & 1, k0 = 64 * kt;
        if (it + 1 < nt) AT_LOAD(kt + 1);
        if (k0 <= qw0 + 31) {
            const bool near = (k0 + 63 > qw0 - 128) || (kt == 1);
            f32x16 p0, p1;
            { const float ini = near ? 0.f : b128;
#pragma unroll
              for (int r = 0; r < 16; ++r) { p0[r] = ini; p1[r] = ini; } }
            const LAS unsigned char* kb = lds + AT_K + buf * 16384 + c * 8192 + r32 * 128;
#pragma unroll
            for (int ks = 0; ks < 4; ++ks) {
                const int off = ((2 * ks + hi) ^ kswz) * 16;
                const bf16x8 k0f = *(const LAS bf16x8*)(kb + off), k1f = *(const LAS bf16x8*)(kb + 4096 + off);
                p0 = __builtin_amdgcn_mfma_f32_32x32x16_bf16(k0f, qr[ks], p0, 0, 0, 0);
                p1 = __builtin_amdgcn_mfma_f32_32x32x16_bf16(k1f, qr[ks], p1, 0, 0, 0);
            }
            if (near) {
#pragma unroll
                for (int r = 0; r < 16; ++r) {
                    const int tk = k0 + crow(r, hi), d0 = tq - tk, d1 = d0 - 32;
                    const float b0 = biasl[d0 < 0 ? 0 : (d0 > 128 ? 128 : d0)], b1 = biasl[d1 < 0 ? 0 : (d1 > 128 ? 128 : d1)];
                    p0[r] = (d0 < 0 || tk < FIRSTV) ? -INFINITY : p0[r] + b0;
                    p1[r] = (d1 < 0 || tk + 32 < FIRSTV) ? -INFINITY : p1[r] + b1;
                }
            }
            float mx = fmaxf(p0[0], p1[0]);
#pragma unroll
            for (int r = 1; r < 16; ++r) mx = fmaxf(fmaxf(mx, p0[r]), p1[r]);
            mx = fmaxf(mx, __shfl_xor(mx, 32));
            if (__any(mx > mref + 8.0f)) {
                const float mnew = fmaxf(mref, mx), f = __builtin_amdgcn_exp2f(mref - mnew);
                lsum *= f; mref = mnew;
                if (hi == 0) wsf[r32] = f;
                LDS_WAIT(); asm volatile("" ::: "memory");
#pragma unroll
                for (int g = 0; g < 4; ++g) { const f32x4 fv = *(const LAS f32x4*)(wsf + 8 * g + 4 * hi);
#pragma unroll
                    for (int d = 0; d < 4; ++d) { o[d][4 * g + 0] *= fv[0]; o[d][4 * g + 1] *= fv[1]; o[d][4 * g + 2] *= fv[2]; o[d][4 * g + 3] *= fv[3]; } }
            }
            float ps = 0.f;
#pragma unroll
            for (int r = 0; r < 16; ++r) { p0[r] = __builtin_amdgcn_exp2f(p0[r] - mref); p1[r] = __builtin_amdgcn_exp2f(p1[r] - mref); ps += p0[r] + p1[r]; }
            lsum += ps;
            const bf16x8 pa0 = pack8(p0, 0), pa1 = pack8(p0, 8), pa2 = pack8(p1, 0), pa3 = pack8(p1, 8);
            const LAS unsigned char* vp = lds + AT_V + buf * 16384 + vb;
#pragma unroll
            for (int d = 0; d < 4; ++d) {
#define AT_VF(s) ({ const s16x4 lo_ = vtr(vp + (2 * (s)) * 2048 + d * 512), hi_ = vtr(vp + (2 * (s) + 1) * 2048 + d * 512); (bf16x8){lo_[0], lo_[1], lo_[2], lo_[3], hi_[0], hi_[1], hi_[2], hi_[3]}; })
                o[d] = __builtin_amdgcn_mfma_f32_32x32x16_bf16(pa0, AT_VF(0), o[d], 0, 0, 0);
                o[d] = __builtin_amdgcn_mfma_f32_32x32x16_bf16(pa1, AT_VF(1), o[d], 0, 0, 0);
                o[d] = __builtin_amdgcn_mfma_f32_32x32x16_bf16(pa2, AT_VF(2), o[d], 0, 0, 0);
                o[d] = __builtin_amdgcn_mfma_f32_32x32x16_bf16(pa3, AT_VF(3), o[d], 0, 0, 0);
#undef AT_VF
            }
        }
        if (it + 1 < nt) AT_STORE(buf ^ 1);
        __syncthreads();
    }
#undef AT_LOAD
#undef AT_STORE
    lsum += __shfl_xor(lsum, 32);
    { const float inv = lsum > 0.f ? 1.f / lsum : 0.f;
      if (hi == 0) wsf[r32] = inv;
      LDS_WAIT(); asm volatile("" ::: "memory");
#pragma unroll
      for (int g = 0; g < 4; ++g) { const f32x4 fv = *(const LAS f32x4*)(wsf + 8 * g + 4 * hi);
#pragma unroll
          for (int d = 0; d < 4; ++d) { o[d][4 * g + 0] *= fv[0]; o[d][4 * g + 1] *= fv[1]; o[d][4 * g + 2] *= fv[2]; o[d][4 * g + 3] *= fv[3]; } } }
    LAS float* xch = (LAS float*)(lds + AT_XCH) + rg * 4096;
    if (c == 1) {
#pragma unroll
        for (int d = 0; d < 4; ++d)
#pragma unroll
            for (int r = 0; r < 16; ++r) xch[(d * 16 + r) * 64 + lane] = o[d][r];
    }
    __syncthreads();
    if (c == 0) {
        float ss[16];
#pragma unroll
        for (int r = 0; r < 16; ++r) ss[r] = 0.f;
#pragma unroll
        for (int d = 0; d < 4; ++d)
#pragma unroll
            for (int r = 0; r < 16; ++r) { const float a = o[d][r] - lam * xch[(d * 16 + r) * 64 + lane]; o[d][r] = a; ss[r] += a * a; }
#pragma unroll
        for (int r = 0; r < 16; ++r) {
            float s = ss[r];
            s += __shfl_xor(s, 1); s += __shfl_xor(s, 2); s += __shfl_xor(s, 4); s += __shfl_xor(s, 8); s += __shfl_xor(s, 16);
            ss[r] = rsqrtf(s * (1.0f / 128.0f) + EPS) * (1.f - lam_init);
        }
        LAS bf16* stg = (LAS bf16*)(lds + AT_STG) + rg * 4096;
        const float* sw = C.SUBLN() + l * 128 + r32;
#pragma unroll
        for (int d = 0; d < 4; ++d) { const float w = sw[32 * d];
#pragma unroll
            for (int r = 0; r < 16; ++r) stg[crow(r, hi) * 128 + 32 * d + r32] = (bf16)f2bf(o[d][r] * ss[r] * w); }
        LDS_WAIT(); asm volatile("" ::: "memory");
        bf16* op = C.MIX() + (rowbase + qw0) * D + 512 + h * 128;
#pragma unroll
        for (int i = 0; i < 8; ++i) { const int ch = i * 64 + lane, row = ch >> 4, cc = ch & 15; *(v4u*)(op + (size_t)row * D + cc * 8) = *(const LAS v4u*)(stg + row * 128 + cc * 8); }
    }
    __syncthreads();
}
constexpr int HG_QM = 0, HG_KR = 16384, HG_KT = 32768, HG_V = 49152, HG_ST = 65536, HG_XT = 98304, HG_OS = 106496, HG_SQ = 122880, HG_VEC = 123904;
__device__ __forceinline__ bf16x8 tr_frag(const LAS unsigned char* p) { const s16x4 lo = vtr(p), hi4 = vtr(p + 256); return (bf16x8){lo[0], lo[1], lo[2], lo[3], hi4[0], hi4[1], hi4[2], hi4[3]}; }
__device__ __forceinline__ void hgrn_unit(Ctx& C, int l, int b, int h) {
    LAS unsigned char* lds = C.lds;
    const int tid = C.tid, lane = C.lane, wave = C.wave, r32 = lane & 31, hi = lane >> 5;
    const size_t rowbase = (size_t)b * LT;
    const bf16* PJ = C.PROJ() + h * 128; const float* BL = C.LOGF() + h * 128;
    const int c4 = tid & 31, tg = tid >> 5;
    const int dkb = wave >> 1, dvb0 = 2 * (wave & 1);
    const int th = wave >> 2, dvb = wave & 3;
    const int vbq = ((lane & 15) >> 2) * 64 + ((lane >> 4) & 1) * 32 + (lane & 3) * 8;
    LAS float* vec = (LAS float*)(lds + HG_VEC);
    LAS float* sq = (LAS float*)(lds + HG_SQ);
    f32x16 st[2];
#pragma unroll
    for (int j = 0; j < 2; ++j)
#pragma unroll
        for (int r = 0; r < 16; ++r) st[j][r] = 0.f;
    v2u pq[4], pk[4], pv[4]; f32x4 pb[4], pbm;
#define HG_LOAD(ch) do { const size_t r0_ = rowbase + (size_t)(ch) * 64; \
        _Pragma("unroll") for (int i = 0; i < 4; ++i) { const size_t row_ = r0_ + 4 * tg + i; const bf16* p_ = PJ + row_ * WIN + 4 * c4; \
            pq[i] = *(const v2u*)p_; pk[i] = *(const v2u*)(p_ + 512); pv[i] = *(const v2u*)(p_ + 1024); pb[i] = *(const f32x4*)(BL + row_ * 512 + 4 * c4); } \
        pbm = *(const f32x4*)(BL + (r0_ + 31) * 512 + 4 * c4); } while (0)
    HG_LOAD(0);
    const float* nw = C.HGNW() + l * 128;
    for (int ch = 0; ch < LT / 64; ++ch) {
#pragma unroll
        for (int i = 0; i < 4; ++i) {
            const int t = 4 * tg + i;
            float qm[4], km[4];
            const float qv[4] = {bf_lo(pq[i].x), bf_hi(pq[i].x), bf_lo(pq[i].y), bf_hi(pq[i].y)};
            const float kv[4] = {bf_lo(pk[i].x), bf_hi(pk[i].x), bf_lo(pk[i].y), bf_hi(pk[i].y)};
#pragma unroll
            for (int j = 0; j < 4; ++j) { const float x = fminf(fmaxf(pb[i][j] - pbm[j], -80.f), 80.f); qm[j] = qv[j] * __expf(x); km[j] = kv[j] * __expf(-x); }
            const int rsw = (((c4 >> 1) ^ (t & 15)) * 16) + (c4 & 1) * 8;
            *(LAS v2u*)(lds + HG_QM + t * 256 + rsw) = pack4(qm[0], qm[1], qm[2], qm[3]);
            const v2u kmw = pack4(km[0], km[1], km[2], km[3]);
            *(LAS v2u*)(lds + HG_KR + t * 256 + rsw) = kmw;
            const int tso = ((t >> 3) * 4 + (c4 >> 3)) * 512 + (t & 7) * 64 + (c4 & 7) * 8;
            *(LAS v2u*)(lds + HG_KT + tso) = kmw;
            *(LAS v2u*)(lds + HG_V + tso) = pv[i];
            if (t == 31) *(LAS f32x4*)(vec + 4 * c4) = pb[i];
            if (t == 63) *(LAS f32x4*)(vec + 128 + 4 * c4) = pb[i];
        }
        __syncthreads();
        if (ch + 1 < LT / 64) HG_LOAD(ch + 1);
        const v4u g0 = *(const v4u*)(PJ + (rowbase + (size_t)ch * 64 + (tid >> 3)) * WIN + 1536 + 16 * (tid & 7)), g1 = *(const v4u*)(PJ + (rowbase + (size_t)ch * 64 + (tid >> 3)) * WIN + 1536 + 16 * (tid & 7) + 8);
#pragma unroll
        for (int g = 0; g < 4; ++g) {
            const f32x4 bm = *(const LAS f32x4*)(vec + 32 * dkb + 8 * g + 4 * hi);
            const float e0 = __expf(bm[0]), e1 = __expf(bm[1]), e2 = __expf(bm[2]), e3 = __expf(bm[3]);
#pragma unroll
            for (int j = 0; j < 2; ++j) {
                st[j][4 * g + 0] *= e0; st[j][4 * g + 1] *= e1; st[j][4 * g + 2] *= e2; st[j][4 * g + 3] *= e3;
                const int dv = 32 * (dvb0 + j) + r32;
                *(LAS v2u*)(lds + HG_ST + dv * 256 + (((4 * dkb + g) ^ (dv & 15)) * 16) + hi * 8) = pack4(st[j][4 * g + 0], st[j][4 * g + 1], st[j][4 * g + 2], st[j][4 * g + 3]);
            }
        }
        if (wave < 3) {
            const int sb = (wave == 2) ? 1 : 0, tb = (wave == 0) ? 0 : 1;
            const int s = 32 * sb + r32, t = 32 * tb + r32;
            f32x16 x;
#pragma unroll
            for (int r = 0; r < 16; ++r) x[r] = 0.f;
#pragma unroll
            for (int ks = 0; ks < 8; ++ks) {
                const bf16x8 a = *(const LAS bf16x8*)(lds + HG_KR + s * 256 + (((2 * ks + hi) ^ (s & 15)) * 16));
                const bf16x8 bq = *(const LAS bf16x8*)(lds + HG_QM + t * 256 + (((2 * ks + hi) ^ (t & 15)) * 16));
                x = __builtin_amdgcn_mfma_f32_32x32x16_bf16(a, bq, x, 0, 0, 0);
            }
            if (sb == tb) {
#pragma unroll
                for (int r = 0; r < 16; ++r) x[r] = (crow(r, hi) > r32) ? 0.f : x[r];
            }
#pragma unroll
            for (int g = 0; g < 4; ++g)
                *(LAS v2u*)(lds + HG_XT + t * 128 + (((4 * sb + g) ^ ((t >> 1) & 7)) * 16) + hi * 8) = pack4(x[4 * g + 0], x[4 * g + 1], x[4 * g + 2], x[4 * g + 3]);
        }
#pragma unroll
        for (int ks = 0; ks < 4; ++ks) {
            const bf16x8 a = tr_frag(lds + HG_KT + ((2 * ks + hi) * 4 + dkb) * 512 + vbq);
#pragma unroll
            for (int j = 0; j < 2; ++j) {
                const bf16x8 bv = tr_frag(lds + HG_V + ((2 * ks + hi) * 4 + dvb0 + j) * 512 + vbq);
                st[j] = __builtin_amdgcn_mfma_f32_32x32x16_bf16(a, bv, st[j], 0, 0, 0);
            }
        }
#pragma unroll
        for (int g = 0; g < 4; ++g) {
            const f32x4 bm = *(const LAS f32x4*)(vec + 32 * dkb + 8 * g + 4 * hi), be = *(const LAS f32x4*)(vec + 128 + 32 * dkb + 8 * g + 4 * hi);
            const float e0 = __expf(be[0] - bm[0]), e1 = __expf(be[1] - bm[1]), e2 = __expf(be[2] - bm[2]), e3 = __expf(be[3] - bm[3]);
#pragma unroll
            for (int j = 0; j < 2; ++j) { st[j][4 * g + 0] *= e0; st[j][4 * g + 1] *= e1; st[j][4 * g + 2] *= e2; st[j][4 * g + 3] *= e3; }
        }
        __syncthreads();
        {
            const int dv = 32 * dvb + r32, t = 32 * th + r32;
            f32x16 o;
#pragma unroll
            for (int r = 0; r < 16; ++r) o[r] = 0.f;
#pragma unroll
            for (int ks = 0; ks < 8; ++ks) {
                const bf16x8 a = *(const LAS bf16x8*)(lds + HG_ST + dv * 256 + (((2 * ks + hi) ^ (dv & 15)) * 16));
                const bf16x8 bq = *(const LAS bf16x8*)(lds + HG_QM + t * 256 + (((2 * ks + hi) ^ (t & 15)) * 16));
                o = __builtin_amdgcn_mfma_f32_32x32x16_bf16(a, bq, o, 0, 0, 0);
            }
#pragma unroll
            for (int sb = 0; sb < 2; ++sb) {
                if (sb <= th) {
#pragma unroll
                    for (int k2 = 0; k2 < 2; ++k2) {
                        const int kg = 4 * sb + 2 * k2 + hi;
                        const bf16x8 a = tr_frag(lds + HG_V + (kg * 4 + dvb) * 512 + vbq);
                        const bf16x8 bx = *(const LAS bf16x8*)(lds + HG_XT + t * 128 + ((kg ^ ((t >> 1) & 7)) * 16));
                        o = __builtin_amdgcn_mfma_f32_32x32x16_bf16(a, bx, o, 0, 0, 0);
                    }
                }
            }
            float s2 = 0.f;
#pragma unroll
            for (int r = 0; r < 16; ++r) s2 += o[r] * o[r];
            s2 += __shfl_xor(s2, 32);
            if (hi == 0) sq[t * 4 + dvb] = s2;
#pragma unroll
            for (int g = 0; g < 4; ++g)
                *(LAS v2u*)(lds + HG_OS + t * 256 + (((4 * dvb + g) ^ (t & 15)) * 16) + hi * 8) = pack4(o[4 * g + 0], o[4 * g + 1], o[4 * g + 2], o[4 * g + 3]);
        }
        __syncthreads();
        {
            const int t = tid >> 3, seg = tid & 7;
            const size_t row = rowbase + (size_t)ch * 64 + t;
            const f32x4 sv = *(const LAS f32x4*)(sq + t * 4);
            const float rs = rsqrtf(((sv[0] + sv[1]) + (sv[2] + sv[3])) * (1.0f / 128.0f) + EPS);
            const v4u o0 = *(const LAS v4u*)(lds + HG_OS + t * 256 + (((2 * seg) ^ (t & 15)) * 16)), o1 = *(const LAS v4u*)(lds + HG_OS + t * 256 + (((2 * seg + 1) ^ (t & 15)) * 16));
            const f32x4 w0 = *(const f32x4*)(nw + 16 * seg), w1 = *(const f32x4*)(nw + 16 * seg + 4), w2 = *(const f32x4*)(nw + 16 * seg + 8), w3 = *(const f32x4*)(nw + 16 * seg + 12);
            v4u r0, r1;
            r0.x = pk2(bf_lo(o0.x) * rs * w0[0] * bf_lo(g0.x), bf_hi(o0.x) * rs * w0[1] * bf_hi(g0.x)); r0.y = pk2(bf_lo(o0.y) * rs * w0[2] * bf_lo(g0.y), bf_hi(o0.y) * rs * w0[3] * bf_hi(g0.y));
            r0.z = pk2(bf_lo(o0.z) * rs * w1[0] * bf_lo(g0.z), bf_hi(o0.z) * rs * w1[1] * bf_hi(g0.z)); r0.w = pk2(bf_lo(o0.w) * rs * w1[2] * bf_lo(g0.w), bf_hi(o0.w) * rs * w1[3] * bf_hi(g0.w));
            r1.x = pk2(bf_lo(o1.x) * rs * w2[0] * bf_lo(g1.x), bf_hi(o1.x) * rs * w2[1] * bf_hi(g1.x)); r1.y = pk2(bf_lo(o1.y) * rs * w2[2] * bf_lo(g1.y), bf_hi(o1.y) * rs * w2[3] * bf_hi(g1.y));
            r1.z = pk2(bf_lo(o1.z) * rs * w3[0] * bf_lo(g1.z), bf_hi(o1.z) * rs * w3[1] * bf_hi(g1.z)); r1.w = pk2(bf_lo(o1.w) * rs * w3[2] * bf_lo(g1.w), bf_hi(o1.w) * rs * w3[3] * bf_hi(g1.w));
            bf16* op = C.MIX() + row * D + h * 128 + 16 * seg;
            *(v4u*)op = r0; *(v4u*)(op + 8) = r1;
        }
    }
#undef HG_LOAD
    __syncthreads();
}
__device__ __forceinline__ void mixer_phase(Ctx& C, int l) {
    const int NA = C.G - 32;
    if (C.bid < NA) {
        for (int rep = 0; rep < REP_ATT; ++rep)
        for (int k = 0; k * NA < 17 * 32; ++k) {
            const int u = k * NA + ((k & 1) ? (NA - 1 - C.bid) : C.bid);
            if (u < 17 * 32) { const int qi = 16 - u / 32, bh = u % 32; attn_unit(C, l, bh >> 2, bh & 3, qi); }
        }
    } else {
        for (int rep = 0; rep < REP_HG; ++rep) { const int u = C.bid - NA; hgrn_unit(C, l, u >> 2, u & 3); }
    }
}


template <class F> __device__ __forceinline__ void mini_tile(LAS unsigned char* lds, const bf16* A, const bf16* Bt, int K, int r0, int c0, int lane, int wave, const F& epi) {
    const int fr = lane & 15, fq = lane >> 4;
    const int srow = 8 * wave + (lane >> 3), lch = (lane & 7) ^ ((srow >> 1) & 7);
    const bf16* asrc = A + (size_t)(r0 + srow) * K + 8 * lch;
    const bf16* bsrc = Bt + (size_t)(c0 + srow) * K + 8 * lch;
    const int nk = K / 64;
    LAS unsigned char* wbase = lds + wave * 1024;
#define RT_ISSUE(s) do { const int sl_ = ((s) & 7) * 16384; __builtin_amdgcn_global_load_lds((const unsigned*)(asrc + (size_t)(s) * 64), (LAS unsigned*)(wbase + sl_), 16, 0, 0); \
        __builtin_amdgcn_global_load_lds((const unsigned*)(bsrc + (size_t)(s) * 64), (LAS unsigned*)(wbase + sl_ + 8192), 16, 0, 0); } while (0)
#pragma unroll
    for (int s = 0; s < 7; ++s) RT_ISSUE(s);
    f32x4 acc0 = (f32x4){0.f, 0.f, 0.f, 0.f}, acc1 = acc0;
    const int arow = 32 * (wave >> 2) + fr, brow = 16 * (wave & 3) + fr;
    const int asw = (arow >> 1) & 7, bsw = (brow >> 1) & 7;
    for (int s = 0; s < nk; ++s) {
        if (s + 6 < nk) asm volatile("s_waitcnt vmcnt(12)" ::: "memory"); else asm volatile("s_waitcnt vmcnt(0)" ::: "memory");
        __builtin_amdgcn_s_barrier(); asm volatile("" ::: "memory");
        if (s + 7 < nk) RT_ISSUE(s + 7);
        const LAS unsigned char* sa = lds + (s & 7) * 16384; const LAS unsigned char* sb = sa + 8192;
#pragma unroll
        for (int j = 0; j < 2; ++j) {
            const bf16x8 a0 = *(const LAS bf16x8*)(sa + arow * 128 + (((4 * j + fq) ^ asw) * 16)), a1 = *(const LAS bf16x8*)(sa + (arow + 16) * 128 + (((4 * j + fq) ^ asw) * 16));
            const bf16x8 b = *(const LAS bf16x8*)(sb + brow * 128 + (((4 * j + fq) ^ bsw) * 16));
            acc0 = __builtin_amdgcn_mfma_f32_16x16x32_bf16(b, a0, acc0, 0, 0, 0); acc1 = __builtin_amdgcn_mfma_f32_16x16x32_bf16(b, a1, acc1, 0, 0, 0);
        }
    }
#undef RT_ISSUE
    const int row = r0 + 32 * (wave >> 2) + fr, col = c0 + 16 * (wave & 3) + 4 * fq;
    epi(acc0, acc1, row, col);
    asm volatile("s_waitcnt lgkmcnt(0)" ::: "memory"); __builtin_amdgcn_s_barrier(); asm volatile("" ::: "memory");
}
__device__ __forceinline__ void mini_resid_phase(Ctx& C, const bf16* A, const bf16* Bt, int K, int row_lo) {
    LAS float* red = (LAS float*)(C.lds + RING_BYTES + 2048);
    const int nrb = (NTOK - row_lo) / 64, ntile = nrb * 16;
    bf16* HB = C.HB(); float* SSQ = C.SSQ();
    for (int mt = C.bid; mt < ntile; mt += C.G) {
        const int rb = mt >> 4, cb = mt & 15, r0 = row_lo + 64 * rb, c0 = 64 * cb;
        const int lane = C.lane, wave = C.wave;
        mini_tile(C.lds, A, Bt, K, r0, c0, lane, wave, [&](const f32x4& x0, const f32x4& x1, int row, int col) {
            bf16* hp = HB + (size_t)row * D + col;
            const f32x4 h0 = bf4(*(const v2u*)hp) + x0, h1 = bf4(*(const v2u*)(hp + (size_t)16 * D)) + x1;
            *(v2u*)hp = pack4(h0[0], h0[1], h0[2], h0[3]); *(v2u*)(hp + (size_t)16 * D) = pack4(h1[0], h1[1], h1[2], h1[3]);
            float s0 = (h0[0] * h0[0] + h0[1] * h0[1]) + (h0[2] * h0[2] + h0[3] * h0[3]), s1 = (h1[0] * h1[0] + h1[1] * h1[1]) + (h1[2] * h1[2] + h1[3] * h1[3]);
            s0 += __shfl_xor(s0, 16); s0 += __shfl_xor(s0, 32); s1 += __shfl_xor(s1, 16); s1 += __shfl_xor(s1, 32);
            if ((lane >> 4) == 0) { red[(row - r0) * 4 + (wave & 3)] = s0; red[(row - r0 + 16) * 4 + (wave & 3)] = s1; }
        });
        __syncthreads();
        if (C.tid < 64) { const f32x4 p = *(const LAS f32x4*)(red + C.tid * 4); SSQ[(size_t)(r0 + C.tid) * 16 + cb] = (p[0] + p[1]) + (p[2] + p[3]); }
        __syncthreads();
    }
}
__device__ __forceinline__ void mini_y_phase(Ctx& C, const bf16* A, const bf16* Bt, size_t bstride_el, int K, int plim, int pend, int p1, int p2, int p3, int p4, int p5, int p6, int p7) {
    const int ntile = (pend - plim) * 4 * 16;
    bf16* Y = C.Y();
    for (int mt = C.bid; mt < ntile; mt += C.G) {
        const int rb = mt >> 4, cb = mt & 15, pm = plim + (rb >> 2), r0 = plim * 256 + 64 * rb, c0 = 64 * cb;
        const int e = (pm >= p1) + (pm >= p2) + (pm >= p3) + (pm >= p4) + (pm >= p5) + (pm >= p6) + (pm >= p7);
        mini_tile(C.lds, A, Bt + (size_t)e * bstride_el, K, r0, c0, C.lane, C.wave, [&](const f32x4& x0, const f32x4& x1, int row, int col) {
            *(v2u*)(Y + (size_t)row * D + col) = pack4(x0[0], x0[1], x0[2], x0[3]); *(v2u*)(Y + (size_t)(row + 16) * D + col) = pack4(x1[0], x1[1], x1[2], x1[3]);
        });
    }
}

constexpr int RMAX = 128;
__device__ __forceinline__ void route_phase(Ctx& C, int li) {
    LAS float* rf = (LAS float*)C.lds;
    LAS int* lcnt = (LAS int*)(C.lds + 32768);
    LAS int* lbase = lcnt + 8;
    LAS int* ti = lbase + 8;
    LAS float* tf = (LAS float*)(ti + RMAX * 4);
    const int tid = C.tid, lane = C.lane;
    for (int i = tid; i < 8192; i += 512) rf[i] = C.RF()[li * 8192 + i];
    if (tid < 8) lcnt[tid] = 0;
    __syncthreads();
    const int nrows = (NTOK - C.bid + C.G - 1) / C.G;
    for (int k = C.wave; k < nrows; k += 8) {
        const size_t row = (size_t)C.bid + (size_t)k * C.G;
        if ((int)(row % LT) < FIRSTV) { if (lane == 0) ti[k * 4] = -1; continue; }
        f32x4 v[4]; float ss = 0.f;
#pragma unroll
        for (int j = 0; j < 4; ++j) { v[j] = bf4(*(const v2u*)(C.HB() + row * D + 4 * lane + 256 * j)); ss += (v[j][0] * v[j][0] + v[j][1] * v[j][1]) + (v[j][2] * v[j][2] + v[j][3] * v[j][3]); }
        ss = wave_sum(ss);
        const float rstd = rsqrtf(ss * (1.0f / 1024.0f) + EPS);
        float lg[8];
#pragma unroll
        for (int e = 0; e < 8; ++e) {
            float p = 0.f;
#pragma unroll
            for (int j = 0; j < 4; ++j) { const f32x4 w = *(const LAS f32x4*)(rf + e * 1024 + 4 * lane + 256 * j); p += (v[j][0] * w[0] + v[j][1] * w[1]) + (v[j][2] * w[2] + v[j][3] * w[3]); }
            lg[e] = wave_sum(p) * rstd;
        }
        int e1 = 0; float l1 = lg[0];
#pragma unroll
        for (int e = 1; e < 8; ++e) if (lg[e] > l1) { l1 = lg[e]; e1 = e; }
        int e2 = -1; float l2 = -3.0e38f;
#pragma unroll
        for (int e = 0; e < 8; ++e) if (e != e1 && lg[e] > l2) { l2 = lg[e]; e2 = e; }
        const float g1 = 1.f / (1.f + expf(l2 - l1)), g2 = 1.f - g1;
        if (lane == 0) {
            const int lr1 = __hip_atomic_fetch_add(&lcnt[e1], 1, __ATOMIC_RELAXED, __HIP_MEMORY_SCOPE_WORKGROUP), lr2 = __hip_atomic_fetch_add(&lcnt[e2], 1, __ATOMIC_RELAXED, __HIP_MEMORY_SCOPE_WORKGROUP);
            ti[k * 4 + 0] = e1; ti[k * 4 + 1] = e2; ti[k * 4 + 2] = lr1; ti[k * 4 + 3] = lr2;
            tf[k * 4 + 0] = g1; tf[k * 4 + 1] = g2; tf[k * 4 + 2] = rstd;
        }
    }
    __syncthreads();
    if (tid < 8) lbase[tid] = (int)__hip_atomic_fetch_add(C.ctl() + CW_CNT + (li * 8 + tid) * 64, (unsigned)lcnt[tid], RLX_AGENT);
    __syncthreads();
    for (int k = tid; k < nrows; k += 512) {
        const int row = C.bid + k * C.G;
        if (ti[k * 4] < 0) continue;
        const int e1 = ti[k * 4], e2 = ti[k * 4 + 1], r1 = lbase[e1] + ti[k * 4 + 2], r2 = lbase[e2] + ti[k * 4 + 3];
        C.LIST()[(size_t)e1 * NTOK + r1] = row; C.LIST()[(size_t)e2 * NTOK + r2] = row;
        unsigned* inf = C.TINFO() + (size_t)row * 8;
        inf[0] = (unsigned)e1; inf[1] = (unsigned)e2; inf[2] = (unsigned)r1; inf[3] = (unsigned)r2; inf[4] = __builtin_bit_cast(unsigned, tf[k * 4]); inf[5] = __builtin_bit_cast(unsigned, tf[k * 4 + 1]);
        C.RSTD()[row] = tf[k * 4 + 2];
    }
    __syncthreads();
}
__device__ __forceinline__ void load_panels(Ctx& C, int li, LAS int* pst) {
    __syncthreads();
    if (C.tid == 0) { int acc = 0;
        for (int e = 0; e < 8; ++e) { const int c = (int)__hip_atomic_load(C.ctl() + CW_CNT + (li * 8 + e) * 64, RLX_AGENT); pst[e] = acc; pst[16 + e] = c; acc += (c + 255) >> 8; }
        pst[8] = acc; }
    __syncthreads();
}
__device__ __forceinline__ void gather_phase(Ctx& C, int li) {
    LAS int* pst = (LAS int*)C.lds;
    load_panels(C, li, pst);
    const int gw = C.bid * 8 + C.wave, NGW = C.G * 8, lane = C.lane;
    const int nslot = pst[8] * 256;
    for (int s = gw; s < nslot; s += NGW) {
        const int panel = s >> 8; int e = 0;
#pragma unroll
        for (int j = 1; j < 8; ++j) if (panel >= pst[j]) e = j;
        const int rank = s - pst[e] * 256;
        bf16* xp = C.XG() + (size_t)s * D;
        if (rank < pst[16 + e]) {
            const int tok = C.LIST()[(size_t)e * NTOK + rank]; const float r = C.RSTD()[tok];
#pragma unroll
            for (int j = 0; j < 4; ++j) { const f32x4 v = bf4(*(const v2u*)(C.HB() + (size_t)tok * D + 4 * lane + 256 * j)); v2u w; w.x = pk2(v[0] * r, v[1] * r); w.y = pk2(v[2] * r, v[3] * r); *(v2u*)(xp + 4 * lane + 256 * j) = w; }
        } else {
#pragma unroll
            for (int j = 0; j < 4; ++j) *(v2u*)(xp + 4 * lane + 256 * j) = (v2u){0u, 0u};
        }
    }
}
__device__ __forceinline__ void combine_phase(Ctx& C, int li, bool last) {
    LAS int* pst = (LAS int*)C.lds;
    load_panels(C, li, pst);
    const int gw = C.bid * 8 + C.wave, NGW = C.G * 8, lane = C.lane;
    for (int row = gw; row < NTOK; row += NGW) {
        if ((row % LT) < FIRSTV) continue;
        const unsigned* inf = C.TINFO() + (size_t)row * 8;
        const int e1 = (int)inf[0], e2 = (int)inf[1];
        const size_t s1 = (size_t)pst[e1] * 256 + inf[2], s2 = (size_t)pst[e2] * 256 + inf[3];
        const float g1 = __builtin_bit_cast(float, inf[4]), g2 = __builtin_bit_cast(float, inf[5]);
        f32x4 v[4]; float ss = 0.f;
#pragma unroll
        for (int j = 0; j < 4; ++j) {
            const int col = 4 * lane + 256 * j;
            v[j] = bf4(*(const v2u*)(C.HB() + (size_t)row * D + col));
            const v2u a = *(const v2u*)(C.Y() + s1 * D + col), b = *(const v2u*)(C.Y() + s2 * D + col);
            v[j][0] += g1 * bf_lo(a.x) + g2 * bf_lo(b.x); v[j][1] += g1 * bf_hi(a.x) + g2 * bf_hi(b.x);
            v[j][2] += g1 * bf_lo(a.y) + g2 * bf_lo(b.y); v[j][3] += g1 * bf_hi(a.y) + g2 * bf_hi(b.y);
            ss += (v[j][0] * v[j][0] + v[j][1] * v[j][1]) + (v[j][2] * v[j][2] + v[j][3] * v[j][3]);
        }
        ss = wave_sum(ss);
        if (!last) {
#pragma unroll
            for (int j = 0; j < 4; ++j) { const int col = 4 * lane + 256 * j; v2u w; w.x = pk2(v[j][0], v[j][1]); w.y = pk2(v[j][2], v[j][3]); *(v2u*)(C.HB() + (size_t)row * D + col) = w; }
            if (lane < 16) C.SSQ()[(size_t)row * 16 + lane] = (lane == 0) ? ss : 0.f;
        } else {
            const int b = row / LT, t = row % LT;
            if (t >= LEAD) {
                const float rs = rsqrtf(ss * (1.0f / 1024.0f) + EPS);
#pragma unroll
                for (int j = 0; j < 4; ++j) { const int col = 4 * lane + 256 * j; const f32x4 fw = *(const f32x4*)(C.FNORM() + col);
                    *(f32x4*)(C.out + ((size_t)b * SEQ + (t - LEAD)) * D + col) = (f32x4){v[j][0] * rs * fw[0], v[j][1] * rs * fw[1], v[j][2] * rs * fw[2], v[j][3] * rs * fw[3]}; }
            }
        }
    }
}

__global__ void __launch_bounds__(512, 2) mk_fwd(Args args) {
    extern __shared__ __attribute__((aligned(16))) unsigned char lds[];
    Ctx C;
    C.lds = (LAS unsigned char*)lds;
    C.tid = threadIdx.x; C.lane = C.tid & 63; C.wave = __builtin_amdgcn_readfirstlane(C.tid >> 6); C.G = gridDim.x; C.bid = blockIdx.x;
    unsigned char* ws = args.ws; C.ws = ws; C.out = args.out;
    volatile LAS unsigned* MISC = (volatile LAS unsigned*)(C.lds + MISC_OFF);
    for (int u = C.tid; u < (LDS_BYTES - RING_BYTES) / 4; u += 512) ((LAS unsigned*)(C.lds + RING_BYTES))[u] = 0u;
    __syncthreads();
    const int lo = args.ph_lo, hi = args.ph_hi;
    const bool multi = (hi - lo) > 1;
    XcdBarrier bar; bar.bar = (unsigned*)(C.ctl() + CW_BAR); bar.x = 0; bar.st = nullptr;
    if (multi) bar = xcd_barrier_post((unsigned*)(C.ctl() + CW_BAR), MISC + 8);
#define PHASE_CTX(P) Ctx P = C; { GAS unsigned char* w_ = (GAS unsigned char*)C.ws; asm volatile("" : "+s"(w_)); P.ws = (unsigned char*)w_;     int t_ = C.tid; asm volatile("" : "+v"(t_)); P.tid = t_; P.lane = t_ & 63; P.wave = __builtin_amdgcn_readfirstlane(t_ >> 6); int g_ = C.G, b_ = C.bid; asm volatile("" : "+s"(g_), "+s"(b_)); P.G = g_; P.bid = b_; }
#define IN(k) (lo_l <= (k) && (k) < hi_l)
#define SEAM(k) do { if ((k) + 1 < hi_l) { xcd_barrier(bar); if (PROBE_XBAR) xcd_barrier(bar); } } while (0)

    { int lo_l = lo, hi_l = hi; asm volatile("" : "+s"(lo_l), "+s"(hi_l));
      if (IN(0)) { for (int rep = 0; rep < REP_PRO; ++rep) { PHASE_CTX(P); prologue_phase(P, args); SEAM(0); } } }

    for (int l = 0; l < DEPTH; ++l) {
        int lo_l = lo, hi_l = hi; asm volatile("" : "+s"(lo_l), "+s"(hi_l));
        const int pb = 1 + 8 * l, li = l >> 1; const bool moe = (l & 1) != 0;
        if (PROBE_PROJ_NOEPI && IN(pb + 0)) {
            PHASE_CTX(P);
            pg8::Gemm g{P.HB(), (const bf16*)(P.ws + WS_WIN) + (size_t)l * WIN * D, NTOK, WIN, D, 0};
            pg8::StaticOrder S; S.init(NTOK, WIN, P.G, P.bid);
            EpiNone E{(unsigned*)(P.ws + WS_CTL) + 64};
            pg8::gemm_phase<EpiNone, pg8::StaticOrder, true, true>(P.lds, g, S, E);
            SEAM(pb + 0);
        }
        if (PROBE_WOUT_NOEPI && IN(pb + 2)) {
            PHASE_CTX(P);
            pg8::Gemm g{P.HB(), (const bf16*)(P.ws + WS_WOUT) + (size_t)l * D * D, NTOK, D, D, 0};
            pg8::StaticOrder S; S.init(NTOK, D, P.G, P.bid);
            EpiNone E{(unsigned*)(P.ws + WS_CTL) + 64};
            pg8::gemm_phase<EpiNone, pg8::StaticOrder, true, true>(P.lds, g, S, E);
            SEAM(pb + 0);
        }
        if (PROBE_FF2_NOEPI && IN(pb + 2)) {
            PHASE_CTX(P);
            pg8::Gemm g{(const bf16*)(P.ws + WS_WD13), (const bf16*)(P.ws + WS_WD2) + (size_t)li * D * FFD, NTOK, D, FFD, 0};
            pg8::StaticOrder S; S.init(NTOK, D, P.G, P.bid);
            EpiNone E{(unsigned*)(P.ws + WS_CTL) + 64};
            pg8::gemm_phase<EpiNone, pg8::StaticOrder, true, true>(P.lds, g, S, E);
            SEAM(pb + 0);
        }
        if (IN(pb + 0)) for (int rep = 0; rep < REP_PROJ; ++rep) {
            PHASE_CTX(P);
            pg8::Gemm g{P.HB(), (const bf16*)(P.ws + WS_WIN) + (size_t)l * WIN * D, NTOK, WIN, D, 0};
            pg8::StaticOrder S; S.init(NTOK, WIN, P.G, P.bid);
            rstd_table(P.lds, P.SSQ(), S, P.tid);
            EpiProj E{P.PROJ(), P.LOGF(), (const LAS float*)(P.lds + RS_OFF), P.LB() + l * 512};
            pg8::gemm_phase<EpiProj, pg8::StaticOrder, true, true>(P.lds, g, S, E);
            SEAM(pb + 0);
        }
        if (IN(pb + 1)) for (int rep = 0; rep < REP_MIX; ++rep) { PHASE_CTX(P); mixer_phase(P, l); SEAM(pb + 1); }
        if (IN(pb + 2)) {
            PHASE_CTX(P);
            pg8::Gemm g{P.MIX(), (const bf16*)(P.ws + WS_WOUT) + (size_t)l * D * D, NTOK, D, D, 0};
            pg8::StaticOrder S; S.init(MAINROWS, D, P.G, P.bid);
            EpiResid E{P.HB(), P.SSQ()};
            pg8::gemm_phase<EpiResid, pg8::StaticOrder, true, true>(P.lds, g, S, E);
            mini_resid_phase(P, g.A, g.Bt, D, MAINROWS);
            SEAM(pb + 2);
        }
        if (!moe) {
            if (IN(pb + 5)) for (int rep = 0; rep < REP_FF1; ++rep) {
                PHASE_CTX(P);
                pg8::Gemm g{P.HB(), (const bf16*)(P.ws + WS_WD13) + (size_t)li * 2 * FFD * D, NTOK, 2 * FFD, D, 0};
                pg8::StaticOrder S; S.init(NTOK, 2 * FFD, P.G, P.bid);
                rstd_table(P.lds, P.SSQ(), S, P.tid);
                EpiGLU E{P.T(), FFD, (const LAS float*)(P.lds + RS_OFF)};
                pg8::gemm_phase<EpiGLU, pg8::StaticOrder, true, true>(P.lds, g, S, E);
                SEAM(pb + 5);
            }
            if (IN(pb + 6)) {
                PHASE_CTX(P);
                pg8::Gemm g{P.T(), (const bf16*)(P.ws + WS_WD2) + (size_t)li * D * FFD, NTOK, D, FFD, 0};
                pg8::StaticOrder S; S.init(MAINROWS, D, P.G, P.bid);
                EpiResid E{P.HB(), P.SSQ()};
                pg8::gemm_phase<EpiResid, pg8::StaticOrder, true, true>(P.lds, g, S, E);
                mini_resid_phase(P, g.A, g.Bt, FFD, MAINROWS);
                SEAM(pb + 6);
            }
        } else {
            if (IN(pb + 3)) { PHASE_CTX(P); route_phase(P, li); SEAM(pb + 3); }
            if (IN(pb + 4)) for (int rep = 0; rep < REP_GATHER; ++rep) { PHASE_CTX(P); gather_phase(P, li); SEAM(pb + 4); }
            if (IN(pb + 5)) for (int rep = 0; rep < REP_FF1; ++rep) {
                PHASE_CTX(P);
                LAS int* pst = (LAS int*)(P.lds + RING_BYTES + 1024);
                load_panels(P, li, pst);
#define PS(i) __builtin_amdgcn_readfirstlane(pst[i])
                pg8::GroupedOrder S{PS(0), PS(1), PS(2), PS(3), PS(4), PS(5), PS(6), PS(7), PS(8), 2 * FFE / 256, P.G, P.bid};
                pg8::Gemm g{P.XG(), (const bf16*)(P.ws + WS_WM13) + (size_t)li * 8 * 2 * FFE * D, 0, 2 * FFE, D, (size_t)2 * FFE * D * 2};
                EpiGLU E{P.T(), FFE, nullptr};
                pg8::gemm_phase<EpiGLU, pg8::GroupedOrder, true, true>(P.lds, g, S, E);
                SEAM(pb + 5);
            }
            if (IN(pb + 6)) {
                PHASE_CTX(P);
                LAS int* pst = (LAS int*)(P.lds + RING_BYTES + 1024);
                load_panels(P, li, pst);
                const int ptot = PS(8), pfull = (ptot / 64) * 64, plim = (ptot - pfull <= 32) ? pfull : ptot;
                pg8::GroupedPanelOrder S{PS(1), PS(2), PS(3), PS(4), PS(5), PS(6), PS(7), plim, D / 256, P.G, P.bid};
                pg8::Gemm g{P.T(), (const bf16*)(P.ws + WS_WM2) + (size_t)li * 8 * D * FFE, 0, D, FFE, (size_t)D * FFE * 2};
                EpiY E{P.Y()};
                pg8::gemm_phase<EpiY, pg8::GroupedPanelOrder, true, true>(P.lds, g, S, E);
                mini_y_phase(P, g.A, g.Bt, (size_t)D * FFE, FFE, plim, ptot, PS(1), PS(2), PS(3), PS(4), PS(5), PS(6), PS(7));
                SEAM(pb + 6);
            }
#undef PS
            if (IN(pb + 7)) { PHASE_CTX(P); combine_phase(P, li, l == DEPTH - 1); SEAM(pb + 7); }
        }
    }
#undef IN
#undef SEAM
#undef PHASE_CTX
}

extern "C" void kernel_launch(void* const* d_in, const int* in_sizes, int n_in, void* d_out, int out_size, void* d_ws, size_t ws_size, hipStream_t stream) {
    static int grid = 0;
    if (grid == 0) {
        if (n_in != 19 || out_size != NB * SEQ * D || ws_size < WS_END) { fprintf(stderr, "kernel_launch: unexpected shapes (n_in %d, out %d, ws %zu < %zu); nothing launched\n", n_in, out_size, ws_size, (size_t)WS_END); grid = -1; return; }
        int dev = 0, cus = 0, per_cu = 0;
        if (hipGetDevice(&dev) != hipSuccess || hipDeviceGetAttribute(&cus, hipDeviceAttributeMultiprocessorCount, dev) != hipSuccess) { grid = -1; return; }
        if (hipFuncSetAttribute((const void*)mk_fwd, hipFuncAttributeMaxDynamicSharedMemorySize, LDS_BYTES) != hipSuccess) { fprintf(stderr, "kernel_launch: hipFuncSetAttribute failed\n"); grid = -1; return; }
        if (hipOccupancyMaxActiveBlocksPerMultiprocessor(&per_cu, (const void*)mk_fwd, 512, LDS_BYTES) != hipSuccess || per_cu < 1) { fprintf(stderr, "kernel_launch: occupancy query says %d blocks per CU\n", per_cu); }
        (void)hipGetLastError();
        grid = cus;
    }
    if (grid < 0) return;
    if (hipMemsetAsync((char*)d_ws + WS_CTL, 0, CTL_ZERO_BYTES, stream) != hipSuccess) return;
    Args a{};
    for (int i = 0; i < 19; ++i) a.in[i] = (const float*)d_in[i];
    a.out = (float*)d_out; a.ws = (unsigned char*)d_ws;
#if MK_ONE_LAUNCH
    a.ph_lo = 0; a.ph_hi = NPHASE;
    hipLaunchKernelGGL(mk_fwd, dim3(grid), dim3(512), LDS_BYTES, stream, a);
#else
    for (int p = 0; p < NPHASE; ++p) {
        if (p > 0) { const int l = (p - 1) / 8, k = (p - 1) % 8; const bool moe = (l & 1) != 0; if (!moe && (k == 3 || k == 4 || k == 7)) continue; }
        a.ph_lo = p; a.ph_hi = p + 1;
        hipLaunchKernelGGL(mk_fwd, dim3(grid), dim3(512), LDS_BYTES, stream, a);
    }
#endif
}
```

```cpp
#include <hip/hip_runtime.h>
#include <cstdio>
#include <cstdint>

#ifndef REP_ATT
#define REP_ATT 1
#endif
#ifndef REP_HG
#define REP_HG 1
#endif
#ifndef PROBE_PROJ_NOEPI
#define PROBE_PROJ_NOEPI 0
#endif
#ifndef PROBE_WOUT_NOEPI
#define PROBE_WOUT_NOEPI 0
#endif
#ifndef PROBE_FF2_NOEPI
#define PROBE_FF2_NOEPI 0
#endif
#ifndef PROBE_XBAR
#define PROBE_XBAR 0
#endif
#ifndef NT_STORES
#define NT_STORES 0
#endif
#ifndef STAG_PROJ
#define STAG_PROJ 0
#endif
#ifndef STAG_FF1D
#define STAG_FF1D 0
#endif
#ifndef STAG_FF1M
#define STAG_FF1M 0
#endif
#ifndef FP8_MOE_MASK
#define FP8_MOE_MASK 3
#endif
#ifndef REP_ROUTE
#define REP_ROUTE 1
#endif
#ifndef REP_COMB
#define REP_COMB 1
#endif
#ifndef COMB_PIPE
#define COMB_PIPE 0
#endif
#ifndef NT_WLOAD
#define NT_WLOAD 1
#endif
#ifndef XOR32_PERMLANE
#define XOR32_PERMLANE 1
#endif
#ifndef WSUM_DPP
#define WSUM_DPP 1
#endif
#ifndef PUSH_GATHER
#define PUSH_GATHER 1
#endif
#ifndef HG_TWO_STAGE
#define HG_TWO_STAGE 0
#endif
#ifndef ATT_V2
#define ATT_V2 0
#endif
#ifndef PRO_MODE
#define PRO_MODE 0
#endif
#ifndef HG_EQ
#define HG_EQ 0
#endif
#if HG_EQ && HG_TWO_STAGE
#error "HG_EQ is wired into the one-stage chain only"
#endif
#ifndef HG_EQ_BOTH
#define HG_EQ_BOTH 0
#endif
#ifndef HG_EQ_CHAIN
#define HG_EQ_CHAIN HG_EQ
#endif
#ifndef HGV_DUP
#define HGV_DUP 0
#endif
#ifndef TD_TILED
#define TD_TILED 0
#endif
#ifndef REP_FF2M
#define REP_FF2M 1
#endif
#ifndef T8_TILED
#define T8_TILED 2
#endif
#ifndef FF1_PROBE
#define FF1_PROBE 0
#endif
#ifndef HG_C4MAP
#define HG_C4MAP 1
#endif
#ifndef HG_DSHAPE
#define HG_DSHAPE 1
#endif
#ifndef HF_MERGE
#define HF_MERGE 1
#endif
#if HF_MERGE && (HG_TWO_STAGE || HG_EQ)
#error "HF_MERGE is wired into the one-stage, non-EQ chain only"
#endif
#ifndef HF_V2
#define HF_V2 1
#endif
#ifndef PROJ_PROBE
#define PROJ_PROBE 0
#endif
#ifndef HGV_PREFILL
#define HGV_PREFILL 0
#endif
#ifndef HGV_MIB
#define HGV_MIB 24
#endif
#ifndef ATT_DRY2
#define ATT_DRY2 0
#endif
#ifndef REP_HGPRE
#define REP_HGPRE 1
#endif
#ifndef PRO_NT_ST
#define PRO_NT_ST 1
#endif
#ifndef PRO_F8_WIDE
#define PRO_F8_WIDE 1
#endif
#ifndef PRO_F8_DOUBLE
#define PRO_F8_DOUBLE 0
#endif
#ifndef REP_PRO
#define REP_PRO 1
#endif
#ifndef REP_PROJ
#define REP_PROJ 1
#endif
#ifndef REP_MIX
#define REP_MIX 1
#endif
#ifndef REP_FF1
#define REP_FF1 1
#endif
#ifndef REP_GATHER
#define REP_GATHER 1
#endif
#ifndef MK_ONE_LAUNCH
#define MK_ONE_LAUNCH 1
#endif
#if PUSH_GATHER && !MK_ONE_LAUNCH
#error "PUSH_GATHER keeps routing records in LDS across the grid barrier: one launch only"
#endif

namespace pg8 {
#define PG8_LAS __attribute__((address_space(3)))
typedef unsigned short bf16_t;
typedef short bf16x8 __attribute__((ext_vector_type(8)));
typedef float f32x4 __attribute__((ext_vector_type(4)));
typedef unsigned u32x4 __attribute__((ext_vector_type(4)));
typedef unsigned u32x2 __attribute__((ext_vector_type(2)));
constexpr int BM = 256, BK = 64, HALF = 128, HTB = HALF * BK * 2  , STAGE_BYTES = 8 * HTB, NXCD = 8, WGM = 8;

__host__ __device__ __forceinline__ int lds_byte(int r, int c) { const int st = (r >> 4) * 2 + (c >> 5), rr = r & 15, cc = c & 31, ob = rr * 64 + cc * 2; return st * 1024 + (ob ^ (((ob >> 9) & 1) << 5)); }
__host__ __device__ __forceinline__ void stage_rc(int b, int& R, int& C) { const int st = b / 1024, sb = b % 1024, swz = sb ^ (((sb >> 9) & 1) << 5); R = (st >> 1) * 16 + swz / 64; C = (st & 1) * 32 + (swz % 64) / 2; }
__host__ __device__ __forceinline__ int perm32(int rho) { const int n = rho >> 4, i = rho & 15; return 8 * (i >> 2) + 4 * n + (i & 3); }

struct Unit { int pm, pn, e, idx; };
struct Gemm { const bf16_t* A; const bf16_t* Bt; int M, N, K; size_t bstride; };

struct StaticOrder {
    int nM, nN, nwg, G, c;
    __host__ __device__ void init(int M, int N, int G_, int c_) { nM = M / BM; nN = N / BM; nwg = nM * nN; G = G_; c = c_; }
    __host__ __device__ bool next(int i, Unit& u) const {
        const long L = (long)i * G + c; if (L >= nwg) return false;
        int wgid = (int)L; { const int q = nwg / NXCD, r = nwg % NXCD, xcd = wgid % NXCD, off = wgid / NXCD; wgid = (xcd < r ? xcd * (q + 1) : r * (q + 1) + (xcd - r) * q) + off; }
        const int nig = WGM * nN, gid = wgid / nig, fm = gid * WGM, gsz = (nM - fm) < WGM ? (nM - fm) : WGM;
        u.pm = fm + ((wgid % nig) % gsz); u.pn = (wgid % nig) / gsz; u.e = 0; u.idx = i; return true;
    }
    __device__ __forceinline__ void a_ready(const Unit&) const {}
    __device__ __forceinline__ void done(const Unit&) const {}
};
struct ProjOrder {
    int c;
    __device__ __forceinline__ bool next(int i, Unit& u) const {
        const int p = i * 256 + c; if (p >= 952) return false;
        u.e = 0; u.idx = i;
        const int h0 = p - 184, h1 = p - 440;
        if (h0 >= 0 && h0 < 68) { const int k = 2 * h0; u.pm = k >> 1; u.pn = 2 + (k & 1); return true; }
        if (h1 >= 0 && h1 < 68) { const int k = 2 * h1 + 1; u.pm = k >> 1; u.pn = 2 + (k & 1); return true; }
        int q = p - (h0 < 0 ? 0 : (h0 > 68 ? 68 : h0)) - (h1 < 0 ? 0 : (h1 > 68 ? 68 : h1));
        q = (q & 7) * 102 + (q >> 3);
        int pm, t;
        if (q < 768) { const int g = q / 96, r = q - g * 96; pm = 8 * g + (r & 7); t = r >> 3; } else { const int r = q - 768; pm = 64 + (r & 3); t = r >> 2; }
        u.pm = pm; u.pn = t < 2 ? t : t + 2; return true;
    }
    __device__ __forceinline__ void a_ready(const Unit&) const {}
    __device__ __forceinline__ void done(const Unit&) const {}
};
struct GroupedPanelOrder {
    int p1, p2, p3, p4, p5, p6, p7, plim, nN, G, c;
    __device__ __forceinline__ bool next(int i, Unit& u) const {
        const int L = i * G + c; if (L >= plim * nN) return false;
        const int pm = L / nN; u.pm = pm; u.pn = L - pm * nN;
        u.e = (pm >= p1) + (pm >= p2) + (pm >= p3) + (pm >= p4) + (pm >= p5) + (pm >= p6) + (pm >= p7); u.idx = i; return true;
    }
    __device__ __forceinline__ void a_ready(const Unit&) const {}
    __device__ __forceinline__ void done(const Unit&) const {}
};
struct GroupedOrder {
    int p0, p1, p2, p3, p4, p5, p6, p7, p8, nN, G, c;
    __device__ __forceinline__ bool next(int i, Unit& u) const {
        const int L = i * G + c; if (L >= p8 * nN) return false;
        int e = 0, ps = 0, pe = p1;
        if (L >= p1 * nN) { e = 1; ps = p1; pe = p2; }
        if (L >= p2 * nN) { e = 2; ps = p2; pe = p3; }
        if (L >= p3 * nN) { e = 3; ps = p3; pe = p4; }
        if (L >= p4 * nN) { e = 4; ps = p4; pe = p5; }
        if (L >= p5 * nN) { e = 5; ps = p5; pe = p6; }
        if (L >= p6 * nN) { e = 6; ps = p6; pe = p7; }
        if (L >= p7 * nN) { e = 7; ps = p7; pe = p8; }
        const int rem = L - ps * nN, R = pe - ps;
        u.e = e; u.pn = rem / R; u.pm = ps + rem % R; u.idx = i; return true;
    }
    __device__ __forceinline__ void a_ready(const Unit&) const {}
    __device__ __forceinline__ void done(const Unit&) const {}
};

__device__ __forceinline__ unsigned cvt_pk_bf16(float lo, float hi) { unsigned r; asm volatile("v_cvt_pk_bf16_f32 %0, %1, %2" : "=v"(r) : "v"(lo), "v"(hi)); return r; }

typedef int i32x4 __attribute__((ext_vector_type(4)));
typedef int i32x8 __attribute__((ext_vector_type(8)));
__device__ __forceinline__ f32x4 mma8(bf16x8 b0, bf16x8 b1, bf16x8 a0, bf16x8 a1, f32x4 c) {
    const i32x8 b = __builtin_shufflevector(__builtin_bit_cast(i32x4, b0), __builtin_bit_cast(i32x4, b1), 0, 1, 2, 3, 4, 5, 6, 7);
    const i32x8 a = __builtin_shufflevector(__builtin_bit_cast(i32x4, a0), __builtin_bit_cast(i32x4, a1), 0, 1, 2, 3, 4, 5, 6, 7);
    return __builtin_amdgcn_mfma_scale_f32_16x16x128_f8f6f4(b, a, c, 0, 0, 0, 0x7f7f7f7f, 0, 0x7f7f7f7f);
}
__device__ __forceinline__ f32x4 mma8v(i32x8 b, i32x8 a, f32x4 c) {
    const int one = 0x7f7f7f7f;
    asm volatile("v_mfma_scale_f32_16x16x128_f8f6f4 %0, %1, %2, %0, %3, %3 op_sel_hi:[0,0,0]" : "+v"(c) : "v"(b), "v"(a), "v"(one));
    return c;
}
template <class Epi, class Sched, bool ALIGN_EPI = false, bool SP2 = false, bool FP8 = false, int ATILE = 0>
__device__ __forceinline__ void gemm_phase(PG8_LAS unsigned char* lds, const Gemm g, const Sched& S, const Epi& E) {
    int tid_l = threadIdx.x; asm volatile("" : "+v"(tid_l));
    const int tid = tid_l, wid = __builtin_amdgcn_readfirstlane(tid >> 6), lane = tid & 63, wr = wid >> 2, wc = wid & 3, fr = lane & 15, fq = lane >> 4;
    const int K = g.K, nt = K / BK;
    unsigned voffA[2], voffB[2];
#pragma unroll
    for (int i = 0; i < 2; ++i) { int R, C; stage_rc(tid * 16 + i * 8192, R, C); const int Rb = Epi::PERM ? ((R & ~31) + perm32(R & 31)) : R;
        voffA[i] = ATILE == 1 ? (unsigned)((R >> 4) * (32 * K) + ((2 * C) >> 5) * 512 + (R & 15) * 32 + ((2 * C) & 31)) : ATILE ? (unsigned)((((2 * C) / ATILE) * 256 + R) * ATILE + ((2 * C) % ATILE)) : (unsigned)(R * K + C) * 2u; voffB[i] = (unsigned)(Rb * K + C) * 2u; }
    const size_t kstep = (size_t)(BK * 2);
    const size_t hstep = (size_t)HALF * K * 2;
    const size_t kstepA = ATILE == 1 ? (size_t)2048 : ATILE ? (size_t)32768 : kstep, hstepA = ATILE == 1 ? hstep : ATILE ? (size_t)(128 * ATILE) : hstep;
    const size_t tstep = 2 * hstep;
    const unsigned ldsw = (unsigned)wid * 1024u;
    const int aoff = lds_byte(wr * 64 + fr, fq * 8), boff = lds_byte(wc * 32 + fr, fq * 8);
#define PG8_SA(b, h) (((b) * 2 + (h)) * HTB)
#define PG8_SB(b, h) ((4 + (b) * 2 + (h)) * HTB)
#define PG8_STAGE(bufoff, gbase, voff) do { _Pragma("unroll") for (int _i = 0; _i < 2; ++_i) \
        __builtin_amdgcn_global_load_lds((const unsigned*)((const char*)(gbase) + (voff)[_i]), (PG8_LAS unsigned*)(lds + (bufoff) + ldsw + _i * 8192), 16, 0, 0); } while (0)
#define PG8_LDA(dst, b, h) do { if constexpr (FP8) { _Pragma("unroll") for (int m = 0; m < 4; ++m) dst##8[m] = __builtin_shufflevector(*(const PG8_LAS i32x4*)(lds + PG8_SA(b, h) + aoff + m * 2048), *(const PG8_LAS i32x4*)(lds + PG8_SA(b, h) + aoff + m * 2048 + 1024), 0, 1, 2, 3, 4, 5, 6, 7); } else { _Pragma("unroll") for (int m = 0; m < 4; ++m) _Pragma("unroll") for (int k = 0; k < 2; ++k) dst[m][k] = *(const PG8_LAS bf16x8*)(lds + PG8_SA(b, h) + aoff + m * 2048 + k * 1024); } } while (0)
#define PG8_LDB(dst, b, h) do { if constexpr (FP8) { _Pragma("unroll") for (int n = 0; n < 2; ++n) dst##8[n] = __builtin_shufflevector(*(const PG8_LAS i32x4*)(lds + PG8_SB(b, h) + boff + n * 2048), *(const PG8_LAS i32x4*)(lds + PG8_SB(b, h) + boff + n * 2048 + 1024), 0, 1, 2, 3, 4, 5, 6, 7); } else { _Pragma("unroll") for (int n = 0; n < 2; ++n) _Pragma("unroll") for (int k = 0; k < 2; ++k) dst[n][k] = *(const PG8_LAS bf16x8*)(lds + PG8_SB(b, h) + boff + n * 2048 + k * 1024); } } while (0)
#define PG8_MMA(ai, bj, At, Bt) do { __builtin_amdgcn_s_setprio(1); _Pragma("unroll") for (int m = 0; m < 4; ++m) _Pragma("unroll") for (int n = 0; n < 2; ++n) { if constexpr (FP8) acc[ai][bj][m][n] = mma8v(Bt##8[n], At##8[m], acc[ai][bj][m][n]); else { _Pragma("unroll") for (int k = 0; k < 2; ++k) \
        acc[ai][bj][m][n] = __builtin_amdgcn_mfma_f32_16x16x32_bf16(Bt[n][k], At[m][k], acc[ai][bj][m][n], 0, 0, 0); } } __builtin_amdgcn_s_setprio(0); } while (0)
#define PG8_WAIT_V(n) asm volatile("s_waitcnt vmcnt(" #n ")" ::: "memory")
#define PG8_WAIT_L(n) asm volatile("s_waitcnt lgkmcnt(" #n ")" ::: "memory")
#define PG8_BAR __builtin_amdgcn_s_barrier()
#define PG8_SCHED __builtin_amdgcn_sched_barrier(0)
    Unit cur, nxt; int ui = 0;
    if (!S.next(0, cur)) return;
    f32x4 acc[2][2][4][2];
#pragma unroll
    for (int a = 0; a < 2; ++a)
#pragma unroll
        for (int b = 0; b < 2; ++b)
#pragma unroll
            for (int m = 0; m < 4; ++m)
#pragma unroll
                for (int n = 0; n < 2; ++n) acc[a][b][m][n] = (f32x4){0.f, 0.f, 0.f, 0.f};
    bf16x8 At[4][2], B0[2][2], B1[2][2]; i32x8 At8[4], B08[2], B18[2];
    const char* cA = (const char*)g.A + (size_t)cur.pm * tstep; const char* cB = (const char*)g.Bt + (size_t)cur.e * g.bstride + (size_t)cur.pn * tstep;
    S.a_ready(cur);
    if constexpr (SP2) {
        PG8_STAGE(PG8_SB(0, 0), cB, voffB); PG8_STAGE(PG8_SB(0, 1), cB + hstep, voffB); PG8_STAGE(PG8_SA(0, 0), cA, voffA); PG8_STAGE(PG8_SA(0, 1), cA + hstepA, voffA);
        if (wr == 1) PG8_BAR;
        PG8_WAIT_V(2); PG8_BAR;
        PG8_STAGE(PG8_SB(1, 0), cB + kstep, voffB); PG8_STAGE(PG8_SA(1, 0), cA + kstepA, voffA); PG8_STAGE(PG8_SB(1, 1), cB + hstep + kstep, voffB);
        PG8_WAIT_V(6); PG8_BAR;
    } else {
        PG8_STAGE(PG8_SB(0, 0), cB, voffB); PG8_STAGE(PG8_SA(0, 0), cA, voffA); PG8_STAGE(PG8_SB(0, 1), cB + hstep, voffB); PG8_STAGE(PG8_SA(0, 1), cA + hstepA, voffA);
        if (wr == 1) PG8_BAR;
        PG8_WAIT_V(4); PG8_BAR;
        PG8_STAGE(PG8_SB(1, 0), cB + kstep, voffB); PG8_STAGE(PG8_SA(1, 0), cA + kstepA, voffA); PG8_STAGE(PG8_SB(1, 1), cB + hstep + kstep, voffB);
        PG8_WAIT_V(6); PG8_BAR;
    }
    for (;;) {
        const bool has_next = S.next(ui + 1, nxt);
        const char* nA = has_next ? (const char*)g.A + (size_t)nxt.pm * tstep : cA; const char* nB = has_next ? (const char*)g.Bt + (size_t)nxt.e * g.bstride + (size_t)nxt.pn * tstep : cB;
        _Pragma("nounroll") for (int t = 0; t < nt; t += 2) {
            const bool last = (t == nt - 2);
            const char* a1 = cA + (size_t)(t + 1) * kstepA;
            const char* a2 = last ? nA : cA + (size_t)(t + 2) * kstepA; const char* b2 = last ? nB : cB + (size_t)(t + 2) * kstep;
            const char* a3 = a2 + kstepA; const char* b3 = b2 + kstep;
            if (last && has_next) S.a_ready(nxt);
            if constexpr (SP2) {
            PG8_LDB(B0, 0, 0); PG8_LDB(B1, 0, 1); PG8_SCHED; PG8_LDA(At, 0, 0); PG8_STAGE(PG8_SA(1, 1), a1 + hstepA, voffA);
            PG8_WAIT_V(8); PG8_WAIT_L(0); PG8_BAR; PG8_MMA(0, 0, At, B0); PG8_MMA(0, 1, At, B1); PG8_BAR; PG8_SCHED;
            PG8_LDA(At, 0, 1); PG8_STAGE(PG8_SB(0, 0), b2, voffB); PG8_STAGE(PG8_SB(0, 1), b2 + hstep, voffB); PG8_STAGE(PG8_SA(0, 0), a2, voffA);
            PG8_WAIT_V(8); PG8_WAIT_L(0); PG8_BAR; PG8_MMA(1, 0, At, B0); PG8_MMA(1, 1, At, B1); PG8_BAR; PG8_SCHED;
            PG8_LDB(B0, 1, 0); PG8_LDB(B1, 1, 1); PG8_SCHED; PG8_LDA(At, 1, 0); PG8_STAGE(PG8_SA(0, 1), a2 + hstepA, voffA);
            PG8_WAIT_V(8); PG8_WAIT_L(0); PG8_BAR; PG8_MMA(0, 0, At, B0); PG8_MMA(0, 1, At, B1); PG8_BAR; PG8_SCHED;
            PG8_LDA(At, 1, 1); PG8_STAGE(PG8_SB(1, 0), b3, voffB); PG8_STAGE(PG8_SB(1, 1), b3 + hstep, voffB); PG8_STAGE(PG8_SA(1, 0), a3, voffA);
            PG8_WAIT_V(8); PG8_WAIT_L(0); PG8_BAR; PG8_MMA(1, 0, At, B0); PG8_MMA(1, 1, At, B1); PG8_BAR; PG8_SCHED;
            } else {
            PG8_LDB(B0, 0, 0); PG8_SCHED; PG8_LDA(At, 0, 0); PG8_STAGE(PG8_SA(1, 1), a1 + hstepA, voffA);
            PG8_WAIT_L(8); PG8_BAR; PG8_WAIT_L(0); PG8_MMA(0, 0, At, B0); PG8_BAR; PG8_SCHED;
            PG8_LDB(B1, 0, 1); PG8_STAGE(PG8_SB(0, 0), b2, voffB);
            PG8_BAR; PG8_WAIT_L(0); PG8_MMA(0, 1, At, B1); PG8_BAR;
            PG8_LDA(At, 0, 1); PG8_STAGE(PG8_SA(0, 0), a2, voffA);
            PG8_BAR; PG8_WAIT_L(0); PG8_MMA(1, 0, At, B0); PG8_BAR; PG8_SCHED;
            PG8_STAGE(PG8_SB(0, 1), b2 + hstep, voffB);
            PG8_WAIT_V(6); PG8_BAR; PG8_MMA(1, 1, At, B1); PG8_BAR;
            PG8_LDB(B0, 1, 0); PG8_SCHED; PG8_LDA(At, 1, 0); PG8_STAGE(PG8_SA(0, 1), a2 + hstepA, voffA);
            PG8_WAIT_L(8); PG8_BAR; PG8_WAIT_L(0); PG8_MMA(0, 0, At, B0); PG8_BAR; PG8_SCHED;
            PG8_LDB(B1, 1, 1); PG8_STAGE(PG8_SB(1, 0), b3, voffB);
            PG8_BAR; PG8_WAIT_L(0); PG8_MMA(0, 1, At, B1); PG8_BAR;
            PG8_LDA(At, 1, 1); PG8_STAGE(PG8_SA(1, 0), a3, voffA);
            PG8_BAR; PG8_WAIT_L(0); PG8_MMA(1, 0, At, B0); PG8_BAR; PG8_SCHED;
            PG8_STAGE(PG8_SB(1, 1), b3 + hstep, voffB);
            PG8_WAIT_V(6); PG8_BAR; PG8_MMA(1, 1, At, B1); PG8_BAR;
            }
        }
        if constexpr (FP8) asm volatile("s_nop 15\n\ts_nop 15" ::: "memory");
        if constexpr (ALIGN_EPI) { if (wr == 0) PG8_BAR; }
        if constexpr (!Epi::AFTER_DRAIN) { E(acc, cur, wr, wc, fr, fq); S.done(cur); }
        if (!has_next) break;
#pragma unroll
        for (int a = 0; a < 2; ++a)
#pragma unroll
            for (int b = 0; b < 2; ++b)
#pragma unroll
                for (int m = 0; m < 4; ++m)
#pragma unroll
                    for (int n = 0; n < 2; ++n) acc[a][b][m][n] = (f32x4){0.f, 0.f, 0.f, 0.f};
        cur = nxt; cA = nA; cB = nB; ++ui;
        if constexpr (ALIGN_EPI) { if (wr == 1) PG8_BAR; }
    }
    PG8_WAIT_V(0);
    if constexpr (!ALIGN_EPI) { if (wr == 0) PG8_BAR; }
    PG8_BAR;
    if constexpr (Epi::AFTER_DRAIN) { E.fused(acc, cur, wr, wc, fr, fq, lds, wid, lane); S.done(cur); }
#undef PG8_SA
#undef PG8_SB
#undef PG8_STAGE
#undef PG8_LDA
#undef PG8_LDB
#undef PG8_MMA
#undef PG8_WAIT_V
#undef PG8_WAIT_L
#undef PG8_BAR
#undef PG8_SCHED
}

}

constexpr int D = 1024, NB = 8, SEQ = 2048, DEPTH = 4, LEAD = 128, FIRSTV = 112, LT = LEAD + SEQ, NTOK = NB * LT;
constexpr int WIN = 3584, FFD = 2816, FFE = 3584, NE = 8, MAXSLOT = 36864;
constexpr float EPS = 1e-6f;
constexpr int NPHASE = 1 + 8 * DEPTH;
constexpr int MAINROWS = (NTOK / (64 * 256)) * (64 * 256);

constexpr size_t MiB = 1u << 20;
constexpr size_t WS_CTL = 0, CTL_ZERO_BYTES = MiB;
constexpr size_t WS_TAB = 1 * MiB;
constexpr size_t WS_WIN = 2 * MiB;
constexpr size_t WS_WOUT = WS_WIN + 28 * MiB;
constexpr size_t WS_WD13 = WS_WOUT + 8 * MiB;
constexpr size_t WS_WD2 = WS_WD13 + 22 * MiB;
constexpr size_t WS_WM13 = WS_WD2 + 11 * MiB;
constexpr size_t WS_WM2 = WS_WM13 + 224 * MiB;
constexpr size_t WS_H = WS_WM2 + 112 * MiB;
constexpr size_t WS_HB = WS_H + 68 * MiB;
constexpr size_t WS_SSQ = WS_HB + 34 * MiB;
constexpr size_t WS_ROUTE = WS_SSQ + 2 * MiB;
constexpr size_t WS_ACT = WS_ROUTE + 2 * MiB;
constexpr size_t WS_XG = WS_ACT + 252 * MiB;
constexpr size_t WS_END = WS_XG + 72 * MiB;
constexpr size_t ACT_PROJ = 0, ACT_LOGF = 119 * MiB, ACT_MIX = 153 * MiB;
constexpr size_t HGV_OFF = (size_t)HGV_MIB * MiB;
constexpr size_t TAB_LB = 0, TAB_BIAS = 8192, TAB_LAM = 12288, TAB_SUBLN = 12544, TAB_HGNW = 14592, TAB_RF = 20480, TAB_FNORM = 20480 + 65536;
constexpr size_t ROUTE_INFO = 0, ROUTE_LIST = 640 * 1024, ROUTE_RSTD = 1280 * 1024;
constexpr int CW_TMO = 0, CW_BAR = 4096, CW_CNT = 8192;

constexpr int RING_BYTES = 131072, MISC_OFF = RING_BYTES + 320, LDS_BYTES = 147456;

#define GAS __attribute__((address_space(1)))
#define LAS __attribute__((address_space(3)))
typedef unsigned short bf16;
typedef unsigned v4u __attribute__((ext_vector_type(4)));
typedef unsigned v2u __attribute__((ext_vector_type(2)));
typedef float f32x4 __attribute__((ext_vector_type(4)));
typedef GAS unsigned gu32;
#define RLX_AGENT __ATOMIC_RELAXED, __HIP_MEMORY_SCOPE_AGENT
#define LDS_WAIT() asm volatile("s_waitcnt lgkmcnt(0)" ::: "memory")
__device__ __forceinline__ unsigned f2bf(float f) { unsigned u = __builtin_bit_cast(unsigned, f); return (u + 0x7fffu + ((u >> 16) & 1u)) >> 16; }
__device__ __forceinline__ unsigned pk2(float lo, float hi) { return pg8::cvt_pk_bf16(lo, hi); }
__device__ __forceinline__ float bf_lo(unsigned w) { return __builtin_bit_cast(float, w << 16); }
__device__ __forceinline__ float bf_hi(unsigned w) { return __builtin_bit_cast(float, w & 0xffff0000u); }
__device__ __forceinline__ f32x4 bf4(v2u w) { return (f32x4){bf_lo(w.x), bf_hi(w.x), bf_lo(w.y), bf_hi(w.y)}; }
template <class V> __device__ __forceinline__ void st_out(V* p, V v) { if (NT_STORES) __builtin_nontemporal_store(v, p); else *p = v; }
__device__ __forceinline__ float sat8(float x) { return __builtin_amdgcn_fmed3f(x, -448.f, 448.f); }
__device__ __forceinline__ unsigned pk_fp8x4(float a, float b, float c, float d) { int w = 0; w = __builtin_amdgcn_cvt_pk_fp8_f32(sat8(a), sat8(b), w, false); w = __builtin_amdgcn_cvt_pk_fp8_f32(sat8(c), sat8(d), w, true); return (unsigned)w; }
__device__ __forceinline__ float silu_f(float x) { return x * __builtin_amdgcn_rcpf(1.f + __expf(-x)); }
template <int N> __device__ __forceinline__ float dpp_row_ror(float x) {
    return __builtin_bit_cast(float, __builtin_amdgcn_update_dpp(0, __builtin_bit_cast(int, x), 0x120 + N, 0xf, 0xf, false));
}
template <int N> __device__ __forceinline__ float dpp_row_shr(float x) {
    return __builtin_bit_cast(float, __builtin_amdgcn_update_dpp(0, __builtin_bit_cast(int, x), 0x110 + N, 0xf, 0xf, true));
}
__device__ __forceinline__ float wave_sum(float v) {
    if (!WSUM_DPP) { _Pragma("unroll") for (int o = 1; o < 64; o <<= 1) v += __shfl_xor(v, o); return v; }
    v += dpp_row_shr<1>(v); v += dpp_row_shr<2>(v); v += dpp_row_shr<4>(v); v += dpp_row_shr<8>(v);
    const int b = __builtin_bit_cast(int, v);
    return (__builtin_bit_cast(float, __builtin_amdgcn_readlane(b, 15)) + __builtin_bit_cast(float, __builtin_amdgcn_readlane(b, 31))) + (__builtin_bit_cast(float, __builtin_amdgcn_readlane(b, 47)) + __builtin_bit_cast(float, __builtin_amdgcn_readlane(b, 63)));
}
__device__ __forceinline__ void swap32(unsigned& a, unsigned& b) { asm volatile("v_nop\n\tv_nop\n\tv_permlane32_swap_b32 %0, %1" : "+v"(a), "+v"(b)); }
__device__ __forceinline__ float xor32_sum(float v) { if (!XOR32_PERMLANE) return v + __shfl_xor(v, 32); unsigned a = __builtin_bit_cast(unsigned, v), b = a; swap32(a, b); return __builtin_bit_cast(float, a) + __builtin_bit_cast(float, b); }
__device__ __forceinline__ float xor32_max(float v) { if (!XOR32_PERMLANE) return fmaxf(v, __shfl_xor(v, 32)); unsigned a = __builtin_bit_cast(unsigned, v), b = a; swap32(a, b); return fmaxf(__builtin_bit_cast(float, a), __builtin_bit_cast(float, b)); }

#define XB_TMO      128
#define XB_XCNT(j)  (256  + 64 * (j))
#define XB_XSUB(j)  (1280 + 64 * (j))
#define XB_XGEN(j)  (2304 + 64 * (j))
#define XB_TOP      3328
#define XB_TOPGEN   3392
#define XCD_BAR_WORDS 3456
#define XB_SPIN_CAP (1u << 18)

__device__ __forceinline__ unsigned xb_ld(unsigned* p)              { return __hip_atomic_load(p, __ATOMIC_RELAXED, __HIP_MEMORY_SCOPE_AGENT); }
__device__ __forceinline__ unsigned xb_add(unsigned* p, unsigned v) { return __hip_atomic_fetch_add(p, v, __ATOMIC_RELAXED, __HIP_MEMORY_SCOPE_AGENT); }
__device__ __forceinline__ unsigned xb_xcc_id() { return (unsigned)__builtin_amdgcn_s_getreg((3 << 11) | 20) & 0xFu; }
#define XB_SPIN(cond, bar) do { unsigned _sp = 0; while (cond) { __builtin_amdgcn_s_sleep(1); \
    if ((++_sp & 255u) == 0u) { if (xb_ld(&(bar)[XB_TMO])) break; if (_sp > XB_SPIN_CAP) { atomicAdd(&(bar)[XB_TMO], 1u); break; } } } } while (0)

struct XcdBarrier {
    unsigned* bar; unsigned x;
    volatile LAS unsigned* st;
};

__device__ __forceinline__ XcdBarrier xcd_barrier_post(unsigned* bar, volatile LAS unsigned* st) {
    XcdBarrier b; b.bar = bar; b.x = xb_xcc_id(); b.st = st;
    if (threadIdx.x == 0) (void)xb_add(&bar[XB_XCNT(b.x)], 1u);
    return b;
}
__device__ __forceinline__ void xcd_barrier_complete(unsigned* bar, unsigned x, unsigned& nloc, unsigned& nx) {
    const unsigned G = gridDim.x * gridDim.y * gridDim.z;
    unsigned sum, cnt, mine, sp = 0u;
    for (;;) {
        sum = 0u; cnt = 0u; mine = 0u;
#pragma unroll
        for (unsigned j = 0; j < 16; ++j) { const unsigned c = xb_ld(&bar[XB_XCNT(j)]); sum += c; cnt += (c > 0u) ? 1u : 0u; mine = (j == x) ? c : mine; }
        if (sum == G) break;
        __builtin_amdgcn_s_sleep(1);
        if ((++sp & 255u) == 0u) { if (xb_ld(&bar[XB_TMO])) break; if (sp > XB_SPIN_CAP) { atomicAdd(&bar[XB_TMO], 1u); break; } }
    }
    nloc = mine > 0u ? mine : 1u; nx = cnt > 0u ? cnt : 1u;
}

__device__ __forceinline__ void xcd_barrier(const XcdBarrier& b) {
    asm volatile("s_waitcnt vmcnt(0)" ::: "memory");
    __syncthreads();
    if (threadIdx.x == 0) {
        unsigned* bar = b.bar;
        __builtin_amdgcn_s_waitcnt(0);
        unsigned nloc = b.st[0], nx = b.st[1];
        if (nloc == 0u) { xcd_barrier_complete(bar, b.x, nloc, nx); b.st[0] = nloc; b.st[1] = nx; }
        const unsigned old = xb_add(&bar[XB_XSUB(b.x)], 1u);
        const unsigned gen = old / nloc;
        if (old + 1u == (gen + 1u) * nloc) {
            __builtin_amdgcn_fence(__ATOMIC_RELEASE, "agent");
            asm volatile("s_waitcnt vmcnt(0)" ::: "memory");
            const unsigned og = xb_add(&bar[XB_TOP], 1u);
            const unsigned tg = og / nx;
            if (og + 1u == (tg + 1u) * nx) xb_add(&bar[XB_TOPGEN], 1u);
            else XB_SPIN(xb_ld(&bar[XB_TOPGEN]) == tg, bar);
            __builtin_amdgcn_fence(__ATOMIC_ACQUIRE, "agent");
            xb_add(&bar[XB_XGEN(b.x)], 1u);
            asm volatile("s_waitcnt vmcnt(0)" ::: "memory");
        } else {
            XB_SPIN(xb_ld(&bar[XB_XGEN(b.x)]) == gen, bar);
            __builtin_amdgcn_fence(__ATOMIC_ACQUIRE, "agent");
            asm volatile("s_waitcnt vmcnt(0)" ::: "memory");
        }
    }
    __syncthreads();
}


static __device__ const unsigned char T5B[129] = {0, 1, 2, 3, 4, 5, 6, 7, 8, 9, 10, 11, 12, 13, 14, 15, 16, 16, 16, 17, 17, 18, 18, 18, 19, 19, 19, 20, 20, 20, 20, 21, 21, 21, 21, 22, 22, 22, 22, 22, 23, 23, 23, 23, 23, 23, 24, 24, 24, 24, 24, 24, 25, 25, 25, 25, 25, 25, 25, 26, 26, 26, 26, 26, 26, 26, 26, 27, 27, 27, 27, 27, 27, 27, 27, 27, 27, 28, 28, 28, 28, 28, 28, 28, 28, 28, 28, 29, 29, 29, 29, 29, 29, 29, 29, 29, 29, 29, 29, 30, 30, 30, 30, 30, 30, 30, 30, 30, 30, 30, 30, 30, 30, 31, 31, 31, 31, 31, 31, 31, 31, 31, 31, 31, 31, 31, 31, 31, 31};

struct Ctx {
    LAS unsigned char* lds;
    int tid, lane, wave, G, bid;
    float* out;
    unsigned char* ws;
    __device__ __forceinline__ gu32* ctl() const { return (gu32*)(ws + WS_CTL); }
    __device__ __forceinline__ bf16* HB() const { return (bf16*)(ws + WS_HB); }
    __device__ __forceinline__ float* SSQ() const { return (float*)(ws + WS_SSQ); }
    __device__ __forceinline__ bf16* PROJ() const { return (bf16*)(ws + WS_ACT + ACT_PROJ); }
    __device__ __forceinline__ float* LOGF() const { return (float*)(ws + WS_ACT + ACT_LOGF); }
    __device__ __forceinline__ bf16* MIX() const { return (bf16*)(ws + WS_ACT + ACT_MIX); }
    __device__ __forceinline__ bf16* T() const { return (bf16*)(ws + WS_ACT); }
    __device__ __forceinline__ bf16* XG() const { return (bf16*)(ws + WS_XG); }
    __device__ __forceinline__ bf16* Y() const { return (bf16*)(ws + WS_XG); }
    __device__ __forceinline__ float* LB() const { return (float*)(ws + WS_TAB + TAB_LB); }
    __device__ __forceinline__ float* BIAST() const { return (float*)(ws + WS_TAB + TAB_BIAS); }
    __device__ __forceinline__ float* LAM() const { return (float*)(ws + WS_TAB + TAB_LAM); }
    __device__ __forceinline__ float* RF() const { return (float*)(ws + WS_TAB + TAB_RF); }
    __device__ __forceinline__ float* SUBLN() const { return (float*)(ws + WS_TAB + TAB_SUBLN); }
    __device__ __forceinline__ float* HGNW() const { return (float*)(ws + WS_TAB + TAB_HGNW); }
    __device__ __forceinline__ float* FNORM() const { return (float*)(ws + WS_TAB + TAB_FNORM); }
    __device__ __forceinline__ unsigned* TINFO() const { return (unsigned*)(ws + WS_ROUTE + ROUTE_INFO); }
    __device__ __forceinline__ int* LIST() const { return (int*)(ws + WS_ROUTE + ROUTE_LIST); }
    __device__ __forceinline__ float* RSTD() const { return (float*)(ws + WS_ROUTE + ROUTE_RSTD); }
};
struct Args { const float* in[19]; float* out; unsigned char* ws; int ph_lo, ph_hi; };
enum { IN_X = 0, IN_META, IN_RELB, IN_NMIX, IN_WIN, IN_LBL, IN_HGNW, IN_LAMBDA, IN_SUBLN, IN_WOUT, IN_NFFN, IN_DW1, IN_DW3, IN_DW2, IN_ROUTER, IN_MW1, IN_MW3, IN_MW2, IN_FNORM };

__device__ __forceinline__ v2u pack4(float a, float b, float c, float d) { v2u w; w.x = pg8::cvt_pk_bf16(a, b); w.y = pg8::cvt_pk_bf16(c, d); return w; }
__device__ __forceinline__ float row_rstd(const float* ssq, int row) {
    const f32x4* p = (const f32x4*)(ssq + (size_t)row * 16);
    const f32x4 a = p[0], b = p[1], c = p[2], d = p[3];
    const float s = ((a[0] + a[1]) + (a[2] + a[3])) + ((b[0] + b[1]) + (b[2] + b[3])) + ((c[0] + c[1]) + (c[2] + c[3])) + ((d[0] + d[1]) + (d[2] + d[3]));
    return rsqrtf(s * (1.0f / 1024.0f) + EPS);
}
constexpr int RS_OFF = RING_BYTES + 4096, RS_MAXU = 12;
template <class Sched> __device__ __forceinline__ void rstd_table(LAS unsigned char* lds, const float* ssq, const Sched& S, int tid) {
    LAS float* rs = (LAS float*)(lds + RS_OFF);
    pg8::Unit u;
    for (int i0 = 0; i0 < RS_MAXU; i0 += 2) {
        const int i = i0 + (tid >> 8);
        if (S.next(i, u)) rs[i * 256 + (tid & 255)] = row_rstd(ssq, u.pm * 256 + (tid & 255));
    }
    __syncthreads();
}
__device__ __forceinline__ void stagger_start(int bid, unsigned quarter_ticks) {
    const unsigned grp = ((unsigned)bid >> 3) & 3u;
    if (grp) { const unsigned long long t0 = __builtin_amdgcn_s_memrealtime(); while ((unsigned)(__builtin_amdgcn_s_memrealtime() - t0) < grp * quarter_ticks) __builtin_amdgcn_s_sleep(16); }
}
struct EpiProj {
    static constexpr bool PERM = true, AFTER_DRAIN = false;
    bf16* proj; float* logfp; const LAS float* rs; const float* lb; const float* hgw; unsigned char* scr2; int mode;
#if HF_MERGE
    template <int AI, int BJ> __device__ __forceinline__ void hf_block8(const pg8::f32x4 (&acc)[2][2][4][2], int row0, int colb, const LAS float* rsu) const {
        const int c0 = colb + BJ * 128, cc = c0 - 512;
        const f32x4 l0 = *(const f32x4*)(lb + cc), l1 = *(const f32x4*)(lb + cc + 4);
        float lf[4][8];
#pragma unroll
        for (int m = 0; m < 4; ++m) {
            const int row = row0 + AI * 128 + m * 16;
            const float rn = rsu[AI * 128 + m * 16] * -1.4426950408889634f;
            const bool valid = (row % LT) >= FIRSTV;
            float kx[8];
#pragma unroll
            for (int j = 0; j < 8; ++j) {
                const float lbv = (j < 4) ? l0[j & 3] : l1[j & 3];
                const float xs = __builtin_amdgcn_fmed3f(acc[AI][BJ][m][j >> 2][j & 3] * rn, -43.280851f, 43.280851f);
                const float te = __builtin_amdgcn_exp2f(xs), sg = __builtin_amdgcn_rcpf(1.f + te);
                float lg2 = __builtin_amdgcn_logf(lbv + (1.f - lbv) * sg);
                float kk = (1.f - lbv) * (te * sg);
                if (!valid) { lg2 = 0.f; kk = 0.f; }
                lf[m][j] = lg2; kx[j] = kk;
            }
            v4u w; w.x = pg8::cvt_pk_bf16(kx[0], kx[1]); w.y = pg8::cvt_pk_bf16(kx[2], kx[3]); w.z = pg8::cvt_pk_bf16(kx[4], kx[5]); w.w = pg8::cvt_pk_bf16(kx[6], kx[7]);
            *(v4u*)(proj + (size_t)row * WIN + c0) = w;
        }
#pragma unroll
        for (int j = 0; j < 8; ++j) {
            float tot[4];
#pragma unroll
            for (int m = 0; m < 4; ++m) {
                float x = lf[m][j], t = x;
                x += dpp_row_shr<1>(x); x += dpp_row_shr<2>(x); x += dpp_row_shr<4>(x); x += dpp_row_shr<8>(x);
                lf[m][j] = x;
                if (m < 3) { t += dpp_row_ror<8>(t); t += dpp_row_ror<4>(t); t += dpp_row_ror<2>(t); t += dpp_row_ror<1>(t); }
                tot[m] = t;
            }
            const float c1 = tot[0], c2 = c1 + tot[1], c3 = c2 + tot[2];
            lf[1][j] += c1; lf[2][j] += c2; lf[3][j] += c3;
        }
#pragma unroll
        for (int m = 0; m < 4; ++m) {
            float* d = logfp + (size_t)(row0 + AI * 128 + m * 16) * 512 + (cc >> 1);
            *(f32x4*)d = (f32x4){lf[m][0], lf[m][1], lf[m][2], lf[m][3]};
            *(f32x4*)(d + 256) = (f32x4){lf[m][4], lf[m][5], lf[m][6], lf[m][7]};
        }
    }
#endif
    template <int AI, int BJ, int NN> __device__ __forceinline__ void hf_block(const pg8::f32x4 (&acc)[2][2][4][2], int row0, int colb, const LAS float* rsu) const {
        const int c0 = colb + BJ * 128 + 4 * NN, cc = c0 - 512;
        const f32x4 l0 = *(const f32x4*)(lb + cc);
        float lf[4][4];
#if HG_EQ
        float kxa[4][4];
#endif
#pragma unroll
        for (int m = 0; m < 4; ++m) {
            const int row = row0 + AI * 128 + m * 16;
            const float r = rsu[AI * 128 + m * 16];
            const bool valid = (row % LT) >= FIRSTV;
            float kx[4];
#pragma unroll
            for (int j = 0; j < 4; ++j) {
                const float lbv = l0[j];
#if HF_V2
                const float xs = __builtin_amdgcn_fmed3f(acc[AI][BJ][m][NN][j] * (r * -1.4426950408889634f), -43.280851f, 43.280851f);
                const float te = __builtin_amdgcn_exp2f(xs), sg = __builtin_amdgcn_rcpf(1.f + te);
                float lg2 = __builtin_amdgcn_logf(lbv + (1.f - lbv) * sg);
                float kk = (1.f - lbv) * (te * sg);
                if (!valid) { lg2 = 0.f; kk = 0.f; }
                lf[m][j] = lg2; kx[j] = kk;
#else
                const float xx = acc[AI][BJ][m][NN][j] * r;
                const float xc = fminf(fmaxf(xx, -30.f), 30.f);
                const float te = __expf(-xc), sg = __builtin_amdgcn_rcpf(1.f + te);
                float lgf = __logf(lbv + (1.f - lbv) * sg);
                float kk = (1.f - lbv) * (te * sg);
                if (!valid) { lgf = 0.f; kk = 0.f; }
                lf[m][j] = lgf * 1.4426950408889634f; kx[j] = kk;
#endif
            }
#if HG_EQ
#pragma unroll
            for (int j = 0; j < 4; ++j) kxa[m][j] = kx[j];
#endif
#if !HG_EQ || HG_EQ_BOTH
            v2u w; w.x = pg8::cvt_pk_bf16(kx[0], kx[1]); w.y = pg8::cvt_pk_bf16(kx[2], kx[3]);
            if (PROJ_PROBE && (mode & 8)) asm volatile("" :: "v"(w.x), "v"(w.y)); else *(v2u*)(proj + (size_t)row * WIN + c0) = w;
#endif
        }
#if HG_EQ
        float bm[4], be[4];
#endif
#if HF_V2
#pragma unroll
        for (int j = 0; j < 4; ++j) {
            float tot[4];
#pragma unroll
            for (int m = 0; m < 4; ++m) {
                float x = lf[m][j], t = x;
                x += dpp_row_shr<1>(x); x += dpp_row_shr<2>(x); x += dpp_row_shr<4>(x); x += dpp_row_shr<8>(x);
                lf[m][j] = x;
                if (m < 3 || HG_EQ) { t += dpp_row_ror<8>(t); t += dpp_row_ror<4>(t); t += dpp_row_ror<2>(t); t += dpp_row_ror<1>(t); }
                tot[m] = t;
            }
            const float c1 = tot[0], c2 = c1 + tot[1], c3 = c2 + tot[2];
            lf[1][j] += c1; lf[2][j] += c2; lf[3][j] += c3;
#if HG_EQ
            bm[j] = c2; be[j] = c3 + tot[3];
#endif
        }
#else
#pragma unroll
        for (int j = 0; j < 4; ++j) {
            float carry = 0.f;
#pragma unroll
            for (int m = 0; m < 4; ++m) {
                float x = lf[m][j];
                x += dpp_row_shr<1>(x); x += dpp_row_shr<2>(x); x += dpp_row_shr<4>(x); x += dpp_row_shr<8>(x);
                x += carry;
                carry = __shfl(x, 15, 16);
                lf[m][j] = x;
#if HG_EQ
                if (m == 1) bm[j] = carry;
                if (m == 3) be[j] = carry;
#endif
            }
        }
#endif
#if HG_EQ
#if HG_EQ_BOTH
        bf16* eqb = (bf16*)scr2; bf16* kmb = (bf16*)(scr2 + 36 * MiB) - c0 + cc; const size_t kmp = 512; float* vgb = (float*)(scr2 + 60 * MiB);
#else
        bf16* eqb = (bf16*)logfp; bf16* kmb = proj; const size_t kmp = WIN; float* vgb = (float*)((unsigned char*)logfp + HGV_OFF);
#endif
#pragma unroll
        for (int m = 0; m < 4; ++m) {
            const int row = row0 + AI * 128 + m * 16;
            float eq[4], km[4];
#pragma unroll
            for (int j = 0; j < 4; ++j) { const float x = __builtin_amdgcn_fmed3f(lf[m][j] - bm[j], -115.f, 115.f); eq[j] = __builtin_amdgcn_exp2f(x); km[j] = kxa[m][j] * __builtin_amdgcn_exp2f(-x); }
            v2u w; w.x = pg8::cvt_pk_bf16(km[0], km[1]); w.y = pg8::cvt_pk_bf16(km[2], km[3]);
            *(v2u*)(kmb + (size_t)row * kmp + c0) = w;
            v2u e; e.x = pg8::cvt_pk_bf16(eq[0], eq[1]); e.y = pg8::cvt_pk_bf16(eq[2], eq[3]);
            *(v2u*)(eqb + (size_t)row * 512 + cc) = e;
        }
        if ((row0 & 15) == 15) {
            float* vg = vgb + (size_t)((row0 + AI * 128) >> 6) * 1024 + cc;
            *(f32x4*)vg = (f32x4){__builtin_amdgcn_exp2f(bm[0]), __builtin_amdgcn_exp2f(bm[1]), __builtin_amdgcn_exp2f(bm[2]), __builtin_amdgcn_exp2f(bm[3])};
            *(f32x4*)(vg + 512) = (f32x4){__builtin_amdgcn_exp2f(be[0] - bm[0]), __builtin_amdgcn_exp2f(be[1] - bm[1]), __builtin_amdgcn_exp2f(be[2] - bm[2]), __builtin_amdgcn_exp2f(be[3] - bm[3])};
#if HGV_DUP
            { float* vg2 = (float*)((unsigned char*)vg + (size_t)(HGV_DUP - HGV_MIB) * MiB); *(f32x4*)vg2 = *(f32x4*)vg; *(f32x4*)(vg2 + 512) = *(f32x4*)(vg + 512); }
#endif
        }
#endif
#if !HG_EQ || HG_EQ_BOTH
#pragma unroll
        for (int m = 0; m < 4; ++m) { if (PROJ_PROBE && (mode & 8)) asm volatile("" :: "v"(lf[m][0]), "v"(lf[m][1]), "v"(lf[m][2]), "v"(lf[m][3])); else *(f32x4*)(logfp + (size_t)(row0 + AI * 128 + m * 16) * 512 + cc) = (f32x4){lf[m][0], lf[m][1], lf[m][2], lf[m][3]}; }
#endif
    }
    __device__ __forceinline__ void operator()(const pg8::f32x4 (&acc)[2][2][4][2], const pg8::Unit& u, int wr, int wc, int fr, int fq) const {
        int grp = u.pn >> 1;
        const int row0 = u.pm * 256 + wr * 64 + fr, colb = u.pn * 256 + wc * 32 + 8 * fq;
        if (PROJ_PROBE && (mode & 4)) { pg8::f32x4 s_ = acc[0][0][0][0];
            _Pragma("unroll") for (int a = 0; a < 2; ++a) _Pragma("unroll") for (int b = 0; b < 2; ++b) _Pragma("unroll") for (int m = 0; m < 4; ++m) _Pragma("unroll") for (int n = 0; n < 2; ++n) s_ = s_ + acc[a][b][m][n];
            if (s_[0] + s_[1] + s_[2] + s_[3] == 1.2345e38f) proj[0] = 0; return; }
        if (PROJ_PROBE && (mode & 2) && grp == 1) grp = 2;
        const LAS float* rsu = rs + u.idx * 256 + wr * 64 + fr;
        if (grp == 1) {
#if HF_MERGE
            hf_block8<0, 0>(acc, row0, colb, rsu); hf_block8<0, 1>(acc, row0, colb, rsu); hf_block8<1, 0>(acc, row0, colb, rsu); hf_block8<1, 1>(acc, row0, colb, rsu);
#else
            hf_block<0, 0, 0>(acc, row0, colb, rsu); hf_block<0, 0, 1>(acc, row0, colb, rsu); hf_block<0, 1, 0>(acc, row0, colb, rsu); hf_block<0, 1, 1>(acc, row0, colb, rsu);
            hf_block<1, 0, 0>(acc, row0, colb, rsu); hf_block<1, 0, 1>(acc, row0, colb, rsu); hf_block<1, 1, 0>(acc, row0, colb, rsu); hf_block<1, 1, 1>(acc, row0, colb, rsu);
#endif
            return;
        }
#pragma unroll
        for (int ai = 0; ai < 2; ++ai)
#pragma unroll
            for (int m = 0; m < 4; ++m) {
                const int row = row0 + ai * 128 + m * 16;
                const float r = rsu[ai * 128 + m * 16];
#pragma unroll
                for (int bj = 0; bj < 2; ++bj) {
                    const int c0 = colb + bj * 128;
                    float x[8];
#pragma unroll
                    for (int j = 0; j < 4; ++j) { x[j] = acc[ai][bj][m][0][j] * r; x[4 + j] = acc[ai][bj][m][1][j] * r; }
                    if (grp == 0) {
#pragma unroll
                        for (int j = 0; j < 8; ++j) x[j] = silu_f(x[j]);
                    } else if (grp == 3) {
                        const f32x4 g0 = *(const f32x4*)(hgw + (c0 & 127)), g1 = *(const f32x4*)(hgw + (c0 & 127) + 4);
#pragma unroll
                        for (int j = 0; j < 4; ++j) { x[j] = silu_f(x[j]) * g0[j]; x[4 + j] = silu_f(x[4 + j]) * g1[j]; }
                    } else if (grp == 4) {
#pragma unroll
                        for (int j = 0; j < 8; ++j) x[j] *= 0.18033688011112042f;
                    }
                    v4u w; w.x = pg8::cvt_pk_bf16(x[0], x[1]); w.y = pg8::cvt_pk_bf16(x[2], x[3]); w.z = pg8::cvt_pk_bf16(x[4], x[5]); w.w = pg8::cvt_pk_bf16(x[6], x[7]);
                    if (PROJ_PROBE && (mode & 1)) asm volatile("" :: "v"(w.x), "v"(w.y), "v"(w.z), "v"(w.w)); else st_out((v4u*)(proj + (size_t)row * WIN + c0), w);
                }
            }
    }
};
struct EpiResid {
    static constexpr bool PERM = true, AFTER_DRAIN = false;
    bf16* HB; float* ssq;
    __device__ __forceinline__ void operator()(const pg8::f32x4 (&acc)[2][2][4][2], const pg8::Unit& u, int wr, int wc, int fr, int fq) const {
        const int row0 = u.pm * 256 + wr * 64 + fr, colb = u.pn * 256 + wc * 32 + 8 * fq;
#pragma unroll
        for (int ai = 0; ai < 2; ++ai) {
            v4u h[4][2];
#pragma unroll
            for (int m = 0; m < 4; ++m)
#pragma unroll
                for (int bj = 0; bj < 2; ++bj) h[m][bj] = *(const v4u*)(HB + (size_t)(row0 + ai * 128 + m * 16) * D + colb + bj * 128);
#pragma unroll
            for (int m = 0; m < 4; ++m) {
                const int row = row0 + ai * 128 + m * 16;
                float s = 0.f;
#pragma unroll
                for (int bj = 0; bj < 2; ++bj) {
                    const v4u hw = h[m][bj];
                    const f32x4 h0 = (f32x4){bf_lo(hw.x), bf_hi(hw.x), bf_lo(hw.y), bf_hi(hw.y)} + acc[ai][bj][m][0], h1 = (f32x4){bf_lo(hw.z), bf_hi(hw.z), bf_lo(hw.w), bf_hi(hw.w)} + acc[ai][bj][m][1];
                    s += (h0[0] * h0[0] + h0[1] * h0[1]) + (h0[2] * h0[2] + h0[3] * h0[3]) + (h1[0] * h1[0] + h1[1] * h1[1]) + (h1[2] * h1[2] + h1[3] * h1[3]);
                    v4u w; w.x = pg8::cvt_pk_bf16(h0[0], h0[1]); w.y = pg8::cvt_pk_bf16(h0[2], h0[3]); w.z = pg8::cvt_pk_bf16(h1[0], h1[1]); w.w = pg8::cvt_pk_bf16(h1[2], h1[3]);
                    *(v4u*)(HB + (size_t)row * D + colb + bj * 128) = w;
                }
                s += __shfl_xor(s, 16); s = xor32_sum(s);
                if (fq == 0) ssq[(size_t)row * 16 + u.pn * 4 + wc] = s;
            }
        }
    }
};
struct EpiGLU {
    static constexpr bool PERM = true, AFTER_DRAIN = false;
    bf16* T; int ldt; const LAS float* rs; int mode; bool tiled;
    __device__ __forceinline__ void operator()(const pg8::f32x4 (&acc)[2][2][4][2], const pg8::Unit& u, int wr, int wc, int fr, int fq) const {
        const int row0 = u.pm * 256 + wr * 64 + fr, colb = u.pn * 128 + wc * 32 + 8 * fq;
#pragma unroll
        for (int ai = 0; ai < 2; ++ai)
#pragma unroll
            for (int m = 0; m < 4; ++m) {
                const int row = row0 + ai * 128 + m * 16;
                const float r = rs ? rs[u.idx * 256 + wr * 64 + fr + ai * 128 + m * 16] : 1.f;
                float x[8];
                const float c1 = -1.4426950408889634f * r, c2 = r * r;
#pragma unroll
                for (int j = 0; j < 4; ++j) {
                    const float a1 = acc[ai][0][m][0][j], a3 = acc[ai][1][m][0][j], b1 = acc[ai][0][m][1][j], b3 = acc[ai][1][m][1][j];
                    x[j] = (a1 * a3) * (c2 * __builtin_amdgcn_rcpf(1.f + __builtin_amdgcn_exp2f(a1 * c1)));
                    x[4 + j] = (b1 * b3) * (c2 * __builtin_amdgcn_rcpf(1.f + __builtin_amdgcn_exp2f(b1 * c1)));
                }
                v4u w; w.x = pg8::cvt_pk_bf16(x[0], x[1]); w.y = pg8::cvt_pk_bf16(x[2], x[3]); w.z = pg8::cvt_pk_bf16(x[4], x[5]); w.w = pg8::cvt_pk_bf16(x[6], x[7]);
                bf16* d_ = T + (size_t)row * ldt + colb;
                if (TD_TILED && tiled) d_ = (bf16*)((unsigned char*)T + (unsigned)(((u.pm * (ldt >> 5) + 4 * u.pn + wc) * 256 + (wr * 64 + fr + ai * 128 + m * 16)) * 64 + 16 * fq));
                if (FF1_PROBE && (mode & 1)) asm volatile("" :: "v"(w.x), "v"(w.y), "v"(w.z), "v"(w.w)); else st_out((v4u*)d_, w);
            }
    }
};
struct EpiGLU8 {
    static constexpr bool PERM = true, AFTER_DRAIN = false;
    unsigned char* T8; int ldt; float s; int mode;
    __device__ __forceinline__ void operator()(const pg8::f32x4 (&acc)[2][2][4][2], const pg8::Unit& u, int wr, int wc, int fr, int fq) const {
        const int row0 = u.pm * 256 + wr * 64 + fr, colb = u.pn * 128 + wc * 32 + 8 * fq;
#pragma unroll
        for (int ai = 0; ai < 2; ++ai)
#pragma unroll
            for (int m = 0; m < 4; ++m) {
                const int row = row0 + ai * 128 + m * 16;
                float x[8];
                const float c1 = -1.4426950408889634f * s, c2 = 16.f * s * s;
#pragma unroll
                for (int j = 0; j < 4; ++j) {
                    const float a1 = acc[ai][0][m][0][j], a3 = acc[ai][1][m][0][j], b1 = acc[ai][0][m][1][j], b3 = acc[ai][1][m][1][j];
                    x[j] = (a1 * a3) * (c2 * __builtin_amdgcn_rcpf(1.f + __builtin_amdgcn_exp2f(a1 * c1)));
                    x[4 + j] = (b1 * b3) * (c2 * __builtin_amdgcn_rcpf(1.f + __builtin_amdgcn_exp2f(b1 * c1)));
                }
                v2u w; w.x = pk_fp8x4(x[0], x[1], x[2], x[3]); w.y = pk_fp8x4(x[4], x[5], x[6], x[7]);
#if T8_TILED
#if T8_TILED == 2
                unsigned char* d_ = T8 + (unsigned)((u.pm * 16 + 4 * wr + 8 * ai + m) * (16 * ldt) + (4 * u.pn + wc) * 512 + fr * 32 + 8 * fq);
#else
                unsigned char* d_ = T8 + (unsigned)(((u.pm * (ldt >> 5) + 4 * u.pn + wc) * 256 + (wr * 64 + fr + ai * 128 + m * 16)) * 32 + 8 * fq);
#endif
#else
                unsigned char* d_ = T8 + (size_t)row * ldt + colb;
#endif
                if (FF1_PROBE && (mode & 1)) asm volatile("" :: "v"(w.x), "v"(w.y)); else *(v2u*)d_ = w;
            }
    }
};
struct EpiNone { static constexpr bool PERM = true, AFTER_DRAIN = false; unsigned* sink;
    __device__ __forceinline__ void operator()(const pg8::f32x4 (&acc)[2][2][4][2], const pg8::Unit& u, int wr, int wc, int fr, int fq) const { pg8::f32x4 s = acc[0][0][0][0];
#pragma unroll
        for (int a = 0; a < 2; ++a)
#pragma unroll
            for (int b = 0; b < 2; ++b)
#pragma unroll
                for (int m = 0; m < 4; ++m)
#pragma unroll
                    for (int n = 0; n < 2; ++n) s = s + acc[a][b][m][n];
        if (s[0] + s[1] + s[2] + s[3] == 1.2345e38f) sink[0] = 1u; } };
struct EpiY {
    static constexpr bool PERM = true, AFTER_DRAIN = false;
    bf16* Y; float sc;
    __device__ __forceinline__ void operator()(const pg8::f32x4 (&acc)[2][2][4][2], const pg8::Unit& u, int wr, int wc, int fr, int fq) const {
        const int row0 = u.pm * 256 + wr * 64 + fr, colb = u.pn * 256 + wc * 32 + 8 * fq;
#pragma unroll
        for (int ai = 0; ai < 2; ++ai)
#pragma unroll
            for (int m = 0; m < 4; ++m) {
                const int row = row0 + ai * 128 + m * 16;
#pragma unroll
                for (int bj = 0; bj < 2; ++bj) {
                    const pg8::f32x4 a = acc[ai][bj][m][0] * sc, b = acc[ai][bj][m][1] * sc;
                    v4u w; w.x = pg8::cvt_pk_bf16(a[0], a[1]); w.y = pg8::cvt_pk_bf16(a[2], a[3]); w.z = pg8::cvt_pk_bf16(b[0], b[1]); w.w = pg8::cvt_pk_bf16(b[2], b[3]);
                    *(v4u*)(Y + (size_t)row * D + colb + bj * 128) = w;
                }
            }
    }
};

__device__ __forceinline__ void transpose_item(const float* W, const float* fold, int K, int N, bf16* WT, int k0, int n0, int drow0, LAS float* scr, int lane, int mode = 0) {
    const int kr = lane >> 4, n4 = lane & 15;
    f32x4 v[16];
#pragma unroll
    for (int i = 0; i < 16; ++i) { const f32x4* p_ = (const f32x4*)(W + (size_t)(k0 + 4 * i + kr) * N + n0 + 4 * n4); if (mode & 2) v[i] = (f32x4){1.f, 2.f, 3.f, 4.f}; else v[i] = NT_WLOAD ? __builtin_nontemporal_load(p_) : *p_; }
#pragma unroll
    for (int i = 0; i < 16; ++i) { const int k = 4 * i + kr; *(LAS f32x4*)(scr + k * 64 + ((4 * n4) ^ (4 * ((k >> 3) & 7)))) = v[i]; }
    LDS_WAIT(); asm volatile("" ::: "memory");
    const int c = lane & 7, nn = lane >> 3;
    f32x4 f0 = (f32x4){1.f, 1.f, 1.f, 1.f}, f1 = f0;
    if (fold) { f0 = *(const f32x4*)(fold + k0 + 8 * c); f1 = *(const f32x4*)(fold + k0 + 8 * c + 4); }
#pragma unroll
    for (int i2 = 0; i2 < 8; ++i2) {
        const int n = 8 * i2 + nn; const LAS float* s = scr + (8 * c) * 64 + (n ^ (4 * c));
        v4u o; o.x = pk2(s[0 * 64] * f0[0], s[1 * 64] * f0[1]); o.y = pk2(s[2 * 64] * f0[2], s[3 * 64] * f0[3]); o.z = pk2(s[4 * 64] * f1[0], s[5 * 64] * f1[1]); o.w = pk2(s[6 * 64] * f1[2], s[7 * 64] * f1[3]);
        if (mode & 1) asm volatile("" :: "v"(o.x), "v"(o.y), "v"(o.z), "v"(o.w)); else { GAS v4u* d_ = (GAS v4u*)(WT + (size_t)(drow0 + n) * K + k0 + 8 * c); if (PRO_NT_ST) __builtin_nontemporal_store(o, d_); else *d_ = o; }
    }
    LDS_WAIT(); asm volatile("" ::: "memory");
}
__device__ __forceinline__ void transpose_item8(const float* W, const float* fold, float scale, int K, int N, unsigned char* WT8, int k0, int n0, int drow0, LAS float* scr, int lane, int mode = 0) {
    const int kr = lane >> 4, n4 = lane & 15;
    f32x4 v[16];
#pragma unroll
    for (int i = 0; i < 16; ++i) { const f32x4* p_ = (const f32x4*)(W + (size_t)(k0 + 4 * i + kr) * N + n0 + 4 * n4); if (mode & 2) v[i] = (f32x4){1.f, 2.f, 3.f, 4.f}; else v[i] = NT_WLOAD ? __builtin_nontemporal_load(p_) : *p_; }
#pragma unroll
    for (int i = 0; i < 16; ++i) { const int k = 4 * i + kr; *(LAS f32x4*)(scr + k * 64 + ((4 * n4) ^ (4 * ((k >> 3) & 7)))) = v[i]; }
    LDS_WAIT(); asm volatile("" ::: "memory");
    const int c = lane & 7, nn = lane >> 3;
    f32x4 f0 = (f32x4){scale, scale, scale, scale}, f1 = f0;
    if (fold) { f0 = *(const f32x4*)(fold + k0 + 8 * c) * scale; f1 = *(const f32x4*)(fold + k0 + 8 * c + 4) * scale; }
#pragma unroll
    for (int i2 = 0; i2 < 8; ++i2) {
        const int n = 8 * i2 + nn; const LAS float* s = scr + (8 * c) * 64 + (n ^ (4 * c));
        v2u o; o.x = pk_fp8x4(s[0 * 64] * f0[0], s[1 * 64] * f0[1], s[2 * 64] * f0[2], s[3 * 64] * f0[3]); o.y = pk_fp8x4(s[4 * 64] * f1[0], s[5 * 64] * f1[1], s[6 * 64] * f1[2], s[7 * 64] * f1[3]);
        if (mode & 1) asm volatile("" :: "v"(o.x), "v"(o.y)); else *(GAS v2u*)(WT8 + (size_t)(drow0 + n) * K + k0 + 8 * c) = o;
    }
    LDS_WAIT(); asm volatile("" ::: "memory");
}
__device__ __forceinline__ void transpose_item8w(const float* W, const float* fold, float scale, int K, int N, unsigned char* WT8, int k0, int n0, int drow0, LAS float* scr, int lane, int mode = 0) {
    const int kr = lane >> 3, n4 = lane & 7;
    f32x4 v[16];
#pragma unroll
    for (int i = 0; i < 16; ++i) { const f32x4* p_ = (const f32x4*)(W + (size_t)(k0 + 8 * i + kr) * N + n0 + 4 * n4); if (mode & 2) v[i] = (f32x4){1.f, 2.f, 3.f, 4.f}; else v[i] = NT_WLOAD ? __builtin_nontemporal_load(p_) : *p_; }
#pragma unroll
    for (int i = 0; i < 16; ++i) { const int k = 8 * i + kr; *(LAS f32x4*)(scr + k * 32 + ((4 * n4) ^ (8 * ((k >> 4) & 3)))) = v[i]; }
    LDS_WAIT(); asm volatile("" ::: "memory");
    const int c = lane & 7, nn = lane >> 3;
    f32x4 f[4];
#pragma unroll
    for (int q = 0; q < 4; ++q) { f[q] = (f32x4){scale, scale, scale, scale}; if (fold) f[q] = *(const f32x4*)(fold + k0 + 16 * c + 4 * q) * scale; }
#pragma unroll
    for (int i2 = 0; i2 < 4; ++i2) {
        const int n = 8 * i2 + nn; const LAS float* s = scr + (16 * c) * 32 + (n ^ (8 * (c & 3)));
        v4u o;
        o.x = pk_fp8x4(s[0 * 32] * f[0][0], s[1 * 32] * f[0][1], s[2 * 32] * f[0][2], s[3 * 32] * f[0][3]);
        o.y = pk_fp8x4(s[4 * 32] * f[1][0], s[5 * 32] * f[1][1], s[6 * 32] * f[1][2], s[7 * 32] * f[1][3]);
        o.z = pk_fp8x4(s[8 * 32] * f[2][0], s[9 * 32] * f[2][1], s[10 * 32] * f[2][2], s[11 * 32] * f[2][3]);
        o.w = pk_fp8x4(s[12 * 32] * f[3][0], s[13 * 32] * f[3][1], s[14 * 32] * f[3][2], s[15 * 32] * f[3][3]);
        if (mode & 1) asm volatile("" :: "v"(o.x), "v"(o.y), "v"(o.z), "v"(o.w)); else { GAS v4u* d_ = (GAS v4u*)(WT8 + (size_t)(drow0 + n) * K + k0 + 16 * c); if (PRO_NT_ST) __builtin_nontemporal_store(o, d_); else *d_ = o; }
    }
    LDS_WAIT(); asm volatile("" ::: "memory");
}
__device__ __forceinline__ void prologue_phase(Ctx& C, const Args& A, int mode = 0) {
    LAS float* scr = (LAS float*)(C.lds + C.wave * 16384);
    const int gw = C.bid * 8 + C.wave, NGW = C.G * 8;
    constexpr int F8D = (PRO_F8_DOUBLE && FP8_MOE_MASK == 3) ? 2 : 1;
    constexpr int I_IN = 16 * 56, I_OUT = 16 * 16, I_D1 = 16 * 44, I_D2 = 44 * 16, I_M1 = (16 / F8D) * 56, I_M2 = (56 / F8D) * 16;
    constexpr int N_IN = 4 * I_IN, N_OUT = 4 * I_OUT, N_D1 = 2 * I_D1, N_D2 = 2 * I_D2, N_M1 = 16 * I_M1, N_M2 = 16 * I_M2;
    constexpr int NITEMS = N_IN + N_OUT + 2 * N_D1 + N_D2 + 2 * N_M1 + N_M2;
    for (int it = gw; it < NITEMS; it += NGW) {
        int r = it;
        const float* W; const float* fold = nullptr; bf16* WT; int K, N, glu = -1, loc; bool f8 = false; float f8s = 1.f; unsigned char* WT8 = nullptr;
        if (r < N_IN) { const int l = r / I_IN; loc = r % I_IN; W = A.in[IN_WIN] + (size_t)l * D * WIN; fold = A.in[IN_NMIX] + l * D; WT = (bf16*)(C.ws + WS_WIN) + (size_t)l * WIN * D; K = D; N = WIN; }
        else if ((r -= N_IN) < N_OUT) { const int l = r / I_OUT; loc = r % I_OUT; W = A.in[IN_WOUT] + (size_t)l * D * D; WT = (bf16*)(C.ws + WS_WOUT) + (size_t)l * D * D; K = D; N = D; }
        else if ((r -= N_OUT) < N_D1) { const int i = r / I_D1; loc = r % I_D1; W = A.in[IN_DW1] + (size_t)i * D * FFD; fold = A.in[IN_NFFN] + (2 * i) * D; WT = (bf16*)(C.ws + WS_WD13) + (size_t)i * 2 * FFD * D; K = D; N = FFD; glu = 0; }
        else if ((r -= N_D1) < N_D1) { const int i = r / I_D1; loc = r % I_D1; W = A.in[IN_DW3] + (size_t)i * D * FFD; fold = A.in[IN_NFFN] + (2 * i) * D; WT = (bf16*)(C.ws + WS_WD13) + (size_t)i * 2 * FFD * D; K = D; N = FFD; glu = 1; }
        else if ((r -= N_D1) < N_D2) { const int i = r / I_D2; loc = r % I_D2; W = A.in[IN_DW2] + (size_t)i * FFD * D; WT = (bf16*)(C.ws + WS_WD2) + (size_t)i * D * FFD; K = FFD; N = D; }
        else if ((r -= N_D2) < N_M1) { const int ie = r / I_M1; loc = r % I_M1; W = A.in[IN_MW1] + (size_t)ie * D * FFE; fold = A.in[IN_NFFN] + (2 * (ie >> 3) + 1) * D; WT = (bf16*)(C.ws + WS_WM13) + (size_t)ie * 2 * FFE * D; K = D; N = FFE; glu = 0; if ((FP8_MOE_MASK >> (ie >> 3)) & 1) { f8 = true; f8s = 32.f; WT8 = C.ws + WS_WM13 + ((size_t)(ie >> 3) * 8 * 2 * FFE * D * 2) + (size_t)(ie & 7) * 2 * FFE * D; } }
        else if ((r -= N_M1) < N_M1) { const int ie = r / I_M1; loc = r % I_M1; W = A.in[IN_MW3] + (size_t)ie * D * FFE; fold = A.in[IN_NFFN] + (2 * (ie >> 3) + 1) * D; WT = (bf16*)(C.ws + WS_WM13) + (size_t)ie * 2 * FFE * D; K = D; N = FFE; glu = 1; if ((FP8_MOE_MASK >> (ie >> 3)) & 1) { f8 = true; f8s = 32.f; WT8 = C.ws + WS_WM13 + ((size_t)(ie >> 3) * 8 * 2 * FFE * D * 2) + (size_t)(ie & 7) * 2 * FFE * D; } }
        else { r -= N_M1; const int ie = r / I_M2; loc = r % I_M2; W = A.in[IN_MW2] + (size_t)ie * FFE * D; WT = (bf16*)(C.ws + WS_WM2) + (size_t)ie * D * FFE; K = FFE; N = D; if ((FP8_MOE_MASK >> (ie >> 3)) & 1) { f8 = true; f8s = 64.f; WT8 = C.ws + WS_WM2 + ((size_t)(ie >> 3) * 8 * D * FFE * 2) + (size_t)(ie & 7) * D * FFE; } }
        const bool wide = PRO_F8_WIDE && f8;
        const int nw = wide ? 32 : 64, nblk = N / nw, kb = loc / nblk, nb = loc % nblk, k0 = (wide ? 128 : f8 ? 64 * F8D : 64) * kb, n0 = nw * nb;
        const int drow0 = (glu < 0) ? n0 : ((n0 >> 7) * 256 + glu * 128 + (n0 & 127));
        if (wide) transpose_item8w(W, fold, f8s, K, N, WT8, k0, n0, drow0, scr, C.lane, mode);
        else if (f8) { transpose_item8(W, fold, f8s, K, N, WT8, k0, n0, drow0, scr, C.lane, mode); if (F8D == 2) transpose_item8(W, fold, f8s, K, N, WT8, k0 + 64, n0, drow0, scr, C.lane, mode); }
        else transpose_item(W, fold, K, N, WT, k0, n0, drow0, scr, C.lane, mode);
    }
    for (int row = gw; row < NTOK; row += NGW) {
        const int b = row / LT, t = row % LT;
        f32x4 v[4]; float s = 0.f;
#pragma unroll
        for (int j = 0; j < 4; ++j) {
            const int col = 4 * C.lane + 256 * j;
            if (t < FIRSTV) v[j] = (f32x4){0.f, 0.f, 0.f, 0.f};
            else if (t < LEAD) v[j] = *(const f32x4*)(A.in[IN_META] + (size_t)(t - FIRSTV) * D + col);
            else v[j] = *(const f32x4*)(A.in[IN_X] + ((size_t)b * SEQ + (t - LEAD)) * D + col);
            s += (v[j][0] * v[j][0] + v[j][1] * v[j][1]) + (v[j][2] * v[j][2] + v[j][3] * v[j][3]);
            v2u w; w.x = pk2(v[j][0], v[j][1]); w.y = pk2(v[j][2], v[j][3]);
            *(v2u*)(C.HB() + (size_t)row * D + col) = w;
        }
        s = wave_sum(s);
        if (C.lane < 16) C.SSQ()[(size_t)row * 16 + C.lane] = (C.lane == 0) ? s : 0.f;
    }
#if HGV_PREFILL
    {
        f32x4* vz = (f32x4*)(C.ws + WS_ACT + ACT_LOGF + HGV_OFF);
        for (int i = C.bid * 512 + C.tid; i < (NTOK / 64) * 1024 / 4; i += C.G * 512) vz[i] = (f32x4){1.f, 1.f, 1.f, 1.f};
    }
#endif
    if (C.bid == 0) {
        const int tid = C.tid;
        {
            const float* lg = A.in[IN_LBL];
            const float a0 = lg[tid], a1 = lg[512 + tid], a2 = lg[1024 + tid], a3 = lg[1536 + tid];
            const float mx = fmaxf(fmaxf(a0, a1), fmaxf(a2, a3));
            const float e0 = expf(a0 - mx), e1 = expf(a1 - mx), e2 = expf(a2 - mx), e3 = expf(a3 - mx);
            const float inv = 1.f / (((e0 + e1) + e2) + e3);
            const float p0 = e0 * inv, p1 = e1 * inv, p2 = e2 * inv, p3 = e3 * inv;
            const float c0 = p0, c1 = c0 + p1, c2 = c1 + p2, c3 = c2 + p3;
            C.LB()[tid] = 0.f;
            C.LB()[512 + tid] = fminf(fmaxf(c1 - c0, 0.f), 0.999f);
            C.LB()[1024 + tid] = fminf(fmaxf(c2 - c0, 0.f), 0.999f);
            C.LB()[1536 + tid] = fminf(fmaxf(c3 - c0, 0.f), 0.999f);
        }
        for (int i = tid; i < 4 * 132; i += 512) { const int h = i / 132, d = i % 132; C.BIAST()[i] = (d <= 128) ? A.in[IN_RELB][T5B[d] * 4 + h] : 0.f; }
        if (tid < 4) {
            const float* lv = A.in[IN_LAMBDA] + tid * 256;
            float s01 = 0.f, s23 = 0.f;
            for (int j = 0; j < 64; ++j) { s01 += lv[j] * lv[64 + j]; s23 += lv[128 + j] * lv[192 + j]; }
            const float li = 0.8f - 0.6f * expf(-0.3f * (float)tid);
            C.LAM()[tid * 2] = expf(s01) - expf(s23) + li; C.LAM()[tid * 2 + 1] = li;
        }
        if (tid < 512) { C.SUBLN()[tid] = A.in[IN_SUBLN][tid]; C.HGNW()[tid] = A.in[IN_HGNW][tid]; C.FNORM()[tid] = A.in[IN_FNORM][tid]; C.FNORM()[512 + tid] = A.in[IN_FNORM][512 + tid]; }
        for (int i = tid; i < 2 * 8 * 1024; i += 512) { const int li = i >> 13, e = (i >> 10) & 7, k = i & 1023; C.RF()[i] = A.in[IN_NFFN][(2 * li + 1) * D + k] * A.in[IN_ROUTER][(size_t)li * D * NE + k * NE + e]; }
    }
}

typedef float f32x16 __attribute__((ext_vector_type(16)));
typedef short bf16x8 __attribute__((ext_vector_type(8)));
typedef short s16x4 __attribute__((ext_vector_type(4)));
constexpr float LOG2E = 1.4426950408889634f;
constexpr int AT_K = 0, AT_V = 32768, AT_BIAS = 65536, AT_WSF = 66560, AT_STG = 69632, AT_XCH = 0;
__device__ __forceinline__ int crow(int r, int hi) { return (r & 3) + 8 * (r >> 2) + 4 * hi; }
__device__ __forceinline__ s16x4 vtr(const LAS unsigned char* p) { typedef short v4i16_t __attribute__((ext_vector_type(4))); return __builtin_bit_cast(s16x4, __builtin_amdgcn_ds_read_tr16_b64_v4i16((LAS v4i16_t*)p)); }
__device__ __forceinline__ bf16x8 pack8(const f32x16& p, int b0) {
    v4u w; w.x = pg8::cvt_pk_bf16(p[b0 + 0], p[b0 + 1]); w.y = pg8::cvt_pk_bf16(p[b0 + 2], p[b0 + 3]); w.z = pg8::cvt_pk_bf16(p[b0 + 4], p[b0 + 5]); w.w = pg8::cvt_pk_bf16(p[b0 + 6], p[b0 + 7]);
    return __builtin_bit_cast(bf16x8, w);
}

#if ATT_V2
template <bool NEAR, bool FIRST>
__device__ __forceinline__ void attn_tile(LAS unsigned char* lds, int buf, int k0, int qw0, int tq, int c, int r32, int hi, int kswz, int vb, const bf16x8 (&qr)[4],
                                          const LAS float* biasl, LAS float* wsf, f32x16 (&o)[4], f32x16& cfar, float& mref, float& lsum) {
    if (NEAR && k0 > qw0 + 31) return;
    f32x16 p0, p1;
    const LAS unsigned char* kb = lds + AT_K + buf * 16384 + c * 8192 + r32 * 128;
    if (NEAR) {
#pragma unroll
        for (int r = 0; r < 16; ++r) { p0[r] = 0.f; p1[r] = 0.f; }
    } else { p0 = cfar; p1 = cfar; }
#pragma unroll
    for (int ks = 0; ks < 4; ++ks) {
        const int off = ((2 * ks + hi) ^ kswz) * 16;
        const bf16x8 k0f = *(const LAS bf16x8*)(kb + off), k1f = *(const LAS bf16x8*)(kb + 4096 + off);
        p0 = __builtin_amdgcn_mfma_f32_32x32x16_bf16(k0f, qr[ks], p0, 0, 0, 0);
        p1 = __builtin_amdgcn_mfma_f32_32x32x16_bf16(k1f, qr[ks], p1, 0, 0, 0);
    }
    if (NEAR) {
#pragma unroll
        for (int r = 0; r < 16; ++r) {
            const int tk = k0 + crow(r, hi), d0 = tq - tk, d1 = d0 - 32;
            const float b0 = biasl[d0 < 0 ? 0 : (d0 > 128 ? 128 : d0)] - mref, b1 = biasl[d1 < 0 ? 0 : (d1 > 128 ? 128 : d1)] - mref;
            p0[r] = (d0 < 0 || tk < FIRSTV) ? -INFINITY : p0[r] + b0;
            p1[r] = (d1 < 0 || tk + 32 < FIRSTV) ? -INFINITY : p1[r] + b1;
        }
    }
    float mx = fmaxf(p0[0], p1[0]);
#pragma unroll
    for (int r = 1; r < 16; ++r) mx = fmaxf(fmaxf(mx, p0[r]), p1[r]);
    mx = xor32_max(mx);
    if (FIRST || __any(mx > 8.0f)) {
        const float dl = FIRST ? ((mx > -1e30f) ? mx : 0.f) : fmaxf(mx, 0.f);
        mref += dl;
#pragma unroll
        for (int r = 0; r < 16; ++r) { p0[r] -= dl; p1[r] -= dl; if (!NEAR) cfar[r] -= dl; }
        if (!FIRST) {
            const float f = __builtin_amdgcn_exp2f(-dl);
            lsum *= f;
            if (hi == 0) wsf[r32] = f;
            LDS_WAIT(); asm volatile("" ::: "memory");
#pragma unroll
            for (int g = 0; g < 4; ++g) { const f32x4 fv = *(const LAS f32x4*)(wsf + 8 * g + 4 * hi);
#pragma unroll
                for (int d = 0; d < 4; ++d) { o[d][4 * g + 0] *= fv[0]; o[d][4 * g + 1] *= fv[1]; o[d][4 * g + 2] *= fv[2]; o[d][4 * g + 3] *= fv[3]; } }
        }
    }
    float ps = 0.f;
#pragma unroll
    for (int r = 0; r < 16; ++r) { p0[r] = __builtin_amdgcn_exp2f(p0[r]); p1[r] = __builtin_amdgcn_exp2f(p1[r]); ps += p0[r] + p1[r]; }
    lsum += ps;
    const bf16x8 pa0 = pack8(p0, 0), pa1 = pack8(p0, 8), pa2 = pack8(p1, 0), pa3 = pack8(p1, 8);
    const LAS unsigned char* vp = lds + AT_V + buf * 16384 + vb;
#pragma unroll
    for (int d = 0; d < 4; ++d) {
#define AT_VF(s) ({ const s16x4 lo_ = vtr(vp + (2 * (s)) * 2048 + d * 512), hi_ = vtr(vp + (2 * (s) + 1) * 2048 + d * 512); (bf16x8){lo_[0], lo_[1], lo_[2], lo_[3], hi_[0], hi_[1], hi_[2], hi_[3]}; })
        o[d] = __builtin_amdgcn_mfma_f32_32x32x16_bf16(pa0, AT_VF(0), o[d], 0, 0, 0);
        o[d] = __builtin_amdgcn_mfma_f32_32x32x16_bf16(pa1, AT_VF(1), o[d], 0, 0, 0);
        o[d] = __builtin_amdgcn_mfma_f32_32x32x16_bf16(pa2, AT_VF(2), o[d], 0, 0, 0);
        o[d] = __builtin_amdgcn_mfma_f32_32x32x16_bf16(pa3, AT_VF(3), o[d], 0, 0, 0);
#undef AT_VF
    }
}
#endif
__device__ __forceinline__ void attn_unit(Ctx& C, int l, int b, int h, int qi, bool dry = false) {
    LAS unsigned char* lds = C.lds;
    const int tid = C.tid, lane = C.lane, wave = C.wave, rg = wave >> 1, c = wave & 1, r32 = lane & 31, hi = lane >> 5;
    const size_t rowbase = (size_t)b * LT;
    const bf16* PJ = C.PROJ();
    LAS float* biasl = (LAS float*)(lds + AT_BIAS);
    LAS float* wsf = (LAS float*)(lds + AT_WSF) + wave * 64;
    if (tid < 132) biasl[tid] = C.BIAST()[h * 132 + tid] * LOG2E;
    const float lam = C.LAM()[l * 2], lam_init = C.LAM()[l * 2 + 1];
    const int qw0 = 128 * qi + 32 * rg, tq = qw0 + r32;
    bf16x8 qr[4];
    { const bf16* qp = PJ + (rowbase + tq) * WIN + 2048 + h * 128 + c * 64 + 8 * hi;
#pragma unroll
      for (int ks = 0; ks < 4; ++ks) qr[ks] = *(const bf16x8*)(qp + 16 * ks); }
    const int kkey = tid >> 3, kch = tid & 7;
    const bf16* ksrc = PJ + (rowbase + kkey) * WIN + 2560 + h * 128 + kch * 8;
    const int kdst = kkey * 128 + ((kch ^ ((kkey >> 1) & 7)) * 16);
    const int vkey0 = tid >> 4, vch = tid & 15;
    const bf16* vsrc = PJ + (rowbase + vkey0) * WIN + 3072 + h * 128 + vch * 8;
    const int vdst0 = ((vkey0 >> 3) * 4 + (vch >> 2)) * 512 + (vkey0 & 7) * 64 + (vch & 3) * 16;
    v4u kreg0, kreg1, vreg0, vreg1;
#define AT_LOAD(kt) do { const size_t o_ = (size_t)(kt) * 64 * WIN; kreg0 = *(const v4u*)(ksrc + o_); kreg1 = *(const v4u*)(ksrc + o_ + 64); vreg0 = *(const v4u*)(vsrc + o_); vreg1 = *(const v4u*)(vsrc + o_ + (size_t)32 * WIN); } while (0)
#define AT_STORE(buf) do { *(LAS v4u*)(lds + AT_K + (buf) * 16384 + kdst) = kreg0; *(LAS v4u*)(lds + AT_K + (buf) * 16384 + 8192 + kdst) = kreg1; \
        *(LAS v4u*)(lds + AT_V + (buf) * 16384 + vdst0) = vreg0; *(LAS v4u*)(lds + AT_V + (buf) * 16384 + 8192 + vdst0) = vreg1; } while (0)
    const int nt = 2 * qi + 1;
    AT_LOAD(1); AT_STORE(0);
    __syncthreads();
    f32x16 o[4];
#pragma unroll
    for (int d = 0; d < 4; ++d)
#pragma unroll
        for (int r = 0; r < 16; ++r) o[d][r] = 0.f;
#if ATT_V2
    float mref = 0.f, lsum = 0.f;
    const int kswz = (r32 >> 1) & 7;
    const int vb = (4 * hi + ((lane & 15) >> 2)) * 64 + ((lane >> 4) & 1) * 32 + (lane & 3) * 8;
    f32x16 cfar;
    if (nt > 1) AT_LOAD(2);
    attn_tile<true, true>(lds, 0, 64, qw0, tq, c, r32, hi, kswz, vb, qr, biasl, wsf, o, cfar, mref, lsum);
    if (nt > 1) AT_STORE(1);
    { const float cb = biasl[128] - mref;
#pragma unroll
      for (int r = 0; r < 16; ++r) cfar[r] = cb; }
    __syncthreads();
    for (int kt = 2; kt <= 2 * qi - 3; ++kt) {
        AT_LOAD(kt + 1);
        attn_tile<false, false>(lds, (kt - 1) & 1, 64 * kt, qw0, tq, c, r32, hi, kswz, vb, qr, biasl, wsf, o, cfar, mref, lsum);
        AT_STORE(kt & 1);
        __syncthreads();
    }
    for (int kt = (2 * qi - 2 > 2) ? 2 * qi - 2 : 2; kt <= nt; ++kt) {
        if (kt < nt) AT_LOAD(kt + 1);
        attn_tile<true, false>(lds, (kt - 1) & 1, 64 * kt, qw0, tq, c, r32, hi, kswz, vb, qr, biasl, wsf, o, cfar, mref, lsum);
        if (kt < nt) AT_STORE(kt & 1);
        __syncthreads();
    }
#else
    float mref = -1e30f, lsum = 0.f;
    const int kswz = (r32 >> 1) & 7;
    const int vb = (4 * hi + ((lane & 15) >> 2)) * 64 + ((lane >> 4) & 1) * 32 + (lane & 3) * 8;
    const float b128 = biasl[128];
    for (int it = 0; it < nt; ++it) {
        const int kt = it + 1, buf = it & 1, k0 = 64 * kt;
        if (it + 1 < nt) AT_LOAD(kt + 1);
        if (k0 <= qw0 + 31) {
            const bool near = (k0 + 63 > qw0 - 128) || (kt == 1);
            f32x16 p0, p1;
            { const float ini = near ? 0.f : b128;
#pragma unroll
              for (int r = 0; r < 16; ++r) { p0[r] = ini; p1[r] = ini; } }
            const LAS unsigned char* kb = lds + AT_K + buf * 16384 + c * 8192 + r32 * 128;
#pragma unroll
            for (int ks = 0; ks < 4; ++ks) {
                const int off = ((2 * ks + hi) ^ kswz) * 16;
                const bf16x8 k0f = *(const LAS bf16x8*)(kb + off), k1f = *(const LAS bf16x8*)(kb + 4096 + off);
                p0 = __builtin_amdgcn_mfma_f32_32x32x16_bf16(k0f, qr[ks], p0, 0, 0, 0);
                p1 = __builtin_amdgcn_mfma_f32_32x32x16_bf16(k1f, qr[ks], p1, 0, 0, 0);
            }
            if (near) {
#pragma unroll
                for (int r = 0; r < 16; ++r) {
                    const int tk = k0 + crow(r, hi), d0 = tq - tk, d1 = d0 - 32;
                    const float b0 = biasl[d0 < 0 ? 0 : (d0 > 128 ? 128 : d0)], b1 = biasl[d1 < 0 ? 0 : (d1 > 128 ? 128 : d1)];
                    p0[r] = (d0 < 0 || tk < FIRSTV) ? -INFINITY : p0[r] + b0;
                    p1[r] = (d1 < 0 || tk + 32 < FIRSTV) ? -INFINITY : p1[r] + b1;
                }
            }
            float mx = fmaxf(p0[0], p1[0]);
#pragma unroll
            for (int r = 1; r < 16; ++r) mx = fmaxf(fmaxf(mx, p0[r]), p1[r]);
            mx = xor32_max(mx);
            if (__any(mx > mref + 8.0f)) {
                const float mnew = fmaxf(mref, mx), f = __builtin_amdgcn_exp2f(mref - mnew);
                lsum *= f; mref = mnew;
                if (hi == 0) wsf[r32] = f;
                LDS_WAIT(); asm volatile("" ::: "memory");
#pragma unroll
                for (int g = 0; g < 4; ++g) { const f32x4 fv = *(const LAS f32x4*)(wsf + 8 * g + 4 * hi);
#pragma unroll
                    for (int d = 0; d < 4; ++d) { o[d][4 * g + 0] *= fv[0]; o[d][4 * g + 1] *= fv[1]; o[d][4 * g + 2] *= fv[2]; o[d][4 * g + 3] *= fv[3]; } }
            }
            float ps = 0.f;
#pragma unroll
            for (int r = 0; r < 16; ++r) { p0[r] = __builtin_amdgcn_exp2f(p0[r] - mref); p1[r] = __builtin_amdgcn_exp2f(p1[r] - mref); ps += p0[r] + p1[r]; }
            lsum += ps;
            const bf16x8 pa0 = pack8(p0, 0), pa1 = pack8(p0, 8), pa2 = pack8(p1, 0), pa3 = pack8(p1, 8);
            const LAS unsigned char* vp = lds + AT_V + buf * 16384 + vb;
#pragma unroll
            for (int d = 0; d < 4; ++d) {
#define AT_VF(s) ({ const s16x4 lo_ = vtr(vp + (2 * (s)) * 2048 + d * 512), hi_ = vtr(vp + (2 * (s) + 1) * 2048 + d * 512); (bf16x8){lo_[0], lo_[1], lo_[2], lo_[3], hi_[0], hi_[1], hi_[2], hi_[3]}; })
                o[d] = __builtin_amdgcn_mfma_f32_32x32x16_bf16(pa0, AT_VF(0), o[d], 0, 0, 0);
                o[d] = __builtin_amdgcn_mfma_f32_32x32x16_bf16(pa1, AT_VF(1), o[d], 0, 0, 0);
                o[d] = __builtin_amdgcn_mfma_f32_32x32x16_bf16(pa2, AT_VF(2), o[d], 0, 0, 0);
                o[d] = __builtin_amdgcn_mfma_f32_32x32x16_bf16(pa3, AT_VF(3), o[d], 0, 0, 0);
#undef AT_VF
            }
        }
        if (it + 1 < nt) AT_STORE(buf ^ 1);
        __syncthreads();
    }
#endif
#undef AT_LOAD
#undef AT_STORE
    lsum = xor32_sum(lsum);
    { const float inv = lsum > 0.f ? 1.f / lsum : 0.f;
      if (hi == 0) wsf[r32] = inv;
      LDS_WAIT(); asm volatile("" ::: "memory");
#pragma unroll
      for (int g = 0; g < 4; ++g) { const f32x4 fv = *(const LAS f32x4*)(wsf + 8 * g + 4 * hi);
#pragma unroll
          for (int d = 0; d < 4; ++d) { o[d][4 * g + 0] *= fv[0]; o[d][4 * g + 1] *= fv[1]; o[d][4 * g + 2] *= fv[2]; o[d][4 * g + 3] *= fv[3]; } } }
    LAS float* xch = (LAS float*)(lds + AT_XCH) + rg * 4096;
    if (c == 1) {
#pragma unroll
        for (int d = 0; d < 4; ++d)
#pragma unroll
            for (int r = 0; r < 16; ++r) xch[(d * 16 + r) * 64 + lane] = o[d][r];
    }
    __syncthreads();
    if (c == 0) {
        float ss[16];
#pragma unroll
        for (int r = 0; r < 16; ++r) ss[r] = 0.f;
#pragma unroll
        for (int d = 0; d < 4; ++d)
#pragma unroll
            for (int r = 0; r < 16; ++r) { const float a = o[d][r] - lam * xch[(d * 16 + r) * 64 + lane]; o[d][r] = a; ss[r] += a * a; }
#pragma unroll
        for (int r = 0; r < 16; ++r) {
            float s = ss[r];
            s += __shfl_xor(s, 1); s += __shfl_xor(s, 2); s += __shfl_xor(s, 4); s += __shfl_xor(s, 8); s += __shfl_xor(s, 16);
            ss[r] = rsqrtf(s * (1.0f / 128.0f) + EPS) * (1.f - lam_init);
        }
        LAS bf16* stg = (LAS bf16*)(lds + AT_STG) + rg * 4096;
        const float* sw = C.SUBLN() + l * 128 + r32;
#pragma unroll
        for (int d = 0; d < 4; ++d) { const float w = sw[32 * d];
#pragma unroll
            for (int r = 0; r < 16; ++r) stg[crow(r, hi) * 128 + 32 * d + r32] = (bf16)f2bf(o[d][r] * ss[r] * w); }
        LDS_WAIT(); asm volatile("" ::: "memory");
        bf16* op = (dry ? (bf16*)(C.ws + WS_H) : C.MIX()) + (rowbase + qw0) * D + 512 + h * 128;
#pragma unroll
        for (int i = 0; i < 8; ++i) { const int ch = i * 64 + lane, row = ch >> 4, cc = ch & 15; *(v4u*)(op + (size_t)row * D + cc * 8) = *(const LAS v4u*)(stg + row * 128 + cc * 8); }
    }
    __syncthreads();
}
constexpr int HG_QM = 0, HG_KR = 16384, HG_KT = 32768, HG_V = 49152, HG_ST = 65536, HG_XT = 98304, HG_OS = 106496, HG_SQ = 122880, HG_VEC = 123904;
__device__ __forceinline__ bf16x8 tr_frag(const LAS unsigned char* p) { const s16x4 lo = vtr(p), hi4 = vtr(p + 256); return (bf16x8){lo[0], lo[1], lo[2], lo[3], hi4[0], hi4[1], hi4[2], hi4[3]}; }

#if HG_TWO_STAGE
constexpr int HGS_QM = 0, HGS_KT = 16384, HGS_V = 32768, HGS_XT = 49152, HGS_VEC = 57344, HGS_STRIDE = 65536;
__device__ __forceinline__ unsigned char* hgs_block(Ctx& C, int bh, int ch) { return C.ws + WS_H + (size_t)(bh * (LT / 64) + ch) * HGS_STRIDE; }
__device__ __forceinline__ void hgrn_pre_phase(Ctx& C, int l) {
    LAS unsigned char* lds = C.lds;
    const int tid = C.tid, lane = C.lane, wave = C.wave;
    const int c4 = tid & 31, tg = tid >> 5;
    LAS float* vec = (LAS float*)(lds + HG_VEC);
    constexpr int NCH = LT / 64 - 1, NU = 32 * NCH;
    v2u pq[4], pk[4], pv[4]; f32x4 pb[4], pbm;
#define HP_LOAD(u) do { const int bh_ = (u) / NCH, ch_ = 1 + (u) % NCH; const size_t r0_ = (size_t)(bh_ >> 2) * LT + (size_t)ch_ * 64; const bf16* PJ_ = C.PROJ() + (bh_ & 3) * 128; const float* BL_ = C.LOGF() + (bh_ & 3) * 128; \
        _Pragma("unroll") for (int i = 0; i < 4; ++i) { const size_t row_ = r0_ + 4 * tg + i; const bf16* p_ = PJ_ + row_ * WIN + 4 * c4; \
            pq[i] = *(const v2u*)p_; pk[i] = *(const v2u*)(p_ + 512); pv[i] = *(const v2u*)(p_ + 1024); pb[i] = *(const f32x4*)(BL_ + row_ * 512 + 4 * c4); } \
        pbm = *(const f32x4*)(BL_ + (r0_ + 31) * 512 + 4 * c4); } while (0)
    if (C.bid < NU) HP_LOAD(C.bid);
    for (int u = C.bid; u < NU; u += C.G) {
#pragma unroll
        for (int i = 0; i < 4; ++i) {
            const int t = 4 * tg + i;
            float qm[4], km[4];
            const float qv[4] = {bf_lo(pq[i].x), bf_hi(pq[i].x), bf_lo(pq[i].y), bf_hi(pq[i].y)};
            const float kv[4] = {bf_lo(pk[i].x), bf_hi(pk[i].x), bf_lo(pk[i].y), bf_hi(pk[i].y)};
#pragma unroll
            for (int j = 0; j < 4; ++j) { const float x = __builtin_amdgcn_fmed3f(pb[i][j] - pbm[j], -115.f, 115.f); qm[j] = qv[j] * __builtin_amdgcn_exp2f(x); km[j] = kv[j] * __builtin_amdgcn_exp2f(-x); }
            const int rsw = (((c4 >> 1) ^ (t & 15)) * 16) + (c4 & 1) * 8;
            *(LAS v2u*)(lds + HG_QM + t * 256 + rsw) = pack4(qm[0], qm[1], qm[2], qm[3]);
            const v2u kmw = pack4(km[0], km[1], km[2], km[3]);
            *(LAS v2u*)(lds + HG_KR + t * 256 + rsw) = kmw;
            const int tso = ((t >> 3) * 4 + (c4 >> 3)) * 512 + (t & 7) * 64 + (c4 & 7) * 8;
            *(LAS v2u*)(lds + HG_KT + tso) = kmw;
            *(LAS v2u*)(lds + HG_V + tso) = pv[i];
            if (t == 31) *(LAS f32x4*)(vec + 4 * c4) = (f32x4){__builtin_amdgcn_exp2f(pb[i][0]), __builtin_amdgcn_exp2f(pb[i][1]), __builtin_amdgcn_exp2f(pb[i][2]), __builtin_amdgcn_exp2f(pb[i][3])};
            if (t == 63) *(LAS f32x4*)(vec + 128 + 4 * c4) = (f32x4){__builtin_amdgcn_exp2f(pb[i][0] - pbm[0]), __builtin_amdgcn_exp2f(pb[i][1] - pbm[1]), __builtin_amdgcn_exp2f(pb[i][2] - pbm[2]), __builtin_amdgcn_exp2f(pb[i][3] - pbm[3])};
        }
        __syncthreads();
        if (u + C.G < NU) HP_LOAD(u + C.G);
#pragma unroll
        for (int rep2 = 0; rep2 < 2; ++rep2) {
            const int ti = wave + 8 * rep2;
            if (ti == 10 || ti == 11) {
                const int sb = (ti == 10) ? 1 : 3, tb = sb - 1, fr = lane & 15, fq = lane >> 4, tt = 16 * tb + fr;
                unsigned z_; asm volatile("v_mov_b32 %0, 0" : "=v"(z_));
                *(LAS v2u*)(lds + HG_XT + tt * 128 + (((2 * sb + (fq >> 1)) ^ ((tt >> 1) & 7)) * 16) + (fq & 1) * 8) = (v2u){z_, z_};
            }
            if (ti < 10) {
                const int sb = (ti < 4) ? 0 : (ti < 7) ? 1 : (ti < 9) ? 2 : 3, tb = (ti < 4) ? ti : (ti < 7) ? ti - 3 : (ti < 9) ? ti - 5 : 3;
                const int fr = lane & 15, fq = lane >> 4, s = 16 * sb + fr, tt = 16 * tb + fr;
                f32x4 x = (f32x4){0.f, 0.f, 0.f, 0.f};
#pragma unroll
                for (int ks = 0; ks < 4; ++ks) {
                    const bf16x8 a = *(const LAS bf16x8*)(lds + HG_KR + s * 256 + (((4 * ks + fq) ^ (s & 15)) * 16));
                    const bf16x8 bq = *(const LAS bf16x8*)(lds + HG_QM + tt * 256 + (((4 * ks + fq) ^ (tt & 15)) * 16));
                    x = __builtin_amdgcn_mfma_f32_16x16x32_bf16(a, bq, x, 0, 0, 0);
                }
                if (sb == tb) {
#pragma unroll
                    for (int r = 0; r < 4; ++r) x[r] = (4 * fq + r > fr) ? 0.f : x[r];
                }
                *(LAS v2u*)(lds + HG_XT + tt * 128 + (((2 * sb + (fq >> 1)) ^ ((tt >> 1) & 7)) * 16) + (fq & 1) * 8) = pack4(x[0], x[1], x[2], x[3]);
            }
        }
        __syncthreads();
        {
            unsigned char* blk = hgs_block(C, u / NCH, 1 + u % NCH);
#pragma unroll
            for (int p = 0; p < 2; ++p) {
                *(v4u*)(blk + HGS_QM + 8192 * p + 16 * tid) = *(const LAS v4u*)(lds + HG_QM + 8192 * p + 16 * tid);
                *(v4u*)(blk + HGS_KT + 8192 * p + 16 * tid) = *(const LAS v4u*)(lds + HG_KT + 8192 * p + 16 * tid);
                *(v4u*)(blk + HGS_V + 8192 * p + 16 * tid) = *(const LAS v4u*)(lds + HG_V + 8192 * p + 16 * tid);
            }
            *(v4u*)(blk + HGS_XT + 16 * tid) = *(const LAS v4u*)(lds + HG_XT + 16 * tid);
            if (tid < 64) *(v4u*)(blk + HGS_VEC + 16 * tid) = *(const LAS v4u*)(lds + HG_VEC + 16 * tid);
        }
        __syncthreads();
    }
#undef HP_LOAD
}
#endif
__device__ __forceinline__ void hgrn_unit(Ctx& C, int l, int b, int h) {
    LAS unsigned char* lds = C.lds;
    const int tid = C.tid, lane = C.lane, wave = C.wave, r32 = lane & 31, hi = lane >> 5;
    const size_t rowbase = (size_t)b * LT;
    const bf16* PJ = C.PROJ() + h * 128;
#if HF_MERGE && HG_C4MAP
    const int c4p = tid & 31, c4 = 2 * (c4p & 15) + (c4p >> 4), tg = tid >> 5;
    const float* BL = C.LOGF(); const int BLC = (c4p >> 4) * 256 + (16 * h + (c4p & 15)) * 4;
#elif HF_MERGE
    const int c4 = tid & 31, tg = tid >> 5;
    const float* BL = C.LOGF(); const int BLC = (c4 & 1) * 256 + (16 * h + (c4 >> 1)) * 4;
#else
    const int c4 = tid & 31, tg = tid >> 5;
    const float* BL = C.LOGF() + h * 128; const int BLC = 4 * c4;
#endif
    const int dkb = wave >> 1, dvb0 = 2 * (wave & 1);
    const int th = wave >> 2, dvb = wave & 3;
    const int vbq = ((lane & 15) >> 2) * 64 + ((lane >> 4) & 1) * 32 + (lane & 3) * 8;
    LAS float* vec = (LAS float*)(lds + HG_VEC);
    LAS float* sq = (LAS float*)(lds + HG_SQ);
    f32x16 st[2];
#pragma unroll
    for (int j = 0; j < 2; ++j)
#pragma unroll
        for (int r = 0; r < 16; ++r) st[j][r] = 0.f;
#if HG_TWO_STAGE
    v4u im[7], imv = (v4u){0u, 0u, 0u, 0u};
#define HG_LOAD(ch) do { const unsigned char* blk_ = hgs_block(C, b * 4 + h, (ch)); \
        _Pragma("unroll") for (int p = 0; p < 7; ++p) im[p] = *(const v4u*)(blk_ + 8192 * p + 16 * tid); \
        if (tid < 64) imv = *(const v4u*)(blk_ + HGS_VEC + 16 * tid); } while (0)
#else
#if HG_EQ_CHAIN
    v2u pq[4], pk[4], pv[4], pe[4]; f32x4 pvec = (f32x4){0.f, 0.f, 0.f, 0.f};
#if HG_EQ_BOTH
    const bf16* EQB = (const bf16*)(C.ws + WS_H) + h * 128; const float* VG = (const float*)(C.ws + WS_H + 60 * MiB) + h * 128; const bf16* KMB = (const bf16*)(C.ws + WS_H + 36 * MiB) + h * 128;
#else
    const bf16* EQB = (const bf16*)C.LOGF() + h * 128; const float* VG = (const float*)((const unsigned char*)C.LOGF() + (HGV_DUP ? (size_t)HGV_DUP * MiB : HGV_OFF)) + h * 128; const bf16* KMB = PJ;
#endif
#define HG_LOAD(ch) do { const size_t r0_ = rowbase + (size_t)(ch) * 64; const bf16* KMB_ = HG_EQ_BOTH ? KMB : PJ; \
        _Pragma("unroll") for (int i = 0; i < 4; ++i) { const size_t row_ = r0_ + 4 * tg + i; const bf16* p_ = PJ + row_ * WIN + 4 * c4; \
            pq[i] = *(const v2u*)p_; pk[i] = HG_EQ_BOTH ? *(const v2u*)(KMB_ + row_ * 512 + 4 * c4) : *(const v2u*)(p_ + 512); pv[i] = *(const v2u*)(p_ + 1024); pe[i] = *(const v2u*)(EQB + row_ * 512 + 4 * c4); } \
        if (tid < 64) pvec = *(const f32x4*)(VG + (r0_ >> 6) * 1024 + (tid >> 5) * 512 + 4 * (tid & 31)); } while (0)
#else
    v2u pq[4], pk[4], pv[4]; f32x4 pb[4], pbm;
#define HG_LOAD(ch) do { const size_t r0_ = rowbase + (size_t)(ch) * 64; \
        _Pragma("unroll") for (int i = 0; i < 4; ++i) { const size_t row_ = r0_ + 4 * tg + i; const bf16* p_ = PJ + row_ * WIN + 4 * c4; \
            pq[i] = *(const v2u*)p_; pk[i] = *(const v2u*)(p_ + 512); pv[i] = *(const v2u*)(p_ + 1024); pb[i] = *(const f32x4*)(BL + row_ * 512 + BLC); } \
        pbm = *(const f32x4*)(BL + (r0_ + 31) * 512 + BLC); } while (0)
#endif
#endif
    HG_LOAD(1);
    for (int ch = 1; ch < LT / 64; ++ch) {
#if HG_TWO_STAGE
        *(LAS v4u*)(lds + HG_QM + 16 * tid) = im[0]; *(LAS v4u*)(lds + HG_QM + 8192 + 16 * tid) = im[1];
        *(LAS v4u*)(lds + HG_KT + 16 * tid) = im[2]; *(LAS v4u*)(lds + HG_KT + 8192 + 16 * tid) = im[3];
        *(LAS v4u*)(lds + HG_V + 16 * tid) = im[4]; *(LAS v4u*)(lds + HG_V + 8192 + 16 * tid) = im[5];
        *(LAS v4u*)(lds + HG_XT + 16 * tid) = im[6];
        if (tid < 64) *(LAS v4u*)(lds + HG_VEC + 16 * tid) = imv;
#else
#if HG_EQ_CHAIN
#pragma unroll
        for (int i = 0; i < 4; ++i) {
            const int t = 4 * tg + i;
            const int rsw = (((c4 >> 1) ^ (t & 15)) * 16) + (c4 & 1) * 8;
            *(LAS v2u*)(lds + HG_QM + t * 256 + rsw) = pack4(bf_lo(pq[i].x) * bf_lo(pe[i].x), bf_hi(pq[i].x) * bf_hi(pe[i].x), bf_lo(pq[i].y) * bf_lo(pe[i].y), bf_hi(pq[i].y) * bf_hi(pe[i].y));
            *(LAS v2u*)(lds + HG_KR + t * 256 + rsw) = pk[i];
            const int tso = ((t >> 3) * 4 + (c4 >> 3)) * 512 + (t & 7) * 64 + (c4 & 7) * 8;
            *(LAS v2u*)(lds + HG_KT + tso) = pk[i];
            *(LAS v2u*)(lds + HG_V + tso) = pv[i];
        }
        if (tid < 64) *(LAS f32x4*)(vec + (tid >> 5) * 128 + 4 * (tid & 31)) = pvec;
#else
#pragma unroll
        for (int i = 0; i < 4; ++i) {
            const int t = 4 * tg + i;
            float qm[4], km[4];
            const float qv[4] = {bf_lo(pq[i].x), bf_hi(pq[i].x), bf_lo(pq[i].y), bf_hi(pq[i].y)};
            const float kv[4] = {bf_lo(pk[i].x), bf_hi(pk[i].x), bf_lo(pk[i].y), bf_hi(pk[i].y)};
#pragma unroll
            for (int j = 0; j < 4; ++j) { const float x = __builtin_amdgcn_fmed3f(pb[i][j] - pbm[j], -115.f, 115.f); qm[j] = qv[j] * __builtin_amdgcn_exp2f(x); km[j] = kv[j] * __builtin_amdgcn_exp2f(-x); }
            const int rsw = (((c4 >> 1) ^ (t & 15)) * 16) + (c4 & 1) * 8;
            *(LAS v2u*)(lds + HG_QM + t * 256 + rsw) = pack4(qm[0], qm[1], qm[2], qm[3]);
            const v2u kmw = pack4(km[0], km[1], km[2], km[3]);
            *(LAS v2u*)(lds + HG_KR + t * 256 + rsw) = kmw;
            const int tso = ((t >> 3) * 4 + (c4 >> 3)) * 512 + (t & 7) * 64 + (c4 & 7) * 8;
            *(LAS v2u*)(lds + HG_KT + tso) = kmw;
            *(LAS v2u*)(lds + HG_V + tso) = pv[i];
            if (t == 31) *(LAS f32x4*)(vec + 4 * c4) = (f32x4){__builtin_amdgcn_exp2f(pb[i][0]), __builtin_amdgcn_exp2f(pb[i][1]), __builtin_amdgcn_exp2f(pb[i][2]), __builtin_amdgcn_exp2f(pb[i][3])};
            if (t == 63) *(LAS f32x4*)(vec + 128 + 4 * c4) = (f32x4){__builtin_amdgcn_exp2f(pb[i][0] - pbm[0]), __builtin_amdgcn_exp2f(pb[i][1] - pbm[1]), __builtin_amdgcn_exp2f(pb[i][2] - pbm[2]), __builtin_amdgcn_exp2f(pb[i][3] - pbm[3])};
        }
#endif
#endif
        __syncthreads();
        if (ch + 1 < LT / 64) HG_LOAD(ch + 1);
#if HG_DSHAPE
        const v4u g0 = *(const v4u*)(PJ + (rowbase + (size_t)ch * 64 + (tid >> 3)) * WIN + 1536 + 8 * (tid & 7)), g1 = *(const v4u*)(PJ + (rowbase + (size_t)ch * 64 + (tid >> 3)) * WIN + 1536 + 64 + 8 * (tid & 7));
#else
        const v4u g0 = *(const v4u*)(PJ + (rowbase + (size_t)ch * 64 + (tid >> 3)) * WIN + 1536 + 16 * (tid & 7)), g1 = *(const v4u*)(PJ + (rowbase + (size_t)ch * 64 + (tid >> 3)) * WIN + 1536 + 16 * (tid & 7) + 8);
#endif
#pragma unroll
        for (int g = 0; g < 4; ++g) {
            const f32x4 bm = *(const LAS f32x4*)(vec + 32 * dkb + 8 * g + 4 * hi);
            const float e0 = bm[0], e1 = bm[1], e2 = bm[2], e3 = bm[3];
#pragma unroll
            for (int j = 0; j < 2; ++j) {
                st[j][4 * g + 0] *= e0; st[j][4 * g + 1] *= e1; st[j][4 * g + 2] *= e2; st[j][4 * g + 3] *= e3;
                const int dv = 32 * (dvb0 + j) + r32;
                *(LAS v2u*)(lds + HG_ST + dv * 256 + (((4 * dkb + g) ^ (dv & 15)) * 16) + hi * 8) = pack4(st[j][4 * g + 0], st[j][4 * g + 1], st[j][4 * g + 2], st[j][4 * g + 3]);
            }
        }
#if !HG_TWO_STAGE
#pragma unroll
        for (int rep2 = 0; rep2 < 2; ++rep2) {
            const int ti = wave + 8 * rep2;
            if (ti == 10 || ti == 11) {
                const int sb = (ti == 10) ? 1 : 3, tb = sb - 1, fr = lane & 15, fq = lane >> 4, tt = 16 * tb + fr;
                unsigned z_; asm volatile("v_mov_b32 %0, 0" : "=v"(z_));
                *(LAS v2u*)(lds + HG_XT + tt * 128 + (((2 * sb + (fq >> 1)) ^ ((tt >> 1) & 7)) * 16) + (fq & 1) * 8) = (v2u){z_, z_};
            }
            if (ti < 10) {
                const int sb = (ti < 4) ? 0 : (ti < 7) ? 1 : (ti < 9) ? 2 : 3, tb = (ti < 4) ? ti : (ti < 7) ? ti - 3 : (ti < 9) ? ti - 5 : 3;
                const int fr = lane & 15, fq = lane >> 4, s = 16 * sb + fr, tt = 16 * tb + fr;
                f32x4 x = (f32x4){0.f, 0.f, 0.f, 0.f};
#pragma unroll
                for (int ks = 0; ks < 4; ++ks) {
                    const bf16x8 a = *(const LAS bf16x8*)(lds + HG_KR + s * 256 + (((4 * ks + fq) ^ (s & 15)) * 16));
                    const bf16x8 bq = *(const LAS bf16x8*)(lds + HG_QM + tt * 256 + (((4 * ks + fq) ^ (tt & 15)) * 16));
                    x = __builtin_amdgcn_mfma_f32_16x16x32_bf16(a, bq, x, 0, 0, 0);
                }
                if (sb == tb) {
#pragma unroll
                    for (int r = 0; r < 4; ++r) x[r] = (4 * fq + r > fr) ? 0.f : x[r];
                }
                *(LAS v2u*)(lds + HG_XT + tt * 128 + (((2 * sb + (fq >> 1)) ^ ((tt >> 1) & 7)) * 16) + (fq & 1) * 8) = pack4(x[0], x[1], x[2], x[3]);
            }
        }
#endif
#pragma unroll
        for (int ks = 0; ks < 4; ++ks) {
            const bf16x8 a = tr_frag(lds + HG_KT + ((2 * ks + hi) * 4 + dkb) * 512 + vbq);
#pragma unroll
            for (int j = 0; j < 2; ++j) {
                const bf16x8 bv = tr_frag(lds + HG_V + ((2 * ks + hi) * 4 + dvb0 + j) * 512 + vbq);
                st[j] = __builtin_amdgcn_mfma_f32_32x32x16_bf16(a, bv, st[j], 0, 0, 0);
            }
        }
#pragma unroll
        for (int g = 0; g < 4; ++g) {
            const f32x4 be = *(const LAS f32x4*)(vec + 128 + 32 * dkb + 8 * g + 4 * hi);
            const float e0 = be[0], e1 = be[1], e2 = be[2], e3 = be[3];
#pragma unroll
            for (int j = 0; j < 2; ++j) { st[j][4 * g + 0] *= e0; st[j][4 * g + 1] *= e1; st[j][4 * g + 2] *= e2; st[j][4 * g + 3] *= e3; }
        }
        __syncthreads();
        {
            const int dv = 32 * dvb + r32, t = 32 * th + r32;
            f32x16 o;
#pragma unroll
            for (int r = 0; r < 16; ++r) o[r] = 0.f;
#pragma unroll
            for (int ks = 0; ks < 8; ++ks) {
                const bf16x8 a = *(const LAS bf16x8*)(lds + HG_ST + dv * 256 + (((2 * ks + hi) ^ (dv & 15)) * 16));
                const bf16x8 bq = *(const LAS bf16x8*)(lds + HG_QM + t * 256 + (((2 * ks + hi) ^ (t & 15)) * 16));
                o = __builtin_amdgcn_mfma_f32_32x32x16_bf16(a, bq, o, 0, 0, 0);
            }
#pragma unroll
            for (int sb = 0; sb < 2; ++sb) {
                if (sb <= th) {
#pragma unroll
                    for (int k2 = 0; k2 < 2; ++k2) {
                        const int kg = 4 * sb + 2 * k2 + hi;
                        const bf16x8 a = tr_frag(lds + HG_V + (kg * 4 + dvb) * 512 + vbq);
                        const bf16x8 bx = *(const LAS bf16x8*)(lds + HG_XT + t * 128 + ((kg ^ ((t >> 1) & 7)) * 16));
                        o = __builtin_amdgcn_mfma_f32_32x32x16_bf16(a, bx, o, 0, 0, 0);
                    }
                }
            }
            float s2 = 0.f;
#pragma unroll
            for (int r = 0; r < 16; ++r) s2 += o[r] * o[r];
            s2 = xor32_sum(s2);
            if (hi == 0) sq[t * 4 + dvb] = s2;
#pragma unroll
            for (int g = 0; g < 4; ++g)
                *(LAS v2u*)(lds + HG_OS + t * 256 + (((4 * dvb + g) ^ (t & 15)) * 16) + hi * 8) = pack4(o[4 * g + 0], o[4 * g + 1], o[4 * g + 2], o[4 * g + 3]);
        }
        __syncthreads();
        {
            const int t = tid >> 3, seg = tid & 7;
            const size_t row = rowbase + (size_t)ch * 64 + t;
            const f32x4 sv = *(const LAS f32x4*)(sq + t * 4);
            const float rs = rsqrtf(((sv[0] + sv[1]) + (sv[2] + sv[3])) * (1.0f / 128.0f) + EPS);
#if HG_DSHAPE
            const v4u o0 = *(const LAS v4u*)(lds + HG_OS + t * 256 + ((seg ^ (t & 15)) * 16)), o1 = *(const LAS v4u*)(lds + HG_OS + t * 256 + (((seg + 8) ^ (t & 15)) * 16));
#else
            const v4u o0 = *(const LAS v4u*)(lds + HG_OS + t * 256 + (((2 * seg) ^ (t & 15)) * 16)), o1 = *(const LAS v4u*)(lds + HG_OS + t * 256 + (((2 * seg + 1) ^ (t & 15)) * 16));
#endif
            v4u r0, r1;
            r0.x = pk2(bf_lo(o0.x) * rs * bf_lo(g0.x), bf_hi(o0.x) * rs * bf_hi(g0.x)); r0.y = pk2(bf_lo(o0.y) * rs * bf_lo(g0.y), bf_hi(o0.y) * rs * bf_hi(g0.y));
            r0.z = pk2(bf_lo(o0.z) * rs * bf_lo(g0.z), bf_hi(o0.z) * rs * bf_hi(g0.z)); r0.w = pk2(bf_lo(o0.w) * rs * bf_lo(g0.w), bf_hi(o0.w) * rs * bf_hi(g0.w));
            r1.x = pk2(bf_lo(o1.x) * rs * bf_lo(g1.x), bf_hi(o1.x) * rs * bf_hi(g1.x)); r1.y = pk2(bf_lo(o1.y) * rs * bf_lo(g1.y), bf_hi(o1.y) * rs * bf_hi(g1.y));
            r1.z = pk2(bf_lo(o1.z) * rs * bf_lo(g1.z), bf_hi(o1.z) * rs * bf_hi(g1.z)); r1.w = pk2(bf_lo(o1.w) * rs * bf_lo(g1.w), bf_hi(o1.w) * rs * bf_hi(g1.w));
#if HG_DSHAPE
            bf16* op = C.MIX() + row * D + h * 128 + 8 * seg;
            *(v4u*)op = r0; *(v4u*)(op + 64) = r1;
#else
            bf16* op = C.MIX() + row * D + h * 128 + 16 * seg;
            *(v4u*)op = r0; *(v4u*)(op + 8) = r1;
#endif
        }
    }
#undef HG_LOAD
    __syncthreads();
}
__device__ __forceinline__ void mixer_phase(Ctx& C, int l) {
    const int NA = C.G - 32;
    if (C.bid < NA) {
        const bool part = (NA == 224);
        const int g = C.bid >> 5, nu = part ? ((g < 6) ? 2 : 5) : (17 * 32 + NA - 1) / NA;
        for (int rep = 0; rep < REP_ATT; ++rep)
        for (int k = 0; k < nu; ++k) {
            int qi, bh;
            if (part) { bh = C.bid & 31; qi = (g < 6) ? (k == 0 ? 16 - g : 4 + g) : (k == 0 ? 10 : 4 - k); }
            else { const int u = k * NA + ((k & 1) ? (NA - 1 - C.bid) : C.bid); if (u >= 17 * 32) continue; qi = 16 - u / 32; bh = u % 32; }
            attn_unit(C, l, bh >> 2, bh & 3, qi, ATT_DRY2 && rep > 0);
        }
    } else {
        { const int u = C.bid - NA; _Pragma("nounroll") for (int rep = 0; rep < REP_HG; ++rep) { int uu = u; asm volatile("" : "+s"(uu) :: "memory"); hgrn_unit(C, l, uu >> 2, uu & 3); } }
    }
}


template <bool FP8, class F, int ATILE = 0> __device__ __forceinline__ void mini_tile(LAS unsigned char* lds, const bf16* A, const bf16* Bt, int K, int r0, int c0, int lane, int wave, const F& epi) {
    const int fr = lane & 15, fq = lane >> 4;
    const int srow = 8 * wave + (lane >> 3), lch = (lane & 7) ^ ((srow >> 1) & 7);
    const unsigned char* asrc; size_t astep;
    if (ATILE == 1) { const int rr = r0 + srow; asrc = (const unsigned char*)A + (size_t)(rr >> 4) * (size_t)K * 32 + (lch >> 1) * 512 + (rr & 15) * 32 + (lch & 1) * 16; astep = 2048; }
    else if (ATILE) { const int rr = r0 + srow; asrc = (const unsigned char*)A + (size_t)(rr >> 8) * (size_t)K * 512 + (size_t)(rr & 255) * ATILE + ((16 * lch) / ATILE) * (256 * ATILE) + ((16 * lch) % ATILE); astep = 32768; }
    else { asrc = (const unsigned char*)(A + (size_t)(r0 + srow) * K + 8 * lch); astep = 128; }
    const bf16* bsrc = Bt + (size_t)(c0 + srow) * K + 8 * lch;
    const int nk = K / 64;
    LAS unsigned char* wbase = lds + wave * 1024;
#define RT_ISSUE(s) do { const int sl_ = ((s) & 7) * 16384; __builtin_amdgcn_global_load_lds((const unsigned*)(asrc + (size_t)(s) * astep), (LAS unsigned*)(wbase + sl_), 16, 0, 0); \
        __builtin_amdgcn_global_load_lds((const unsigned*)(bsrc + (size_t)(s) * 64), (LAS unsigned*)(wbase + sl_ + 8192), 16, 0, 0); } while (0)
#pragma unroll
    for (int s = 0; s < 7; ++s) RT_ISSUE(s);
    f32x4 acc0 = (f32x4){0.f, 0.f, 0.f, 0.f}, acc1 = acc0;
    const int arow = 32 * (wave >> 2) + fr, brow = 16 * (wave & 3) + fr;
    const int asw = (arow >> 1) & 7, bsw = (brow >> 1) & 7;
    for (int s = 0; s < nk; ++s) {
        if (s + 6 < nk) asm volatile("s_waitcnt vmcnt(12)" ::: "memory"); else asm volatile("s_waitcnt vmcnt(0)" ::: "memory");
        __builtin_amdgcn_s_barrier(); asm volatile("" ::: "memory");
        if (s + 7 < nk) RT_ISSUE(s + 7);
        const LAS unsigned char* sa = lds + (s & 7) * 16384; const LAS unsigned char* sb = sa + 8192;
        bf16x8 a0[2], a1[2], b[2];
#pragma unroll
        for (int j = 0; j < 2; ++j) {
            a0[j] = *(const LAS bf16x8*)(sa + arow * 128 + (((4 * j + fq) ^ asw) * 16)); a1[j] = *(const LAS bf16x8*)(sa + (arow + 16) * 128 + (((4 * j + fq) ^ asw) * 16));
            b[j] = *(const LAS bf16x8*)(sb + brow * 128 + (((4 * j + fq) ^ bsw) * 16));
        }
        if constexpr (FP8) { acc0 = pg8::mma8(b[0], b[1], a0[0], a0[1], acc0); acc1 = pg8::mma8(b[0], b[1], a1[0], a1[1], acc1); }
        else {
#pragma unroll
            for (int j = 0; j < 2; ++j) { acc0 = __builtin_amdgcn_mfma_f32_16x16x32_bf16(b[j], a0[j], acc0, 0, 0, 0); acc1 = __builtin_amdgcn_mfma_f32_16x16x32_bf16(b[j], a1[j], acc1, 0, 0, 0); }
        }
    }
#undef RT_ISSUE
    const int row = r0 + 32 * (wave >> 2) + fr, col = c0 + 16 * (wave & 3) + 4 * fq;
    epi(acc0, acc1, row, col);
    asm volatile("s_waitcnt lgkmcnt(0)" ::: "memory"); __builtin_amdgcn_s_barrier(); asm volatile("" ::: "memory");
}
template <int ATILE = 0> __device__ __forceinline__ void mini_resid_phase(Ctx& C, const bf16* A, const bf16* Bt, int K, int row_lo) {
    LAS float* red = (LAS float*)(C.lds + RING_BYTES + 2048);
    const int nrb = (NTOK - row_lo) / 64, ntile = nrb * 16;
    bf16* HB = C.HB(); float* SSQ = C.SSQ();
    for (int mt = C.bid; mt < ntile; mt += C.G) {
        const int rb = mt >> 4, cb = mt & 15, r0 = row_lo + 64 * rb, c0 = 64 * cb;
        const int lane = C.lane, wave = C.wave;
        auto epi_ = [&](const f32x4& x0, const f32x4& x1, int row, int col) {
            bf16* hp = HB + (size_t)row * D + col;
            const f32x4 h0 = bf4(*(const v2u*)hp) + x0, h1 = bf4(*(const v2u*)(hp + (size_t)16 * D)) + x1;
            *(v2u*)hp = pack4(h0[0], h0[1], h0[2], h0[3]); *(v2u*)(hp + (size_t)16 * D) = pack4(h1[0], h1[1], h1[2], h1[3]);
            float s0 = (h0[0] * h0[0] + h0[1] * h0[1]) + (h0[2] * h0[2] + h0[3] * h0[3]), s1 = (h1[0] * h1[0] + h1[1] * h1[1]) + (h1[2] * h1[2] + h1[3] * h1[3]);
            s0 += __shfl_xor(s0, 16); s0 += __shfl_xor(s0, 32); s1 += __shfl_xor(s1, 16); s1 += __shfl_xor(s1, 32);
            if ((lane >> 4) == 0) { red[(row - r0) * 4 + (wave & 3)] = s0; red[(row - r0 + 16) * 4 + (wave & 3)] = s1; }
        };
        mini_tile<false, decltype(epi_), ATILE>(C.lds, A, Bt, K, r0, c0, lane, wave, epi_);
        __syncthreads();
        if (C.tid < 64) { const f32x4 p = *(const LAS f32x4*)(red + C.tid * 4); SSQ[(size_t)(r0 + C.tid) * 16 + cb] = (p[0] + p[1]) + (p[2] + p[3]); }
        __syncthreads();
    }
}
template <bool FP8> __device__ __forceinline__ void mini_y_phase(Ctx& C, const bf16* A, const bf16* Bt, size_t bstride_el, int K, float sc, int plim, int pend, int p1, int p2, int p3, int p4, int p5, int p6, int p7) {
    const int ntile = (pend - plim) * 4 * 16;
    bf16* Y = C.Y();
    for (int mt = C.bid; mt < ntile; mt += C.G) {
        const int rb = mt >> 4, cb = mt & 15, pm = plim + (rb >> 2), r0 = plim * 256 + 64 * rb, c0 = 64 * cb;
        const int e = (pm >= p1) + (pm >= p2) + (pm >= p3) + (pm >= p4) + (pm >= p5) + (pm >= p6) + (pm >= p7);
        auto epi_ = [&](const f32x4& x0, const f32x4& x1, int row, int col) {
            *(v2u*)(Y + (size_t)row * D + col) = pack4(x0[0] * sc, x0[1] * sc, x0[2] * sc, x0[3] * sc); *(v2u*)(Y + (size_t)(row + 16) * D + col) = pack4(x1[0] * sc, x1[1] * sc, x1[2] * sc, x1[3] * sc);
        };
        mini_tile<FP8, decltype(epi_), ((FP8 && T8_TILED == 2) ? 1 : (FP8 && T8_TILED) ? 32 : 0)>(C.lds, A, Bt + (size_t)e * bstride_el, K, r0, c0, C.lane, C.wave, epi_);
    }
}

constexpr int RMAX = 128;
__device__ __forceinline__ void route_phase(Ctx& C, int li) {
    LAS float* rf = (LAS float*)C.lds;
    LAS int* lcnt = (LAS int*)(C.lds + 32768);
    LAS int* lbase = lcnt + 8;
    LAS int* ti = lbase + 8;
    LAS float* tf = (LAS float*)(ti + RMAX * 4);
    const int tid = C.tid, lane = C.lane;
    for (int i = tid; i < 8192; i += 512) rf[i] = C.RF()[li * 8192 + i];
    if (tid < 8) lcnt[tid] = 0;
    __syncthreads();
    const int nrows = (NTOK - C.bid + C.G - 1) / C.G;
    v2u nx[4];
#define RT_ROWLOAD(kk) do { const size_t r_ = (size_t)C.bid + (size_t)(kk) * C.G; _Pragma("unroll") for (int j = 0; j < 4; ++j) nx[j] = *(const v2u*)(C.HB() + r_ * D + 4 * lane + 256 * j); } while (0)
    if (C.wave < nrows) RT_ROWLOAD(C.wave);
    for (int k = C.wave; k < nrows; k += 8) {
        const size_t row = (size_t)C.bid + (size_t)k * C.G;
        v2u cur[4];
#pragma unroll
        for (int j = 0; j < 4; ++j) cur[j] = nx[j];
        if (k + 8 < nrows) RT_ROWLOAD(k + 8);
        if ((int)(row % LT) < FIRSTV) { if (lane == 0) ti[k * 4] = -1; continue; }
        f32x4 v[4]; float ss = 0.f;
#pragma unroll
        for (int j = 0; j < 4; ++j) { v[j] = bf4(cur[j]); ss += (v[j][0] * v[j][0] + v[j][1] * v[j][1]) + (v[j][2] * v[j][2] + v[j][3] * v[j][3]); }
        ss = wave_sum(ss);
        const float rstd = rsqrtf(ss * (1.0f / 1024.0f) + EPS);
        float lg[8];
#pragma unroll
        for (int e = 0; e < 8; ++e) {
            float p = 0.f;
#pragma unroll
            for (int j = 0; j < 4; ++j) { const f32x4 w = *(const LAS f32x4*)(rf + e * 1024 + 4 * lane + 256 * j); p += (v[j][0] * w[0] + v[j][1] * w[1]) + (v[j][2] * w[2] + v[j][3] * w[3]); }
            lg[e] = wave_sum(p) * rstd;
        }
        int e1 = 0; float l1 = lg[0];
#pragma unroll
        for (int e = 1; e < 8; ++e) if (lg[e] > l1) { l1 = lg[e]; e1 = e; }
        int e2 = -1; float l2 = -3.0e38f;
#pragma unroll
        for (int e = 0; e < 8; ++e) if (e != e1 && lg[e] > l2) { l2 = lg[e]; e2 = e; }
        const float g1 = 1.f / (1.f + expf(l2 - l1)), g2 = 1.f - g1;
        if (lane == 0) {
            const int lr1 = __hip_atomic_fetch_add(&lcnt[e1], 1, __ATOMIC_RELAXED, __HIP_MEMORY_SCOPE_WORKGROUP), lr2 = __hip_atomic_fetch_add(&lcnt[e2], 1, __ATOMIC_RELAXED, __HIP_MEMORY_SCOPE_WORKGROUP);
            ti[k * 4 + 0] = e1; ti[k * 4 + 1] = e2; ti[k * 4 + 2] = lr1; ti[k * 4 + 3] = lr2;
            tf[k * 4 + 0] = g1; tf[k * 4 + 1] = g2; tf[k * 4 + 2] = rstd;
        }
    }
#undef RT_ROWLOAD
    __syncthreads();
#if PUSH_GATHER
    if (tid < 8) ((int*)(C.ws + WS_ROUTE + ROUTE_LIST))[((size_t)li * C.G + C.bid) * 8 + tid] = lcnt[tid];
#else
    if (tid < 8) lbase[tid] = (int)__hip_atomic_fetch_add(C.ctl() + CW_CNT + (li * 8 + tid) * 64, (unsigned)lcnt[tid], RLX_AGENT);
    __syncthreads();
    for (int k = tid; k < nrows; k += 512) {
        const int row = C.bid + k * C.G;
        if (ti[k * 4] < 0) continue;
        const int e1 = ti[k * 4], e2 = ti[k * 4 + 1], r1 = lbase[e1] + ti[k * 4 + 2], r2 = lbase[e2] + ti[k * 4 + 3];
        C.LIST()[(size_t)e1 * NTOK + r1] = row; C.LIST()[(size_t)e2 * NTOK + r2] = row;
        unsigned* inf = C.TINFO() + (size_t)row * 8;
        inf[0] = (unsigned)e1; inf[1] = (unsigned)e2; inf[2] = (unsigned)r1; inf[3] = (unsigned)r2; inf[4] = __builtin_bit_cast(unsigned, tf[k * 4]); inf[5] = __builtin_bit_cast(unsigned, tf[k * 4 + 1]);
        C.RSTD()[row] = tf[k * 4 + 2];
    }
    __syncthreads();
#endif
}
__device__ __forceinline__ void load_panels(Ctx& C, int li, LAS int* pst) {
    __syncthreads();
    if (C.tid == 0) { int acc = 0;
        for (int e = 0; e < 8; ++e) { const int c = (int)__hip_atomic_load(C.ctl() + CW_CNT + (li * 8 + e) * 64, RLX_AGENT); pst[e] = acc; pst[16 + e] = c; acc += (c + 255) >> 8; }
        pst[8] = acc; }
    __syncthreads();
}
#if PUSH_GATHER
__device__ __forceinline__ void push_phase(Ctx& C, int li) {
    LAS int* lcnt = (LAS int*)(C.lds + 32768);
    LAS int* lbase = lcnt + 8;
    LAS int* ti = lbase + 8;
    LAS float* tf = (LAS float*)(ti + RMAX * 4);
    LAS int* pst = (LAS int*)C.lds;
    const int tid = C.tid, lane = C.lane;
    const int* cntb = (const int*)(C.ws + WS_ROUTE + ROUTE_LIST) + (size_t)li * C.G * 8;
    LAS int* cb = (LAS int*)(C.lds + 4096);
    for (int i = tid; i < C.G * 8; i += 512) cb[i] = cntb[i];
    __syncthreads();
    if (tid < 16) {
        const int e = tid & 7, nb = (tid < 8) ? C.G : C.bid;
        int s = 0;
        for (int b = 0; b < nb; ++b) s += cb[b * 8 + e];
        if (tid < 8) { pst[16 + e] = s; if (C.bid == 0) __hip_atomic_store(C.ctl() + CW_CNT + (li * 8 + e) * 64, (unsigned)s, RLX_AGENT); }
        else lbase[e] = s;
    }
    __syncthreads();
    if (tid == 0) { int acc = 0; for (int e = 0; e < 8; ++e) { pst[e] = acc; acc += (pst[16 + e] + 255) >> 8; } pst[8] = acc; }
    __syncthreads();
    const int nrows = (NTOK - C.bid + C.G - 1) / C.G;
    for (int k = C.wave; k < nrows; k += 8) {
        if (ti[k * 4] < 0) continue;
        const size_t row = (size_t)C.bid + (size_t)k * C.G;
        const int e1 = ti[k * 4], e2 = ti[k * 4 + 1], r1 = lbase[e1] + ti[k * 4 + 2], r2 = lbase[e2] + ti[k * 4 + 3];
        const size_t s1 = (size_t)pst[e1] * 256 + r1, s2 = (size_t)pst[e2] * 256 + r2;
        const float r = tf[k * 4 + 2];
        if (lane == 0) { unsigned* inf = C.TINFO() + row * 8; *(v4u*)inf = (v4u){(unsigned)e1, (unsigned)e2, (unsigned)r1, (unsigned)r2}; *(v2u*)(inf + 4) = (v2u){__builtin_bit_cast(unsigned, tf[k * 4]), __builtin_bit_cast(unsigned, tf[k * 4 + 1])}; }
        if ((FP8_MOE_MASK >> li) & 1) {
            unsigned* x1 = (unsigned*)(C.ws + WS_XG + s1 * D); unsigned* x2 = (unsigned*)(C.ws + WS_XG + s2 * D);
#pragma unroll
            for (int j = 0; j < 4; ++j) { const f32x4 v = bf4(*(const v2u*)(C.HB() + row * D + 4 * lane + 256 * j)); const unsigned w = pk_fp8x4(v[0] * r, v[1] * r, v[2] * r, v[3] * r); x1[lane + 64 * j] = w; x2[lane + 64 * j] = w; }
        } else {
            bf16* x1 = C.XG() + s1 * D; bf16* x2 = C.XG() + s2 * D;
#pragma unroll
            for (int j = 0; j < 4; ++j) { const f32x4 v = bf4(*(const v2u*)(C.HB() + row * D + 4 * lane + 256 * j)); v2u w; w.x = pk2(v[0] * r, v[1] * r); w.y = pk2(v[2] * r, v[3] * r); *(v2u*)(x1 + 4 * lane + 256 * j) = w; *(v2u*)(x2 + 4 * lane + 256 * j) = w; }
        }
    }
    __syncthreads();
}
#endif
__device__ __forceinline__ void gather_phase(Ctx& C, int li) {
    LAS int* pst = (LAS int*)C.lds;
    load_panels(C, li, pst);
    const int gw = C.bid * 8 + C.wave, NGW = C.G * 8, lane = C.lane;
    const int nslot = pst[8] * 256;
    for (int s = gw; s < nslot; s += NGW) {
        const int panel = s >> 8; int e = 0;
#pragma unroll
        for (int j = 1; j < 8; ++j) if (panel >= pst[j]) e = j;
        const int rank = s - pst[e] * 256;
        if ((FP8_MOE_MASK >> li) & 1) {
            unsigned* xp8 = (unsigned*)(C.ws + WS_XG + (size_t)s * D);
            if (rank < pst[16 + e]) {
                const int tok = C.LIST()[(size_t)e * NTOK + rank]; const float r = C.RSTD()[tok];
#pragma unroll
                for (int j = 0; j < 4; ++j) { const f32x4 v = bf4(*(const v2u*)(C.HB() + (size_t)tok * D + 4 * lane + 256 * j)); xp8[lane + 64 * j] = pk_fp8x4(v[0] * r, v[1] * r, v[2] * r, v[3] * r); }
            } else {
#pragma unroll
                for (int j = 0; j < 4; ++j) xp8[lane + 64 * j] = 0u;
            }
            continue;
        }
        bf16* xp = C.XG() + (size_t)s * D;
        if (rank < pst[16 + e]) {
            const int tok = C.LIST()[(size_t)e * NTOK + rank]; const float r = C.RSTD()[tok];
#pragma unroll
            for (int j = 0; j < 4; ++j) { const f32x4 v = bf4(*(const v2u*)(C.HB() + (size_t)tok * D + 4 * lane + 256 * j)); v2u w; w.x = pk2(v[0] * r, v[1] * r); w.y = pk2(v[2] * r, v[3] * r); *(v2u*)(xp + 4 * lane + 256 * j) = w; }
        } else {
#pragma unroll
            for (int j = 0; j < 4; ++j) *(v2u*)(xp + 4 * lane + 256 * j) = (v2u){0u, 0u};
        }
    }
}
__device__ __forceinline__ void combine_phase(Ctx& C, int li, bool last, bool dry = false) {
    LAS int* pst = (LAS int*)C.lds;
    load_panels(C, li, pst);
    const int gw = C.bid * 8 + C.wave, NGW = C.G * 8, lane = C.lane;
#if COMB_PIPE
    v4u ia = (v4u){0u, 0u, 0u, 0u}, ib = ia, ja = ia, jb = ia;
    v2u hd[4], ya[4], yb[4];
    v2u hn[4], na[4], nb[4];
#pragma unroll
    for (int j = 0; j < 4; ++j) { hn[j] = (v2u){0u, 0u}; na[j] = hn[j]; nb[j] = hn[j]; }
#define CB_LIVE(r) ((r) < NTOK && ((r) % LT) >= FIRSTV)
#define CB_INFO(r, A_, B_) do { if (CB_LIVE(r)) { const v4u* p_ = (const v4u*)(C.TINFO() + (size_t)(r) * 8); A_ = p_[0]; B_ = p_[1]; } } while (0)
#define CB_DATA(r, A_, H_, Y1_, Y2_) do { if (CB_LIVE(r)) { const size_t s1_ = (size_t)pst[(int)A_.x] * 256 + A_.z, s2_ = (size_t)pst[(int)A_.y] * 256 + A_.w; \
        _Pragma("unroll") for (int j = 0; j < 4; ++j) { const int col_ = 4 * lane + 256 * j; H_[j] = *(const v2u*)(C.HB() + (size_t)(r) * D + col_); Y1_[j] = *(const v2u*)(C.Y() + s1_ * D + col_); Y2_[j] = *(const v2u*)(C.Y() + s2_ * D + col_); } } } while (0)
    CB_INFO(gw, ia, ib);
    CB_INFO(gw + NGW, ja, jb);
    CB_DATA(gw, ia, hn, na, nb);
    for (int row = gw; row < NTOK; row += NGW) {
        const v4u ca = ia, cb = ib;
#pragma unroll
        for (int j = 0; j < 4; ++j) { hd[j] = hn[j]; ya[j] = na[j]; yb[j] = nb[j]; }
        ia = ja; ib = jb;
        CB_DATA(row + NGW, ia, hn, na, nb);
        CB_INFO(row + 2 * NGW, ja, jb);
        if ((row % LT) < FIRSTV) continue;
        const float g1 = __builtin_bit_cast(float, cb.x), g2 = __builtin_bit_cast(float, cb.y);
        f32x4 v[4]; float ss = 0.f;
#pragma unroll
        for (int j = 0; j < 4; ++j) {
            v[j] = bf4(hd[j]);
            const v2u a = ya[j], b = yb[j];
            v[j][0] += g1 * bf_lo(a.x) + g2 * bf_lo(b.x); v[j][1] += g1 * bf_hi(a.x) + g2 * bf_hi(b.x);
            v[j][2] += g1 * bf_lo(a.y) + g2 * bf_lo(b.y); v[j][3] += g1 * bf_hi(a.y) + g2 * bf_hi(b.y);
            ss += (v[j][0] * v[j][0] + v[j][1] * v[j][1]) + (v[j][2] * v[j][2] + v[j][3] * v[j][3]);
        }
#else
    for (int row = gw; row < NTOK; row += NGW) {
        if ((row % LT) < FIRSTV) continue;
        const unsigned* inf = C.TINFO() + (size_t)row * 8;
        const int e1 = (int)inf[0], e2 = (int)inf[1];
        const size_t s1 = (size_t)pst[e1] * 256 + inf[2], s2 = (size_t)pst[e2] * 256 + inf[3];
        const float g1 = __builtin_bit_cast(float, inf[4]), g2 = __builtin_bit_cast(float, inf[5]);
        f32x4 v[4]; float ss = 0.f;
#pragma unroll
        for (int j = 0; j < 4; ++j) {
            const int col = 4 * lane + 256 * j;
            v[j] = bf4(*(const v2u*)(C.HB() + (size_t)row * D + col));
            const v2u a = *(const v2u*)(C.Y() + s1 * D + col), b = *(const v2u*)(C.Y() + s2 * D + col);
            v[j][0] += g1 * bf_lo(a.x) + g2 * bf_lo(b.x); v[j][1] += g1 * bf_hi(a.x) + g2 * bf_hi(b.x);
            v[j][2] += g1 * bf_lo(a.y) + g2 * bf_lo(b.y); v[j][3] += g1 * bf_hi(a.y) + g2 * bf_hi(b.y);
            ss += (v[j][0] * v[j][0] + v[j][1] * v[j][1]) + (v[j][2] * v[j][2] + v[j][3] * v[j][3]);
        }
#endif
        ss = wave_sum(ss);
        if (!last) {
            bf16* hbo = dry ? (bf16*)(C.ws + WS_H) : C.HB(); float* sso = dry ? (float*)(C.ws + WS_H + 40 * MiB) : C.SSQ();
#pragma unroll
            for (int j = 0; j < 4; ++j) { const int col = 4 * lane + 256 * j; v2u w; w.x = pk2(v[j][0], v[j][1]); w.y = pk2(v[j][2], v[j][3]); *(v2u*)(hbo + (size_t)row * D + col) = w; }
            if (lane < 16) sso[(size_t)row * 16 + lane] = (lane == 0) ? ss : 0.f;
        } else {
            const int b = row / LT, t = row % LT;
            if (t >= LEAD) {
                const float rs = rsqrtf(ss * (1.0f / 1024.0f) + EPS);
#pragma unroll
                for (int j = 0; j < 4; ++j) { const int col = 4 * lane + 256 * j; const f32x4 fw = *(const f32x4*)(C.FNORM() + col);
                    *(f32x4*)((dry ? (float*)(C.ws + WS_H) : C.out) + ((size_t)b * SEQ + (t - LEAD)) * D + col) = (f32x4){v[j][0] * rs * fw[0], v[j][1] * rs * fw[1], v[j][2] * rs * fw[2], v[j][3] * rs * fw[3]}; }
            }
        }
    }
#if COMB_PIPE
#undef CB_LIVE
#undef CB_INFO
#undef CB_DATA
#endif
}

__global__ void __launch_bounds__(512, 2) mk_fwd(Args args) {
    extern __shared__ __attribute__((aligned(16))) unsigned char lds[];
    Ctx C;
    C.lds = (LAS unsigned char*)lds;
    C.tid = threadIdx.x; C.lane = C.tid & 63; C.wave = __builtin_amdgcn_readfirstlane(C.tid >> 6); C.G = gridDim.x; C.bid = blockIdx.x;
    unsigned char* ws = args.ws; C.ws = ws; C.out = args.out;
    volatile LAS unsigned* MISC = (volatile LAS unsigned*)(C.lds + MISC_OFF);
    for (int u = C.tid; u < (LDS_BYTES - RING_BYTES) / 4; u += 512) ((LAS unsigned*)(C.lds + RING_BYTES))[u] = 0u;
    __syncthreads();
    const int lo = args.ph_lo, hi = args.ph_hi;
    const bool multi = (hi - lo) > 1;
    XcdBarrier bar; bar.bar = (unsigned*)(C.ctl() + CW_BAR); bar.x = 0; bar.st = nullptr;
    if (multi) bar = xcd_barrier_post((unsigned*)(C.ctl() + CW_BAR), MISC + 8);
#define PHASE_CTX(P) Ctx P = C; { GAS unsigned char* w_ = (GAS unsigned char*)C.ws; asm volatile("" : "+s"(w_)); P.ws = (unsigned char*)w_;     int t_ = C.tid; asm volatile("" : "+v"(t_)); P.tid = t_; P.lane = t_ & 63; P.wave = __builtin_amdgcn_readfirstlane(t_ >> 6); int g_ = C.G, b_ = C.bid; asm volatile("" : "+s"(g_), "+s"(b_)); P.G = g_; P.bid = b_; }
#define IN(k) (lo_l <= (k) && (k) < hi_l)
#define SEAM(k) do { if ((k) + 1 < hi_l) { xcd_barrier(bar); if (PROBE_XBAR) xcd_barrier(bar); } } while (0)

    { int lo_l = lo, hi_l = hi; asm volatile("" : "+s"(lo_l), "+s"(hi_l));
      if (IN(0)) { for (int rep = 0; rep < REP_PRO; ++rep) { PHASE_CTX(P); prologue_phase(P, args, (rep + 1 < REP_PRO) ? PRO_MODE : 0); SEAM(0); } } }

    for (int l = 0; l < DEPTH; ++l) {
        int lo_l = lo, hi_l = hi; asm volatile("" : "+s"(lo_l), "+s"(hi_l));
        const int pb = 1 + 8 * l, li = l >> 1; const bool moe = (l & 1) != 0;
        if (PROBE_PROJ_NOEPI && IN(pb + 0)) {
            PHASE_CTX(P);
            pg8::Gemm g{P.HB(), (const bf16*)(P.ws + WS_WIN) + (size_t)l * WIN * D, NTOK, WIN, D, 0};
            pg8::StaticOrder S; S.init(NTOK, WIN, P.G, P.bid);
            EpiNone E{(unsigned*)(P.ws + WS_CTL) + 64};
            pg8::gemm_phase<EpiNone, pg8::StaticOrder, true, true>(P.lds, g, S, E);
            SEAM(pb + 0);
        }
        if (PROBE_WOUT_NOEPI && IN(pb + 2)) {
            PHASE_CTX(P);
            pg8::Gemm g{P.HB(), (const bf16*)(P.ws + WS_WOUT) + (size_t)l * D * D, NTOK, D, D, 0};
            pg8::StaticOrder S; S.init(NTOK, D, P.G, P.bid);
            EpiNone E{(unsigned*)(P.ws + WS_CTL) + 64};
            pg8::gemm_phase<EpiNone, pg8::StaticOrder, true, true>(P.lds, g, S, E);
            SEAM(pb + 0);
        }
        if (PROBE_FF2_NOEPI && IN(pb + 2)) {
            PHASE_CTX(P);
            pg8::Gemm g{(const bf16*)(P.ws + WS_WD13), (const bf16*)(P.ws + WS_WD2) + (size_t)li * D * FFD, NTOK, D, FFD, 0};
            pg8::StaticOrder S; S.init(NTOK, D, P.G, P.bid);
            EpiNone E{(unsigned*)(P.ws + WS_CTL) + 64};
            pg8::gemm_phase<EpiNone, pg8::StaticOrder, true, true>(P.lds, g, S, E);
            SEAM(pb + 0);
        }
        if (IN(pb + 0)) for (int rep = 0; rep < REP_PROJ; ++rep) {
            PHASE_CTX(P);
            pg8::Gemm g{P.HB(), (const bf16*)(P.ws + WS_WIN) + (size_t)l * WIN * D, NTOK, WIN, D, 0};
            EpiProj E{P.PROJ(), P.LOGF(), (const LAS float*)(P.lds + RS_OFF), P.LB() + l * 512, P.HGNW() + l * 128, P.ws + WS_H, (rep + 1 < REP_PROJ) ? PROJ_PROBE : 0};
            if (P.G == 256) {
                pg8::ProjOrder S{P.bid};
                rstd_table(P.lds, P.SSQ(), S, P.tid);
                pg8::gemm_phase<EpiProj, pg8::ProjOrder, true, true>(P.lds, g, S, E);
            } else {
                pg8::StaticOrder S; S.init(NTOK, WIN, P.G, P.bid);
                rstd_table(P.lds, P.SSQ(), S, P.tid);
                pg8::gemm_phase<EpiProj, pg8::StaticOrder, true, true>(P.lds, g, S, E);
            }
            SEAM(pb + 0);
        }
        if (IN(pb + 1)) _Pragma("nounroll") for (int rep = 0; rep < REP_MIX; ++rep) { PHASE_CTX(P);
#if HG_TWO_STAGE
            for (int rp = 0; rp < REP_HGPRE; ++rp) { hgrn_pre_phase(P, l); xcd_barrier(bar); }
#endif
            mixer_phase(P, l); SEAM(pb + 1); }
        if (IN(pb + 2)) {
            PHASE_CTX(P);
            pg8::Gemm g{P.MIX(), (const bf16*)(P.ws + WS_WOUT) + (size_t)l * D * D, NTOK, D, D, 0};
            pg8::StaticOrder S; S.init(MAINROWS, D, P.G, P.bid);
            EpiResid E{P.HB(), P.SSQ()};
            pg8::gemm_phase<EpiResid, pg8::StaticOrder, true, true>(P.lds, g, S, E);
            mini_resid_phase(P, g.A, g.Bt, D, MAINROWS);
            SEAM(pb + 2);
        }
        if (!moe) {
            if (IN(pb + 5)) for (int rep = 0; rep < REP_FF1; ++rep) {
                PHASE_CTX(P);
                pg8::Gemm g{P.HB(), (const bf16*)(P.ws + WS_WD13) + (size_t)li * 2 * FFD * D, NTOK, 2 * FFD, D, 0};
                pg8::StaticOrder S; S.init(NTOK, 2 * FFD, P.G, P.bid);
                rstd_table(P.lds, P.SSQ(), S, P.tid);
                if (STAG_FF1D) stagger_start(P.bid, STAG_FF1D);
                EpiGLU E{P.T(), FFD, (const LAS float*)(P.lds + RS_OFF), (rep + 1 < REP_FF1 && (FF1_PROBE & 3)) ? 1 : 0, true};
                pg8::gemm_phase<EpiGLU, pg8::StaticOrder, true, true>(P.lds, g, S, E);
                SEAM(pb + 5);
            }
            if (IN(pb + 6)) {
                PHASE_CTX(P);
                pg8::Gemm g{P.T(), (const bf16*)(P.ws + WS_WD2) + (size_t)li * D * FFD, NTOK, D, FFD, 0};
                pg8::StaticOrder S; S.init(MAINROWS, D, P.G, P.bid);
                EpiResid E{P.HB(), P.SSQ()};
                pg8::gemm_phase<EpiResid, pg8::StaticOrder, true, true, false, (TD_TILED ? 64 : 0)>(P.lds, g, S, E);
                mini_resid_phase<(TD_TILED ? 64 : 0)>(P, g.A, g.Bt, FFD, MAINROWS);
                SEAM(pb + 6);
            }
        } else {
            if (IN(pb + 3)) for (int rep = 0; rep < REP_ROUTE; ++rep) { PHASE_CTX(P);
                if (rep > 0) { if (P.bid == 0 && P.tid < 8) __hip_atomic_store(P.ctl() + CW_CNT + (li * 8 + P.tid) * 64, 0u, RLX_AGENT); xcd_barrier(bar); }
                route_phase(P, li); SEAM(pb + 3); }
            if (IN(pb + 4)) for (int rep = 0; rep < REP_GATHER; ++rep) { PHASE_CTX(P);
#if PUSH_GATHER
                push_phase(P, li);
#else
                gather_phase(P, li);
#endif
                SEAM(pb + 4); }
            if (IN(pb + 5)) for (int rep = 0; rep < REP_FF1; ++rep) {
                PHASE_CTX(P);
                LAS int* pst = (LAS int*)(P.lds + RING_BYTES + 1024);
                load_panels(P, li, pst);
#define PS(i) __builtin_amdgcn_readfirstlane(pst[i])
                pg8::GroupedOrder S{PS(0), PS(1), PS(2), PS(3), PS(4), PS(5), PS(6), PS(7), PS(8), 2 * FFE / 256, P.G, P.bid};
                if (FP8_MOE_MASK != 0 && ((FP8_MOE_MASK >> li) & 1)) {
                    pg8::Gemm g{(const bf16*)(P.ws + WS_XG), (const bf16*)(P.ws + WS_WM13 + (size_t)li * 8 * 2 * FFE * D * 2), 0, 2 * FFE, D / 2, (size_t)2 * FFE * D};
                    EpiGLU8 E{P.ws + WS_ACT, FFE, 1.0f / 32.0f, (rep + 1 < REP_FF1 && (FF1_PROBE & 5)) ? 1 : 0};
                    pg8::gemm_phase<EpiGLU8, pg8::GroupedOrder, true, true, true>(P.lds, g, S, E);
                } else if (FP8_MOE_MASK != 3) {
                    pg8::Gemm g{P.XG(), (const bf16*)(P.ws + WS_WM13) + (size_t)li * 8 * 2 * FFE * D, 0, 2 * FFE, D, (size_t)2 * FFE * D * 2};
                    if (STAG_FF1M) stagger_start(P.bid, STAG_FF1M);
                    EpiGLU E{P.T(), FFE, nullptr, 0, false};
                    pg8::gemm_phase<EpiGLU, pg8::GroupedOrder, true, true>(P.lds, g, S, E);
                }
                SEAM(pb + 5);
            }
            if (IN(pb + 6)) {
                PHASE_CTX(P);
                LAS int* pst = (LAS int*)(P.lds + RING_BYTES + 1024);
                load_panels(P, li, pst);
                const int ptot = PS(8), pfull = (ptot / 64) * 64, plim = (ptot - pfull <= 32) ? pfull : ptot;
                pg8::GroupedPanelOrder S{PS(1), PS(2), PS(3), PS(4), PS(5), PS(6), PS(7), plim, D / 256, P.G, P.bid};
                if (FP8_MOE_MASK != 0 && ((FP8_MOE_MASK >> li) & 1)) {
                    pg8::Gemm g{(const bf16*)(P.ws + WS_ACT), (const bf16*)(P.ws + WS_WM2 + (size_t)li * 8 * D * FFE * 2), 0, D, FFE / 2, (size_t)D * FFE};
                    EpiY E{P.Y(), 1.0f / 1024.0f};
                    _Pragma("nounroll") for (int rep = 0; rep < REP_FF2M; ++rep) { if (rep) __syncthreads(); pg8::gemm_phase<EpiY, pg8::GroupedPanelOrder, true, true, true, (T8_TILED == 2 ? 1 : T8_TILED ? 32 : 0)>(P.lds, g, S, E); }
                    mini_y_phase<true>(P, g.A, g.Bt, (size_t)D * FFE / 2, FFE / 2, 1.0f / 1024.0f, plim, ptot, PS(1), PS(2), PS(3), PS(4), PS(5), PS(6), PS(7));
                } else if (FP8_MOE_MASK != 3) {
                    pg8::Gemm g{P.T(), (const bf16*)(P.ws + WS_WM2) + (size_t)li * 8 * D * FFE, 0, D, FFE, (size_t)D * FFE * 2};
                    EpiY E{P.Y(), 1.0f};
                    pg8::gemm_phase<EpiY, pg8::GroupedPanelOrder, true, true>(P.lds, g, S, E);
                    mini_y_phase<false>(P, g.A, g.Bt, (size_t)D * FFE, FFE, 1.0f, plim, ptot, PS(1), PS(2), PS(3), PS(4), PS(5), PS(6), PS(7));
                }
                SEAM(pb + 6);
            }
#undef PS
            if (IN(pb + 7)) { for (int rep = 1; rep < REP_COMB; ++rep) { PHASE_CTX(P); combine_phase(P, li, l == DEPTH - 1, true); xcd_barrier(bar); }
                PHASE_CTX(P); combine_phase(P, li, l == DEPTH - 1); SEAM(pb + 7); }
        }
    }
#undef IN
#undef SEAM
#undef PHASE_CTX
}

extern "C" void kernel_launch(void* const* d_in, const int* in_sizes, int n_in, void* d_out, int out_size, void* d_ws, size_t ws_size, hipStream_t stream) {
    static int grid = 0;
    if (grid == 0) {
        if (n_in != 19 || out_size != NB * SEQ * D || ws_size < WS_END) { fprintf(stderr, "kernel_launch: unexpected shapes (n_in %d, out %d, ws %zu < %zu); nothing launched\n", n_in, out_size, ws_size, (size_t)WS_END); grid = -1; return; }
        int dev = 0, cus = 0, per_cu = 0;
        if (hipGetDevice(&dev) != hipSuccess || hipDeviceGetAttribute(&cus, hipDeviceAttributeMultiprocessorCount, dev) != hipSuccess) { grid = -1; return; }
        if (hipFuncSetAttribute((const void*)mk_fwd, hipFuncAttributeMaxDynamicSharedMemorySize, LDS_BYTES) != hipSuccess) { fprintf(stderr, "kernel_launch: hipFuncSetAttribute failed\n"); grid = -1; return; }
        if (hipOccupancyMaxActiveBlocksPerMultiprocessor(&per_cu, (const void*)mk_fwd, 512, LDS_BYTES) != hipSuccess || per_cu < 1) { fprintf(stderr, "kernel_launch: occupancy query says %d blocks per CU\n", per_cu); }
        (void)hipGetLastError();
        grid = cus;
    }
    if (grid < 0) return;
    if (hipMemsetAsync((char*)d_ws + WS_CTL, 0, CTL_ZERO_BYTES, stream) != hipSuccess) return;
    Args a{};
    for (int i = 0; i < 19; ++i) a.in[i] = (const float*)d_in[i];
    a.out = (float*)d_out; a.ws = (unsigned char*)d_ws;
#if MK_ONE_LAUNCH
    a.ph_lo = 0; a.ph_hi = NPHASE;
    hipLaunchKernelGGL(mk_fwd, dim3(grid), dim3(512), LDS_BYTES, stream, a);
#else
    for (int p = 0; p < NPHASE; ++p) {
        if (p > 0) { const int l = (p - 1) / 8, k = (p - 1) % 8; const bool moe = (l & 1) != 0; if (!moe && (k == 3 || k == 4 || k == 7)) continue; }
        a.ph_lo = p; a.ph_hi = p + 1;
        hipLaunchKernelGGL(mk_fwd, dim3(grid), dim3(512), LDS_BYTES, stream, a);
    }
#endif
}
```

```cpp
#include <hip/hip_runtime.h>
#include <cstdio>
#include <cstdint>

#ifndef REP_ATT
#define REP_ATT 1
#endif
#ifndef REP_HG
#define REP_HG 1
#endif
#ifndef PROBE_PROJ_NOEPI
#define PROBE_PROJ_NOEPI 0
#endif
#ifndef PROBE_WOUT_NOEPI
#define PROBE_WOUT_NOEPI 0
#endif
#ifndef PROBE_FF2_NOEPI
#define PROBE_FF2_NOEPI 0
#endif
#ifndef PROBE_XBAR
#define PROBE_XBAR 0
#endif
#ifndef NT_STORES
#define NT_STORES 0
#endif
#ifndef STAG_PROJ
#define STAG_PROJ 0
#endif
#ifndef STAG_FF1D
#define STAG_FF1D 0
#endif
#ifndef STAG_FF1M
#define STAG_FF1M 0
#endif
#ifndef FP8_MOE_MASK
#define FP8_MOE_MASK 3
#endif
#ifndef REP_ROUTE
#define REP_ROUTE 1
#endif
#ifndef REP_COMB
#define REP_COMB 1
#endif
#ifndef COMB_PIPE
#define COMB_PIPE 0
#endif
#ifndef NT_WLOAD
#define NT_WLOAD 1
#endif
#ifndef XOR32_PERMLANE
#define XOR32_PERMLANE 1
#endif
#ifndef WSUM_DPP
#define WSUM_DPP 1
#endif
#ifndef PUSH_GATHER
#define PUSH_GATHER 1
#endif
#ifndef HG_TWO_STAGE
#define HG_TWO_STAGE 0
#endif
#ifndef ATT_V2
#define ATT_V2 0
#endif
#ifndef PRO_MODE
#define PRO_MODE 0
#endif
#ifndef HG_EQ
#define HG_EQ 0
#endif
#if HG_EQ && HG_TWO_STAGE
#error "HG_EQ is wired into the one-stage chain only"
#endif
#ifndef HG_EQ_BOTH
#define HG_EQ_BOTH 0
#endif
#ifndef HG_EQ_CHAIN
#define HG_EQ_CHAIN HG_EQ
#endif
#ifndef HGV_DUP
#define HGV_DUP 0
#endif
#ifndef T8_TILED
#define T8_TILED 1
#endif
#ifndef FF1_PROBE
#define FF1_PROBE 0
#endif
#ifndef HG_C4MAP
#define HG_C4MAP 1
#endif
#ifndef HG_DSHAPE
#define HG_DSHAPE 1
#endif
#ifndef HF_MERGE
#define HF_MERGE 1
#endif
#if HF_MERGE && (HG_TWO_STAGE || HG_EQ)
#error "HF_MERGE is wired into the one-stage, non-EQ chain only"
#endif
#ifndef HF_V2
#define HF_V2 1
#endif
#ifndef PROJ_PROBE
#define PROJ_PROBE 0
#endif
#ifndef HGV_PREFILL
#define HGV_PREFILL 0
#endif
#ifndef HGV_MIB
#define HGV_MIB 24
#endif
#ifndef ATT_DRY2
#define ATT_DRY2 0
#endif
#ifndef REP_HGPRE
#define REP_HGPRE 1
#endif
#ifndef PRO_NT_ST
#define PRO_NT_ST 1
#endif
#ifndef PRO_F8_WIDE
#define PRO_F8_WIDE 1
#endif
#ifndef PRO_F8_DOUBLE
#define PRO_F8_DOUBLE 0
#endif
#ifndef REP_PRO
#define REP_PRO 1
#endif
#ifndef REP_PROJ
#define REP_PROJ 1
#endif
#ifndef REP_MIX
#define REP_MIX 1
#endif
#ifndef REP_FF1
#define REP_FF1 1
#endif
#ifndef REP_GATHER
#define REP_GATHER 1
#endif
#ifndef MK_ONE_LAUNCH
#define MK_ONE_LAUNCH 1
#endif
#if PUSH_GATHER && !MK_ONE_LAUNCH
#error "PUSH_GATHER keeps routing records in LDS across the grid barrier: one launch only"
#endif

namespace pg8 {
#define PG8_LAS __attribute__((address_space(3)))
typedef unsigned short bf16_t;
typedef short bf16x8 __attribute__((ext_vector_type(8)));
typedef float f32x4 __attribute__((ext_vector_type(4)));
typedef unsigned u32x4 __attribute__((ext_vector_type(4)));
typedef unsigned u32x2 __attribute__((ext_vector_type(2)));
constexpr int BM = 256, BK = 64, HALF = 128, HTB = HALF * BK * 2  , STAGE_BYTES = 8 * HTB, NXCD = 8, WGM = 8;

__host__ __device__ __forceinline__ int lds_byte(int r, int c) { const int st = (r >> 4) * 2 + (c >> 5), rr = r & 15, cc = c & 31, ob = rr * 64 + cc * 2; return st * 1024 + (ob ^ (((ob >> 9) & 1) << 5)); }
__host__ __device__ __forceinline__ void stage_rc(int b, int& R, int& C) { const int st = b / 1024, sb = b % 1024, swz = sb ^ (((sb >> 9) & 1) << 5); R = (st >> 1) * 16 + swz / 64; C = (st & 1) * 32 + (swz % 64) / 2; }
__host__ __device__ __forceinline__ int perm32(int rho) { const int n = rho >> 4, i = rho & 15; return 8 * (i >> 2) + 4 * n + (i & 3); }

struct Unit { int pm, pn, e, idx; };
struct Gemm { const bf16_t* A; const bf16_t* Bt; int M, N, K; size_t bstride; };

struct StaticOrder {
    int nM, nN, nwg, G, c;
    __host__ __device__ void init(int M, int N, int G_, int c_) { nM = M / BM; nN = N / BM; nwg = nM * nN; G = G_; c = c_; }
    __host__ __device__ bool next(int i, Unit& u) const {
        const long L = (long)i * G + c; if (L >= nwg) return false;
        int wgid = (int)L; { const int q = nwg / NXCD, r = nwg % NXCD, xcd = wgid % NXCD, off = wgid / NXCD; wgid = (xcd < r ? xcd * (q + 1) : r * (q + 1) + (xcd - r) * q) + off; }
        const int nig = WGM * nN, gid = wgid / nig, fm = gid * WGM, gsz = (nM - fm) < WGM ? (nM - fm) : WGM;
        u.pm = fm + ((wgid % nig) % gsz); u.pn = (wgid % nig) / gsz; u.e = 0; u.idx = i; return true;
    }
    __device__ __forceinline__ void a_ready(const Unit&) const {}
    __device__ __forceinline__ void done(const Unit&) const {}
};
struct ProjOrder {
    int c;
    __device__ __forceinline__ bool next(int i, Unit& u) const {
        const int p = i * 256 + c; if (p >= 952) return false;
        u.e = 0; u.idx = i;
        const int h0 = p - 184, h1 = p - 440;
        if (h0 >= 0 && h0 < 68) { const int k = 2 * h0; u.pm = k >> 1; u.pn = 2 + (k & 1); return true; }
        if (h1 >= 0 && h1 < 68) { const int k = 2 * h1 + 1; u.pm = k >> 1; u.pn = 2 + (k & 1); return true; }
        int q = p - (h0 < 0 ? 0 : (h0 > 68 ? 68 : h0)) - (h1 < 0 ? 0 : (h1 > 68 ? 68 : h1));
        q = (q & 7) * 102 + (q >> 3);
        int pm, t;
        if (q < 768) { const int g = q / 96, r = q - g * 96; pm = 8 * g + (r & 7); t = r >> 3; } else { const int r = q - 768; pm = 64 + (r & 3); t = r >> 2; }
        u.pm = pm; u.pn = t < 2 ? t : t + 2; return true;
    }
    __device__ __forceinline__ void a_ready(const Unit&) const {}
    __device__ __forceinline__ void done(const Unit&) const {}
};
struct GroupedPanelOrder {
    int p1, p2, p3, p4, p5, p6, p7, plim, nN, G, c;
    __device__ __forceinline__ bool next(int i, Unit& u) const {
        const int L = i * G + c; if (L >= plim * nN) return false;
        const int pm = L / nN; u.pm = pm; u.pn = L - pm * nN;
        u.e = (pm >= p1) + (pm >= p2) + (pm >= p3) + (pm >= p4) + (pm >= p5) + (pm >= p6) + (pm >= p7); u.idx = i; return true;
    }
    __device__ __forceinline__ void a_ready(const Unit&) const {}
    __device__ __forceinline__ void done(const Unit&) const {}
};
struct GroupedOrder {
    int p0, p1, p2, p3, p4, p5, p6, p7, p8, nN, G, c;
    __device__ __forceinline__ bool next(int i, Unit& u) const {
        const int L = i * G + c; if (L >= p8 * nN) return false;
        int e = 0, ps = 0, pe = p1;
        if (L >= p1 * nN) { e = 1; ps = p1; pe = p2; }
        if (L >= p2 * nN) { e = 2; ps = p2; pe = p3; }
        if (L >= p3 * nN) { e = 3; ps = p3; pe = p4; }
        if (L >= p4 * nN) { e = 4; ps = p4; pe = p5; }
        if (L >= p5 * nN) { e = 5; ps = p5; pe = p6; }
        if (L >= p6 * nN) { e = 6; ps = p6; pe = p7; }
        if (L >= p7 * nN) { e = 7; ps = p7; pe = p8; }
        const int rem = L - ps * nN, R = pe - ps;
        u.e = e; u.pn = rem / R; u.pm = ps + rem % R; u.idx = i; return true;
    }
    __device__ __forceinline__ void a_ready(const Unit&) const {}
    __device__ __forceinline__ void done(const Unit&) const {}
};

__device__ __forceinline__ unsigned cvt_pk_bf16(float lo, float hi) { unsigned r; asm volatile("v_cvt_pk_bf16_f32 %0, %1, %2" : "=v"(r) : "v"(lo), "v"(hi)); return r; }

typedef int i32x4 __attribute__((ext_vector_type(4)));
typedef int i32x8 __attribute__((ext_vector_type(8)));
__device__ __forceinline__ f32x4 mma8(bf16x8 b0, bf16x8 b1, bf16x8 a0, bf16x8 a1, f32x4 c) {
    const i32x8 b = __builtin_shufflevector(__builtin_bit_cast(i32x4, b0), __builtin_bit_cast(i32x4, b1), 0, 1, 2, 3, 4, 5, 6, 7);
    const i32x8 a = __builtin_shufflevector(__builtin_bit_cast(i32x4, a0), __builtin_bit_cast(i32x4, a1), 0, 1, 2, 3, 4, 5, 6, 7);
    return __builtin_amdgcn_mfma_scale_f32_16x16x128_f8f6f4(b, a, c, 0, 0, 0, 0x7f7f7f7f, 0, 0x7f7f7f7f);
}
__device__ __forceinline__ f32x4 mma8v(i32x8 b, i32x8 a, f32x4 c) {
    const int one = 0x7f7f7f7f;
    asm volatile("v_mfma_scale_f32_16x16x128_f8f6f4 %0, %1, %2, %0, %3, %3 op_sel_hi:[0,0,0]" : "+v"(c) : "v"(b), "v"(a), "v"(one));
    return c;
}
template <class Epi, class Sched, bool ALIGN_EPI = false, bool SP2 = false, bool FP8 = false, bool ATILE = false>
__device__ __forceinline__ void gemm_phase(PG8_LAS unsigned char* lds, const Gemm g, const Sched& S, const Epi& E) {
    int tid_l = threadIdx.x; asm volatile("" : "+v"(tid_l));
    const int tid = tid_l, wid = __builtin_amdgcn_readfirstlane(tid >> 6), lane = tid & 63, wr = wid >> 2, wc = wid & 3, fr = lane & 15, fq = lane >> 4;
    const int K = g.K, nt = K / BK;
    unsigned voffA[2], voffB[2];
#pragma unroll
    for (int i = 0; i < 2; ++i) { int R, C; stage_rc(tid * 16 + i * 8192, R, C); const int Rb = Epi::PERM ? ((R & ~31) + perm32(R & 31)) : R;
        voffA[i] = ATILE ? (unsigned)((((2 * C) >> 5) * 256 + R) * 32 + ((2 * C) & 31)) : (unsigned)(R * K + C) * 2u; voffB[i] = (unsigned)(Rb * K + C) * 2u; }
    const size_t kstep = (size_t)(BK * 2);
    const size_t hstep = (size_t)HALF * K * 2;
    const size_t kstepA = ATILE ? (size_t)32768 : kstep, hstepA = ATILE ? (size_t)4096 : hstep;
    const size_t tstep = 2 * hstep;
    const unsigned ldsw = (unsigned)wid * 1024u;
    const int aoff = lds_byte(wr * 64 + fr, fq * 8), boff = lds_byte(wc * 32 + fr, fq * 8);
#define PG8_SA(b, h) (((b) * 2 + (h)) * HTB)
#define PG8_SB(b, h) ((4 + (b) * 2 + (h)) * HTB)
#define PG8_STAGE(bufoff, gbase, voff) do { _Pragma("unroll") for (int _i = 0; _i < 2; ++_i) \
        __builtin_amdgcn_global_load_lds((const unsigned*)((const char*)(gbase) + (voff)[_i]), (PG8_LAS unsigned*)(lds + (bufoff) + ldsw + _i * 8192), 16, 0, 0); } while (0)
#define PG8_LDA(dst, b, h) do { if constexpr (FP8) { _Pragma("unroll") for (int m = 0; m < 4; ++m) dst##8[m] = __builtin_shufflevector(*(const PG8_LAS i32x4*)(lds + PG8_SA(b, h) + aoff + m * 2048), *(const PG8_LAS i32x4*)(lds + PG8_SA(b, h) + aoff + m * 2048 + 1024), 0, 1, 2, 3, 4, 5, 6, 7); } else { _Pragma("unroll") for (int m = 0; m < 4; ++m) _Pragma("unroll") for (int k = 0; k < 2; ++k) dst[m][k] = *(const PG8_LAS bf16x8*)(lds + PG8_SA(b, h) + aoff + m * 2048 + k * 1024); } } while (0)
#define PG8_LDB(dst, b, h) do { if constexpr (FP8) { _Pragma("unroll") for (int n = 0; n < 2; ++n) dst##8[n] = __builtin_shufflevector(*(const PG8_LAS i32x4*)(lds + PG8_SB(b, h) + boff + n * 2048), *(const PG8_LAS i32x4*)(lds + PG8_SB(b, h) + boff + n * 2048 + 1024), 0, 1, 2, 3, 4, 5, 6, 7); } else { _Pragma("unroll") for (int n = 0; n < 2; ++n) _Pragma("unroll") for (int k = 0; k < 2; ++k) dst[n][k] = *(const PG8_LAS bf16x8*)(lds + PG8_SB(b, h) + boff + n * 2048 + k * 1024); } } while (0)
#define PG8_MMA(ai, bj, At, Bt) do { __builtin_amdgcn_s_setprio(1); _Pragma("unroll") for (int m = 0; m < 4; ++m) _Pragma("unroll") for (int n = 0; n < 2; ++n) { if constexpr (FP8) acc[ai][bj][m][n] = mma8v(Bt##8[n], At##8[m], acc[ai][bj][m][n]); else { _Pragma("unroll") for (int k = 0; k < 2; ++k) \
        acc[ai][bj][m][n] = __builtin_amdgcn_mfma_f32_16x16x32_bf16(Bt[n][k], At[m][k], acc[ai][bj][m][n], 0, 0, 0); } } __builtin_amdgcn_s_setprio(0); } while (0)
#define PG8_WAIT_V(n) asm volatile("s_waitcnt vmcnt(" #n ")" ::: "memory")
#define PG8_WAIT_L(n) asm volatile("s_waitcnt lgkmcnt(" #n ")" ::: "memory")
#define PG8_BAR __builtin_amdgcn_s_barrier()
#define PG8_SCHED __builtin_amdgcn_sched_barrier(0)
    Unit cur, nxt; int ui = 0;
    if (!S.next(0, cur)) return;
    f32x4 acc[2][2][4][2];
#pragma unroll
    for (int a = 0; a < 2; ++a)
#pragma unroll
        for (int b = 0; b < 2; ++b)
#pragma unroll
            for (int m = 0; m < 4; ++m)
#pragma unroll
                for (int n = 0; n < 2; ++n) acc[a][b][m][n] = (f32x4){0.f, 0.f, 0.f, 0.f};
    bf16x8 At[4][2], B0[2][2], B1[2][2]; i32x8 At8[4], B08[2], B18[2];
    const char* cA = (const char*)g.A + (size_t)cur.pm * tstep; const char* cB = (const char*)g.Bt + (size_t)cur.e * g.bstride + (size_t)cur.pn * tstep;
    S.a_ready(cur);
    if constexpr (SP2) {
        PG8_STAGE(PG8_SB(0, 0), cB, voffB); PG8_STAGE(PG8_SB(0, 1), cB + hstep, voffB); PG8_STAGE(PG8_SA(0, 0), cA, voffA); PG8_STAGE(PG8_SA(0, 1), cA + hstepA, voffA);
        if (wr == 1) PG8_BAR;
        PG8_WAIT_V(2); PG8_BAR;
        PG8_STAGE(PG8_SB(1, 0), cB + kstep, voffB); PG8_STAGE(PG8_SA(1, 0), cA + kstepA, voffA); PG8_STAGE(PG8_SB(1, 1), cB + hstep + kstep, voffB);
        PG8_WAIT_V(6); PG8_BAR;
    } else {
        PG8_STAGE(PG8_SB(0, 0), cB, voffB); PG8_STAGE(PG8_SA(0, 0), cA, voffA); PG8_STAGE(PG8_SB(0, 1), cB + hstep, voffB); PG8_STAGE(PG8_SA(0, 1), cA + hstepA, voffA);
        if (wr == 1) PG8_BAR;
        PG8_WAIT_V(4); PG8_BAR;
        PG8_STAGE(PG8_SB(1, 0), cB + kstep, voffB); PG8_STAGE(PG8_SA(1, 0), cA + kstepA, voffA); PG8_STAGE(PG8_SB(1, 1), cB + hstep + kstep, voffB);
        PG8_WAIT_V(6); PG8_BAR;
    }
    for (;;) {
        const bool has_next = S.next(ui + 1, nxt);
        const char* nA = has_next ? (const char*)g.A + (size_t)nxt.pm * tstep : cA; const char* nB = has_next ? (const char*)g.Bt + (size_t)nxt.e * g.bstride + (size_t)nxt.pn * tstep : cB;
        _Pragma("nounroll") for (int t = 0; t < nt; t += 2) {
            const bool last = (t == nt - 2);
            const char* a1 = cA + (size_t)(t + 1) * kstepA;
            const char* a2 = last ? nA : cA + (size_t)(t + 2) * kstepA; const char* b2 = last ? nB : cB + (size_t)(t + 2) * kstep;
            const char* a3 = a2 + kstepA; const char* b3 = b2 + kstep;
            if (last && has_next) S.a_ready(nxt);
            if constexpr (SP2) {
            PG8_LDB(B0, 0, 0); PG8_LDB(B1, 0, 1); PG8_SCHED; PG8_LDA(At, 0, 0); PG8_STAGE(PG8_SA(1, 1), a1 + hstepA, voffA);
            PG8_WAIT_V(8); PG8_WAIT_L(0); PG8_BAR; PG8_MMA(0, 0, At, B0); PG8_MMA(0, 1, At, B1); PG8_BAR; PG8_SCHED;
            PG8_LDA(At, 0, 1); PG8_STAGE(PG8_SB(0, 0), b2, voffB); PG8_STAGE(PG8_SB(0, 1), b2 + hstep, voffB); PG8_STAGE(PG8_SA(0, 0), a2, voffA);
            PG8_WAIT_V(8); PG8_WAIT_L(0); PG8_BAR; PG8_MMA(1, 0, At, B0); PG8_MMA(1, 1, At, B1); PG8_BAR; PG8_SCHED;
            PG8_LDB(B0, 1, 0); PG8_LDB(B1, 1, 1); PG8_SCHED; PG8_LDA(At, 1, 0); PG8_STAGE(PG8_SA(0, 1), a2 + hstepA, voffA);
            PG8_WAIT_V(8); PG8_WAIT_L(0); PG8_BAR; PG8_MMA(0, 0, At, B0); PG8_MMA(0, 1, At, B1); PG8_BAR; PG8_SCHED;
            PG8_LDA(At, 1, 1); PG8_STAGE(PG8_SB(1, 0), b3, voffB); PG8_STAGE(PG8_SB(1, 1), b3 + hstep, voffB); PG8_STAGE(PG8_SA(1, 0), a3, voffA);
            PG8_WAIT_V(8); PG8_WAIT_L(0); PG8_BAR; PG8_MMA(1, 0, At, B0); PG8_MMA(1, 1, At, B1); PG8_BAR; PG8_SCHED;
            } else {
            PG8_LDB(B0, 0, 0); PG8_SCHED; PG8_LDA(At, 0, 0); PG8_STAGE(PG8_SA(1, 1), a1 + hstepA, voffA);
            PG8_WAIT_L(8); PG8_BAR; PG8_WAIT_L(0); PG8_MMA(0, 0, At, B0); PG8_BAR; PG8_SCHED;
            PG8_LDB(B1, 0, 1); PG8_STAGE(PG8_SB(0, 0), b2, voffB);
            PG8_BAR; PG8_WAIT_L(0); PG8_MMA(0, 1, At, B1); PG8_BAR;
            PG8_LDA(At, 0, 1); PG8_STAGE(PG8_SA(0, 0), a2, voffA);
            PG8_BAR; PG8_WAIT_L(0); PG8_MMA(1, 0, At, B0); PG8_BAR; PG8_SCHED;
            PG8_STAGE(PG8_SB(0, 1), b2 + hstep, voffB);
            PG8_WAIT_V(6); PG8_BAR; PG8_MMA(1, 1, At, B1); PG8_BAR;
            PG8_LDB(B0, 1, 0); PG8_SCHED; PG8_LDA(At, 1, 0); PG8_STAGE(PG8_SA(0, 1), a2 + hstepA, voffA);
            PG8_WAIT_L(8); PG8_BAR; PG8_WAIT_L(0); PG8_MMA(0, 0, At, B0); PG8_BAR; PG8_SCHED;
            PG8_LDB(B1, 1, 1); PG8_STAGE(PG8_SB(1, 0), b3, voffB);
            PG8_BAR; PG8_WAIT_L(0); PG8_MMA(0, 1, At, B1); PG8_BAR;
            PG8_LDA(At, 1, 1); PG8_STAGE(PG8_SA(1, 0), a3, voffA);
            PG8_BAR; PG8_WAIT_L(0); PG8_MMA(1, 0, At, B0); PG8_BAR; PG8_SCHED;
            PG8_STAGE(PG8_SB(1, 1), b3 + hstep, voffB);
            PG8_WAIT_V(6); PG8_BAR; PG8_MMA(1, 1, At, B1); PG8_BAR;
            }
        }
        if constexpr (FP8) asm volatile("s_nop 15\n\ts_nop 15" ::: "memory");
        if constexpr (ALIGN_EPI) { if (wr == 0) PG8_BAR; }
        if constexpr (!Epi::AFTER_DRAIN) { E(acc, cur, wr, wc, fr, fq); S.done(cur); }
        if (!has_next) break;
#pragma unroll
        for (int a = 0; a < 2; ++a)
#pragma unroll
            for (int b = 0; b < 2; ++b)
#pragma unroll
                for (int m = 0; m < 4; ++m)
#pragma unroll
                    for (int n = 0; n < 2; ++n) acc[a][b][m][n] = (f32x4){0.f, 0.f, 0.f, 0.f};
        cur = nxt; cA = nA; cB = nB; ++ui;
        if constexpr (ALIGN_EPI) { if (wr == 1) PG8_BAR; }
    }
    PG8_WAIT_V(0);
    if constexpr (!ALIGN_EPI) { if (wr == 0) PG8_BAR; }
    PG8_BAR;
    if constexpr (Epi::AFTER_DRAIN) { E.fused(acc, cur, wr, wc, fr, fq, lds, wid, lane); S.done(cur); }
#undef PG8_SA
#undef PG8_SB
#undef PG8_STAGE
#undef PG8_LDA
#undef PG8_LDB
#undef PG8_MMA
#undef PG8_WAIT_V
#undef PG8_WAIT_L
#undef PG8_BAR
#undef PG8_SCHED
}

}

constexpr int D = 1024, NB = 8, SEQ = 2048, DEPTH = 4, LEAD = 128, FIRSTV = 112, LT = LEAD + SEQ, NTOK = NB * LT;
constexpr int WIN = 3584, FFD = 2816, FFE = 3584, NE = 8, MAXSLOT = 36864;
constexpr float EPS = 1e-6f;
constexpr int NPHASE = 1 + 8 * DEPTH;
constexpr int MAINROWS = (NTOK / (64 * 256)) * (64 * 256);

constexpr size_t MiB = 1u << 20;
constexpr size_t WS_CTL = 0, CTL_ZERO_BYTES = MiB;
constexpr size_t WS_TAB = 1 * MiB;
constexpr size_t WS_WIN = 2 * MiB;
constexpr size_t WS_WOUT = WS_WIN + 28 * MiB;
constexpr size_t WS_WD13 = WS_WOUT + 8 * MiB;
constexpr size_t WS_WD2 = WS_WD13 + 22 * MiB;
constexpr size_t WS_WM13 = WS_WD2 + 11 * MiB;
constexpr size_t WS_WM2 = WS_WM13 + 224 * MiB;
constexpr size_t WS_H = WS_WM2 + 112 * MiB;
constexpr size_t WS_HB = WS_H + 68 * MiB;
constexpr size_t WS_SSQ = WS_HB + 34 * MiB;
constexpr size_t WS_ROUTE = WS_SSQ + 2 * MiB;
constexpr size_t WS_ACT = WS_ROUTE + 2 * MiB;
constexpr size_t WS_XG = WS_ACT + 252 * MiB;
constexpr size_t WS_END = WS_XG + 72 * MiB;
constexpr size_t ACT_PROJ = 0, ACT_LOGF = 119 * MiB, ACT_MIX = 153 * MiB;
constexpr size_t HGV_OFF = (size_t)HGV_MIB * MiB;
constexpr size_t TAB_LB = 0, TAB_BIAS = 8192, TAB_LAM = 12288, TAB_SUBLN = 12544, TAB_HGNW = 14592, TAB_RF = 20480, TAB_FNORM = 20480 + 65536;
constexpr size_t ROUTE_INFO = 0, ROUTE_LIST = 640 * 1024, ROUTE_RSTD = 1280 * 1024;
constexpr int CW_TMO = 0, CW_BAR = 4096, CW_CNT = 8192;

constexpr int RING_BYTES = 131072, MISC_OFF = RING_BYTES + 320, LDS_BYTES = 147456;

#define GAS __attribute__((address_space(1)))
#define LAS __attribute__((address_space(3)))
typedef unsigned short bf16;
typedef unsigned v4u __attribute__((ext_vector_type(4)));
typedef unsigned v2u __attribute__((ext_vector_type(2)));
typedef float f32x4 __attribute__((ext_vector_type(4)));
typedef GAS unsigned gu32;
#define RLX_AGENT __ATOMIC_RELAXED, __HIP_MEMORY_SCOPE_AGENT
#define LDS_WAIT() asm volatile("s_waitcnt lgkmcnt(0)" ::: "memory")
__device__ __forceinline__ unsigned f2bf(float f) { unsigned u = __builtin_bit_cast(unsigned, f); return (u + 0x7fffu + ((u >> 16) & 1u)) >> 16; }
__device__ __forceinline__ unsigned pk2(float lo, float hi) { return pg8::cvt_pk_bf16(lo, hi); }
__device__ __forceinline__ float bf_lo(unsigned w) { return __builtin_bit_cast(float, w << 16); }
__device__ __forceinline__ float bf_hi(unsigned w) { return __builtin_bit_cast(float, w & 0xffff0000u); }
__device__ __forceinline__ f32x4 bf4(v2u w) { return (f32x4){bf_lo(w.x), bf_hi(w.x), bf_lo(w.y), bf_hi(w.y)}; }
template <class V> __device__ __forceinline__ void st_out(V* p, V v) { if (NT_STORES) __builtin_nontemporal_store(v, p); else *p = v; }
__device__ __forceinline__ float sat8(float x) { return __builtin_amdgcn_fmed3f(x, -448.f, 448.f); }
__device__ __forceinline__ unsigned pk_fp8x4(float a, float b, float c, float d) { int w = 0; w = __builtin_amdgcn_cvt_pk_fp8_f32(sat8(a), sat8(b), w, false); w = __builtin_amdgcn_cvt_pk_fp8_f32(sat8(c), sat8(d), w, true); return (unsigned)w; }
__device__ __forceinline__ float silu_f(float x) { return x * __builtin_amdgcn_rcpf(1.f + __expf(-x)); }
template <int N> __device__ __forceinline__ float dpp_row_ror(float x) {
    return __builtin_bit_cast(float, __builtin_amdgcn_update_dpp(0, __builtin_bit_cast(int, x), 0x120 + N, 0xf, 0xf, false));
}
template <int N> __device__ __forceinline__ float dpp_row_shr(float x) {
    return __builtin_bit_cast(float, __builtin_amdgcn_update_dpp(0, __builtin_bit_cast(int, x), 0x110 + N, 0xf, 0xf, true));
}
__device__ __forceinline__ float wave_sum(float v) {
    if (!WSUM_DPP) { _Pragma("unroll") for (int o = 1; o < 64; o <<= 1) v += __shfl_xor(v, o); return v; }
    v += dpp_row_shr<1>(v); v += dpp_row_shr<2>(v); v += dpp_row_shr<4>(v); v += dpp_row_shr<8>(v);
    const int b = __builtin_bit_cast(int, v);
    return (__builtin_bit_cast(float, __builtin_amdgcn_readlane(b, 15)) + __builtin_bit_cast(float, __builtin_amdgcn_readlane(b, 31))) + (__builtin_bit_cast(float, __builtin_amdgcn_readlane(b, 47)) + __builtin_bit_cast(float, __builtin_amdgcn_readlane(b, 63)));
}
__device__ __forceinline__ void swap32(unsigned& a, unsigned& b) { asm volatile("v_nop\n\tv_nop\n\tv_permlane32_swap_b32 %0, %1" : "+v"(a), "+v"(b)); }
__device__ __forceinline__ float xor32_sum(float v) { if (!XOR32_PERMLANE) return v + __shfl_xor(v, 32); unsigned a = __builtin_bit_cast(unsigned, v), b = a; swap32(a, b); return __builtin_bit_cast(float, a) + __builtin_bit_cast(float, b); }
__device__ __forceinline__ float xor32_max(float v) { if (!XOR32_PERMLANE) return fmaxf(v, __shfl_xor(v, 32)); unsigned a = __builtin_bit_cast(unsigned, v), b = a; swap32(a, b); return fmaxf(__builtin_bit_cast(float, a), __builtin_bit_cast(float, b)); }

#define XB_TMO      128
#define XB_XCNT(j)  (256  + 64 * (j))
#define XB_XSUB(j)  (1280 + 64 * (j))
#define XB_XGEN(j)  (2304 + 64 * (j))
#define XB_TOP      3328
#define XB_TOPGEN   3392
#define XCD_BAR_WORDS 3456
#define XB_SPIN_CAP (1u << 18)

__device__ __forceinline__ unsigned xb_ld(unsigned* p)              { return __hip_atomic_load(p, __ATOMIC_RELAXED, __HIP_MEMORY_SCOPE_AGENT); }
__device__ __forceinline__ unsigned xb_add(unsigned* p, unsigned v) { return __hip_atomic_fetch_add(p, v, __ATOMIC_RELAXED, __HIP_MEMORY_SCOPE_AGENT); }
__device__ __forceinline__ unsigned xb_xcc_id() { return (unsigned)__builtin_amdgcn_s_getreg((3 << 11) | 20) & 0xFu; }
#define XB_SPIN(cond, bar) do { unsigned _sp = 0; while (cond) { __builtin_amdgcn_s_sleep(1); \
    if ((++_sp & 255u) == 0u) { if (xb_ld(&(bar)[XB_TMO])) break; if (_sp > XB_SPIN_CAP) { atomicAdd(&(bar)[XB_TMO], 1u); break; } } } } while (0)

struct XcdBarrier {
    unsigned* bar; unsigned x;
    volatile LAS unsigned* st;
};

__device__ __forceinline__ XcdBarrier xcd_barrier_post(unsigned* bar, volatile LAS unsigned* st) {
    XcdBarrier b; b.bar = bar; b.x = xb_xcc_id(); b.st = st;
    if (threadIdx.x == 0) (void)xb_add(&bar[XB_XCNT(b.x)], 1u);
    return b;
}
__device__ __forceinline__ void xcd_barrier_complete(unsigned* bar, unsigned x, unsigned& nloc, unsigned& nx) {
    const unsigned G = gridDim.x * gridDim.y * gridDim.z;
    unsigned sum, cnt, mine, sp = 0u;
    for (;;) {
        sum = 0u; cnt = 0u; mine = 0u;
#pragma unroll
        for (unsigned j = 0; j < 16; ++j) { const unsigned c = xb_ld(&bar[XB_XCNT(j)]); sum += c; cnt += (c > 0u) ? 1u : 0u; mine = (j == x) ? c : mine; }
        if (sum == G) break;
        __builtin_amdgcn_s_sleep(1);
        if ((++sp & 255u) == 0u) { if (xb_ld(&bar[XB_TMO])) break; if (sp > XB_SPIN_CAP) { atomicAdd(&bar[XB_TMO], 1u); break; } }
    }
    nloc = mine > 0u ? mine : 1u; nx = cnt > 0u ? cnt : 1u;
}

__device__ __forceinline__ void xcd_barrier(const XcdBarrier& b) {
    asm volatile("s_waitcnt vmcnt(0)" ::: "memory");
    __syncthreads();
    if (threadIdx.x == 0) {
        unsigned* bar = b.bar;
        __builtin_amdgcn_s_waitcnt(0);
        unsigned nloc = b.st[0], nx = b.st[1];
        if (nloc == 0u) { xcd_barrier_complete(bar, b.x, nloc, nx); b.st[0] = nloc; b.st[1] = nx; }
        const unsigned old = xb_add(&bar[XB_XSUB(b.x)], 1u);
        const unsigned gen = old / nloc;
        if (old + 1u == (gen + 1u) * nloc) {
            __builtin_amdgcn_fence(__ATOMIC_RELEASE, "agent");
            asm volatile("s_waitcnt vmcnt(0)" ::: "memory");
            const unsigned og = xb_add(&bar[XB_TOP], 1u);
            const unsigned tg = og / nx;
            if (og + 1u == (tg + 1u) * nx) xb_add(&bar[XB_TOPGEN], 1u);
            else XB_SPIN(xb_ld(&bar[XB_TOPGEN]) == tg, bar);
            __builtin_amdgcn_fence(__ATOMIC_ACQUIRE, "agent");
            xb_add(&bar[XB_XGEN(b.x)], 1u);
            asm volatile("s_waitcnt vmcnt(0)" ::: "memory");
        } else {
            XB_SPIN(xb_ld(&bar[XB_XGEN(b.x)]) == gen, bar);
            __builtin_amdgcn_fence(__ATOMIC_ACQUIRE, "agent");
            asm volatile("s_waitcnt vmcnt(0)" ::: "memory");
        }
    }
    __syncthreads();
}


static __device__ const unsigned char T5B[129] = {0, 1, 2, 3, 4, 5, 6, 7, 8, 9, 10, 11, 12, 13, 14, 15, 16, 16, 16, 17, 17, 18, 18, 18, 19, 19, 19, 20, 20, 20, 20, 21, 21, 21, 21, 22, 22, 22, 22, 22, 23, 23, 23, 23, 23, 23, 24, 24, 24, 24, 24, 24, 25, 25, 25, 25, 25, 25, 25, 26, 26, 26, 26, 26, 26, 26, 26, 27, 27, 27, 27, 27, 27, 27, 27, 27, 27, 28, 28, 28, 28, 28, 28, 28, 28, 28, 28, 29, 29, 29, 29, 29, 29, 29, 29, 29, 29, 29, 29, 30, 30, 30, 30, 30, 30, 30, 30, 30, 30, 30, 30, 30, 30, 31, 31, 31, 31, 31, 31, 31, 31, 31, 31, 31, 31, 31, 31, 31, 31};

struct Ctx {
    LAS unsigned char* lds;
    int tid, lane, wave, G, bid;
    float* out;
    unsigned char* ws;
    __device__ __forceinline__ gu32* ctl() const { return (gu32*)(ws + WS_CTL); }
    __device__ __forceinline__ bf16* HB() const { return (bf16*)(ws + WS_HB); }
    __device__ __forceinline__ float* SSQ() const { return (float*)(ws + WS_SSQ); }
    __device__ __forceinline__ bf16* PROJ() const { return (bf16*)(ws + WS_ACT + ACT_PROJ); }
    __device__ __forceinline__ float* LOGF() const { return (float*)(ws + WS_ACT + ACT_LOGF); }
    __device__ __forceinline__ bf16* MIX() const { return (bf16*)(ws + WS_ACT + ACT_MIX); }
    __device__ __forceinline__ bf16* T() const { return (bf16*)(ws + WS_ACT); }
    __device__ __forceinline__ bf16* XG() const { return (bf16*)(ws + WS_XG); }
    __device__ __forceinline__ bf16* Y() const { return (bf16*)(ws + WS_XG); }
    __device__ __forceinline__ float* LB() const { return (float*)(ws + WS_TAB + TAB_LB); }
    __device__ __forceinline__ float* BIAST() const { return (float*)(ws + WS_TAB + TAB_BIAS); }
    __device__ __forceinline__ float* LAM() const { return (float*)(ws + WS_TAB + TAB_LAM); }
    __device__ __forceinline__ float* RF() const { return (float*)(ws + WS_TAB + TAB_RF); }
    __device__ __forceinline__ float* SUBLN() const { return (float*)(ws + WS_TAB + TAB_SUBLN); }
    __device__ __forceinline__ float* HGNW() const { return (float*)(ws + WS_TAB + TAB_HGNW); }
    __device__ __forceinline__ float* FNORM() const { return (float*)(ws + WS_TAB + TAB_FNORM); }
    __device__ __forceinline__ unsigned* TINFO() const { return (unsigned*)(ws + WS_ROUTE + ROUTE_INFO); }
    __device__ __forceinline__ int* LIST() const { return (int*)(ws + WS_ROUTE + ROUTE_LIST); }
    __device__ __forceinline__ float* RSTD() const { return (float*)(ws + WS_ROUTE + ROUTE_RSTD); }
};
struct Args { const float* in[19]; float* out; unsigned char* ws; int ph_lo, ph_hi; };
enum { IN_X = 0, IN_META, IN_RELB, IN_NMIX, IN_WIN, IN_LBL, IN_HGNW, IN_LAMBDA, IN_SUBLN, IN_WOUT, IN_NFFN, IN_DW1, IN_DW3, IN_DW2, IN_ROUTER, IN_MW1, IN_MW3, IN_MW2, IN_FNORM };

__device__ __forceinline__ v2u pack4(float a, float b, float c, float d) { v2u w; w.x = pg8::cvt_pk_bf16(a, b); w.y = pg8::cvt_pk_bf16(c, d); return w; }
__device__ __forceinline__ float row_rstd(const float* ssq, int row) {
    const f32x4* p = (const f32x4*)(ssq + (size_t)row * 16);
    const f32x4 a = p[0], b = p[1], c = p[2], d = p[3];
    const float s = ((a[0] + a[1]) + (a[2] + a[3])) + ((b[0] + b[1]) + (b[2] + b[3])) + ((c[0] + c[1]) + (c[2] + c[3])) + ((d[0] + d[1]) + (d[2] + d[3]));
    return rsqrtf(s * (1.0f / 1024.0f) + EPS);
}
constexpr int RS_OFF = RING_BYTES + 4096, RS_MAXU = 12;
template <class Sched> __device__ __forceinline__ void rstd_table(LAS unsigned char* lds, const float* ssq, const Sched& S, int tid) {
    LAS float* rs = (LAS float*)(lds + RS_OFF);
    pg8::Unit u;
    for (int i0 = 0; i0 < RS_MAXU; i0 += 2) {
        const int i = i0 + (tid >> 8);
        if (S.next(i, u)) rs[i * 256 + (tid & 255)] = row_rstd(ssq, u.pm * 256 + (tid & 255));
    }
    __syncthreads();
}
__device__ __forceinline__ void stagger_start(int bid, unsigned quarter_ticks) {
    const unsigned grp = ((unsigned)bid >> 3) & 3u;
    if (grp) { const unsigned long long t0 = __builtin_amdgcn_s_memrealtime(); while ((unsigned)(__builtin_amdgcn_s_memrealtime() - t0) < grp * quarter_ticks) __builtin_amdgcn_s_sleep(16); }
}
struct EpiProj {
    static constexpr bool PERM = true, AFTER_DRAIN = false;
    bf16* proj; float* logfp; const LAS float* rs; const float* lb; const float* hgw; unsigned char* scr2; int mode;
#if HF_MERGE
    template <int AI, int BJ> __device__ __forceinline__ void hf_block8(const pg8::f32x4 (&acc)[2][2][4][2], int row0, int colb, const LAS float* rsu) const {
        const int c0 = colb + BJ * 128, cc = c0 - 512;
        const f32x4 l0 = *(const f32x4*)(lb + cc), l1 = *(const f32x4*)(lb + cc + 4);
        float lf[4][8];
#pragma unroll
        for (int m = 0; m < 4; ++m) {
            const int row = row0 + AI * 128 + m * 16;
            const float rn = rsu[AI * 128 + m * 16] * -1.4426950408889634f;
            const bool valid = (row % LT) >= FIRSTV;
            float kx[8];
#pragma unroll
            for (int j = 0; j < 8; ++j) {
                const float lbv = (j < 4) ? l0[j & 3] : l1[j & 3];
                const float xs = __builtin_amdgcn_fmed3f(acc[AI][BJ][m][j >> 2][j & 3] * rn, -43.280851f, 43.280851f);
                const float te = __builtin_amdgcn_exp2f(xs), sg = __builtin_amdgcn_rcpf(1.f + te);
                float lg2 = __builtin_amdgcn_logf(lbv + (1.f - lbv) * sg);
                float kk = (1.f - lbv) * (te * sg);
                if (!valid) { lg2 = 0.f; kk = 0.f; }
                lf[m][j] = lg2; kx[j] = kk;
            }
            v4u w; w.x = pg8::cvt_pk_bf16(kx[0], kx[1]); w.y = pg8::cvt_pk_bf16(kx[2], kx[3]); w.z = pg8::cvt_pk_bf16(kx[4], kx[5]); w.w = pg8::cvt_pk_bf16(kx[6], kx[7]);
            *(v4u*)(proj + (size_t)row * WIN + c0) = w;
        }
#pragma unroll
        for (int j = 0; j < 8; ++j) {
            float tot[4];
#pragma unroll
            for (int m = 0; m < 4; ++m) {
                float x = lf[m][j], t = x;
                x += dpp_row_shr<1>(x); x += dpp_row_shr<2>(x); x += dpp_row_shr<4>(x); x += dpp_row_shr<8>(x);
                lf[m][j] = x;
                if (m < 3) { t += dpp_row_ror<8>(t); t += dpp_row_ror<4>(t); t += dpp_row_ror<2>(t); t += dpp_row_ror<1>(t); }
                tot[m] = t;
            }
            const float c1 = tot[0], c2 = c1 + tot[1], c3 = c2 + tot[2];
            lf[1][j] += c1; lf[2][j] += c2; lf[3][j] += c3;
        }
#pragma unroll
        for (int m = 0; m < 4; ++m) {
            float* d = logfp + (size_t)(row0 + AI * 128 + m * 16) * 512 + (cc >> 1);
            *(f32x4*)d = (f32x4){lf[m][0], lf[m][1], lf[m][2], lf[m][3]};
            *(f32x4*)(d + 256) = (f32x4){lf[m][4], lf[m][5], lf[m][6], lf[m][7]};
        }
    }
#endif
    template <int AI, int BJ, int NN> __device__ __forceinline__ void hf_block(const pg8::f32x4 (&acc)[2][2][4][2], int row0, int colb, const LAS float* rsu) const {
        const int c0 = colb + BJ * 128 + 4 * NN, cc = c0 - 512;
        const f32x4 l0 = *(const f32x4*)(lb + cc);
        float lf[4][4];
#if HG_EQ
        float kxa[4][4];
#endif
#pragma unroll
        for (int m = 0; m < 4; ++m) {
            const int row = row0 + AI * 128 + m * 16;
            const float r = rsu[AI * 128 + m * 16];
            const bool valid = (row % LT) >= FIRSTV;
            float kx[4];
#pragma unroll
            for (int j = 0; j < 4; ++j) {
                const float lbv = l0[j];
#if HF_V2
                const float xs = __builtin_amdgcn_fmed3f(acc[AI][BJ][m][NN][j] * (r * -1.4426950408889634f), -43.280851f, 43.280851f);
                const float te = __builtin_amdgcn_exp2f(xs), sg = __builtin_amdgcn_rcpf(1.f + te);
                float lg2 = __builtin_amdgcn_logf(lbv + (1.f - lbv) * sg);
                float kk = (1.f - lbv) * (te * sg);
                if (!valid) { lg2 = 0.f; kk = 0.f; }
                lf[m][j] = lg2; kx[j] = kk;
#else
                const float xx = acc[AI][BJ][m][NN][j] * r;
                const float xc = fminf(fmaxf(xx, -30.f), 30.f);
                const float te = __expf(-xc), sg = __builtin_amdgcn_rcpf(1.f + te);
                float lgf = __logf(lbv + (1.f - lbv) * sg);
                float kk = (1.f - lbv) * (te * sg);
                if (!valid) { lgf = 0.f; kk = 0.f; }
                lf[m][j] = lgf * 1.4426950408889634f; kx[j] = kk;
#endif
            }
#if HG_EQ
#pragma unroll
            for (int j = 0; j < 4; ++j) kxa[m][j] = kx[j];
#endif
#if !HG_EQ || HG_EQ_BOTH
            v2u w; w.x = pg8::cvt_pk_bf16(kx[0], kx[1]); w.y = pg8::cvt_pk_bf16(kx[2], kx[3]);
            if (PROJ_PROBE && (mode & 8)) asm volatile("" :: "v"(w.x), "v"(w.y)); else *(v2u*)(proj + (size_t)row * WIN + c0) = w;
#endif
        }
#if HG_EQ
        float bm[4], be[4];
#endif
#if HF_V2
#pragma unroll
        for (int j = 0; j < 4; ++j) {
            float tot[4];
#pragma unroll
            for (int m = 0; m < 4; ++m) {
                float x = lf[m][j], t = x;
                x += dpp_row_shr<1>(x); x += dpp_row_shr<2>(x); x += dpp_row_shr<4>(x); x += dpp_row_shr<8>(x);
                lf[m][j] = x;
                if (m < 3 || HG_EQ) { t += dpp_row_ror<8>(t); t += dpp_row_ror<4>(t); t += dpp_row_ror<2>(t); t += dpp_row_ror<1>(t); }
                tot[m] = t;
            }
            const float c1 = tot[0], c2 = c1 + tot[1], c3 = c2 + tot[2];
            lf[1][j] += c1; lf[2][j] += c2; lf[3][j] += c3;
#if HG_EQ
            bm[j] = c2; be[j] = c3 + tot[3];
#endif
        }
#else
#pragma unroll
        for (int j = 0; j < 4; ++j) {
            float carry = 0.f;
#pragma unroll
            for (int m = 0; m < 4; ++m) {
                float x = lf[m][j];
                x += dpp_row_shr<1>(x); x += dpp_row_shr<2>(x); x += dpp_row_shr<4>(x); x += dpp_row_shr<8>(x);
                x += carry;
                carry = __shfl(x, 15, 16);
                lf[m][j] = x;
#if HG_EQ
                if (m == 1) bm[j] = carry;
                if (m == 3) be[j] = carry;
#endif
            }
        }
#endif
#if HG_EQ
#if HG_EQ_BOTH
        bf16* eqb = (bf16*)scr2; bf16* kmb = (bf16*)(scr2 + 36 * MiB) - c0 + cc; const size_t kmp = 512; float* vgb = (float*)(scr2 + 60 * MiB);
#else
        bf16* eqb = (bf16*)logfp; bf16* kmb = proj; const size_t kmp = WIN; float* vgb = (float*)((unsigned char*)logfp + HGV_OFF);
#endif
#pragma unroll
        for (int m = 0; m < 4; ++m) {
            const int row = row0 + AI * 128 + m * 16;
            float eq[4], km[4];
#pragma unroll
            for (int j = 0; j < 4; ++j) { const float x = __builtin_amdgcn_fmed3f(lf[m][j] - bm[j], -115.f, 115.f); eq[j] = __builtin_amdgcn_exp2f(x); km[j] = kxa[m][j] * __builtin_amdgcn_exp2f(-x); }
            v2u w; w.x = pg8::cvt_pk_bf16(km[0], km[1]); w.y = pg8::cvt_pk_bf16(km[2], km[3]);
            *(v2u*)(kmb + (size_t)row * kmp + c0) = w;
            v2u e; e.x = pg8::cvt_pk_bf16(eq[0], eq[1]); e.y = pg8::cvt_pk_bf16(eq[2], eq[3]);
            *(v2u*)(eqb + (size_t)row * 512 + cc) = e;
        }
        if ((row0 & 15) == 15) {
            float* vg = vgb + (size_t)((row0 + AI * 128) >> 6) * 1024 + cc;
            *(f32x4*)vg = (f32x4){__builtin_amdgcn_exp2f(bm[0]), __builtin_amdgcn_exp2f(bm[1]), __builtin_amdgcn_exp2f(bm[2]), __builtin_amdgcn_exp2f(bm[3])};
            *(f32x4*)(vg + 512) = (f32x4){__builtin_amdgcn_exp2f(be[0] - bm[0]), __builtin_amdgcn_exp2f(be[1] - bm[1]), __builtin_amdgcn_exp2f(be[2] - bm[2]), __builtin_amdgcn_exp2f(be[3] - bm[3])};
#if HGV_DUP
            { float* vg2 = (float*)((unsigned char*)vg + (size_t)(HGV_DUP - HGV_MIB) * MiB); *(f32x4*)vg2 = *(f32x4*)vg; *(f32x4*)(vg2 + 512) = *(f32x4*)(vg + 512); }
#endif
        }
#endif
#if !HG_EQ || HG_EQ_BOTH
#pragma unroll
        for (int m = 0; m < 4; ++m) { if (PROJ_PROBE && (mode & 8)) asm volatile("" :: "v"(lf[m][0]), "v"(lf[m][1]), "v"(lf[m][2]), "v"(lf[m][3])); else *(f32x4*)(logfp + (size_t)(row0 + AI * 128 + m * 16) * 512 + cc) = (f32x4){lf[m][0], lf[m][1], lf[m][2], lf[m][3]}; }
#endif
    }
    __device__ __forceinline__ void operator()(const pg8::f32x4 (&acc)[2][2][4][2], const pg8::Unit& u, int wr, int wc, int fr, int fq) const {
        int grp = u.pn >> 1;
        const int row0 = u.pm * 256 + wr * 64 + fr, colb = u.pn * 256 + wc * 32 + 8 * fq;
        if (PROJ_PROBE && (mode & 4)) { pg8::f32x4 s_ = acc[0][0][0][0];
            _Pragma("unroll") for (int a = 0; a < 2; ++a) _Pragma("unroll") for (int b = 0; b < 2; ++b) _Pragma("unroll") for (int m = 0; m < 4; ++m) _Pragma("unroll") for (int n = 0; n < 2; ++n) s_ = s_ + acc[a][b][m][n];
            if (s_[0] + s_[1] + s_[2] + s_[3] == 1.2345e38f) proj[0] = 0; return; }
        if (PROJ_PROBE && (mode & 2) && grp == 1) grp = 2;
        const LAS float* rsu = rs + u.idx * 256 + wr * 64 + fr;
        if (grp == 1) {
#if HF_MERGE
            hf_block8<0, 0>(acc, row0, colb, rsu); hf_block8<0, 1>(acc, row0, colb, rsu); hf_block8<1, 0>(acc, row0, colb, rsu); hf_block8<1, 1>(acc, row0, colb, rsu);
#else
            hf_block<0, 0, 0>(acc, row0, colb, rsu); hf_block<0, 0, 1>(acc, row0, colb, rsu); hf_block<0, 1, 0>(acc, row0, colb, rsu); hf_block<0, 1, 1>(acc, row0, colb, rsu);
            hf_block<1, 0, 0>(acc, row0, colb, rsu); hf_block<1, 0, 1>(acc, row0, colb, rsu); hf_block<1, 1, 0>(acc, row0, colb, rsu); hf_block<1, 1, 1>(acc, row0, colb, rsu);
#endif
            return;
        }
#pragma unroll
        for (int ai = 0; ai < 2; ++ai)
#pragma unroll
            for (int m = 0; m < 4; ++m) {
                const int row = row0 + ai * 128 + m * 16;
                const float r = rsu[ai * 128 + m * 16];
#pragma unroll
                for (int bj = 0; bj < 2; ++bj) {
                    const int c0 = colb + bj * 128;
                    float x[8];
#pragma unroll
                    for (int j = 0; j < 4; ++j) { x[j] = acc[ai][bj][m][0][j] * r; x[4 + j] = acc[ai][bj][m][1][j] * r; }
                    if (grp == 0) {
#pragma unroll
                        for (int j = 0; j < 8; ++j) x[j] = silu_f(x[j]);
                    } else if (grp == 3) {
                        const f32x4 g0 = *(const f32x4*)(hgw + (c0 & 127)), g1 = *(const f32x4*)(hgw + (c0 & 127) + 4);
#pragma unroll
                        for (int j = 0; j < 4; ++j) { x[j] = silu_f(x[j]) * g0[j]; x[4 + j] = silu_f(x[4 + j]) * g1[j]; }
                    } else if (grp == 4) {
#pragma unroll
                        for (int j = 0; j < 8; ++j) x[j] *= 0.18033688011112042f;
                    }
                    v4u w; w.x = pg8::cvt_pk_bf16(x[0], x[1]); w.y = pg8::cvt_pk_bf16(x[2], x[3]); w.z = pg8::cvt_pk_bf16(x[4], x[5]); w.w = pg8::cvt_pk_bf16(x[6], x[7]);
                    if (PROJ_PROBE && (mode & 1)) asm volatile("" :: "v"(w.x), "v"(w.y), "v"(w.z), "v"(w.w)); else st_out((v4u*)(proj + (size_t)row * WIN + c0), w);
                }
            }
    }
};
struct EpiResid {
    static constexpr bool PERM = true, AFTER_DRAIN = false;
    bf16* HB; float* ssq;
    __device__ __forceinline__ void operator()(const pg8::f32x4 (&acc)[2][2][4][2], const pg8::Unit& u, int wr, int wc, int fr, int fq) const {
        const int row0 = u.pm * 256 + wr * 64 + fr, colb = u.pn * 256 + wc * 32 + 8 * fq;
#pragma unroll
        for (int ai = 0; ai < 2; ++ai) {
            v4u h[4][2];
#pragma unroll
            for (int m = 0; m < 4; ++m)
#pragma unroll
                for (int bj = 0; bj < 2; ++bj) h[m][bj] = *(const v4u*)(HB + (size_t)(row0 + ai * 128 + m * 16) * D + colb + bj * 128);
#pragma unroll
            for (int m = 0; m < 4; ++m) {
                const int row = row0 + ai * 128 + m * 16;
                float s = 0.f;
#pragma unroll
                for (int bj = 0; bj < 2; ++bj) {
                    const v4u hw = h[m][bj];
                    const f32x4 h0 = (f32x4){bf_lo(hw.x), bf_hi(hw.x), bf_lo(hw.y), bf_hi(hw.y)} + acc[ai][bj][m][0], h1 = (f32x4){bf_lo(hw.z), bf_hi(hw.z), bf_lo(hw.w), bf_hi(hw.w)} + acc[ai][bj][m][1];
                    s += (h0[0] * h0[0] + h0[1] * h0[1]) + (h0[2] * h0[2] + h0[3] * h0[3]) + (h1[0] * h1[0] + h1[1] * h1[1]) + (h1[2] * h1[2] + h1[3] * h1[3]);
                    v4u w; w.x = pg8::cvt_pk_bf16(h0[0], h0[1]); w.y = pg8::cvt_pk_bf16(h0[2], h0[3]); w.z = pg8::cvt_pk_bf16(h1[0], h1[1]); w.w = pg8::cvt_pk_bf16(h1[2], h1[3]);
                    *(v4u*)(HB + (size_t)row * D + colb + bj * 128) = w;
                }
                s += __shfl_xor(s, 16); s = xor32_sum(s);
                if (fq == 0) ssq[(size_t)row * 16 + u.pn * 4 + wc] = s;
            }
        }
    }
};
struct EpiGLU {
    static constexpr bool PERM = true, AFTER_DRAIN = false;
    bf16* T; int ldt; const LAS float* rs; int mode;
    __device__ __forceinline__ void operator()(const pg8::f32x4 (&acc)[2][2][4][2], const pg8::Unit& u, int wr, int wc, int fr, int fq) const {
        const int row0 = u.pm * 256 + wr * 64 + fr, colb = u.pn * 128 + wc * 32 + 8 * fq;
#pragma unroll
        for (int ai = 0; ai < 2; ++ai)
#pragma unroll
            for (int m = 0; m < 4; ++m) {
                const int row = row0 + ai * 128 + m * 16;
                const float r = rs ? rs[u.idx * 256 + wr * 64 + fr + ai * 128 + m * 16] : 1.f;
                float x[8];
                const float c1 = -1.4426950408889634f * r, c2 = r * r;
#pragma unroll
                for (int j = 0; j < 4; ++j) {
                    const float a1 = acc[ai][0][m][0][j], a3 = acc[ai][1][m][0][j], b1 = acc[ai][0][m][1][j], b3 = acc[ai][1][m][1][j];
                    x[j] = (a1 * a3) * (c2 * __builtin_amdgcn_rcpf(1.f + __builtin_amdgcn_exp2f(a1 * c1)));
                    x[4 + j] = (b1 * b3) * (c2 * __builtin_amdgcn_rcpf(1.f + __builtin_amdgcn_exp2f(b1 * c1)));
                }
                v4u w; w.x = pg8::cvt_pk_bf16(x[0], x[1]); w.y = pg8::cvt_pk_bf16(x[2], x[3]); w.z = pg8::cvt_pk_bf16(x[4], x[5]); w.w = pg8::cvt_pk_bf16(x[6], x[7]);
                if (FF1_PROBE && (mode & 1)) asm volatile("" :: "v"(w.x), "v"(w.y), "v"(w.z), "v"(w.w)); else st_out((v4u*)(T + (size_t)row * ldt + colb), w);
            }
    }
};
struct EpiGLU8 {
    static constexpr bool PERM = true, AFTER_DRAIN = false;
    unsigned char* T8; int ldt; float s; int mode;
    __device__ __forceinline__ void operator()(const pg8::f32x4 (&acc)[2][2][4][2], const pg8::Unit& u, int wr, int wc, int fr, int fq) const {
        const int row0 = u.pm * 256 + wr * 64 + fr, colb = u.pn * 128 + wc * 32 + 8 * fq;
#pragma unroll
        for (int ai = 0; ai < 2; ++ai)
#pragma unroll
            for (int m = 0; m < 4; ++m) {
                const int row = row0 + ai * 128 + m * 16;
                float x[8];
                const float c1 = -1.4426950408889634f * s, c2 = 16.f * s * s;
#pragma unroll
                for (int j = 0; j < 4; ++j) {
                    const float a1 = acc[ai][0][m][0][j], a3 = acc[ai][1][m][0][j], b1 = acc[ai][0][m][1][j], b3 = acc[ai][1][m][1][j];
                    x[j] = (a1 * a3) * (c2 * __builtin_amdgcn_rcpf(1.f + __builtin_amdgcn_exp2f(a1 * c1)));
                    x[4 + j] = (b1 * b3) * (c2 * __builtin_amdgcn_rcpf(1.f + __builtin_amdgcn_exp2f(b1 * c1)));
                }
                v2u w; w.x = pk_fp8x4(x[0], x[1], x[2], x[3]); w.y = pk_fp8x4(x[4], x[5], x[6], x[7]);
#if T8_TILED
                unsigned char* d_ = T8 + (unsigned)(((u.pm * (ldt >> 5) + 4 * u.pn + wc) * 256 + (wr * 64 + fr + ai * 128 + m * 16)) * 32 + 8 * fq);
#else
                unsigned char* d_ = T8 + (size_t)row * ldt + colb;
#endif
                if (FF1_PROBE && (mode & 1)) asm volatile("" :: "v"(w.x), "v"(w.y)); else *(v2u*)d_ = w;
            }
    }
};
struct EpiNone { static constexpr bool PERM = true, AFTER_DRAIN = false; unsigned* sink;
    __device__ __forceinline__ void operator()(const pg8::f32x4 (&acc)[2][2][4][2], const pg8::Unit& u, int wr, int wc, int fr, int fq) const { pg8::f32x4 s = acc[0][0][0][0];
#pragma unroll
        for (int a = 0; a < 2; ++a)
#pragma unroll
            for (int b = 0; b < 2; ++b)
#pragma unroll
                for (int m = 0; m < 4; ++m)
#pragma unroll
                    for (int n = 0; n < 2; ++n) s = s + acc[a][b][m][n];
        if (s[0] + s[1] + s[2] + s[3] == 1.2345e38f) sink[0] = 1u; } };
struct EpiY {
    static constexpr bool PERM = true, AFTER_DRAIN = false;
    bf16* Y; float sc;
    __device__ __forceinline__ void operator()(const pg8::f32x4 (&acc)[2][2][4][2], const pg8::Unit& u, int wr, int wc, int fr, int fq) const {
        const int row0 = u.pm * 256 + wr * 64 + fr, colb = u.pn * 256 + wc * 32 + 8 * fq;
#pragma unroll
        for (int ai = 0; ai < 2; ++ai)
#pragma unroll
            for (int m = 0; m < 4; ++m) {
                const int row = row0 + ai * 128 + m * 16;
#pragma unroll
                for (int bj = 0; bj < 2; ++bj) {
                    const pg8::f32x4 a = acc[ai][bj][m][0] * sc, b = acc[ai][bj][m][1] * sc;
                    v4u w; w.x = pg8::cvt_pk_bf16(a[0], a[1]); w.y = pg8::cvt_pk_bf16(a[2], a[3]); w.z = pg8::cvt_pk_bf16(b[0], b[1]); w.w = pg8::cvt_pk_bf16(b[2], b[3]);
                    *(v4u*)(Y + (size_t)row * D + colb + bj * 128) = w;
                }
            }
    }
};

__device__ __forceinline__ void transpose_item(const float* W, const float* fold, int K, int N, bf16* WT, int k0, int n0, int drow0, LAS float* scr, int lane, int mode = 0) {
    const int kr = lane >> 4, n4 = lane & 15;
    f32x4 v[16];
#pragma unroll
    for (int i = 0; i < 16; ++i) { const f32x4* p_ = (const f32x4*)(W + (size_t)(k0 + 4 * i + kr) * N + n0 + 4 * n4); if (mode & 2) v[i] = (f32x4){1.f, 2.f, 3.f, 4.f}; else v[i] = NT_WLOAD ? __builtin_nontemporal_load(p_) : *p_; }
#pragma unroll
    for (int i = 0; i < 16; ++i) { const int k = 4 * i + kr; *(LAS f32x4*)(scr + k * 64 + ((4 * n4) ^ (4 * ((k >> 3) & 7)))) = v[i]; }
    LDS_WAIT(); asm volatile("" ::: "memory");
    const int c = lane & 7, nn = lane >> 3;
    f32x4 f0 = (f32x4){1.f, 1.f, 1.f, 1.f}, f1 = f0;
    if (fold) { f0 = *(const f32x4*)(fold + k0 + 8 * c); f1 = *(const f32x4*)(fold + k0 + 8 * c + 4); }
#pragma unroll
    for (int i2 = 0; i2 < 8; ++i2) {
        const int n = 8 * i2 + nn; const LAS float* s = scr + (8 * c) * 64 + (n ^ (4 * c));
        v4u o; o.x = pk2(s[0 * 64] * f0[0], s[1 * 64] * f0[1]); o.y = pk2(s[2 * 64] * f0[2], s[3 * 64] * f0[3]); o.z = pk2(s[4 * 64] * f1[0], s[5 * 64] * f1[1]); o.w = pk2(s[6 * 64] * f1[2], s[7 * 64] * f1[3]);
        if (mode & 1) asm volatile("" :: "v"(o.x), "v"(o.y), "v"(o.z), "v"(o.w)); else { GAS v4u* d_ = (GAS v4u*)(WT + (size_t)(drow0 + n) * K + k0 + 8 * c); if (PRO_NT_ST) __builtin_nontemporal_store(o, d_); else *d_ = o; }
    }
    LDS_WAIT(); asm volatile("" ::: "memory");
}
__device__ __forceinline__ void transpose_item8(const float* W, const float* fold, float scale, int K, int N, unsigned char* WT8, int k0, int n0, int drow0, LAS float* scr, int lane, int mode = 0) {
    const int kr = lane >> 4, n4 = lane & 15;
    f32x4 v[16];
#pragma unroll
    for (int i = 0; i < 16; ++i) { const f32x4* p_ = (const f32x4*)(W + (size_t)(k0 + 4 * i + kr) * N + n0 + 4 * n4); if (mode & 2) v[i] = (f32x4){1.f, 2.f, 3.f, 4.f}; else v[i] = NT_WLOAD ? __builtin_nontemporal_load(p_) : *p_; }
#pragma unroll
    for (int i = 0; i < 16; ++i) { const int k = 4 * i + kr; *(LAS f32x4*)(scr + k * 64 + ((4 * n4) ^ (4 * ((k >> 3) & 7)))) = v[i]; }
    LDS_WAIT(); asm volatile("" ::: "memory");
    const int c = lane & 7, nn = lane >> 3;
    f32x4 f0 = (f32x4){scale, scale, scale, scale}, f1 = f0;
    if (fold) { f0 = *(const f32x4*)(fold + k0 + 8 * c) * scale; f1 = *(const f32x4*)(fold + k0 + 8 * c + 4) * scale; }
#pragma unroll
    for (int i2 = 0; i2 < 8; ++i2) {
        const int n = 8 * i2 + nn; const LAS float* s = scr + (8 * c) * 64 + (n ^ (4 * c));
        v2u o; o.x = pk_fp8x4(s[0 * 64] * f0[0], s[1 * 64] * f0[1], s[2 * 64] * f0[2], s[3 * 64] * f0[3]); o.y = pk_fp8x4(s[4 * 64] * f1[0], s[5 * 64] * f1[1], s[6 * 64] * f1[2], s[7 * 64] * f1[3]);
        if (mode & 1) asm volatile("" :: "v"(o.x), "v"(o.y)); else *(GAS v2u*)(WT8 + (size_t)(drow0 + n) * K + k0 + 8 * c) = o;
    }
    LDS_WAIT(); asm volatile("" ::: "memory");
}
__device__ __forceinline__ void transpose_item8w(const float* W, const float* fold, float scale, int K, int N, unsigned char* WT8, int k0, int n0, int drow0, LAS float* scr, int lane, int mode = 0) {
    const int kr = lane >> 3, n4 = lane & 7;
    f32x4 v[16];
#pragma unroll
    for (int i = 0; i < 16; ++i) { const f32x4* p_ = (const f32x4*)(W + (size_t)(k0 + 8 * i + kr) * N + n0 + 4 * n4); if (mode & 2) v[i] = (f32x4){1.f, 2.f, 3.f, 4.f}; else v[i] = NT_WLOAD ? __builtin_nontemporal_load(p_) : *p_; }
#pragma unroll
    for (int i = 0; i < 16; ++i) { const int k = 8 * i + kr; *(LAS f32x4*)(scr + k * 32 + ((4 * n4) ^ (8 * ((k >> 4) & 3)))) = v[i]; }
    LDS_WAIT(); asm volatile("" ::: "memory");
    const int c = lane & 7, nn = lane >> 3;
    f32x4 f[4];
#pragma unroll
    for (int q = 0; q < 4; ++q) { f[q] = (f32x4){scale, scale, scale, scale}; if (fold) f[q] = *(const f32x4*)(fold + k0 + 16 * c + 4 * q) * scale; }
#pragma unroll
    for (int i2 = 0; i2 < 4; ++i2) {
        const int n = 8 * i2 + nn; const LAS float* s = scr + (16 * c) * 32 + (n ^ (8 * (c & 3)));
        v4u o;
        o.x = pk_fp8x4(s[0 * 32] * f[0][0], s[1 * 32] * f[0][1], s[2 * 32] * f[0][2], s[3 * 32] * f[0][3]);
        o.y = pk_fp8x4(s[4 * 32] * f[1][0], s[5 * 32] * f[1][1], s[6 * 32] * f[1][2], s[7 * 32] * f[1][3]);
        o.z = pk_fp8x4(s[8 * 32] * f[2][0], s[9 * 32] * f[2][1], s[10 * 32] * f[2][2], s[11 * 32] * f[2][3]);
        o.w = pk_fp8x4(s[12 * 32] * f[3][0], s[13 * 32] * f[3][1], s[14 * 32] * f[3][2], s[15 * 32] * f[3][3]);
        if (mode & 1) asm volatile("" :: "v"(o.x), "v"(o.y), "v"(o.z), "v"(o.w)); else { GAS v4u* d_ = (GAS v4u*)(WT8 + (size_t)(drow0 + n) * K + k0 + 16 * c); if (PRO_NT_ST) __builtin_nontemporal_store(o, d_); else *d_ = o; }
    }
    LDS_WAIT(); asm volatile("" ::: "memory");
}
__device__ __forceinline__ void prologue_phase(Ctx& C, const Args& A, int mode = 0) {
    LAS float* scr = (LAS float*)(C.lds + C.wave * 16384);
    const int gw = C.bid * 8 + C.wave, NGW = C.G * 8;
    constexpr int F8D = (PRO_F8_DOUBLE && FP8_MOE_MASK == 3) ? 2 : 1;
    constexpr int I_IN = 16 * 56, I_OUT = 16 * 16, I_D1 = 16 * 44, I_D2 = 44 * 16, I_M1 = (16 / F8D) * 56, I_M2 = (56 / F8D) * 16;
    constexpr int N_IN = 4 * I_IN, N_OUT = 4 * I_OUT, N_D1 = 2 * I_D1, N_D2 = 2 * I_D2, N_M1 = 16 * I_M1, N_M2 = 16 * I_M2;
    constexpr int NITEMS = N_IN + N_OUT + 2 * N_D1 + N_D2 + 2 * N_M1 + N_M2;
    for (int it = gw; it < NITEMS; it += NGW) {
        int r = it;
        const float* W; const float* fold = nullptr; bf16* WT; int K, N, glu = -1, loc; bool f8 = false; float f8s = 1.f; unsigned char* WT8 = nullptr;
        if (r < N_IN) { const int l = r / I_IN; loc = r % I_IN; W = A.in[IN_WIN] + (size_t)l * D * WIN; fold = A.in[IN_NMIX] + l * D; WT = (bf16*)(C.ws + WS_WIN) + (size_t)l * WIN * D; K = D; N = WIN; }
        else if ((r -= N_IN) < N_OUT) { const int l = r / I_OUT; loc = r % I_OUT; W = A.in[IN_WOUT] + (size_t)l * D * D; WT = (bf16*)(C.ws + WS_WOUT) + (size_t)l * D * D; K = D; N = D; }
        else if ((r -= N_OUT) < N_D1) { const int i = r / I_D1; loc = r % I_D1; W = A.in[IN_DW1] + (size_t)i * D * FFD; fold = A.in[IN_NFFN] + (2 * i) * D; WT = (bf16*)(C.ws + WS_WD13) + (size_t)i * 2 * FFD * D; K = D; N = FFD; glu = 0; }
        else if ((r -= N_D1) < N_D1) { const int i = r / I_D1; loc = r % I_D1; W = A.in[IN_DW3] + (size_t)i * D * FFD; fold = A.in[IN_NFFN] + (2 * i) * D; WT = (bf16*)(C.ws + WS_WD13) + (size_t)i * 2 * FFD * D; K = D; N = FFD; glu = 1; }
        else if ((r -= N_D1) < N_D2) { const int i = r / I_D2; loc = r % I_D2; W = A.in[IN_DW2] + (size_t)i * FFD * D; WT = (bf16*)(C.ws + WS_WD2) + (size_t)i * D * FFD; K = FFD; N = D; }
        else if ((r -= N_D2) < N_M1) { const int ie = r / I_M1; loc = r % I_M1; W = A.in[IN_MW1] + (size_t)ie * D * FFE; fold = A.in[IN_NFFN] + (2 * (ie >> 3) + 1) * D; WT = (bf16*)(C.ws + WS_WM13) + (size_t)ie * 2 * FFE * D; K = D; N = FFE; glu = 0; if ((FP8_MOE_MASK >> (ie >> 3)) & 1) { f8 = true; f8s = 32.f; WT8 = C.ws + WS_WM13 + ((size_t)(ie >> 3) * 8 * 2 * FFE * D * 2) + (size_t)(ie & 7) * 2 * FFE * D; } }
        else if ((r -= N_M1) < N_M1) { const int ie = r / I_M1; loc = r % I_M1; W = A.in[IN_MW3] + (size_t)ie * D * FFE; fold = A.in[IN_NFFN] + (2 * (ie >> 3) + 1) * D; WT = (bf16*)(C.ws + WS_WM13) + (size_t)ie * 2 * FFE * D; K = D; N = FFE; glu = 1; if ((FP8_MOE_MASK >> (ie >> 3)) & 1) { f8 = true; f8s = 32.f; WT8 = C.ws + WS_WM13 + ((size_t)(ie >> 3) * 8 * 2 * FFE * D * 2) + (size_t)(ie & 7) * 2 * FFE * D; } }
        else { r -= N_M1; const int ie = r / I_M2; loc = r % I_M2; W = A.in[IN_MW2] + (size_t)ie * FFE * D; WT = (bf16*)(C.ws + WS_WM2) + (size_t)ie * D * FFE; K = FFE; N = D; if ((FP8_MOE_MASK >> (ie >> 3)) & 1) { f8 = true; f8s = 64.f; WT8 = C.ws + WS_WM2 + ((size_t)(ie >> 3) * 8 * D * FFE * 2) + (size_t)(ie & 7) * D * FFE; } }
        const bool wide = PRO_F8_WIDE && f8;
        const int nw = wide ? 32 : 64, nblk = N / nw, kb = loc / nblk, nb = loc % nblk, k0 = (wide ? 128 : f8 ? 64 * F8D : 64) * kb, n0 = nw * nb;
        const int drow0 = (glu < 0) ? n0 : ((n0 >> 7) * 256 + glu * 128 + (n0 & 127));
        if (wide) transpose_item8w(W, fold, f8s, K, N, WT8, k0, n0, drow0, scr, C.lane, mode);
        else if (f8) { transpose_item8(W, fold, f8s, K, N, WT8, k0, n0, drow0, scr, C.lane, mode); if (F8D == 2) transpose_item8(W, fold, f8s, K, N, WT8, k0 + 64, n0, drow0, scr, C.lane, mode); }
        else transpose_item(W, fold, K, N, WT, k0, n0, drow0, scr, C.lane, mode);
    }
    for (int row = gw; row < NTOK; row += NGW) {
        const int b = row / LT, t = row % LT;
        f32x4 v[4]; float s = 0.f;
#pragma unroll
        for (int j = 0; j < 4; ++j) {
            const int col = 4 * C.lane + 256 * j;
            if (t < FIRSTV) v[j] = (f32x4){0.f, 0.f, 0.f, 0.f};
            else if (t < LEAD) v[j] = *(const f32x4*)(A.in[IN_META] + (size_t)(t - FIRSTV) * D + col);
            else v[j] = *(const f32x4*)(A.in[IN_X] + ((size_t)b * SEQ + (t - LEAD)) * D + col);
            s += (v[j][0] * v[j][0] + v[j][1] * v[j][1]) + (v[j][2] * v[j][2] + v[j][3] * v[j][3]);
            v2u w; w.x = pk2(v[j][0], v[j][1]); w.y = pk2(v[j][2], v[j][3]);
            *(v2u*)(C.HB() + (size_t)row * D + col) = w;
        }
        s = wave_sum(s);
        if (C.lane < 16) C.SSQ()[(size_t)row * 16 + C.lane] = (C.lane == 0) ? s : 0.f;
    }
#if HGV_PREFILL
    {
        f32x4* vz = (f32x4*)(C.ws + WS_ACT + ACT_LOGF + HGV_OFF);
        for (int i = C.bid * 512 + C.tid; i < (NTOK / 64) * 1024 / 4; i += C.G * 512) vz[i] = (f32x4){1.f, 1.f, 1.f, 1.f};
    }
#endif
    if (C.bid == 0) {
        const int tid = C.tid;
        {
            const float* lg = A.in[IN_LBL];
            const float a0 = lg[tid], a1 = lg[512 + tid], a2 = lg[1024 + tid], a3 = lg[1536 + tid];
            const float mx = fmaxf(fmaxf(a0, a1), fmaxf(a2, a3));
            const float e0 = expf(a0 - mx), e1 = expf(a1 - mx), e2 = expf(a2 - mx), e3 = expf(a3 - mx);
            const float inv = 1.f / (((e0 + e1) + e2) + e3);
            const float p0 = e0 * inv, p1 = e1 * inv, p2 = e2 * inv, p3 = e3 * inv;
            const float c0 = p0, c1 = c0 + p1, c2 = c1 + p2, c3 = c2 + p3;
            C.LB()[tid] = 0.f;
            C.LB()[512 + tid] = fminf(fmaxf(c1 - c0, 0.f), 0.999f);
            C.LB()[1024 + tid] = fminf(fmaxf(c2 - c0, 0.f), 0.999f);
            C.LB()[1536 + tid] = fminf(fmaxf(c3 - c0, 0.f), 0.999f);
        }
        for (int i = tid; i < 4 * 132; i += 512) { const int h = i / 132, d = i % 132; C.BIAST()[i] = (d <= 128) ? A.in[IN_RELB][T5B[d] * 4 + h] : 0.f; }
        if (tid < 4) {
            const float* lv = A.in[IN_LAMBDA] + tid * 256;
            float s01 = 0.f, s23 = 0.f;
            for (int j = 0; j < 64; ++j) { s01 += lv[j] * lv[64 + j]; s23 += lv[128 + j] * lv[192 + j]; }
            const float li = 0.8f - 0.6f * expf(-0.3f * (float)tid);
            C.LAM()[tid * 2] = expf(s01) - expf(s23) + li; C.LAM()[tid * 2 + 1] = li;
        }
        if (tid < 512) { C.SUBLN()[tid] = A.in[IN_SUBLN][tid]; C.HGNW()[tid] = A.in[IN_HGNW][tid]; C.FNORM()[tid] = A.in[IN_FNORM][tid]; C.FNORM()[512 + tid] = A.in[IN_FNORM][512 + tid]; }
        for (int i = tid; i < 2 * 8 * 1024; i += 512) { const int li = i >> 13, e = (i >> 10) & 7, k = i & 1023; C.RF()[i] = A.in[IN_NFFN][(2 * li + 1) * D + k] * A.in[IN_ROUTER][(size_t)li * D * NE + k * NE + e]; }
    }
}

typedef float f32x16 __attribute__((ext_vector_type(16)));
typedef short bf16x8 __attribute__((ext_vector_type(8)));
typedef short s16x4 __attribute__((ext_vector_type(4)));
constexpr float LOG2E = 1.4426950408889634f;
constexpr int AT_K = 0, AT_V = 32768, AT_BIAS = 65536, AT_WSF = 66560, AT_STG = 69632, AT_XCH = 0;
__device__ __forceinline__ int crow(int r, int hi) { return (r & 3) + 8 * (r >> 2) + 4 * hi; }
__device__ __forceinline__ s16x4 vtr(const LAS unsigned char* p) { typedef short v4i16_t __attribute__((ext_vector_type(4))); return __builtin_bit_cast(s16x4, __builtin_amdgcn_ds_read_tr16_b64_v4i16((LAS v4i16_t*)p)); }
__device__ __forceinline__ bf16x8 pack8(const f32x16& p, int b0) {
    v4u w; w.x = pg8::cvt_pk_bf16(p[b0 + 0], p[b0 + 1]); w.y = pg8::cvt_pk_bf16(p[b0 + 2], p[b0 + 3]); w.z = pg8::cvt_pk_bf16(p[b0 + 4], p[b0 + 5]); w.w = pg8::cvt_pk_bf16(p[b0 + 6], p[b0 + 7]);
    return __builtin_bit_cast(bf16x8, w);
}

#if ATT_V2
template <bool NEAR, bool FIRST>
__device__ __forceinline__ void attn_tile(LAS unsigned char* lds, int buf, int k0, int qw0, int tq, int c, int r32, int hi, int kswz, int vb, const bf16x8 (&qr)[4],
                                          const LAS float* biasl, LAS float* wsf, f32x16 (&o)[4], f32x16& cfar, float& mref, float& lsum) {
    if (NEAR && k0 > qw0 + 31) return;
    f32x16 p0, p1;
    const LAS unsigned char* kb = lds + AT_K + buf * 16384 + c * 8192 + r32 * 128;
    if (NEAR) {
#pragma unroll
        for (int r = 0; r < 16; ++r) { p0[r] = 0.f; p1[r] = 0.f; }
    } else { p0 = cfar; p1 = cfar; }
#pragma unroll
    for (int ks = 0; ks < 4; ++ks) {
        const int off = ((2 * ks + hi) ^ kswz) * 16;
        const bf16x8 k0f = *(const LAS bf16x8*)(kb + off), k1f = *(const LAS bf16x8*)(kb + 4096 + off);
        p0 = __builtin_amdgcn_mfma_f32_32x32x16_bf16(k0f, qr[ks], p0, 0, 0, 0);
        p1 = __builtin_amdgcn_mfma_f32_32x32x16_bf16(k1f, qr[ks], p1, 0, 0, 0);
    }
    if (NEAR) {
#pragma unroll
        for (int r = 0; r < 16; ++r) {
            const int tk = k0 + crow(r, hi), d0 = tq - tk, d1 = d0 - 32;
            const float b0 = biasl[d0 < 0 ? 0 : (d0 > 128 ? 128 : d0)] - mref, b1 = biasl[d1 < 0 ? 0 : (d1 > 128 ? 128 : d1)] - mref;
            p0[r] = (d0 < 0 || tk < FIRSTV) ? -INFINITY : p0[r] + b0;
            p1[r] = (d1 < 0 || tk + 32 < FIRSTV) ? -INFINITY : p1[r] + b1;
        }
    }
    float mx = fmaxf(p0[0], p1[0]);
#pragma unroll
    for (int r = 1; r < 16; ++r) mx = fmaxf(fmaxf(mx, p0[r]), p1[r]);
    mx = xor32_max(mx);
    if (FIRST || __any(mx > 8.0f)) {
        const float dl = FIRST ? ((mx > -1e30f) ? mx : 0.f) : fmaxf(mx, 0.f);
        mref += dl;
#pragma unroll
        for (int r = 0; r < 16; ++r) { p0[r] -= dl; p1[r] -= dl; if (!NEAR) cfar[r] -= dl; }
        if (!FIRST) {
            const float f = __builtin_amdgcn_exp2f(-dl);
            lsum *= f;
            if (hi == 0) wsf[r32] = f;
            LDS_WAIT(); asm volatile("" ::: "memory");
#pragma unroll
            for (int g = 0; g < 4; ++g) { const f32x4 fv = *(const LAS f32x4*)(wsf + 8 * g + 4 * hi);
#pragma unroll
                for (int d = 0; d < 4; ++d) { o[d][4 * g + 0] *= fv[0]; o[d][4 * g + 1] *= fv[1]; o[d][4 * g + 2] *= fv[2]; o[d][4 * g + 3] *= fv[3]; } }
        }
    }
    float ps = 0.f;
#pragma unroll
    for (int r = 0; r < 16; ++r) { p0[r] = __builtin_amdgcn_exp2f(p0[r]); p1[r] = __builtin_amdgcn_exp2f(p1[r]); ps += p0[r] + p1[r]; }
    lsum += ps;
    const bf16x8 pa0 = pack8(p0, 0), pa1 = pack8(p0, 8), pa2 = pack8(p1, 0), pa3 = pack8(p1, 8);
    const LAS unsigned char* vp = lds + AT_V + buf * 16384 + vb;
#pragma unroll
    for (int d = 0; d < 4; ++d) {
#define AT_VF(s) ({ const s16x4 lo_ = vtr(vp + (2 * (s)) * 2048 + d * 512), hi_ = vtr(vp + (2 * (s) + 1) * 2048 + d * 512); (bf16x8){lo_[0], lo_[1], lo_[2], lo_[3], hi_[0], hi_[1], hi_[2], hi_[3]}; })
        o[d] = __builtin_amdgcn_mfma_f32_32x32x16_bf16(pa0, AT_VF(0), o[d], 0, 0, 0);
        o[d] = __builtin_amdgcn_mfma_f32_32x32x16_bf16(pa1, AT_VF(1), o[d], 0, 0, 0);
        o[d] = __builtin_amdgcn_mfma_f32_32x32x16_bf16(pa2, AT_VF(2), o[d], 0, 0, 0);
        o[d] = __builtin_amdgcn_mfma_f32_32x32x16_bf16(pa3, AT_VF(3), o[d], 0, 0, 0);
#undef AT_VF
    }
}
#endif
__device__ __forceinline__ void attn_unit(Ctx& C, int l, int b, int h, int qi, bool dry = false) {
    LAS unsigned char* lds = C.lds;
    const int tid = C.tid, lane = C.lane, wave = C.wave, rg = wave >> 1, c = wave & 1, r32 = lane & 31, hi = lane >> 5;
    const size_t rowbase = (size_t)b * LT;
    const bf16* PJ = C.PROJ();
    LAS float* biasl = (LAS float*)(lds + AT_BIAS);
    LAS float* wsf = (LAS float*)(lds + AT_WSF) + wave * 64;
    if (tid < 132) biasl[tid] = C.BIAST()[h * 132 + tid] * LOG2E;
    const float lam = C.LAM()[l * 2], lam_init = C.LAM()[l * 2 + 1];
    const int qw0 = 128 * qi + 32 * rg, tq = qw0 + r32;
    bf16x8 qr[4];
    { const bf16* qp = PJ + (rowbase + tq) * WIN + 2048 + h * 128 + c * 64 + 8 * hi;
#pragma unroll
      for (int ks = 0; ks < 4; ++ks) qr[ks] = *(const bf16x8*)(qp + 16 * ks); }
    const int kkey = tid >> 3, kch = tid & 7;
    const bf16* ksrc = PJ + (rowbase + kkey) * WIN + 2560 + h * 128 + kch * 8;
    const int kdst = kkey * 128 + ((kch ^ ((kkey >> 1) & 7)) * 16);
    const int vkey0 = tid >> 4, vch = tid & 15;
    const bf16* vsrc = PJ + (rowbase + vkey0) * WIN + 3072 + h * 128 + vch * 8;
    const int vdst0 = ((vkey0 >> 3) * 4 + (vch >> 2)) * 512 + (vkey0 & 7) * 64 + (vch & 3) * 16;
    v4u kreg0, kreg1, vreg0, vreg1;
#define AT_LOAD(kt) do { const size_t o_ = (size_t)(kt) * 64 * WIN; kreg0 = *(const v4u*)(ksrc + o_); kreg1 = *(const v4u*)(ksrc + o_ + 64); vreg0 = *(const v4u*)(vsrc + o_); vreg1 = *(const v4u*)(vsrc + o_ + (size_t)32 * WIN); } while (0)
#define AT_STORE(buf) do { *(LAS v4u*)(lds + AT_K + (buf) * 16384 + kdst) = kreg0; *(LAS v4u*)(lds + AT_K + (buf) * 16384 + 8192 + kdst) = kreg1; \
        *(LAS v4u*)(lds + AT_V + (buf) * 16384 + vdst0) = vreg0; *(LAS v4u*)(lds + AT_V + (buf) * 16384 + 8192 + vdst0) = vreg1; } while (0)
    const int nt = 2 * qi + 1;
    AT_LOAD(1); AT_STORE(0);
    __syncthreads();
    f32x16 o[4];
#pragma unroll
    for (int d = 0; d < 4; ++d)
#pragma unroll
        for (int r = 0; r < 16; ++r) o[d][r] = 0.f;
#if ATT_V2
    float mref = 0.f, lsum = 0.f;
    const int kswz = (r32 >> 1) & 7;
    const int vb = (4 * hi + ((lane & 15) >> 2)) * 64 + ((lane >> 4) & 1) * 32 + (lane & 3) * 8;
    f32x16 cfar;
    if (nt > 1) AT_LOAD(2);
    attn_tile<true, true>(lds, 0, 64, qw0, tq, c, r32, hi, kswz, vb, qr, biasl, wsf, o, cfar, mref, lsum);
    if (nt > 1) AT_STORE(1);
    { const float cb = biasl[128] - mref;
#pragma unroll
      for (int r = 0; r < 16; ++r) cfar[r] = cb; }
    __syncthreads();
    for (int kt = 2; kt <= 2 * qi - 3; ++kt) {
        AT_LOAD(kt + 1);
        attn_tile<false, false>(lds, (kt - 1) & 1, 64 * kt, qw0, tq, c, r32, hi, kswz, vb, qr, biasl, wsf, o, cfar, mref, lsum);
        AT_STORE(kt & 1);
        __syncthreads();
    }
    for (int kt = (2 * qi - 2 > 2) ? 2 * qi - 2 : 2; kt <= nt; ++kt) {
        if (kt < nt) AT_LOAD(kt + 1);
        attn_tile<true, false>(lds, (kt - 1) & 1, 64 * kt, qw0, tq, c, r32, hi, kswz, vb, qr, biasl, wsf, o, cfar, mref, lsum);
        if (kt < nt) AT_STORE(kt & 1);
        __syncthreads();
    }
#else
    float mref = -1e30f, lsum = 0.f;
    const int kswz = (r32 >> 1) & 7;
    const int vb = (4 * hi + ((lane & 15) >> 2)) * 64 + ((lane >> 4) & 1) * 32 + (lane & 3) * 8;
    const float b128 = biasl[128];
    for (int it = 0; it < nt; ++it) {
        const int kt = it + 1, buf = it & 1, k0 = 64 * kt;
        if (it + 1 < nt) AT_LOAD(kt + 1);
        if (k0 <= qw0 + 31) {
            const bool near = (k0 + 63 > qw0 - 128) || (kt == 1);
            f32x16 p0, p1;
            { const float ini = near ? 0.f : b128;
#pragma unroll
              for (int r = 0; r < 16; ++r) { p0[r] = ini; p1[r] = ini; } }
            const LAS unsigned char* kb = lds + AT_K + buf * 16384 + c * 8192 + r32 * 128;
#pragma unroll
            for (int ks = 0; ks < 4; ++ks) {
                const int off = ((2 * ks + hi) ^ kswz) * 16;
                const bf16x8 k0f = *(const LAS bf16x8*)(kb + off), k1f = *(const LAS bf16x8*)(kb + 4096 + off);
                p0 = __builtin_amdgcn_mfma_f32_32x32x16_bf16(k0f, qr[ks], p0, 0, 0, 0);
                p1 = __builtin_amdgcn_mfma_f32_32x32x16_bf16(k1f, qr[ks], p1, 0, 0, 0);
            }
            if (near) {
#pragma unroll
                for (int r = 0; r < 16; ++r) {
                    const int tk = k0 + crow(r, hi), d0 = tq - tk, d1 = d0 - 32;
                    const float b0 = biasl[d0 < 0 ? 0 : (d0 > 128 ? 128 : d0)], b1 = biasl[d1 < 0 ? 0 : (d1 > 128 ? 128 : d1)];
                    p0[r] = (d0 < 0 || tk < FIRSTV) ? -INFINITY : p0[r] + b0;
                    p1[r] = (d1 < 0 || tk + 32 < FIRSTV) ? -INFINITY : p1[r] + b1;
                }
            }
            float mx = fmaxf(p0[0], p1[0]);
#pragma unroll
            for (int r = 1; r < 16; ++r) mx = fmaxf(fmaxf(mx, p0[r]), p1[r]);
            mx = xor32_max(mx);
            if (__any(mx > mref + 8.0f)) {
                const float mnew = fmaxf(mref, mx), f = __builtin_amdgcn_exp2f(mref - mnew);
                lsum *= f; mref = mnew;
                if (hi == 0) wsf[r32] = f;
                LDS_WAIT(); asm volatile("" ::: "memory");
#pragma unroll
                for (int g = 0; g < 4; ++g) { const f32x4 fv = *(const LAS f32x4*)(wsf + 8 * g + 4 * hi);
#pragma unroll
                    for (int d = 0; d < 4; ++d) { o[d][4 * g + 0] *= fv[0]; o[d][4 * g + 1] *= fv[1]; o[d][4 * g + 2] *= fv[2]; o[d][4 * g + 3] *= fv[3]; } }
            }
            float ps = 0.f;
#pragma unroll
            for (int r = 0; r < 16; ++r) { p0[r] = __builtin_amdgcn_exp2f(p0[r] - mref); p1[r] = __builtin_amdgcn_exp2f(p1[r] - mref); ps += p0[r] + p1[r]; }
            lsum += ps;
            const bf16x8 pa0 = pack8(p0, 0), pa1 = pack8(p0, 8), pa2 = pack8(p1, 0), pa3 = pack8(p1, 8);
            const LAS unsigned char* vp = lds + AT_V + buf * 16384 + vb;
#pragma unroll
            for (int d = 0; d < 4; ++d) {
#define AT_VF(s) ({ const s16x4 lo_ = vtr(vp + (2 * (s)) * 2048 + d * 512), hi_ = vtr(vp + (2 * (s) + 1) * 2048 + d * 512); (bf16x8){lo_[0], lo_[1], lo_[2], lo_[3], hi_[0], hi_[1], hi_[2], hi_[3]}; })
                o[d] = __builtin_amdgcn_mfma_f32_32x32x16_bf16(pa0, AT_VF(0), o[d], 0, 0, 0);
                o[d] = __builtin_amdgcn_mfma_f32_32x32x16_bf16(pa1, AT_VF(1), o[d], 0, 0, 0);
                o[d] = __builtin_amdgcn_mfma_f32_32x32x16_bf16(pa2, AT_VF(2), o[d], 0, 0, 0);
                o[d] = __builtin_amdgcn_mfma_f32_32x32x16_bf16(pa3, AT_VF(3), o[d], 0, 0, 0);
#undef AT_VF
            }
        }
        if (it + 1 < nt) AT_STORE(buf ^ 1);
        __syncthreads();
    }
#endif
#undef AT_LOAD
#undef AT_STORE
    lsum = xor32_sum(lsum);
    { const float inv = lsum > 0.f ? 1.f / lsum : 0.f;
      if (hi == 0) wsf[r32] = inv;
      LDS_WAIT(); asm volatile("" ::: "memory");
#pragma unroll
      for (int g = 0; g < 4; ++g) { const f32x4 fv = *(const LAS f32x4*)(wsf + 8 * g + 4 * hi);
#pragma unroll
          for (int d = 0; d < 4; ++d) { o[d][4 * g + 0] *= fv[0]; o[d][4 * g + 1] *= fv[1]; o[d][4 * g + 2] *= fv[2]; o[d][4 * g + 3] *= fv[3]; } } }
    LAS float* xch = (LAS float*)(lds + AT_XCH) + rg * 4096;
    if (c == 1) {
#pragma unroll
        for (int d = 0; d < 4; ++d)
#pragma unroll
            for (int r = 0; r < 16; ++r) xch[(d * 16 + r) * 64 + lane] = o[d][r];
    }
    __syncthreads();
    if (c == 0) {
        float ss[16];
#pragma unroll
        for (int r = 0; r < 16; ++r) ss[r] = 0.f;
#pragma unroll
        for (int d = 0; d < 4; ++d)
#pragma unroll
            for (int r = 0; r < 16; ++r) { const float a = o[d][r] - lam * xch[(d * 16 + r) * 64 + lane]; o[d][r] = a; ss[r] += a * a; }
#pragma unroll
        for (int r = 0; r < 16; ++r) {
            float s = ss[r];
            s += __shfl_xor(s, 1); s += __shfl_xor(s, 2); s += __shfl_xor(s, 4); s += __shfl_xor(s, 8); s += __shfl_xor(s, 16);
            ss[r] = rsqrtf(s * (1.0f / 128.0f) + EPS) * (1.f - lam_init);
        }
        LAS bf16* stg = (LAS bf16*)(lds + AT_STG) + rg * 4096;
        const float* sw = C.SUBLN() + l * 128 + r32;
#pragma unroll
        for (int d = 0; d < 4; ++d) { const float w = sw[32 * d];
#pragma unroll
            for (int r = 0; r < 16; ++r) stg[crow(r, hi) * 128 + 32 * d + r32] = (bf16)f2bf(o[d][r] * ss[r] * w); }
        LDS_WAIT(); asm volatile("" ::: "memory");
        bf16* op = (dry ? (bf16*)(C.ws + WS_H) : C.MIX()) + (rowbase + qw0) * D + 512 + h * 128;
#pragma unroll
        for (int i = 0; i < 8; ++i) { const int ch = i * 64 + lane, row = ch >> 4, cc = ch & 15; *(v4u*)(op + (size_t)row * D + cc * 8) = *(const LAS v4u*)(stg + row * 128 + cc * 8); }
    }
    __syncthreads();
}
constexpr int HG_QM = 0, HG_KR = 16384, HG_KT = 32768, HG_V = 49152, HG_ST = 65536, HG_XT = 98304, HG_OS = 106496, HG_SQ = 122880, HG_VEC = 123904;
__device__ __forceinline__ bf16x8 tr_frag(const LAS unsigned char* p) { const s16x4 lo = vtr(p), hi4 = vtr(p + 256); return (bf16x8){lo[0], lo[1], lo[2], lo[3], hi4[0], hi4[1], hi4[2], hi4[3]}; }

#if HG_TWO_STAGE
constexpr int HGS_QM = 0, HGS_KT = 16384, HGS_V = 32768, HGS_XT = 49152, HGS_VEC = 57344, HGS_STRIDE = 65536;
__device__ __forceinline__ unsigned char* hgs_block(Ctx& C, int bh, int ch) { return C.ws + WS_H + (size_t)(bh * (LT / 64) + ch) * HGS_STRIDE; }
__device__ __forceinline__ void hgrn_pre_phase(Ctx& C, int l) {
    LAS unsigned char* lds = C.lds;
    const int tid = C.tid, lane = C.lane, wave = C.wave;
    const int c4 = tid & 31, tg = tid >> 5;
    LAS float* vec = (LAS float*)(lds + HG_VEC);
    constexpr int NCH = LT / 64 - 1, NU = 32 * NCH;
    v2u pq[4], pk[4], pv[4]; f32x4 pb[4], pbm;
#define HP_LOAD(u) do { const int bh_ = (u) / NCH, ch_ = 1 + (u) % NCH; const size_t r0_ = (size_t)(bh_ >> 2) * LT + (size_t)ch_ * 64; const bf16* PJ_ = C.PROJ() + (bh_ & 3) * 128; const float* BL_ = C.LOGF() + (bh_ & 3) * 128; \
        _Pragma("unroll") for (int i = 0; i < 4; ++i) { const size_t row_ = r0_ + 4 * tg + i; const bf16* p_ = PJ_ + row_ * WIN + 4 * c4; \
            pq[i] = *(const v2u*)p_; pk[i] = *(const v2u*)(p_ + 512); pv[i] = *(const v2u*)(p_ + 1024); pb[i] = *(const f32x4*)(BL_ + row_ * 512 + 4 * c4); } \
        pbm = *(const f32x4*)(BL_ + (r0_ + 31) * 512 + 4 * c4); } while (0)
    if (C.bid < NU) HP_LOAD(C.bid);
    for (int u = C.bid; u < NU; u += C.G) {
#pragma unroll
        for (int i = 0; i < 4; ++i) {
            const int t = 4 * tg + i;
            float qm[4], km[4];
            const float qv[4] = {bf_lo(pq[i].x), bf_hi(pq[i].x), bf_lo(pq[i].y), bf_hi(pq[i].y)};
            const float kv[4] = {bf_lo(pk[i].x), bf_hi(pk[i].x), bf_lo(pk[i].y), bf_hi(pk[i].y)};
#pragma unroll
            for (int j = 0; j < 4; ++j) { const float x = __builtin_amdgcn_fmed3f(pb[i][j] - pbm[j], -115.f, 115.f); qm[j] = qv[j] * __builtin_amdgcn_exp2f(x); km[j] = kv[j] * __builtin_amdgcn_exp2f(-x); }
            const int rsw = (((c4 >> 1) ^ (t & 15)) * 16) + (c4 & 1) * 8;
            *(LAS v2u*)(lds + HG_QM + t * 256 + rsw) = pack4(qm[0], qm[1], qm[2], qm[3]);
            const v2u kmw = pack4(km[0], km[1], km[2], km[3]);
            *(LAS v2u*)(lds + HG_KR + t * 256 + rsw) = kmw;
            const int tso = ((t >> 3) * 4 + (c4 >> 3)) * 512 + (t & 7) * 64 + (c4 & 7) * 8;
            *(LAS v2u*)(lds + HG_KT + tso) = kmw;
            *(LAS v2u*)(lds + HG_V + tso) = pv[i];
            if (t == 31) *(LAS f32x4*)(vec + 4 * c4) = (f32x4){__builtin_amdgcn_exp2f(pb[i][0]), __builtin_amdgcn_exp2f(pb[i][1]), __builtin_amdgcn_exp2f(pb[i][2]), __builtin_amdgcn_exp2f(pb[i][3])};
            if (t == 63) *(LAS f32x4*)(vec + 128 + 4 * c4) = (f32x4){__builtin_amdgcn_exp2f(pb[i][0] - pbm[0]), __builtin_amdgcn_exp2f(pb[i][1] - pbm[1]), __builtin_amdgcn_exp2f(pb[i][2] - pbm[2]), __builtin_amdgcn_exp2f(pb[i][3] - pbm[3])};
        }
        __syncthreads();
        if (u + C.G < NU) HP_LOAD(u + C.G);
#pragma unroll
        for (int rep2 = 0; rep2 < 2; ++rep2) {
            const int ti = wave + 8 * rep2;
            if (ti == 10 || ti == 11) {
                const int sb = (ti == 10) ? 1 : 3, tb = sb - 1, fr = lane & 15, fq = lane >> 4, tt = 16 * tb + fr;
                unsigned z_; asm volatile("v_mov_b32 %0, 0" : "=v"(z_));
                *(LAS v2u*)(lds + HG_XT + tt * 128 + (((2 * sb + (fq >> 1)) ^ ((tt >> 1) & 7)) * 16) + (fq & 1) * 8) = (v2u){z_, z_};
            }
            if (ti < 10) {
                const int sb = (ti < 4) ? 0 : (ti < 7) ? 1 : (ti < 9) ? 2 : 3, tb = (ti < 4) ? ti : (ti < 7) ? ti - 3 : (ti < 9) ? ti - 5 : 3;
                const int fr = lane & 15, fq = lane >> 4, s = 16 * sb + fr, tt = 16 * tb + fr;
                f32x4 x = (f32x4){0.f, 0.f, 0.f, 0.f};
#pragma unroll
                for (int ks = 0; ks < 4; ++ks) {
                    const bf16x8 a = *(const LAS bf16x8*)(lds + HG_KR + s * 256 + (((4 * ks + fq) ^ (s & 15)) * 16));
                    const bf16x8 bq = *(const LAS bf16x8*)(lds + HG_QM + tt * 256 + (((4 * ks + fq) ^ (tt & 15)) * 16));
                    x = __builtin_amdgcn_mfma_f32_16x16x32_bf16(a, bq, x, 0, 0, 0);
                }
                if (sb == tb) {
#pragma unroll
                    for (int r = 0; r < 4; ++r) x[r] = (4 * fq + r > fr) ? 0.f : x[r];
                }
                *(LAS v2u*)(lds + HG_XT + tt * 128 + (((2 * sb + (fq >> 1)) ^ ((tt >> 1) & 7)) * 16) + (fq & 1) * 8) = pack4(x[0], x[1], x[2], x[3]);
            }
        }
        __syncthreads();
        {
            unsigned char* blk = hgs_block(C, u / NCH, 1 + u % NCH);
#pragma unroll
            for (int p = 0; p < 2; ++p) {
                *(v4u*)(blk + HGS_QM + 8192 * p + 16 * tid) = *(const LAS v4u*)(lds + HG_QM + 8192 * p + 16 * tid);
                *(v4u*)(blk + HGS_KT + 8192 * p + 16 * tid) = *(const LAS v4u*)(lds + HG_KT + 8192 * p + 16 * tid);
                *(v4u*)(blk + HGS_V + 8192 * p + 16 * tid) = *(const LAS v4u*)(lds + HG_V + 8192 * p + 16 * tid);
            }
            *(v4u*)(blk + HGS_XT + 16 * tid) = *(const LAS v4u*)(lds + HG_XT + 16 * tid);
            if (tid < 64) *(v4u*)(blk + HGS_VEC + 16 * tid) = *(const LAS v4u*)(lds + HG_VEC + 16 * tid);
        }
        __syncthreads();
    }
#undef HP_LOAD
}
#endif
__device__ __forceinline__ void hgrn_unit(Ctx& C, int l, int b, int h) {
    LAS unsigned char* lds = C.lds;
    const int tid = C.tid, lane = C.lane, wave = C.wave, r32 = lane & 31, hi = lane >> 5;
    const size_t rowbase = (size_t)b * LT;
    const bf16* PJ = C.PROJ() + h * 128;
#if HF_MERGE && HG_C4MAP
    const int c4p = tid & 31, c4 = 2 * (c4p & 15) + (c4p >> 4), tg = tid >> 5;
    const float* BL = C.LOGF(); const int BLC = (c4p >> 4) * 256 + (16 * h + (c4p & 15)) * 4;
#elif HF_MERGE
    const int c4 = tid & 31, tg = tid >> 5;
    const float* BL = C.LOGF(); const int BLC = (c4 & 1) * 256 + (16 * h + (c4 >> 1)) * 4;
#else
    const int c4 = tid & 31, tg = tid >> 5;
    const float* BL = C.LOGF() + h * 128; const int BLC = 4 * c4;
#endif
    const int dkb = wave >> 1, dvb0 = 2 * (wave & 1);
    const int th = wave >> 2, dvb = wave & 3;
    const int vbq = ((lane & 15) >> 2) * 64 + ((lane >> 4) & 1) * 32 + (lane & 3) * 8;
    LAS float* vec = (LAS float*)(lds + HG_VEC);
    LAS float* sq = (LAS float*)(lds + HG_SQ);
    f32x16 st[2];
#pragma unroll
    for (int j = 0; j < 2; ++j)
#pragma unroll
        for (int r = 0; r < 16; ++r) st[j][r] = 0.f;
#if HG_TWO_STAGE
    v4u im[7], imv = (v4u){0u, 0u, 0u, 0u};
#define HG_LOAD(ch) do { const unsigned char* blk_ = hgs_block(C, b * 4 + h, (ch)); \
        _Pragma("unroll") for (int p = 0; p < 7; ++p) im[p] = *(const v4u*)(blk_ + 8192 * p + 16 * tid); \
        if (tid < 64) imv = *(const v4u*)(blk_ + HGS_VEC + 16 * tid); } while (0)
#else
#if HG_EQ_CHAIN
    v2u pq[4], pk[4], pv[4], pe[4]; f32x4 pvec = (f32x4){0.f, 0.f, 0.f, 0.f};
#if HG_EQ_BOTH
    const bf16* EQB = (const bf16*)(C.ws + WS_H) + h * 128; const float* VG = (const float*)(C.ws + WS_H + 60 * MiB) + h * 128; const bf16* KMB = (const bf16*)(C.ws + WS_H + 36 * MiB) + h * 128;
#else
    const bf16* EQB = (const bf16*)C.LOGF() + h * 128; const float* VG = (const float*)((const unsigned char*)C.LOGF() + (HGV_DUP ? (size_t)HGV_DUP * MiB : HGV_OFF)) + h * 128; const bf16* KMB = PJ;
#endif
#define HG_LOAD(ch) do { const size_t r0_ = rowbase + (size_t)(ch) * 64; const bf16* KMB_ = HG_EQ_BOTH ? KMB : PJ; \
        _Pragma("unroll") for (int i = 0; i < 4; ++i) { const size_t row_ = r0_ + 4 * tg + i; const bf16* p_ = PJ + row_ * WIN + 4 * c4; \
            pq[i] = *(const v2u*)p_; pk[i] = HG_EQ_BOTH ? *(const v2u*)(KMB_ + row_ * 512 + 4 * c4) : *(const v2u*)(p_ + 512); pv[i] = *(const v2u*)(p_ + 1024); pe[i] = *(const v2u*)(EQB + row_ * 512 + 4 * c4); } \
        if (tid < 64) pvec = *(const f32x4*)(VG + (r0_ >> 6) * 1024 + (tid >> 5) * 512 + 4 * (tid & 31)); } while (0)
#else
    v2u pq[4], pk[4], pv[4]; f32x4 pb[4], pbm;
#define HG_LOAD(ch) do { const size_t r0_ = rowbase + (size_t)(ch) * 64; \
        _Pragma("unroll") for (int i = 0; i < 4; ++i) { const size_t row_ = r0_ + 4 * tg + i; const bf16* p_ = PJ + row_ * WIN + 4 * c4; \
            pq[i] = *(const v2u*)p_; pk[i] = *(const v2u*)(p_ + 512); pv[i] = *(const v2u*)(p_ + 1024); pb[i] = *(const f32x4*)(BL + row_ * 512 + BLC); } \
        pbm = *(const f32x4*)(BL + (r0_ + 31) * 512 + BLC); } while (0)
#endif
#endif
    HG_LOAD(1);
    for (int ch = 1; ch < LT / 64; ++ch) {
#if HG_TWO_STAGE
        *(LAS v4u*)(lds + HG_QM + 16 * tid) = im[0]; *(LAS v4u*)(lds + HG_QM + 8192 + 16 * tid) = im[1];
        *(LAS v4u*)(lds + HG_KT + 16 * tid) = im[2]; *(LAS v4u*)(lds + HG_KT + 8192 + 16 * tid) = im[3];
        *(LAS v4u*)(lds + HG_V + 16 * tid) = im[4]; *(LAS v4u*)(lds + HG_V + 8192 + 16 * tid) = im[5];
        *(LAS v4u*)(lds + HG_XT + 16 * tid) = im[6];
        if (tid < 64) *(LAS v4u*)(lds + HG_VEC + 16 * tid) = imv;
#else
#if HG_EQ_CHAIN
#pragma unroll
        for (int i = 0; i < 4; ++i) {
            const int t = 4 * tg + i;
            const int rsw = (((c4 >> 1) ^ (t & 15)) * 16) + (c4 & 1) * 8;
            *(LAS v2u*)(lds + HG_QM + t * 256 + rsw) = pack4(bf_lo(pq[i].x) * bf_lo(pe[i].x), bf_hi(pq[i].x) * bf_hi(pe[i].x), bf_lo(pq[i].y) * bf_lo(pe[i].y), bf_hi(pq[i].y) * bf_hi(pe[i].y));
            *(LAS v2u*)(lds + HG_KR + t * 256 + rsw) = pk[i];
            const int tso = ((t >> 3) * 4 + (c4 >> 3)) * 512 + (t & 7) * 64 + (c4 & 7) * 8;
            *(LAS v2u*)(lds + HG_KT + tso) = pk[i];
            *(LAS v2u*)(lds + HG_V + tso) = pv[i];
        }
        if (tid < 64) *(LAS f32x4*)(vec + (tid >> 5) * 128 + 4 * (tid & 31)) = pvec;
#else
#pragma unroll
        for (int i = 0; i < 4; ++i) {
            const int t = 4 * tg + i;
            float qm[4], km[4];
            const float qv[4] = {bf_lo(pq[i].x), bf_hi(pq[i].x), bf_lo(pq[i].y), bf_hi(pq[i].y)};
            const float kv[4] = {bf_lo(pk[i].x), bf_hi(pk[i].x), bf_lo(pk[i].y), bf_hi(pk[i].y)};
#pragma unroll
            for (int j = 0; j < 4; ++j) { const float x = __builtin_amdgcn_fmed3f(pb[i][j] - pbm[j], -115.f, 115.f); qm[j] = qv[j] * __builtin_amdgcn_exp2f(x); km[j] = kv[j] * __builtin_amdgcn_exp2f(-x); }
            const int rsw = (((c4 >> 1) ^ (t & 15)) * 16) + (c4 & 1) * 8;
            *(LAS v2u*)(lds + HG_QM + t * 256 + rsw) = pack4(qm[0], qm[1], qm[2], qm[3]);
            const v2u kmw = pack4(km[0], km[1], km[2], km[3]);
            *(LAS v2u*)(lds + HG_KR + t * 256 + rsw) = kmw;
            const int tso = ((t >> 3) * 4 + (c4 >> 3)) * 512 + (t & 7) * 64 + (c4 & 7) * 8;
            *(LAS v2u*)(lds + HG_KT + tso) = kmw;
            *(LAS v2u*)(lds + HG_V + tso) = pv[i];
            if (t == 31) *(LAS f32x4*)(vec + 4 * c4) = (f32x4){__builtin_amdgcn_exp2f(pb[i][0]), __builtin_amdgcn_exp2f(pb[i][1]), __builtin_amdgcn_exp2f(pb[i][2]), __builtin_amdgcn_exp2f(pb[i][3])};
            if (t == 63) *(LAS f32x4*)(vec + 128 + 4 * c4) = (f32x4){__builtin_amdgcn_exp2f(pb[i][0] - pbm[0]), __builtin_amdgcn_exp2f(pb[i][1] - pbm[1]), __builtin_amdgcn_exp2f(pb[i][2] - pbm[2]), __builtin_amdgcn_exp2f(pb[i][3] - pbm[3])};
        }
#endif
#endif
        __syncthreads();
        if (ch + 1 < LT / 64) HG_LOAD(ch + 1);
#if HG_DSHAPE
        const v4u g0 = *(const v4u*)(PJ + (rowbase + (size_t)ch * 64 + (tid >> 3)) * WIN + 1536 + 8 * (tid & 7)), g1 = *(const v4u*)(PJ + (rowbase + (size_t)ch * 64 + (tid >> 3)) * WIN + 1536 + 64 + 8 * (tid & 7));
#else
        const v4u g0 = *(const v4u*)(PJ + (rowbase + (size_t)ch * 64 + (tid >> 3)) * WIN + 1536 + 16 * (tid & 7)), g1 = *(const v4u*)(PJ + (rowbase + (size_t)ch * 64 + (tid >> 3)) * WIN + 1536 + 16 * (tid & 7) + 8);
#endif
#pragma unroll
        for (int g = 0; g < 4; ++g) {
            const f32x4 bm = *(const LAS f32x4*)(vec + 32 * dkb + 8 * g + 4 * hi);
            const float e0 = bm[0], e1 = bm[1], e2 = bm[2], e3 = bm[3];
#pragma unroll
            for (int j = 0; j < 2; ++j) {
                st[j][4 * g + 0] *= e0; st[j][4 * g + 1] *= e1; st[j][4 * g + 2] *= e2; st[j][4 * g + 3] *= e3;
                const int dv = 32 * (dvb0 + j) + r32;
                *(LAS v2u*)(lds + HG_ST + dv * 256 + (((4 * dkb + g) ^ (dv & 15)) * 16) + hi * 8) = pack4(st[j][4 * g + 0], st[j][4 * g + 1], st[j][4 * g + 2], st[j][4 * g + 3]);
            }
        }
#if !HG_TWO_STAGE
#pragma unroll
        for (int rep2 = 0; rep2 < 2; ++rep2) {
            const int ti = wave + 8 * rep2;
            if (ti == 10 || ti == 11) {
                const int sb = (ti == 10) ? 1 : 3, tb = sb - 1, fr = lane & 15, fq = lane >> 4, tt = 16 * tb + fr;
                unsigned z_; asm volatile("v_mov_b32 %0, 0" : "=v"(z_));
                *(LAS v2u*)(lds + HG_XT + tt * 128 + (((2 * sb + (fq >> 1)) ^ ((tt >> 1) & 7)) * 16) + (fq & 1) * 8) = (v2u){z_, z_};
            }
            if (ti < 10) {
                const int sb = (ti < 4) ? 0 : (ti < 7) ? 1 : (ti < 9) ? 2 : 3, tb = (ti < 4) ? ti : (ti < 7) ? ti - 3 : (ti < 9) ? ti - 5 : 3;
                const int fr = lane & 15, fq = lane >> 4, s = 16 * sb + fr, tt = 16 * tb + fr;
                f32x4 x = (f32x4){0.f, 0.f, 0.f, 0.f};
#pragma unroll
                for (int ks = 0; ks < 4; ++ks) {
                    const bf16x8 a = *(const LAS bf16x8*)(lds + HG_KR + s * 256 + (((4 * ks + fq) ^ (s & 15)) * 16));
                    const bf16x8 bq = *(const LAS bf16x8*)(lds + HG_QM + tt * 256 + (((4 * ks + fq) ^ (tt & 15)) * 16));
                    x = __builtin_amdgcn_mfma_f32_16x16x32_bf16(a, bq, x, 0, 0, 0);
                }
                if (sb == tb) {
#pragma unroll
                    for (int r = 0; r < 4; ++r) x[r] = (4 * fq + r > fr) ? 0.f : x[r];
                }
                *(LAS v2u*)(lds + HG_XT + tt * 128 + (((2 * sb + (fq >> 1)) ^ ((tt >> 1) & 7)) * 16) + (fq & 1) * 8) = pack4(x[0], x[1], x[2], x[3]);
            }
        }
#endif
#pragma unroll
        for (int ks = 0; ks < 4; ++ks) {
            const bf16x8 a = tr_frag(lds + HG_KT + ((2 * ks + hi) * 4 + dkb) * 512 + vbq);
#pragma unroll
            for (int j = 0; j < 2; ++j) {
                const bf16x8 bv = tr_frag(lds + HG_V + ((2 * ks + hi) * 4 + dvb0 + j) * 512 + vbq);
                st[j] = __builtin_amdgcn_mfma_f32_32x32x16_bf16(a, bv, st[j], 0, 0, 0);
            }
        }
#pragma unroll
        for (int g = 0; g < 4; ++g) {
            const f32x4 be = *(const LAS f32x4*)(vec + 128 + 32 * dkb + 8 * g + 4 * hi);
            const float e0 = be[0], e1 = be[1], e2 = be[2], e3 = be[3];
#pragma unroll
            for (int j = 0; j < 2; ++j) { st[j][4 * g + 0] *= e0; st[j][4 * g + 1] *= e1; st[j][4 * g + 2] *= e2; st[j][4 * g + 3] *= e3; }
        }
        __syncthreads();
        {
            const int dv = 32 * dvb + r32, t = 32 * th + r32;
            f32x16 o;
#pragma unroll
            for (int r = 0; r < 16; ++r) o[r] = 0.f;
#pragma unroll
            for (int ks = 0; ks < 8; ++ks) {
                const bf16x8 a = *(const LAS bf16x8*)(lds + HG_ST + dv * 256 + (((2 * ks + hi) ^ (dv & 15)) * 16));
                const bf16x8 bq = *(const LAS bf16x8*)(lds + HG_QM + t * 256 + (((2 * ks + hi) ^ (t & 15)) * 16));
                o = __builtin_amdgcn_mfma_f32_32x32x16_bf16(a, bq, o, 0, 0, 0);
            }
#pragma unroll
            for (int sb = 0; sb < 2; ++sb) {
                if (sb <= th) {
#pragma unroll
                    for (int k2 = 0; k2 < 2; ++k2) {
                        const int kg = 4 * sb + 2 * k2 + hi;
                        const bf16x8 a = tr_frag(lds + HG_V + (kg * 4 + dvb) * 512 + vbq);
                        const bf16x8 bx = *(const LAS bf16x8*)(lds + HG_XT + t * 128 + ((kg ^ ((t >> 1) & 7)) * 16));
                        o = __builtin_amdgcn_mfma_f32_32x32x16_bf16(a, bx, o, 0, 0, 0);
                    }
                }
            }
            float s2 = 0.f;
#pragma unroll
            for (int r = 0; r < 16; ++r) s2 += o[r] * o[r];
            s2 = xor32_sum(s2);
            if (hi == 0) sq[t * 4 + dvb] = s2;
#pragma unroll
            for (int g = 0; g < 4; ++g)
                *(LAS v2u*)(lds + HG_OS + t * 256 + (((4 * dvb + g) ^ (t & 15)) * 16) + hi * 8) = pack4(o[4 * g + 0], o[4 * g + 1], o[4 * g + 2], o[4 * g + 3]);
        }
        __syncthreads();
        {
            const int t = tid >> 3, seg = tid & 7;
            const size_t row = rowbase + (size_t)ch * 64 + t;
            const f32x4 sv = *(const LAS f32x4*)(sq + t * 4);
            const float rs = rsqrtf(((sv[0] + sv[1]) + (sv[2] + sv[3])) * (1.0f / 128.0f) + EPS);
#if HG_DSHAPE
            const v4u o0 = *(const LAS v4u*)(lds + HG_OS + t * 256 + ((seg ^ (t & 15)) * 16)), o1 = *(const LAS v4u*)(lds + HG_OS + t * 256 + (((seg + 8) ^ (t & 15)) * 16));
#else
            const v4u o0 = *(const LAS v4u*)(lds + HG_OS + t * 256 + (((2 * seg) ^ (t & 15)) * 16)), o1 = *(const LAS v4u*)(lds + HG_OS + t * 256 + (((2 * seg + 1) ^ (t & 15)) * 16));
#endif
            v4u r0, r1;
            r0.x = pk2(bf_lo(o0.x) * rs * bf_lo(g0.x), bf_hi(o0.x) * rs * bf_hi(g0.x)); r0.y = pk2(bf_lo(o0.y) * rs * bf_lo(g0.y), bf_hi(o0.y) * rs * bf_hi(g0.y));
            r0.z = pk2(bf_lo(o0.z) * rs * bf_lo(g0.z), bf_hi(o0.z) * rs * bf_hi(g0.z)); r0.w = pk2(bf_lo(o0.w) * rs * bf_lo(g0.w), bf_hi(o0.w) * rs * bf_hi(g0.w));
            r1.x = pk2(bf_lo(o1.x) * rs * bf_lo(g1.x), bf_hi(o1.x) * rs * bf_hi(g1.x)); r1.y = pk2(bf_lo(o1.y) * rs * bf_lo(g1.y), bf_hi(o1.y) * rs * bf_hi(g1.y));
            r1.z = pk2(bf_lo(o1.z) * rs * bf_lo(g1.z), bf_hi(o1.z) * rs * bf_hi(g1.z)); r1.w = pk2(bf_lo(o1.w) * rs * bf_lo(g1.w), bf_hi(o1.w) * rs * bf_hi(g1.w));
#if HG_DSHAPE
            bf16* op = C.MIX() + row * D + h * 128 + 8 * seg;
            *(v4u*)op = r0; *(v4u*)(op + 64) = r1;
#else
            bf16* op = C.MIX() + row * D + h * 128 + 16 * seg;
            *(v4u*)op = r0; *(v4u*)(op + 8) = r1;
#endif
        }
    }
#undef HG_LOAD
    __syncthreads();
}
__device__ __forceinline__ void mixer_phase(Ctx& C, int l) {
    const int NA = C.G - 32;
    if (C.bid < NA) {
        const bool part = (NA == 224);
        const int g = C.bid >> 5, nu = part ? ((g < 6) ? 2 : 5) : (17 * 32 + NA - 1) / NA;
        for (int rep = 0; rep < REP_ATT; ++rep)
        for (int k = 0; k < nu; ++k) {
            int qi, bh;
            if (part) { bh = C.bid & 31; qi = (g < 6) ? (k == 0 ? 16 - g : 4 + g) : (k == 0 ? 10 : 4 - k); }
            else { const int u = k * NA + ((k & 1) ? (NA - 1 - C.bid) : C.bid); if (u >= 17 * 32) continue; qi = 16 - u / 32; bh = u % 32; }
            attn_unit(C, l, bh >> 2, bh & 3, qi, ATT_DRY2 && rep > 0);
        }
    } else {
        { const int u = C.bid - NA; _Pragma("nounroll") for (int rep = 0; rep < REP_HG; ++rep) { int uu = u; asm volatile("" : "+s"(uu) :: "memory"); hgrn_unit(C, l, uu >> 2, uu & 3); } }
    }
}


template <bool FP8, class F, bool ATILE = false> __device__ __forceinline__ void mini_tile(LAS unsigned char* lds, const bf16* A, const bf16* Bt, int K, int r0, int c0, int lane, int wave, const F& epi) {
    const int fr = lane & 15, fq = lane >> 4;
    const int srow = 8 * wave + (lane >> 3), lch = (lane & 7) ^ ((srow >> 1) & 7);
    const unsigned char* asrc; size_t astep;
    if (ATILE) { const int rr = r0 + srow; asrc = (const unsigned char*)A + (size_t)(rr >> 8) * (size_t)(K >> 4) * 8192 + (size_t)(rr & 255) * 32 + (lch >> 1) * 8192 + (lch & 1) * 16; astep = 32768; }
    else { asrc = (const unsigned char*)(A + (size_t)(r0 + srow) * K + 8 * lch); astep = 128; }
    const bf16* bsrc = Bt + (size_t)(c0 + srow) * K + 8 * lch;
    const int nk = K / 64;
    LAS unsigned char* wbase = lds + wave * 1024;
#define RT_ISSUE(s) do { const int sl_ = ((s) & 7) * 16384; __builtin_amdgcn_global_load_lds((const unsigned*)(asrc + (size_t)(s) * astep), (LAS unsigned*)(wbase + sl_), 16, 0, 0); \
        __builtin_amdgcn_global_load_lds((const unsigned*)(bsrc + (size_t)(s) * 64), (LAS unsigned*)(wbase + sl_ + 8192), 16, 0, 0); } while (0)
#pragma unroll
    for (int s = 0; s < 7; ++s) RT_ISSUE(s);
    f32x4 acc0 = (f32x4){0.f, 0.f, 0.f, 0.f}, acc1 = acc0;
    const int arow = 32 * (wave >> 2) + fr, brow = 16 * (wave & 3) + fr;
    const int asw = (arow >> 1) & 7, bsw = (brow >> 1) & 7;
    for (int s = 0; s < nk; ++s) {
        if (s + 6 < nk) asm volatile("s_waitcnt vmcnt(12)" ::: "memory"); else asm volatile("s_waitcnt vmcnt(0)" ::: "memory");
        __builtin_amdgcn_s_barrier(); asm volatile("" ::: "memory");
        if (s + 7 < nk) RT_ISSUE(s + 7);
        const LAS unsigned char* sa = lds + (s & 7) * 16384; const LAS unsigned char* sb = sa + 8192;
        bf16x8 a0[2], a1[2], b[2];
#pragma unroll
        for (int j = 0; j < 2; ++j) {
            a0[j] = *(const LAS bf16x8*)(sa + arow * 128 + (((4 * j + fq) ^ asw) * 16)); a1[j] = *(const LAS bf16x8*)(sa + (arow + 16) * 128 + (((4 * j + fq) ^ asw) * 16));
            b[j] = *(const LAS bf16x8*)(sb + brow * 128 + (((4 * j + fq) ^ bsw) * 16));
        }
        if constexpr (FP8) { acc0 = pg8::mma8(b[0], b[1], a0[0], a0[1], acc0); acc1 = pg8::mma8(b[0], b[1], a1[0], a1[1], acc1); }
        else {
#pragma unroll
            for (int j = 0; j < 2; ++j) { acc0 = __builtin_amdgcn_mfma_f32_16x16x32_bf16(b[j], a0[j], acc0, 0, 0, 0); acc1 = __builtin_amdgcn_mfma_f32_16x16x32_bf16(b[j], a1[j], acc1, 0, 0, 0); }
        }
    }
#undef RT_ISSUE
    const int row = r0 + 32 * (wave >> 2) + fr, col = c0 + 16 * (wave & 3) + 4 * fq;
    epi(acc0, acc1, row, col);
    asm volatile("s_waitcnt lgkmcnt(0)" ::: "memory"); __builtin_amdgcn_s_barrier(); asm volatile("" ::: "memory");
}
__device__ __forceinline__ void mini_resid_phase(Ctx& C, const bf16* A, const bf16* Bt, int K, int row_lo) {
    LAS float* red = (LAS float*)(C.lds + RING_BYTES + 2048);
    const int nrb = (NTOK - row_lo) / 64, ntile = nrb * 16;
    bf16* HB = C.HB(); float* SSQ = C.SSQ();
    for (int mt = C.bid; mt < ntile; mt += C.G) {
        const int rb = mt >> 4, cb = mt & 15, r0 = row_lo + 64 * rb, c0 = 64 * cb;
        const int lane = C.lane, wave = C.wave;
        mini_tile<false>(C.lds, A, Bt, K, r0, c0, lane, wave, [&](const f32x4& x0, const f32x4& x1, int row, int col) {
            bf16* hp = HB + (size_t)row * D + col;
            const f32x4 h0 = bf4(*(const v2u*)hp) + x0, h1 = bf4(*(const v2u*)(hp + (size_t)16 * D)) + x1;
            *(v2u*)hp = pack4(h0[0], h0[1], h0[2], h0[3]); *(v2u*)(hp + (size_t)16 * D) = pack4(h1[0], h1[1], h1[2], h1[3]);
            float s0 = (h0[0] * h0[0] + h0[1] * h0[1]) + (h0[2] * h0[2] + h0[3] * h0[3]), s1 = (h1[0] * h1[0] + h1[1] * h1[1]) + (h1[2] * h1[2] + h1[3] * h1[3]);
            s0 += __shfl_xor(s0, 16); s0 += __shfl_xor(s0, 32); s1 += __shfl_xor(s1, 16); s1 += __shfl_xor(s1, 32);
            if ((lane >> 4) == 0) { red[(row - r0) * 4 + (wave & 3)] = s0; red[(row - r0 + 16) * 4 + (wave & 3)] = s1; }
        });
        __syncthreads();
        if (C.tid < 64) { const f32x4 p = *(const LAS f32x4*)(red + C.tid * 4); SSQ[(size_t)(r0 + C.tid) * 16 + cb] = (p[0] + p[1]) + (p[2] + p[3]); }
        __syncthreads();
    }
}
template <bool FP8> __device__ __forceinline__ void mini_y_phase(Ctx& C, const bf16* A, const bf16* Bt, size_t bstride_el, int K, float sc, int plim, int pend, int p1, int p2, int p3, int p4, int p5, int p6, int p7) {
    const int ntile = (pend - plim) * 4 * 16;
    bf16* Y = C.Y();
    for (int mt = C.bid; mt < ntile; mt += C.G) {
        const int rb = mt >> 4, cb = mt & 15, pm = plim + (rb >> 2), r0 = plim * 256 + 64 * rb, c0 = 64 * cb;
        const int e = (pm >= p1) + (pm >= p2) + (pm >= p3) + (pm >= p4) + (pm >= p5) + (pm >= p6) + (pm >= p7);
        auto epi_ = [&](const f32x4& x0, const f32x4& x1, int row, int col) {
            *(v2u*)(Y + (size_t)row * D + col) = pack4(x0[0] * sc, x0[1] * sc, x0[2] * sc, x0[3] * sc); *(v2u*)(Y + (size_t)(row + 16) * D + col) = pack4(x1[0] * sc, x1[1] * sc, x1[2] * sc, x1[3] * sc);
        };
        mini_tile<FP8, decltype(epi_), (FP8 && T8_TILED != 0)>(C.lds, A, Bt + (size_t)e * bstride_el, K, r0, c0, C.lane, C.wave, epi_);
    }
}

constexpr int RMAX = 128;
__device__ __forceinline__ void route_phase(Ctx& C, int li) {
    LAS float* rf = (LAS float*)C.lds;
    LAS int* lcnt = (LAS int*)(C.lds + 32768);
    LAS int* lbase = lcnt + 8;
    LAS int* ti = lbase + 8;
    LAS float* tf = (LAS float*)(ti + RMAX * 4);
    const int tid = C.tid, lane = C.lane;
    for (int i = tid; i < 8192; i += 512) rf[i] = C.RF()[li * 8192 + i];
    if (tid < 8) lcnt[tid] = 0;
    __syncthreads();
    const int nrows = (NTOK - C.bid + C.G - 1) / C.G;
    v2u nx[4];
#define RT_ROWLOAD(kk) do { const size_t r_ = (size_t)C.bid + (size_t)(kk) * C.G; _Pragma("unroll") for (int j = 0; j < 4; ++j) nx[j] = *(const v2u*)(C.HB() + r_ * D + 4 * lane + 256 * j); } while (0)
    if (C.wave < nrows) RT_ROWLOAD(C.wave);
    for (int k = C.wave; k < nrows; k += 8) {
        const size_t row = (size_t)C.bid + (size_t)k * C.G;
        v2u cur[4];
#pragma unroll
        for (int j = 0; j < 4; ++j) cur[j] = nx[j];
        if (k + 8 < nrows) RT_ROWLOAD(k + 8);
        if ((int)(row % LT) < FIRSTV) { if (lane == 0) ti[k * 4] = -1; continue; }
        f32x4 v[4]; float ss = 0.f;
#pragma unroll
        for (int j = 0; j < 4; ++j) { v[j] = bf4(cur[j]); ss += (v[j][0] * v[j][0] + v[j][1] * v[j][1]) + (v[j][2] * v[j][2] + v[j][3] * v[j][3]); }
        ss = wave_sum(ss);
        const float rstd = rsqrtf(ss * (1.0f / 1024.0f) + EPS);
        float lg[8];
#pragma unroll
        for (int e = 0; e < 8; ++e) {
            float p = 0.f;
#pragma unroll
            for (int j = 0; j < 4; ++j) { const f32x4 w = *(const LAS f32x4*)(rf + e * 1024 + 4 * lane + 256 * j); p += (v[j][0] * w[0] + v[j][1] * w[1]) + (v[j][2] * w[2] + v[j][3] * w[3]); }
            lg[e] = wave_sum(p) * rstd;
        }
        int e1 = 0; float l1 = lg[0];
#pragma unroll
        for (int e = 1; e < 8; ++e) if (lg[e] > l1) { l1 = lg[e]; e1 = e; }
        int e2 = -1; float l2 = -3.0e38f;
#pragma unroll
        for (int e = 0; e < 8; ++e) if (e != e1 && lg[e] > l2) { l2 = lg[e]; e2 = e; }
        const float g1 = 1.f / (1.f + expf(l2 - l1)), g2 = 1.f - g1;
        if (lane == 0) {
            const int lr1 = __hip_atomic_fetch_add(&lcnt[e1], 1, __ATOMIC_RELAXED, __HIP_MEMORY_SCOPE_WORKGROUP), lr2 = __hip_atomic_fetch_add(&lcnt[e2], 1, __ATOMIC_RELAXED, __HIP_MEMORY_SCOPE_WORKGROUP);
            ti[k * 4 + 0] = e1; ti[k * 4 + 1] = e2; ti[k * 4 + 2] = lr1; ti[k * 4 + 3] = lr2;
            tf[k * 4 + 0] = g1; tf[k * 4 + 1] = g2; tf[k * 4 + 2] = rstd;
        }
    }
#undef RT_ROWLOAD
    __syncthreads();
#if PUSH_GATHER
    if (tid < 8) ((int*)(C.ws + WS_ROUTE + ROUTE_LIST))[((size_t)li * C.G + C.bid) * 8 + tid] = lcnt[tid];
#else
    if (tid < 8) lbase[tid] = (int)__hip_atomic_fetch_add(C.ctl() + CW_CNT + (li * 8 + tid) * 64, (unsigned)lcnt[tid], RLX_AGENT);
    __syncthreads();
    for (int k = tid; k < nrows; k += 512) {
        const int row = C.bid + k * C.G;
        if (ti[k * 4] < 0) continue;
        const int e1 = ti[k * 4], e2 = ti[k * 4 + 1], r1 = lbase[e1] + ti[k * 4 + 2], r2 = lbase[e2] + ti[k * 4 + 3];
        C.LIST()[(size_t)e1 * NTOK + r1] = row; C.LIST()[(size_t)e2 * NTOK + r2] = row;
        unsigned* inf = C.TINFO() + (size_t)row * 8;
        inf[0] = (unsigned)e1; inf[1] = (unsigned)e2; inf[2] = (unsigned)r1; inf[3] = (unsigned)r2; inf[4] = __builtin_bit_cast(unsigned, tf[k * 4]); inf[5] = __builtin_bit_cast(unsigned, tf[k * 4 + 1]);
        C.RSTD()[row] = tf[k * 4 + 2];
    }
    __syncthreads();
#endif
}
__device__ __forceinline__ void load_panels(Ctx& C, int li, LAS int* pst) {
    __syncthreads();
    if (C.tid == 0) { int acc = 0;
        for (int e = 0; e < 8; ++e) { const int c = (int)__hip_atomic_load(C.ctl() + CW_CNT + (li * 8 + e) * 64, RLX_AGENT); pst[e] = acc; pst[16 + e] = c; acc += (c + 255) >> 8; }
        pst[8] = acc; }
    __syncthreads();
}
#if PUSH_GATHER
__device__ __forceinline__ void push_phase(Ctx& C, int li) {
    LAS int* lcnt = (LAS int*)(C.lds + 32768);
    LAS int* lbase = lcnt + 8;
    LAS int* ti = lbase + 8;
    LAS float* tf = (LAS float*)(ti + RMAX * 4);
    LAS int* pst = (LAS int*)C.lds;
    const int tid = C.tid, lane = C.lane;
    const int* cntb = (const int*)(C.ws + WS_ROUTE + ROUTE_LIST) + (size_t)li * C.G * 8;
    LAS int* cb = (LAS int*)(C.lds + 4096);
    for (int i = tid; i < C.G * 8; i += 512) cb[i] = cntb[i];
    __syncthreads();
    if (tid < 16) {
        const int e = tid & 7, nb = (tid < 8) ? C.G : C.bid;
        int s = 0;
        for (int b = 0; b < nb; ++b) s += cb[b * 8 + e];
        if (tid < 8) { pst[16 + e] = s; if (C.bid == 0) __hip_atomic_store(C.ctl() + CW_CNT + (li * 8 + e) * 64, (unsigned)s, RLX_AGENT); }
        else lbase[e] = s;
    }
    __syncthreads();
    if (tid == 0) { int acc = 0; for (int e = 0; e < 8; ++e) { pst[e] = acc; acc += (pst[16 + e] + 255) >> 8; } pst[8] = acc; }
    __syncthreads();
    const int nrows = (NTOK - C.bid + C.G - 1) / C.G;
    for (int k = C.wave; k < nrows; k += 8) {
        if (ti[k * 4] < 0) continue;
        const size_t row = (size_t)C.bid + (size_t)k * C.G;
        const int e1 = ti[k * 4], e2 = ti[k * 4 + 1], r1 = lbase[e1] + ti[k * 4 + 2], r2 = lbase[e2] + ti[k * 4 + 3];
        const size_t s1 = (size_t)pst[e1] * 256 + r1, s2 = (size_t)pst[e2] * 256 + r2;
        const float r = tf[k * 4 + 2];
        if (lane == 0) { unsigned* inf = C.TINFO() + row * 8; *(v4u*)inf = (v4u){(unsigned)e1, (unsigned)e2, (unsigned)r1, (unsigned)r2}; *(v2u*)(inf + 4) = (v2u){__builtin_bit_cast(unsigned, tf[k * 4]), __builtin_bit_cast(unsigned, tf[k * 4 + 1])}; }
        if ((FP8_MOE_MASK >> li) & 1) {
            unsigned* x1 = (unsigned*)(C.ws + WS_XG + s1 * D); unsigned* x2 = (unsigned*)(C.ws + WS_XG + s2 * D);
#pragma unroll
            for (int j = 0; j < 4; ++j) { const f32x4 v = bf4(*(const v2u*)(C.HB() + row * D + 4 * lane + 256 * j)); const unsigned w = pk_fp8x4(v[0] * r, v[1] * r, v[2] * r, v[3] * r); x1[lane + 64 * j] = w; x2[lane + 64 * j] = w; }
        } else {
            bf16* x1 = C.XG() + s1 * D; bf16* x2 = C.XG() + s2 * D;
#pragma unroll
            for (int j = 0; j < 4; ++j) { const f32x4 v = bf4(*(const v2u*)(C.HB() + row * D + 4 * lane + 256 * j)); v2u w; w.x = pk2(v[0] * r, v[1] * r); w.y = pk2(v[2] * r, v[3] * r); *(v2u*)(x1 + 4 * lane + 256 * j) = w; *(v2u*)(x2 + 4 * lane + 256 * j) = w; }
        }
    }
    __syncthreads();
}
#endif
__device__ __forceinline__ void gather_phase(Ctx& C, int li) {
    LAS int* pst = (LAS int*)C.lds;
    load_panels(C, li, pst);
    const int gw = C.bid * 8 + C.wave, NGW = C.G * 8, lane = C.lane;
    const int nslot = pst[8] * 256;
    for (int s = gw; s < nslot; s += NGW) {
        const int panel = s >> 8; int e = 0;
#pragma unroll
        for (int j = 1; j < 8; ++j) if (panel >= pst[j]) e = j;
        const int rank = s - pst[e] * 256;
        if ((FP8_MOE_MASK >> li) & 1) {
            unsigned* xp8 = (unsigned*)(C.ws + WS_XG + (size_t)s * D);
            if (rank < pst[16 + e]) {
                const int tok = C.LIST()[(size_t)e * NTOK + rank]; const float r = C.RSTD()[tok];
#pragma unroll
                for (int j = 0; j < 4; ++j) { const f32x4 v = bf4(*(const v2u*)(C.HB() + (size_t)tok * D + 4 * lane + 256 * j)); xp8[lane + 64 * j] = pk_fp8x4(v[0] * r, v[1] * r, v[2] * r, v[3] * r); }
            } else {
#pragma unroll
                for (int j = 0; j < 4; ++j) xp8[lane + 64 * j] = 0u;
            }
            continue;
        }
        bf16* xp = C.XG() + (size_t)s * D;
        if (rank < pst[16 + e]) {
            const int tok = C.LIST()[(size_t)e * NTOK + rank]; const float r = C.RSTD()[tok];
#pragma unroll
            for (int j = 0; j < 4; ++j) { const f32x4 v = bf4(*(const v2u*)(C.HB() + (size_t)tok * D + 4 * lane + 256 * j)); v2u w; w.x = pk2(v[0] * r, v[1] * r); w.y = pk2(v[2] * r, v[3] * r); *(v2u*)(xp + 4 * lane + 256 * j) = w; }
        } else {
#pragma unroll
            for (int j = 0; j < 4; ++j) *(v2u*)(xp + 4 * lane + 256 * j) = (v2u){0u, 0u};
        }
    }
}
__device__ __forceinline__ void combine_phase(Ctx& C, int li, bool last, bool dry = false) {
    LAS int* pst = (LAS int*)C.lds;
    load_panels(C, li, pst);
    const int gw = C.bid * 8 + C.wave, NGW = C.G * 8, lane = C.lane;
#if COMB_PIPE
    v4u ia = (v4u){0u, 0u, 0u, 0u}, ib = ia, ja = ia, jb = ia;
    v2u hd[4], ya[4], yb[4];
    v2u hn[4], na[4], nb[4];
#pragma unroll
    for (int j = 0; j < 4; ++j) { hn[j] = (v2u){0u, 0u}; na[j] = hn[j]; nb[j] = hn[j]; }
#define CB_LIVE(r) ((r) < NTOK && ((r) % LT) >= FIRSTV)
#define CB_INFO(r, A_, B_) do { if (CB_LIVE(r)) { const v4u* p_ = (const v4u*)(C.TINFO() + (size_t)(r) * 8); A_ = p_[0]; B_ = p_[1]; } } while (0)
#define CB_DATA(r, A_, H_, Y1_, Y2_) do { if (CB_LIVE(r)) { const size_t s1_ = (size_t)pst[(int)A_.x] * 256 + A_.z, s2_ = (size_t)pst[(int)A_.y] * 256 + A_.w; \
        _Pragma("unroll") for (int j = 0; j < 4; ++j) { const int col_ = 4 * lane + 256 * j; H_[j] = *(const v2u*)(C.HB() + (size_t)(r) * D + col_); Y1_[j] = *(const v2u*)(C.Y() + s1_ * D + col_); Y2_[j] = *(const v2u*)(C.Y() + s2_ * D + col_); } } } while (0)
    CB_INFO(gw, ia, ib);
    CB_INFO(gw + NGW, ja, jb);
    CB_DATA(gw, ia, hn, na, nb);
    for (int row = gw; row < NTOK; row += NGW) {
        const v4u ca = ia, cb = ib;
#pragma unroll
        for (int j = 0; j < 4; ++j) { hd[j] = hn[j]; ya[j] = na[j]; yb[j] = nb[j]; }
        ia = ja; ib = jb;
        CB_DATA(row + NGW, ia, hn, na, nb);
        CB_INFO(row + 2 * NGW, ja, jb);
        if ((row % LT) < FIRSTV) continue;
        const float g1 = __builtin_bit_cast(float, cb.x), g2 = __builtin_bit_cast(float, cb.y);
        f32x4 v[4]; float ss = 0.f;
#pragma unroll
        for (int j = 0; j < 4; ++j) {
            v[j] = bf4(hd[j]);
            const v2u a = ya[j], b = yb[j];
            v[j][0] += g1 * bf_lo(a.x) + g2 * bf_lo(b.x); v[j][1] += g1 * bf_hi(a.x) + g2 * bf_hi(b.x);
            v[j][2] += g1 * bf_lo(a.y) + g2 * bf_lo(b.y); v[j][3] += g1 * bf_hi(a.y) + g2 * bf_hi(b.y);
            ss += (v[j][0] * v[j][0] + v[j][1] * v[j][1]) + (v[j][2] * v[j][2] + v[j][3] * v[j][3]);
        }
#else
    for (int row = gw; row < NTOK; row += NGW) {
        if ((row % LT) < FIRSTV) continue;
        const unsigned* inf = C.TINFO() + (size_t)row * 8;
        const int e1 = (int)inf[0], e2 = (int)inf[1];
        const size_t s1 = (size_t)pst[e1] * 256 + inf[2], s2 = (size_t)pst[e2] * 256 + inf[3];
        const float g1 = __builtin_bit_cast(float, inf[4]), g2 = __builtin_bit_cast(float, inf[5]);
        f32x4 v[4]; float ss = 0.f;
#pragma unroll
        for (int j = 0; j < 4; ++j) {
            const int col = 4 * lane + 256 * j;
            v[j] = bf4(*(const v2u*)(C.HB() + (size_t)row * D + col));
            const v2u a = *(const v2u*)(C.Y() + s1 * D + col), b = *(const v2u*)(C.Y() + s2 * D + col);
            v[j][0] += g1 * bf_lo(a.x) + g2 * bf_lo(b.x); v[j][1] += g1 * bf_hi(a.x) + g2 * bf_hi(b.x);
            v[j][2] += g1 * bf_lo(a.y) + g2 * bf_lo(b.y); v[j][3] += g1 * bf_hi(a.y) + g2 * bf_hi(b.y);
            ss += (v[j][0] * v[j][0] + v[j][1] * v[j][1]) + (v[j][2] * v[j][2] + v[j][3] * v[j][3]);
        }
#endif
        ss = wave_sum(ss);
        if (!last) {
            bf16* hbo = dry ? (bf16*)(C.ws + WS_H) : C.HB(); float* sso = dry ? (float*)(C.ws + WS_H + 40 * MiB) : C.SSQ();
#pragma unroll
            for (int j = 0; j < 4; ++j) { const int col = 4 * lane + 256 * j; v2u w; w.x = pk2(v[j][0], v[j][1]); w.y = pk2(v[j][2], v[j][3]); *(v2u*)(hbo + (size_t)row * D + col) = w; }
            if (lane < 16) sso[(size_t)row * 16 + lane] = (lane == 0) ? ss : 0.f;
        } else {
            const int b = row / LT, t = row % LT;
            if (t >= LEAD) {
                const float rs = rsqrtf(ss * (1.0f / 1024.0f) + EPS);
#pragma unroll
                for (int j = 0; j < 4; ++j) { const int col = 4 * lane + 256 * j; const f32x4 fw = *(const f32x4*)(C.FNORM() + col);
                    *(f32x4*)((dry ? (float*)(C.ws + WS_H) : C.out) + ((size_t)b * SEQ + (t - LEAD)) * D + col) = (f32x4){v[j][0] * rs * fw[0], v[j][1] * rs * fw[1], v[j][2] * rs * fw[2], v[j][3] * rs * fw[3]}; }
            }
        }
    }
#if COMB_PIPE
#undef CB_LIVE
#undef CB_INFO
#undef CB_DATA
#endif
}

__global__ void __launch_bounds__(512, 2) mk_fwd(Args args) {
    extern __shared__ __attribute__((aligned(16))) unsigned char lds[];
    Ctx C;
    C.lds = (LAS unsigned char*)lds;
    C.tid = threadIdx.x; C.lane = C.tid & 63; C.wave = __builtin_amdgcn_readfirstlane(C.tid >> 6); C.G = gridDim.x; C.bid = blockIdx.x;
    unsigned char* ws = args.ws; C.ws = ws; C.out = args.out;
    volatile LAS unsigned* MISC = (volatile LAS unsigned*)(C.lds + MISC_OFF);
    for (int u = C.tid; u < (LDS_BYTES - RING_BYTES) / 4; u += 512) ((LAS unsigned*)(C.lds + RING_BYTES))[u] = 0u;
    __syncthreads();
    const int lo = args.ph_lo, hi = args.ph_hi;
    const bool multi = (hi - lo) > 1;
    XcdBarrier bar; bar.bar = (unsigned*)(C.ctl() + CW_BAR); bar.x = 0; bar.st = nullptr;
    if (multi) bar = xcd_barrier_post((unsigned*)(C.ctl() + CW_BAR), MISC + 8);
#define PHASE_CTX(P) Ctx P = C; { GAS unsigned char* w_ = (GAS unsigned char*)C.ws; asm volatile("" : "+s"(w_)); P.ws = (unsigned char*)w_;     int t_ = C.tid; asm volatile("" : "+v"(t_)); P.tid = t_; P.lane = t_ & 63; P.wave = __builtin_amdgcn_readfirstlane(t_ >> 6); int g_ = C.G, b_ = C.bid; asm volatile("" : "+s"(g_), "+s"(b_)); P.G = g_; P.bid = b_; }
#define IN(k) (lo_l <= (k) && (k) < hi_l)
#define SEAM(k) do { if ((k) + 1 < hi_l) { xcd_barrier(bar); if (PROBE_XBAR) xcd_barrier(bar); } } while (0)

    { int lo_l = lo, hi_l = hi; asm volatile("" : "+s"(lo_l), "+s"(hi_l));
      if (IN(0)) { for (int rep = 0; rep < REP_PRO; ++rep) { PHASE_CTX(P); prologue_phase(P, args, (rep + 1 < REP_PRO) ? PRO_MODE : 0); SEAM(0); } } }

    for (int l = 0; l < DEPTH; ++l) {
        int lo_l = lo, hi_l = hi; asm volatile("" : "+s"(lo_l), "+s"(hi_l));
        const int pb = 1 + 8 * l, li = l >> 1; const bool moe = (l & 1) != 0;
        if (PROBE_PROJ_NOEPI && IN(pb + 0)) {
            PHASE_CTX(P);
            pg8::Gemm g{P.HB(), (const bf16*)(P.ws + WS_WIN) + (size_t)l * WIN * D, NTOK, WIN, D, 0};
            pg8::StaticOrder S; S.init(NTOK, WIN, P.G, P.bid);
            EpiNone E{(unsigned*)(P.ws + WS_CTL) + 64};
            pg8::gemm_phase<EpiNone, pg8::StaticOrder, true, true>(P.lds, g, S, E);
            SEAM(pb + 0);
        }
        if (PROBE_WOUT_NOEPI && IN(pb + 2)) {
            PHASE_CTX(P);
            pg8::Gemm g{P.HB(), (const bf16*)(P.ws + WS_WOUT) + (size_t)l * D * D, NTOK, D, D, 0};
            pg8::StaticOrder S; S.init(NTOK, D, P.G, P.bid);
            EpiNone E{(unsigned*)(P.ws + WS_CTL) + 64};
            pg8::gemm_phase<EpiNone, pg8::StaticOrder, true, true>(P.lds, g, S, E);
            SEAM(pb + 0);
        }
        if (PROBE_FF2_NOEPI && IN(pb + 2)) {
            PHASE_CTX(P);
            pg8::Gemm g{(const bf16*)(P.ws + WS_WD13), (const bf16*)(P.ws + WS_WD2) + (size_t)li * D * FFD, NTOK, D, FFD, 0};
            pg8::StaticOrder S; S.init(NTOK, D, P.G, P.bid);
            EpiNone E{(unsigned*)(P.ws + WS_CTL) + 64};
            pg8::gemm_phase<EpiNone, pg8::StaticOrder, true, true>(P.lds, g, S, E);
            SEAM(pb + 0);
        }
        if (IN(pb + 0)) for (int rep = 0; rep < REP_PROJ; ++rep) {
            PHASE_CTX(P);
            pg8::Gemm g{P.HB(), (const bf16*)(P.ws + WS_WIN) + (size_t)l * WIN * D, NTOK, WIN, D, 0};
            EpiProj E{P.PROJ(), P.LOGF(), (const LAS float*)(P.lds + RS_OFF), P.LB() + l * 512, P.HGNW() + l * 128, P.ws + WS_H, (rep + 1 < REP_PROJ) ? PROJ_PROBE : 0};
            if (P.G == 256) {
                pg8::ProjOrder S{P.bid};
                rstd_table(P.lds, P.SSQ(), S, P.tid);
                pg8::gemm_phase<EpiProj, pg8::ProjOrder, true, true>(P.lds, g, S, E);
            } else {
                pg8::StaticOrder S; S.init(NTOK, WIN, P.G, P.bid);
                rstd_table(P.lds, P.SSQ(), S, P.tid);
                pg8::gemm_phase<EpiProj, pg8::StaticOrder, true, true>(P.lds, g, S, E);
            }
            SEAM(pb + 0);
        }
        if (IN(pb + 1)) _Pragma("nounroll") for (int rep = 0; rep < REP_MIX; ++rep) { PHASE_CTX(P);
#if HG_TWO_STAGE
            for (int rp = 0; rp < REP_HGPRE; ++rp) { hgrn_pre_phase(P, l); xcd_barrier(bar); }
#endif
            mixer_phase(P, l); SEAM(pb + 1); }
        if (IN(pb + 2)) {
            PHASE_CTX(P);
            pg8::Gemm g{P.MIX(), (const bf16*)(P.ws + WS_WOUT) + (size_t)l * D * D, NTOK, D, D, 0};
            pg8::StaticOrder S; S.init(MAINROWS, D, P.G, P.bid);
            EpiResid E{P.HB(), P.SSQ()};
            pg8::gemm_phase<EpiResid, pg8::StaticOrder, true, true>(P.lds, g, S, E);
            mini_resid_phase(P, g.A, g.Bt, D, MAINROWS);
            SEAM(pb + 2);
        }
        if (!moe) {
            if (IN(pb + 5)) for (int rep = 0; rep < REP_FF1; ++rep) {
                PHASE_CTX(P);
                pg8::Gemm g{P.HB(), (const bf16*)(P.ws + WS_WD13) + (size_t)li * 2 * FFD * D, NTOK, 2 * FFD, D, 0};
                pg8::StaticOrder S; S.init(NTOK, 2 * FFD, P.G, P.bid);
                rstd_table(P.lds, P.SSQ(), S, P.tid);
                if (STAG_FF1D) stagger_start(P.bid, STAG_FF1D);
                EpiGLU E{P.T(), FFD, (const LAS float*)(P.lds + RS_OFF), (rep + 1 < REP_FF1 && (FF1_PROBE & 3)) ? 1 : 0};
                pg8::gemm_phase<EpiGLU, pg8::StaticOrder, true, true>(P.lds, g, S, E);
                SEAM(pb + 5);
            }
            if (IN(pb + 6)) {
                PHASE_CTX(P);
                pg8::Gemm g{P.T(), (const bf16*)(P.ws + WS_WD2) + (size_t)li * D * FFD, NTOK, D, FFD, 0};
                pg8::StaticOrder S; S.init(MAINROWS, D, P.G, P.bid);
                EpiResid E{P.HB(), P.SSQ()};
                pg8::gemm_phase<EpiResid, pg8::StaticOrder, true, true>(P.lds, g, S, E);
                mini_resid_phase(P, g.A, g.Bt, FFD, MAINROWS);
                SEAM(pb + 6);
            }
        } else {
            if (IN(pb + 3)) for (int rep = 0; rep < REP_ROUTE; ++rep) { PHASE_CTX(P);
                if (rep > 0) { if (P.bid == 0 && P.tid < 8) __hip_atomic_store(P.ctl() + CW_CNT + (li * 8 + P.tid) * 64, 0u, RLX_AGENT); xcd_barrier(bar); }
                route_phase(P, li); SEAM(pb + 3); }
            if (IN(pb + 4)) for (int rep = 0; rep < REP_GATHER; ++rep) { PHASE_CTX(P);
#if PUSH_GATHER
                push_phase(P, li);
#else
                gather_phase(P, li);
#endif
                SEAM(pb + 4); }
            if (IN(pb + 5)) for (int rep = 0; rep < REP_FF1; ++rep) {
                PHASE_CTX(P);
                LAS int* pst = (LAS int*)(P.lds + RING_BYTES + 1024);
                load_panels(P, li, pst);
#define PS(i) __builtin_amdgcn_readfirstlane(pst[i])
                pg8::GroupedOrder S{PS(0), PS(1), PS(2), PS(3), PS(4), PS(5), PS(6), PS(7), PS(8), 2 * FFE / 256, P.G, P.bid};
                if (FP8_MOE_MASK != 0 && ((FP8_MOE_MASK >> li) & 1)) {
                    pg8::Gemm g{(const bf16*)(P.ws + WS_XG), (const bf16*)(P.ws + WS_WM13 + (size_t)li * 8 * 2 * FFE * D * 2), 0, 2 * FFE, D / 2, (size_t)2 * FFE * D};
                    EpiGLU8 E{P.ws + WS_ACT, FFE, 1.0f / 32.0f, (rep + 1 < REP_FF1 && (FF1_PROBE & 5)) ? 1 : 0};
                    pg8::gemm_phase<EpiGLU8, pg8::GroupedOrder, true, true, true>(P.lds, g, S, E);
                } else if (FP8_MOE_MASK != 3) {
                    pg8::Gemm g{P.XG(), (const bf16*)(P.ws + WS_WM13) + (size_t)li * 8 * 2 * FFE * D, 0, 2 * FFE, D, (size_t)2 * FFE * D * 2};
                    if (STAG_FF1M) stagger_start(P.bid, STAG_FF1M);
                    EpiGLU E{P.T(), FFE, nullptr, 0};
                    pg8::gemm_phase<EpiGLU, pg8::GroupedOrder, true, true>(P.lds, g, S, E);
                }
                SEAM(pb + 5);
            }
            if (IN(pb + 6)) {
                PHASE_CTX(P);
                LAS int* pst = (LAS int*)(P.lds + RING_BYTES + 1024);
                load_panels(P, li, pst);
                const int ptot = PS(8), pfull = (ptot / 64) * 64, plim = (ptot - pfull <= 32) ? pfull : ptot;
                pg8::GroupedPanelOrder S{PS(1), PS(2), PS(3), PS(4), PS(5), PS(6), PS(7), plim, D / 256, P.G, P.bid};
                if (FP8_MOE_MASK != 0 && ((FP8_MOE_MASK >> li) & 1)) {
                    pg8::Gemm g{(const bf16*)(P.ws + WS_ACT), (const bf16*)(P.ws + WS_WM2 + (size_t)li * 8 * D * FFE * 2), 0, D, FFE / 2, (size_t)D * FFE};
                    EpiY E{P.Y(), 1.0f / 1024.0f};
                    pg8::gemm_phase<EpiY, pg8::GroupedPanelOrder, true, true, true, (T8_TILED != 0)>(P.lds, g, S, E);
                    mini_y_phase<true>(P, g.A, g.Bt, (size_t)D * FFE / 2, FFE / 2, 1.0f / 1024.0f, plim, ptot, PS(1), PS(2), PS(3), PS(4), PS(5), PS(6), PS(7));
                } else if (FP8_MOE_MASK != 3) {
                    pg8::Gemm g{P.T(), (const bf16*)(P.ws + WS_WM2) + (size_t)li * 8 * D * FFE, 0, D, FFE, (size_t)D * FFE * 2};
                    EpiY E{P.Y(), 1.0f};
                    pg8::gemm_phase<EpiY, pg8::GroupedPanelOrder, true, true>(P.lds, g, S, E);
                    mini_y_phase<false>(P, g.A, g.Bt, (size_t)D * FFE, FFE, 1.0f, plim, ptot, PS(1), PS(2), PS(3), PS(4), PS(5), PS(6), PS(7));
                }
                SEAM(pb + 6);
            }
#undef PS
            if (IN(pb + 7)) { for (int rep = 1; rep < REP_COMB; ++rep) { PHASE_CTX(P); combine_phase(P, li, l == DEPTH - 1, true); xcd_barrier(bar); }
                PHASE_CTX(P); combine_phase(P, li, l == DEPTH - 1); SEAM(pb + 7); }
        }
    }
#undef IN
#undef SEAM
#undef PHASE_CTX
}

extern "C" void kernel_launch(void* const* d_in, const int* in_sizes, int n_in, void* d_out, int out_size, void* d_ws, size_t ws_size, hipStream_t stream) {
    static int grid = 0;
    if (grid == 0) {
        if (n_in != 19 || out_size != NB * SEQ * D || ws_size < WS_END) { fprintf(stderr, "kernel_launch: unexpected shapes (n_in %d, out %d, ws %zu < %zu); nothing launched\n", n_in, out_size, ws_size, (size_t)WS_END); grid = -1; return; }
        int dev = 0, cus = 0, per_cu = 0;
        if (hipGetDevice(&dev) != hipSuccess || hipDeviceGetAttribute(&cus, hipDeviceAttributeMultiprocessorCount, dev) != hipSuccess) { grid = -1; return; }
        if (hipFuncSetAttribute((const void*)mk_fwd, hipFuncAttributeMaxDynamicSharedMemorySize, LDS_BYTES) != hipSuccess) { fprintf(stderr, "kernel_launch: hipFuncSetAttribute failed\n"); grid = -1; return; }
        if (hipOccupancyMaxActiveBlocksPerMultiprocessor(&per_cu, (const void*)mk_fwd, 512, LDS_BYTES) != hipSuccess || per_cu < 1) { fprintf(stderr, "kernel_launch: occupancy query says %d blocks per CU\n", per_cu); }
        (void)hipGetLastError();
        grid = cus;
    }
    if (grid < 0) return;
    if (hipMemsetAsync((char*)d_ws + WS_CTL, 0, CTL_ZERO_BYTES, stream) != hipSuccess) return;
    Args a{};
    for (int i = 0; i < 19; ++i) a.in[i] = (const float*)d_in[i];
    a.out = (float*)d_out; a.ws = (unsigned char*)d_ws;
#if MK_ONE_LAUNCH
    a.ph_lo = 0; a.ph_hi = NPHASE;
    hipLaunchKernelGGL(mk_fwd, dim3(grid), dim3(512), LDS_BYTES, stream, a);
#else
    for (int p = 0; p < NPHASE; ++p) {
        if (p > 0) { const int l = (p - 1) / 8, k = (p - 1) % 8; const bool moe = (l & 1) != 0; if (!moe && (k == 3 || k == 4 || k == 7)) continue; }
        a.ph_lo = p; a.ph_hi = p + 1;
        hipLaunchKernelGGL(mk_fwd, dim3(grid), dim3(512), LDS_BYTES, stream, a);
    }
#endif
}
```
